# Optimizing an MI355X kernel written in HIP

```python
import numpy as np
import jax, jax.numpy as jnp
from jax import lax

D_MODEL = 1024
BATCH = 4
SEQ = 4096
DEPTH = 2

HEAD_DIM = 64
NSA_HEADS = 8
NSA_KV_GROUPS = 2
NSA_CMP_BLOCK = 32
NSA_CMP_STRIDE = 16
NSA_CMP_HIDDEN = 128
NSA_SEL_BLOCK = 64
NSA_TOP_N = 16
NSA_WINDOW = 512
MOBA_HEADS = 8
MOBA_BLOCK = 256
MOBA_TOP_K = 3
GLA_HEADS = 4
GLA_DK = D_MODEL // (2 * GLA_HEADS)
GLA_DV = D_MODEL // GLA_HEADS
GLA_GATE_RANK = 16
GLA_TAU = 16.0
GLA_CHUNK = 64
Q_BLOCK = 32
LN_EPS = 1e-5
DEEPNORM_ALPHA = (2.0 * DEPTH) ** 0.25
DEEPNORM_BETA = (8.0 * DEPTH) ** -0.25
NEG = -1e30
FORCE_BONUS = 1e4

NSA_W = NSA_HEADS * HEAD_DIM
NSA_KV_W = NSA_KV_GROUPS * HEAD_DIM
MOBA_W = MOBA_HEADS * HEAD_DIM
MIX_W = NSA_W + MOBA_W
EVEN_SPLITS = (NSA_W, 6 * NSA_KV_W, 3 * NSA_HEADS, NSA_W, MOBA_W, MOBA_W, MOBA_W, MOBA_W)
EVEN_IN = sum(EVEN_SPLITS)
ODD_SPLITS = (GLA_HEADS * GLA_DK, GLA_HEADS * GLA_DK, GLA_HEADS * GLA_DV, GLA_GATE_RANK, GLA_HEADS * GLA_DV)
ODD_IN = sum(ODD_SPLITS)

kernel_name = "nsa_moba_gla_deepnorm_hybrid"


def _split(h, sizes):
    return jnp.split(h, np.cumsum(sizes)[:-1].tolist(), axis=-1)


def alibi_slopes(n):
    return jnp.asarray(2.0 ** (-8.0 * np.arange(1, n + 1) / n), dtype=jnp.float32)


def masked_softmax(s, valid):
    s = jnp.where(valid, s.astype(jnp.float32), NEG)
    return jax.nn.softmax(s, axis=-1) * valid


def layer_norm(x, g, b):
    xf = x.astype(jnp.float32)
    mu = jnp.mean(xf, axis=-1, keepdims=True)
    var = jnp.mean(jnp.square(xf - mu), axis=-1, keepdims=True)
    return ((xf - mu) * lax.rsqrt(var + LN_EPS) * g + b).astype(x.dtype)


def nsa_mix(q, k_cmp, v_cmp, k_sel, v_sel, k_win, v_win, gates, cmp_pos, cmp_w1, cmp_b1, cmp_w2):
    B, S = q.shape[0], q.shape[1]
    G, Hg, hd = NSA_KV_GROUPS, NSA_HEADS // NSA_KV_GROUPS, HEAD_DIM
    L, d, SB, W, QB = NSA_CMP_BLOCK, NSA_CMP_STRIDE, NSA_SEL_BLOCK, NSA_WINDOW, Q_BLOCK
    scale = hd ** -0.5
    slopes = alibi_slopes(NSA_HEADS).reshape(G, Hg)
    n_cmp = (S - L) // d + 1
    cmp_idx = np.arange(n_cmp)[:, None] * d + np.arange(L)[None, :]
    cmp_end = jnp.asarray(cmp_idx[:, -1])

    def compress(kv, i):
        blocks = kv[:, cmp_idx] + cmp_pos[i][None, None, :, None, :]
        blocks = blocks.transpose(0, 1, 3, 2, 4).reshape(B, n_cmp, G, L * hd)
        hid = jax.nn.silu(blocks @ cmp_w1[i] + cmp_b1[i])
        return hid @ cmp_w2[i]

    kc = compress(k_cmp, 0)
    vc = compress(v_cmp, 1)
    NS = S // SB
    sel_start = np.arange(NS) * SB
    overlap = jnp.asarray(((cmp_idx[:, 0][:, None] <= sel_start[None, :] + SB - 1)
                           & (cmp_idx[:, -1][:, None] >= sel_start[None, :])).astype(np.float32))
    n_top = min(NSA_TOP_N, NS)
    ks_blk = k_sel.reshape(B, NS, SB, G, hd).transpose(0, 3, 1, 2, 4)
    vs_blk = v_sel.reshape(B, NS, SB, G, hd).transpose(0, 3, 1, 2, 4)
    blk_ids = jnp.arange(NS)
    bi = jnp.arange(B)[:, None, None, None]
    gi = jnp.arange(G)[None, :, None, None]
    kw_pad = jnp.pad(k_win, ((0, 0), (W, 0), (0, 0), (0, 0)))
    vw_pad = jnp.pad(v_win, ((0, 0), (W, 0), (0, 0), (0, 0)))

    def block(c):
        q0 = c * QB
        tq = q0 + jnp.arange(QB)
        qc = lax.dynamic_slice_in_dim(q, q0, QB, axis=1).reshape(B, QB, G, Hg, hd)
        gc = lax.dynamic_slice_in_dim(gates, q0, QB, axis=1)
        dist_c = (tq[:, None] - cmp_end[None, :]).astype(jnp.float32)
        s = jnp.einsum('bcgjd,bngd->bgjcn', qc, kc) * scale - slopes[:, :, None, None] * dist_c
        p_cmp = masked_softmax(s, cmp_end[None, :] <= tq[:, None])
        o_cmp = jnp.einsum('bgjcn,bngd->bcgjd', p_cmp.astype(vc.dtype), vc)
        imp = jnp.einsum('bgjcn,ns->bgcs', p_cmp, overlap)
        cur = tq // SB
        forced = ((blk_ids[None, :] == 0) | (blk_ids[None, :] == cur[:, None])
                  | (blk_ids[None, :] == cur[:, None] - 1)).astype(jnp.float32)
        blk_valid = blk_ids[None, :] <= cur[:, None]
        score = jnp.where(blk_valid, imp + FORCE_BONUS * forced, NEG)
        _, idx = lax.top_k(score, n_top)
        kg = ks_blk[bi, gi, idx].reshape(B, G, QB, n_top * SB, hd)
        vg = vs_blk[bi, gi, idx].reshape(B, G, QB, n_top * SB, hd)
        kpos = (idx[..., None] * SB + jnp.arange(SB)).reshape(B, G, QB, n_top * SB)
        dist_s = (tq[:, None] - kpos).astype(jnp.float32)[:, :, None]
        s = jnp.einsum('bcgjd,bgckd->bgjck', qc, kg) * scale - slopes[None, :, :, None, None] * dist_s
        p = masked_softmax(s, (kpos <= tq[:, None])[:, :, None])
        o_sel = jnp.einsum('bgjck,bgckd->bcgjd', p.astype(vg.dtype), vg)
        kw = lax.dynamic_slice_in_dim(kw_pad, q0, W + QB, axis=1)
        vw = lax.dynamic_slice_in_dim(vw_pad, q0, W + QB, axis=1)
        kpos_w = q0 - W + jnp.arange(W + QB)
        rel = tq[:, None] - kpos_w[None, :]
        valid_w = (rel >= 0) & (rel < W) & (kpos_w[None, :] >= 0)
        s = jnp.einsum('bcgjd,bkgd->bgjck', qc, kw) * scale - slopes[:, :, None, None] * rel.astype(jnp.float32)
        p = masked_softmax(s, valid_w)
        o_win = jnp.einsum('bgjck,bkgd->bcgjd', p.astype(vw.dtype), vw)
        g = jax.nn.sigmoid(gc.astype(jnp.float32)).reshape(B, QB, G, Hg, 3)
        o = g[..., 0:1] * o_cmp + g[..., 1:2] * o_sel + g[..., 2:3] * o_win
        return o.reshape(B, QB, NSA_W).astype(q.dtype)

    out = lax.map(block, jnp.arange(S // QB))
    return out.transpose(1, 0, 2, 3).reshape(B, S, NSA_W)


def moba_mix(q, k, v):
    B, S, H, hd = q.shape
    MB, QB = MOBA_BLOCK, Q_BLOCK
    NB = -(-S // MB)
    pad = NB * MB - S
    kp = jnp.pad(k, ((0, 0), (0, pad), (0, 0), (0, 0)))
    vp = jnp.pad(v, ((0, 0), (0, pad), (0, 0), (0, 0)))
    kblk = kp.reshape(B, NB, MB, H, hd)
    kmean = jnp.mean(kblk, axis=2)
    kbt = kblk.transpose(0, 3, 1, 2, 4)
    vbt = vp.reshape(B, NB, MB, H, hd).transpose(0, 3, 1, 2, 4)
    n_top = min(MOBA_TOP_K, NB)
    scale = hd ** -0.5
    slopes = alibi_slopes(H)[:, None, None]
    bi = jnp.arange(B)[:, None, None, None]
    hi = jnp.arange(H)[None, :, None, None]

    def block(c):
        q0 = c * QB
        tq = q0 + jnp.arange(QB)
        qc = lax.dynamic_slice_in_dim(q, q0, QB, axis=1)
        cur = tq // MB
        gate = jnp.einsum('bchd,bnhd->bhcn', qc, kmean).astype(jnp.float32)
        past = jnp.arange(NB)[None, :] < cur[:, None]
        _, idx = lax.top_k(jnp.where(past, gate, NEG), n_top)
        sel_valid = idx < cur[:, None]
        kg = kbt[bi, hi, idx].reshape(B, H, QB, n_top * MB, hd)
        vg = vbt[bi, hi, idx].reshape(B, H, QB, n_top * MB, hd)
        kpos_sel = (idx[..., None] * MB + jnp.arange(MB)).reshape(B, H, QB, n_top * MB)
        valid_sel = jnp.repeat(sel_valid, MB, axis=-1)
        own0 = (q0 // MB) * MB
        ko = lax.dynamic_slice_in_dim(kp, own0, MB, axis=1)
        vo = lax.dynamic_slice_in_dim(vp, own0, MB, axis=1)
        kpos_own = own0 + jnp.arange(MB)
        full = (B, H, QB, MB)
        s = jnp.concatenate([jnp.einsum('bchd,bhckd->bhck', qc, kg),
                             jnp.einsum('bchd,bkhd->bhck', qc, ko)], axis=-1) * scale
        dist = jnp.concatenate([tq[:, None] - kpos_sel,
                                jnp.broadcast_to(tq[:, None] - kpos_own[None, :], full)], axis=-1)
        valid = jnp.concatenate([valid_sel,
                                 jnp.broadcast_to(kpos_own[None, :] <= tq[:, None], full)], axis=-1)
        p = masked_softmax(s - slopes * dist.astype(jnp.float32), valid)
        ns = n_top * MB
        o = (jnp.einsum('bhck,bhckd->bchd', p[..., :ns].astype(vg.dtype), vg)
             + jnp.einsum('bhck,bkhd->bchd', p[..., ns:].astype(vo.dtype), vo))
        return o.reshape(B, QB, H * hd).astype(q.dtype)

    out = lax.map(block, jnp.arange(S // QB))
    return out.transpose(1, 0, 2, 3).reshape(B, S, H * hd)


def gla_mix(q, k, v, log_a):
    B, S, H, dk = q.shape
    dv = v.shape[-1]
    C = GLA_CHUNK
    n = S // C

    def to_chunks(t):
        return t.reshape(B, n, C, H, t.shape[-1]).transpose(1, 0, 3, 2, 4)

    causal = jnp.tril(jnp.ones((C, C), dtype=bool))

    def step(state, inp):
        qc, kc, vc, ac = inp
        b = jnp.cumsum(ac, axis=2)
        inter = jnp.einsum('bhcd,bhde->bhce', qc * jnp.exp(b), state)
        diff = b[:, :, :, None, :] - b[:, :, None, :, :]
        decay = jnp.exp(jnp.where(causal[:, :, None], diff, NEG))
        att = jnp.einsum('bhid,bhjd,bhijd->bhij', qc, kc, decay)
        intra = jnp.einsum('bhij,bhje->bhie', att, vc)
        b_last = b[:, :, -1:, :]
        new_state = (jnp.exp(b_last[:, :, 0, :])[..., None] * state
                     + jnp.einsum('bhcd,bhce->bhde', kc * jnp.exp(b_last - b), vc))
        return new_state, inter + intra

    s0 = jnp.zeros((B, H, dk, dv), jnp.float32)
    _, out = lax.scan(step, s0, (to_chunks(q), to_chunks(k), to_chunks(v), to_chunks(log_a)))
    return out.transpose(1, 0, 3, 2, 4).reshape(B, S, H, dv)


def even_layer(x, w_in, cmp_pos, cmp_w1, cmp_b1, cmp_w2, w_out, ln_g, ln_b):
    B, S, _ = x.shape
    h = x @ w_in
    nq, nkv, ngate, nz, mq, mk, mv, mz = _split(h, EVEN_SPLITS)
    kvs = [t.reshape(B, S, NSA_KV_GROUPS, HEAD_DIM) for t in _split(nkv, (NSA_KV_W,) * 6)]
    o_nsa = nsa_mix(nq.reshape(B, S, NSA_HEADS, HEAD_DIM), *kvs,
                    ngate.reshape(B, S, NSA_HEADS, 3), cmp_pos, cmp_w1, cmp_b1, cmp_w2)
    hs = (B, S, MOBA_HEADS, HEAD_DIM)
    o_moba = moba_mix(mq.reshape(hs), mk.reshape(hs), mv.reshape(hs))
    y = jnp.concatenate([o_nsa * jax.nn.silu(nz), o_moba * jax.nn.silu(mz)], axis=-1) @ w_out
    return layer_norm(DEEPNORM_ALPHA * x + y, ln_g, ln_b)


def odd_layer(x, w_in, gate_w2, gate_b, gn_g, w_out, ln_g, ln_b):
    B, S, _ = x.shape
    h = x @ w_in
    q, k, v, g_lr, z = _split(h, ODD_SPLITS)
    f32 = jnp.float32
    q = q.reshape(B, S, GLA_HEADS, GLA_DK).astype(f32) * (GLA_DK ** -0.5)
    k = k.reshape(B, S, GLA_HEADS, GLA_DK).astype(f32)
    v = v.reshape(B, S, GLA_HEADS, GLA_DV).astype(f32)
    log_a = jax.nn.log_sigmoid((g_lr @ gate_w2 + gate_b).astype(f32)) / GLA_TAU
    o = gla_mix(q, k, v, log_a.reshape(B, S, GLA_HEADS, GLA_DK))
    o = o * lax.rsqrt(jnp.mean(jnp.square(o), axis=-1, keepdims=True) + LN_EPS)
    o = o * gn_g.reshape(GLA_HEADS, GLA_DV)
    y = (o.reshape(B, S, GLA_HEADS * GLA_DV).astype(x.dtype) * jax.nn.silu(z)) @ w_out
    return layer_norm(DEEPNORM_ALPHA * x + y, ln_g, ln_b)


def setup_inputs(seed: int = 0) -> dict:
    key = jax.random.key(seed)
    ks = jax.random.split(key, 16)
    NE = (DEPTH + 1) // 2
    NO = DEPTH // 2
    f32 = jnp.float32

    def nrm(k, shape, scale):
        return jax.random.normal(k, shape, f32) * scale

    L, hd, HID = NSA_CMP_BLOCK, HEAD_DIM, NSA_CMP_HIDDEN
    return {
        "x": jax.random.normal(ks[0], (BATCH, SEQ, D_MODEL), f32),
        "ev_w_in": nrm(ks[1], (NE, D_MODEL, EVEN_IN), D_MODEL ** -0.5),
        "ev_cmp_pos": nrm(ks[2], (NE, 2, L, hd), 0.02),
        "ev_cmp_w1": nrm(ks[3], (NE, 2, L * hd, HID), (L * hd) ** -0.5),
        "ev_cmp_b1": nrm(ks[4], (NE, 2, HID), 0.01),
        "ev_cmp_w2": nrm(ks[5], (NE, 2, HID, hd), HID ** -0.5),
        "ev_w_out": nrm(ks[6], (NE, MIX_W, D_MODEL), DEEPNORM_BETA * MIX_W ** -0.5),
        "ev_ln_g": 1.0 + nrm(ks[7], (NE, D_MODEL), 0.01),
        "ev_ln_b": nrm(ks[8], (NE, D_MODEL), 0.01),
        "od_w_in": nrm(ks[9], (NO, D_MODEL, ODD_IN), D_MODEL ** -0.5),
        "od_gate_w2": nrm(ks[10], (NO, GLA_GATE_RANK, GLA_HEADS * GLA_DK), GLA_GATE_RANK ** -0.5),
        "od_gate_b": nrm(ks[11], (NO, GLA_HEADS * GLA_DK), 0.1),
        "od_gn_g": 1.0 + nrm(ks[12], (NO, GLA_HEADS * GLA_DV), 0.01),
        "od_w_out": nrm(ks[13], (NO, GLA_HEADS * GLA_DV, D_MODEL), DEEPNORM_BETA * (GLA_HEADS * GLA_DV) ** -0.5),
        "od_ln_g": 1.0 + nrm(ks[14], (NO, D_MODEL), 0.01),
        "od_ln_b": nrm(ks[15], (NO, D_MODEL), 0.01),
    }


def reference(x, ev_w_in, ev_cmp_pos, ev_cmp_w1, ev_cmp_b1, ev_cmp_w2, ev_w_out, ev_ln_g, ev_ln_b,
              od_w_in, od_gate_w2, od_gate_b, od_gn_g, od_w_out, od_ln_g, od_ln_b):
    for layer in range(DEPTH):
        i = layer // 2
        if layer % 2 == 0:
            x = even_layer(x, ev_w_in[i], ev_cmp_pos[i], ev_cmp_w1[i], ev_cmp_b1[i], ev_cmp_w2[i],
                           ev_w_out[i], ev_ln_g[i], ev_ln_b[i])
        else:
            x = odd_layer(x, od_w_in[i], od_gate_w2[i], od_gate_b[i], od_gn_g[i],
                          od_w_out[i], od_ln_g[i], od_ln_b[i])
    return x
```

```cpp
#include <hip/hip_runtime.h>
#include <hip/hip_cooperative_groups.h>
#include <cstdio>
#include <cstdint>
namespace cg = cooperative_groups;

typedef unsigned short bf16_t;
typedef short bf16x8 __attribute__((ext_vector_type(8)));
typedef float f32x4 __attribute__((ext_vector_type(4)));

constexpr int B_ = 4, S_ = 4096, M_ = B_ * S_, D_ = 1024;
constexpr int P0 = 4096;
constexpr int P1 = 3328;
constexpr int EVEN_IN = 3864, ODD_IN = 3088;
constexpr int C_NQ = 0, C_KCMP = 512, C_VCMP = 640, C_KSEL = 768, C_VSEL = 896, C_KWIN = 1024, C_VWIN = 1152;
constexpr int C_NZ = 1280, C_MQ = 1792, C_MK = 2304, C_MV = 2816, C_MZ = 3328, C_NG = 3840;
constexpr int G_Q = 0, G_K = 512, G_V = 1024, G_Z = 2048, G_LR = 3072;
constexpr int NCMP = 255;
constexpr float ALPHA = 1.4142135623730951f;
constexpr float LN_EPS = 1e-5f;

constexpr size_t MiB = 1u << 20;
constexpr size_t WS_WT0 = 1 * MiB;
constexpr size_t WS_WO0 = 9 * MiB;
constexpr size_t WS_WT1 = 11 * MiB;
constexpr size_t WS_WO1 = 18 * MiB;
constexpr size_t WS_XB = 20 * MiB;
constexpr size_t WS_MIX = 52 * MiB;
constexpr size_t WS_H = 84 * MiB;
constexpr size_t WS_G = 212 * MiB;
constexpr size_t WS_KC = 245 * MiB;
constexpr size_t WS_VC = 246 * MiB;
constexpr size_t WS_KM = 247 * MiB;
constexpr size_t WS_END = 256 * MiB;

struct Params { const float* in[16]; float* out; unsigned char* ws; };

__device__ __forceinline__ float bf2f(bf16_t v) { return __uint_as_float(((unsigned)v) << 16); }
__device__ __forceinline__ bf16_t f2bf(float f) { unsigned u = __float_as_uint(f); return (bf16_t)((u + 0x7fffu + ((u >> 16) & 1u)) >> 16); }
__device__ __forceinline__ float wave_sum(float v) {
#pragma unroll
  for (int o = 1; o < 64; o <<= 1) v += __shfl_xor(v, o);
  return v;
}
__device__ __forceinline__ float wave_max(float v) {
#pragma unroll
  for (int o = 1; o < 64; o <<= 1) v = fmaxf(v, __shfl_xor(v, o));
  return v;
}
__device__ __forceinline__ float silu_f(float z) { return z / (1.f + __expf(-z)); }
__device__ __forceinline__ float sigmoid_f(float z) { return 1.f / (1.f + __expf(-z)); }

__device__ __forceinline__ int colmap0(int c) {
  if (c < 1280) return c;
  if (c < 1792) return 1304 + (c - 1280);
  if (c < 3840) return 1816 + (c - 1792);
  if (c < 3864) return 1280 + (c - 3840);
  return -1;
}
__device__ __forceinline__ int colmap1(int c) {
  if (c < 2048) return c;
  if (c < 3072) return 2064 + (c - 2048);
  if (c < 3088) return 2048 + (c - 3072);
  return -1;
}

__device__ __forceinline__ void transpose_tile(const float* __restrict__ W, int K, int Nsrc, bf16_t* __restrict__ Wt, int which, int tile, int ntn, float* sm) {
  const int tid = threadIdx.x;
  const int nb = tile % ntn, kb = tile / ntn, n0 = nb * 64, k0 = kb * 64;
#pragma unroll
  for (int i = 0; i < 8; ++i) {
    const int kk = i * 8 + (tid >> 6), nn = tid & 63;
    const int c = n0 + nn;
    const int src = which == 0 ? colmap0(c) : (which == 1 ? colmap1(c) : c);
    sm[kk * 65 + nn] = src >= 0 ? W[(size_t)(k0 + kk) * Nsrc + src] : 0.f;
  }
  __syncthreads();
#pragma unroll
  for (int i = 0; i < 8; ++i) {
    const int nn = i * 8 + (tid >> 6), kk = tid & 63;
    Wt[(size_t)(n0 + nn) * K + k0 + kk] = f2bf(sm[kk * 65 + nn]);
  }
  __syncthreads();
}

__device__ __forceinline__ void gemm_tile(const bf16_t* __restrict__ A, const bf16_t* __restrict__ Bt, int K, int m0, int n0, int mode, void* outp, int ldc, unsigned char* smem) {
  bf16_t* As = (bf16_t*)smem;
  bf16_t* Bs = As + 128 * 72;
  const int tid = threadIdx.x, lane = tid & 63, wid = tid >> 6, wm = wid >> 1, wn = wid & 1;
  f32x4 acc[2][4];
#pragma unroll
  for (int i = 0; i < 2; ++i)
#pragma unroll
    for (int j = 0; j < 4; ++j) acc[i][j] = (f32x4){0.f, 0.f, 0.f, 0.f};
  for (int k0 = 0; k0 < K; k0 += 64) {
#pragma unroll
    for (int i = 0; i < 2; ++i) {
      const int idx = tid + i * 512, r = idx >> 3, c = (idx & 7) * 8;
      *(uint4*)(As + r * 72 + c) = *(const uint4*)(A + (size_t)(m0 + r) * K + k0 + c);
      *(uint4*)(Bs + r * 72 + c) = *(const uint4*)(Bt + (size_t)(n0 + r) * K + k0 + c);
    }
    __syncthreads();
#pragma unroll
    for (int kk = 0; kk < 64; kk += 32) {
      bf16x8 a[2], b[4];
#pragma unroll
      for (int i = 0; i < 2; ++i) a[i] = *(const bf16x8*)(As + (wm * 32 + i * 16 + (lane & 15)) * 72 + kk + (lane >> 4) * 8);
#pragma unroll
      for (int j = 0; j < 4; ++j) b[j] = *(const bf16x8*)(Bs + (wn * 64 + j * 16 + (lane & 15)) * 72 + kk + (lane >> 4) * 8);
#pragma unroll
      for (int i = 0; i < 2; ++i)
#pragma unroll
        for (int j = 0; j < 4; ++j) acc[i][j] = __builtin_amdgcn_mfma_f32_16x16x32_bf16(a[i], b[j], acc[i][j], 0, 0, 0);
    }
    __syncthreads();
  }
#pragma unroll
  for (int i = 0; i < 2; ++i)
#pragma unroll
    for (int j = 0; j < 4; ++j)
#pragma unroll
      for (int r = 0; r < 4; ++r) {
        const int row = m0 + wm * 32 + i * 16 + (lane >> 4) * 4 + r, col = n0 + wn * 64 + j * 16 + (lane & 15);
        if (mode == 0) ((bf16_t*)outp)[(size_t)row * ldc + col] = f2bf(acc[i][j][r]);
        else ((float*)outp)[(size_t)row * ldc + col] = acc[i][j][r];
      }
}
__device__ __forceinline__ void gemm_phase(const bf16_t* A, const bf16_t* Bt, int K, int N, int mode, void* outp, int ldc, unsigned char* smem) {
  const int ntn = N / 128, ntm = M_ / 128;
  for (int t = blockIdx.x; t < ntn * ntm; t += gridDim.x) {
    const int tn = t % ntn, tm = t / ntn;
    gemm_tile(A, Bt, K, tm * 128, tn * 128, mode, outp, ldc, smem);
  }
}

__device__ __forceinline__ void ln_phase(const float* xin, const float* Y, const float* g, const float* bb, float* out, bf16_t* outb) {
  const int lane = threadIdx.x & 63, wid = threadIdx.x >> 6;
  for (int row = blockIdx.x * 8 + wid; row < M_; row += gridDim.x * 8) {
    const float4* xr = (const float4*)(xin + (size_t)row * D_);
    const float4* yr = (const float4*)(Y + (size_t)row * D_);
    float4 v[4]; float s = 0.f;
#pragma unroll
    for (int j = 0; j < 4; ++j) {
      const float4 a = xr[j * 64 + lane], y = yr[j * 64 + lane];
      v[j].x = ALPHA * a.x + y.x; v[j].y = ALPHA * a.y + y.y; v[j].z = ALPHA * a.z + y.z; v[j].w = ALPHA * a.w + y.w;
      s += (v[j].x + v[j].y) + (v[j].z + v[j].w);
    }
    const float mean = wave_sum(s) * (1.f / D_);
    float q = 0.f;
#pragma unroll
    for (int j = 0; j < 4; ++j) {
      v[j].x -= mean; v[j].y -= mean; v[j].z -= mean; v[j].w -= mean;
      q += (v[j].x * v[j].x + v[j].y * v[j].y) + (v[j].z * v[j].z + v[j].w * v[j].w);
    }
    const float rstd = 1.f / sqrtf(wave_sum(q) * (1.f / D_) + LN_EPS);
#pragma unroll
    for (int j = 0; j < 4; ++j) {
      const float4 gg = ((const float4*)g)[j * 64 + lane], bv = ((const float4*)bb)[j * 64 + lane];
      float4 o;
      o.x = v[j].x * rstd * gg.x + bv.x; o.y = v[j].y * rstd * gg.y + bv.y; o.z = v[j].z * rstd * gg.z + bv.z; o.w = v[j].w * rstd * gg.w + bv.w;
      ((float4*)(out + (size_t)row * D_))[j * 64 + lane] = o;
      if (outb) {
        ushort4 ob; ob.x = f2bf(o.x); ob.y = f2bf(o.y); ob.z = f2bf(o.z); ob.w = f2bf(o.w);
        ((ushort4*)(outb + (size_t)row * D_))[j * 64 + lane] = ob;
      }
    }
  }
}

__device__ __forceinline__ void compress_item(const Params& P, int item, float* sm) {
  const bf16_t* H0 = (const bf16_t*)(P.ws + WS_H);
  const int tid = threadIdx.x;
  const int g = item & 1; int r = item >> 1; const int n = r % NCMP; r /= NCMP; const int b = r & 3; const int i = r >> 2;
  const float* pos = P.in[2] + i * 2048;
  const float* w1 = P.in[3] + (size_t)i * 2048 * 128;
  const float* b1 = P.in[4] + i * 128;
  const float* w2 = P.in[5] + (size_t)i * 128 * 64;
  float* blk = sm;
  float* part = sm + 2048;
  float* hid = sm + 2048 + 512;
  const int col = (i == 0 ? C_KCMP : C_VCMP) + g * 64;
#pragma unroll
  for (int k = 0; k < 4; ++k) {
    const int f = tid + k * 512, l = f >> 6, d = f & 63;
    blk[f] = bf2f(H0[((size_t)b * S_ + 16 * n + l) * P0 + col + d]) + pos[f];
  }
  __syncthreads();
  const int hh = tid & 127, pt = tid >> 7;
  float acc = 0.f;
  for (int f = pt * 512; f < pt * 512 + 512; ++f) acc += blk[f] * w1[(size_t)f * 128 + hh];
  part[pt * 128 + hh] = acc;
  __syncthreads();
  if (tid < 128) {
    const float a = part[tid] + part[128 + tid] + part[256 + tid] + part[384 + tid] + b1[tid];
    hid[tid] = silu_f(a);
  }
  __syncthreads();
  if (tid < 64) {
    float o = 0.f;
    for (int k = 0; k < 128; ++k) o += hid[k] * w2[k * 64 + tid];
    float* dst = (float*)(P.ws + (i == 0 ? WS_KC : WS_VC));
    dst[(((size_t)b * NCMP + n) * 2 + g) * 64 + tid] = o;
  }
  __syncthreads();
}
__device__ __forceinline__ void kmean_item(const Params& P, int item, int lane) {
  const bf16_t* H0 = (const bf16_t*)(P.ws + WS_H);
  const int h = item & 7, n = (item >> 3) & 15, b = item >> 7;
  float s = 0.f;
  for (int k = 0; k < 256; ++k) s += bf2f(H0[((size_t)b * S_ + n * 256 + k) * P0 + C_MK + h * 64 + lane]);
  ((float*)(P.ws + WS_KM))[(((size_t)b * 16 + n) * 8 + h) * 64 + lane] = s * (1.f / 256.f);
}

template <int NH>
__device__ __forceinline__ void attend_block(const bf16_t* __restrict__ Kp, const bf16_t* __restrict__ Vp, size_t rowbase, int kp0, int t, int kmin,
                                             const float* qs, float* pb, const float* slope, float* m, float* l, float* o, int lane) {
  asm volatile("" ::: "memory");
  const int kp = kp0 + lane;
  const bool valid = (kp <= t) && (kp >= kmin);
  const uint4* kr = (const uint4*)(Kp + (rowbase + kp) * P0);
  float dot[NH];
#pragma unroll
  for (int j = 0; j < NH; ++j) dot[j] = 0.f;
#pragma unroll 1
  for (int c = 0; c < 8; ++c) {
    asm volatile("" ::: "memory");
    const uint4 u = kr[c];
    float kv[8];
    kv[0] = __uint_as_float(u.x << 16); kv[1] = __uint_as_float(u.x & 0xffff0000u);
    kv[2] = __uint_as_float(u.y << 16); kv[3] = __uint_as_float(u.y & 0xffff0000u);
    kv[4] = __uint_as_float(u.z << 16); kv[5] = __uint_as_float(u.z & 0xffff0000u);
    kv[6] = __uint_as_float(u.w << 16); kv[7] = __uint_as_float(u.w & 0xffff0000u);
#pragma unroll
    for (int j = 0; j < NH; ++j) {
      const float4 q0 = *(const float4*)(qs + j * 64 + c * 8), q1 = *(const float4*)(qs + j * 64 + c * 8 + 4);
      dot[j] += kv[0] * q0.x + kv[1] * q0.y + kv[2] * q0.z + kv[3] * q0.w + kv[4] * q1.x + kv[5] * q1.y + kv[6] * q1.z + kv[7] * q1.w;
    }
  }
#pragma unroll
  for (int j = 0; j < NH; ++j) {
    const float s = valid ? 0.125f * dot[j] - slope[j] * (float)(t - kp) : -1e30f;
    const float mn = fmaxf(m[j], wave_max(s));
    const float al = __expf(m[j] - mn);
    const float p = valid ? __expf(s - mn) : 0.f;
    l[j] = l[j] * al + wave_sum(p);
    o[j] *= al; m[j] = mn;
    pb[j * 64 + lane] = p;
  }
  __builtin_amdgcn_wave_barrier();
  const bf16_t* vr = Vp + (rowbase + kp0) * P0 + lane;
#pragma unroll 8
  for (int k = 0; k < 64; ++k) {
    const float v = bf2f(vr[(size_t)k * P0]);
#pragma unroll
    for (int j = 0; j < NH; ++j) o[j] += pb[j * 64 + k] * v;
  }
  __builtin_amdgcn_wave_barrier();
}

__device__ __forceinline__ void nsa_item(const Params& P, int b, int g, int t, float* wsm, int lane) {
  const bf16_t* H0 = (const bf16_t*)(P.ws + WS_H);
  const float* KC = (const float*)(P.ws + WS_KC);
  const float* VC = (const float*)(P.ws + WS_VC);
  bf16_t* MIX = (bf16_t*)(P.ws + WS_MIX);
  float* qs = wsm;
  float* pc = wsm + 256;
  float* pb = wsm + 1280;
  const size_t row = (size_t)b * S_ + t;
  const bf16_t* hrow = H0 + row * P0;
  float slope[4];
#pragma unroll
  for (int j = 0; j < 4; ++j) { qs[j * 64 + lane] = bf2f(hrow[C_NQ + (g * 4 + j) * 64 + lane]); slope[j] = exp2f(-(float)(g * 4 + j + 1)); }
  __builtin_amdgcn_wave_barrier();
  const int nv = t >= 31 ? (t - 31) / 16 + 1 : 0;
#pragma unroll 1
  for (int c = 0; c < 4; ++c) {
    asm volatile("" ::: "memory");
    const int n = c * 64 + lane;
    float dot[4] = {0.f, 0.f, 0.f, 0.f};
    if (n < nv) {
      const float4* kr = (const float4*)(KC + (((size_t)b * NCMP + n) * 2 + g) * 64);
#pragma unroll 4
      for (int d4 = 0; d4 < 16; ++d4) {
        const float4 kv = kr[d4];
#pragma unroll
        for (int j = 0; j < 4; ++j) {
          const float4 q = *(const float4*)(qs + j * 64 + d4 * 4);
          dot[j] += kv.x * q.x + kv.y * q.y + kv.z * q.z + kv.w * q.w;
        }
      }
    }
#pragma unroll
    for (int j = 0; j < 4; ++j) pc[j * 256 + n] = (n < nv) ? 0.125f * dot[j] - slope[j] * (float)(t - (16 * n + 31)) : -1e30f;
  }
  __builtin_amdgcn_wave_barrier();
#pragma unroll
  for (int j = 0; j < 4; ++j) {
    float sc[4];
#pragma unroll
    for (int c = 0; c < 4; ++c) sc[c] = pc[j * 256 + c * 64 + lane];
    float mx = fmaxf(fmaxf(sc[0], sc[1]), fmaxf(sc[2], sc[3]));
    mx = wave_max(mx);
    float sum = 0.f;
#pragma unroll
    for (int c = 0; c < 4; ++c) { const int n = c * 64 + lane; const float p = (n < nv) ? __expf(sc[c] - mx) : 0.f; sc[c] = p; sum += p; }
    sum = wave_sum(sum);
    const float inv = nv > 0 ? 1.f / sum : 0.f;
#pragma unroll
    for (int c = 0; c < 4; ++c) pc[j * 256 + c * 64 + lane] = sc[c] * inv;
  }
  __builtin_amdgcn_wave_barrier();
  float ocmp[4] = {0.f, 0.f, 0.f, 0.f};
  for (int n = 0; n < nv; ++n) {
    const float v = VC[(((size_t)b * NCMP + n) * 2 + g) * 64 + lane];
#pragma unroll
    for (int j = 0; j < 4; ++j) ocmp[j] += pc[j * 256 + n] * v;
  }
  float imp = 0.f;
  {
    const int lo = max(0, 4 * lane - 1), hi = min(NCMP - 1, 4 * lane + 3);
    for (int n = lo; n <= hi; ++n) imp += (pc[n] + pc[256 + n]) + (pc[512 + n] + pc[768 + n]);
  }
  const int cur = t >> 6;
  const bool bvalid = lane <= cur;
  const bool forced = (lane == 0) || (lane == cur) || (lane == cur - 1);
  const float key = bvalid ? (forced ? 1e9f : imp) : -1e30f;
  int rank = 0;
  for (int s2 = 0; s2 < 64; ++s2) {
    const float ks = __shfl(key, s2);
    rank += (ks > key || (ks == key && s2 < lane)) ? 1 : 0;
  }
  const unsigned long long selmask = __ballot(bvalid && rank < 16);
  float m[4], l[4], osel[4], owin[4];
#pragma unroll
  for (int j = 0; j < 4; ++j) { m[j] = -1e30f; l[j] = 0.f; osel[j] = 0.f; }
  {
    unsigned long long mk = selmask;
    while (mk) {
      const int blk = __builtin_ctzll(mk); mk &= mk - 1;
      attend_block<4>(H0 + C_KSEL + g * 64, H0 + C_VSEL + g * 64, (size_t)b * S_, blk * 64, t, 0, qs, pb, slope, m, l, osel, lane);
    }
  }
#pragma unroll
  for (int j = 0; j < 4; ++j) { osel[j] /= l[j]; m[j] = -1e30f; l[j] = 0.f; owin[j] = 0.f; }
  {
    const int kmin = t - 511;
    const int b0 = (kmin > 0 ? kmin : 0) >> 6;
    for (int blk = b0; blk <= cur; ++blk)
      attend_block<4>(H0 + C_KWIN + g * 64, H0 + C_VWIN + g * 64, (size_t)b * S_, blk * 64, t, kmin, qs, pb, slope, m, l, owin, lane);
  }
#pragma unroll
  for (int j = 0; j < 4; ++j) {
    const int h = g * 4 + j;
    const float g0 = sigmoid_f(bf2f(hrow[C_NG + h * 3 + 0])), g1 = sigmoid_f(bf2f(hrow[C_NG + h * 3 + 1])), g2 = sigmoid_f(bf2f(hrow[C_NG + h * 3 + 2]));
    const float o = g0 * ocmp[j] + g1 * osel[j] + g2 * (owin[j] / l[j]);
    const float z = bf2f(hrow[C_NZ + h * 64 + lane]);
    MIX[row * D_ + h * 64 + lane] = f2bf(o * silu_f(z));
  }
}

__device__ __forceinline__ void moba_item(const Params& P, int b, int h, int t, float* wsm, int lane) {
  const bf16_t* H0 = (const bf16_t*)(P.ws + WS_H);
  const float* KM = (const float*)(P.ws + WS_KM);
  bf16_t* MIX = (bf16_t*)(P.ws + WS_MIX);
  float* qs = wsm;
  float* pb = wsm + 1280;
  const size_t row = (size_t)b * S_ + t;
  const bf16_t* hrow = H0 + row * P0;
  qs[lane] = bf2f(hrow[C_MQ + h * 64 + lane]);
  __builtin_amdgcn_wave_barrier();
  float slope[1] = {exp2f(-(float)(h + 1))};
  const int cur = t >> 8;
  float gate = -1e30f;
  if (lane < cur) {
    const float4* kr = (const float4*)(KM + (((size_t)b * 16 + lane) * 8 + h) * 64);
    float d = 0.f;
#pragma unroll 4
    for (int d4 = 0; d4 < 16; ++d4) { const float4 kv = kr[d4]; const float4 q = *(const float4*)(qs + d4 * 4); d += kv.x * q.x + kv.y * q.y + kv.z * q.z + kv.w * q.w; }
    gate = d;
  }
  int rank = 0;
  for (int s2 = 0; s2 < 16; ++s2) {
    const float ks = __shfl(gate, s2);
    rank += (ks > gate || (ks == gate && s2 < lane)) ? 1 : 0;
  }
  unsigned long long mk = __ballot(lane < cur && rank < 3) | (1ull << cur);
  float m[1] = {-1e30f}, l[1] = {0.f}, o[1] = {0.f};
  while (mk) {
    const int blk = __builtin_ctzll(mk); mk &= mk - 1;
    for (int c = 0; c < 4; ++c) {
      const int kp0 = blk * 256 + c * 64;
      if (kp0 > t) break;
      attend_block<1>(H0 + C_MK + h * 64, H0 + C_MV + h * 64, (size_t)b * S_, kp0, t, 0, qs, pb, slope, m, l, o, lane);
    }
  }
  const float z = bf2f(hrow[C_MZ + h * 64 + lane]);
  MIX[row * D_ + 512 + h * 64 + lane] = f2bf((o[0] / l[0]) * silu_f(z));
}

__device__ __forceinline__ void gla_gate_phase(const Params& P) {
  const bf16_t* H1 = (const bf16_t*)(P.ws + WS_H);
  float* G = (float*)(P.ws + WS_G);
  const float* w2 = P.in[10]; const float* gb = P.in[11];
  const size_t total = (size_t)M_ * 512;
  for (size_t i = (size_t)blockIdx.x * 512 + threadIdx.x; i < total; i += (size_t)gridDim.x * 512) {
    const int c = (int)(i & 511); const size_t row = i >> 9;
    float x = gb[c];
#pragma unroll
    for (int r = 0; r < 16; ++r) x += bf2f(H1[row * P1 + G_LR + r]) * w2[r * 512 + c];
    const float ls = fminf(x, 0.f) - log1pf(__expf(-fabsf(x)));
    G[i] = ls * (1.f / 16.f);
  }
}
__device__ __forceinline__ void gla_scan_vblock(const Params& P, int vb) {
  const bf16_t* __restrict__ H1 = (const bf16_t*)(P.ws + WS_H);
  const float* __restrict__ G = (const float*)(P.ws + WS_G);
  bf16_t* __restrict__ O = (bf16_t*)(P.ws + WS_XB);
  const int tid = threadIdx.x, lane = tid & 63, wid = tid >> 6;
  const int eh = vb & 1, h = (vb >> 1) & 3, b = vb >> 3;
  const int e = eh * 128 + wid * 16 + (lane >> 2), dq = lane & 3;
  float St[32];
#pragma unroll
  for (int i = 0; i < 32; ++i) St[i] = 0.f;
  const float qscale = 0.08838834764831845f;
  for (int t = 0; t < S_; ++t) {
    const size_t row = (size_t)b * S_ + t;
    const float4* gr = (const float4*)(G + row * 512 + h * 128 + dq * 32);
    const uint4* kr = (const uint4*)(H1 + row * P1 + G_K + h * 128 + dq * 32);
    const uint4* qr = (const uint4*)(H1 + row * P1 + G_Q + h * 128 + dq * 32);
    const float v = bf2f(H1[row * P1 + G_V + h * 256 + e]);
    float o = 0.f;
#pragma unroll
    for (int c = 0; c < 4; ++c) {
      const uint4 ku = kr[c], qu = qr[c];
      const float4 g0 = gr[2 * c], g1 = gr[2 * c + 1];
      const float kk[8] = {__uint_as_float(ku.x << 16), __uint_as_float(ku.x & 0xffff0000u), __uint_as_float(ku.y << 16), __uint_as_float(ku.y & 0xffff0000u),
                           __uint_as_float(ku.z << 16), __uint_as_float(ku.z & 0xffff0000u), __uint_as_float(ku.w << 16), __uint_as_float(ku.w & 0xffff0000u)};
      const float qq[8] = {__uint_as_float(qu.x << 16), __uint_as_float(qu.x & 0xffff0000u), __uint_as_float(qu.y << 16), __uint_as_float(qu.y & 0xffff0000u),
                           __uint_as_float(qu.z << 16), __uint_as_float(qu.z & 0xffff0000u), __uint_as_float(qu.w << 16), __uint_as_float(qu.w & 0xffff0000u)};
      const float gg[8] = {g0.x, g0.y, g0.z, g0.w, g1.x, g1.y, g1.z, g1.w};
#pragma unroll
      for (int i = 0; i < 8; ++i) {
        const float a = __expf(gg[i]);
        St[c * 8 + i] = a * St[c * 8 + i] + kk[i] * v;
        o += qq[i] * St[c * 8 + i];
      }
    }
    o += __shfl_xor(o, 1); o += __shfl_xor(o, 2);
    if (dq == 0) O[row * D_ + h * 256 + e] = f2bf(o * qscale);
  }
}
__device__ __forceinline__ void gla_norm_phase(const Params& P) {
  const bf16_t* H1 = (const bf16_t*)(P.ws + WS_H);
  const bf16_t* O = (const bf16_t*)(P.ws + WS_XB);
  bf16_t* MIX = (bf16_t*)(P.ws + WS_MIX);
  const float* gn = P.in[12];
  const int lane = threadIdx.x & 63, wid = threadIdx.x >> 6;
  for (int it = blockIdx.x * 8 + wid; it < M_ * 4; it += gridDim.x * 8) {
    const int h = it & 3; const size_t row = it >> 2;
    float v[4]; float ss = 0.f;
#pragma unroll
    for (int k = 0; k < 4; ++k) { v[k] = bf2f(O[row * D_ + h * 256 + k * 64 + lane]); ss += v[k] * v[k]; }
    const float r = 1.f / sqrtf(wave_sum(ss) * (1.f / 256.f) + LN_EPS);
#pragma unroll
    for (int k = 0; k < 4; ++k) {
      const int c = h * 256 + k * 64 + lane;
      const float z = bf2f(H1[row * P1 + G_Z + c]);
      MIX[row * D_ + c] = f2bf(v[k] * r * gn[c] * silu_f(z));
    }
  }
}

__global__ void __launch_bounds__(512) fwd_megakernel(Params P) {
  cg::grid_group grid = cg::this_grid();
  extern __shared__ __attribute__((aligned(16))) unsigned char smem[];
  const int tid = threadIdx.x, lane = tid & 63, wid = tid >> 6;
  unsigned char* ws = P.ws;
  bf16_t* XB = (bf16_t*)(ws + WS_XB);
  bf16_t* MIX = (bf16_t*)(ws + WS_MIX);
  bf16_t* Hb = (bf16_t*)(ws + WS_H);
  float* Y = (float*)(ws + WS_H);

  {
    const float4* x4 = (const float4*)P.in[0];
    const size_t n4 = (size_t)M_ * D_ / 4;
    for (size_t i = (size_t)blockIdx.x * 512 + tid; i < n4; i += (size_t)gridDim.x * 512) {
      const float4 v = x4[i]; ushort4 o; o.x = f2bf(v.x); o.y = f2bf(v.y); o.z = f2bf(v.z); o.w = f2bf(v.w);
      ((ushort4*)XB)[i] = o;
    }
    constexpr int T0 = (P0 / 64) * 16, T1 = 16 * 16, T2 = (P1 / 64) * 16, T3 = 16 * 16;
    for (int it = blockIdx.x; it < T0 + T1 + T2 + T3; it += gridDim.x) {
      int r = it;
      if (r < T0) { transpose_tile(P.in[1], D_, EVEN_IN, (bf16_t*)(ws + WS_WT0), 0, r, P0 / 64, (float*)smem); continue; } r -= T0;
      if (r < T1) { transpose_tile(P.in[6], D_, D_, (bf16_t*)(ws + WS_WO0), 2, r, 16, (float*)smem); continue; } r -= T1;
      if (r < T2) { transpose_tile(P.in[9], D_, ODD_IN, (bf16_t*)(ws + WS_WT1), 1, r, P1 / 64, (float*)smem); continue; } r -= T2;
      transpose_tile(P.in[13], D_, D_, (bf16_t*)(ws + WS_WO1), 2, r, 16, (float*)smem);
    }
  }
  grid.sync();
  gemm_phase(XB, (const bf16_t*)(ws + WS_WT0), D_, P0, 0, Hb, P0, smem);
  grid.sync();
  {
    const int NC = 2 * B_ * NCMP * 2;
    for (int it = blockIdx.x; it < NC; it += gridDim.x) compress_item(P, it, (float*)smem);
    for (int it = blockIdx.x * 8 + wid; it < B_ * 16 * 8; it += gridDim.x * 8) kmean_item(P, it, lane);
  }
  grid.sync();
  {
    float* wsm = (float*)smem + wid * 1536;
    const int NV_NSA = B_ * 2 * (S_ / 8), NV_MOBA = B_ * 8 * (S_ / 8);
    for (int vb = blockIdx.x; vb < NV_NSA + NV_MOBA; vb += gridDim.x) {
      if (vb < NV_NSA) {
        const int tb = vb % (S_ / 8), bg = vb / (S_ / 8);
        nsa_item(P, bg >> 1, bg & 1, tb * 8 + wid, wsm, lane);
      } else {
        const int v2 = vb - NV_NSA; const int tb = v2 % (S_ / 8), bh = v2 / (S_ / 8);
        moba_item(P, bh >> 3, bh & 7, tb * 8 + wid, wsm, lane);
      }
    }
  }
  grid.sync();
  gemm_phase(MIX, (const bf16_t*)(ws + WS_WO0), D_, D_, 1, Y, D_, smem);
  grid.sync();
  ln_phase(P.in[0], Y, P.in[7], P.in[8], P.out, XB);
  grid.sync();
  gemm_phase(XB, (const bf16_t*)(ws + WS_WT1), D_, P1, 0, Hb, P1, smem);
  grid.sync();
  gla_gate_phase(P);
  grid.sync();
  for (int vb = blockIdx.x; vb < B_ * 4 * 2; vb += gridDim.x) gla_scan_vblock(P, vb);
  grid.sync();
  gla_norm_phase(P);
  grid.sync();
  gemm_phase(MIX, (const bf16_t*)(ws + WS_WO1), D_, D_, 1, Y, D_, smem);
  grid.sync();
  ln_phase(P.out, Y, P.in[14], P.in[15], P.out, nullptr);
}

extern "C" void kernel_launch(void* const* d_in, const int* in_sizes, int n_in, void* d_out, int out_size,
                              void* d_ws, size_t ws_size, hipStream_t stream) {
  constexpr size_t kDynLds = 65536;
  static int grid_blocks = 0;
  if (!grid_blocks) {
    int dev = 0, cus = 0, per_cu = 0;
    (void)hipGetDevice(&dev);
    (void)hipDeviceGetAttribute(&cus, hipDeviceAttributeMultiprocessorCount, dev);
    (void)hipFuncSetAttribute((const void*)fwd_megakernel, hipFuncAttributeMaxDynamicSharedMemorySize, (int)kDynLds);
    (void)hipOccupancyMaxActiveBlocksPerMultiprocessor(&per_cu, fwd_megakernel, 512, kDynLds);
    if (per_cu < 1) per_cu = 1;
    if (per_cu > 2) per_cu = 2;
    grid_blocks = cus * per_cu;
    if (n_in != 16 || ws_size < WS_END) { fprintf(stderr, "kernel_launch: unexpected n_in %d / ws %zu\n", n_in, ws_size); }
  }
  Params p{};
  for (int i = 0; i < 16; ++i) p.in[i] = (const float*)d_in[i];
  p.out = (float*)d_out; p.ws = (unsigned char*)d_ws;
  void* args[] = {&p};
  hipError_t e = hipLaunchCooperativeKernel((void*)fwd_megakernel, dim3(grid_blocks), dim3(512), args, kDynLds, stream);
  if (e != hipSuccess) fprintf(stderr, "cooperative launch failed: %s (grid %d)\n", hipGetErrorString(e), grid_blocks);
}
```

```cpp
#include <hip/hip_runtime.h>
#include <hip/hip_cooperative_groups.h>
#include <cstdio>
#include <cstdint>
namespace cg = cooperative_groups;

typedef unsigned short bf16_t;
typedef short bf16x8 __attribute__((ext_vector_type(8)));
typedef float f32x4 __attribute__((ext_vector_type(4)));
typedef unsigned u32x4 __attribute__((ext_vector_type(4)));

constexpr int B_ = 4, S_ = 4096, M_ = B_ * S_, D_ = 1024;
constexpr int P0 = 4096;
constexpr int P1 = 3328;
constexpr int EVEN_IN = 3864, ODD_IN = 3088;
constexpr int C_NQ = 0, C_KCMP = 512, C_VCMP = 640, C_KSEL = 768, C_VSEL = 896, C_KWIN = 1024, C_VWIN = 1152;
constexpr int C_NZ = 1280, C_MQ = 1792, C_MK = 2304, C_MV = 2816, C_MZ = 3328, C_NG = 3840;
constexpr int G_Q = 0, G_K = 512, G_V = 1024, G_Z = 2048, G_LR = 3072;
constexpr int NCMP = 255;
constexpr float ALPHA = 1.4142135623730951f;
constexpr float LN_EPS = 1e-5f;

constexpr size_t MiB = 1u << 20;
constexpr size_t WS_WT0 = 1 * MiB;
constexpr size_t WS_WO0 = 9 * MiB;
constexpr size_t WS_WT1 = 11 * MiB;
constexpr size_t WS_WO1 = 18 * MiB;
constexpr size_t WS_XB = 20 * MiB;
constexpr size_t WS_MIX = 52 * MiB;
constexpr size_t WS_H = 84 * MiB;
constexpr size_t WS_G = 212 * MiB;
constexpr size_t WS_KC = 245 * MiB;
constexpr size_t WS_VC = 246 * MiB;
constexpr size_t WS_KM = 247 * MiB;
constexpr size_t WS_END = 256 * MiB;

struct Params { const float* in[16]; float* out; unsigned char* ws; };

__device__ __forceinline__ int otid() { int t = __builtin_amdgcn_workitem_id_x(); asm volatile("" : "+v"(t)); return t; }
__device__ __forceinline__ float bf2f(bf16_t v) { return __uint_as_float(((unsigned)v) << 16); }
__device__ __forceinline__ bf16_t f2bf(float f) { unsigned u = __float_as_uint(f); return (bf16_t)((u + 0x7fffu + ((u >> 16) & 1u)) >> 16); }
template <int M> __device__ __forceinline__ float xsum(float v) {
  if constexpr (M == 32) { auto rr = __builtin_amdgcn_permlane32_swap(__float_as_uint(v), __float_as_uint(v), false, false); return __uint_as_float(rr[0]) + __uint_as_float(rr[1]); }
  else return v + __int_as_float(__builtin_amdgcn_ds_swizzle(__float_as_int(v), (M << 10) | 0x1f));
}
template <int M> __device__ __forceinline__ float xmax(float v) {
  if constexpr (M == 32) { auto rr = __builtin_amdgcn_permlane32_swap(__float_as_uint(v), __float_as_uint(v), false, false); return fmaxf(__uint_as_float(rr[0]), __uint_as_float(rr[1])); }
  else return fmaxf(v, __int_as_float(__builtin_amdgcn_ds_swizzle(__float_as_int(v), (M << 10) | 0x1f)));
}
template <int M> __device__ __forceinline__ unsigned xorr(unsigned v) {
  if constexpr (M == 32) { auto rr = __builtin_amdgcn_permlane32_swap(v, v, false, false); return rr[0] | rr[1]; }
  else return v | (unsigned)__builtin_amdgcn_ds_swizzle((int)v, (M << 10) | 0x1f);
}
__device__ __forceinline__ float wave_sum(float v) { v = xsum<1>(v); v = xsum<2>(v); v = xsum<4>(v); v = xsum<8>(v); v = xsum<16>(v); return xsum<32>(v); }
__device__ __forceinline__ float wave_max(float v) { v = xmax<1>(v); v = xmax<2>(v); v = xmax<4>(v); v = xmax<8>(v); v = xmax<16>(v); return xmax<32>(v); }
__device__ __forceinline__ float silu_f(float z) { return z / (1.f + __expf(-z)); }
__device__ __forceinline__ float sigmoid_f(float z) { return 1.f / (1.f + __expf(-z)); }

__device__ __forceinline__ int colmap0(int c) {
  if (c < 1280) return c;
  if (c < 1792) return 1304 + (c - 1280);
  if (c < 3840) return 1816 + (c - 1792);
  if (c < 3864) return 1280 + (c - 3840);
  return -1;
}
__device__ __forceinline__ int colmap1(int c) {
  if (c < 2048) return c;
  if (c < 3072) return 2064 + (c - 2048);
  if (c < 3088) return 2048 + (c - 3072);
  return -1;
}

__device__ __forceinline__ void transpose_tile(const float* __restrict__ W, int K, int Nsrc, bf16_t* __restrict__ Wt, int which, int tile, int ntn, float* sm) {
  const int tid = otid();
  const int nb = tile % ntn, kb = tile / ntn, n0 = nb * 64, k0 = kb * 64;
#pragma unroll
  for (int i = 0; i < 8; ++i) {
    const int kk = i * 8 + (tid >> 6), nn = tid & 63;
    const int c = n0 + nn;
    const int src = which == 0 ? colmap0(c) : (which == 1 ? colmap1(c) : c);
    sm[kk * 65 + nn] = src >= 0 ? W[(size_t)(k0 + kk) * Nsrc + src] : 0.f;
  }
  __syncthreads();
#pragma unroll
  for (int i = 0; i < 8; ++i) {
    const int nn = i * 8 + (tid >> 6), kk = tid & 63;
    Wt[(size_t)(n0 + nn) * K + k0 + kk] = f2bf(sm[kk * 65 + nn]);
  }
  __syncthreads();
}

__device__ __forceinline__ void gemm_tile(const bf16_t* __restrict__ A, const bf16_t* __restrict__ Bt, int K, int m0, int n0, int mode, void* outp, int ldc, unsigned char* smem) {
  bf16_t* As = (bf16_t*)smem;
  bf16_t* Bs = As + 128 * 72;
  const int tid = otid(), lane = tid & 63, wid = tid >> 6, wm = wid >> 1, wn = wid & 1;
  f32x4 acc[2][4];
#pragma unroll
  for (int i = 0; i < 2; ++i)
#pragma unroll
    for (int j = 0; j < 4; ++j) acc[i][j] = (f32x4){0.f, 0.f, 0.f, 0.f};
  for (int k0 = 0; k0 < K; k0 += 64) {
#pragma unroll
    for (int i = 0; i < 2; ++i) {
      const int idx = tid + i * 512, r = idx >> 3, c = (idx & 7) * 8;
      *(uint4*)(As + r * 72 + c) = *(const uint4*)(A + (size_t)(m0 + r) * K + k0 + c);
      *(uint4*)(Bs + r * 72 + c) = *(const uint4*)(Bt + (size_t)(n0 + r) * K + k0 + c);
    }
    __syncthreads();
#pragma unroll
    for (int kk = 0; kk < 64; kk += 32) {
      bf16x8 a[2], b[4];
#pragma unroll
      for (int i = 0; i < 2; ++i) a[i] = *(const bf16x8*)(As + (wm * 32 + i * 16 + (lane & 15)) * 72 + kk + (lane >> 4) * 8);
#pragma unroll
      for (int j = 0; j < 4; ++j) b[j] = *(const bf16x8*)(Bs + (wn * 64 + j * 16 + (lane & 15)) * 72 + kk + (lane >> 4) * 8);
#pragma unroll
      for (int i = 0; i < 2; ++i)
#pragma unroll
        for (int j = 0; j < 4; ++j) acc[i][j] = __builtin_amdgcn_mfma_f32_16x16x32_bf16(a[i], b[j], acc[i][j], 0, 0, 0);
    }
    __syncthreads();
  }
#pragma unroll
  for (int i = 0; i < 2; ++i)
#pragma unroll
    for (int j = 0; j < 4; ++j)
#pragma unroll
      for (int r = 0; r < 4; ++r) {
        const int row = m0 + wm * 32 + i * 16 + (lane >> 4) * 4 + r, col = n0 + wn * 64 + j * 16 + (lane & 15);
        if (mode == 0) ((bf16_t*)outp)[(size_t)row * ldc + col] = f2bf(acc[i][j][r]);
        else ((float*)outp)[(size_t)row * ldc + col] = acc[i][j][r];
      }
}
__device__ __forceinline__ void gemm_phase(const bf16_t* A, const bf16_t* Bt, int K, int N, int mode, void* outp, int ldc, unsigned char* smem) {
  const int ntn = N / 128, ntm = M_ / 128;
  for (int t = blockIdx.x; t < ntn * ntm; t += gridDim.x) {
    const int tn = t % ntn, tm = t / ntn;
    gemm_tile(A, Bt, K, tm * 128, tn * 128, mode, outp, ldc, smem);
  }
}

__device__ __forceinline__ void ln_phase(const float* xin, const float* Y, const float* g, const float* bb, float* out, bf16_t* outb) {
  const int lane = otid() & 63, wid = otid() >> 6;
  for (int row = blockIdx.x * 8 + wid; row < M_; row += gridDim.x * 8) {
    const float4* xr = (const float4*)(xin + (size_t)row * D_);
    const float4* yr = (const float4*)(Y + (size_t)row * D_);
    float4 v[4]; float s = 0.f;
#pragma unroll
    for (int j = 0; j < 4; ++j) {
      const float4 a = xr[j * 64 + lane], y = yr[j * 64 + lane];
      v[j].x = ALPHA * a.x + y.x; v[j].y = ALPHA * a.y + y.y; v[j].z = ALPHA * a.z + y.z; v[j].w = ALPHA * a.w + y.w;
      s += (v[j].x + v[j].y) + (v[j].z + v[j].w);
    }
    const float mean = wave_sum(s) * (1.f / D_);
    float q = 0.f;
#pragma unroll
    for (int j = 0; j < 4; ++j) {
      v[j].x -= mean; v[j].y -= mean; v[j].z -= mean; v[j].w -= mean;
      q += (v[j].x * v[j].x + v[j].y * v[j].y) + (v[j].z * v[j].z + v[j].w * v[j].w);
    }
    const float rstd = 1.f / sqrtf(wave_sum(q) * (1.f / D_) + LN_EPS);
#pragma unroll
    for (int j = 0; j < 4; ++j) {
      const float4 gg = ((const float4*)g)[j * 64 + lane], bv = ((const float4*)bb)[j * 64 + lane];
      float4 o;
      o.x = v[j].x * rstd * gg.x + bv.x; o.y = v[j].y * rstd * gg.y + bv.y; o.z = v[j].z * rstd * gg.z + bv.z; o.w = v[j].w * rstd * gg.w + bv.w;
      ((float4*)(out + (size_t)row * D_))[j * 64 + lane] = o;
      if (outb) {
        ushort4 ob; ob.x = f2bf(o.x); ob.y = f2bf(o.y); ob.z = f2bf(o.z); ob.w = f2bf(o.w);
        ((ushort4*)(outb + (size_t)row * D_))[j * 64 + lane] = ob;
      }
    }
  }
}

__device__ __forceinline__ void compress_item(const Params& P, int item, float* sm) {
  const bf16_t* H0 = (const bf16_t*)(P.ws + WS_H);
  const int tid = otid();
  const int g = item & 1; int r = item >> 1; const int n = r % NCMP; r /= NCMP; const int b = r & 3; const int i = r >> 2;
  const float* pos = P.in[2] + i * 2048;
  const float* w1 = P.in[3] + (size_t)i * 2048 * 128;
  const float* b1 = P.in[4] + i * 128;
  const float* w2 = P.in[5] + (size_t)i * 128 * 64;
  float* blk = sm;
  float* part = sm + 2048;
  float* hid = sm + 2048 + 512;
  const int col = (i == 0 ? C_KCMP : C_VCMP) + g * 64;
#pragma unroll
  for (int k = 0; k < 4; ++k) {
    const int f = tid + k * 512, l = f >> 6, d = f & 63;
    blk[f] = bf2f(H0[((size_t)b * S_ + 16 * n + l) * P0 + col + d]) + pos[f];
  }
  __syncthreads();
  const int hh = tid & 127, pt = tid >> 7;
  float acc = 0.f;
  for (int f = pt * 512; f < pt * 512 + 512; ++f) acc += blk[f] * w1[(size_t)f * 128 + hh];
  part[pt * 128 + hh] = acc;
  __syncthreads();
  if (tid < 128) {
    const float a = part[tid] + part[128 + tid] + part[256 + tid] + part[384 + tid] + b1[tid];
    hid[tid] = silu_f(a);
  }
  __syncthreads();
  if (tid < 64) {
    float o = 0.f;
    for (int k = 0; k < 128; ++k) o += hid[k] * w2[k * 64 + tid];
    float* dst = (float*)(P.ws + (i == 0 ? WS_KC : WS_VC));
    dst[(((size_t)b * NCMP + n) * 2 + g) * 64 + tid] = o;
    bf16_t* dstb = (bf16_t*)(P.ws + (i == 0 ? (size_t)(248 * MiB) : (size_t)(249 * MiB)));
    dstb[(((size_t)b * 2 + g) * 256 + n) * 64 + tid] = f2bf(o);
    if (n == 0) dstb[(((size_t)b * 2 + g) * 256 + 255) * 64 + tid] = 0;
  }
  __syncthreads();
}
__device__ __forceinline__ void kmean_item(const Params& P, int item, int lane) {
  const bf16_t* H0 = (const bf16_t*)(P.ws + WS_H);
  const int h = item & 7, n = (item >> 3) & 15, b = item >> 7;
  float s = 0.f;
  for (int k = 0; k < 256; ++k) s += bf2f(H0[((size_t)b * S_ + n * 256 + k) * P0 + C_MK + h * 64 + lane]);
  ((float*)(P.ws + WS_KM))[(((size_t)b * 16 + n) * 8 + h) * 64 + lane] = s * (1.f / 256.f);
}

template <int NH>
__device__ __forceinline__ void attend_block(const bf16_t* __restrict__ Kp, const bf16_t* __restrict__ Vp, size_t rowbase, int kp0, int t, int kmin,
                                             const float* qs, float* pb, const float* slope, float* m, float* l, float* o, int lane) {
  asm volatile("" ::: "memory");
  const int kp = kp0 + lane;
  const bool valid = (kp <= t) && (kp >= kmin);
  const uint4* kr = (const uint4*)(Kp + (rowbase + kp) * P0);
  float dot[NH];
#pragma unroll
  for (int j = 0; j < NH; ++j) dot[j] = 0.f;
#pragma unroll 1
  for (int c = 0; c < 8; ++c) {
    asm volatile("" ::: "memory");
    const uint4 u = kr[c];
    float kv[8];
    kv[0] = __uint_as_float(u.x << 16); kv[1] = __uint_as_float(u.x & 0xffff0000u);
    kv[2] = __uint_as_float(u.y << 16); kv[3] = __uint_as_float(u.y & 0xffff0000u);
    kv[4] = __uint_as_float(u.z << 16); kv[5] = __uint_as_float(u.z & 0xffff0000u);
    kv[6] = __uint_as_float(u.w << 16); kv[7] = __uint_as_float(u.w & 0xffff0000u);
#pragma unroll
    for (int j = 0; j < NH; ++j) {
      const float4 q0 = *(const float4*)(qs + j * 64 + c * 8), q1 = *(const float4*)(qs + j * 64 + c * 8 + 4);
      dot[j] += kv[0] * q0.x + kv[1] * q0.y + kv[2] * q0.z + kv[3] * q0.w + kv[4] * q1.x + kv[5] * q1.y + kv[6] * q1.z + kv[7] * q1.w;
    }
  }
#pragma unroll
  for (int j = 0; j < NH; ++j) {
    const float s = valid ? 0.125f * dot[j] - slope[j] * (float)(t - kp) : -1e30f;
    const float mn = fmaxf(m[j], wave_max(s));
    const float al = __expf(m[j] - mn);
    const float p = valid ? __expf(s - mn) : 0.f;
    l[j] = l[j] * al + wave_sum(p);
    o[j] *= al; m[j] = mn;
    pb[j * 64 + lane] = p;
  }
  __builtin_amdgcn_wave_barrier();
  const bf16_t* vr = Vp + (rowbase + kp0) * P0 + lane;
#pragma unroll 8
  for (int k = 0; k < 64; ++k) {
    const float v = bf2f(vr[(size_t)k * P0]);
#pragma unroll
    for (int j = 0; j < NH; ++j) o[j] += pb[j * 64 + k] * v;
  }
  __builtin_amdgcn_wave_barrier();
}

__device__ __forceinline__ void nsa_item(const Params& P, int b, int g, int t, float* wsm, int lane) {
  const bf16_t* H0 = (const bf16_t*)(P.ws + WS_H);
  const float* KC = (const float*)(P.ws + WS_KC);
  const float* VC = (const float*)(P.ws + WS_VC);
  bf16_t* MIX = (bf16_t*)(P.ws + WS_MIX);
  float* qs = wsm;
  float* pc = wsm + 256;
  float* pb = wsm + 1280;
  const size_t row = (size_t)b * S_ + t;
  const bf16_t* hrow = H0 + row * P0;
  float slope[4];
#pragma unroll
  for (int j = 0; j < 4; ++j) { qs[j * 64 + lane] = bf2f(hrow[C_NQ + (g * 4 + j) * 64 + lane]); slope[j] = exp2f(-(float)(g * 4 + j + 1)); }
  __builtin_amdgcn_wave_barrier();
  const int nv = t >= 31 ? (t - 31) / 16 + 1 : 0;
#pragma unroll 1
  for (int c = 0; c < 4; ++c) {
    asm volatile("" ::: "memory");
    const int n = c * 64 + lane;
    float dot[4] = {0.f, 0.f, 0.f, 0.f};
    if (n < nv) {
      const float4* kr = (const float4*)(KC + (((size_t)b * NCMP + n) * 2 + g) * 64);
#pragma unroll 4
      for (int d4 = 0; d4 < 16; ++d4) {
        const float4 kv = kr[d4];
#pragma unroll
        for (int j = 0; j < 4; ++j) {
          const float4 q = *(const float4*)(qs + j * 64 + d4 * 4);
          dot[j] += kv.x * q.x + kv.y * q.y + kv.z * q.z + kv.w * q.w;
        }
      }
    }
#pragma unroll
    for (int j = 0; j < 4; ++j) pc[j * 256 + n] = (n < nv) ? 0.125f * dot[j] - slope[j] * (float)(t - (16 * n + 31)) : -1e30f;
  }
  __builtin_amdgcn_wave_barrier();
#pragma unroll
  for (int j = 0; j < 4; ++j) {
    float sc[4];
#pragma unroll
    for (int c = 0; c < 4; ++c) sc[c] = pc[j * 256 + c * 64 + lane];
    float mx = fmaxf(fmaxf(sc[0], sc[1]), fmaxf(sc[2], sc[3]));
    mx = wave_max(mx);
    float sum = 0.f;
#pragma unroll
    for (int c = 0; c < 4; ++c) { const int n = c * 64 + lane; const float p = (n < nv) ? __expf(sc[c] - mx) : 0.f; sc[c] = p; sum += p; }
    sum = wave_sum(sum);
    const float inv = nv > 0 ? 1.f / sum : 0.f;
#pragma unroll
    for (int c = 0; c < 4; ++c) pc[j * 256 + c * 64 + lane] = sc[c] * inv;
  }
  __builtin_amdgcn_wave_barrier();
  float ocmp[4] = {0.f, 0.f, 0.f, 0.f};
  for (int n = 0; n < nv; ++n) {
    const float v = VC[(((size_t)b * NCMP + n) * 2 + g) * 64 + lane];
#pragma unroll
    for (int j = 0; j < 4; ++j) ocmp[j] += pc[j * 256 + n] * v;
  }
  float imp = 0.f;
  {
    const int lo = max(0, 4 * lane - 1), hi = min(NCMP - 1, 4 * lane + 3);
    for (int n = lo; n <= hi; ++n) imp += (pc[n] + pc[256 + n]) + (pc[512 + n] + pc[768 + n]);
  }
  const int cur = t >> 6;
  const bool bvalid = lane <= cur;
  const bool forced = (lane == 0) || (lane == cur) || (lane == cur - 1);
  const float key = bvalid ? (forced ? 1e9f : imp) : -1e30f;
  int rank = 0;
  for (int s2 = 0; s2 < 64; ++s2) {
    const float ks = __shfl(key, s2);
    rank += (ks > key || (ks == key && s2 < lane)) ? 1 : 0;
  }
  const unsigned long long selmask = __ballot(bvalid && rank < 16);
  float m[4], l[4], osel[4], owin[4];
#pragma unroll
  for (int j = 0; j < 4; ++j) { m[j] = -1e30f; l[j] = 0.f; osel[j] = 0.f; }
  {
    unsigned long long mk = selmask;
    while (mk) {
      const int blk = __builtin_ctzll(mk); mk &= mk - 1;
      attend_block<4>(H0 + C_KSEL + g * 64, H0 + C_VSEL + g * 64, (size_t)b * S_, blk * 64, t, 0, qs, pb, slope, m, l, osel, lane);
    }
  }
#pragma unroll
  for (int j = 0; j < 4; ++j) { osel[j] /= l[j]; m[j] = -1e30f; l[j] = 0.f; owin[j] = 0.f; }
  {
    const int kmin = t - 511;
    const int b0 = (kmin > 0 ? kmin : 0) >> 6;
    for (int blk = b0; blk <= cur; ++blk)
      attend_block<4>(H0 + C_KWIN + g * 64, H0 + C_VWIN + g * 64, (size_t)b * S_, blk * 64, t, kmin, qs, pb, slope, m, l, owin, lane);
  }
#pragma unroll
  for (int j = 0; j < 4; ++j) {
    const int h = g * 4 + j;
    const float g0 = sigmoid_f(bf2f(hrow[C_NG + h * 3 + 0])), g1 = sigmoid_f(bf2f(hrow[C_NG + h * 3 + 1])), g2 = sigmoid_f(bf2f(hrow[C_NG + h * 3 + 2]));
    const float o = g0 * ocmp[j] + g1 * osel[j] + g2 * (owin[j] / l[j]);
    const float z = bf2f(hrow[C_NZ + h * 64 + lane]);
    MIX[row * D_ + h * 64 + lane] = f2bf(o * silu_f(z));
  }
}

__device__ __forceinline__ void moba_item(const Params& P, int b, int h, int t, float* wsm, int lane) {
  const bf16_t* H0 = (const bf16_t*)(P.ws + WS_H);
  const float* KM = (const float*)(P.ws + WS_KM);
  bf16_t* MIX = (bf16_t*)(P.ws + WS_MIX);
  float* qs = wsm;
  float* pb = wsm + 1280;
  const size_t row = (size_t)b * S_ + t;
  const bf16_t* hrow = H0 + row * P0;
  qs[lane] = bf2f(hrow[C_MQ + h * 64 + lane]);
  __builtin_amdgcn_wave_barrier();
  float slope[1] = {exp2f(-(float)(h + 1))};
  const int cur = t >> 8;
  float gate = -1e30f;
  if (lane < cur) {
    const float4* kr = (const float4*)(KM + (((size_t)b * 16 + lane) * 8 + h) * 64);
    float d = 0.f;
#pragma unroll 4
    for (int d4 = 0; d4 < 16; ++d4) { const float4 kv = kr[d4]; const float4 q = *(const float4*)(qs + d4 * 4); d += kv.x * q.x + kv.y * q.y + kv.z * q.z + kv.w * q.w; }
    gate = d;
  }
  int rank = 0;
  for (int s2 = 0; s2 < 16; ++s2) {
    const float ks = __shfl(gate, s2);
    rank += (ks > gate || (ks == gate && s2 < lane)) ? 1 : 0;
  }
  unsigned long long mk = __ballot(lane < cur && rank < 3) | (1ull << cur);
  float m[1] = {-1e30f}, l[1] = {0.f}, o[1] = {0.f};
  while (mk) {
    const int blk = __builtin_ctzll(mk); mk &= mk - 1;
    for (int c = 0; c < 4; ++c) {
      const int kp0 = blk * 256 + c * 64;
      if (kp0 > t) break;
      attend_block<1>(H0 + C_MK + h * 64, H0 + C_MV + h * 64, (size_t)b * S_, kp0, t, 0, qs, pb, slope, m, l, o, lane);
    }
  }
  const float z = bf2f(hrow[C_MZ + h * 64 + lane]);
  MIX[row * D_ + 512 + h * 64 + lane] = f2bf((o[0] / l[0]) * silu_f(z));
}


#define LAS __attribute__((address_space(3)))
typedef short s16x4 __attribute__((ext_vector_type(4)));
typedef float f32x2_t __attribute__((ext_vector_type(2)));
typedef __bf16 bf16x2_t __attribute__((ext_vector_type(2)));
__device__ __forceinline__ unsigned cvtpk(float lo, float hi) { f32x2_t v = {lo, hi}; bf16x2_t b = __builtin_convertvector(v, bf16x2_t); return __builtin_bit_cast(unsigned, b); }
__device__ __forceinline__ s16x4 vtr(LAS const unsigned char* p) { return __builtin_bit_cast(s16x4, __builtin_amdgcn_ds_read_tr16_b64_v4i16((LAS s16x4*)p)); }
constexpr int KT_BYTES = 8192;
constexpr int VT_DT = 2080;
constexpr int VT_BYTES = 4 * VT_DT;
constexpr int AT_BUF = KT_BYTES + VT_BYTES;
constexpr int AT_MISC = 2 * AT_BUF;
constexpr int AT_STASH = AT_MISC + 256;
constexpr int AT_LDS_END = AT_STASH + 8 * 512 * 16;
constexpr float C1 = 0.125f * 1.4426950408889634f;
constexpr float LOG2E = 1.4426950408889634f;

__device__ __forceinline__ void at_stage_write(LAS unsigned char* buf, const u32x4& kreg, const u32x4& vreg, int tid) {
  const int key = tid >> 3, c = tid & 7;
  *(LAS u32x4*)(buf + key * 128 + ((c ^ ((key >> 1) & 7)) << 4)) = kreg;
  *(LAS u32x4*)(buf + KT_BYTES + (c >> 1) * VT_DT + key * 32 + (c & 1) * 16) = vreg;
}
__device__ __forceinline__ void at_stage_dma(LAS unsigned char* buf, const bf16_t* Kt, const bf16_t* Vt, unsigned pitch, int lane, int wid) {
  const int kkey = 8 * wid + (lane >> 3), c = (lane & 7) ^ ((kkey >> 1) & 7);
  __builtin_amdgcn_global_load_lds((const unsigned*)(Kt + (unsigned)kkey * pitch + c * 8), (LAS unsigned*)(buf + wid * 1024), 16, 0, 0);
  const int vkey = 32 * (wid & 1) + (lane >> 1), dt = wid >> 1;
  __builtin_amdgcn_global_load_lds((const unsigned*)(Vt + (unsigned)vkey * pitch + dt * 16 + (lane & 1) * 8), (LAS unsigned*)(buf + KT_BYTES + dt * VT_DT + (wid & 1) * 1024), 16, 0, 0);
}
template <int NRG, bool EDGE, int IMPT  >
__device__ __forceinline__ void at_tile_x(LAS const unsigned char* buf, const bf16x8 (&qf)[NRG][2], f32x4 (&O)[NRG][4], float (&m)[NRG], float (&l)[NRG],
                                        const float (&base)[NRG], const float (&soff)[NRG], const int (&lim)[NRG], const int (&lo)[NRG], int lane,
                                        float (&imp)[NRG][16], float (&carry)[NRG]) {
  const int g = lane >> 4, i = lane & 15;
  const int swz = (i >> 1) & 7;
  LAS const unsigned char* kb = buf + i * 128;
  const int kc0 = ((g ^ swz) << 4), kc1 = (((4 + g) ^ swz) << 4);
  f32x4 S[NRG][4];
#pragma unroll
  for (int mt = 0; mt < 4; ++mt) {
    const bf16x8 k0f = *(LAS const bf16x8*)(kb + mt * 2048 + kc0);
    const bf16x8 k1f = *(LAS const bf16x8*)(kb + mt * 2048 + kc1);
#pragma unroll
    for (int rg = 0; rg < NRG; ++rg) {
      f32x4 a = __builtin_amdgcn_mfma_f32_16x16x32_bf16(k0f, qf[rg][0], (f32x4){0.f, 0.f, 0.f, 0.f}, 0, 0, 0);
      S[rg][mt] = __builtin_amdgcn_mfma_f32_16x16x32_bf16(k1f, qf[rg][1], a, 0, 0, 0);
    }
  }
  __builtin_amdgcn_sched_barrier(0);
  unsigned pk[NRG][2][4];
#pragma unroll
  for (int rg = 0; rg < NRG; ++rg) {
    float mx = -INFINITY;
#pragma unroll
    for (int mt = 0; mt < 4; ++mt)
#pragma unroll
      for (int r = 0; r < 4; ++r) {
        float sv = __builtin_fmaf(S[rg][mt][r], C1, base[rg] + soff[rg] * (float)(16 * mt + r));
        if (EDGE) { const int c = 16 * mt + r; sv = (c <= lim[rg] && c >= lo[rg]) ? sv : -INFINITY; }
        S[rg][mt][r] = sv; mx = fmaxf(mx, sv);
      }
    mx = xmax<16>(mx); mx = xmax<32>(mx);
    const float mn = fmaxf(m[rg], mx);
    const float al = __builtin_amdgcn_exp2f(m[rg] - mn);
    m[rg] = mn;
    float ps = 0.f;
#pragma unroll
    for (int mt = 0; mt < 4; ++mt)
#pragma unroll
      for (int r = 0; r < 4; ++r) { const float pv = __builtin_amdgcn_exp2f(S[rg][mt][r] - mn); S[rg][mt][r] = pv; ps += pv; }
    l[rg] = l[rg] * al + ps;
    if (IMPT >= 0) {
#pragma unroll
      for (int k = 0; k < 4 * IMPT; ++k) imp[rg][k] *= al;
      carry[rg] *= al;
      float sh[4];
#pragma unroll
      for (int mt = 0; mt < 4; ++mt) sh[mt] = __uint_as_float(__builtin_amdgcn_ds_bpermute(((lane + 48) & 63) << 2, __float_as_uint(S[rg][mt][3])));
#pragma unroll
      for (int mt = 0; mt < 4; ++mt) {
        const float own = (S[rg][mt][0] + S[rg][mt][1]) + (S[rg][mt][2] + S[rg][mt][3]);
        const float prev = g > 0 ? sh[mt] : (mt > 0 ? sh[mt > 0 ? mt - 1 : 0] : carry[rg]);
        imp[rg][(IMPT >= 0 ? 4 * IMPT : 0) + mt] = own + prev;
      }
      carry[rg] = sh[3];
    }
#pragma unroll
    for (int dt = 0; dt < 4; ++dt) O[rg][dt] = O[rg][dt] * al;
#pragma unroll
    for (int ks = 0; ks < 2; ++ks) {
      pk[rg][ks][0] = cvtpk(S[rg][2 * ks][0], S[rg][2 * ks][1]); pk[rg][ks][1] = cvtpk(S[rg][2 * ks][2], S[rg][2 * ks][3]);
      pk[rg][ks][2] = cvtpk(S[rg][2 * ks + 1][0], S[rg][2 * ks + 1][1]); pk[rg][ks][3] = cvtpk(S[rg][2 * ks + 1][2], S[rg][2 * ks + 1][3]);
    }
  }
  LAS const unsigned char* vb = buf + KT_BYTES + (4 * g + (i >> 2)) * 32 + (i & 3) * 8;
#pragma unroll
  for (int dt = 0; dt < 4; ++dt)
#pragma unroll
    for (int ks = 0; ks < 2; ++ks) {
      const s16x4 v0 = vtr(vb + dt * VT_DT + ks * 1024);
      const s16x4 v1 = vtr(vb + dt * VT_DT + ks * 1024 + 512);
      const bf16x8 vf = (bf16x8){v0[0], v0[1], v0[2], v0[3], v1[0], v1[1], v1[2], v1[3]};
#pragma unroll
      for (int rg = 0; rg < NRG; ++rg) {
        const u32x4 pw = {pk[rg][ks][0], pk[rg][ks][1], pk[rg][ks][2], pk[rg][ks][3]};
        O[rg][dt] = __builtin_amdgcn_mfma_f32_16x16x32_bf16(vf, __builtin_bit_cast(bf16x8, pw), O[rg][dt], 0, 0, 0);
      }
    }
}

template <int NRG, bool EDGE>
__device__ __forceinline__ void at_tile(LAS const unsigned char* buf, const bf16x8 (&qf)[NRG][2], f32x4 (&O)[NRG][4], float (&m)[NRG], float (&l)[NRG],
                                        const float (&base)[NRG], const float (&soff)[NRG], const int (&lim)[NRG], const int (&lo)[NRG], int lane) {
  float dimp[NRG][16]; float dc[NRG];
  at_tile_x<NRG, EDGE, -1>(buf, qf, O, m, l, base, soff, lim, lo, lane, dimp, dc);
}

__device__ __forceinline__ void moba_mfma_item(const Params& P, int b, int h, int cur, unsigned char* smem_g) {
  LAS unsigned char* lds = (LAS unsigned char*)smem_g;
  const bf16_t* __restrict__ H0 = (const bf16_t*)(P.ws + WS_H);
  const float* __restrict__ KM = (const float*)(P.ws + WS_KM);
  bf16_t* __restrict__ MIX = (bf16_t*)(P.ws + WS_MIX);
  const int tid = otid(), lane = tid & 63, wid = __builtin_amdgcn_readfirstlane(tid >> 6), g = lane >> 4, i = lane & 15;
  const float slope2 = exp2f(-(float)(h + 1)) * LOG2E;
  const int t0 = cur * 256;
  int trow[2]; bf16x8 qf[2][2]; unsigned sel[2];
#pragma unroll
  for (int rg = 0; rg < 2; ++rg) {
    trow[rg] = t0 + wid * 32 + rg * 16 + i;
    const bf16_t* qp = H0 + ((size_t)b * S_ + trow[rg]) * P0 + C_MQ + h * 64 + 8 * g;
    qf[rg][0] = *(const bf16x8*)qp; qf[rg][1] = *(const bf16x8*)(qp + 32);
  }
#pragma unroll
  for (int rg = 0; rg < 2; ++rg) {
    float qv[16];
#pragma unroll
    for (int j = 0; j < 8; ++j) { qv[j] = bf2f((bf16_t)qf[rg][0][j]); qv[8 + j] = bf2f((bf16_t)qf[rg][1][j]); }
    float v1 = -INFINITY, v2 = -INFINITY, v3 = -INFINITY; int i1 = -1, i2 = -1, i3 = -1;
    for (int n = 0; n < cur; ++n) {
      const float* kr = KM + (((size_t)b * 16 + n) * 8 + h) * 64 + 8 * g;
      const float4 a0 = *(const float4*)kr, a1 = *(const float4*)(kr + 4), b0 = *(const float4*)(kr + 32), b1 = *(const float4*)(kr + 36);
      float d = qv[0] * a0.x + qv[1] * a0.y + qv[2] * a0.z + qv[3] * a0.w + qv[4] * a1.x + qv[5] * a1.y + qv[6] * a1.z + qv[7] * a1.w
              + qv[8] * b0.x + qv[9] * b0.y + qv[10] * b0.z + qv[11] * b0.w + qv[12] * b1.x + qv[13] * b1.y + qv[14] * b1.z + qv[15] * b1.w;
      d = xsum<16>(d); d = xsum<32>(d);
      if (d > v1) { v3 = v2; i3 = i2; v2 = v1; i2 = i1; v1 = d; i1 = n; }
      else if (d > v2) { v3 = v2; i3 = i2; v2 = d; i2 = n; }
      else if (d > v3) { v3 = d; i3 = n; }
    }
    unsigned mk = 0u;
    if (i1 >= 0) mk |= 1u << i1;
    if (i2 >= 0) mk |= 1u << i2;
    if (i3 >= 0) mk |= 1u << i3;
    sel[rg] = mk;
  }
  {
    unsigned u = sel[0] | sel[1];
    u = xorr<1>(u); u = xorr<2>(u); u = xorr<4>(u); u = xorr<8>(u);
    LAS unsigned* misc = (LAS unsigned*)(lds + AT_MISC);
    if (lane == 0) misc[wid] = u;
  }
  __syncthreads();
  unsigned umask = 0u;
  {
    LAS unsigned* misc = (LAS unsigned*)(lds + AT_MISC);
#pragma unroll
    for (int w = 0; w < 8; ++w) umask |= misc[w];
  }
  umask = __builtin_amdgcn_readfirstlane(umask);
  const int npast = __builtin_popcount(umask);
  const int nt = 4 * npast + 4;
  f32x4 O[2][4]; float m[2], l[2];
#pragma unroll
  for (int rg = 0; rg < 2; ++rg) { m[rg] = -1e30f; l[rg] = 0.f;
#pragma unroll
    for (int dt = 0; dt < 4; ++dt) O[rg][dt] = (f32x4){0.f, 0.f, 0.f, 0.f}; }
  const bf16_t* Kg = H0 + (size_t)b * S_ * P0 + C_MK + h * 64;
  const bf16_t* Vg = H0 + (size_t)b * S_ * P0 + C_MV + h * 64;
  unsigned rem = umask; int blk = -1, sub = 4;
  auto next_tile = [&](int& kblk, int& k0) {
    if (sub == 4) { sub = 0; if (rem) { blk = __builtin_ctz(rem); rem &= rem - 1; } else blk = cur; }
    kblk = blk; k0 = blk * 256 + sub * 64; ++sub;
  };
  int kblk, k0; next_tile(kblk, k0);
  at_stage_dma(lds, Kg + (size_t)k0 * P0, Vg + (size_t)k0 * P0, P0, lane, wid);
  __syncthreads();
  for (int ti = 0; ti < nt; ++ti) {
    const int cblk = kblk, ck0 = k0;
    if (ti + 1 < nt) {
      next_tile(kblk, k0);
      at_stage_dma(lds + ((ti + 1) & 1) * AT_BUF, Kg + (size_t)k0 * P0, Vg + (size_t)k0 * P0, P0, lane, wid);
    }
    LAS const unsigned char* buf = lds + (ti & 1) * AT_BUF;
    float base[2], soff[2]; int lim[2], lo[2];
#pragma unroll
    for (int rg = 0; rg < 2; ++rg) {
      const bool rs = (cblk == cur) || ((sel[rg] >> cblk) & 1u);
      base[rg] = rs ? slope2 * (float)(ck0 + 4 * g - trow[rg]) : -INFINITY;
      soff[rg] = slope2; lim[rg] = trow[rg] - ck0 - 4 * g; lo[rg] = -1000000;
    }
    if (cblk == cur) at_tile<2, true>(buf, qf, O, m, l, base, soff, lim, lo, lane);
    else at_tile<2, false>(buf, qf, O, m, l, base, soff, lim, lo, lane);
    __syncthreads();
  }
#pragma unroll
  for (int rg = 0; rg < 2; ++rg) {
    float lt = l[rg]; lt = xsum<16>(lt); lt = xsum<32>(lt);
    const float inv = 1.f / lt;
    const size_t row = (size_t)b * S_ + trow[rg];
#pragma unroll
    for (int dt = 0; dt < 4; ++dt) {
      const int dv = 16 * dt + 4 * g;
      const ushort4 zz = *(const ushort4*)(H0 + row * P0 + C_MZ + h * 64 + dv);
      ushort4 ov;
      ov.x = f2bf(O[rg][dt][0] * inv * silu_f(bf2f(zz.x))); ov.y = f2bf(O[rg][dt][1] * inv * silu_f(bf2f(zz.y)));
      ov.z = f2bf(O[rg][dt][2] * inv * silu_f(bf2f(zz.z))); ov.w = f2bf(O[rg][dt][3] * inv * silu_f(bf2f(zz.w)));
      *(ushort4*)(MIX + row * D_ + 512 + h * 64 + dv) = ov;
    }
  }
}


constexpr size_t WS_KCB = 248 * MiB;
constexpr size_t WS_VCB = 249 * MiB;
__device__ __forceinline__ void nsa_mfma_item(const Params& P, int b, int grp, int sb, unsigned char* smem_g) {
  LAS unsigned char* lds = (LAS unsigned char*)smem_g;
  const bf16_t* __restrict__ H0 = (const bf16_t*)(P.ws + WS_H);
  bf16_t* __restrict__ MIX = (bf16_t*)(P.ws + WS_MIX);
  const int tid = otid(), lane = tid & 63, wid = __builtin_amdgcn_readfirstlane(tid >> 6), g = lane >> 4, i = lane & 15;
  const int t0 = sb * 64;
  int trow[2]; bf16x8 qf[2][2];
  const int hh = grp * 4 + (i & 3);
  const float slope2 = exp2f(-(float)(hh + 1)) * LOG2E;
  const bf16_t* __restrict__ Hb = H0 + (size_t)b * S_ * P0;
#pragma unroll
  for (int rg = 0; rg < 2; ++rg) {
    trow[rg] = t0 + wid * 8 + rg * 4 + (i >> 2);
    const unsigned qo = (unsigned)trow[rg] * P0 + C_NQ + hh * 64 + 8 * g;
    qf[rg][0] = *(const bf16x8*)(Hb + qo); qf[rg][1] = *(const bf16x8*)(Hb + qo + 32);
  }
  LAS f32x4* stash = (LAS f32x4*)(lds + AT_STASH) + tid;
  f32x4 O[2][4]; float m[2], l[2];
  unsigned mlo[2], mhi[2];
#pragma unroll
  for (int rg = 0; rg < 2; ++rg) {
    float imp[1][16], carry[1], m1[1], l1[1]; f32x4 O1[1][4]; bf16x8 q1[1][2];
    q1[0][0] = qf[rg][0]; q1[0][1] = qf[rg][1];
    m1[0] = -1e30f; l1[0] = 0.f; carry[0] = 0.f;
#pragma unroll
    for (int k = 0; k < 16; ++k) imp[0][k] = 0.f;
#pragma unroll
    for (int dt = 0; dt < 4; ++dt) O1[0][dt] = (f32x4){0.f, 0.f, 0.f, 0.f};
    const int ntc = ((4 * sb + 2) >> 6) + 1;
    const bf16_t* Kg = (const bf16_t*)(P.ws + WS_KCB) + (size_t)(b * 2 + grp) * 256 * 64;
    const bf16_t* Vg = (const bf16_t*)(P.ws + WS_VCB) + (size_t)(b * 2 + grp) * 256 * 64;
    at_stage_dma(lds, Kg, Vg, 64, lane, wid);
    __syncthreads();
#pragma unroll
    for (int tile = 0; tile < 4; ++tile) {
      if (tile < ntc) {
        if (tile + 1 < ntc) at_stage_dma(lds + ((tile + 1) & 1) * AT_BUF, Kg + (tile + 1) * 4096, Vg + (tile + 1) * 4096, 64, lane, wid);
        LAS const unsigned char* buf = lds + (tile & 1) * AT_BUF;
        float base[1], soff[1]; int lim[1], lo[1];
        const int nlim = trow[rg] >= 31 ? ((trow[rg] - 31) >> 4) : -1;
        base[0] = slope2 * (float)(16 * (64 * tile + 4 * g) + 31 - trow[rg]);
        soff[0] = 16.f * slope2; lim[0] = nlim - 64 * tile - 4 * g; lo[0] = -1000000;
        if (tile == 0) at_tile_x<1, true, 0>(buf, q1, O1, m1, l1, base, soff, lim, lo, lane, imp, carry);
        else if (tile == 1) at_tile_x<1, true, 1>(buf, q1, O1, m1, l1, base, soff, lim, lo, lane, imp, carry);
        else if (tile == 2) at_tile_x<1, true, 2>(buf, q1, O1, m1, l1, base, soff, lim, lo, lane, imp, carry);
        else at_tile_x<1, true, 3>(buf, q1, O1, m1, l1, base, soff, lim, lo, lane, imp, carry);
        __syncthreads();
      }
    }
    {
      float lt = l1[0]; lt = xsum<16>(lt); lt = xsum<32>(lt);
      const float inv = lt > 0.f ? 1.f / lt : 0.f;
      const float g0 = sigmoid_f(bf2f(Hb[(unsigned)trow[rg] * P0 + C_NG + hh * 3 + 0]));
#pragma unroll
      for (int dt = 0; dt < 4; ++dt) stash[(rg * 4 + dt) * 512] = O1[0][dt] * (g0 * inv);
      if (sb < 16) { mlo[rg] = (1u << (sb + 1)) - 1u; mhi[rg] = 0u; }
      else {
        float key[16];
#pragma unroll
        for (int k = 0; k < 16; ++k) {
          float v = imp[0][k] * inv; v = xsum<1>(v); v = xsum<2>(v);
          const int sidx = 4 * k + g;
          const bool forced = (sidx == 0) || (sidx == sb) || (sidx == sb - 1);
          key[k] = (sidx <= sb) ? (forced ? 1e9f : v) : -1e30f;
        }
        const int j = i & 3;
        float mykey[4]; int mys[4], rank[4];
#pragma unroll
        for (int q = 0; q < 4; ++q) {
          mykey[q] = j == 0 ? key[q] : (j == 1 ? key[4 + q] : (j == 2 ? key[8 + q] : key[12 + q]));
          mys[q] = 4 * (4 * j + q) + g; rank[q] = 0;
        }
#pragma unroll 1
        for (int gg = 0; gg < 4; ++gg)
#pragma unroll
          for (int kk = 0; kk < 16; ++kk) {
            const float other = __uint_as_float(__builtin_amdgcn_ds_bpermute((gg * 16 + i) << 2, __float_as_uint(key[kk])));
            const int sp = 4 * kk + gg;
#pragma unroll
            for (int q = 0; q < 4; ++q) rank[q] += (other > mykey[q] || (other == mykey[q] && sp < mys[q])) ? 1 : 0;
          }
        unsigned a = 0u, bb = 0u;
#pragma unroll
        for (int q = 0; q < 4; ++q) if (rank[q] < 16 && mys[q] <= sb) { if (mys[q] < 32) a |= 1u << mys[q]; else bb |= 1u << (mys[q] - 32); }
        a = xorr<1>(a); bb = xorr<1>(bb); a = xorr<2>(a); bb = xorr<2>(bb);
        a = xorr<16>(a); bb = xorr<16>(bb); a = xorr<32>(a); bb = xorr<32>(bb);
        mlo[rg] = a; mhi[rg] = bb;
      }
    }
  }
  {
    unsigned ua = mlo[0] | mlo[1], ub = mhi[0] | mhi[1];
    ua = xorr<4>(ua); ub = xorr<4>(ub); ua = xorr<8>(ua); ub = xorr<8>(ub);
    LAS unsigned* misc = (LAS unsigned*)(lds + AT_MISC);
    if (lane == 0) { misc[2 * wid] = ua; misc[2 * wid + 1] = ub; }
    __syncthreads();
    ua = 0u; ub = 0u;
#pragma unroll
    for (int w = 0; w < 8; ++w) { ua |= misc[2 * w]; ub |= misc[2 * w + 1]; }
    unsigned long long rem = ((unsigned long long)(unsigned)__builtin_amdgcn_readfirstlane(ub) << 32) | (unsigned)__builtin_amdgcn_readfirstlane(ua);
    const int nt = __builtin_popcountll(rem);
#pragma unroll
    for (int rg = 0; rg < 2; ++rg) { m[rg] = -1e30f; l[rg] = 0.f;
#pragma unroll
      for (int dt = 0; dt < 4; ++dt) O[rg][dt] = (f32x4){0.f, 0.f, 0.f, 0.f}; }
    const bf16_t* Kg = Hb + C_KSEL + grp * 64;
    const bf16_t* Vg = Hb + C_VSEL + grp * 64;
    int blk = __builtin_ctzll(rem); rem &= rem - 1;
    at_stage_dma(lds, Kg + (size_t)blk * 64 * P0, Vg + (size_t)blk * 64 * P0, P0, lane, wid);
    __syncthreads();
    for (int ti = 0; ti < nt; ++ti) {
      const int cblk = blk;
      if (ti + 1 < nt) { blk = __builtin_ctzll(rem); rem &= rem - 1;
        at_stage_dma(lds + ((ti + 1) & 1) * AT_BUF, Kg + (size_t)blk * 64 * P0, Vg + (size_t)blk * 64 * P0, P0, lane, wid); }
      LAS const unsigned char* buf = lds + (ti & 1) * AT_BUF;
      float base[2], soff[2]; int lim[2], lo[2];
#pragma unroll
      for (int rg = 0; rg < 2; ++rg) {
        const bool rs = cblk < 32 ? ((mlo[rg] >> cblk) & 1u) : ((mhi[rg] >> (cblk - 32)) & 1u);
        base[rg] = rs ? slope2 * (float)(cblk * 64 + 4 * g - trow[rg]) : -INFINITY;
        soff[rg] = slope2; lim[rg] = trow[rg] - cblk * 64 - 4 * g; lo[rg] = -1000000;
      }
      if (cblk == sb) at_tile<2, true>(buf, qf, O, m, l, base, soff, lim, lo, lane);
      else at_tile<2, false>(buf, qf, O, m, l, base, soff, lim, lo, lane);
      __syncthreads();
    }
#pragma unroll
    for (int rg = 0; rg < 2; ++rg) {
      float lt = l[rg]; lt = xsum<16>(lt); lt = xsum<32>(lt);
      const float g1 = sigmoid_f(bf2f(Hb[(unsigned)trow[rg] * P0 + C_NG + hh * 3 + 1]));
#pragma unroll
      for (int dt = 0; dt < 4; ++dt) stash[(rg * 4 + dt) * 512] += O[rg][dt] * (g1 / lt);
    }
  }
  {
    const int b0 = sb >= 8 ? sb - 8 : 0;
    const int nt = sb - b0 + 1;
#pragma unroll
    for (int rg = 0; rg < 2; ++rg) { m[rg] = -1e30f; l[rg] = 0.f;
#pragma unroll
      for (int dt = 0; dt < 4; ++dt) O[rg][dt] = (f32x4){0.f, 0.f, 0.f, 0.f}; }
    const bf16_t* Kg = Hb + C_KWIN + grp * 64;
    const bf16_t* Vg = Hb + C_VWIN + grp * 64;
    at_stage_dma(lds, Kg + (size_t)b0 * 64 * P0, Vg + (size_t)b0 * 64 * P0, P0, lane, wid);
    __syncthreads();
    for (int ti = 0; ti < nt; ++ti) {
      const int cblk = b0 + ti;
      if (ti + 1 < nt) at_stage_dma(lds + ((ti + 1) & 1) * AT_BUF, Kg + (size_t)(cblk + 1) * 64 * P0, Vg + (size_t)(cblk + 1) * 64 * P0, P0, lane, wid);
      LAS const unsigned char* buf = lds + (ti & 1) * AT_BUF;
      float base[2], soff[2]; int lim[2], lo[2];
#pragma unroll
      for (int rg = 0; rg < 2; ++rg) {
        base[rg] = slope2 * (float)(cblk * 64 + 4 * g - trow[rg]);
        soff[rg] = slope2; lim[rg] = trow[rg] - cblk * 64 - 4 * g; lo[rg] = trow[rg] - 511 - cblk * 64 - 4 * g;
      }
      if (cblk == sb || cblk == sb - 8) at_tile<2, true>(buf, qf, O, m, l, base, soff, lim, lo, lane);
      else at_tile<2, false>(buf, qf, O, m, l, base, soff, lim, lo, lane);
      __syncthreads();
    }
  }
#pragma unroll
  for (int rg = 0; rg < 2; ++rg) {
    float lt = l[rg]; lt = xsum<16>(lt); lt = xsum<32>(lt);
    const unsigned ro = (unsigned)trow[rg] * P0;
    const float g2 = sigmoid_f(bf2f(Hb[ro + C_NG + hh * 3 + 2])) / lt;
#pragma unroll
    for (int dt = 0; dt < 4; ++dt) {
      const int dv = 16 * dt + 4 * g;
      const ushort4 zz = *(const ushort4*)(Hb + ro + C_NZ + hh * 64 + dv);
      const f32x4 ov = stash[(rg * 4 + dt) * 512] + O[rg][dt] * g2;
      ushort4 o4;
      o4.x = f2bf(ov[0] * silu_f(bf2f(zz.x))); o4.y = f2bf(ov[1] * silu_f(bf2f(zz.y)));
      o4.z = f2bf(ov[2] * silu_f(bf2f(zz.z))); o4.w = f2bf(ov[3] * silu_f(bf2f(zz.w)));
      *(ushort4*)(MIX + (size_t)b * S_ * D_ + (unsigned)trow[rg] * D_ + hh * 64 + dv) = o4;
    }
  }
}

__device__ __forceinline__ void gla_gate_phase(const Params& P) {
  const bf16_t* H1 = (const bf16_t*)(P.ws + WS_H);
  float* G = (float*)(P.ws + WS_G);
  const float* w2 = P.in[10]; const float* gb = P.in[11];
  const size_t total = (size_t)M_ * 512;
  for (size_t i = (size_t)blockIdx.x * 512 + otid(); i < total; i += (size_t)gridDim.x * 512) {
    const int c = (int)(i & 511); const size_t row = i >> 9;
    float x = gb[c];
#pragma unroll
    for (int r = 0; r < 16; ++r) x += bf2f(H1[row * P1 + G_LR + r]) * w2[r * 512 + c];
    const float ls = fminf(x, 0.f) - log1pf(__expf(-fabsf(x)));
    G[i] = ls * (1.f / 16.f);
  }
}
__device__ __forceinline__ void gla_scan_vblock(const Params& P, int vb) {
  const bf16_t* __restrict__ H1 = (const bf16_t*)(P.ws + WS_H);
  const float* __restrict__ G = (const float*)(P.ws + WS_G);
  bf16_t* __restrict__ O = (bf16_t*)(P.ws + WS_XB);
  const int tid = otid(), lane = tid & 63, wid = tid >> 6;
  const int eh = vb & 1, h = (vb >> 1) & 3, b = vb >> 3;
  const int e = eh * 128 + wid * 16 + (lane >> 2), dq = lane & 3;
  float St[32];
#pragma unroll
  for (int i = 0; i < 32; ++i) St[i] = 0.f;
  const float qscale = 0.08838834764831845f;
  for (int t = 0; t < S_; ++t) {
    const size_t row = (size_t)b * S_ + t;
    const float4* gr = (const float4*)(G + row * 512 + h * 128 + dq * 32);
    const uint4* kr = (const uint4*)(H1 + row * P1 + G_K + h * 128 + dq * 32);
    const uint4* qr = (const uint4*)(H1 + row * P1 + G_Q + h * 128 + dq * 32);
    const float v = bf2f(H1[row * P1 + G_V + h * 256 + e]);
    float o = 0.f;
#pragma unroll
    for (int c = 0; c < 4; ++c) {
      const uint4 ku = kr[c], qu = qr[c];
      const float4 g0 = gr[2 * c], g1 = gr[2 * c + 1];
      const float kk[8] = {__uint_as_float(ku.x << 16), __uint_as_float(ku.x & 0xffff0000u), __uint_as_float(ku.y << 16), __uint_as_float(ku.y & 0xffff0000u),
                           __uint_as_float(ku.z << 16), __uint_as_float(ku.z & 0xffff0000u), __uint_as_float(ku.w << 16), __uint_as_float(ku.w & 0xffff0000u)};
      const float qq[8] = {__uint_as_float(qu.x << 16), __uint_as_float(qu.x & 0xffff0000u), __uint_as_float(qu.y << 16), __uint_as_float(qu.y & 0xffff0000u),
                           __uint_as_float(qu.z << 16), __uint_as_float(qu.z & 0xffff0000u), __uint_as_float(qu.w << 16), __uint_as_float(qu.w & 0xffff0000u)};
      const float gg[8] = {g0.x, g0.y, g0.z, g0.w, g1.x, g1.y, g1.z, g1.w};
#pragma unroll
      for (int i = 0; i < 8; ++i) {
        const float a = __expf(gg[i]);
        St[c * 8 + i] = a * St[c * 8 + i] + kk[i] * v;
        o += qq[i] * St[c * 8 + i];
      }
    }
    o = xsum<1>(o); o = xsum<2>(o);
    if (dq == 0) O[row * D_ + h * 256 + e] = f2bf(o * qscale);
  }
}
__device__ __forceinline__ void gla_norm_phase(const Params& P) {
  const bf16_t* H1 = (const bf16_t*)(P.ws + WS_H);
  const bf16_t* O = (const bf16_t*)(P.ws + WS_XB);
  bf16_t* MIX = (bf16_t*)(P.ws + WS_MIX);
  const float* gn = P.in[12];
  const int lane = otid() & 63, wid = otid() >> 6;
  for (int it = blockIdx.x * 8 + wid; it < M_ * 4; it += gridDim.x * 8) {
    const int h = it & 3; const size_t row = it >> 2;
    float v[4]; float ss = 0.f;
#pragma unroll
    for (int k = 0; k < 4; ++k) { v[k] = bf2f(O[row * D_ + h * 256 + k * 64 + lane]); ss += v[k] * v[k]; }
    const float r = 1.f / sqrtf(wave_sum(ss) * (1.f / 256.f) + LN_EPS);
#pragma unroll
    for (int k = 0; k < 4; ++k) {
      const int c = h * 256 + k * 64 + lane;
      const float z = bf2f(H1[row * P1 + G_Z + c]);
      MIX[row * D_ + c] = f2bf(v[k] * r * gn[c] * silu_f(z));
    }
  }
}

__global__ void __launch_bounds__(512) fwd_megakernel(Params P) {
  cg::grid_group grid = cg::this_grid();
  extern __shared__ __attribute__((aligned(16))) unsigned char smem[];
  const int tid = otid(), lane = tid & 63, wid = tid >> 6;
  unsigned char* ws = P.ws;
  bf16_t* XB = (bf16_t*)(ws + WS_XB);
  bf16_t* MIX = (bf16_t*)(ws + WS_MIX);
  bf16_t* Hb = (bf16_t*)(ws + WS_H);
  float* Y = (float*)(ws + WS_H);

  {
    const float4* x4 = (const float4*)P.in[0];
    const size_t n4 = (size_t)M_ * D_ / 4;
    for (size_t i = (size_t)blockIdx.x * 512 + tid; i < n4; i += (size_t)gridDim.x * 512) {
      const float4 v = x4[i]; ushort4 o; o.x = f2bf(v.x); o.y = f2bf(v.y); o.z = f2bf(v.z); o.w = f2bf(v.w);
      ((ushort4*)XB)[i] = o;
    }
    constexpr int T0 = (P0 / 64) * 16, T1 = 16 * 16, T2 = (P1 / 64) * 16, T3 = 16 * 16;
    for (int it = blockIdx.x; it < T0 + T1 + T2 + T3; it += gridDim.x) {
      int r = it;
      if (r < T0) { transpose_tile(P.in[1], D_, EVEN_IN, (bf16_t*)(ws + WS_WT0), 0, r, P0 / 64, (float*)smem); continue; } r -= T0;
      if (r < T1) { transpose_tile(P.in[6], D_, D_, (bf16_t*)(ws + WS_WO0), 2, r, 16, (float*)smem); continue; } r -= T1;
      if (r < T2) { transpose_tile(P.in[9], D_, ODD_IN, (bf16_t*)(ws + WS_WT1), 1, r, P1 / 64, (float*)smem); continue; } r -= T2;
      transpose_tile(P.in[13], D_, D_, (bf16_t*)(ws + WS_WO1), 2, r, 16, (float*)smem);
    }
  }
  grid.sync();
  gemm_phase(XB, (const bf16_t*)(ws + WS_WT0), D_, P0, 0, Hb, P0, smem);
  grid.sync();
  {
    const int NC = 2 * B_ * NCMP * 2;
    for (int it = blockIdx.x; it < NC; it += gridDim.x) compress_item(P, it, (float*)smem);
    for (int it = blockIdx.x * 8 + wid; it < B_ * 16 * 8; it += gridDim.x * 8) kmean_item(P, it, lane);
  }
  grid.sync();
  {
    for (int it = blockIdx.x; it < 1024; it += gridDim.x) {
      const int lvl = it >> 4, r = it & 15;
      if (r < 8) nsa_mfma_item(P, r >> 1, r & 1, 63 - lvl, smem);
      else { const int q = (lvl << 3) + (r - 8); moba_mfma_item(P, (q & 31) >> 3, q & 7, 15 - (q >> 5), smem); }
    }
  }
  grid.sync();
  gemm_phase(MIX, (const bf16_t*)(ws + WS_WO0), D_, D_, 1, Y, D_, smem);
  grid.sync();
  ln_phase(P.in[0], Y, P.in[7], P.in[8], P.out, XB);
  grid.sync();
  gemm_phase(XB, (const bf16_t*)(ws + WS_WT1), D_, P1, 0, Hb, P1, smem);
  grid.sync();
  gla_gate_phase(P);
  grid.sync();
  for (int vb = blockIdx.x; vb < B_ * 4 * 2; vb += gridDim.x) gla_scan_vblock(P, vb);
  grid.sync();
  gla_norm_phase(P);
  grid.sync();
  gemm_phase(MIX, (const bf16_t*)(ws + WS_WO1), D_, D_, 1, Y, D_, smem);
  grid.sync();
  ln_phase(P.out, Y, P.in[14], P.in[15], P.out, nullptr);
}

extern "C" void kernel_launch(void* const* d_in, const int* in_sizes, int n_in, void* d_out, int out_size,
                              void* d_ws, size_t ws_size, hipStream_t stream) {
  constexpr size_t kDynLds = 102400;
  static_assert(kDynLds >= (size_t)AT_LDS_END, "LDS");
  static int grid_blocks = 0;
  if (!grid_blocks) {
    int dev = 0, cus = 0, per_cu = 0;
    (void)hipGetDevice(&dev);
    (void)hipDeviceGetAttribute(&cus, hipDeviceAttributeMultiprocessorCount, dev);
    (void)hipFuncSetAttribute((const void*)fwd_megakernel, hipFuncAttributeMaxDynamicSharedMemorySize, (int)kDynLds);
    (void)hipOccupancyMaxActiveBlocksPerMultiprocessor(&per_cu, fwd_megakernel, 512, kDynLds);
    if (per_cu < 1) per_cu = 1;
    if (per_cu > 2) per_cu = 2;
    grid_blocks = cus * per_cu;
    if (n_in != 16 || ws_size < WS_END) { fprintf(stderr, "kernel_launch: unexpected n_in %d / ws %zu\n", n_in, ws_size); }
  }
  Params p{};
  for (int i = 0; i < 16; ++i) p.in[i] = (const float*)d_in[i];
  p.out = (float*)d_out; p.ws = (unsigned char*)d_ws;
  void* args[] = {&p};
  hipError_t e = hipLaunchCooperativeKernel((void*)fwd_megakernel, dim3(grid_blocks), dim3(512), args, kDynLds, stream);
  if (e != hipSuccess) fprintf(stderr, "cooperative launch failed: %s (grid %d)\n", hipGetErrorString(e), grid_blocks);
}
```

```cpp
#include <hip/hip_runtime.h>
#include <hip/hip_cooperative_groups.h>
#include <cstdio>
#include <cstdint>
namespace cg = cooperative_groups;

typedef unsigned short bf16_t;
typedef short bf16x8 __attribute__((ext_vector_type(8)));
typedef float f32x4 __attribute__((ext_vector_type(4)));
typedef unsigned u32x4 __attribute__((ext_vector_type(4)));

constexpr int B_ = 4, S_ = 4096, M_ = B_ * S_, D_ = 1024;
constexpr int P0 = 4096;
constexpr int P1 = 3328;
constexpr int EVEN_IN = 3864, ODD_IN = 3088;
constexpr int C_NQ = 0, C_KCMP = 512, C_VCMP = 640, C_KSEL = 768, C_VSEL = 896, C_KWIN = 1024, C_VWIN = 1152;
constexpr int C_NZ = 1280, C_MQ = 1792, C_MK = 2304, C_MV = 2816, C_MZ = 3328, C_NG = 3840;
constexpr int G_Q = 0, G_K = 512, G_V = 1024, G_Z = 2048, G_LR = 3072;
constexpr int NCMP = 255;
constexpr float ALPHA = 1.4142135623730951f;
constexpr float LN_EPS = 1e-5f;

constexpr size_t MiB = 1u << 20;
constexpr size_t WS_WT0 = 1 * MiB;
constexpr size_t WS_WO0 = 9 * MiB;
constexpr size_t WS_WT1 = 11 * MiB;
constexpr size_t WS_WO1 = 18 * MiB;
constexpr size_t WS_XB = 20 * MiB;
constexpr size_t WS_MIX = 52 * MiB;
constexpr size_t WS_H = 84 * MiB;
constexpr size_t WS_G = 212 * MiB;
constexpr size_t WS_KC = 245 * MiB;
constexpr size_t WS_VC = 246 * MiB;
constexpr size_t WS_KM = 247 * MiB;
constexpr size_t WS_END = 256 * MiB;

struct Params { const float* in[16]; float* out; unsigned char* ws; };

__device__ __forceinline__ int otid() { int t = __builtin_amdgcn_workitem_id_x(); asm volatile("" : "+v"(t)); return t; }
__device__ __forceinline__ float bf2f(bf16_t v) { return __uint_as_float(((unsigned)v) << 16); }
__device__ __forceinline__ bf16_t f2bf(float f) { unsigned u = __float_as_uint(f); return (bf16_t)((u + 0x7fffu + ((u >> 16) & 1u)) >> 16); }
template <int M> __device__ __forceinline__ float xsum(float v) {
  if constexpr (M == 32) { auto rr = __builtin_amdgcn_permlane32_swap(__float_as_uint(v), __float_as_uint(v), false, false); return __uint_as_float(rr[0]) + __uint_as_float(rr[1]); }
  else return v + __int_as_float(__builtin_amdgcn_ds_swizzle(__float_as_int(v), (M << 10) | 0x1f));
}
template <int M> __device__ __forceinline__ float xmax(float v) {
  if constexpr (M == 32) { auto rr = __builtin_amdgcn_permlane32_swap(__float_as_uint(v), __float_as_uint(v), false, false); return fmaxf(__uint_as_float(rr[0]), __uint_as_float(rr[1])); }
  else return fmaxf(v, __int_as_float(__builtin_amdgcn_ds_swizzle(__float_as_int(v), (M << 10) | 0x1f)));
}
template <int M> __device__ __forceinline__ unsigned xorr(unsigned v) {
  if constexpr (M == 32) { auto rr = __builtin_amdgcn_permlane32_swap(v, v, false, false); return rr[0] | rr[1]; }
  else return v | (unsigned)__builtin_amdgcn_ds_swizzle((int)v, (M << 10) | 0x1f);
}
__device__ __forceinline__ float wave_sum(float v) { v = xsum<1>(v); v = xsum<2>(v); v = xsum<4>(v); v = xsum<8>(v); v = xsum<16>(v); return xsum<32>(v); }
__device__ __forceinline__ float wave_max(float v) { v = xmax<1>(v); v = xmax<2>(v); v = xmax<4>(v); v = xmax<8>(v); v = xmax<16>(v); return xmax<32>(v); }
__device__ __forceinline__ float silu_f(float z) { return z / (1.f + __expf(-z)); }
__device__ __forceinline__ float sigmoid_f(float z) { return 1.f / (1.f + __expf(-z)); }

__device__ __forceinline__ int colmap0(int c) {
  if (c < 1280) return c;
  if (c < 1792) return 1304 + (c - 1280);
  if (c < 3840) return 1816 + (c - 1792);
  if (c < 3864) return 1280 + (c - 3840);
  return -1;
}
__device__ __forceinline__ int colmap1(int c) {
  if (c < 2048) return c;
  if (c < 3072) return 2064 + (c - 2048);
  if (c < 3088) return 2048 + (c - 3072);
  return -1;
}

__device__ __forceinline__ void transpose_tile(const float* __restrict__ W, int K, int Nsrc, bf16_t* __restrict__ Wt, int which, int tile, int ntn, float* sm) {
  const int tid = otid();
  const int nb = tile % ntn, kb = tile / ntn, n0 = nb * 64, k0 = kb * 64;
#pragma unroll
  for (int i = 0; i < 8; ++i) {
    const int kk = i * 8 + (tid >> 6), nn = tid & 63;
    const int c = n0 + nn;
    const int src = which == 0 ? colmap0(c) : (which == 1 ? colmap1(c) : c);
    sm[kk * 65 + nn] = src >= 0 ? W[(size_t)(k0 + kk) * Nsrc + src] : 0.f;
  }
  __syncthreads();
#pragma unroll
  for (int i = 0; i < 8; ++i) {
    const int nn = i * 8 + (tid >> 6), kk = tid & 63;
    Wt[(size_t)(n0 + nn) * K + k0 + kk] = f2bf(sm[kk * 65 + nn]);
  }
  __syncthreads();
}

__device__ __forceinline__ void gemm_tile(const bf16_t* __restrict__ A, const bf16_t* __restrict__ Bt, int K, int m0, int n0, int mode, void* outp, int ldc, unsigned char* smem) {
  bf16_t* As = (bf16_t*)smem;
  bf16_t* Bs = As + 128 * 72;
  const int tid = otid(), lane = tid & 63, wid = tid >> 6, wm = wid >> 1, wn = wid & 1;
  f32x4 acc[2][4];
#pragma unroll
  for (int i = 0; i < 2; ++i)
#pragma unroll
    for (int j = 0; j < 4; ++j) acc[i][j] = (f32x4){0.f, 0.f, 0.f, 0.f};
  for (int k0 = 0; k0 < K; k0 += 64) {
#pragma unroll
    for (int i = 0; i < 2; ++i) {
      const int idx = tid + i * 512, r = idx >> 3, c = (idx & 7) * 8;
      *(uint4*)(As + r * 72 + c) = *(const uint4*)(A + (size_t)(m0 + r) * K + k0 + c);
      *(uint4*)(Bs + r * 72 + c) = *(const uint4*)(Bt + (size_t)(n0 + r) * K + k0 + c);
    }
    __syncthreads();
#pragma unroll
    for (int kk = 0; kk < 64; kk += 32) {
      bf16x8 a[2], b[4];
#pragma unroll
      for (int i = 0; i < 2; ++i) a[i] = *(const bf16x8*)(As + (wm * 32 + i * 16 + (lane & 15)) * 72 + kk + (lane >> 4) * 8);
#pragma unroll
      for (int j = 0; j < 4; ++j) b[j] = *(const bf16x8*)(Bs + (wn * 64 + j * 16 + (lane & 15)) * 72 + kk + (lane >> 4) * 8);
#pragma unroll
      for (int i = 0; i < 2; ++i)
#pragma unroll
        for (int j = 0; j < 4; ++j) acc[i][j] = __builtin_amdgcn_mfma_f32_16x16x32_bf16(a[i], b[j], acc[i][j], 0, 0, 0);
    }
    __syncthreads();
  }
#pragma unroll
  for (int i = 0; i < 2; ++i)
#pragma unroll
    for (int j = 0; j < 4; ++j)
#pragma unroll
      for (int r = 0; r < 4; ++r) {
        const int row = m0 + wm * 32 + i * 16 + (lane >> 4) * 4 + r, col = n0 + wn * 64 + j * 16 + (lane & 15);
        if (mode == 0) ((bf16_t*)outp)[(size_t)row * ldc + col] = f2bf(acc[i][j][r]);
        else ((float*)outp)[(size_t)row * ldc + col] = acc[i][j][r];
      }
}
__device__ __forceinline__ void gemm_phase(const bf16_t* A, const bf16_t* Bt, int K, int N, int mode, void* outp, int ldc, unsigned char* smem) {
  const int ntn = N / 128, ntm = M_ / 128;
  for (int t = blockIdx.x; t < ntn * ntm; t += gridDim.x) {
    const int tn = t % ntn, tm = t / ntn;
    gemm_tile(A, Bt, K, tm * 128, tn * 128, mode, outp, ldc, smem);
  }
}

__device__ __forceinline__ void ln_phase(const float* xin, const float* Y, const float* g, const float* bb, float* out, bf16_t* outb) {
  const int lane = otid() & 63, wid = otid() >> 6;
  for (int row = blockIdx.x * 8 + wid; row < M_; row += gridDim.x * 8) {
    const float4* xr = (const float4*)(xin + (size_t)row * D_);
    const float4* yr = (const float4*)(Y + (size_t)row * D_);
    float4 v[4]; float s = 0.f;
#pragma unroll
    for (int j = 0; j < 4; ++j) {
      const float4 a = xr[j * 64 + lane], y = yr[j * 64 + lane];
      v[j].x = ALPHA * a.x + y.x; v[j].y = ALPHA * a.y + y.y; v[j].z = ALPHA * a.z + y.z; v[j].w = ALPHA * a.w + y.w;
      s += (v[j].x + v[j].y) + (v[j].z + v[j].w);
    }
    const float mean = wave_sum(s) * (1.f / D_);
    float q = 0.f;
#pragma unroll
    for (int j = 0; j < 4; ++j) {
      v[j].x -= mean; v[j].y -= mean; v[j].z -= mean; v[j].w -= mean;
      q += (v[j].x * v[j].x + v[j].y * v[j].y) + (v[j].z * v[j].z + v[j].w * v[j].w);
    }
    const float rstd = 1.f / sqrtf(wave_sum(q) * (1.f / D_) + LN_EPS);
#pragma unroll
    for (int j = 0; j < 4; ++j) {
      const float4 gg = ((const float4*)g)[j * 64 + lane], bv = ((const float4*)bb)[j * 64 + lane];
      float4 o;
      o.x = v[j].x * rstd * gg.x + bv.x; o.y = v[j].y * rstd * gg.y + bv.y; o.z = v[j].z * rstd * gg.z + bv.z; o.w = v[j].w * rstd * gg.w + bv.w;
      ((float4*)(out + (size_t)row * D_))[j * 64 + lane] = o;
      if (outb) {
        ushort4 ob; ob.x = f2bf(o.x); ob.y = f2bf(o.y); ob.z = f2bf(o.z); ob.w = f2bf(o.w);
        ((ushort4*)(outb + (size_t)row * D_))[j * 64 + lane] = ob;
      }
    }
  }
}

__device__ __forceinline__ void compress_item(const Params& P, int item, float* sm) {
  const bf16_t* H0 = (const bf16_t*)(P.ws + WS_H);
  const int tid = otid();
  const int g = item & 1; int r = item >> 1; const int n = r % NCMP; r /= NCMP; const int b = r & 3; const int i = r >> 2;
  const float* pos = P.in[2] + i * 2048;
  const float* w1 = P.in[3] + (size_t)i * 2048 * 128;
  const float* b1 = P.in[4] + i * 128;
  const float* w2 = P.in[5] + (size_t)i * 128 * 64;
  float* blk = sm;
  float* part = sm + 2048;
  float* hid = sm + 2048 + 512;
  const int col = (i == 0 ? C_KCMP : C_VCMP) + g * 64;
#pragma unroll
  for (int k = 0; k < 4; ++k) {
    const int f = tid + k * 512, l = f >> 6, d = f & 63;
    blk[f] = bf2f(H0[((size_t)b * S_ + 16 * n + l) * P0 + col + d]) + pos[f];
  }
  __syncthreads();
  const int hh = tid & 127, pt = tid >> 7;
  float acc = 0.f;
  for (int f = pt * 512; f < pt * 512 + 512; ++f) acc += blk[f] * w1[(size_t)f * 128 + hh];
  part[pt * 128 + hh] = acc;
  __syncthreads();
  if (tid < 128) {
    const float a = part[tid] + part[128 + tid] + part[256 + tid] + part[384 + tid] + b1[tid];
    hid[tid] = silu_f(a);
  }
  __syncthreads();
  if (tid < 64) {
    float o = 0.f;
    for (int k = 0; k < 128; ++k) o += hid[k] * w2[k * 64 + tid];
    float* dst = (float*)(P.ws + (i == 0 ? WS_KC : WS_VC));
    dst[(((size_t)b * NCMP + n) * 2 + g) * 64 + tid] = o;
    bf16_t* dstb = (bf16_t*)(P.ws + (i == 0 ? (size_t)(248 * MiB) : (size_t)(249 * MiB)));
    dstb[(((size_t)b * 2 + g) * 256 + n) * 64 + tid] = f2bf(o);
    if (n == 0) dstb[(((size_t)b * 2 + g) * 256 + 255) * 64 + tid] = 0;
  }
  __syncthreads();
}
__device__ __forceinline__ void kmean_item(const Params& P, int item, int lane) {
  const bf16_t* H0 = (const bf16_t*)(P.ws + WS_H);
  const int h = item & 7, n = (item >> 3) & 15, b = item >> 7;
  float s = 0.f;
  for (int k = 0; k < 256; ++k) s += bf2f(H0[((size_t)b * S_ + n * 256 + k) * P0 + C_MK + h * 64 + lane]);
  ((float*)(P.ws + WS_KM))[(((size_t)b * 16 + n) * 8 + h) * 64 + lane] = s * (1.f / 256.f);
}

template <int NH>
__device__ __forceinline__ void attend_block(const bf16_t* __restrict__ Kp, const bf16_t* __restrict__ Vp, size_t rowbase, int kp0, int t, int kmin,
                                             const float* qs, float* pb, const float* slope, float* m, float* l, float* o, int lane) {
  asm volatile("" ::: "memory");
  const int kp = kp0 + lane;
  const bool valid = (kp <= t) && (kp >= kmin);
  const uint4* kr = (const uint4*)(Kp + (rowbase + kp) * P0);
  float dot[NH];
#pragma unroll
  for (int j = 0; j < NH; ++j) dot[j] = 0.f;
#pragma unroll 1
  for (int c = 0; c < 8; ++c) {
    asm volatile("" ::: "memory");
    const uint4 u = kr[c];
    float kv[8];
    kv[0] = __uint_as_float(u.x << 16); kv[1] = __uint_as_float(u.x & 0xffff0000u);
    kv[2] = __uint_as_float(u.y << 16); kv[3] = __uint_as_float(u.y & 0xffff0000u);
    kv[4] = __uint_as_float(u.z << 16); kv[5] = __uint_as_float(u.z & 0xffff0000u);
    kv[6] = __uint_as_float(u.w << 16); kv[7] = __uint_as_float(u.w & 0xffff0000u);
#pragma unroll
    for (int j = 0; j < NH; ++j) {
      const float4 q0 = *(const float4*)(qs + j * 64 + c * 8), q1 = *(const float4*)(qs + j * 64 + c * 8 + 4);
      dot[j] += kv[0] * q0.x + kv[1] * q0.y + kv[2] * q0.z + kv[3] * q0.w + kv[4] * q1.x + kv[5] * q1.y + kv[6] * q1.z + kv[7] * q1.w;
    }
  }
#pragma unroll
  for (int j = 0; j < NH; ++j) {
    const float s = valid ? 0.125f * dot[j] - slope[j] * (float)(t - kp) : -1e30f;
    const float mn = fmaxf(m[j], wave_max(s));
    const float al = __expf(m[j] - mn);
    const float p = valid ? __expf(s - mn) : 0.f;
    l[j] = l[j] * al + wave_sum(p);
    o[j] *= al; m[j] = mn;
    pb[j * 64 + lane] = p;
  }
  __builtin_amdgcn_wave_barrier();
  const bf16_t* vr = Vp + (rowbase + kp0) * P0 + lane;
#pragma unroll 8
  for (int k = 0; k < 64; ++k) {
    const float v = bf2f(vr[(size_t)k * P0]);
#pragma unroll
    for (int j = 0; j < NH; ++j) o[j] += pb[j * 64 + k] * v;
  }
  __builtin_amdgcn_wave_barrier();
}

__device__ __forceinline__ void nsa_item(const Params& P, int b, int g, int t, float* wsm, int lane) {
  const bf16_t* H0 = (const bf16_t*)(P.ws + WS_H);
  const float* KC = (const float*)(P.ws + WS_KC);
  const float* VC = (const float*)(P.ws + WS_VC);
  bf16_t* MIX = (bf16_t*)(P.ws + WS_MIX);
  float* qs = wsm;
  float* pc = wsm + 256;
  float* pb = wsm + 1280;
  const size_t row = (size_t)b * S_ + t;
  const bf16_t* hrow = H0 + row * P0;
  float slope[4];
#pragma unroll
  for (int j = 0; j < 4; ++j) { qs[j * 64 + lane] = bf2f(hrow[C_NQ + (g * 4 + j) * 64 + lane]); slope[j] = exp2f(-(float)(g * 4 + j + 1)); }
  __builtin_amdgcn_wave_barrier();
  const int nv = t >= 31 ? (t - 31) / 16 + 1 : 0;
#pragma unroll 1
  for (int c = 0; c < 4; ++c) {
    asm volatile("" ::: "memory");
    const int n = c * 64 + lane;
    float dot[4] = {0.f, 0.f, 0.f, 0.f};
    if (n < nv) {
      const float4* kr = (const float4*)(KC + (((size_t)b * NCMP + n) * 2 + g) * 64);
#pragma unroll 4
      for (int d4 = 0; d4 < 16; ++d4) {
        const float4 kv = kr[d4];
#pragma unroll
        for (int j = 0; j < 4; ++j) {
          const float4 q = *(const float4*)(qs + j * 64 + d4 * 4);
          dot[j] += kv.x * q.x + kv.y * q.y + kv.z * q.z + kv.w * q.w;
        }
      }
    }
#pragma unroll
    for (int j = 0; j < 4; ++j) pc[j * 256 + n] = (n < nv) ? 0.125f * dot[j] - slope[j] * (float)(t - (16 * n + 31)) : -1e30f;
  }
  __builtin_amdgcn_wave_barrier();
#pragma unroll
  for (int j = 0; j < 4; ++j) {
    float sc[4];
#pragma unroll
    for (int c = 0; c < 4; ++c) sc[c] = pc[j * 256 + c * 64 + lane];
    float mx = fmaxf(fmaxf(sc[0], sc[1]), fmaxf(sc[2], sc[3]));
    mx = wave_max(mx);
    float sum = 0.f;
#pragma unroll
    for (int c = 0; c < 4; ++c) { const int n = c * 64 + lane; const float p = (n < nv) ? __expf(sc[c] - mx) : 0.f; sc[c] = p; sum += p; }
    sum = wave_sum(sum);
    const float inv = nv > 0 ? 1.f / sum : 0.f;
#pragma unroll
    for (int c = 0; c < 4; ++c) pc[j * 256 + c * 64 + lane] = sc[c] * inv;
  }
  __builtin_amdgcn_wave_barrier();
  float ocmp[4] = {0.f, 0.f, 0.f, 0.f};
  for (int n = 0; n < nv; ++n) {
    const float v = VC[(((size_t)b * NCMP + n) * 2 + g) * 64 + lane];
#pragma unroll
    for (int j = 0; j < 4; ++j) ocmp[j] += pc[j * 256 + n] * v;
  }
  float imp = 0.f;
  {
    const int lo = max(0, 4 * lane - 1), hi = min(NCMP - 1, 4 * lane + 3);
    for (int n = lo; n <= hi; ++n) imp += (pc[n] + pc[256 + n]) + (pc[512 + n] + pc[768 + n]);
  }
  const int cur = t >> 6;
  const bool bvalid = lane <= cur;
  const bool forced = (lane == 0) || (lane == cur) || (lane == cur - 1);
  const float key = bvalid ? (forced ? 1e9f : imp) : -1e30f;
  int rank = 0;
  for (int s2 = 0; s2 < 64; ++s2) {
    const float ks = __shfl(key, s2);
    rank += (ks > key || (ks == key && s2 < lane)) ? 1 : 0;
  }
  const unsigned long long selmask = __ballot(bvalid && rank < 16);
  float m[4], l[4], osel[4], owin[4];
#pragma unroll
  for (int j = 0; j < 4; ++j) { m[j] = -1e30f; l[j] = 0.f; osel[j] = 0.f; }
  {
    unsigned long long mk = selmask;
    while (mk) {
      const int blk = __builtin_ctzll(mk); mk &= mk - 1;
      attend_block<4>(H0 + C_KSEL + g * 64, H0 + C_VSEL + g * 64, (size_t)b * S_, blk * 64, t, 0, qs, pb, slope, m, l, osel, lane);
    }
  }
#pragma unroll
  for (int j = 0; j < 4; ++j) { osel[j] /= l[j]; m[j] = -1e30f; l[j] = 0.f; owin[j] = 0.f; }
  {
    const int kmin = t - 511;
    const int b0 = (kmin > 0 ? kmin : 0) >> 6;
    for (int blk = b0; blk <= cur; ++blk)
      attend_block<4>(H0 + C_KWIN + g * 64, H0 + C_VWIN + g * 64, (size_t)b * S_, blk * 64, t, kmin, qs, pb, slope, m, l, owin, lane);
  }
#pragma unroll
  for (int j = 0; j < 4; ++j) {
    const int h = g * 4 + j;
    const float g0 = sigmoid_f(bf2f(hrow[C_NG + h * 3 + 0])), g1 = sigmoid_f(bf2f(hrow[C_NG + h * 3 + 1])), g2 = sigmoid_f(bf2f(hrow[C_NG + h * 3 + 2]));
    const float o = g0 * ocmp[j] + g1 * osel[j] + g2 * (owin[j] / l[j]);
    const float z = bf2f(hrow[C_NZ + h * 64 + lane]);
    MIX[row * D_ + h * 64 + lane] = f2bf(o * silu_f(z));
  }
}

__device__ __forceinline__ void moba_item(const Params& P, int b, int h, int t, float* wsm, int lane) {
  const bf16_t* H0 = (const bf16_t*)(P.ws + WS_H);
  const float* KM = (const float*)(P.ws + WS_KM);
  bf16_t* MIX = (bf16_t*)(P.ws + WS_MIX);
  float* qs = wsm;
  float* pb = wsm + 1280;
  const size_t row = (size_t)b * S_ + t;
  const bf16_t* hrow = H0 + row * P0;
  qs[lane] = bf2f(hrow[C_MQ + h * 64 + lane]);
  __builtin_amdgcn_wave_barrier();
  float slope[1] = {exp2f(-(float)(h + 1))};
  const int cur = t >> 8;
  float gate = -1e30f;
  if (lane < cur) {
    const float4* kr = (const float4*)(KM + (((size_t)b * 16 + lane) * 8 + h) * 64);
    float d = 0.f;
#pragma unroll 4
    for (int d4 = 0; d4 < 16; ++d4) { const float4 kv = kr[d4]; const float4 q = *(const float4*)(qs + d4 * 4); d += kv.x * q.x + kv.y * q.y + kv.z * q.z + kv.w * q.w; }
    gate = d;
  }
  int rank = 0;
  for (int s2 = 0; s2 < 16; ++s2) {
    const float ks = __shfl(gate, s2);
    rank += (ks > gate || (ks == gate && s2 < lane)) ? 1 : 0;
  }
  unsigned long long mk = __ballot(lane < cur && rank < 3) | (1ull << cur);
  float m[1] = {-1e30f}, l[1] = {0.f}, o[1] = {0.f};
  while (mk) {
    const int blk = __builtin_ctzll(mk); mk &= mk - 1;
    for (int c = 0; c < 4; ++c) {
      const int kp0 = blk * 256 + c * 64;
      if (kp0 > t) break;
      attend_block<1>(H0 + C_MK + h * 64, H0 + C_MV + h * 64, (size_t)b * S_, kp0, t, 0, qs, pb, slope, m, l, o, lane);
    }
  }
  const float z = bf2f(hrow[C_MZ + h * 64 + lane]);
  MIX[row * D_ + 512 + h * 64 + lane] = f2bf((o[0] / l[0]) * silu_f(z));
}


#define LAS __attribute__((address_space(3)))
typedef short s16x4 __attribute__((ext_vector_type(4)));
typedef float f32x2_t __attribute__((ext_vector_type(2)));
typedef __bf16 bf16x2_t __attribute__((ext_vector_type(2)));
__device__ __forceinline__ unsigned cvtpk(float lo, float hi) { f32x2_t v = {lo, hi}; bf16x2_t b = __builtin_convertvector(v, bf16x2_t); return __builtin_bit_cast(unsigned, b); }
__device__ __forceinline__ s16x4 vtr(LAS const unsigned char* p) { return __builtin_bit_cast(s16x4, __builtin_amdgcn_ds_read_tr16_b64_v4i16((LAS s16x4*)p)); }
constexpr int KT_BYTES = 8192;
constexpr int VT_DT = 2080;
constexpr int VT_BYTES = 4 * VT_DT;
constexpr int AT_BUF = KT_BYTES + VT_BYTES;
constexpr int AT_MISC = 2 * AT_BUF;
constexpr int AT_STASH = AT_MISC + 256;
constexpr int AT_LDS_END = AT_STASH + 8 * 512 * 16;
constexpr float C1 = 0.125f * 1.4426950408889634f;
constexpr float LOG2E = 1.4426950408889634f;

__device__ __forceinline__ void at_stage_write(LAS unsigned char* buf, const u32x4& kreg, const u32x4& vreg, int tid) {
  const int key = tid >> 3, c = tid & 7;
  *(LAS u32x4*)(buf + key * 128 + ((c ^ ((key >> 1) & 7)) << 4)) = kreg;
  *(LAS u32x4*)(buf + KT_BYTES + (c >> 1) * VT_DT + key * 32 + (c & 1) * 16) = vreg;
}
__device__ __forceinline__ void at_stage_dma(LAS unsigned char* buf, const bf16_t* Kt, const bf16_t* Vt, unsigned pitch, int lane, int wid) {
  const int kkey = 8 * wid + (lane >> 3), c = (lane & 7) ^ ((kkey >> 1) & 7);
  __builtin_amdgcn_global_load_lds((const unsigned*)(Kt + (unsigned)kkey * pitch + c * 8), (LAS unsigned*)(buf + wid * 1024), 16, 0, 0);
  const int vkey = 32 * (wid & 1) + (lane >> 1), dt = wid >> 1;
  __builtin_amdgcn_global_load_lds((const unsigned*)(Vt + (unsigned)vkey * pitch + dt * 16 + (lane & 1) * 8), (LAS unsigned*)(buf + KT_BYTES + dt * VT_DT + (wid & 1) * 1024), 16, 0, 0);
}
template <int NRG, bool EDGE, int IMPT  >
__device__ __forceinline__ void at_tile_x(LAS const unsigned char* buf, const bf16x8 (&qf)[NRG][2], f32x4 (&O)[NRG][4], float (&m)[NRG], float (&l)[NRG],
                                        const float (&base)[NRG], const float (&soff)[NRG], const int (&lim)[NRG], const int (&lo)[NRG], int lane,
                                        float (&imp)[NRG][16], float (&carry)[NRG]) {
  const int g = lane >> 4, i = lane & 15;
  const int swz = (i >> 1) & 7;
  LAS const unsigned char* kb = buf + i * 128;
  const int kc0 = ((g ^ swz) << 4), kc1 = (((4 + g) ^ swz) << 4);
  f32x4 S[NRG][4];
#pragma unroll
  for (int mt = 0; mt < 4; ++mt) {
    const bf16x8 k0f = *(LAS const bf16x8*)(kb + mt * 2048 + kc0);
    const bf16x8 k1f = *(LAS const bf16x8*)(kb + mt * 2048 + kc1);
#pragma unroll
    for (int rg = 0; rg < NRG; ++rg) {
      f32x4 a = __builtin_amdgcn_mfma_f32_16x16x32_bf16(k0f, qf[rg][0], (f32x4){0.f, 0.f, 0.f, 0.f}, 0, 0, 0);
      S[rg][mt] = __builtin_amdgcn_mfma_f32_16x16x32_bf16(k1f, qf[rg][1], a, 0, 0, 0);
    }
  }
  __builtin_amdgcn_sched_barrier(0);
  unsigned pk[NRG][2][4];
#pragma unroll
  for (int rg = 0; rg < NRG; ++rg) {
    float mx = -INFINITY;
#pragma unroll
    for (int mt = 0; mt < 4; ++mt)
#pragma unroll
      for (int r = 0; r < 4; ++r) {
        float sv = __builtin_fmaf(S[rg][mt][r], C1, base[rg] + soff[rg] * (float)(16 * mt + r));
        if (EDGE) { const int c = 16 * mt + r; sv = (c <= lim[rg] && c >= lo[rg]) ? sv : -INFINITY; }
        S[rg][mt][r] = sv; mx = fmaxf(mx, sv);
      }
    mx = xmax<16>(mx); mx = xmax<32>(mx);
    const float mn = fmaxf(m[rg], mx);
    const float al = __builtin_amdgcn_exp2f(m[rg] - mn);
    m[rg] = mn;
    float ps = 0.f;
#pragma unroll
    for (int mt = 0; mt < 4; ++mt)
#pragma unroll
      for (int r = 0; r < 4; ++r) { const float pv = __builtin_amdgcn_exp2f(S[rg][mt][r] - mn); S[rg][mt][r] = pv; ps += pv; }
    l[rg] = l[rg] * al + ps;
    if (IMPT >= 0) {
#pragma unroll
      for (int k = 0; k < 4 * IMPT; ++k) imp[rg][k] *= al;
      carry[rg] *= al;
      float sh[4];
#pragma unroll
      for (int mt = 0; mt < 4; ++mt) sh[mt] = __uint_as_float(__builtin_amdgcn_ds_bpermute(((lane + 48) & 63) << 2, __float_as_uint(S[rg][mt][3])));
#pragma unroll
      for (int mt = 0; mt < 4; ++mt) {
        const float own = (S[rg][mt][0] + S[rg][mt][1]) + (S[rg][mt][2] + S[rg][mt][3]);
        const float prev = g > 0 ? sh[mt] : (mt > 0 ? sh[mt > 0 ? mt - 1 : 0] : carry[rg]);
        imp[rg][(IMPT >= 0 ? 4 * IMPT : 0) + mt] = own + prev;
      }
      carry[rg] = sh[3];
    }
#pragma unroll
    for (int dt = 0; dt < 4; ++dt) O[rg][dt] = O[rg][dt] * al;
#pragma unroll
    for (int ks = 0; ks < 2; ++ks) {
      pk[rg][ks][0] = cvtpk(S[rg][2 * ks][0], S[rg][2 * ks][1]); pk[rg][ks][1] = cvtpk(S[rg][2 * ks][2], S[rg][2 * ks][3]);
      pk[rg][ks][2] = cvtpk(S[rg][2 * ks + 1][0], S[rg][2 * ks + 1][1]); pk[rg][ks][3] = cvtpk(S[rg][2 * ks + 1][2], S[rg][2 * ks + 1][3]);
    }
  }
  LAS const unsigned char* vb = buf + KT_BYTES + (4 * g + (i >> 2)) * 32 + (i & 3) * 8;
#pragma unroll
  for (int dt = 0; dt < 4; ++dt)
#pragma unroll
    for (int ks = 0; ks < 2; ++ks) {
      const s16x4 v0 = vtr(vb + dt * VT_DT + ks * 1024);
      const s16x4 v1 = vtr(vb + dt * VT_DT + ks * 1024 + 512);
      const bf16x8 vf = (bf16x8){v0[0], v0[1], v0[2], v0[3], v1[0], v1[1], v1[2], v1[3]};
#pragma unroll
      for (int rg = 0; rg < NRG; ++rg) {
        const u32x4 pw = {pk[rg][ks][0], pk[rg][ks][1], pk[rg][ks][2], pk[rg][ks][3]};
        O[rg][dt] = __builtin_amdgcn_mfma_f32_16x16x32_bf16(vf, __builtin_bit_cast(bf16x8, pw), O[rg][dt], 0, 0, 0);
      }
    }
}

template <int NRG, bool EDGE>
__device__ __forceinline__ void at_tile(LAS const unsigned char* buf, const bf16x8 (&qf)[NRG][2], f32x4 (&O)[NRG][4], float (&m)[NRG], float (&l)[NRG],
                                        const float (&base)[NRG], const float (&soff)[NRG], const int (&lim)[NRG], const int (&lo)[NRG], int lane) {
  float dimp[NRG][16]; float dc[NRG];
  at_tile_x<NRG, EDGE, -1>(buf, qf, O, m, l, base, soff, lim, lo, lane, dimp, dc);
}

__device__ __forceinline__ void moba_mfma_item(const Params& P, int b, int h, int cur, unsigned char* smem_g) {
  LAS unsigned char* lds = (LAS unsigned char*)smem_g;
  const bf16_t* __restrict__ H0 = (const bf16_t*)(P.ws + WS_H);
  const float* __restrict__ KM = (const float*)(P.ws + WS_KM);
  bf16_t* __restrict__ MIX = (bf16_t*)(P.ws + WS_MIX);
  const int tid = otid(), lane = tid & 63, wid = __builtin_amdgcn_readfirstlane(tid >> 6), g = lane >> 4, i = lane & 15;
  const float slope2 = exp2f(-(float)(h + 1)) * LOG2E;
  const int t0 = cur * 256;
  int trow[2]; bf16x8 qf[2][2]; unsigned sel[2];
#pragma unroll
  for (int rg = 0; rg < 2; ++rg) {
    trow[rg] = t0 + wid * 32 + rg * 16 + i;
    const bf16_t* qp = H0 + ((size_t)b * S_ + trow[rg]) * P0 + C_MQ + h * 64 + 8 * g;
    qf[rg][0] = *(const bf16x8*)qp; qf[rg][1] = *(const bf16x8*)(qp + 32);
  }
#pragma unroll
  for (int rg = 0; rg < 2; ++rg) {
    float qv[16];
#pragma unroll
    for (int j = 0; j < 8; ++j) { qv[j] = bf2f((bf16_t)qf[rg][0][j]); qv[8 + j] = bf2f((bf16_t)qf[rg][1][j]); }
    float v1 = -INFINITY, v2 = -INFINITY, v3 = -INFINITY; int i1 = -1, i2 = -1, i3 = -1;
    for (int n = 0; n < cur; ++n) {
      const float* kr = KM + (((size_t)b * 16 + n) * 8 + h) * 64 + 8 * g;
      const float4 a0 = *(const float4*)kr, a1 = *(const float4*)(kr + 4), b0 = *(const float4*)(kr + 32), b1 = *(const float4*)(kr + 36);
      float d = qv[0] * a0.x + qv[1] * a0.y + qv[2] * a0.z + qv[3] * a0.w + qv[4] * a1.x + qv[5] * a1.y + qv[6] * a1.z + qv[7] * a1.w
              + qv[8] * b0.x + qv[9] * b0.y + qv[10] * b0.z + qv[11] * b0.w + qv[12] * b1.x + qv[13] * b1.y + qv[14] * b1.z + qv[15] * b1.w;
      d = xsum<16>(d); d = xsum<32>(d);
      if (d > v1) { v3 = v2; i3 = i2; v2 = v1; i2 = i1; v1 = d; i1 = n; }
      else if (d > v2) { v3 = v2; i3 = i2; v2 = d; i2 = n; }
      else if (d > v3) { v3 = d; i3 = n; }
    }
    unsigned mk = 0u;
    if (i1 >= 0) mk |= 1u << i1;
    if (i2 >= 0) mk |= 1u << i2;
    if (i3 >= 0) mk |= 1u << i3;
    sel[rg] = mk;
  }
  {
    unsigned u = sel[0] | sel[1];
    u = xorr<1>(u); u = xorr<2>(u); u = xorr<4>(u); u = xorr<8>(u);
    LAS unsigned* misc = (LAS unsigned*)(lds + AT_MISC);
    if (lane == 0) misc[wid] = u;
  }
  __syncthreads();
  unsigned umask = 0u;
  {
    LAS unsigned* misc = (LAS unsigned*)(lds + AT_MISC);
#pragma unroll
    for (int w = 0; w < 8; ++w) umask |= misc[w];
  }
  umask = __builtin_amdgcn_readfirstlane(umask);
  const int npast = __builtin_popcount(umask);
  const int nt = 4 * npast + 4;
  f32x4 O[2][4]; float m[2], l[2];
#pragma unroll
  for (int rg = 0; rg < 2; ++rg) { m[rg] = -1e30f; l[rg] = 0.f;
#pragma unroll
    for (int dt = 0; dt < 4; ++dt) O[rg][dt] = (f32x4){0.f, 0.f, 0.f, 0.f}; }
  const bf16_t* Kg = H0 + (size_t)b * S_ * P0 + C_MK + h * 64;
  const bf16_t* Vg = H0 + (size_t)b * S_ * P0 + C_MV + h * 64;
  unsigned rem = umask; int blk = -1, sub = 4;
  auto next_tile = [&](int& kblk, int& k0) {
    if (sub == 4) { sub = 0; if (rem) { blk = __builtin_ctz(rem); rem &= rem - 1; } else blk = cur; }
    kblk = blk; k0 = blk * 256 + sub * 64; ++sub;
  };
  int kblk, k0; next_tile(kblk, k0);
  at_stage_dma(lds, Kg + (size_t)k0 * P0, Vg + (size_t)k0 * P0, P0, lane, wid);
  __syncthreads();
  for (int ti = 0; ti < nt; ++ti) {
    const int cblk = kblk, ck0 = k0;
    if (ti + 1 < nt) {
      next_tile(kblk, k0);
      at_stage_dma(lds + ((ti + 1) & 1) * AT_BUF, Kg + (size_t)k0 * P0, Vg + (size_t)k0 * P0, P0, lane, wid);
    }
    LAS const unsigned char* buf = lds + (ti & 1) * AT_BUF;
    float base[2], soff[2]; int lim[2], lo[2];
#pragma unroll
    for (int rg = 0; rg < 2; ++rg) {
      const bool rs = (cblk == cur) || ((sel[rg] >> cblk) & 1u);
      base[rg] = rs ? slope2 * (float)(ck0 + 4 * g - trow[rg]) : -INFINITY;
      soff[rg] = slope2; lim[rg] = trow[rg] - ck0 - 4 * g; lo[rg] = -1000000;
    }
    if (cblk == cur) at_tile<2, true>(buf, qf, O, m, l, base, soff, lim, lo, lane);
    else at_tile<2, false>(buf, qf, O, m, l, base, soff, lim, lo, lane);
    __syncthreads();
  }
#pragma unroll
  for (int rg = 0; rg < 2; ++rg) {
    float lt = l[rg]; lt = xsum<16>(lt); lt = xsum<32>(lt);
    const float inv = 1.f / lt;
    const size_t row = (size_t)b * S_ + trow[rg];
#pragma unroll
    for (int dt = 0; dt < 4; ++dt) {
      const int dv = 16 * dt + 4 * g;
      const ushort4 zz = *(const ushort4*)(H0 + row * P0 + C_MZ + h * 64 + dv);
      ushort4 ov;
      ov.x = f2bf(O[rg][dt][0] * inv * silu_f(bf2f(zz.x))); ov.y = f2bf(O[rg][dt][1] * inv * silu_f(bf2f(zz.y)));
      ov.z = f2bf(O[rg][dt][2] * inv * silu_f(bf2f(zz.z))); ov.w = f2bf(O[rg][dt][3] * inv * silu_f(bf2f(zz.w)));
      *(ushort4*)(MIX + row * D_ + 512 + h * 64 + dv) = ov;
    }
  }
}


constexpr size_t WS_KCB = 248 * MiB;
constexpr size_t WS_VCB = 249 * MiB;
__device__ __forceinline__ void nsa_mfma_item(const Params& P, int b, int grp, int sb, unsigned char* smem_g) {
  LAS unsigned char* lds = (LAS unsigned char*)smem_g;
  const bf16_t* __restrict__ H0 = (const bf16_t*)(P.ws + WS_H);
  bf16_t* __restrict__ MIX = (bf16_t*)(P.ws + WS_MIX);
  const int tid = otid(), lane = tid & 63, wid = __builtin_amdgcn_readfirstlane(tid >> 6), g = lane >> 4, i = lane & 15;
  const int t0 = sb * 64;
  int trow[2]; bf16x8 qf[2][2];
  const int hh = grp * 4 + (i & 3);
  const float slope2 = exp2f(-(float)(hh + 1)) * LOG2E;
  const bf16_t* __restrict__ Hb = H0 + (size_t)b * S_ * P0;
#pragma unroll
  for (int rg = 0; rg < 2; ++rg) {
    trow[rg] = t0 + wid * 8 + rg * 4 + (i >> 2);
    const unsigned qo = (unsigned)trow[rg] * P0 + C_NQ + hh * 64 + 8 * g;
    qf[rg][0] = *(const bf16x8*)(Hb + qo); qf[rg][1] = *(const bf16x8*)(Hb + qo + 32);
  }
  LAS f32x4* stash = (LAS f32x4*)(lds + AT_STASH) + tid;
  f32x4 O[2][4]; float m[2], l[2];
  unsigned mlo[2], mhi[2];
#pragma unroll
  for (int rg = 0; rg < 2; ++rg) {
    float imp[1][16], carry[1], m1[1], l1[1]; f32x4 O1[1][4]; bf16x8 q1[1][2];
    q1[0][0] = qf[rg][0]; q1[0][1] = qf[rg][1];
    m1[0] = -1e30f; l1[0] = 0.f; carry[0] = 0.f;
#pragma unroll
    for (int k = 0; k < 16; ++k) imp[0][k] = 0.f;
#pragma unroll
    for (int dt = 0; dt < 4; ++dt) O1[0][dt] = (f32x4){0.f, 0.f, 0.f, 0.f};
    const int ntc = ((4 * sb + 2) >> 6) + 1;
    const bf16_t* Kg = (const bf16_t*)(P.ws + WS_KCB) + (size_t)(b * 2 + grp) * 256 * 64;
    const bf16_t* Vg = (const bf16_t*)(P.ws + WS_VCB) + (size_t)(b * 2 + grp) * 256 * 64;
    at_stage_dma(lds, Kg, Vg, 64, lane, wid);
    __syncthreads();
#pragma unroll
    for (int tile = 0; tile < 4; ++tile) {
      if (tile < ntc) {
        if (tile + 1 < ntc) at_stage_dma(lds + ((tile + 1) & 1) * AT_BUF, Kg + (tile + 1) * 4096, Vg + (tile + 1) * 4096, 64, lane, wid);
        LAS const unsigned char* buf = lds + (tile & 1) * AT_BUF;
        float base[1], soff[1]; int lim[1], lo[1];
        const int nlim = trow[rg] >= 31 ? ((trow[rg] - 31) >> 4) : -1;
        base[0] = slope2 * (float)(16 * (64 * tile + 4 * g) + 31 - trow[rg]);
        soff[0] = 16.f * slope2; lim[0] = nlim - 64 * tile - 4 * g; lo[0] = -1000000;
        if (tile == 0) at_tile_x<1, true, 0>(buf, q1, O1, m1, l1, base, soff, lim, lo, lane, imp, carry);
        else if (tile == 1) at_tile_x<1, true, 1>(buf, q1, O1, m1, l1, base, soff, lim, lo, lane, imp, carry);
        else if (tile == 2) at_tile_x<1, true, 2>(buf, q1, O1, m1, l1, base, soff, lim, lo, lane, imp, carry);
        else at_tile_x<1, true, 3>(buf, q1, O1, m1, l1, base, soff, lim, lo, lane, imp, carry);
        __syncthreads();
      }
    }
    {
      float lt = l1[0]; lt = xsum<16>(lt); lt = xsum<32>(lt);
      const float inv = lt > 0.f ? 1.f / lt : 0.f;
      const float g0 = sigmoid_f(bf2f(Hb[(unsigned)trow[rg] * P0 + C_NG + hh * 3 + 0]));
#pragma unroll
      for (int dt = 0; dt < 4; ++dt) stash[(rg * 4 + dt) * 512] = O1[0][dt] * (g0 * inv);
      if (sb < 16) { mlo[rg] = (1u << (sb + 1)) - 1u; mhi[rg] = 0u; }
      else {
        float key[16];
#pragma unroll
        for (int k = 0; k < 16; ++k) {
          float v = imp[0][k] * inv; v = xsum<1>(v); v = xsum<2>(v);
          const int sidx = 4 * k + g;
          const bool forced = (sidx == 0) || (sidx == sb) || (sidx == sb - 1);
          key[k] = (sidx <= sb) ? (forced ? 1e9f : v) : -1e30f;
        }
        const int j = i & 3;
        float mykey[4]; int mys[4], rank[4];
#pragma unroll
        for (int q = 0; q < 4; ++q) {
          mykey[q] = j == 0 ? key[q] : (j == 1 ? key[4 + q] : (j == 2 ? key[8 + q] : key[12 + q]));
          mys[q] = 4 * (4 * j + q) + g; rank[q] = 0;
        }
#pragma unroll 1
        for (int gg = 0; gg < 4; ++gg)
#pragma unroll
          for (int kk = 0; kk < 16; ++kk) {
            const float other = __uint_as_float(__builtin_amdgcn_ds_bpermute((gg * 16 + i) << 2, __float_as_uint(key[kk])));
            const int sp = 4 * kk + gg;
#pragma unroll
            for (int q = 0; q < 4; ++q) rank[q] += (other > mykey[q] || (other == mykey[q] && sp < mys[q])) ? 1 : 0;
          }
        unsigned a = 0u, bb = 0u;
#pragma unroll
        for (int q = 0; q < 4; ++q) if (rank[q] < 16 && mys[q] <= sb) { if (mys[q] < 32) a |= 1u << mys[q]; else bb |= 1u << (mys[q] - 32); }
        a = xorr<1>(a); bb = xorr<1>(bb); a = xorr<2>(a); bb = xorr<2>(bb);
        a = xorr<16>(a); bb = xorr<16>(bb); a = xorr<32>(a); bb = xorr<32>(bb);
        mlo[rg] = a; mhi[rg] = bb;
      }
    }
  }
  {
    unsigned ua = mlo[0] | mlo[1], ub = mhi[0] | mhi[1];
    ua = xorr<4>(ua); ub = xorr<4>(ub); ua = xorr<8>(ua); ub = xorr<8>(ub);
    LAS unsigned* misc = (LAS unsigned*)(lds + AT_MISC);
    if (lane == 0) { misc[2 * wid] = ua; misc[2 * wid + 1] = ub; }
    __syncthreads();
    ua = 0u; ub = 0u;
#pragma unroll
    for (int w = 0; w < 8; ++w) { ua |= misc[2 * w]; ub |= misc[2 * w + 1]; }
    unsigned long long rem = ((unsigned long long)(unsigned)__builtin_amdgcn_readfirstlane(ub) << 32) | (unsigned)__builtin_amdgcn_readfirstlane(ua);
    const int nt = __builtin_popcountll(rem);
#pragma unroll
    for (int rg = 0; rg < 2; ++rg) { m[rg] = -1e30f; l[rg] = 0.f;
#pragma unroll
      for (int dt = 0; dt < 4; ++dt) O[rg][dt] = (f32x4){0.f, 0.f, 0.f, 0.f}; }
    const bf16_t* Kg = Hb + C_KSEL + grp * 64;
    const bf16_t* Vg = Hb + C_VSEL + grp * 64;
    int blk = __builtin_ctzll(rem); rem &= rem - 1;
    at_stage_dma(lds, Kg + (size_t)blk * 64 * P0, Vg + (size_t)blk * 64 * P0, P0, lane, wid);
    __syncthreads();
    for (int ti = 0; ti < nt; ++ti) {
      const int cblk = blk;
      if (ti + 1 < nt) { blk = __builtin_ctzll(rem); rem &= rem - 1;
        at_stage_dma(lds + ((ti + 1) & 1) * AT_BUF, Kg + (size_t)blk * 64 * P0, Vg + (size_t)blk * 64 * P0, P0, lane, wid); }
      LAS const unsigned char* buf = lds + (ti & 1) * AT_BUF;
      float base[2], soff[2]; int lim[2], lo[2];
#pragma unroll
      for (int rg = 0; rg < 2; ++rg) {
        const bool rs = cblk < 32 ? ((mlo[rg] >> cblk) & 1u) : ((mhi[rg] >> (cblk - 32)) & 1u);
        base[rg] = rs ? slope2 * (float)(cblk * 64 + 4 * g - trow[rg]) : -INFINITY;
        soff[rg] = slope2; lim[rg] = trow[rg] - cblk * 64 - 4 * g; lo[rg] = -1000000;
      }
      if (cblk == sb) at_tile<2, true>(buf, qf, O, m, l, base, soff, lim, lo, lane);
      else at_tile<2, false>(buf, qf, O, m, l, base, soff, lim, lo, lane);
      __syncthreads();
    }
#pragma unroll
    for (int rg = 0; rg < 2; ++rg) {
      float lt = l[rg]; lt = xsum<16>(lt); lt = xsum<32>(lt);
      const float g1 = sigmoid_f(bf2f(Hb[(unsigned)trow[rg] * P0 + C_NG + hh * 3 + 1]));
#pragma unroll
      for (int dt = 0; dt < 4; ++dt) stash[(rg * 4 + dt) * 512] += O[rg][dt] * (g1 / lt);
    }
  }
  {
    const int b0 = sb >= 8 ? sb - 8 : 0;
    const int nt = sb - b0 + 1;
#pragma unroll
    for (int rg = 0; rg < 2; ++rg) { m[rg] = -1e30f; l[rg] = 0.f;
#pragma unroll
      for (int dt = 0; dt < 4; ++dt) O[rg][dt] = (f32x4){0.f, 0.f, 0.f, 0.f}; }
    const bf16_t* Kg = Hb + C_KWIN + grp * 64;
    const bf16_t* Vg = Hb + C_VWIN + grp * 64;
    at_stage_dma(lds, Kg + (size_t)b0 * 64 * P0, Vg + (size_t)b0 * 64 * P0, P0, lane, wid);
    __syncthreads();
    for (int ti = 0; ti < nt; ++ti) {
      const int cblk = b0 + ti;
      if (ti + 1 < nt) at_stage_dma(lds + ((ti + 1) & 1) * AT_BUF, Kg + (size_t)(cblk + 1) * 64 * P0, Vg + (size_t)(cblk + 1) * 64 * P0, P0, lane, wid);
      LAS const unsigned char* buf = lds + (ti & 1) * AT_BUF;
      float base[2], soff[2]; int lim[2], lo[2];
#pragma unroll
      for (int rg = 0; rg < 2; ++rg) {
        base[rg] = slope2 * (float)(cblk * 64 + 4 * g - trow[rg]);
        soff[rg] = slope2; lim[rg] = trow[rg] - cblk * 64 - 4 * g; lo[rg] = trow[rg] - 511 - cblk * 64 - 4 * g;
      }
      if (cblk == sb || cblk == sb - 8) at_tile<2, true>(buf, qf, O, m, l, base, soff, lim, lo, lane);
      else at_tile<2, false>(buf, qf, O, m, l, base, soff, lim, lo, lane);
      __syncthreads();
    }
  }
#pragma unroll
  for (int rg = 0; rg < 2; ++rg) {
    float lt = l[rg]; lt = xsum<16>(lt); lt = xsum<32>(lt);
    const unsigned ro = (unsigned)trow[rg] * P0;
    const float g2 = sigmoid_f(bf2f(Hb[ro + C_NG + hh * 3 + 2])) / lt;
#pragma unroll
    for (int dt = 0; dt < 4; ++dt) {
      const int dv = 16 * dt + 4 * g;
      const ushort4 zz = *(const ushort4*)(Hb + ro + C_NZ + hh * 64 + dv);
      const f32x4 ov = stash[(rg * 4 + dt) * 512] + O[rg][dt] * g2;
      ushort4 o4;
      o4.x = f2bf(ov[0] * silu_f(bf2f(zz.x))); o4.y = f2bf(ov[1] * silu_f(bf2f(zz.y)));
      o4.z = f2bf(ov[2] * silu_f(bf2f(zz.z))); o4.w = f2bf(ov[3] * silu_f(bf2f(zz.w)));
      *(ushort4*)(MIX + (size_t)b * S_ * D_ + (unsigned)trow[rg] * D_ + hh * 64 + dv) = o4;
    }
  }
}

__device__ __forceinline__ void gla_gate_phase(const Params& P) {
  const bf16_t* H1 = (const bf16_t*)(P.ws + WS_H);
  float* G = (float*)(P.ws + WS_G);
  const float* w2 = P.in[10]; const float* gb = P.in[11];
  const size_t total = (size_t)M_ * 512;
  for (size_t i = (size_t)blockIdx.x * 512 + otid(); i < total; i += (size_t)gridDim.x * 512) {
    const int c = (int)(i & 511); const size_t row = i >> 9;
    float x = gb[c];
#pragma unroll
    for (int r = 0; r < 16; ++r) x += bf2f(H1[row * P1 + G_LR + r]) * w2[r * 512 + c];
    const float ls = fminf(x, 0.f) - log1pf(__expf(-fabsf(x)));
    G[i] = ls * (1.f / 16.f);
  }
}
__device__ __forceinline__ void gla_scan_vblock(const Params& P, int vb) {
  const bf16_t* __restrict__ H1 = (const bf16_t*)(P.ws + WS_H);
  const float* __restrict__ G = (const float*)(P.ws + WS_G);
  bf16_t* __restrict__ O = (bf16_t*)(P.ws + WS_XB);
  const int tid = otid(), lane = tid & 63, wid = tid >> 6;
  const int eh = vb & 1, h = (vb >> 1) & 3, b = vb >> 3;
  const int e = eh * 128 + wid * 16 + (lane >> 2), dq = lane & 3;
  float St[32];
#pragma unroll
  for (int i = 0; i < 32; ++i) St[i] = 0.f;
  const float qscale = 0.08838834764831845f;
  for (int t = 0; t < S_; ++t) {
    const size_t row = (size_t)b * S_ + t;
    const float4* gr = (const float4*)(G + row * 512 + h * 128 + dq * 32);
    const uint4* kr = (const uint4*)(H1 + row * P1 + G_K + h * 128 + dq * 32);
    const uint4* qr = (const uint4*)(H1 + row * P1 + G_Q + h * 128 + dq * 32);
    const float v = bf2f(H1[row * P1 + G_V + h * 256 + e]);
    float o = 0.f;
#pragma unroll
    for (int c = 0; c < 4; ++c) {
      const uint4 ku = kr[c], qu = qr[c];
      const float4 g0 = gr[2 * c], g1 = gr[2 * c + 1];
      const float kk[8] = {__uint_as_float(ku.x << 16), __uint_as_float(ku.x & 0xffff0000u), __uint_as_float(ku.y << 16), __uint_as_float(ku.y & 0xffff0000u),
                           __uint_as_float(ku.z << 16), __uint_as_float(ku.z & 0xffff0000u), __uint_as_float(ku.w << 16), __uint_as_float(ku.w & 0xffff0000u)};
      const float qq[8] = {__uint_as_float(qu.x << 16), __uint_as_float(qu.x & 0xffff0000u), __uint_as_float(qu.y << 16), __uint_as_float(qu.y & 0xffff0000u),
                           __uint_as_float(qu.z << 16), __uint_as_float(qu.z & 0xffff0000u), __uint_as_float(qu.w << 16), __uint_as_float(qu.w & 0xffff0000u)};
      const float gg[8] = {g0.x, g0.y, g0.z, g0.w, g1.x, g1.y, g1.z, g1.w};
#pragma unroll
      for (int i = 0; i < 8; ++i) {
        const float a = __expf(gg[i]);
        St[c * 8 + i] = a * St[c * 8 + i] + kk[i] * v;
        o += qq[i] * St[c * 8 + i];
      }
    }
    o = xsum<1>(o); o = xsum<2>(o);
    if (dq == 0) O[row * D_ + h * 256 + e] = f2bf(o * qscale);
  }
}

constexpr size_t WS_QT = WS_G;
constexpr size_t WS_KH = WS_G + 16 * MiB;
constexpr size_t WS_ATT = 190 * MiB;
constexpr size_t WS_DEC = 199 * MiB;
__device__ __forceinline__ int kperm(int x) { const int dl = x & 31, hi = dl >> 4, d2 = dl & 15; return (x & ~31) + 8 * (d2 >> 2) + 4 * hi + (d2 & 3); }

__device__ __forceinline__ void gla_prep_item(const Params& P, int item, unsigned char* smem_g) {
  const bf16_t* __restrict__ H1 = (const bf16_t*)(P.ws + WS_H);
  bf16_t* __restrict__ QT = (bf16_t*)(P.ws + WS_QT) + (size_t)item * 8192;
  bf16_t* __restrict__ KH = (bf16_t*)(P.ws + WS_KH) + (size_t)item * 8192;
  bf16_t* __restrict__ ATT = (bf16_t*)(P.ws + WS_ATT) + (size_t)item * 4096;
  float* __restrict__ DEC = (float*)(P.ws + WS_DEC) + (size_t)item * 128;
  const int tid = otid(), lane = tid & 63, wid = tid >> 6, g = lane >> 4, i = lane & 15;
  const int c = item & 63, h = (item >> 6) & 3, b = item >> 8;
  const size_t rowbase = (size_t)b * S_ + c * 64;
  float* glr = (float*)smem_g;
  float* tot = (float*)(smem_g + 4096);
  bf16_t* qs = (bf16_t*)(smem_g + 6144);
  bf16_t* ks = (bf16_t*)(smem_g + 6144 + 17408);
  const int d = tid & 127, ig = tid >> 7;
#pragma unroll
  for (int k = 0; k < 2; ++k) { const int e = tid + 512 * k; glr[e] = bf2f(H1[(rowbase + (e >> 4)) * P1 + G_LR + (e & 15)]); }
  float w[16];
#pragma unroll
  for (int r = 0; r < 16; ++r) w[r] = P.in[10][r * 512 + h * 128 + d];
  const float gb = P.in[11][h * 128 + d];
  __syncthreads();
  float bb[16]; float run = 0.f;
#pragma unroll
  for (int k = 0; k < 16; ++k) {
    const float* gr = glr + (16 * ig + k) * 16;
    float x = gb;
#pragma unroll
    for (int r = 0; r < 16; ++r) x += gr[r] * w[r];
    const float la = (fminf(x, 0.f) - log1pf(__expf(-fabsf(x)))) * (1.f / 16.f);
    run += la; bb[k] = run;
  }
  tot[ig * 128 + d] = run;
  __syncthreads();
  float off = 0.f, total = 0.f;
#pragma unroll
  for (int q = 0; q < 4; ++q) { const float tv = tot[q * 128 + d]; total += tv; if (q < ig) off += tv; }
  const float qscale = 0.08838834764831845f;
  const int dp = kperm(d);
#pragma unroll
  for (int k = 0; k < 16; ++k) {
    const int r = 16 * ig + k;
    const float bv = bb[k] + off;
    const float qv = bf2f(H1[(rowbase + r) * P1 + G_Q + h * 128 + d]), kv = bf2f(H1[(rowbase + r) * P1 + G_K + h * 128 + d]);
    const float eb = __expf(bv);
    const bf16_t qt = f2bf(qv * eb * qscale), kt = f2bf(kv * __expf(-bv)), kh = f2bf(kv * __expf(total - bv));
    qs[r * 136 + d] = qt; ks[r * 136 + d] = kt;
    QT[r * 128 + dp] = qt; KH[r * 128 + d] = kh;
  }
  if (ig == 0) DEC[d] = __expf(total);
  __syncthreads();
  {
    const int it = wid >> 1, jt0 = 2 * (wid & 1);
    f32x4 acc[2] = {(f32x4){0.f, 0.f, 0.f, 0.f}, (f32x4){0.f, 0.f, 0.f, 0.f}};
#pragma unroll
    for (int kk = 0; kk < 4; ++kk) {
      const bf16x8 a = *(const bf16x8*)(qs + (16 * it + i) * 136 + 32 * kk + 8 * g);
#pragma unroll
      for (int n = 0; n < 2; ++n) {
        const bf16x8 bf = *(const bf16x8*)(ks + (16 * (jt0 + n) + i) * 136 + 32 * kk + 8 * g);
        acc[n] = __builtin_amdgcn_mfma_f32_16x16x32_bf16(a, bf, acc[n], 0, 0, 0);
      }
    }
#pragma unroll
    for (int n = 0; n < 2; ++n)
#pragma unroll
      for (int r = 0; r < 4; ++r) {
        const int ri = 16 * it + 4 * g + r, cj = 16 * (jt0 + n) + i;
        ATT[ri * 64 + kperm(cj)] = f2bf(cj <= ri ? acc[n][r] : 0.f);
      }
  }
  __syncthreads();
}

constexpr int GS_Q = 0, GS_K = 16384, GS_V = 32768, GS_A = 49152, GS_BYTES = 57344;
__device__ __forceinline__ void gla_stage_dma(LAS unsigned char* st, const Params& P, int item, size_t rowbase, int h, int eh, int lane, int wid) {
  const bf16_t* QT = (const bf16_t*)(P.ws + WS_QT) + (size_t)item * 8192;
  const bf16_t* KH = (const bf16_t*)(P.ws + WS_KH) + (size_t)item * 8192;
  const bf16_t* ATT = (const bf16_t*)(P.ws + WS_ATT) + (size_t)item * 4096;
  const bf16_t* V = (const bf16_t*)(P.ws + WS_H) + rowbase * P1 + G_V + h * 256 + eh * 128;
#pragma unroll
  for (int n = 0; n < 2; ++n) {
    const int q = 2 * wid + n;
    { const int row = 4 * q + (lane >> 4), ch = (lane & 15) ^ (row & 15);
      __builtin_amdgcn_global_load_lds((const unsigned*)(QT + row * 128 + ch * 8), (LAS unsigned*)(st + GS_Q + q * 1024), 16, 0, 0); }
    { const int dt = q >> 1, j = 32 * (q & 1) + (lane >> 1);
      __builtin_amdgcn_global_load_lds((const unsigned*)(KH + j * 128 + dt * 16 + (lane & 1) * 8), (LAS unsigned*)(st + GS_K + q * 1024), 16, 0, 0);
      __builtin_amdgcn_global_load_lds((const unsigned*)(V + (unsigned)j * P1 + dt * 16 + (lane & 1) * 8), (LAS unsigned*)(st + GS_V + q * 1024), 16, 0, 0); }
  }
  { const int row = 8 * wid + (lane >> 3), ch = (lane & 7) ^ ((row >> 1) & 7);
    __builtin_amdgcn_global_load_lds((const unsigned*)(ATT + row * 64 + ch * 8), (LAS unsigned*)(st + GS_A + wid * 1024), 16, 0, 0); }
}
__device__ __forceinline__ void gla_chain(const Params& P, int chain, unsigned char* smem_g) {
  LAS unsigned char* lds = (LAS unsigned char*)smem_g;
  bf16_t* __restrict__ O = (bf16_t*)(P.ws + WS_XB);
  const int tid = otid(), lane = tid & 63, wid = __builtin_amdgcn_readfirstlane(tid >> 6), g = lane >> 4, i = lane & 15;
  const int eh = chain & 1, h = (chain >> 1) & 3, b = chain >> 3;
  const int item0 = (b * 4 + h) * 64;
  f32x4 S[8];
#pragma unroll
  for (int dt = 0; dt < 8; ++dt) S[dt] = (f32x4){0.f, 0.f, 0.f, 0.f};
  gla_stage_dma(lds, P, item0, (size_t)b * S_, h, eh, lane, wid);
  __syncthreads();
  for (int c = 0; c < 64; ++c) {
    if (c + 1 < 64) gla_stage_dma(lds + ((c + 1) & 1) * GS_BYTES, P, item0 + c + 1, (size_t)b * S_ + (c + 1) * 64, h, eh, lane, wid);
    LAS const unsigned char* st = lds + (c & 1) * GS_BYTES;
    const float* DEC = (const float*)(P.ws + WS_DEC) + (size_t)(item0 + c) * 128;
    f32x4 dc[8];
#pragma unroll
    for (int dt = 0; dt < 8; ++dt) dc[dt] = *(const f32x4*)(DEC + 16 * dt + 4 * g);
    u32x4 spk[4];
#pragma unroll
    for (int kk = 0; kk < 4; ++kk) {
      spk[kk][0] = cvtpk(S[2 * kk][0], S[2 * kk][1]); spk[kk][1] = cvtpk(S[2 * kk][2], S[2 * kk][3]);
      spk[kk][2] = cvtpk(S[2 * kk + 1][0], S[2 * kk + 1][1]); spk[kk][3] = cvtpk(S[2 * kk + 1][2], S[2 * kk + 1][3]);
    }
    bf16x8 vf[2];
    {
      LAS const unsigned char* vb = st + GS_V + wid * 2048 + (4 * g + (i >> 2)) * 32 + (i & 3) * 8;
#pragma unroll
      for (int k2 = 0; k2 < 2; ++k2) {
        const s16x4 v0 = vtr(vb + k2 * 1024), v1 = vtr(vb + k2 * 1024 + 512);
        vf[k2] = (bf16x8){v0[0], v0[1], v0[2], v0[3], v1[0], v1[1], v1[2], v1[3]};
      }
    }
#pragma unroll
    for (int it = 0; it < 4; ++it) {
      f32x4 acc = (f32x4){0.f, 0.f, 0.f, 0.f};
      LAS const unsigned char* qrow = st + GS_Q + (16 * it + i) * 256;
#pragma unroll
      for (int kk = 0; kk < 4; ++kk) {
        const bf16x8 a = *(LAS const bf16x8*)(qrow + (((4 * kk + g) ^ i) << 4));
        acc = __builtin_amdgcn_mfma_f32_16x16x32_bf16(a, __builtin_bit_cast(bf16x8, spk[kk]), acc, 0, 0, 0);
      }
      LAS const unsigned char* arow = st + GS_A + (16 * it + i) * 128;
#pragma unroll
      for (int k2 = 0; k2 < 2; ++k2) {
        const bf16x8 a = *(LAS const bf16x8*)(arow + (((4 * k2 + g) ^ ((i >> 1) & 7)) << 4));
        acc = __builtin_amdgcn_mfma_f32_16x16x32_bf16(a, vf[k2], acc, 0, 0, 0);
      }
      bf16_t* op = O + ((size_t)b * S_ + c * 64 + 16 * it + 4 * g) * D_ + h * 256 + eh * 128 + 16 * wid + i;
#pragma unroll
      for (int r = 0; r < 4; ++r) op[(size_t)r * D_] = f2bf(acc[r]);
    }
#pragma unroll
    for (int dt = 0; dt < 8; ++dt) {
      S[dt] = S[dt] * dc[dt];
      LAS const unsigned char* kb = st + GS_K + dt * 2048 + (4 * g + (i >> 2)) * 32 + (i & 3) * 8;
#pragma unroll
      for (int k2 = 0; k2 < 2; ++k2) {
        const s16x4 k0 = vtr(kb + k2 * 1024), k1 = vtr(kb + k2 * 1024 + 512);
        const bf16x8 kf = (bf16x8){k0[0], k0[1], k0[2], k0[3], k1[0], k1[1], k1[2], k1[3]};
        S[dt] = __builtin_amdgcn_mfma_f32_16x16x32_bf16(kf, vf[k2], S[dt], 0, 0, 0);
      }
    }
    __syncthreads();
  }
}

__device__ __forceinline__ void gla_norm_phase(const Params& P) {
  const bf16_t* H1 = (const bf16_t*)(P.ws + WS_H);
  const bf16_t* O = (const bf16_t*)(P.ws + WS_XB);
  bf16_t* MIX = (bf16_t*)(P.ws + WS_MIX);
  const float* gn = P.in[12];
  const int lane = otid() & 63, wid = otid() >> 6;
  for (int it = blockIdx.x * 8 + wid; it < M_ * 4; it += gridDim.x * 8) {
    const int h = it & 3; const size_t row = it >> 2;
    float v[4]; float ss = 0.f;
#pragma unroll
    for (int k = 0; k < 4; ++k) { v[k] = bf2f(O[row * D_ + h * 256 + k * 64 + lane]); ss += v[k] * v[k]; }
    const float r = 1.f / sqrtf(wave_sum(ss) * (1.f / 256.f) + LN_EPS);
#pragma unroll
    for (int k = 0; k < 4; ++k) {
      const int c = h * 256 + k * 64 + lane;
      const float z = bf2f(H1[row * P1 + G_Z + c]);
      MIX[row * D_ + c] = f2bf(v[k] * r * gn[c] * silu_f(z));
    }
  }
}

__global__ void __launch_bounds__(512) fwd_megakernel(Params P) {
  cg::grid_group grid = cg::this_grid();
  extern __shared__ __attribute__((aligned(16))) unsigned char smem[];
  const int tid = otid(), lane = tid & 63, wid = tid >> 6;
  unsigned char* ws = P.ws;
  bf16_t* XB = (bf16_t*)(ws + WS_XB);
  bf16_t* MIX = (bf16_t*)(ws + WS_MIX);
  bf16_t* Hb = (bf16_t*)(ws + WS_H);
  float* Y = (float*)(ws + WS_H);

  {
    const float4* x4 = (const float4*)P.in[0];
    const size_t n4 = (size_t)M_ * D_ / 4;
    for (size_t i = (size_t)blockIdx.x * 512 + tid; i < n4; i += (size_t)gridDim.x * 512) {
      const float4 v = x4[i]; ushort4 o; o.x = f2bf(v.x); o.y = f2bf(v.y); o.z = f2bf(v.z); o.w = f2bf(v.w);
      ((ushort4*)XB)[i] = o;
    }
    constexpr int T0 = (P0 / 64) * 16, T1 = 16 * 16, T2 = (P1 / 64) * 16, T3 = 16 * 16;
    for (int it = blockIdx.x; it < T0 + T1 + T2 + T3; it += gridDim.x) {
      int r = it;
      if (r < T0) { transpose_tile(P.in[1], D_, EVEN_IN, (bf16_t*)(ws + WS_WT0), 0, r, P0 / 64, (float*)smem); continue; } r -= T0;
      if (r < T1) { transpose_tile(P.in[6], D_, D_, (bf16_t*)(ws + WS_WO0), 2, r, 16, (float*)smem); continue; } r -= T1;
      if (r < T2) { transpose_tile(P.in[9], D_, ODD_IN, (bf16_t*)(ws + WS_WT1), 1, r, P1 / 64, (float*)smem); continue; } r -= T2;
      transpose_tile(P.in[13], D_, D_, (bf16_t*)(ws + WS_WO1), 2, r, 16, (float*)smem);
    }
  }
  grid.sync();
  gemm_phase(XB, (const bf16_t*)(ws + WS_WT0), D_, P0, 0, Hb, P0, smem);
  grid.sync();
  {
    const int NC = 2 * B_ * NCMP * 2;
    for (int it = blockIdx.x; it < NC; it += gridDim.x) compress_item(P, it, (float*)smem);
    for (int it = blockIdx.x * 8 + wid; it < B_ * 16 * 8; it += gridDim.x * 8) kmean_item(P, it, lane);
  }
  grid.sync();
  {
    for (int it = blockIdx.x; it < 1024; it += gridDim.x) {
      const int lvl = it >> 4, r = it & 15;
      if (r < 8) nsa_mfma_item(P, r >> 1, r & 1, 63 - lvl, smem);
      else { const int q = (lvl << 3) + (r - 8); moba_mfma_item(P, (q & 31) >> 3, q & 7, 15 - (q >> 5), smem); }
    }
  }
  grid.sync();
  gemm_phase(MIX, (const bf16_t*)(ws + WS_WO0), D_, D_, 1, Y, D_, smem);
  grid.sync();
  ln_phase(P.in[0], Y, P.in[7], P.in[8], P.out, XB);
  grid.sync();
  gemm_phase(XB, (const bf16_t*)(ws + WS_WT1), D_, P1, 0, Hb, P1, smem);
  grid.sync();
  for (int it = blockIdx.x; it < 1024; it += gridDim.x) gla_prep_item(P, it, smem);
  grid.sync();
  for (int ch = blockIdx.x; ch < 32; ch += gridDim.x) gla_chain(P, ch, smem);
  grid.sync();
  gla_norm_phase(P);
  grid.sync();
  gemm_phase(MIX, (const bf16_t*)(ws + WS_WO1), D_, D_, 1, Y, D_, smem);
  grid.sync();
  ln_phase(P.out, Y, P.in[14], P.in[15], P.out, nullptr);
}

extern "C" void kernel_launch(void* const* d_in, const int* in_sizes, int n_in, void* d_out, int out_size,
                              void* d_ws, size_t ws_size, hipStream_t stream) {
  constexpr size_t kDynLds = 116736;
  static_assert(kDynLds >= (size_t)AT_LDS_END && kDynLds >= 2 * (size_t)GS_BYTES, "LDS");
  static int grid_blocks = 0;
  if (!grid_blocks) {
    int dev = 0, cus = 0, per_cu = 0;
    (void)hipGetDevice(&dev);
    (void)hipDeviceGetAttribute(&cus, hipDeviceAttributeMultiprocessorCount, dev);
    (void)hipFuncSetAttribute((const void*)fwd_megakernel, hipFuncAttributeMaxDynamicSharedMemorySize, (int)kDynLds);
    (void)hipOccupancyMaxActiveBlocksPerMultiprocessor(&per_cu, fwd_megakernel, 512, kDynLds);
    if (per_cu < 1) per_cu = 1;
    if (per_cu > 2) per_cu = 2;
    grid_blocks = cus * per_cu;
    if (n_in != 16 || ws_size < WS_END) { fprintf(stderr, "kernel_launch: unexpected n_in %d / ws %zu\n", n_in, ws_size); }
  }
  Params p{};
  for (int i = 0; i < 16; ++i) p.in[i] = (const float*)d_in[i];
  p.out = (float*)d_out; p.ws = (unsigned char*)d_ws;
  void* args[] = {&p};
  hipError_t e = hipLaunchCooperativeKernel((void*)fwd_megakernel, dim3(grid_blocks), dim3(512), args, kDynLds, stream);
  if (e != hipSuccess) fprintf(stderr, "cooperative launch failed: %s (grid %d)\n", hipGetErrorString(e), grid_blocks);
}
```

```cpp
#include <hip/hip_runtime.h>
#include <hip/hip_cooperative_groups.h>
#include <cstdio>
#include <cstdint>
namespace cg = cooperative_groups;

typedef unsigned short bf16_t;
typedef short bf16x8 __attribute__((ext_vector_type(8)));
typedef float f32x4 __attribute__((ext_vector_type(4)));
typedef unsigned u32x4 __attribute__((ext_vector_type(4)));

constexpr int B_ = 4, S_ = 4096, M_ = B_ * S_, D_ = 1024;
constexpr int P0 = 4096;
constexpr int P1 = 3328;
constexpr int EVEN_IN = 3864, ODD_IN = 3088;
constexpr int C_NQ = 0, C_KCMP = 512, C_VCMP = 640, C_KSEL = 768, C_VSEL = 896, C_KWIN = 1024, C_VWIN = 1152;
constexpr int C_NZ = 1280, C_MQ = 1792, C_MK = 2304, C_MV = 2816, C_MZ = 3328, C_NG = 3840;
constexpr int G_Q = 0, G_K = 512, G_V = 1024, G_Z = 2048, G_LR = 3072;
constexpr int NCMP = 255;
constexpr float ALPHA = 1.4142135623730951f;
constexpr float LN_EPS = 1e-5f;

constexpr size_t MiB = 1u << 20;
constexpr size_t WS_WT0 = 1 * MiB;
constexpr size_t WS_WO0 = 9 * MiB;
constexpr size_t WS_WT1 = 11 * MiB;
constexpr size_t WS_WO1 = 18 * MiB;
constexpr size_t WS_XB = 20 * MiB;
constexpr size_t WS_MIX = 52 * MiB;
constexpr size_t WS_H = 84 * MiB;
constexpr size_t WS_G = 212 * MiB;
constexpr size_t WS_KC = 245 * MiB;
constexpr size_t WS_VC = 246 * MiB;
constexpr size_t WS_KM = 247 * MiB;
constexpr size_t WS_END = 256 * MiB;

struct Params { const float* in[16]; float* out; unsigned char* ws; };

__device__ __forceinline__ int otid() { int t = __builtin_amdgcn_workitem_id_x(); asm volatile("" : "+v"(t)); return t; }
__device__ __forceinline__ float bf2f(bf16_t v) { return __uint_as_float(((unsigned)v) << 16); }
__device__ __forceinline__ bf16_t f2bf(float f) { unsigned u = __float_as_uint(f); return (bf16_t)((u + 0x7fffu + ((u >> 16) & 1u)) >> 16); }
template <int M> __device__ __forceinline__ float xsum(float v) {
  if constexpr (M == 32) { auto rr = __builtin_amdgcn_permlane32_swap(__float_as_uint(v), __float_as_uint(v), false, false); return __uint_as_float(rr[0]) + __uint_as_float(rr[1]); }
  else return v + __int_as_float(__builtin_amdgcn_ds_swizzle(__float_as_int(v), (M << 10) | 0x1f));
}
template <int M> __device__ __forceinline__ float xmax(float v) {
  if constexpr (M == 32) { auto rr = __builtin_amdgcn_permlane32_swap(__float_as_uint(v), __float_as_uint(v), false, false); return fmaxf(__uint_as_float(rr[0]), __uint_as_float(rr[1])); }
  else return fmaxf(v, __int_as_float(__builtin_amdgcn_ds_swizzle(__float_as_int(v), (M << 10) | 0x1f)));
}
template <int M> __device__ __forceinline__ unsigned xorr(unsigned v) {
  if constexpr (M == 32) { auto rr = __builtin_amdgcn_permlane32_swap(v, v, false, false); return rr[0] | rr[1]; }
  else return v | (unsigned)__builtin_amdgcn_ds_swizzle((int)v, (M << 10) | 0x1f);
}
__device__ __forceinline__ float wave_sum(float v) { v = xsum<1>(v); v = xsum<2>(v); v = xsum<4>(v); v = xsum<8>(v); v = xsum<16>(v); return xsum<32>(v); }
__device__ __forceinline__ float wave_max(float v) { v = xmax<1>(v); v = xmax<2>(v); v = xmax<4>(v); v = xmax<8>(v); v = xmax<16>(v); return xmax<32>(v); }
__device__ __forceinline__ float silu_f(float z) { return z / (1.f + __expf(-z)); }
__device__ __forceinline__ float sigmoid_f(float z) { return 1.f / (1.f + __expf(-z)); }

__device__ __forceinline__ int colmap0(int c) {
  if (c < 1280) return c;
  if (c < 1792) return 1304 + (c - 1280);
  if (c < 3840) return 1816 + (c - 1792);
  if (c < 3864) return 1280 + (c - 3840);
  return -1;
}
__device__ __forceinline__ int colmap1(int c) {
  if (c < 2048) return c;
  if (c < 3072) return 2064 + (c - 2048);
  if (c < 3088) return 2048 + (c - 3072);
  return -1;
}

__device__ __forceinline__ void transpose_tile(const float* __restrict__ W, int K, int Nsrc, bf16_t* __restrict__ Wt, int which, int tile, int ntn, float* sm) {
  const int tid = otid();
  const int nb = tile % ntn, kb = tile / ntn, n0 = nb * 64, k0 = kb * 64;
#pragma unroll
  for (int i = 0; i < 8; ++i) {
    const int kk = i * 8 + (tid >> 6), nn = tid & 63;
    const int c = n0 + nn;
    const int src = which == 0 ? colmap0(c) : (which == 1 ? colmap1(c) : c);
    sm[kk * 65 + nn] = src >= 0 ? W[(size_t)(k0 + kk) * Nsrc + src] : 0.f;
  }
  __syncthreads();
#pragma unroll
  for (int i = 0; i < 8; ++i) {
    const int nn = i * 8 + (tid >> 6), kk = tid & 63;
    Wt[(size_t)(n0 + nn) * K + k0 + kk] = f2bf(sm[kk * 65 + nn]);
  }
  __syncthreads();
}

__device__ __forceinline__ void gemm_tile(const bf16_t* __restrict__ A, const bf16_t* __restrict__ Bt, int K, int m0, int n0, int mode, void* outp, int ldc, unsigned char* smem) {
  bf16_t* As = (bf16_t*)smem;
  bf16_t* Bs = As + 128 * 72;
  const int tid = otid(), lane = tid & 63, wid = tid >> 6, wm = wid >> 1, wn = wid & 1;
  f32x4 acc[2][4];
#pragma unroll
  for (int i = 0; i < 2; ++i)
#pragma unroll
    for (int j = 0; j < 4; ++j) acc[i][j] = (f32x4){0.f, 0.f, 0.f, 0.f};
  for (int k0 = 0; k0 < K; k0 += 64) {
#pragma unroll
    for (int i = 0; i < 2; ++i) {
      const int idx = tid + i * 512, r = idx >> 3, c = (idx & 7) * 8;
      *(uint4*)(As + r * 72 + c) = *(const uint4*)(A + (size_t)(m0 + r) * K + k0 + c);
      *(uint4*)(Bs + r * 72 + c) = *(const uint4*)(Bt + (size_t)(n0 + r) * K + k0 + c);
    }
    __syncthreads();
#pragma unroll
    for (int kk = 0; kk < 64; kk += 32) {
      bf16x8 a[2], b[4];
#pragma unroll
      for (int i = 0; i < 2; ++i) a[i] = *(const bf16x8*)(As + (wm * 32 + i * 16 + (lane & 15)) * 72 + kk + (lane >> 4) * 8);
#pragma unroll
      for (int j = 0; j < 4; ++j) b[j] = *(const bf16x8*)(Bs + (wn * 64 + j * 16 + (lane & 15)) * 72 + kk + (lane >> 4) * 8);
#pragma unroll
      for (int i = 0; i < 2; ++i)
#pragma unroll
        for (int j = 0; j < 4; ++j) acc[i][j] = __builtin_amdgcn_mfma_f32_16x16x32_bf16(a[i], b[j], acc[i][j], 0, 0, 0);
    }
    __syncthreads();
  }
#pragma unroll
  for (int i = 0; i < 2; ++i)
#pragma unroll
    for (int j = 0; j < 4; ++j)
#pragma unroll
      for (int r = 0; r < 4; ++r) {
        const int row = m0 + wm * 32 + i * 16 + (lane >> 4) * 4 + r, col = n0 + wn * 64 + j * 16 + (lane & 15);
        if (mode == 0) ((bf16_t*)outp)[(size_t)row * ldc + col] = f2bf(acc[i][j][r]);
        else ((float*)outp)[(size_t)row * ldc + col] = acc[i][j][r];
      }
}
__device__ __forceinline__ void gemm_phase(const bf16_t* A, const bf16_t* Bt, int K, int N, int mode, void* outp, int ldc, unsigned char* smem) {
  const int ntn = N / 128, ntm = M_ / 128;
  for (int t = blockIdx.x; t < ntn * ntm; t += gridDim.x) {
    const int tn = t % ntn, tm = t / ntn;
    gemm_tile(A, Bt, K, tm * 128, tn * 128, mode, outp, ldc, smem);
  }
}

namespace pg8 {
#define PG8_LAS __attribute__((address_space(3)))
typedef unsigned short bf16_t;
typedef short bf16x8 __attribute__((ext_vector_type(8)));
typedef float f32x4 __attribute__((ext_vector_type(4)));
typedef unsigned u32x4 __attribute__((ext_vector_type(4)));
constexpr int BM = 256, BK = 64, HALF = 128, HTB = HALF * BK * 2  , STAGE_BYTES = 8 * HTB, NXCD = 8, WGM = 8;

__host__ __device__ __forceinline__ int lds_byte(int r, int c) { const int st = (r >> 4) * 2 + (c >> 5), rr = r & 15, cc = c & 31, ob = rr * 64 + cc * 2; return st * 1024 + (ob ^ (((ob >> 9) & 1) << 5)); }
__host__ __device__ __forceinline__ void stage_rc(int b, int& R, int& C) { const int st = b / 1024, sb = b % 1024, swz = sb ^ (((sb >> 9) & 1) << 5); R = (st >> 1) * 16 + swz / 64; C = (st & 1) * 32 + (swz % 64) / 2; }
__host__ __device__ __forceinline__ int perm32(int rho) { const int n = rho >> 4, i = rho & 15; return 8 * (i >> 2) + 4 * n + (i & 3); }

__device__ __forceinline__ unsigned cvtpk(float lo, float hi) { typedef float f2 __attribute__((ext_vector_type(2))); typedef __bf16 b2 __attribute__((ext_vector_type(2))); f2 v = {lo, hi}; b2 b = __builtin_convertvector(v, b2); return __builtin_bit_cast(unsigned, b); }
struct Unit { int pm, pn; };
struct Gemm { const bf16_t* A; const bf16_t* Bt; int M, N, K; };

struct StaticOrder {
    int nM, nN, nwg, G, c;
    __host__ __device__ void init(int M, int N, int G_, int c_) { nM = M / BM; nN = N / BM; nwg = nM * nN; G = G_; c = c_; }
    __host__ __device__ bool next(int i, Unit& u) const {
        const long L = (long)i * G + c; if (L >= nwg) return false;
        int wgid = (int)L; { const int q = nwg / NXCD, r = nwg % NXCD, xcd = wgid % NXCD, off = wgid / NXCD; wgid = (xcd < r ? xcd * (q + 1) : r * (q + 1) + (xcd - r) * q) + off; }
        const int nig = WGM * nN, gid = wgid / nig, fm = gid * WGM, gsz = (nM - fm) < WGM ? (nM - fm) : WGM;
        u.pm = fm + ((wgid % nig) % gsz); u.pn = (wgid % nig) / gsz; return true;
    }
    __device__ __forceinline__ void a_ready(const Unit&) const {}
    __device__ __forceinline__ void done(const Unit&) const {}
};


struct EpiBf16s {
    static constexpr bool PERM = true, AFTER_DRAIN = false;
    bf16_t* O; int ldc;
    __device__ __forceinline__ void operator()(const f32x4 (&acc)[2][2][4][2], const Unit& u, int wr, int wc, int fr, int fq) const {
        const int row0 = u.pm * BM + wr * 64 + fr, col0 = u.pn * BM + wc * 32 + 8 * fq;
#pragma unroll
        for (int ai = 0; ai < 2; ++ai)
#pragma unroll
            for (int m = 0; m < 4; ++m) { bf16_t* rowp = O + (size_t)(row0 + ai * HALF + m * 16) * ldc + col0;
#pragma unroll
                for (int bj = 0; bj < 2; ++bj) { const f32x4 v0 = acc[ai][bj][m][0], v1 = acc[ai][bj][m][1];
                    u32x4 w; w.x = cvtpk(v0[0], v0[1]); w.y = cvtpk(v0[2], v0[3]); w.z = cvtpk(v1[0], v1[1]); w.w = cvtpk(v1[2], v1[3]);
                    *(u32x4*)(rowp + bj * HALF) = w; } }
    }
};
struct EpiF32 {
    static constexpr bool PERM = false, AFTER_DRAIN = false;
    float* O; int ldc;
    __device__ __forceinline__ void operator()(const f32x4 (&acc)[2][2][4][2], const Unit& u, int wr, int wc, int fr, int fq) const {
        const int col0 = u.pn * BM + wc * 32 + 4 * fq;
#pragma unroll
        for (int ai = 0; ai < 2; ++ai)
#pragma unroll
            for (int m = 0; m < 4; ++m) { float* rowp = O + (size_t)(u.pm * BM + ai * HALF + wr * 64 + m * 16 + fr) * ldc + col0;
#pragma unroll
                for (int bj = 0; bj < 2; ++bj)
#pragma unroll
                    for (int n = 0; n < 2; ++n) *(f32x4*)(rowp + bj * HALF + n * 16) = acc[ai][bj][m][n]; }
    }
};

template <class Epi, class Sched, bool ALIGN_EPI = false, bool SP2 = false>
__device__ __forceinline__ void gemm_phase(PG8_LAS unsigned char* lds, const Gemm g, const Sched& S, const Epi& E) {
    const int tid = otid(), wid = __builtin_amdgcn_readfirstlane(tid >> 6), lane = tid & 63, wr = wid >> 2, wc = wid & 3, fr = lane & 15, fq = lane >> 4;
    const int K = g.K, nt = K / BK;
    unsigned voffA[2], voffB[2];
#pragma unroll
    for (int i = 0; i < 2; ++i) { int R, C; stage_rc(tid * 16 + i * 8192, R, C); const int Rb = Epi::PERM ? ((R & ~31) + perm32(R & 31)) : R;
        voffA[i] = (unsigned)(R * K + C) * 2u; voffB[i] = (unsigned)(Rb * K + C) * 2u; }
    const size_t kstep = (size_t)(BK * 2);
    const size_t hstep = (size_t)HALF * K * 2;
    const size_t tstep = 2 * hstep;
    const unsigned ldsw = (unsigned)wid * 1024u;
    const int aoff = lds_byte(wr * 64 + fr, fq * 8), boff = lds_byte(wc * 32 + fr, fq * 8);
#define PG8_SA(b, h) (((b) * 2 + (h)) * HTB)
#define PG8_SB(b, h) ((4 + (b) * 2 + (h)) * HTB)
#define PG8_STAGE(bufoff, gbase, voff) do { _Pragma("unroll") for (int _i = 0; _i < 2; ++_i) \
        __builtin_amdgcn_global_load_lds((const unsigned*)((const char*)(gbase) + (voff)[_i]), (PG8_LAS unsigned*)(lds + (bufoff) + ldsw + _i * 8192), 16, 0, 0); } while (0)
#define PG8_LDA(dst, b, h) do { _Pragma("unroll") for (int m = 0; m < 4; ++m) _Pragma("unroll") for (int k = 0; k < 2; ++k) dst[m][k] = *(const PG8_LAS bf16x8*)(lds + PG8_SA(b, h) + aoff + m * 2048 + k * 1024); } while (0)
#define PG8_LDB(dst, b, h) do { _Pragma("unroll") for (int n = 0; n < 2; ++n) _Pragma("unroll") for (int k = 0; k < 2; ++k) dst[n][k] = *(const PG8_LAS bf16x8*)(lds + PG8_SB(b, h) + boff + n * 2048 + k * 1024); } while (0)
#define PG8_MMA(ai, bj, At, Bt) do { __builtin_amdgcn_s_setprio(1); _Pragma("unroll") for (int m = 0; m < 4; ++m) _Pragma("unroll") for (int n = 0; n < 2; ++n) _Pragma("unroll") for (int k = 0; k < 2; ++k) \
        acc[ai][bj][m][n] = __builtin_amdgcn_mfma_f32_16x16x32_bf16(Bt[n][k], At[m][k], acc[ai][bj][m][n], 0, 0, 0); __builtin_amdgcn_s_setprio(0); } while (0)
#define PG8_WAIT_V(n) asm volatile("s_waitcnt vmcnt(" #n ")" ::: "memory")
#define PG8_WAIT_L(n) asm volatile("s_waitcnt lgkmcnt(" #n ")" ::: "memory")
#define PG8_BAR __builtin_amdgcn_s_barrier()
#define PG8_SCHED __builtin_amdgcn_sched_barrier(0)
    Unit cur, nxt; int ui = 0;
    if (!S.next(0, cur)) return;
    f32x4 acc[2][2][4][2];
#pragma unroll
    for (int a = 0; a < 2; ++a)
#pragma unroll
        for (int b = 0; b < 2; ++b)
#pragma unroll
            for (int m = 0; m < 4; ++m)
#pragma unroll
                for (int n = 0; n < 2; ++n) acc[a][b][m][n] = (f32x4){0.f, 0.f, 0.f, 0.f};
    bf16x8 At[4][2], B0[2][2], B1[2][2];
    const char* cA = (const char*)g.A + (size_t)cur.pm * tstep; const char* cB = (const char*)g.Bt + (size_t)cur.pn * tstep;
    S.a_ready(cur);
    if constexpr (SP2) {
        PG8_STAGE(PG8_SB(0, 0), cB, voffB); PG8_STAGE(PG8_SB(0, 1), cB + hstep, voffB); PG8_STAGE(PG8_SA(0, 0), cA, voffA); PG8_STAGE(PG8_SA(0, 1), cA + hstep, voffA);
        if (wr == 1) PG8_BAR;
        PG8_WAIT_V(2); PG8_BAR;
        PG8_STAGE(PG8_SB(1, 0), cB + kstep, voffB); PG8_STAGE(PG8_SA(1, 0), cA + kstep, voffA); PG8_STAGE(PG8_SB(1, 1), cB + hstep + kstep, voffB);
        PG8_WAIT_V(6); PG8_BAR;
    } else {
        PG8_STAGE(PG8_SB(0, 0), cB, voffB); PG8_STAGE(PG8_SA(0, 0), cA, voffA); PG8_STAGE(PG8_SB(0, 1), cB + hstep, voffB); PG8_STAGE(PG8_SA(0, 1), cA + hstep, voffA);
        if (wr == 1) PG8_BAR;
        PG8_WAIT_V(4); PG8_BAR;
        PG8_STAGE(PG8_SB(1, 0), cB + kstep, voffB); PG8_STAGE(PG8_SA(1, 0), cA + kstep, voffA); PG8_STAGE(PG8_SB(1, 1), cB + hstep + kstep, voffB);
        PG8_WAIT_V(6); PG8_BAR;
    }
    for (;;) {
        const bool has_next = S.next(ui + 1, nxt);
        const char* nA = has_next ? (const char*)g.A + (size_t)nxt.pm * tstep : cA; const char* nB = has_next ? (const char*)g.Bt + (size_t)nxt.pn * tstep : cB;
        for (int t = 0; t < nt; t += 2) {
            const bool last = (t == nt - 2);
            const char* a1 = cA + (size_t)(t + 1) * kstep;
            const char* a2 = last ? nA : cA + (size_t)(t + 2) * kstep; const char* b2 = last ? nB : cB + (size_t)(t + 2) * kstep;
            const char* a3 = a2 + kstep; const char* b3 = b2 + kstep;
            if (last && has_next) S.a_ready(nxt);
            if constexpr (SP2) {
            PG8_LDB(B0, 0, 0); PG8_LDB(B1, 0, 1); PG8_SCHED; PG8_LDA(At, 0, 0); PG8_STAGE(PG8_SA(1, 1), a1 + hstep, voffA);
            PG8_WAIT_V(8); PG8_WAIT_L(0); PG8_BAR; PG8_MMA(0, 0, At, B0); PG8_MMA(0, 1, At, B1); PG8_BAR; PG8_SCHED;
            PG8_LDA(At, 0, 1); PG8_STAGE(PG8_SB(0, 0), b2, voffB); PG8_STAGE(PG8_SB(0, 1), b2 + hstep, voffB); PG8_STAGE(PG8_SA(0, 0), a2, voffA);
            PG8_WAIT_V(8); PG8_WAIT_L(0); PG8_BAR; PG8_MMA(1, 0, At, B0); PG8_MMA(1, 1, At, B1); PG8_BAR; PG8_SCHED;
            PG8_LDB(B0, 1, 0); PG8_LDB(B1, 1, 1); PG8_SCHED; PG8_LDA(At, 1, 0); PG8_STAGE(PG8_SA(0, 1), a2 + hstep, voffA);
            PG8_WAIT_V(8); PG8_WAIT_L(0); PG8_BAR; PG8_MMA(0, 0, At, B0); PG8_MMA(0, 1, At, B1); PG8_BAR; PG8_SCHED;
            PG8_LDA(At, 1, 1); PG8_STAGE(PG8_SB(1, 0), b3, voffB); PG8_STAGE(PG8_SB(1, 1), b3 + hstep, voffB); PG8_STAGE(PG8_SA(1, 0), a3, voffA);
            PG8_WAIT_V(8); PG8_WAIT_L(0); PG8_BAR; PG8_MMA(1, 0, At, B0); PG8_MMA(1, 1, At, B1); PG8_BAR; PG8_SCHED;
            } else {
            PG8_LDB(B0, 0, 0); PG8_SCHED; PG8_LDA(At, 0, 0); PG8_STAGE(PG8_SA(1, 1), a1 + hstep, voffA);
            PG8_WAIT_L(8); PG8_BAR; PG8_WAIT_L(0); PG8_MMA(0, 0, At, B0); PG8_BAR; PG8_SCHED;
            PG8_LDB(B1, 0, 1); PG8_STAGE(PG8_SB(0, 0), b2, voffB);
            PG8_BAR; PG8_WAIT_L(0); PG8_MMA(0, 1, At, B1); PG8_BAR;
            PG8_LDA(At, 0, 1); PG8_STAGE(PG8_SA(0, 0), a2, voffA);
            PG8_BAR; PG8_WAIT_L(0); PG8_MMA(1, 0, At, B0); PG8_BAR; PG8_SCHED;
            PG8_STAGE(PG8_SB(0, 1), b2 + hstep, voffB);
            PG8_WAIT_V(6); PG8_BAR; PG8_MMA(1, 1, At, B1); PG8_BAR;
            PG8_LDB(B0, 1, 0); PG8_SCHED; PG8_LDA(At, 1, 0); PG8_STAGE(PG8_SA(0, 1), a2 + hstep, voffA);
            PG8_WAIT_L(8); PG8_BAR; PG8_WAIT_L(0); PG8_MMA(0, 0, At, B0); PG8_BAR; PG8_SCHED;
            PG8_LDB(B1, 1, 1); PG8_STAGE(PG8_SB(1, 0), b3, voffB);
            PG8_BAR; PG8_WAIT_L(0); PG8_MMA(0, 1, At, B1); PG8_BAR;
            PG8_LDA(At, 1, 1); PG8_STAGE(PG8_SA(1, 0), a3, voffA);
            PG8_BAR; PG8_WAIT_L(0); PG8_MMA(1, 0, At, B0); PG8_BAR; PG8_SCHED;
            PG8_STAGE(PG8_SB(1, 1), b3 + hstep, voffB);
            PG8_WAIT_V(6); PG8_BAR; PG8_MMA(1, 1, At, B1); PG8_BAR;
            }
        }
        if constexpr (ALIGN_EPI) { if (wr == 0) PG8_BAR; }
        if constexpr (!Epi::AFTER_DRAIN) { E(acc, cur, wr, wc, fr, fq); S.done(cur); }
        if (!has_next) break;
#pragma unroll
        for (int a = 0; a < 2; ++a)
#pragma unroll
            for (int b = 0; b < 2; ++b)
#pragma unroll
                for (int m = 0; m < 4; ++m)
#pragma unroll
                    for (int n = 0; n < 2; ++n) acc[a][b][m][n] = (f32x4){0.f, 0.f, 0.f, 0.f};
        cur = nxt; cA = nA; cB = nB; ++ui;
        if constexpr (ALIGN_EPI) { if (wr == 1) PG8_BAR; }
    }
    PG8_WAIT_V(0);
    if constexpr (!ALIGN_EPI) { if (wr == 0) PG8_BAR; }
    PG8_BAR;
    if constexpr (Epi::AFTER_DRAIN) { E.fused(acc, cur, wr, wc, fr, fq, lds, wid, lane); S.done(cur); }
#undef PG8_SA
#undef PG8_SB
#undef PG8_STAGE
#undef PG8_LDA
#undef PG8_LDB
#undef PG8_MMA
#undef PG8_WAIT_V
#undef PG8_WAIT_L
#undef PG8_BAR
#undef PG8_SCHED
}
}

__device__ __forceinline__ void ln_phase(const float* xin, const float* Y, const float* g, const float* bb, float* out, bf16_t* outb) {
  const int lane = otid() & 63, wid = otid() >> 6;
  for (int row = blockIdx.x * 8 + wid; row < M_; row += gridDim.x * 8) {
    const float4* xr = (const float4*)(xin + (size_t)row * D_);
    const float4* yr = (const float4*)(Y + (size_t)row * D_);
    float4 v[4]; float s = 0.f;
#pragma unroll
    for (int j = 0; j < 4; ++j) {
      const float4 a = xr[j * 64 + lane], y = yr[j * 64 + lane];
      v[j].x = ALPHA * a.x + y.x; v[j].y = ALPHA * a.y + y.y; v[j].z = ALPHA * a.z + y.z; v[j].w = ALPHA * a.w + y.w;
      s += (v[j].x + v[j].y) + (v[j].z + v[j].w);
    }
    const float mean = wave_sum(s) * (1.f / D_);
    float q = 0.f;
#pragma unroll
    for (int j = 0; j < 4; ++j) {
      v[j].x -= mean; v[j].y -= mean; v[j].z -= mean; v[j].w -= mean;
      q += (v[j].x * v[j].x + v[j].y * v[j].y) + (v[j].z * v[j].z + v[j].w * v[j].w);
    }
    const float rstd = 1.f / sqrtf(wave_sum(q) * (1.f / D_) + LN_EPS);
#pragma unroll
    for (int j = 0; j < 4; ++j) {
      const float4 gg = ((const float4*)g)[j * 64 + lane], bv = ((const float4*)bb)[j * 64 + lane];
      float4 o;
      o.x = v[j].x * rstd * gg.x + bv.x; o.y = v[j].y * rstd * gg.y + bv.y; o.z = v[j].z * rstd * gg.z + bv.z; o.w = v[j].w * rstd * gg.w + bv.w;
      ((float4*)(out + (size_t)row * D_))[j * 64 + lane] = o;
      if (outb) {
        ushort4 ob; ob.x = f2bf(o.x); ob.y = f2bf(o.y); ob.z = f2bf(o.z); ob.w = f2bf(o.w);
        ((ushort4*)(outb + (size_t)row * D_))[j * 64 + lane] = ob;
      }
    }
  }
}

__device__ __forceinline__ void compress_item(const Params& P, int item, float* sm) {
  const bf16_t* H0 = (const bf16_t*)(P.ws + WS_H);
  const int tid = otid();
  const int g = item & 1; int r = item >> 1; const int n = r % NCMP; r /= NCMP; const int b = r & 3; const int i = r >> 2;
  const float* pos = P.in[2] + i * 2048;
  const float* w1 = P.in[3] + (size_t)i * 2048 * 128;
  const float* b1 = P.in[4] + i * 128;
  const float* w2 = P.in[5] + (size_t)i * 128 * 64;
  float* blk = sm;
  float* part = sm + 2048;
  float* hid = sm + 2048 + 512;
  const int col = (i == 0 ? C_KCMP : C_VCMP) + g * 64;
#pragma unroll
  for (int k = 0; k < 4; ++k) {
    const int f = tid + k * 512, l = f >> 6, d = f & 63;
    blk[f] = bf2f(H0[((size_t)b * S_ + 16 * n + l) * P0 + col + d]) + pos[f];
  }
  __syncthreads();
  const int hh = tid & 127, pt = tid >> 7;
  float acc = 0.f;
  for (int f = pt * 512; f < pt * 512 + 512; ++f) acc += blk[f] * w1[(size_t)f * 128 + hh];
  part[pt * 128 + hh] = acc;
  __syncthreads();
  if (tid < 128) {
    const float a = part[tid] + part[128 + tid] + part[256 + tid] + part[384 + tid] + b1[tid];
    hid[tid] = silu_f(a);
  }
  __syncthreads();
  if (tid < 64) {
    float o = 0.f;
    for (int k = 0; k < 128; ++k) o += hid[k] * w2[k * 64 + tid];
    float* dst = (float*)(P.ws + (i == 0 ? WS_KC : WS_VC));
    dst[(((size_t)b * NCMP + n) * 2 + g) * 64 + tid] = o;
    bf16_t* dstb = (bf16_t*)(P.ws + (i == 0 ? (size_t)(248 * MiB) : (size_t)(249 * MiB)));
    dstb[(((size_t)b * 2 + g) * 256 + n) * 64 + tid] = f2bf(o);
    if (n == 0) dstb[(((size_t)b * 2 + g) * 256 + 255) * 64 + tid] = 0;
  }
  __syncthreads();
}
__device__ __forceinline__ void kmean_item(const Params& P, int item, int lane) {
  const bf16_t* H0 = (const bf16_t*)(P.ws + WS_H);
  const int h = item & 7, n = (item >> 3) & 15, b = item >> 7;
  float s = 0.f;
  for (int k = 0; k < 256; ++k) s += bf2f(H0[((size_t)b * S_ + n * 256 + k) * P0 + C_MK + h * 64 + lane]);
  ((float*)(P.ws + WS_KM))[(((size_t)b * 16 + n) * 8 + h) * 64 + lane] = s * (1.f / 256.f);
}


constexpr size_t WS_W1T = 250 * MiB;
constexpr size_t WS_W2T = 251 * MiB;
constexpr size_t WS_C1P = 252 * MiB;
__device__ __forceinline__ void compress_mfma_tile(const Params& P, int tile, unsigned char* smem_g) {
  const bf16_t* __restrict__ H0 = (const bf16_t*)(P.ws + WS_H);
  const int tid = otid(), lane = tid & 63, wid = __builtin_amdgcn_readfirstlane(tid >> 6), g = lane >> 4, ii = lane & 15;
  const int i = tile >> 7, R0 = (tile & 127) * 16;
  bf16_t* hs = (bf16_t*)smem_g;
  {
    const int R = min(R0 + ii, 2039), b = R / 510, rem = R - b * 510, n = rem >> 1, grp = rem & 1;
    const bf16_t* abase = H0 + ((size_t)b * S_ + 16 * n) * P0 + (i == 0 ? C_KCMP : C_VCMP) + grp * 64 + 8 * g;
    const bf16_t* bbase = (const bf16_t*)(P.ws + WS_W1T) + (size_t)(i * 128 + 16 * wid + ii) * 2048 + 8 * g;
    f32x4 acc = (f32x4){0.f, 0.f, 0.f, 0.f};
#pragma unroll 8
    for (int ks = 0; ks < 64; ++ks) {
      const bf16x8 a = *(const bf16x8*)(abase + (size_t)(ks >> 1) * P0 + (ks & 1) * 32);
      const bf16x8 bq = *(const bf16x8*)(bbase + ks * 32);
      acc = __builtin_amdgcn_mfma_f32_16x16x32_bf16(a, bq, acc, 0, 0, 0);
    }
    const int col = 16 * wid + ii;
    float bias = P.in[4][i * 128 + col];
    const float* c1p = (const float*)(P.ws + WS_C1P) + i * 32 * 128 + col;
#pragma unroll 8
    for (int q = 0; q < 32; ++q) bias += c1p[q * 128];
#pragma unroll
    for (int r = 0; r < 4; ++r) hs[(4 * g + r) * 136 + col] = f2bf(silu_f(acc[r] + bias));
  }
  __syncthreads();
  if (wid < 4) {
    const bf16_t* b2 = (const bf16_t*)(P.ws + WS_W2T) + (size_t)(i * 64 + 16 * wid + ii) * 128 + 8 * g;
    f32x4 acc = (f32x4){0.f, 0.f, 0.f, 0.f};
#pragma unroll
    for (int k2 = 0; k2 < 4; ++k2) {
      const bf16x8 a = *(const bf16x8*)(hs + ii * 136 + 32 * k2 + 8 * g);
      const bf16x8 bq = *(const bf16x8*)(b2 + 32 * k2);
      acc = __builtin_amdgcn_mfma_f32_16x16x32_bf16(a, bq, acc, 0, 0, 0);
    }
    bf16_t* dst = (bf16_t*)(P.ws + (i == 0 ? (size_t)(248 * MiB) : (size_t)(249 * MiB)));
#pragma unroll
    for (int r = 0; r < 4; ++r) {
      const int R = R0 + 4 * g + r;
      if (R < 2040) { const int b = R / 510, rem = R - b * 510, n = rem >> 1, grp = rem & 1;
        dst[(((size_t)b * 2 + grp) * 256 + n) * 64 + 16 * wid + ii] = f2bf(acc[r]); }
    }
  }
  __syncthreads();
}
__device__ __forceinline__ void kmean_item2(const Params& P, int item) {
  const bf16_t* __restrict__ H0 = (const bf16_t*)(P.ws + WS_H);
  const int tid = otid();
  const bf16_t* src = H0 + ((size_t)(item >> 4) * S_ + (item & 15) * 256) * P0 + C_MK + tid;
  float s0 = 0.f, s1 = 0.f, s2 = 0.f, s3 = 0.f;
#pragma unroll 4
  for (int r = 0; r < 256; r += 4) {
    s0 += bf2f(src[(size_t)r * P0]); s1 += bf2f(src[(size_t)(r + 1) * P0]); s2 += bf2f(src[(size_t)(r + 2) * P0]); s3 += bf2f(src[(size_t)(r + 3) * P0]);
  }
  ((float*)(P.ws + WS_KM))[(size_t)item * 512 + tid] = ((s0 + s1) + (s2 + s3)) * (1.f / 256.f);
}

template <int NH>
__device__ __forceinline__ void attend_block(const bf16_t* __restrict__ Kp, const bf16_t* __restrict__ Vp, size_t rowbase, int kp0, int t, int kmin,
                                             const float* qs, float* pb, const float* slope, float* m, float* l, float* o, int lane) {
  asm volatile("" ::: "memory");
  const int kp = kp0 + lane;
  const bool valid = (kp <= t) && (kp >= kmin);
  const uint4* kr = (const uint4*)(Kp + (rowbase + kp) * P0);
  float dot[NH];
#pragma unroll
  for (int j = 0; j < NH; ++j) dot[j] = 0.f;
#pragma unroll 1
  for (int c = 0; c < 8; ++c) {
    asm volatile("" ::: "memory");
    const uint4 u = kr[c];
    float kv[8];
    kv[0] = __uint_as_float(u.x << 16); kv[1] = __uint_as_float(u.x & 0xffff0000u);
    kv[2] = __uint_as_float(u.y << 16); kv[3] = __uint_as_float(u.y & 0xffff0000u);
    kv[4] = __uint_as_float(u.z << 16); kv[5] = __uint_as_float(u.z & 0xffff0000u);
    kv[6] = __uint_as_float(u.w << 16); kv[7] = __uint_as_float(u.w & 0xffff0000u);
#pragma unroll
    for (int j = 0; j < NH; ++j) {
      const float4 q0 = *(const float4*)(qs + j * 64 + c * 8), q1 = *(const float4*)(qs + j * 64 + c * 8 + 4);
      dot[j] += kv[0] * q0.x + kv[1] * q0.y + kv[2] * q0.z + kv[3] * q0.w + kv[4] * q1.x + kv[5] * q1.y + kv[6] * q1.z + kv[7] * q1.w;
    }
  }
#pragma unroll
  for (int j = 0; j < NH; ++j) {
    const float s = valid ? 0.125f * dot[j] - slope[j] * (float)(t - kp) : -1e30f;
    const float mn = fmaxf(m[j], wave_max(s));
    const float al = __expf(m[j] - mn);
    const float p = valid ? __expf(s - mn) : 0.f;
    l[j] = l[j] * al + wave_sum(p);
    o[j] *= al; m[j] = mn;
    pb[j * 64 + lane] = p;
  }
  __builtin_amdgcn_wave_barrier();
  const bf16_t* vr = Vp + (rowbase + kp0) * P0 + lane;
#pragma unroll 8
  for (int k = 0; k < 64; ++k) {
    const float v = bf2f(vr[(size_t)k * P0]);
#pragma unroll
    for (int j = 0; j < NH; ++j) o[j] += pb[j * 64 + k] * v;
  }
  __builtin_amdgcn_wave_barrier();
}

__device__ __forceinline__ void nsa_item(const Params& P, int b, int g, int t, float* wsm, int lane) {
  const bf16_t* H0 = (const bf16_t*)(P.ws + WS_H);
  const float* KC = (const float*)(P.ws + WS_KC);
  const float* VC = (const float*)(P.ws + WS_VC);
  bf16_t* MIX = (bf16_t*)(P.ws + WS_MIX);
  float* qs = wsm;
  float* pc = wsm + 256;
  float* pb = wsm + 1280;
  const size_t row = (size_t)b * S_ + t;
  const bf16_t* hrow = H0 + row * P0;
  float slope[4];
#pragma unroll
  for (int j = 0; j < 4; ++j) { qs[j * 64 + lane] = bf2f(hrow[C_NQ + (g * 4 + j) * 64 + lane]); slope[j] = exp2f(-(float)(g * 4 + j + 1)); }
  __builtin_amdgcn_wave_barrier();
  const int nv = t >= 31 ? (t - 31) / 16 + 1 : 0;
#pragma unroll 1
  for (int c = 0; c < 4; ++c) {
    asm volatile("" ::: "memory");
    const int n = c * 64 + lane;
    float dot[4] = {0.f, 0.f, 0.f, 0.f};
    if (n < nv) {
      const float4* kr = (const float4*)(KC + (((size_t)b * NCMP + n) * 2 + g) * 64);
#pragma unroll 4
      for (int d4 = 0; d4 < 16; ++d4) {
        const float4 kv = kr[d4];
#pragma unroll
        for (int j = 0; j < 4; ++j) {
          const float4 q = *(const float4*)(qs + j * 64 + d4 * 4);
          dot[j] += kv.x * q.x + kv.y * q.y + kv.z * q.z + kv.w * q.w;
        }
      }
    }
#pragma unroll
    for (int j = 0; j < 4; ++j) pc[j * 256 + n] = (n < nv) ? 0.125f * dot[j] - slope[j] * (float)(t - (16 * n + 31)) : -1e30f;
  }
  __builtin_amdgcn_wave_barrier();
#pragma unroll
  for (int j = 0; j < 4; ++j) {
    float sc[4];
#pragma unroll
    for (int c = 0; c < 4; ++c) sc[c] = pc[j * 256 + c * 64 + lane];
    float mx = fmaxf(fmaxf(sc[0], sc[1]), fmaxf(sc[2], sc[3]));
    mx = wave_max(mx);
    float sum = 0.f;
#pragma unroll
    for (int c = 0; c < 4; ++c) { const int n = c * 64 + lane; const float p = (n < nv) ? __expf(sc[c] - mx) : 0.f; sc[c] = p; sum += p; }
    sum = wave_sum(sum);
    const float inv = nv > 0 ? 1.f / sum : 0.f;
#pragma unroll
    for (int c = 0; c < 4; ++c) pc[j * 256 + c * 64 + lane] = sc[c] * inv;
  }
  __builtin_amdgcn_wave_barrier();
  float ocmp[4] = {0.f, 0.f, 0.f, 0.f};
  for (int n = 0; n < nv; ++n) {
    const float v = VC[(((size_t)b * NCMP + n) * 2 + g) * 64 + lane];
#pragma unroll
    for (int j = 0; j < 4; ++j) ocmp[j] += pc[j * 256 + n] * v;
  }
  float imp = 0.f;
  {
    const int lo = max(0, 4 * lane - 1), hi = min(NCMP - 1, 4 * lane + 3);
    for (int n = lo; n <= hi; ++n) imp += (pc[n] + pc[256 + n]) + (pc[512 + n] + pc[768 + n]);
  }
  const int cur = t >> 6;
  const bool bvalid = lane <= cur;
  const bool forced = (lane == 0) || (lane == cur) || (lane == cur - 1);
  const float key = bvalid ? (forced ? 1e9f : imp) : -1e30f;
  int rank = 0;
  for (int s2 = 0; s2 < 64; ++s2) {
    const float ks = __shfl(key, s2);
    rank += (ks > key || (ks == key && s2 < lane)) ? 1 : 0;
  }
  const unsigned long long selmask = __ballot(bvalid && rank < 16);
  float m[4], l[4], osel[4], owin[4];
#pragma unroll
  for (int j = 0; j < 4; ++j) { m[j] = -1e30f; l[j] = 0.f; osel[j] = 0.f; }
  {
    unsigned long long mk = selmask;
    while (mk) {
      const int blk = __builtin_ctzll(mk); mk &= mk - 1;
      attend_block<4>(H0 + C_KSEL + g * 64, H0 + C_VSEL + g * 64, (size_t)b * S_, blk * 64, t, 0, qs, pb, slope, m, l, osel, lane);
    }
  }
#pragma unroll
  for (int j = 0; j < 4; ++j) { osel[j] /= l[j]; m[j] = -1e30f; l[j] = 0.f; owin[j] = 0.f; }
  {
    const int kmin = t - 511;
    const int b0 = (kmin > 0 ? kmin : 0) >> 6;
    for (int blk = b0; blk <= cur; ++blk)
      attend_block<4>(H0 + C_KWIN + g * 64, H0 + C_VWIN + g * 64, (size_t)b * S_, blk * 64, t, kmin, qs, pb, slope, m, l, owin, lane);
  }
#pragma unroll
  for (int j = 0; j < 4; ++j) {
    const int h = g * 4 + j;
    const float g0 = sigmoid_f(bf2f(hrow[C_NG + h * 3 + 0])), g1 = sigmoid_f(bf2f(hrow[C_NG + h * 3 + 1])), g2 = sigmoid_f(bf2f(hrow[C_NG + h * 3 + 2]));
    const float o = g0 * ocmp[j] + g1 * osel[j] + g2 * (owin[j] / l[j]);
    const float z = bf2f(hrow[C_NZ + h * 64 + lane]);
    MIX[row * D_ + h * 64 + lane] = f2bf(o * silu_f(z));
  }
}

__device__ __forceinline__ void moba_item(const Params& P, int b, int h, int t, float* wsm, int lane) {
  const bf16_t* H0 = (const bf16_t*)(P.ws + WS_H);
  const float* KM = (const float*)(P.ws + WS_KM);
  bf16_t* MIX = (bf16_t*)(P.ws + WS_MIX);
  float* qs = wsm;
  float* pb = wsm + 1280;
  const size_t row = (size_t)b * S_ + t;
  const bf16_t* hrow = H0 + row * P0;
  qs[lane] = bf2f(hrow[C_MQ + h * 64 + lane]);
  __builtin_amdgcn_wave_barrier();
  float slope[1] = {exp2f(-(float)(h + 1))};
  const int cur = t >> 8;
  float gate = -1e30f;
  if (lane < cur) {
    const float4* kr = (const float4*)(KM + (((size_t)b * 16 + lane) * 8 + h) * 64);
    float d = 0.f;
#pragma unroll 4
    for (int d4 = 0; d4 < 16; ++d4) { const float4 kv = kr[d4]; const float4 q = *(const float4*)(qs + d4 * 4); d += kv.x * q.x + kv.y * q.y + kv.z * q.z + kv.w * q.w; }
    gate = d;
  }
  int rank = 0;
  for (int s2 = 0; s2 < 16; ++s2) {
    const float ks = __shfl(gate, s2);
    rank += (ks > gate || (ks == gate && s2 < lane)) ? 1 : 0;
  }
  unsigned long long mk = __ballot(lane < cur && rank < 3) | (1ull << cur);
  float m[1] = {-1e30f}, l[1] = {0.f}, o[1] = {0.f};
  while (mk) {
    const int blk = __builtin_ctzll(mk); mk &= mk - 1;
    for (int c = 0; c < 4; ++c) {
      const int kp0 = blk * 256 + c * 64;
      if (kp0 > t) break;
      attend_block<1>(H0 + C_MK + h * 64, H0 + C_MV + h * 64, (size_t)b * S_, kp0, t, 0, qs, pb, slope, m, l, o, lane);
    }
  }
  const float z = bf2f(hrow[C_MZ + h * 64 + lane]);
  MIX[row * D_ + 512 + h * 64 + lane] = f2bf((o[0] / l[0]) * silu_f(z));
}


#define LAS __attribute__((address_space(3)))
typedef short s16x4 __attribute__((ext_vector_type(4)));
typedef float f32x2_t __attribute__((ext_vector_type(2)));
typedef __bf16 bf16x2_t __attribute__((ext_vector_type(2)));
__device__ __forceinline__ unsigned cvtpk(float lo, float hi) { f32x2_t v = {lo, hi}; bf16x2_t b = __builtin_convertvector(v, bf16x2_t); return __builtin_bit_cast(unsigned, b); }
__device__ __forceinline__ s16x4 vtr(LAS const unsigned char* p) { return __builtin_bit_cast(s16x4, __builtin_amdgcn_ds_read_tr16_b64_v4i16((LAS s16x4*)p)); }
constexpr int KT_BYTES = 8192;
constexpr int VT_DT = 2080;
constexpr int VT_BYTES = 4 * VT_DT;
constexpr int AT_BUF = KT_BYTES + VT_BYTES;
constexpr int AT_MISC = 2 * AT_BUF;
constexpr int AT_STASH = AT_MISC + 256;
constexpr int AT_LDS_END = AT_STASH + 8 * 512 * 16;
constexpr float C1 = 0.125f * 1.4426950408889634f;
constexpr float LOG2E = 1.4426950408889634f;

__device__ __forceinline__ void at_stage_write(LAS unsigned char* buf, const u32x4& kreg, const u32x4& vreg, int tid) {
  const int key = tid >> 3, c = tid & 7;
  *(LAS u32x4*)(buf + key * 128 + ((c ^ ((key >> 1) & 7)) << 4)) = kreg;
  *(LAS u32x4*)(buf + KT_BYTES + (c >> 1) * VT_DT + key * 32 + (c & 1) * 16) = vreg;
}
__device__ __forceinline__ void at_stage_dma(LAS unsigned char* buf, const bf16_t* Kt, const bf16_t* Vt, unsigned pitch, int lane, int wid) {
  const int kkey = 8 * wid + (lane >> 3), c = (lane & 7) ^ ((kkey >> 1) & 7);
  __builtin_amdgcn_global_load_lds((const unsigned*)(Kt + (unsigned)kkey * pitch + c * 8), (LAS unsigned*)(buf + wid * 1024), 16, 0, 0);
  const int vkey = 32 * (wid & 1) + (lane >> 1), dt = wid >> 1;
  __builtin_amdgcn_global_load_lds((const unsigned*)(Vt + (unsigned)vkey * pitch + dt * 16 + (lane & 1) * 8), (LAS unsigned*)(buf + KT_BYTES + dt * VT_DT + (wid & 1) * 1024), 16, 0, 0);
}
template <int NRG, bool EDGE, int IMPT  >
__device__ __forceinline__ void at_tile_x(LAS const unsigned char* buf, const bf16x8 (&qf)[NRG][2], f32x4 (&O)[NRG][4], float (&m)[NRG], float (&l)[NRG],
                                        const float (&base)[NRG], const float (&soff)[NRG], const int (&lim)[NRG], const int (&lo)[NRG], int lane,
                                        float (&imp)[NRG][16], float (&carry)[NRG]) {
  const int g = lane >> 4, i = lane & 15;
  const int swz = (i >> 1) & 7;
  LAS const unsigned char* kb = buf + i * 128;
  const int kc0 = ((g ^ swz) << 4), kc1 = (((4 + g) ^ swz) << 4);
  f32x4 S[NRG][4];
#pragma unroll
  for (int mt = 0; mt < 4; ++mt) {
    const bf16x8 k0f = *(LAS const bf16x8*)(kb + mt * 2048 + kc0);
    const bf16x8 k1f = *(LAS const bf16x8*)(kb + mt * 2048 + kc1);
#pragma unroll
    for (int rg = 0; rg < NRG; ++rg) {
      f32x4 a = __builtin_amdgcn_mfma_f32_16x16x32_bf16(k0f, qf[rg][0], (f32x4){0.f, 0.f, 0.f, 0.f}, 0, 0, 0);
      S[rg][mt] = __builtin_amdgcn_mfma_f32_16x16x32_bf16(k1f, qf[rg][1], a, 0, 0, 0);
    }
  }
  __builtin_amdgcn_sched_barrier(0);
  unsigned pk[NRG][2][4];
#pragma unroll
  for (int rg = 0; rg < NRG; ++rg) {
    float mx = -INFINITY;
#pragma unroll
    for (int mt = 0; mt < 4; ++mt)
#pragma unroll
      for (int r = 0; r < 4; ++r) {
        float sv = __builtin_fmaf(S[rg][mt][r], C1, base[rg] + soff[rg] * (float)(16 * mt + r));
        if (EDGE) { const int c = 16 * mt + r; sv = (c <= lim[rg] && c >= lo[rg]) ? sv : -INFINITY; }
        S[rg][mt][r] = sv; mx = fmaxf(mx, sv);
      }
    mx = xmax<16>(mx); mx = xmax<32>(mx);
    const float mn = fmaxf(m[rg], mx);
    const float al = __builtin_amdgcn_exp2f(m[rg] - mn);
    m[rg] = mn;
    float ps = 0.f;
#pragma unroll
    for (int mt = 0; mt < 4; ++mt)
#pragma unroll
      for (int r = 0; r < 4; ++r) { const float pv = __builtin_amdgcn_exp2f(S[rg][mt][r] - mn); S[rg][mt][r] = pv; ps += pv; }
    l[rg] = l[rg] * al + ps;
    if (IMPT >= 0) {
#pragma unroll
      for (int k = 0; k < 4 * IMPT; ++k) imp[rg][k] *= al;
      carry[rg] *= al;
      float sh[4];
#pragma unroll
      for (int mt = 0; mt < 4; ++mt) sh[mt] = __uint_as_float(__builtin_amdgcn_ds_bpermute(((lane + 48) & 63) << 2, __float_as_uint(S[rg][mt][3])));
#pragma unroll
      for (int mt = 0; mt < 4; ++mt) {
        const float own = (S[rg][mt][0] + S[rg][mt][1]) + (S[rg][mt][2] + S[rg][mt][3]);
        const float prev = g > 0 ? sh[mt] : (mt > 0 ? sh[mt > 0 ? mt - 1 : 0] : carry[rg]);
        imp[rg][(IMPT >= 0 ? 4 * IMPT : 0) + mt] = own + prev;
      }
      carry[rg] = sh[3];
    }
#pragma unroll
    for (int dt = 0; dt < 4; ++dt) O[rg][dt] = O[rg][dt] * al;
#pragma unroll
    for (int ks = 0; ks < 2; ++ks) {
      pk[rg][ks][0] = cvtpk(S[rg][2 * ks][0], S[rg][2 * ks][1]); pk[rg][ks][1] = cvtpk(S[rg][2 * ks][2], S[rg][2 * ks][3]);
      pk[rg][ks][2] = cvtpk(S[rg][2 * ks + 1][0], S[rg][2 * ks + 1][1]); pk[rg][ks][3] = cvtpk(S[rg][2 * ks + 1][2], S[rg][2 * ks + 1][3]);
    }
  }
  LAS const unsigned char* vb = buf + KT_BYTES + (4 * g + (i >> 2)) * 32 + (i & 3) * 8;
#pragma unroll
  for (int dt = 0; dt < 4; ++dt)
#pragma unroll
    for (int ks = 0; ks < 2; ++ks) {
      const s16x4 v0 = vtr(vb + dt * VT_DT + ks * 1024);
      const s16x4 v1 = vtr(vb + dt * VT_DT + ks * 1024 + 512);
      const bf16x8 vf = (bf16x8){v0[0], v0[1], v0[2], v0[3], v1[0], v1[1], v1[2], v1[3]};
#pragma unroll
      for (int rg = 0; rg < NRG; ++rg) {
        const u32x4 pw = {pk[rg][ks][0], pk[rg][ks][1], pk[rg][ks][2], pk[rg][ks][3]};
        O[rg][dt] = __builtin_amdgcn_mfma_f32_16x16x32_bf16(vf, __builtin_bit_cast(bf16x8, pw), O[rg][dt], 0, 0, 0);
      }
    }
}

template <int NRG, bool EDGE>
__device__ __forceinline__ void at_tile(LAS const unsigned char* buf, const bf16x8 (&qf)[NRG][2], f32x4 (&O)[NRG][4], float (&m)[NRG], float (&l)[NRG],
                                        const float (&base)[NRG], const float (&soff)[NRG], const int (&lim)[NRG], const int (&lo)[NRG], int lane) {
  float dimp[NRG][16]; float dc[NRG];
  at_tile_x<NRG, EDGE, -1>(buf, qf, O, m, l, base, soff, lim, lo, lane, dimp, dc);
}

__device__ __forceinline__ void moba_mfma_item(const Params& P, int b, int h, int cur, unsigned char* smem_g) {
  LAS unsigned char* lds = (LAS unsigned char*)smem_g;
  const bf16_t* __restrict__ H0 = (const bf16_t*)(P.ws + WS_H);
  const float* __restrict__ KM = (const float*)(P.ws + WS_KM);
  bf16_t* __restrict__ MIX = (bf16_t*)(P.ws + WS_MIX);
  const int tid = otid(), lane = tid & 63, wid = __builtin_amdgcn_readfirstlane(tid >> 6), g = lane >> 4, i = lane & 15;
  const float slope2 = exp2f(-(float)(h + 1)) * LOG2E;
  const int t0 = cur * 256;
  int trow[2]; bf16x8 qf[2][2]; unsigned sel[2];
#pragma unroll
  for (int rg = 0; rg < 2; ++rg) {
    trow[rg] = t0 + wid * 32 + rg * 16 + i;
    const bf16_t* qp = H0 + ((size_t)b * S_ + trow[rg]) * P0 + C_MQ + h * 64 + 8 * g;
    qf[rg][0] = *(const bf16x8*)qp; qf[rg][1] = *(const bf16x8*)(qp + 32);
  }
#pragma unroll
  for (int rg = 0; rg < 2; ++rg) {
    float qv[16];
#pragma unroll
    for (int j = 0; j < 8; ++j) { qv[j] = bf2f((bf16_t)qf[rg][0][j]); qv[8 + j] = bf2f((bf16_t)qf[rg][1][j]); }
    float v1 = -INFINITY, v2 = -INFINITY, v3 = -INFINITY; int i1 = -1, i2 = -1, i3 = -1;
    for (int n = 0; n < cur; ++n) {
      const float* kr = KM + (((size_t)b * 16 + n) * 8 + h) * 64 + 8 * g;
      const float4 a0 = *(const float4*)kr, a1 = *(const float4*)(kr + 4), b0 = *(const float4*)(kr + 32), b1 = *(const float4*)(kr + 36);
      float d = qv[0] * a0.x + qv[1] * a0.y + qv[2] * a0.z + qv[3] * a0.w + qv[4] * a1.x + qv[5] * a1.y + qv[6] * a1.z + qv[7] * a1.w
              + qv[8] * b0.x + qv[9] * b0.y + qv[10] * b0.z + qv[11] * b0.w + qv[12] * b1.x + qv[13] * b1.y + qv[14] * b1.z + qv[15] * b1.w;
      d = xsum<16>(d); d = xsum<32>(d);
      if (d > v1) { v3 = v2; i3 = i2; v2 = v1; i2 = i1; v1 = d; i1 = n; }
      else if (d > v2) { v3 = v2; i3 = i2; v2 = d; i2 = n; }
      else if (d > v3) { v3 = d; i3 = n; }
    }
    unsigned mk = 0u;
    if (i1 >= 0) mk |= 1u << i1;
    if (i2 >= 0) mk |= 1u << i2;
    if (i3 >= 0) mk |= 1u << i3;
    sel[rg] = mk;
  }
  {
    unsigned u = sel[0] | sel[1];
    u = xorr<1>(u); u = xorr<2>(u); u = xorr<4>(u); u = xorr<8>(u);
    LAS unsigned* misc = (LAS unsigned*)(lds + AT_MISC);
    if (lane == 0) misc[wid] = u;
  }
  __syncthreads();
  unsigned umask = 0u;
  {
    LAS unsigned* misc = (LAS unsigned*)(lds + AT_MISC);
#pragma unroll
    for (int w = 0; w < 8; ++w) umask |= misc[w];
  }
  umask = __builtin_amdgcn_readfirstlane(umask);
  const int npast = __builtin_popcount(umask);
  const int nt = 4 * npast + 4;
  f32x4 O[2][4]; float m[2], l[2];
#pragma unroll
  for (int rg = 0; rg < 2; ++rg) { m[rg] = -1e30f; l[rg] = 0.f;
#pragma unroll
    for (int dt = 0; dt < 4; ++dt) O[rg][dt] = (f32x4){0.f, 0.f, 0.f, 0.f}; }
  const bf16_t* Kg = H0 + (size_t)b * S_ * P0 + C_MK + h * 64;
  const bf16_t* Vg = H0 + (size_t)b * S_ * P0 + C_MV + h * 64;
  unsigned rem = umask; int blk = -1, sub = 4;
  auto next_tile = [&](int& kblk, int& k0) {
    if (sub == 4) { sub = 0; if (rem) { blk = __builtin_ctz(rem); rem &= rem - 1; } else blk = cur; }
    kblk = blk; k0 = blk * 256 + sub * 64; ++sub;
  };
  int kblk, k0; next_tile(kblk, k0);
  at_stage_dma(lds, Kg + (size_t)k0 * P0, Vg + (size_t)k0 * P0, P0, lane, wid);
  __syncthreads();
  for (int ti = 0; ti < nt; ++ti) {
    const int cblk = kblk, ck0 = k0;
    if (ti + 1 < nt) {
      next_tile(kblk, k0);
      at_stage_dma(lds + ((ti + 1) & 1) * AT_BUF, Kg + (size_t)k0 * P0, Vg + (size_t)k0 * P0, P0, lane, wid);
    }
    LAS const unsigned char* buf = lds + (ti & 1) * AT_BUF;
    float base[2], soff[2]; int lim[2], lo[2];
#pragma unroll
    for (int rg = 0; rg < 2; ++rg) {
      const bool rs = (cblk == cur) || ((sel[rg] >> cblk) & 1u);
      base[rg] = rs ? slope2 * (float)(ck0 + 4 * g - trow[rg]) : -INFINITY;
      soff[rg] = slope2; lim[rg] = trow[rg] - ck0 - 4 * g; lo[rg] = -1000000;
    }
    if (cblk == cur) at_tile<2, true>(buf, qf, O, m, l, base, soff, lim, lo, lane);
    else at_tile<2, false>(buf, qf, O, m, l, base, soff, lim, lo, lane);
    __syncthreads();
  }
#pragma unroll
  for (int rg = 0; rg < 2; ++rg) {
    float lt = l[rg]; lt = xsum<16>(lt); lt = xsum<32>(lt);
    const float inv = 1.f / lt;
    const size_t row = (size_t)b * S_ + trow[rg];
#pragma unroll
    for (int dt = 0; dt < 4; ++dt) {
      const int dv = 16 * dt + 4 * g;
      const ushort4 zz = *(const ushort4*)(H0 + row * P0 + C_MZ + h * 64 + dv);
      ushort4 ov;
      ov.x = f2bf(O[rg][dt][0] * inv * silu_f(bf2f(zz.x))); ov.y = f2bf(O[rg][dt][1] * inv * silu_f(bf2f(zz.y)));
      ov.z = f2bf(O[rg][dt][2] * inv * silu_f(bf2f(zz.z))); ov.w = f2bf(O[rg][dt][3] * inv * silu_f(bf2f(zz.w)));
      *(ushort4*)(MIX + row * D_ + 512 + h * 64 + dv) = ov;
    }
  }
}


constexpr size_t WS_KCB = 248 * MiB;
constexpr size_t WS_VCB = 249 * MiB;
__device__ __forceinline__ void nsa_mfma_item(const Params& P, int b, int grp, int sb, unsigned char* smem_g) {
  LAS unsigned char* lds = (LAS unsigned char*)smem_g;
  const bf16_t* __restrict__ H0 = (const bf16_t*)(P.ws + WS_H);
  bf16_t* __restrict__ MIX = (bf16_t*)(P.ws + WS_MIX);
  const int tid = otid(), lane = tid & 63, wid = __builtin_amdgcn_readfirstlane(tid >> 6), g = lane >> 4, i = lane & 15;
  const int t0 = sb * 64;
  int trow[2]; bf16x8 qf[2][2];
  const int hh = grp * 4 + (i & 3);
  const float slope2 = exp2f(-(float)(hh + 1)) * LOG2E;
  const bf16_t* __restrict__ Hb = H0 + (size_t)b * S_ * P0;
#pragma unroll
  for (int rg = 0; rg < 2; ++rg) {
    trow[rg] = t0 + wid * 8 + rg * 4 + (i >> 2);
    const unsigned qo = (unsigned)trow[rg] * P0 + C_NQ + hh * 64 + 8 * g;
    qf[rg][0] = *(const bf16x8*)(Hb + qo); qf[rg][1] = *(const bf16x8*)(Hb + qo + 32);
  }
  LAS f32x4* stash = (LAS f32x4*)(lds + AT_STASH) + tid;
  f32x4 O[2][4]; float m[2], l[2];
  unsigned mlo[2], mhi[2];
#pragma unroll
  for (int rg = 0; rg < 2; ++rg) {
    float imp[1][16], carry[1], m1[1], l1[1]; f32x4 O1[1][4]; bf16x8 q1[1][2];
    q1[0][0] = qf[rg][0]; q1[0][1] = qf[rg][1];
    m1[0] = -1e30f; l1[0] = 0.f; carry[0] = 0.f;
#pragma unroll
    for (int k = 0; k < 16; ++k) imp[0][k] = 0.f;
#pragma unroll
    for (int dt = 0; dt < 4; ++dt) O1[0][dt] = (f32x4){0.f, 0.f, 0.f, 0.f};
    const int ntc = ((4 * sb + 2) >> 6) + 1;
    const bf16_t* Kg = (const bf16_t*)(P.ws + WS_KCB) + (size_t)(b * 2 + grp) * 256 * 64;
    const bf16_t* Vg = (const bf16_t*)(P.ws + WS_VCB) + (size_t)(b * 2 + grp) * 256 * 64;
    at_stage_dma(lds, Kg, Vg, 64, lane, wid);
    __syncthreads();
#pragma unroll
    for (int tile = 0; tile < 4; ++tile) {
      if (tile < ntc) {
        if (tile + 1 < ntc) at_stage_dma(lds + ((tile + 1) & 1) * AT_BUF, Kg + (tile + 1) * 4096, Vg + (tile + 1) * 4096, 64, lane, wid);
        LAS const unsigned char* buf = lds + (tile & 1) * AT_BUF;
        float base[1], soff[1]; int lim[1], lo[1];
        const int nlim = trow[rg] >= 31 ? ((trow[rg] - 31) >> 4) : -1;
        base[0] = slope2 * (float)(16 * (64 * tile + 4 * g) + 31 - trow[rg]);
        soff[0] = 16.f * slope2; lim[0] = nlim - 64 * tile - 4 * g; lo[0] = -1000000;
        if (tile == 0) at_tile_x<1, true, 0>(buf, q1, O1, m1, l1, base, soff, lim, lo, lane, imp, carry);
        else if (tile == 1) at_tile_x<1, true, 1>(buf, q1, O1, m1, l1, base, soff, lim, lo, lane, imp, carry);
        else if (tile == 2) at_tile_x<1, true, 2>(buf, q1, O1, m1, l1, base, soff, lim, lo, lane, imp, carry);
        else at_tile_x<1, true, 3>(buf, q1, O1, m1, l1, base, soff, lim, lo, lane, imp, carry);
        __syncthreads();
      }
    }
    {
      float lt = l1[0]; lt = xsum<16>(lt); lt = xsum<32>(lt);
      const float inv = lt > 0.f ? 1.f / lt : 0.f;
      const float g0 = sigmoid_f(bf2f(Hb[(unsigned)trow[rg] * P0 + C_NG + hh * 3 + 0]));
#pragma unroll
      for (int dt = 0; dt < 4; ++dt) stash[(rg * 4 + dt) * 512] = O1[0][dt] * (g0 * inv);
      if (sb < 16) { mlo[rg] = (1u << (sb + 1)) - 1u; mhi[rg] = 0u; }
      else {
        float key[16];
#pragma unroll
        for (int k = 0; k < 16; ++k) {
          float v = imp[0][k] * inv; v = xsum<1>(v); v = xsum<2>(v);
          const int sidx = 4 * k + g;
          const bool forced = (sidx == 0) || (sidx == sb) || (sidx == sb - 1);
          key[k] = (sidx <= sb) ? (forced ? 1e9f : v) : -1e30f;
        }
        const int j = i & 3;
        float mykey[4]; int mys[4], rank[4];
#pragma unroll
        for (int q = 0; q < 4; ++q) {
          mykey[q] = j == 0 ? key[q] : (j == 1 ? key[4 + q] : (j == 2 ? key[8 + q] : key[12 + q]));
          mys[q] = 4 * (4 * j + q) + g; rank[q] = 0;
        }
#pragma unroll 1
        for (int gg = 0; gg < 4; ++gg)
#pragma unroll
          for (int kk = 0; kk < 16; ++kk) {
            const float other = __uint_as_float(__builtin_amdgcn_ds_bpermute((gg * 16 + i) << 2, __float_as_uint(key[kk])));
            const int sp = 4 * kk + gg;
#pragma unroll
            for (int q = 0; q < 4; ++q) rank[q] += (other > mykey[q] || (other == mykey[q] && sp < mys[q])) ? 1 : 0;
          }
        unsigned a = 0u, bb = 0u;
#pragma unroll
        for (int q = 0; q < 4; ++q) if (rank[q] < 16 && mys[q] <= sb) { if (mys[q] < 32) a |= 1u << mys[q]; else bb |= 1u << (mys[q] - 32); }
        a = xorr<1>(a); bb = xorr<1>(bb); a = xorr<2>(a); bb = xorr<2>(bb);
        a = xorr<16>(a); bb = xorr<16>(bb); a = xorr<32>(a); bb = xorr<32>(bb);
        mlo[rg] = a; mhi[rg] = bb;
      }
    }
  }
  {
    unsigned ua = mlo[0] | mlo[1], ub = mhi[0] | mhi[1];
    ua = xorr<4>(ua); ub = xorr<4>(ub); ua = xorr<8>(ua); ub = xorr<8>(ub);
    LAS unsigned* misc = (LAS unsigned*)(lds + AT_MISC);
    if (lane == 0) { misc[2 * wid] = ua; misc[2 * wid + 1] = ub; }
    __syncthreads();
    ua = 0u; ub = 0u;
#pragma unroll
    for (int w = 0; w < 8; ++w) { ua |= misc[2 * w]; ub |= misc[2 * w + 1]; }
    unsigned long long rem = ((unsigned long long)(unsigned)__builtin_amdgcn_readfirstlane(ub) << 32) | (unsigned)__builtin_amdgcn_readfirstlane(ua);
    const int nt = __builtin_popcountll(rem);
#pragma unroll
    for (int rg = 0; rg < 2; ++rg) { m[rg] = -1e30f; l[rg] = 0.f;
#pragma unroll
      for (int dt = 0; dt < 4; ++dt) O[rg][dt] = (f32x4){0.f, 0.f, 0.f, 0.f}; }
    const bf16_t* Kg = Hb + C_KSEL + grp * 64;
    const bf16_t* Vg = Hb + C_VSEL + grp * 64;
    int blk = __builtin_ctzll(rem); rem &= rem - 1;
    at_stage_dma(lds, Kg + (size_t)blk * 64 * P0, Vg + (size_t)blk * 64 * P0, P0, lane, wid);
    __syncthreads();
    for (int ti = 0; ti < nt; ++ti) {
      const int cblk = blk;
      if (ti + 1 < nt) { blk = __builtin_ctzll(rem); rem &= rem - 1;
        at_stage_dma(lds + ((ti + 1) & 1) * AT_BUF, Kg + (size_t)blk * 64 * P0, Vg + (size_t)blk * 64 * P0, P0, lane, wid); }
      LAS const unsigned char* buf = lds + (ti & 1) * AT_BUF;
      float base[2], soff[2]; int lim[2], lo[2];
#pragma unroll
      for (int rg = 0; rg < 2; ++rg) {
        const bool rs = cblk < 32 ? ((mlo[rg] >> cblk) & 1u) : ((mhi[rg] >> (cblk - 32)) & 1u);
        base[rg] = rs ? slope2 * (float)(cblk * 64 + 4 * g - trow[rg]) : -INFINITY;
        soff[rg] = slope2; lim[rg] = trow[rg] - cblk * 64 - 4 * g; lo[rg] = -1000000;
      }
      if (cblk == sb) at_tile<2, true>(buf, qf, O, m, l, base, soff, lim, lo, lane);
      else at_tile<2, false>(buf, qf, O, m, l, base, soff, lim, lo, lane);
      __syncthreads();
    }
#pragma unroll
    for (int rg = 0; rg < 2; ++rg) {
      float lt = l[rg]; lt = xsum<16>(lt); lt = xsum<32>(lt);
      const float g1 = sigmoid_f(bf2f(Hb[(unsigned)trow[rg] * P0 + C_NG + hh * 3 + 1]));
#pragma unroll
      for (int dt = 0; dt < 4; ++dt) stash[(rg * 4 + dt) * 512] += O[rg][dt] * (g1 / lt);
    }
  }
  {
    const int b0 = sb >= 8 ? sb - 8 : 0;
    const int nt = sb - b0 + 1;
#pragma unroll
    for (int rg = 0; rg < 2; ++rg) { m[rg] = -1e30f; l[rg] = 0.f;
#pragma unroll
      for (int dt = 0; dt < 4; ++dt) O[rg][dt] = (f32x4){0.f, 0.f, 0.f, 0.f}; }
    const bf16_t* Kg = Hb + C_KWIN + grp * 64;
    const bf16_t* Vg = Hb + C_VWIN + grp * 64;
    at_stage_dma(lds, Kg + (size_t)b0 * 64 * P0, Vg + (size_t)b0 * 64 * P0, P0, lane, wid);
    __syncthreads();
    for (int ti = 0; ti < nt; ++ti) {
      const int cblk = b0 + ti;
      if (ti + 1 < nt) at_stage_dma(lds + ((ti + 1) & 1) * AT_BUF, Kg + (size_t)(cblk + 1) * 64 * P0, Vg + (size_t)(cblk + 1) * 64 * P0, P0, lane, wid);
      LAS const unsigned char* buf = lds + (ti & 1) * AT_BUF;
      float base[2], soff[2]; int lim[2], lo[2];
#pragma unroll
      for (int rg = 0; rg < 2; ++rg) {
        base[rg] = slope2 * (float)(cblk * 64 + 4 * g - trow[rg]);
        soff[rg] = slope2; lim[rg] = trow[rg] - cblk * 64 - 4 * g; lo[rg] = trow[rg] - 511 - cblk * 64 - 4 * g;
      }
      if (cblk == sb || cblk == sb - 8) at_tile<2, true>(buf, qf, O, m, l, base, soff, lim, lo, lane);
      else at_tile<2, false>(buf, qf, O, m, l, base, soff, lim, lo, lane);
      __syncthreads();
    }
  }
#pragma unroll
  for (int rg = 0; rg < 2; ++rg) {
    float lt = l[rg]; lt = xsum<16>(lt); lt = xsum<32>(lt);
    const unsigned ro = (unsigned)trow[rg] * P0;
    const float g2 = sigmoid_f(bf2f(Hb[ro + C_NG + hh * 3 + 2])) / lt;
#pragma unroll
    for (int dt = 0; dt < 4; ++dt) {
      const int dv = 16 * dt + 4 * g;
      const ushort4 zz = *(const ushort4*)(Hb + ro + C_NZ + hh * 64 + dv);
      const f32x4 ov = stash[(rg * 4 + dt) * 512] + O[rg][dt] * g2;
      ushort4 o4;
      o4.x = f2bf(ov[0] * silu_f(bf2f(zz.x))); o4.y = f2bf(ov[1] * silu_f(bf2f(zz.y)));
      o4.z = f2bf(ov[2] * silu_f(bf2f(zz.z))); o4.w = f2bf(ov[3] * silu_f(bf2f(zz.w)));
      *(ushort4*)(MIX + (size_t)b * S_ * D_ + (unsigned)trow[rg] * D_ + hh * 64 + dv) = o4;
    }
  }
}

__device__ __forceinline__ void gla_gate_phase(const Params& P) {
  const bf16_t* H1 = (const bf16_t*)(P.ws + WS_H);
  float* G = (float*)(P.ws + WS_G);
  const float* w2 = P.in[10]; const float* gb = P.in[11];
  const size_t total = (size_t)M_ * 512;
  for (size_t i = (size_t)blockIdx.x * 512 + otid(); i < total; i += (size_t)gridDim.x * 512) {
    const int c = (int)(i & 511); const size_t row = i >> 9;
    float x = gb[c];
#pragma unroll
    for (int r = 0; r < 16; ++r) x += bf2f(H1[row * P1 + G_LR + r]) * w2[r * 512 + c];
    const float ls = fminf(x, 0.f) - log1pf(__expf(-fabsf(x)));
    G[i] = ls * (1.f / 16.f);
  }
}
__device__ __forceinline__ void gla_scan_vblock(const Params& P, int vb) {
  const bf16_t* __restrict__ H1 = (const bf16_t*)(P.ws + WS_H);
  const float* __restrict__ G = (const float*)(P.ws + WS_G);
  bf16_t* __restrict__ O = (bf16_t*)(P.ws + WS_XB);
  const int tid = otid(), lane = tid & 63, wid = tid >> 6;
  const int eh = vb & 1, h = (vb >> 1) & 3, b = vb >> 3;
  const int e = eh * 128 + wid * 16 + (lane >> 2), dq = lane & 3;
  float St[32];
#pragma unroll
  for (int i = 0; i < 32; ++i) St[i] = 0.f;
  const float qscale = 0.08838834764831845f;
  for (int t = 0; t < S_; ++t) {
    const size_t row = (size_t)b * S_ + t;
    const float4* gr = (const float4*)(G + row * 512 + h * 128 + dq * 32);
    const uint4* kr = (const uint4*)(H1 + row * P1 + G_K + h * 128 + dq * 32);
    const uint4* qr = (const uint4*)(H1 + row * P1 + G_Q + h * 128 + dq * 32);
    const float v = bf2f(H1[row * P1 + G_V + h * 256 + e]);
    float o = 0.f;
#pragma unroll
    for (int c = 0; c < 4; ++c) {
      const uint4 ku = kr[c], qu = qr[c];
      const float4 g0 = gr[2 * c], g1 = gr[2 * c + 1];
      const float kk[8] = {__uint_as_float(ku.x << 16), __uint_as_float(ku.x & 0xffff0000u), __uint_as_float(ku.y << 16), __uint_as_float(ku.y & 0xffff0000u),
                           __uint_as_float(ku.z << 16), __uint_as_float(ku.z & 0xffff0000u), __uint_as_float(ku.w << 16), __uint_as_float(ku.w & 0xffff0000u)};
      const float qq[8] = {__uint_as_float(qu.x << 16), __uint_as_float(qu.x & 0xffff0000u), __uint_as_float(qu.y << 16), __uint_as_float(qu.y & 0xffff0000u),
                           __uint_as_float(qu.z << 16), __uint_as_float(qu.z & 0xffff0000u), __uint_as_float(qu.w << 16), __uint_as_float(qu.w & 0xffff0000u)};
      const float gg[8] = {g0.x, g0.y, g0.z, g0.w, g1.x, g1.y, g1.z, g1.w};
#pragma unroll
      for (int i = 0; i < 8; ++i) {
        const float a = __expf(gg[i]);
        St[c * 8 + i] = a * St[c * 8 + i] + kk[i] * v;
        o += qq[i] * St[c * 8 + i];
      }
    }
    o = xsum<1>(o); o = xsum<2>(o);
    if (dq == 0) O[row * D_ + h * 256 + e] = f2bf(o * qscale);
  }
}

constexpr size_t WS_QT = WS_G;
constexpr size_t WS_KH = WS_G + 16 * MiB;
constexpr size_t WS_ATT = 190 * MiB;
constexpr size_t WS_DEC = 199 * MiB;
__device__ __forceinline__ int kperm(int x) { const int dl = x & 31, hi = dl >> 4, d2 = dl & 15; return (x & ~31) + 8 * (d2 >> 2) + 4 * hi + (d2 & 3); }

__device__ __forceinline__ void gla_prep_item(const Params& P, int item, unsigned char* smem_g) {
  const bf16_t* __restrict__ H1 = (const bf16_t*)(P.ws + WS_H);
  bf16_t* __restrict__ QT = (bf16_t*)(P.ws + WS_QT) + (size_t)item * 8192;
  bf16_t* __restrict__ KH = (bf16_t*)(P.ws + WS_KH) + (size_t)item * 8192;
  bf16_t* __restrict__ ATT = (bf16_t*)(P.ws + WS_ATT) + (size_t)item * 4096;
  float* __restrict__ DEC = (float*)(P.ws + WS_DEC) + (size_t)item * 128;
  const int tid = otid(), lane = tid & 63, wid = tid >> 6, g = lane >> 4, i = lane & 15;
  const int c = item & 63, h = (item >> 6) & 3, b = item >> 8;
  const size_t rowbase = (size_t)b * S_ + c * 64;
  float* glr = (float*)smem_g;
  float* tot = (float*)(smem_g + 4096);
  bf16_t* qs = (bf16_t*)(smem_g + 6144);
  bf16_t* ks = (bf16_t*)(smem_g + 6144 + 17408);
  const int d = tid & 127, ig = tid >> 7;
#pragma unroll
  for (int k = 0; k < 2; ++k) { const int e = tid + 512 * k; glr[e] = bf2f(H1[(rowbase + (e >> 4)) * P1 + G_LR + (e & 15)]); }
  float w[16];
#pragma unroll
  for (int r = 0; r < 16; ++r) w[r] = P.in[10][r * 512 + h * 128 + d];
  const float gb = P.in[11][h * 128 + d];
  __syncthreads();
  float bb[16]; float run = 0.f;
#pragma unroll
  for (int k = 0; k < 16; ++k) {
    const float* gr = glr + (16 * ig + k) * 16;
    float x = gb;
#pragma unroll
    for (int r = 0; r < 16; ++r) x += gr[r] * w[r];
    const float la = (fminf(x, 0.f) - log1pf(__expf(-fabsf(x)))) * (1.f / 16.f);
    run += la; bb[k] = run;
  }
  tot[ig * 128 + d] = run;
  __syncthreads();
  float off = 0.f, total = 0.f;
#pragma unroll
  for (int q = 0; q < 4; ++q) { const float tv = tot[q * 128 + d]; total += tv; if (q < ig) off += tv; }
  const float qscale = 0.08838834764831845f;
  const int dp = kperm(d);
#pragma unroll
  for (int k = 0; k < 16; ++k) {
    const int r = 16 * ig + k;
    const float bv = bb[k] + off;
    const float qv = bf2f(H1[(rowbase + r) * P1 + G_Q + h * 128 + d]), kv = bf2f(H1[(rowbase + r) * P1 + G_K + h * 128 + d]);
    const float eb = __expf(bv);
    const bf16_t qt = f2bf(qv * eb * qscale), kt = f2bf(kv * __expf(-bv)), kh = f2bf(kv * __expf(total - bv));
    qs[r * 136 + d] = qt; ks[r * 136 + d] = kt;
    QT[r * 128 + dp] = qt; KH[r * 128 + d] = kh;
  }
  if (ig == 0) DEC[d] = __expf(total);
  __syncthreads();
  {
    const int it = wid >> 1, jt0 = 2 * (wid & 1);
    f32x4 acc[2] = {(f32x4){0.f, 0.f, 0.f, 0.f}, (f32x4){0.f, 0.f, 0.f, 0.f}};
#pragma unroll
    for (int kk = 0; kk < 4; ++kk) {
      const bf16x8 a = *(const bf16x8*)(qs + (16 * it + i) * 136 + 32 * kk + 8 * g);
#pragma unroll
      for (int n = 0; n < 2; ++n) {
        const bf16x8 bf = *(const bf16x8*)(ks + (16 * (jt0 + n) + i) * 136 + 32 * kk + 8 * g);
        acc[n] = __builtin_amdgcn_mfma_f32_16x16x32_bf16(a, bf, acc[n], 0, 0, 0);
      }
    }
#pragma unroll
    for (int n = 0; n < 2; ++n)
#pragma unroll
      for (int r = 0; r < 4; ++r) {
        const int ri = 16 * it + 4 * g + r, cj = 16 * (jt0 + n) + i;
        ATT[ri * 64 + kperm(cj)] = f2bf(cj <= ri ? acc[n][r] : 0.f);
      }
  }
  __syncthreads();
}

constexpr int GS_Q = 0, GS_K = 16384, GS_V = 32768, GS_A = 49152, GS_BYTES = 57344;
__device__ __forceinline__ void gla_stage_dma(LAS unsigned char* st, const Params& P, int item, size_t rowbase, int h, int eh, int lane, int wid) {
  const bf16_t* QT = (const bf16_t*)(P.ws + WS_QT) + (size_t)item * 8192;
  const bf16_t* KH = (const bf16_t*)(P.ws + WS_KH) + (size_t)item * 8192;
  const bf16_t* ATT = (const bf16_t*)(P.ws + WS_ATT) + (size_t)item * 4096;
  const bf16_t* V = (const bf16_t*)(P.ws + WS_H) + rowbase * P1 + G_V + h * 256 + eh * 128;
#pragma unroll
  for (int n = 0; n < 2; ++n) {
    const int q = 2 * wid + n;
    { const int row = 4 * q + (lane >> 4), ch = (lane & 15) ^ (row & 15);
      __builtin_amdgcn_global_load_lds((const unsigned*)(QT + row * 128 + ch * 8), (LAS unsigned*)(st + GS_Q + q * 1024), 16, 0, 0); }
    { const int dt = q >> 1, j = 32 * (q & 1) + (lane >> 1);
      __builtin_amdgcn_global_load_lds((const unsigned*)(KH + j * 128 + dt * 16 + (lane & 1) * 8), (LAS unsigned*)(st + GS_K + q * 1024), 16, 0, 0);
      __builtin_amdgcn_global_load_lds((const unsigned*)(V + (unsigned)j * P1 + dt * 16 + (lane & 1) * 8), (LAS unsigned*)(st + GS_V + q * 1024), 16, 0, 0); }
  }
  { const int row = 8 * wid + (lane >> 3), ch = (lane & 7) ^ ((row >> 1) & 7);
    __builtin_amdgcn_global_load_lds((const unsigned*)(ATT + row * 64 + ch * 8), (LAS unsigned*)(st + GS_A + wid * 1024), 16, 0, 0); }
}
__device__ __forceinline__ void gla_chain(const Params& P, int chain, unsigned char* smem_g) {
  LAS unsigned char* lds = (LAS unsigned char*)smem_g;
  bf16_t* __restrict__ O = (bf16_t*)(P.ws + WS_XB);
  const int tid = otid(), lane = tid & 63, wid = __builtin_amdgcn_readfirstlane(tid >> 6), g = lane >> 4, i = lane & 15;
  const int eh = chain & 1, h = (chain >> 1) & 3, b = chain >> 3;
  const int item0 = (b * 4 + h) * 64;
  f32x4 S[8];
#pragma unroll
  for (int dt = 0; dt < 8; ++dt) S[dt] = (f32x4){0.f, 0.f, 0.f, 0.f};
  gla_stage_dma(lds, P, item0, (size_t)b * S_, h, eh, lane, wid);
  __syncthreads();
  for (int c = 0; c < 64; ++c) {
    if (c + 1 < 64) gla_stage_dma(lds + ((c + 1) & 1) * GS_BYTES, P, item0 + c + 1, (size_t)b * S_ + (c + 1) * 64, h, eh, lane, wid);
    LAS const unsigned char* st = lds + (c & 1) * GS_BYTES;
    const float* DEC = (const float*)(P.ws + WS_DEC) + (size_t)(item0 + c) * 128;
    f32x4 dc[8];
#pragma unroll
    for (int dt = 0; dt < 8; ++dt) dc[dt] = *(const f32x4*)(DEC + 16 * dt + 4 * g);
    u32x4 spk[4];
#pragma unroll
    for (int kk = 0; kk < 4; ++kk) {
      spk[kk][0] = cvtpk(S[2 * kk][0], S[2 * kk][1]); spk[kk][1] = cvtpk(S[2 * kk][2], S[2 * kk][3]);
      spk[kk][2] = cvtpk(S[2 * kk + 1][0], S[2 * kk + 1][1]); spk[kk][3] = cvtpk(S[2 * kk + 1][2], S[2 * kk + 1][3]);
    }
    bf16x8 vf[2];
    {
      LAS const unsigned char* vb = st + GS_V + wid * 2048 + (4 * g + (i >> 2)) * 32 + (i & 3) * 8;
#pragma unroll
      for (int k2 = 0; k2 < 2; ++k2) {
        const s16x4 v0 = vtr(vb + k2 * 1024), v1 = vtr(vb + k2 * 1024 + 512);
        vf[k2] = (bf16x8){v0[0], v0[1], v0[2], v0[3], v1[0], v1[1], v1[2], v1[3]};
      }
    }
#pragma unroll
    for (int it = 0; it < 4; ++it) {
      f32x4 acc = (f32x4){0.f, 0.f, 0.f, 0.f};
      LAS const unsigned char* qrow = st + GS_Q + (16 * it + i) * 256;
#pragma unroll
      for (int kk = 0; kk < 4; ++kk) {
        const bf16x8 a = *(LAS const bf16x8*)(qrow + (((4 * kk + g) ^ i) << 4));
        acc = __builtin_amdgcn_mfma_f32_16x16x32_bf16(a, __builtin_bit_cast(bf16x8, spk[kk]), acc, 0, 0, 0);
      }
      LAS const unsigned char* arow = st + GS_A + (16 * it + i) * 128;
#pragma unroll
      for (int k2 = 0; k2 < 2; ++k2) {
        const bf16x8 a = *(LAS const bf16x8*)(arow + (((4 * k2 + g) ^ ((i >> 1) & 7)) << 4));
        acc = __builtin_amdgcn_mfma_f32_16x16x32_bf16(a, vf[k2], acc, 0, 0, 0);
      }
      bf16_t* op = O + ((size_t)b * S_ + c * 64 + 16 * it + 4 * g) * D_ + h * 256 + eh * 128 + 16 * wid + i;
#pragma unroll
      for (int r = 0; r < 4; ++r) op[(size_t)r * D_] = f2bf(acc[r]);
    }
#pragma unroll
    for (int dt = 0; dt < 8; ++dt) {
      S[dt] = S[dt] * dc[dt];
      LAS const unsigned char* kb = st + GS_K + dt * 2048 + (4 * g + (i >> 2)) * 32 + (i & 3) * 8;
#pragma unroll
      for (int k2 = 0; k2 < 2; ++k2) {
        const s16x4 k0 = vtr(kb + k2 * 1024), k1 = vtr(kb + k2 * 1024 + 512);
        const bf16x8 kf = (bf16x8){k0[0], k0[1], k0[2], k0[3], k1[0], k1[1], k1[2], k1[3]};
        S[dt] = __builtin_amdgcn_mfma_f32_16x16x32_bf16(kf, vf[k2], S[dt], 0, 0, 0);
      }
    }
    __syncthreads();
  }
}

__device__ __forceinline__ void gla_norm_phase(const Params& P) {
  const bf16_t* H1 = (const bf16_t*)(P.ws + WS_H);
  const bf16_t* O = (const bf16_t*)(P.ws + WS_XB);
  bf16_t* MIX = (bf16_t*)(P.ws + WS_MIX);
  const float* gn = P.in[12];
  const int lane = otid() & 63, wid = otid() >> 6;
  for (int it = blockIdx.x * 8 + wid; it < M_ * 4; it += gridDim.x * 8) {
    const int h = it & 3; const size_t row = it >> 2;
    float v[4]; float ss = 0.f;
#pragma unroll
    for (int k = 0; k < 4; ++k) { v[k] = bf2f(O[row * D_ + h * 256 + k * 64 + lane]); ss += v[k] * v[k]; }
    const float r = 1.f / sqrtf(wave_sum(ss) * (1.f / 256.f) + LN_EPS);
#pragma unroll
    for (int k = 0; k < 4; ++k) {
      const int c = h * 256 + k * 64 + lane;
      const float z = bf2f(H1[row * P1 + G_Z + c]);
      MIX[row * D_ + c] = f2bf(v[k] * r * gn[c] * silu_f(z));
    }
  }
}

#ifndef REP_P0
#define REP_P0 1
#endif
#ifndef REP_P2
#define REP_P2 1
#endif
#ifndef REP_P3
#define REP_P3 1
#endif
#ifndef REP_P7
#define REP_P7 1
#endif
#ifndef REP_P8
#define REP_P8 1
#endif
__global__ void __launch_bounds__(512) fwd_megakernel(Params P) {
  cg::grid_group grid = cg::this_grid();
  extern __shared__ __attribute__((aligned(16))) unsigned char smem[];
  const int tid = otid(), lane = tid & 63, wid = tid >> 6;
  unsigned char* ws = P.ws;
  bf16_t* XB = (bf16_t*)(ws + WS_XB);
  bf16_t* MIX = (bf16_t*)(ws + WS_MIX);
  bf16_t* Hb = (bf16_t*)(ws + WS_H);
  float* Y = (float*)(ws + WS_H);

  for (int rep = 0; rep < REP_P0; ++rep) {
    const float4* x4 = (const float4*)P.in[0];
    const size_t n4 = (size_t)M_ * D_ / 4;
    for (size_t i = (size_t)blockIdx.x * 512 + tid; i < n4; i += (size_t)gridDim.x * 512) {
      const float4 v = x4[i]; ushort4 o; o.x = f2bf(v.x); o.y = f2bf(v.y); o.z = f2bf(v.z); o.w = f2bf(v.w);
      ((ushort4*)XB)[i] = o;
    }
    constexpr int T0 = (P0 / 64) * 16, T1 = 16 * 16, T2 = (P1 / 64) * 16, T3 = 16 * 16;
    for (int it = blockIdx.x; it < T0 + T1 + T2 + T3; it += gridDim.x) {
      int r = it;
      if (r < T0) { transpose_tile(P.in[1], D_, EVEN_IN, (bf16_t*)(ws + WS_WT0), 0, r, P0 / 64, (float*)smem); continue; } r -= T0;
      if (r < T1) { transpose_tile(P.in[6], D_, D_, (bf16_t*)(ws + WS_WO0), 2, r, 16, (float*)smem); continue; } r -= T1;
      if (r < T2) { transpose_tile(P.in[9], D_, ODD_IN, (bf16_t*)(ws + WS_WT1), 1, r, P1 / 64, (float*)smem); continue; } r -= T2;
      transpose_tile(P.in[13], D_, D_, (bf16_t*)(ws + WS_WO1), 2, r, 16, (float*)smem);
    }
    for (int it = blockIdx.x; it < 2 * 64 + 2 * 2 + 64; it += gridDim.x) {
      if (it < 128) { const int i = it >> 6; transpose_tile(P.in[3] + (size_t)i * 2048 * 128, 2048, 128, (bf16_t*)(ws + WS_W1T) + (size_t)i * 128 * 2048, 2, it & 63, 2, (float*)smem); }
      else if (it < 132) { const int i = (it - 128) >> 1; transpose_tile(P.in[5] + (size_t)i * 128 * 64, 128, 64, (bf16_t*)(ws + WS_W2T) + (size_t)i * 64 * 128, 2, (it - 128) & 1, 1, (float*)smem); }
      else {
        const int t2 = it - 132, i = t2 >> 5, q = t2 & 31, hh = tid & 127, sub = tid >> 7;
        const float* pos = P.in[2] + i * 2048 + q * 64 + sub * 16;
        const float* w1 = P.in[3] + ((size_t)i * 2048 + q * 64 + sub * 16) * 128 + hh;
        float a = 0.f;
#pragma unroll
        for (int f = 0; f < 16; ++f) a += pos[f] * w1[f * 128];
        float* red = (float*)smem;
        red[sub * 128 + hh] = a;
        __syncthreads();
        if (tid < 128) ((float*)(ws + WS_C1P))[(i * 32 + q) * 128 + tid] = (red[tid] + red[128 + tid]) + (red[256 + tid] + red[384 + tid]);
        __syncthreads();
      }
    }
    if (blockIdx.x == 0) { const int which = tid >> 8, r = tid & 255;
      unsigned* z = (unsigned*)(ws + (which == 0 ? (size_t)(248 * MiB) : (size_t)(249 * MiB)));
      const int bg = r >> 5, wd = r & 31; z[((size_t)bg * 256 + 255) * 32 + wd] = 0u; }
    grid.sync();
  }
  { pg8::Gemm gm{XB, (const bf16_t*)(ws + WS_WT0), M_, P0, D_}; pg8::StaticOrder so; so.init(M_, P0, (int)gridDim.x, (int)blockIdx.x);
    pg8::EpiBf16s ep{Hb, P0}; pg8::gemm_phase<pg8::EpiBf16s, pg8::StaticOrder, true, true>((LAS unsigned char*)smem, gm, so, ep); }
  grid.sync();
  for (int rep = 0; rep < REP_P2; ++rep) {
    for (int it = blockIdx.x; it < 256; it += gridDim.x) compress_mfma_tile(P, it, smem);
    for (int it = blockIdx.x; it < 64; it += gridDim.x) kmean_item2(P, it);
    grid.sync();
  }
  for (int rep = 0; rep < REP_P3; ++rep) {
    for (int it = blockIdx.x; it < 1024; it += gridDim.x) {
      const int lvl = it >> 4, r = it & 15;
      if (r < 8) nsa_mfma_item(P, r >> 1, r & 1, 63 - lvl, smem);
      else { const int q = (lvl << 3) + (r - 8); moba_mfma_item(P, (q & 31) >> 3, q & 7, 15 - (q >> 5), smem); }
    }
    grid.sync();
  }
  { pg8::Gemm gm{MIX, (const bf16_t*)(ws + WS_WO0), M_, D_, D_}; pg8::StaticOrder so; so.init(M_, D_, (int)gridDim.x, (int)blockIdx.x);
    pg8::EpiF32 ep{Y, D_}; pg8::gemm_phase<pg8::EpiF32, pg8::StaticOrder, true, true>((LAS unsigned char*)smem, gm, so, ep); }
  grid.sync();
  ln_phase(P.in[0], Y, P.in[7], P.in[8], P.out, XB);
  grid.sync();
  { pg8::Gemm gm{XB, (const bf16_t*)(ws + WS_WT1), M_, P1, D_}; pg8::StaticOrder so; so.init(M_, P1, (int)gridDim.x, (int)blockIdx.x);
    pg8::EpiBf16s ep{Hb, P1}; pg8::gemm_phase<pg8::EpiBf16s, pg8::StaticOrder, true, true>((LAS unsigned char*)smem, gm, so, ep); }
  grid.sync();
  for (int rep = 0; rep < REP_P7; ++rep) {
    for (int it = blockIdx.x; it < 1024; it += gridDim.x) gla_prep_item(P, it, smem);
    grid.sync();
  }
  for (int rep = 0; rep < REP_P8; ++rep) {
    for (int ch = blockIdx.x; ch < 32; ch += gridDim.x) gla_chain(P, ch, smem);
    grid.sync();
  }
  gla_norm_phase(P);
  grid.sync();
  { pg8::Gemm gm{MIX, (const bf16_t*)(ws + WS_WO1), M_, D_, D_}; pg8::StaticOrder so; so.init(M_, D_, (int)gridDim.x, (int)blockIdx.x);
    pg8::EpiF32 ep{Y, D_}; pg8::gemm_phase<pg8::EpiF32, pg8::StaticOrder, true, true>((LAS unsigned char*)smem, gm, so, ep); }
  grid.sync();
  ln_phase(P.out, Y, P.in[14], P.in[15], P.out, nullptr);
}

extern "C" void kernel_launch(void* const* d_in, const int* in_sizes, int n_in, void* d_out, int out_size,
                              void* d_ws, size_t ws_size, hipStream_t stream) {
  constexpr size_t kDynLds = 132096;
  static_assert(kDynLds >= (size_t)AT_LDS_END && kDynLds >= 2 * (size_t)GS_BYTES && kDynLds >= (size_t)pg8::STAGE_BYTES, "LDS");
  static int grid_blocks = 0;
  if (!grid_blocks) {
    int dev = 0, cus = 0, per_cu = 0;
    (void)hipGetDevice(&dev);
    (void)hipDeviceGetAttribute(&cus, hipDeviceAttributeMultiprocessorCount, dev);
    (void)hipFuncSetAttribute((const void*)fwd_megakernel, hipFuncAttributeMaxDynamicSharedMemorySize, (int)kDynLds);
    (void)hipOccupancyMaxActiveBlocksPerMultiprocessor(&per_cu, fwd_megakernel, 512, kDynLds);
    if (per_cu < 1) per_cu = 1;
    if (per_cu > 2) per_cu = 2;
    grid_blocks = cus * per_cu;
    if (n_in != 16 || ws_size < WS_END) { fprintf(stderr, "kernel_launch: unexpected n_in %d / ws %zu\n", n_in, ws_size); }
  }
  Params p{};
  for (int i = 0; i < 16; ++i) p.in[i] = (const float*)d_in[i];
  p.out = (float*)d_out; p.ws = (unsigned char*)d_ws;
  void* args[] = {&p};
  hipError_t e = hipLaunchCooperativeKernel((void*)fwd_megakernel, dim3(grid_blocks), dim3(512), args, kDynLds, stream);
  if (e != hipSuccess) fprintf(stderr, "cooperative launch failed: %s (grid %d)\n", hipGetErrorString(e), grid_blocks);
}
```

```cpp
#include <hip/hip_runtime.h>
#include <hip/hip_cooperative_groups.h>
#include <cstdio>
#include <cstdint>
namespace cg = cooperative_groups;

typedef unsigned short bf16_t;
typedef short bf16x8 __attribute__((ext_vector_type(8)));
typedef float f32x4 __attribute__((ext_vector_type(4)));
typedef unsigned u32x4 __attribute__((ext_vector_type(4)));

constexpr int B_ = 4, S_ = 4096, M_ = B_ * S_, D_ = 1024;
constexpr int P0 = 4096;
constexpr int P1 = 3328;
constexpr int EVEN_IN = 3864, ODD_IN = 3088;
constexpr int C_NQ = 0, C_KCMP = 512, C_VCMP = 640, C_KSEL = 768, C_VSEL = 896, C_KWIN = 1024, C_VWIN = 1152;
constexpr int C_NZ = 1280, C_MQ = 1792, C_MK = 2304, C_MV = 2816, C_MZ = 3328, C_NG = 3840;
constexpr int G_Q = 0, G_K = 512, G_V = 1024, G_Z = 2048, G_LR = 3072;
constexpr int NCMP = 255;
constexpr float ALPHA = 1.4142135623730951f;
constexpr float LN_EPS = 1e-5f;

constexpr size_t MiB = 1u << 20;
constexpr int XB_LDS_OFF = 131072 + 512;
constexpr size_t WS_WT0 = 1 * MiB;
constexpr size_t WS_WO0 = 9 * MiB;
constexpr size_t WS_WT1 = 11 * MiB;
constexpr size_t WS_WO1 = 18 * MiB;
constexpr size_t WS_XB = 20 * MiB;
constexpr size_t WS_MIX = 52 * MiB;
constexpr size_t WS_H = 84 * MiB;
constexpr size_t WS_G = 212 * MiB;
constexpr size_t WS_KC = 245 * MiB;
constexpr size_t WS_VC = 246 * MiB;
constexpr size_t WS_KM = 247 * MiB;
constexpr size_t WS_END = 256 * MiB;

struct Params { const float* in[16]; float* out; unsigned char* ws; };

__device__ __forceinline__ int otid() { int t = __builtin_amdgcn_workitem_id_x(); asm volatile("" : "+v"(t)); return t; }
__device__ __forceinline__ float bf2f(bf16_t v) { return __uint_as_float(((unsigned)v) << 16); }
__device__ __forceinline__ bf16_t f2bf(float f) { unsigned u = __float_as_uint(f); return (bf16_t)((u + 0x7fffu + ((u >> 16) & 1u)) >> 16); }
template <int M> __device__ __forceinline__ float xsum(float v) {
  if constexpr (M == 32) { auto rr = __builtin_amdgcn_permlane32_swap(__float_as_uint(v), __float_as_uint(v), false, false); return __uint_as_float(rr[0]) + __uint_as_float(rr[1]); }
  else return v + __int_as_float(__builtin_amdgcn_ds_swizzle(__float_as_int(v), (M << 10) | 0x1f));
}
template <int M> __device__ __forceinline__ float xmax(float v) {
  if constexpr (M == 32) { auto rr = __builtin_amdgcn_permlane32_swap(__float_as_uint(v), __float_as_uint(v), false, false); return fmaxf(__uint_as_float(rr[0]), __uint_as_float(rr[1])); }
  else return fmaxf(v, __int_as_float(__builtin_amdgcn_ds_swizzle(__float_as_int(v), (M << 10) | 0x1f)));
}
template <int M> __device__ __forceinline__ unsigned xorr(unsigned v) {
  if constexpr (M == 32) { auto rr = __builtin_amdgcn_permlane32_swap(v, v, false, false); return rr[0] | rr[1]; }
  else return v | (unsigned)__builtin_amdgcn_ds_swizzle((int)v, (M << 10) | 0x1f);
}
__device__ __forceinline__ float wave_sum(float v) { v = xsum<1>(v); v = xsum<2>(v); v = xsum<4>(v); v = xsum<8>(v); v = xsum<16>(v); return xsum<32>(v); }
__device__ __forceinline__ float wave_max(float v) { v = xmax<1>(v); v = xmax<2>(v); v = xmax<4>(v); v = xmax<8>(v); v = xmax<16>(v); return xmax<32>(v); }
__device__ __forceinline__ float silu_f(float z) { return z / (1.f + __expf(-z)); }
__device__ __forceinline__ float sigmoid_f(float z) { return 1.f / (1.f + __expf(-z)); }

__device__ __forceinline__ int colmap0(int c) {
  if (c < 1280) return c;
  if (c < 1792) return 1304 + (c - 1280);
  if (c < 3840) return 1816 + (c - 1792);
  if (c < 3864) return 1280 + (c - 3840);
  return -1;
}
__device__ __forceinline__ int colmap1(int c) {
  if (c < 2048) return c;
  if (c < 3072) return 2064 + (c - 2048);
  if (c < 3088) return 2048 + (c - 3072);
  return -1;
}

__device__ __forceinline__ void transpose_tile(const float* __restrict__ W, int K, int Nsrc, bf16_t* __restrict__ Wt, int which, int tile, int ntn, float* sm) {
  const int tid = otid();
  const int nb = tile % ntn, kb = tile / ntn, n0 = nb * 64, k0 = kb * 64;
#pragma unroll
  for (int i = 0; i < 8; ++i) {
    const int kk = i * 8 + (tid >> 6), nn = tid & 63;
    const int c = n0 + nn;
    const int src = which == 0 ? colmap0(c) : (which == 1 ? colmap1(c) : c);
    sm[kk * 65 + nn] = src >= 0 ? W[(size_t)(k0 + kk) * Nsrc + src] : 0.f;
  }
  __syncthreads();
#pragma unroll
  for (int i = 0; i < 8; ++i) {
    const int nn = i * 8 + (tid >> 6), kk = tid & 63;
    Wt[(size_t)(n0 + nn) * K + k0 + kk] = f2bf(sm[kk * 65 + nn]);
  }
  __syncthreads();
}

__device__ __forceinline__ void gemm_tile(const bf16_t* __restrict__ A, const bf16_t* __restrict__ Bt, int K, int m0, int n0, int mode, void* outp, int ldc, unsigned char* smem) {
  bf16_t* As = (bf16_t*)smem;
  bf16_t* Bs = As + 128 * 72;
  const int tid = otid(), lane = tid & 63, wid = tid >> 6, wm = wid >> 1, wn = wid & 1;
  f32x4 acc[2][4];
#pragma unroll
  for (int i = 0; i < 2; ++i)
#pragma unroll
    for (int j = 0; j < 4; ++j) acc[i][j] = (f32x4){0.f, 0.f, 0.f, 0.f};
  for (int k0 = 0; k0 < K; k0 += 64) {
#pragma unroll
    for (int i = 0; i < 2; ++i) {
      const int idx = tid + i * 512, r = idx >> 3, c = (idx & 7) * 8;
      *(uint4*)(As + r * 72 + c) = *(const uint4*)(A + (size_t)(m0 + r) * K + k0 + c);
      *(uint4*)(Bs + r * 72 + c) = *(const uint4*)(Bt + (size_t)(n0 + r) * K + k0 + c);
    }
    __syncthreads();
#pragma unroll
    for (int kk = 0; kk < 64; kk += 32) {
      bf16x8 a[2], b[4];
#pragma unroll
      for (int i = 0; i < 2; ++i) a[i] = *(const bf16x8*)(As + (wm * 32 + i * 16 + (lane & 15)) * 72 + kk + (lane >> 4) * 8);
#pragma unroll
      for (int j = 0; j < 4; ++j) b[j] = *(const bf16x8*)(Bs + (wn * 64 + j * 16 + (lane & 15)) * 72 + kk + (lane >> 4) * 8);
#pragma unroll
      for (int i = 0; i < 2; ++i)
#pragma unroll
        for (int j = 0; j < 4; ++j) acc[i][j] = __builtin_amdgcn_mfma_f32_16x16x32_bf16(a[i], b[j], acc[i][j], 0, 0, 0);
    }
    __syncthreads();
  }
#pragma unroll
  for (int i = 0; i < 2; ++i)
#pragma unroll
    for (int j = 0; j < 4; ++j)
#pragma unroll
      for (int r = 0; r < 4; ++r) {
        const int row = m0 + wm * 32 + i * 16 + (lane >> 4) * 4 + r, col = n0 + wn * 64 + j * 16 + (lane & 15);
        if (mode == 0) ((bf16_t*)outp)[(size_t)row * ldc + col] = f2bf(acc[i][j][r]);
        else ((float*)outp)[(size_t)row * ldc + col] = acc[i][j][r];
      }
}
__device__ __forceinline__ void gemm_phase(const bf16_t* A, const bf16_t* Bt, int K, int N, int mode, void* outp, int ldc, unsigned char* smem) {
  const int ntn = N / 128, ntm = M_ / 128;
  for (int t = blockIdx.x; t < ntn * ntm; t += gridDim.x) {
    const int tn = t % ntn, tm = t / ntn;
    gemm_tile(A, Bt, K, tm * 128, tn * 128, mode, outp, ldc, smem);
  }
}

namespace pg8 {
#define PG8_LAS __attribute__((address_space(3)))
typedef unsigned short bf16_t;
typedef short bf16x8 __attribute__((ext_vector_type(8)));
typedef float f32x4 __attribute__((ext_vector_type(4)));
typedef unsigned u32x4 __attribute__((ext_vector_type(4)));
constexpr int BM = 256, BK = 64, HALF = 128, HTB = HALF * BK * 2  , STAGE_BYTES = 8 * HTB, NXCD = 8, WGM = 8;

__host__ __device__ __forceinline__ int lds_byte(int r, int c) { const int st = (r >> 4) * 2 + (c >> 5), rr = r & 15, cc = c & 31, ob = rr * 64 + cc * 2; return st * 1024 + (ob ^ (((ob >> 9) & 1) << 5)); }
__host__ __device__ __forceinline__ void stage_rc(int b, int& R, int& C) { const int st = b / 1024, sb = b % 1024, swz = sb ^ (((sb >> 9) & 1) << 5); R = (st >> 1) * 16 + swz / 64; C = (st & 1) * 32 + (swz % 64) / 2; }
__host__ __device__ __forceinline__ int perm32(int rho) { const int n = rho >> 4, i = rho & 15; return 8 * (i >> 2) + 4 * n + (i & 3); }

__device__ __forceinline__ unsigned cvtpk(float lo, float hi) { typedef float f2 __attribute__((ext_vector_type(2))); typedef __bf16 b2 __attribute__((ext_vector_type(2))); f2 v = {lo, hi}; b2 b = __builtin_convertvector(v, b2); return __builtin_bit_cast(unsigned, b); }
struct Unit { int pm, pn; };
struct Gemm { const bf16_t* A; const bf16_t* Bt; int M, N, K; };

struct StaticOrder {
    int nM, nN, nwg, G, c;
    __host__ __device__ void init(int M, int N, int G_, int c_) { nM = M / BM; nN = N / BM; nwg = nM * nN; G = G_; c = c_; }
    __host__ __device__ bool next(int i, Unit& u) const {
        const long L = (long)i * G + c; if (L >= nwg) return false;
        int wgid = (int)L; { const int q = nwg / NXCD, r = nwg % NXCD, xcd = wgid % NXCD, off = wgid / NXCD; wgid = (xcd < r ? xcd * (q + 1) : r * (q + 1) + (xcd - r) * q) + off; }
        const int nig = WGM * nN, gid = wgid / nig, fm = gid * WGM, gsz = (nM - fm) < WGM ? (nM - fm) : WGM;
        u.pm = fm + ((wgid % nig) % gsz); u.pn = (wgid % nig) / gsz; return true;
    }
    __device__ __forceinline__ void a_ready(const Unit&) const {}
    __device__ __forceinline__ void done(const Unit&) const {}
};


struct EpiBf16s {
    static constexpr bool PERM = true, AFTER_DRAIN = false;
    bf16_t* O; int ldc;
    __device__ __forceinline__ void operator()(const f32x4 (&acc)[2][2][4][2], const Unit& u, int wr, int wc, int fr, int fq) const {
        const int row0 = u.pm * BM + wr * 64 + fr, col0 = u.pn * BM + wc * 32 + 8 * fq;
#pragma unroll
        for (int ai = 0; ai < 2; ++ai)
#pragma unroll
            for (int m = 0; m < 4; ++m) { bf16_t* rowp = O + (size_t)(row0 + ai * HALF + m * 16) * ldc + col0;
#pragma unroll
                for (int bj = 0; bj < 2; ++bj) { const f32x4 v0 = acc[ai][bj][m][0], v1 = acc[ai][bj][m][1];
                    u32x4 w; w.x = cvtpk(v0[0], v0[1]); w.y = cvtpk(v0[2], v0[3]); w.z = cvtpk(v1[0], v1[1]); w.w = cvtpk(v1[2], v1[3]);
                    *(u32x4*)(rowp + bj * HALF) = w; } }
    }
};
struct EpiF32 {
    static constexpr bool PERM = false, AFTER_DRAIN = false;
    float* O; int ldc;
    __device__ __forceinline__ void operator()(const f32x4 (&acc)[2][2][4][2], const Unit& u, int wr, int wc, int fr, int fq) const {
        const int col0 = u.pn * BM + wc * 32 + 4 * fq;
#pragma unroll
        for (int ai = 0; ai < 2; ++ai)
#pragma unroll
            for (int m = 0; m < 4; ++m) { float* rowp = O + (size_t)(u.pm * BM + ai * HALF + wr * 64 + m * 16 + fr) * ldc + col0;
#pragma unroll
                for (int bj = 0; bj < 2; ++bj)
#pragma unroll
                    for (int n = 0; n < 2; ++n) *(f32x4*)(rowp + bj * HALF + n * 16) = acc[ai][bj][m][n]; }
    }
};

template <class Epi, class Sched, bool ALIGN_EPI = false, bool SP2 = false>
__device__ __forceinline__ void gemm_phase(PG8_LAS unsigned char* lds, const Gemm g, const Sched& S, const Epi& E) {
    const int tid = otid(), wid = __builtin_amdgcn_readfirstlane(tid >> 6), lane = tid & 63, wr = wid >> 2, wc = wid & 3, fr = lane & 15, fq = lane >> 4;
    const int K = g.K, nt = K / BK;
    unsigned voffA[2], voffB[2];
#pragma unroll
    for (int i = 0; i < 2; ++i) { int R, C; stage_rc(tid * 16 + i * 8192, R, C); const int Rb = Epi::PERM ? ((R & ~31) + perm32(R & 31)) : R;
        voffA[i] = (unsigned)(R * K + C) * 2u; voffB[i] = (unsigned)(Rb * K + C) * 2u; }
    const size_t kstep = (size_t)(BK * 2);
    const size_t hstep = (size_t)HALF * K * 2;
    const size_t tstep = 2 * hstep;
    const unsigned ldsw = (unsigned)wid * 1024u;
    const int aoff = lds_byte(wr * 64 + fr, fq * 8), boff = lds_byte(wc * 32 + fr, fq * 8);
#define PG8_SA(b, h) (((b) * 2 + (h)) * HTB)
#define PG8_SB(b, h) ((4 + (b) * 2 + (h)) * HTB)
#define PG8_STAGE(bufoff, gbase, voff) do { _Pragma("unroll") for (int _i = 0; _i < 2; ++_i) \
        __builtin_amdgcn_global_load_lds((const unsigned*)((const char*)(gbase) + (voff)[_i]), (PG8_LAS unsigned*)(lds + (bufoff) + ldsw + _i * 8192), 16, 0, 0); } while (0)
#define PG8_LDA(dst, b, h) do { _Pragma("unroll") for (int m = 0; m < 4; ++m) _Pragma("unroll") for (int k = 0; k < 2; ++k) dst[m][k] = *(const PG8_LAS bf16x8*)(lds + PG8_SA(b, h) + aoff + m * 2048 + k * 1024); } while (0)
#define PG8_LDB(dst, b, h) do { _Pragma("unroll") for (int n = 0; n < 2; ++n) _Pragma("unroll") for (int k = 0; k < 2; ++k) dst[n][k] = *(const PG8_LAS bf16x8*)(lds + PG8_SB(b, h) + boff + n * 2048 + k * 1024); } while (0)
#define PG8_MMA(ai, bj, At, Bt) do { __builtin_amdgcn_s_setprio(1); _Pragma("unroll") for (int m = 0; m < 4; ++m) _Pragma("unroll") for (int n = 0; n < 2; ++n) _Pragma("unroll") for (int k = 0; k < 2; ++k) \
        acc[ai][bj][m][n] = __builtin_amdgcn_mfma_f32_16x16x32_bf16(Bt[n][k], At[m][k], acc[ai][bj][m][n], 0, 0, 0); __builtin_amdgcn_s_setprio(0); } while (0)
#define PG8_WAIT_V(n) asm volatile("s_waitcnt vmcnt(" #n ")" ::: "memory")
#define PG8_WAIT_L(n) asm volatile("s_waitcnt lgkmcnt(" #n ")" ::: "memory")
#define PG8_BAR __builtin_amdgcn_s_barrier()
#define PG8_SCHED __builtin_amdgcn_sched_barrier(0)
    Unit cur, nxt; int ui = 0;
    if (!S.next(0, cur)) return;
    f32x4 acc[2][2][4][2];
#pragma unroll
    for (int a = 0; a < 2; ++a)
#pragma unroll
        for (int b = 0; b < 2; ++b)
#pragma unroll
            for (int m = 0; m < 4; ++m)
#pragma unroll
                for (int n = 0; n < 2; ++n) acc[a][b][m][n] = (f32x4){0.f, 0.f, 0.f, 0.f};
    bf16x8 At[4][2], B0[2][2], B1[2][2];
    const char* cA = (const char*)g.A + (size_t)cur.pm * tstep; const char* cB = (const char*)g.Bt + (size_t)cur.pn * tstep;
    S.a_ready(cur);
    if constexpr (SP2) {
        PG8_STAGE(PG8_SB(0, 0), cB, voffB); PG8_STAGE(PG8_SB(0, 1), cB + hstep, voffB); PG8_STAGE(PG8_SA(0, 0), cA, voffA); PG8_STAGE(PG8_SA(0, 1), cA + hstep, voffA);
        if (wr == 1) PG8_BAR;
        PG8_WAIT_V(2); PG8_BAR;
        PG8_STAGE(PG8_SB(1, 0), cB + kstep, voffB); PG8_STAGE(PG8_SA(1, 0), cA + kstep, voffA); PG8_STAGE(PG8_SB(1, 1), cB + hstep + kstep, voffB);
        PG8_WAIT_V(6); PG8_BAR;
    } else {
        PG8_STAGE(PG8_SB(0, 0), cB, voffB); PG8_STAGE(PG8_SA(0, 0), cA, voffA); PG8_STAGE(PG8_SB(0, 1), cB + hstep, voffB); PG8_STAGE(PG8_SA(0, 1), cA + hstep, voffA);
        if (wr == 1) PG8_BAR;
        PG8_WAIT_V(4); PG8_BAR;
        PG8_STAGE(PG8_SB(1, 0), cB + kstep, voffB); PG8_STAGE(PG8_SA(1, 0), cA + kstep, voffA); PG8_STAGE(PG8_SB(1, 1), cB + hstep + kstep, voffB);
        PG8_WAIT_V(6); PG8_BAR;
    }
    for (;;) {
        const bool has_next = S.next(ui + 1, nxt);
        const char* nA = has_next ? (const char*)g.A + (size_t)nxt.pm * tstep : cA; const char* nB = has_next ? (const char*)g.Bt + (size_t)nxt.pn * tstep : cB;
        for (int t = 0; t < nt; t += 2) {
            const bool last = (t == nt - 2);
            const char* a1 = cA + (size_t)(t + 1) * kstep;
            const char* a2 = last ? nA : cA + (size_t)(t + 2) * kstep; const char* b2 = last ? nB : cB + (size_t)(t + 2) * kstep;
            const char* a3 = a2 + kstep; const char* b3 = b2 + kstep;
            if (last && has_next) S.a_ready(nxt);
            if constexpr (SP2) {
            PG8_LDB(B0, 0, 0); PG8_LDB(B1, 0, 1); PG8_SCHED; PG8_LDA(At, 0, 0); PG8_STAGE(PG8_SA(1, 1), a1 + hstep, voffA);
            PG8_WAIT_V(8); PG8_WAIT_L(0); PG8_BAR; PG8_MMA(0, 0, At, B0); PG8_MMA(0, 1, At, B1); PG8_BAR; PG8_SCHED;
            PG8_LDA(At, 0, 1); PG8_STAGE(PG8_SB(0, 0), b2, voffB); PG8_STAGE(PG8_SB(0, 1), b2 + hstep, voffB); PG8_STAGE(PG8_SA(0, 0), a2, voffA);
            PG8_WAIT_V(8); PG8_WAIT_L(0); PG8_BAR; PG8_MMA(1, 0, At, B0); PG8_MMA(1, 1, At, B1); PG8_BAR; PG8_SCHED;
            PG8_LDB(B0, 1, 0); PG8_LDB(B1, 1, 1); PG8_SCHED; PG8_LDA(At, 1, 0); PG8_STAGE(PG8_SA(0, 1), a2 + hstep, voffA);
            PG8_WAIT_V(8); PG8_WAIT_L(0); PG8_BAR; PG8_MMA(0, 0, At, B0); PG8_MMA(0, 1, At, B1); PG8_BAR; PG8_SCHED;
            PG8_LDA(At, 1, 1); PG8_STAGE(PG8_SB(1, 0), b3, voffB); PG8_STAGE(PG8_SB(1, 1), b3 + hstep, voffB); PG8_STAGE(PG8_SA(1, 0), a3, voffA);
            PG8_WAIT_V(8); PG8_WAIT_L(0); PG8_BAR; PG8_MMA(1, 0, At, B0); PG8_MMA(1, 1, At, B1); PG8_BAR; PG8_SCHED;
            } else {
            PG8_LDB(B0, 0, 0); PG8_SCHED; PG8_LDA(At, 0, 0); PG8_STAGE(PG8_SA(1, 1), a1 + hstep, voffA);
            PG8_WAIT_L(8); PG8_BAR; PG8_WAIT_L(0); PG8_MMA(0, 0, At, B0); PG8_BAR; PG8_SCHED;
            PG8_LDB(B1, 0, 1); PG8_STAGE(PG8_SB(0, 0), b2, voffB);
            PG8_BAR; PG8_WAIT_L(0); PG8_MMA(0, 1, At, B1); PG8_BAR;
            PG8_LDA(At, 0, 1); PG8_STAGE(PG8_SA(0, 0), a2, voffA);
            PG8_BAR; PG8_WAIT_L(0); PG8_MMA(1, 0, At, B0); PG8_BAR; PG8_SCHED;
            PG8_STAGE(PG8_SB(0, 1), b2 + hstep, voffB);
            PG8_WAIT_V(6); PG8_BAR; PG8_MMA(1, 1, At, B1); PG8_BAR;
            PG8_LDB(B0, 1, 0); PG8_SCHED; PG8_LDA(At, 1, 0); PG8_STAGE(PG8_SA(0, 1), a2 + hstep, voffA);
            PG8_WAIT_L(8); PG8_BAR; PG8_WAIT_L(0); PG8_MMA(0, 0, At, B0); PG8_BAR; PG8_SCHED;
            PG8_LDB(B1, 1, 1); PG8_STAGE(PG8_SB(1, 0), b3, voffB);
            PG8_BAR; PG8_WAIT_L(0); PG8_MMA(0, 1, At, B1); PG8_BAR;
            PG8_LDA(At, 1, 1); PG8_STAGE(PG8_SA(1, 0), a3, voffA);
            PG8_BAR; PG8_WAIT_L(0); PG8_MMA(1, 0, At, B0); PG8_BAR; PG8_SCHED;
            PG8_STAGE(PG8_SB(1, 1), b3 + hstep, voffB);
            PG8_WAIT_V(6); PG8_BAR; PG8_MMA(1, 1, At, B1); PG8_BAR;
            }
        }
        if constexpr (ALIGN_EPI) { if (wr == 0) PG8_BAR; }
        if constexpr (!Epi::AFTER_DRAIN) { E(acc, cur, wr, wc, fr, fq); S.done(cur); }
        if (!has_next) break;
#pragma unroll
        for (int a = 0; a < 2; ++a)
#pragma unroll
            for (int b = 0; b < 2; ++b)
#pragma unroll
                for (int m = 0; m < 4; ++m)
#pragma unroll
                    for (int n = 0; n < 2; ++n) acc[a][b][m][n] = (f32x4){0.f, 0.f, 0.f, 0.f};
        cur = nxt; cA = nA; cB = nB; ++ui;
        if constexpr (ALIGN_EPI) { if (wr == 1) PG8_BAR; }
    }
    PG8_WAIT_V(0);
    if constexpr (!ALIGN_EPI) { if (wr == 0) PG8_BAR; }
    PG8_BAR;
    if constexpr (Epi::AFTER_DRAIN) { E.fused(acc, cur, wr, wc, fr, fq, lds, wid, lane); S.done(cur); }
#undef PG8_SA
#undef PG8_SB
#undef PG8_STAGE
#undef PG8_LDA
#undef PG8_LDB
#undef PG8_MMA
#undef PG8_WAIT_V
#undef PG8_WAIT_L
#undef PG8_BAR
#undef PG8_SCHED
}
}

__device__ __forceinline__ void ln_phase(const float* xin, const float* Y, const float* g, const float* bb, float* out, bf16_t* outb) {
  const int lane = otid() & 63, wid = otid() >> 6;
  for (int row = blockIdx.x * 8 + wid; row < M_; row += gridDim.x * 8) {
    const float4* xr = (const float4*)(xin + (size_t)row * D_);
    const float4* yr = (const float4*)(Y + (size_t)row * D_);
    float4 v[4]; float s = 0.f;
#pragma unroll
    for (int j = 0; j < 4; ++j) {
      const float4 a = xr[j * 64 + lane], y = yr[j * 64 + lane];
      v[j].x = ALPHA * a.x + y.x; v[j].y = ALPHA * a.y + y.y; v[j].z = ALPHA * a.z + y.z; v[j].w = ALPHA * a.w + y.w;
      s += (v[j].x + v[j].y) + (v[j].z + v[j].w);
    }
    const float mean = wave_sum(s) * (1.f / D_);
    float q = 0.f;
#pragma unroll
    for (int j = 0; j < 4; ++j) {
      v[j].x -= mean; v[j].y -= mean; v[j].z -= mean; v[j].w -= mean;
      q += (v[j].x * v[j].x + v[j].y * v[j].y) + (v[j].z * v[j].z + v[j].w * v[j].w);
    }
    const float rstd = 1.f / sqrtf(wave_sum(q) * (1.f / D_) + LN_EPS);
#pragma unroll
    for (int j = 0; j < 4; ++j) {
      const float4 gg = ((const float4*)g)[j * 64 + lane], bv = ((const float4*)bb)[j * 64 + lane];
      float4 o;
      o.x = v[j].x * rstd * gg.x + bv.x; o.y = v[j].y * rstd * gg.y + bv.y; o.z = v[j].z * rstd * gg.z + bv.z; o.w = v[j].w * rstd * gg.w + bv.w;
      ((float4*)(out + (size_t)row * D_))[j * 64 + lane] = o;
      if (outb) {
        ushort4 ob; ob.x = f2bf(o.x); ob.y = f2bf(o.y); ob.z = f2bf(o.z); ob.w = f2bf(o.w);
        ((ushort4*)(outb + (size_t)row * D_))[j * 64 + lane] = ob;
      }
    }
  }
}

__device__ __forceinline__ void compress_item(const Params& P, int item, float* sm) {
  const bf16_t* H0 = (const bf16_t*)(P.ws + WS_H);
  const int tid = otid();
  const int g = item & 1; int r = item >> 1; const int n = r % NCMP; r /= NCMP; const int b = r & 3; const int i = r >> 2;
  const float* pos = P.in[2] + i * 2048;
  const float* w1 = P.in[3] + (size_t)i * 2048 * 128;
  const float* b1 = P.in[4] + i * 128;
  const float* w2 = P.in[5] + (size_t)i * 128 * 64;
  float* blk = sm;
  float* part = sm + 2048;
  float* hid = sm + 2048 + 512;
  const int col = (i == 0 ? C_KCMP : C_VCMP) + g * 64;
#pragma unroll
  for (int k = 0; k < 4; ++k) {
    const int f = tid + k * 512, l = f >> 6, d = f & 63;
    blk[f] = bf2f(H0[((size_t)b * S_ + 16 * n + l) * P0 + col + d]) + pos[f];
  }
  __syncthreads();
  const int hh = tid & 127, pt = tid >> 7;
  float acc = 0.f;
  for (int f = pt * 512; f < pt * 512 + 512; ++f) acc += blk[f] * w1[(size_t)f * 128 + hh];
  part[pt * 128 + hh] = acc;
  __syncthreads();
  if (tid < 128) {
    const float a = part[tid] + part[128 + tid] + part[256 + tid] + part[384 + tid] + b1[tid];
    hid[tid] = silu_f(a);
  }
  __syncthreads();
  if (tid < 64) {
    float o = 0.f;
    for (int k = 0; k < 128; ++k) o += hid[k] * w2[k * 64 + tid];
    float* dst = (float*)(P.ws + (i == 0 ? WS_KC : WS_VC));
    dst[(((size_t)b * NCMP + n) * 2 + g) * 64 + tid] = o;
    bf16_t* dstb = (bf16_t*)(P.ws + (i == 0 ? (size_t)(248 * MiB) : (size_t)(249 * MiB)));
    dstb[(((size_t)b * 2 + g) * 256 + n) * 64 + tid] = f2bf(o);
    if (n == 0) dstb[(((size_t)b * 2 + g) * 256 + 255) * 64 + tid] = 0;
  }
  __syncthreads();
}
__device__ __forceinline__ void kmean_item(const Params& P, int item, int lane) {
  const bf16_t* H0 = (const bf16_t*)(P.ws + WS_H);
  const int h = item & 7, n = (item >> 3) & 15, b = item >> 7;
  float s = 0.f;
  for (int k = 0; k < 256; ++k) s += bf2f(H0[((size_t)b * S_ + n * 256 + k) * P0 + C_MK + h * 64 + lane]);
  ((float*)(P.ws + WS_KM))[(((size_t)b * 16 + n) * 8 + h) * 64 + lane] = s * (1.f / 256.f);
}


constexpr size_t WS_W1T = 250 * MiB;
constexpr size_t WS_W2T = 251 * MiB;
constexpr size_t WS_C1P = 252 * MiB;
__device__ __forceinline__ void compress_mfma_tile(const Params& P, int tile, unsigned char* smem_g) {
  const bf16_t* __restrict__ H0 = (const bf16_t*)(P.ws + WS_H);
  const int tid = otid(), lane = tid & 63, wid = __builtin_amdgcn_readfirstlane(tid >> 6), g = lane >> 4, ii = lane & 15;
  const int i = tile >> 7, R0 = (tile & 127) * 16;
  bf16_t* hs = (bf16_t*)smem_g;
  {
    const int R = min(R0 + ii, 2039), b = R / 510, rem = R - b * 510, n = rem >> 1, grp = rem & 1;
    const bf16_t* abase = H0 + ((size_t)b * S_ + 16 * n) * P0 + (i == 0 ? C_KCMP : C_VCMP) + grp * 64 + 8 * g;
    const bf16_t* bbase = (const bf16_t*)(P.ws + WS_W1T) + (size_t)(i * 128 + 16 * wid + ii) * 2048 + 8 * g;
    f32x4 acc = (f32x4){0.f, 0.f, 0.f, 0.f};
#pragma unroll 8
    for (int ks = 0; ks < 64; ++ks) {
      const bf16x8 a = *(const bf16x8*)(abase + (size_t)(ks >> 1) * P0 + (ks & 1) * 32);
      const bf16x8 bq = *(const bf16x8*)(bbase + ks * 32);
      acc = __builtin_amdgcn_mfma_f32_16x16x32_bf16(a, bq, acc, 0, 0, 0);
    }
    const int col = 16 * wid + ii;
    float bias = P.in[4][i * 128 + col];
    const float* c1p = (const float*)(P.ws + WS_C1P) + i * 32 * 128 + col;
#pragma unroll 8
    for (int q = 0; q < 32; ++q) bias += c1p[q * 128];
#pragma unroll
    for (int r = 0; r < 4; ++r) hs[(4 * g + r) * 136 + col] = f2bf(silu_f(acc[r] + bias));
  }
  __syncthreads();
  if (wid < 4) {
    const bf16_t* b2 = (const bf16_t*)(P.ws + WS_W2T) + (size_t)(i * 64 + 16 * wid + ii) * 128 + 8 * g;
    f32x4 acc = (f32x4){0.f, 0.f, 0.f, 0.f};
#pragma unroll
    for (int k2 = 0; k2 < 4; ++k2) {
      const bf16x8 a = *(const bf16x8*)(hs + ii * 136 + 32 * k2 + 8 * g);
      const bf16x8 bq = *(const bf16x8*)(b2 + 32 * k2);
      acc = __builtin_amdgcn_mfma_f32_16x16x32_bf16(a, bq, acc, 0, 0, 0);
    }
    bf16_t* dst = (bf16_t*)(P.ws + (i == 0 ? (size_t)(248 * MiB) : (size_t)(249 * MiB)));
#pragma unroll
    for (int r = 0; r < 4; ++r) {
      const int R = R0 + 4 * g + r;
      if (R < 2040) { const int b = R / 510, rem = R - b * 510, n = rem >> 1, grp = rem & 1;
        dst[(((size_t)b * 2 + grp) * 256 + n) * 64 + 16 * wid + ii] = f2bf(acc[r]); }
    }
  }
  __syncthreads();
}
__device__ __forceinline__ void kmean_item2(const Params& P, int item) {
  const bf16_t* __restrict__ H0 = (const bf16_t*)(P.ws + WS_H);
  const int tid = otid();
  const bf16_t* src = H0 + ((size_t)(item >> 4) * S_ + (item & 15) * 256) * P0 + C_MK + tid;
  float s0 = 0.f, s1 = 0.f, s2 = 0.f, s3 = 0.f;
#pragma unroll 4
  for (int r = 0; r < 256; r += 4) {
    s0 += bf2f(src[(size_t)r * P0]); s1 += bf2f(src[(size_t)(r + 1) * P0]); s2 += bf2f(src[(size_t)(r + 2) * P0]); s3 += bf2f(src[(size_t)(r + 3) * P0]);
  }
  ((float*)(P.ws + WS_KM))[(size_t)item * 512 + tid] = ((s0 + s1) + (s2 + s3)) * (1.f / 256.f);
}

template <int NH>
__device__ __forceinline__ void attend_block(const bf16_t* __restrict__ Kp, const bf16_t* __restrict__ Vp, size_t rowbase, int kp0, int t, int kmin,
                                             const float* qs, float* pb, const float* slope, float* m, float* l, float* o, int lane) {
  asm volatile("" ::: "memory");
  const int kp = kp0 + lane;
  const bool valid = (kp <= t) && (kp >= kmin);
  const uint4* kr = (const uint4*)(Kp + (rowbase + kp) * P0);
  float dot[NH];
#pragma unroll
  for (int j = 0; j < NH; ++j) dot[j] = 0.f;
#pragma unroll 1
  for (int c = 0; c < 8; ++c) {
    asm volatile("" ::: "memory");
    const uint4 u = kr[c];
    float kv[8];
    kv[0] = __uint_as_float(u.x << 16); kv[1] = __uint_as_float(u.x & 0xffff0000u);
    kv[2] = __uint_as_float(u.y << 16); kv[3] = __uint_as_float(u.y & 0xffff0000u);
    kv[4] = __uint_as_float(u.z << 16); kv[5] = __uint_as_float(u.z & 0xffff0000u);
    kv[6] = __uint_as_float(u.w << 16); kv[7] = __uint_as_float(u.w & 0xffff0000u);
#pragma unroll
    for (int j = 0; j < NH; ++j) {
      const float4 q0 = *(const float4*)(qs + j * 64 + c * 8), q1 = *(const float4*)(qs + j * 64 + c * 8 + 4);
      dot[j] += kv[0] * q0.x + kv[1] * q0.y + kv[2] * q0.z + kv[3] * q0.w + kv[4] * q1.x + kv[5] * q1.y + kv[6] * q1.z + kv[7] * q1.w;
    }
  }
#pragma unroll
  for (int j = 0; j < NH; ++j) {
    const float s = valid ? 0.125f * dot[j] - slope[j] * (float)(t - kp) : -1e30f;
    const float mn = fmaxf(m[j], wave_max(s));
    const float al = __expf(m[j] - mn);
    const float p = valid ? __expf(s - mn) : 0.f;
    l[j] = l[j] * al + wave_sum(p);
    o[j] *= al; m[j] = mn;
    pb[j * 64 + lane] = p;
  }
  __builtin_amdgcn_wave_barrier();
  const bf16_t* vr = Vp + (rowbase + kp0) * P0 + lane;
#pragma unroll 8
  for (int k = 0; k < 64; ++k) {
    const float v = bf2f(vr[(size_t)k * P0]);
#pragma unroll
    for (int j = 0; j < NH; ++j) o[j] += pb[j * 64 + k] * v;
  }
  __builtin_amdgcn_wave_barrier();
}

__device__ __forceinline__ void nsa_item(const Params& P, int b, int g, int t, float* wsm, int lane) {
  const bf16_t* H0 = (const bf16_t*)(P.ws + WS_H);
  const float* KC = (const float*)(P.ws + WS_KC);
  const float* VC = (const float*)(P.ws + WS_VC);
  bf16_t* MIX = (bf16_t*)(P.ws + WS_MIX);
  float* qs = wsm;
  float* pc = wsm + 256;
  float* pb = wsm + 1280;
  const size_t row = (size_t)b * S_ + t;
  const bf16_t* hrow = H0 + row * P0;
  float slope[4];
#pragma unroll
  for (int j = 0; j < 4; ++j) { qs[j * 64 + lane] = bf2f(hrow[C_NQ + (g * 4 + j) * 64 + lane]); slope[j] = exp2f(-(float)(g * 4 + j + 1)); }
  __builtin_amdgcn_wave_barrier();
  const int nv = t >= 31 ? (t - 31) / 16 + 1 : 0;
#pragma unroll 1
  for (int c = 0; c < 4; ++c) {
    asm volatile("" ::: "memory");
    const int n = c * 64 + lane;
    float dot[4] = {0.f, 0.f, 0.f, 0.f};
    if (n < nv) {
      const float4* kr = (const float4*)(KC + (((size_t)b * NCMP + n) * 2 + g) * 64);
#pragma unroll 4
      for (int d4 = 0; d4 < 16; ++d4) {
        const float4 kv = kr[d4];
#pragma unroll
        for (int j = 0; j < 4; ++j) {
          const float4 q = *(const float4*)(qs + j * 64 + d4 * 4);
          dot[j] += kv.x * q.x + kv.y * q.y + kv.z * q.z + kv.w * q.w;
        }
      }
    }
#pragma unroll
    for (int j = 0; j < 4; ++j) pc[j * 256 + n] = (n < nv) ? 0.125f * dot[j] - slope[j] * (float)(t - (16 * n + 31)) : -1e30f;
  }
  __builtin_amdgcn_wave_barrier();
#pragma unroll
  for (int j = 0; j < 4; ++j) {
    float sc[4];
#pragma unroll
    for (int c = 0; c < 4; ++c) sc[c] = pc[j * 256 + c * 64 + lane];
    float mx = fmaxf(fmaxf(sc[0], sc[1]), fmaxf(sc[2], sc[3]));
    mx = wave_max(mx);
    float sum = 0.f;
#pragma unroll
    for (int c = 0; c < 4; ++c) { const int n = c * 64 + lane; const float p = (n < nv) ? __expf(sc[c] - mx) : 0.f; sc[c] = p; sum += p; }
    sum = wave_sum(sum);
    const float inv = nv > 0 ? 1.f / sum : 0.f;
#pragma unroll
    for (int c = 0; c < 4; ++c) pc[j * 256 + c * 64 + lane] = sc[c] * inv;
  }
  __builtin_amdgcn_wave_barrier();
  float ocmp[4] = {0.f, 0.f, 0.f, 0.f};
  for (int n = 0; n < nv; ++n) {
    const float v = VC[(((size_t)b * NCMP + n) * 2 + g) * 64 + lane];
#pragma unroll
    for (int j = 0; j < 4; ++j) ocmp[j] += pc[j * 256 + n] * v;
  }
  float imp = 0.f;
  {
    const int lo = max(0, 4 * lane - 1), hi = min(NCMP - 1, 4 * lane + 3);
    for (int n = lo; n <= hi; ++n) imp += (pc[n] + pc[256 + n]) + (pc[512 + n] + pc[768 + n]);
  }
  const int cur = t >> 6;
  const bool bvalid = lane <= cur;
  const bool forced = (lane == 0) || (lane == cur) || (lane == cur - 1);
  const float key = bvalid ? (forced ? 1e9f : imp) : -1e30f;
  int rank = 0;
  for (int s2 = 0; s2 < 64; ++s2) {
    const float ks = __shfl(key, s2);
    rank += (ks > key || (ks == key && s2 < lane)) ? 1 : 0;
  }
  const unsigned long long selmask = __ballot(bvalid && rank < 16);
  float m[4], l[4], osel[4], owin[4];
#pragma unroll
  for (int j = 0; j < 4; ++j) { m[j] = -1e30f; l[j] = 0.f; osel[j] = 0.f; }
  {
    unsigned long long mk = selmask;
    while (mk) {
      const int blk = __builtin_ctzll(mk); mk &= mk - 1;
      attend_block<4>(H0 + C_KSEL + g * 64, H0 + C_VSEL + g * 64, (size_t)b * S_, blk * 64, t, 0, qs, pb, slope, m, l, osel, lane);
    }
  }
#pragma unroll
  for (int j = 0; j < 4; ++j) { osel[j] /= l[j]; m[j] = -1e30f; l[j] = 0.f; owin[j] = 0.f; }
  {
    const int kmin = t - 511;
    const int b0 = (kmin > 0 ? kmin : 0) >> 6;
    for (int blk = b0; blk <= cur; ++blk)
      attend_block<4>(H0 + C_KWIN + g * 64, H0 + C_VWIN + g * 64, (size_t)b * S_, blk * 64, t, kmin, qs, pb, slope, m, l, owin, lane);
  }
#pragma unroll
  for (int j = 0; j < 4; ++j) {
    const int h = g * 4 + j;
    const float g0 = sigmoid_f(bf2f(hrow[C_NG + h * 3 + 0])), g1 = sigmoid_f(bf2f(hrow[C_NG + h * 3 + 1])), g2 = sigmoid_f(bf2f(hrow[C_NG + h * 3 + 2]));
    const float o = g0 * ocmp[j] + g1 * osel[j] + g2 * (owin[j] / l[j]);
    const float z = bf2f(hrow[C_NZ + h * 64 + lane]);
    MIX[row * D_ + h * 64 + lane] = f2bf(o * silu_f(z));
  }
}

__device__ __forceinline__ void moba_item(const Params& P, int b, int h, int t, float* wsm, int lane) {
  const bf16_t* H0 = (const bf16_t*)(P.ws + WS_H);
  const float* KM = (const float*)(P.ws + WS_KM);
  bf16_t* MIX = (bf16_t*)(P.ws + WS_MIX);
  float* qs = wsm;
  float* pb = wsm + 1280;
  const size_t row = (size_t)b * S_ + t;
  const bf16_t* hrow = H0 + row * P0;
  qs[lane] = bf2f(hrow[C_MQ + h * 64 + lane]);
  __builtin_amdgcn_wave_barrier();
  float slope[1] = {exp2f(-(float)(h + 1))};
  const int cur = t >> 8;
  float gate = -1e30f;
  if (lane < cur) {
    const float4* kr = (const float4*)(KM + (((size_t)b * 16 + lane) * 8 + h) * 64);
    float d = 0.f;
#pragma unroll 4
    for (int d4 = 0; d4 < 16; ++d4) { const float4 kv = kr[d4]; const float4 q = *(const float4*)(qs + d4 * 4); d += kv.x * q.x + kv.y * q.y + kv.z * q.z + kv.w * q.w; }
    gate = d;
  }
  int rank = 0;
  for (int s2 = 0; s2 < 16; ++s2) {
    const float ks = __shfl(gate, s2);
    rank += (ks > gate || (ks == gate && s2 < lane)) ? 1 : 0;
  }
  unsigned long long mk = __ballot(lane < cur && rank < 3) | (1ull << cur);
  float m[1] = {-1e30f}, l[1] = {0.f}, o[1] = {0.f};
  while (mk) {
    const int blk = __builtin_ctzll(mk); mk &= mk - 1;
    for (int c = 0; c < 4; ++c) {
      const int kp0 = blk * 256 + c * 64;
      if (kp0 > t) break;
      attend_block<1>(H0 + C_MK + h * 64, H0 + C_MV + h * 64, (size_t)b * S_, kp0, t, 0, qs, pb, slope, m, l, o, lane);
    }
  }
  const float z = bf2f(hrow[C_MZ + h * 64 + lane]);
  MIX[row * D_ + 512 + h * 64 + lane] = f2bf((o[0] / l[0]) * silu_f(z));
}


#define LAS __attribute__((address_space(3)))
typedef short s16x4 __attribute__((ext_vector_type(4)));
typedef float f32x2_t __attribute__((ext_vector_type(2)));
typedef __bf16 bf16x2_t __attribute__((ext_vector_type(2)));
__device__ __forceinline__ unsigned cvtpk(float lo, float hi) { f32x2_t v = {lo, hi}; bf16x2_t b = __builtin_convertvector(v, bf16x2_t); return __builtin_bit_cast(unsigned, b); }
__device__ __forceinline__ s16x4 vtr(LAS const unsigned char* p) { return __builtin_bit_cast(s16x4, __builtin_amdgcn_ds_read_tr16_b64_v4i16((LAS s16x4*)p)); }
constexpr int KT_BYTES = 8192;
constexpr int VT_DT = 2080;
constexpr int VT_BYTES = 4 * VT_DT;
constexpr int AT_BUF = KT_BYTES + VT_BYTES;
constexpr int AT_MISC = 2 * AT_BUF;
constexpr int AT_STASH = AT_MISC + 256;
constexpr int AT_LDS_END = AT_STASH + 8 * 512 * 16;
constexpr float C1 = 0.125f * 1.4426950408889634f;
constexpr float LOG2E = 1.4426950408889634f;

__device__ __forceinline__ void at_stage_write(LAS unsigned char* buf, const u32x4& kreg, const u32x4& vreg, int tid) {
  const int key = tid >> 3, c = tid & 7;
  *(LAS u32x4*)(buf + key * 128 + ((c ^ ((key >> 1) & 7)) << 4)) = kreg;
  *(LAS u32x4*)(buf + KT_BYTES + (c >> 1) * VT_DT + key * 32 + (c & 1) * 16) = vreg;
}
__device__ __forceinline__ void at_stage_dma(LAS unsigned char* buf, const bf16_t* Kt, const bf16_t* Vt, unsigned pitch, int lane, int wid) {
  const int kkey = 8 * wid + (lane >> 3), c = (lane & 7) ^ ((kkey >> 1) & 7);
  __builtin_amdgcn_global_load_lds((const unsigned*)(Kt + (unsigned)kkey * pitch + c * 8), (LAS unsigned*)(buf + wid * 1024), 16, 0, 0);
  const int vkey = 32 * (wid & 1) + (lane >> 1), dt = wid >> 1;
  __builtin_amdgcn_global_load_lds((const unsigned*)(Vt + (unsigned)vkey * pitch + dt * 16 + (lane & 1) * 8), (LAS unsigned*)(buf + KT_BYTES + dt * VT_DT + (wid & 1) * 1024), 16, 0, 0);
}
template <int NRG, bool EDGE, int IMPT  >
__device__ __forceinline__ void at_tile_x(LAS const unsigned char* buf, const bf16x8 (&qf)[NRG][2], f32x4 (&O)[NRG][4], float (&m)[NRG], float (&l)[NRG],
                                        const float (&base)[NRG], const float (&soff)[NRG], const int (&lim)[NRG], const int (&lo)[NRG], int lane,
                                        float (&imp)[NRG][16], float (&carry)[NRG]) {
  const int g = lane >> 4, i = lane & 15;
  const int swz = (i >> 1) & 7;
  LAS const unsigned char* kb = buf + i * 128;
  const int kc0 = ((g ^ swz) << 4), kc1 = (((4 + g) ^ swz) << 4);
  f32x4 S[NRG][4];
#pragma unroll
  for (int mt = 0; mt < 4; ++mt) {
    const bf16x8 k0f = *(LAS const bf16x8*)(kb + mt * 2048 + kc0);
    const bf16x8 k1f = *(LAS const bf16x8*)(kb + mt * 2048 + kc1);
#pragma unroll
    for (int rg = 0; rg < NRG; ++rg) {
      f32x4 a = __builtin_amdgcn_mfma_f32_16x16x32_bf16(k0f, qf[rg][0], (f32x4){0.f, 0.f, 0.f, 0.f}, 0, 0, 0);
      S[rg][mt] = __builtin_amdgcn_mfma_f32_16x16x32_bf16(k1f, qf[rg][1], a, 0, 0, 0);
    }
  }
  __builtin_amdgcn_sched_barrier(0);
  unsigned pk[NRG][2][4];
#pragma unroll
  for (int rg = 0; rg < NRG; ++rg) {
    float mx = -INFINITY;
#pragma unroll
    for (int mt = 0; mt < 4; ++mt)
#pragma unroll
      for (int r = 0; r < 4; ++r) {
        float sv = __builtin_fmaf(S[rg][mt][r], C1, base[rg] + soff[rg] * (float)(16 * mt + r));
        if (EDGE) { const int c = 16 * mt + r; sv = (c <= lim[rg] && c >= lo[rg]) ? sv : -INFINITY; }
        S[rg][mt][r] = sv; mx = fmaxf(mx, sv);
      }
    mx = xmax<16>(mx); mx = xmax<32>(mx);
    const float mn = fmaxf(m[rg], mx);
    const float al = __builtin_amdgcn_exp2f(m[rg] - mn);
    m[rg] = mn;
    float ps = 0.f;
#pragma unroll
    for (int mt = 0; mt < 4; ++mt)
#pragma unroll
      for (int r = 0; r < 4; ++r) { const float pv = __builtin_amdgcn_exp2f(S[rg][mt][r] - mn); S[rg][mt][r] = pv; ps += pv; }
    l[rg] = l[rg] * al + ps;
    if (IMPT >= 0) {
#pragma unroll
      for (int k = 0; k < 4 * IMPT; ++k) imp[rg][k] *= al;
      carry[rg] *= al;
      float sh[4];
#pragma unroll
      for (int mt = 0; mt < 4; ++mt) sh[mt] = __uint_as_float(__builtin_amdgcn_ds_bpermute(((lane + 48) & 63) << 2, __float_as_uint(S[rg][mt][3])));
#pragma unroll
      for (int mt = 0; mt < 4; ++mt) {
        const float own = (S[rg][mt][0] + S[rg][mt][1]) + (S[rg][mt][2] + S[rg][mt][3]);
        const float prev = g > 0 ? sh[mt] : (mt > 0 ? sh[mt > 0 ? mt - 1 : 0] : carry[rg]);
        imp[rg][(IMPT >= 0 ? 4 * IMPT : 0) + mt] = own + prev;
      }
      carry[rg] = sh[3];
    }
#pragma unroll
    for (int dt = 0; dt < 4; ++dt) O[rg][dt] = O[rg][dt] * al;
#pragma unroll
    for (int ks = 0; ks < 2; ++ks) {
      pk[rg][ks][0] = cvtpk(S[rg][2 * ks][0], S[rg][2 * ks][1]); pk[rg][ks][1] = cvtpk(S[rg][2 * ks][2], S[rg][2 * ks][3]);
      pk[rg][ks][2] = cvtpk(S[rg][2 * ks + 1][0], S[rg][2 * ks + 1][1]); pk[rg][ks][3] = cvtpk(S[rg][2 * ks + 1][2], S[rg][2 * ks + 1][3]);
    }
  }
  LAS const unsigned char* vb = buf + KT_BYTES + (4 * g + (i >> 2)) * 32 + (i & 3) * 8;
#pragma unroll
  for (int dt = 0; dt < 4; ++dt)
#pragma unroll
    for (int ks = 0; ks < 2; ++ks) {
      const s16x4 v0 = vtr(vb + dt * VT_DT + ks * 1024);
      const s16x4 v1 = vtr(vb + dt * VT_DT + ks * 1024 + 512);
      const bf16x8 vf = (bf16x8){v0[0], v0[1], v0[2], v0[3], v1[0], v1[1], v1[2], v1[3]};
#pragma unroll
      for (int rg = 0; rg < NRG; ++rg) {
        const u32x4 pw = {pk[rg][ks][0], pk[rg][ks][1], pk[rg][ks][2], pk[rg][ks][3]};
        O[rg][dt] = __builtin_amdgcn_mfma_f32_16x16x32_bf16(vf, __builtin_bit_cast(bf16x8, pw), O[rg][dt], 0, 0, 0);
      }
    }
}

template <int NRG, bool EDGE>
__device__ __forceinline__ void at_tile(LAS const unsigned char* buf, const bf16x8 (&qf)[NRG][2], f32x4 (&O)[NRG][4], float (&m)[NRG], float (&l)[NRG],
                                        const float (&base)[NRG], const float (&soff)[NRG], const int (&lim)[NRG], const int (&lo)[NRG], int lane) {
  float dimp[NRG][16]; float dc[NRG];
  at_tile_x<NRG, EDGE, -1>(buf, qf, O, m, l, base, soff, lim, lo, lane, dimp, dc);
}

__device__ __forceinline__ void moba_mfma_item(const Params& P, int b, int h, int cur, unsigned char* smem_g) {
  LAS unsigned char* lds = (LAS unsigned char*)smem_g;
  const bf16_t* __restrict__ H0 = (const bf16_t*)(P.ws + WS_H);
  const float* __restrict__ KM = (const float*)(P.ws + WS_KM);
  bf16_t* __restrict__ MIX = (bf16_t*)(P.ws + WS_MIX);
  const int tid = otid(), lane = tid & 63, wid = __builtin_amdgcn_readfirstlane(tid >> 6), g = lane >> 4, i = lane & 15;
  const float slope2 = exp2f(-(float)(h + 1)) * LOG2E;
  const int t0 = cur * 256;
  int trow[2]; bf16x8 qf[2][2]; unsigned sel[2];
#pragma unroll
  for (int rg = 0; rg < 2; ++rg) {
    trow[rg] = t0 + wid * 32 + rg * 16 + i;
    const bf16_t* qp = H0 + ((size_t)b * S_ + trow[rg]) * P0 + C_MQ + h * 64 + 8 * g;
    qf[rg][0] = *(const bf16x8*)qp; qf[rg][1] = *(const bf16x8*)(qp + 32);
  }
#pragma unroll
  for (int rg = 0; rg < 2; ++rg) {
    float qv[16];
#pragma unroll
    for (int j = 0; j < 8; ++j) { qv[j] = bf2f((bf16_t)qf[rg][0][j]); qv[8 + j] = bf2f((bf16_t)qf[rg][1][j]); }
    float v1 = -INFINITY, v2 = -INFINITY, v3 = -INFINITY; int i1 = -1, i2 = -1, i3 = -1;
    for (int n = 0; n < cur; ++n) {
      const float* kr = KM + (((size_t)b * 16 + n) * 8 + h) * 64 + 8 * g;
      const float4 a0 = *(const float4*)kr, a1 = *(const float4*)(kr + 4), b0 = *(const float4*)(kr + 32), b1 = *(const float4*)(kr + 36);
      float d = qv[0] * a0.x + qv[1] * a0.y + qv[2] * a0.z + qv[3] * a0.w + qv[4] * a1.x + qv[5] * a1.y + qv[6] * a1.z + qv[7] * a1.w
              + qv[8] * b0.x + qv[9] * b0.y + qv[10] * b0.z + qv[11] * b0.w + qv[12] * b1.x + qv[13] * b1.y + qv[14] * b1.z + qv[15] * b1.w;
      d = xsum<16>(d); d = xsum<32>(d);
      if (d > v1) { v3 = v2; i3 = i2; v2 = v1; i2 = i1; v1 = d; i1 = n; }
      else if (d > v2) { v3 = v2; i3 = i2; v2 = d; i2 = n; }
      else if (d > v3) { v3 = d; i3 = n; }
    }
    unsigned mk = 0u;
    if (i1 >= 0) mk |= 1u << i1;
    if (i2 >= 0) mk |= 1u << i2;
    if (i3 >= 0) mk |= 1u << i3;
    sel[rg] = mk;
  }
  {
    unsigned u = sel[0] | sel[1];
    u = xorr<1>(u); u = xorr<2>(u); u = xorr<4>(u); u = xorr<8>(u);
    LAS unsigned* misc = (LAS unsigned*)(lds + AT_MISC);
    if (lane == 0) misc[wid] = u;
  }
  __syncthreads();
  unsigned umask = 0u;
  {
    LAS unsigned* misc = (LAS unsigned*)(lds + AT_MISC);
#pragma unroll
    for (int w = 0; w < 8; ++w) umask |= misc[w];
  }
  umask = __builtin_amdgcn_readfirstlane(umask);
  const int npast = __builtin_popcount(umask);
  const int nt = 4 * npast + 4;
  f32x4 O[2][4]; float m[2], l[2];
#pragma unroll
  for (int rg = 0; rg < 2; ++rg) { m[rg] = -1e30f; l[rg] = 0.f;
#pragma unroll
    for (int dt = 0; dt < 4; ++dt) O[rg][dt] = (f32x4){0.f, 0.f, 0.f, 0.f}; }
  const bf16_t* Kg = H0 + (size_t)b * S_ * P0 + C_MK + h * 64;
  const bf16_t* Vg = H0 + (size_t)b * S_ * P0 + C_MV + h * 64;
  unsigned rem = umask; int blk = -1, sub = 4;
  auto next_tile = [&](int& kblk, int& k0) {
    if (sub == 4) { sub = 0; if (rem) { blk = __builtin_ctz(rem); rem &= rem - 1; } else blk = cur; }
    kblk = blk; k0 = blk * 256 + sub * 64; ++sub;
  };
  int kblk, k0; next_tile(kblk, k0);
  at_stage_dma(lds, Kg + (size_t)k0 * P0, Vg + (size_t)k0 * P0, P0, lane, wid);
  __syncthreads();
  for (int ti = 0; ti < nt; ++ti) {
    const int cblk = kblk, ck0 = k0;
    if (ti + 1 < nt) {
      next_tile(kblk, k0);
      at_stage_dma(lds + ((ti + 1) & 1) * AT_BUF, Kg + (size_t)k0 * P0, Vg + (size_t)k0 * P0, P0, lane, wid);
    }
    LAS const unsigned char* buf = lds + (ti & 1) * AT_BUF;
    float base[2], soff[2]; int lim[2], lo[2];
#pragma unroll
    for (int rg = 0; rg < 2; ++rg) {
      const bool rs = (cblk == cur) || ((sel[rg] >> cblk) & 1u);
      base[rg] = rs ? slope2 * (float)(ck0 + 4 * g - trow[rg]) : -INFINITY;
      soff[rg] = slope2; lim[rg] = trow[rg] - ck0 - 4 * g; lo[rg] = -1000000;
    }
    if (cblk == cur) at_tile<2, true>(buf, qf, O, m, l, base, soff, lim, lo, lane);
    else at_tile<2, false>(buf, qf, O, m, l, base, soff, lim, lo, lane);
    __syncthreads();
  }
#pragma unroll
  for (int rg = 0; rg < 2; ++rg) {
    float lt = l[rg]; lt = xsum<16>(lt); lt = xsum<32>(lt);
    const float inv = 1.f / lt;
    const size_t row = (size_t)b * S_ + trow[rg];
#pragma unroll
    for (int dt = 0; dt < 4; ++dt) {
      const int dv = 16 * dt + 4 * g;
      const ushort4 zz = *(const ushort4*)(H0 + row * P0 + C_MZ + h * 64 + dv);
      ushort4 ov;
      ov.x = f2bf(O[rg][dt][0] * inv * silu_f(bf2f(zz.x))); ov.y = f2bf(O[rg][dt][1] * inv * silu_f(bf2f(zz.y)));
      ov.z = f2bf(O[rg][dt][2] * inv * silu_f(bf2f(zz.z))); ov.w = f2bf(O[rg][dt][3] * inv * silu_f(bf2f(zz.w)));
      *(ushort4*)(MIX + row * D_ + 512 + h * 64 + dv) = ov;
    }
  }
}


constexpr size_t WS_KCB = 248 * MiB;
constexpr size_t WS_VCB = 249 * MiB;
__device__ __forceinline__ void nsa_mfma_item(const Params& P, int b, int grp, int sb, unsigned char* smem_g) {
  LAS unsigned char* lds = (LAS unsigned char*)smem_g;
  const bf16_t* __restrict__ H0 = (const bf16_t*)(P.ws + WS_H);
  bf16_t* __restrict__ MIX = (bf16_t*)(P.ws + WS_MIX);
  const int tid = otid(), lane = tid & 63, wid = __builtin_amdgcn_readfirstlane(tid >> 6), g = lane >> 4, i = lane & 15;
  const int t0 = sb * 64;
  int trow[2]; bf16x8 qf[2][2];
  const int hh = grp * 4 + (i & 3);
  const float slope2 = exp2f(-(float)(hh + 1)) * LOG2E;
  const bf16_t* __restrict__ Hb = H0 + (size_t)b * S_ * P0;
#pragma unroll
  for (int rg = 0; rg < 2; ++rg) {
    trow[rg] = t0 + wid * 8 + rg * 4 + (i >> 2);
    const unsigned qo = (unsigned)trow[rg] * P0 + C_NQ + hh * 64 + 8 * g;
    qf[rg][0] = *(const bf16x8*)(Hb + qo); qf[rg][1] = *(const bf16x8*)(Hb + qo + 32);
  }
  LAS f32x4* stash = (LAS f32x4*)(lds + AT_STASH) + tid;
  f32x4 O[2][4]; float m[2], l[2];
  unsigned mlo[2], mhi[2];
#pragma unroll
  for (int rg = 0; rg < 2; ++rg) {
    float imp[1][16], carry[1], m1[1], l1[1]; f32x4 O1[1][4]; bf16x8 q1[1][2];
    q1[0][0] = qf[rg][0]; q1[0][1] = qf[rg][1];
    m1[0] = -1e30f; l1[0] = 0.f; carry[0] = 0.f;
#pragma unroll
    for (int k = 0; k < 16; ++k) imp[0][k] = 0.f;
#pragma unroll
    for (int dt = 0; dt < 4; ++dt) O1[0][dt] = (f32x4){0.f, 0.f, 0.f, 0.f};
    const int ntc = ((4 * sb + 2) >> 6) + 1;
    const bf16_t* Kg = (const bf16_t*)(P.ws + WS_KCB) + (size_t)(b * 2 + grp) * 256 * 64;
    const bf16_t* Vg = (const bf16_t*)(P.ws + WS_VCB) + (size_t)(b * 2 + grp) * 256 * 64;
    at_stage_dma(lds, Kg, Vg, 64, lane, wid);
    __syncthreads();
#pragma unroll
    for (int tile = 0; tile < 4; ++tile) {
      if (tile < ntc) {
        if (tile + 1 < ntc) at_stage_dma(lds + ((tile + 1) & 1) * AT_BUF, Kg + (tile + 1) * 4096, Vg + (tile + 1) * 4096, 64, lane, wid);
        LAS const unsigned char* buf = lds + (tile & 1) * AT_BUF;
        float base[1], soff[1]; int lim[1], lo[1];
        const int nlim = trow[rg] >= 31 ? ((trow[rg] - 31) >> 4) : -1;
        base[0] = slope2 * (float)(16 * (64 * tile + 4 * g) + 31 - trow[rg]);
        soff[0] = 16.f * slope2; lim[0] = nlim - 64 * tile - 4 * g; lo[0] = -1000000;
        if (tile == 0) at_tile_x<1, true, 0>(buf, q1, O1, m1, l1, base, soff, lim, lo, lane, imp, carry);
        else if (tile == 1) at_tile_x<1, true, 1>(buf, q1, O1, m1, l1, base, soff, lim, lo, lane, imp, carry);
        else if (tile == 2) at_tile_x<1, true, 2>(buf, q1, O1, m1, l1, base, soff, lim, lo, lane, imp, carry);
        else at_tile_x<1, true, 3>(buf, q1, O1, m1, l1, base, soff, lim, lo, lane, imp, carry);
        __syncthreads();
      }
    }
    {
      float lt = l1[0]; lt = xsum<16>(lt); lt = xsum<32>(lt);
      const float inv = lt > 0.f ? 1.f / lt : 0.f;
      const float g0 = sigmoid_f(bf2f(Hb[(unsigned)trow[rg] * P0 + C_NG + hh * 3 + 0]));
#pragma unroll
      for (int dt = 0; dt < 4; ++dt) stash[(rg * 4 + dt) * 512] = O1[0][dt] * (g0 * inv);
      if (sb < 16) { mlo[rg] = (1u << (sb + 1)) - 1u; mhi[rg] = 0u; }
      else {
        float key[16];
#pragma unroll
        for (int k = 0; k < 16; ++k) {
          float v = imp[0][k] * inv; v = xsum<1>(v); v = xsum<2>(v);
          const int sidx = 4 * k + g;
          const bool forced = (sidx == 0) || (sidx == sb) || (sidx == sb - 1);
          key[k] = (sidx <= sb) ? (forced ? 1e9f : v) : -1e30f;
        }
        const int j = i & 3;
        float mykey[4]; int mys[4], rank[4];
#pragma unroll
        for (int q = 0; q < 4; ++q) {
          mykey[q] = j == 0 ? key[q] : (j == 1 ? key[4 + q] : (j == 2 ? key[8 + q] : key[12 + q]));
          mys[q] = 4 * (4 * j + q) + g; rank[q] = 0;
        }
#pragma unroll 1
        for (int gg = 0; gg < 4; ++gg)
#pragma unroll
          for (int kk = 0; kk < 16; ++kk) {
            const float other = __uint_as_float(__builtin_amdgcn_ds_bpermute((gg * 16 + i) << 2, __float_as_uint(key[kk])));
            const int sp = 4 * kk + gg;
#pragma unroll
            for (int q = 0; q < 4; ++q) rank[q] += (other > mykey[q] || (other == mykey[q] && sp < mys[q])) ? 1 : 0;
          }
        unsigned a = 0u, bb = 0u;
#pragma unroll
        for (int q = 0; q < 4; ++q) if (rank[q] < 16 && mys[q] <= sb) { if (mys[q] < 32) a |= 1u << mys[q]; else bb |= 1u << (mys[q] - 32); }
        a = xorr<1>(a); bb = xorr<1>(bb); a = xorr<2>(a); bb = xorr<2>(bb);
        a = xorr<16>(a); bb = xorr<16>(bb); a = xorr<32>(a); bb = xorr<32>(bb);
        mlo[rg] = a; mhi[rg] = bb;
      }
    }
  }
  {
    unsigned ua = mlo[0] | mlo[1], ub = mhi[0] | mhi[1];
    ua = xorr<4>(ua); ub = xorr<4>(ub); ua = xorr<8>(ua); ub = xorr<8>(ub);
    LAS unsigned* misc = (LAS unsigned*)(lds + AT_MISC);
    if (lane == 0) { misc[2 * wid] = ua; misc[2 * wid + 1] = ub; }
    __syncthreads();
    ua = 0u; ub = 0u;
#pragma unroll
    for (int w = 0; w < 8; ++w) { ua |= misc[2 * w]; ub |= misc[2 * w + 1]; }
    unsigned long long rem = ((unsigned long long)(unsigned)__builtin_amdgcn_readfirstlane(ub) << 32) | (unsigned)__builtin_amdgcn_readfirstlane(ua);
    const int nt = __builtin_popcountll(rem);
#pragma unroll
    for (int rg = 0; rg < 2; ++rg) { m[rg] = -1e30f; l[rg] = 0.f;
#pragma unroll
      for (int dt = 0; dt < 4; ++dt) O[rg][dt] = (f32x4){0.f, 0.f, 0.f, 0.f}; }
    const bf16_t* Kg = Hb + C_KSEL + grp * 64;
    const bf16_t* Vg = Hb + C_VSEL + grp * 64;
    int blk = __builtin_ctzll(rem); rem &= rem - 1;
    at_stage_dma(lds, Kg + (size_t)blk * 64 * P0, Vg + (size_t)blk * 64 * P0, P0, lane, wid);
    __syncthreads();
    for (int ti = 0; ti < nt; ++ti) {
      const int cblk = blk;
      if (ti + 1 < nt) { blk = __builtin_ctzll(rem); rem &= rem - 1;
        at_stage_dma(lds + ((ti + 1) & 1) * AT_BUF, Kg + (size_t)blk * 64 * P0, Vg + (size_t)blk * 64 * P0, P0, lane, wid); }
      LAS const unsigned char* buf = lds + (ti & 1) * AT_BUF;
      float base[2], soff[2]; int lim[2], lo[2];
#pragma unroll
      for (int rg = 0; rg < 2; ++rg) {
        const bool rs = cblk < 32 ? ((mlo[rg] >> cblk) & 1u) : ((mhi[rg] >> (cblk - 32)) & 1u);
        base[rg] = rs ? slope2 * (float)(cblk * 64 + 4 * g - trow[rg]) : -INFINITY;
        soff[rg] = slope2; lim[rg] = trow[rg] - cblk * 64 - 4 * g; lo[rg] = -1000000;
      }
      if (cblk == sb) at_tile<2, true>(buf, qf, O, m, l, base, soff, lim, lo, lane);
      else at_tile<2, false>(buf, qf, O, m, l, base, soff, lim, lo, lane);
      __syncthreads();
    }
#pragma unroll
    for (int rg = 0; rg < 2; ++rg) {
      float lt = l[rg]; lt = xsum<16>(lt); lt = xsum<32>(lt);
      const float g1 = sigmoid_f(bf2f(Hb[(unsigned)trow[rg] * P0 + C_NG + hh * 3 + 1]));
#pragma unroll
      for (int dt = 0; dt < 4; ++dt) stash[(rg * 4 + dt) * 512] += O[rg][dt] * (g1 / lt);
    }
  }
  {
    const int b0 = sb >= 8 ? sb - 8 : 0;
    const int nt = sb - b0 + 1;
#pragma unroll
    for (int rg = 0; rg < 2; ++rg) { m[rg] = -1e30f; l[rg] = 0.f;
#pragma unroll
      for (int dt = 0; dt < 4; ++dt) O[rg][dt] = (f32x4){0.f, 0.f, 0.f, 0.f}; }
    const bf16_t* Kg = Hb + C_KWIN + grp * 64;
    const bf16_t* Vg = Hb + C_VWIN + grp * 64;
    at_stage_dma(lds, Kg + (size_t)b0 * 64 * P0, Vg + (size_t)b0 * 64 * P0, P0, lane, wid);
    __syncthreads();
    for (int ti = 0; ti < nt; ++ti) {
      const int cblk = b0 + ti;
      if (ti + 1 < nt) at_stage_dma(lds + ((ti + 1) & 1) * AT_BUF, Kg + (size_t)(cblk + 1) * 64 * P0, Vg + (size_t)(cblk + 1) * 64 * P0, P0, lane, wid);
      LAS const unsigned char* buf = lds + (ti & 1) * AT_BUF;
      float base[2], soff[2]; int lim[2], lo[2];
#pragma unroll
      for (int rg = 0; rg < 2; ++rg) {
        base[rg] = slope2 * (float)(cblk * 64 + 4 * g - trow[rg]);
        soff[rg] = slope2; lim[rg] = trow[rg] - cblk * 64 - 4 * g; lo[rg] = trow[rg] - 511 - cblk * 64 - 4 * g;
      }
      if (cblk == sb || cblk == sb - 8) at_tile<2, true>(buf, qf, O, m, l, base, soff, lim, lo, lane);
      else at_tile<2, false>(buf, qf, O, m, l, base, soff, lim, lo, lane);
      __syncthreads();
    }
  }
#pragma unroll
  for (int rg = 0; rg < 2; ++rg) {
    float lt = l[rg]; lt = xsum<16>(lt); lt = xsum<32>(lt);
    const unsigned ro = (unsigned)trow[rg] * P0;
    const float g2 = sigmoid_f(bf2f(Hb[ro + C_NG + hh * 3 + 2])) / lt;
#pragma unroll
    for (int dt = 0; dt < 4; ++dt) {
      const int dv = 16 * dt + 4 * g;
      const ushort4 zz = *(const ushort4*)(Hb + ro + C_NZ + hh * 64 + dv);
      const f32x4 ov = stash[(rg * 4 + dt) * 512] + O[rg][dt] * g2;
      ushort4 o4;
      o4.x = f2bf(ov[0] * silu_f(bf2f(zz.x))); o4.y = f2bf(ov[1] * silu_f(bf2f(zz.y)));
      o4.z = f2bf(ov[2] * silu_f(bf2f(zz.z))); o4.w = f2bf(ov[3] * silu_f(bf2f(zz.w)));
      *(ushort4*)(MIX + (size_t)b * S_ * D_ + (unsigned)trow[rg] * D_ + hh * 64 + dv) = o4;
    }
  }
}

__device__ __forceinline__ void gla_gate_phase(const Params& P) {
  const bf16_t* H1 = (const bf16_t*)(P.ws + WS_H);
  float* G = (float*)(P.ws + WS_G);
  const float* w2 = P.in[10]; const float* gb = P.in[11];
  const size_t total = (size_t)M_ * 512;
  for (size_t i = (size_t)blockIdx.x * 512 + otid(); i < total; i += (size_t)gridDim.x * 512) {
    const int c = (int)(i & 511); const size_t row = i >> 9;
    float x = gb[c];
#pragma unroll
    for (int r = 0; r < 16; ++r) x += bf2f(H1[row * P1 + G_LR + r]) * w2[r * 512 + c];
    const float ls = fminf(x, 0.f) - log1pf(__expf(-fabsf(x)));
    G[i] = ls * (1.f / 16.f);
  }
}
__device__ __forceinline__ void gla_scan_vblock(const Params& P, int vb) {
  const bf16_t* __restrict__ H1 = (const bf16_t*)(P.ws + WS_H);
  const float* __restrict__ G = (const float*)(P.ws + WS_G);
  bf16_t* __restrict__ O = (bf16_t*)(P.ws + WS_XB);
  const int tid = otid(), lane = tid & 63, wid = tid >> 6;
  const int eh = vb & 1, h = (vb >> 1) & 3, b = vb >> 3;
  const int e = eh * 128 + wid * 16 + (lane >> 2), dq = lane & 3;
  float St[32];
#pragma unroll
  for (int i = 0; i < 32; ++i) St[i] = 0.f;
  const float qscale = 0.08838834764831845f;
  for (int t = 0; t < S_; ++t) {
    const size_t row = (size_t)b * S_ + t;
    const float4* gr = (const float4*)(G + row * 512 + h * 128 + dq * 32);
    const uint4* kr = (const uint4*)(H1 + row * P1 + G_K + h * 128 + dq * 32);
    const uint4* qr = (const uint4*)(H1 + row * P1 + G_Q + h * 128 + dq * 32);
    const float v = bf2f(H1[row * P1 + G_V + h * 256 + e]);
    float o = 0.f;
#pragma unroll
    for (int c = 0; c < 4; ++c) {
      const uint4 ku = kr[c], qu = qr[c];
      const float4 g0 = gr[2 * c], g1 = gr[2 * c + 1];
      const float kk[8] = {__uint_as_float(ku.x << 16), __uint_as_float(ku.x & 0xffff0000u), __uint_as_float(ku.y << 16), __uint_as_float(ku.y & 0xffff0000u),
                           __uint_as_float(ku.z << 16), __uint_as_float(ku.z & 0xffff0000u), __uint_as_float(ku.w << 16), __uint_as_float(ku.w & 0xffff0000u)};
      const float qq[8] = {__uint_as_float(qu.x << 16), __uint_as_float(qu.x & 0xffff0000u), __uint_as_float(qu.y << 16), __uint_as_float(qu.y & 0xffff0000u),
                           __uint_as_float(qu.z << 16), __uint_as_float(qu.z & 0xffff0000u), __uint_as_float(qu.w << 16), __uint_as_float(qu.w & 0xffff0000u)};
      const float gg[8] = {g0.x, g0.y, g0.z, g0.w, g1.x, g1.y, g1.z, g1.w};
#pragma unroll
      for (int i = 0; i < 8; ++i) {
        const float a = __expf(gg[i]);
        St[c * 8 + i] = a * St[c * 8 + i] + kk[i] * v;
        o += qq[i] * St[c * 8 + i];
      }
    }
    o = xsum<1>(o); o = xsum<2>(o);
    if (dq == 0) O[row * D_ + h * 256 + e] = f2bf(o * qscale);
  }
}

constexpr size_t WS_QT = WS_G;
constexpr size_t WS_KH = WS_G + 16 * MiB;
constexpr size_t WS_ATT = 190 * MiB;
constexpr size_t WS_DEC = 199 * MiB;
__device__ __forceinline__ int kperm(int x) { const int dl = x & 31, hi = dl >> 4, d2 = dl & 15; return (x & ~31) + 8 * (d2 >> 2) + 4 * hi + (d2 & 3); }

__device__ __forceinline__ void gla_prep_item(const Params& P, int item, unsigned char* smem_g) {
  const bf16_t* __restrict__ H1 = (const bf16_t*)(P.ws + WS_H);
  bf16_t* __restrict__ QT = (bf16_t*)(P.ws + WS_QT) + (size_t)item * 8192;
  bf16_t* __restrict__ KH = (bf16_t*)(P.ws + WS_KH) + (size_t)item * 8192;
  bf16_t* __restrict__ ATT = (bf16_t*)(P.ws + WS_ATT) + (size_t)item * 4096;
  float* __restrict__ DEC = (float*)(P.ws + WS_DEC) + (size_t)item * 128;
  const int tid = otid(), lane = tid & 63, wid = tid >> 6, g = lane >> 4, i = lane & 15;
  const int c = item & 63, h = (item >> 6) & 3, b = item >> 8;
  const size_t rowbase = (size_t)b * S_ + c * 64;
  float* glr = (float*)smem_g;
  float* tot = (float*)(smem_g + 4096);
  bf16_t* qs = (bf16_t*)(smem_g + 6144);
  bf16_t* ks = (bf16_t*)(smem_g + 6144 + 17408);
  const int d = tid & 127, ig = tid >> 7;
#pragma unroll
  for (int k = 0; k < 2; ++k) { const int e = tid + 512 * k; glr[e] = bf2f(H1[(rowbase + (e >> 4)) * P1 + G_LR + (e & 15)]); }
  float w[16];
#pragma unroll
  for (int r = 0; r < 16; ++r) w[r] = P.in[10][r * 512 + h * 128 + d];
  const float gb = P.in[11][h * 128 + d];
  __syncthreads();
  float bb[16]; float run = 0.f;
#pragma unroll
  for (int k = 0; k < 16; ++k) {
    const float* gr = glr + (16 * ig + k) * 16;
    float x = gb;
#pragma unroll
    for (int r = 0; r < 16; ++r) x += gr[r] * w[r];
    const float la = (fminf(x, 0.f) - log1pf(__expf(-fabsf(x)))) * (1.f / 16.f);
    run += la; bb[k] = run;
  }
  tot[ig * 128 + d] = run;
  __syncthreads();
  float off = 0.f, total = 0.f;
#pragma unroll
  for (int q = 0; q < 4; ++q) { const float tv = tot[q * 128 + d]; total += tv; if (q < ig) off += tv; }
  const float qscale = 0.08838834764831845f;
  const int dp = kperm(d);
#pragma unroll
  for (int k = 0; k < 16; ++k) {
    const int r = 16 * ig + k;
    const float bv = bb[k] + off;
    const float qv = bf2f(H1[(rowbase + r) * P1 + G_Q + h * 128 + d]), kv = bf2f(H1[(rowbase + r) * P1 + G_K + h * 128 + d]);
    const float eb = __expf(bv);
    const bf16_t qt = f2bf(qv * eb * qscale), kt = f2bf(kv * __expf(-bv)), kh = f2bf(kv * __expf(total - bv));
    qs[r * 136 + d] = qt; ks[r * 136 + d] = kt;
    QT[r * 128 + dp] = qt; KH[r * 128 + d] = kh;
  }
  if (ig == 0) DEC[d] = __expf(total);
  __syncthreads();
  {
    const int it = wid >> 1, jt0 = 2 * (wid & 1);
    f32x4 acc[2] = {(f32x4){0.f, 0.f, 0.f, 0.f}, (f32x4){0.f, 0.f, 0.f, 0.f}};
#pragma unroll
    for (int kk = 0; kk < 4; ++kk) {
      const bf16x8 a = *(const bf16x8*)(qs + (16 * it + i) * 136 + 32 * kk + 8 * g);
#pragma unroll
      for (int n = 0; n < 2; ++n) {
        const bf16x8 bf = *(const bf16x8*)(ks + (16 * (jt0 + n) + i) * 136 + 32 * kk + 8 * g);
        acc[n] = __builtin_amdgcn_mfma_f32_16x16x32_bf16(a, bf, acc[n], 0, 0, 0);
      }
    }
#pragma unroll
    for (int n = 0; n < 2; ++n)
#pragma unroll
      for (int r = 0; r < 4; ++r) {
        const int ri = 16 * it + 4 * g + r, cj = 16 * (jt0 + n) + i;
        ATT[ri * 64 + kperm(cj)] = f2bf(cj <= ri ? acc[n][r] : 0.f);
      }
  }
  __syncthreads();
}

constexpr int GS_Q = 0, GS_K = 16384, GS_V = 32768, GS_A = 49152, GS_BYTES = 57344;
__device__ __forceinline__ void gla_stage_dma(LAS unsigned char* st, const Params& P, int item, size_t rowbase, int h, int eh, int lane, int wid) {
  const bf16_t* QT = (const bf16_t*)(P.ws + WS_QT) + (size_t)item * 8192;
  const bf16_t* KH = (const bf16_t*)(P.ws + WS_KH) + (size_t)item * 8192;
  const bf16_t* ATT = (const bf16_t*)(P.ws + WS_ATT) + (size_t)item * 4096;
  const bf16_t* V = (const bf16_t*)(P.ws + WS_H) + rowbase * P1 + G_V + h * 256 + eh * 128;
#pragma unroll
  for (int n = 0; n < 2; ++n) {
    const int q = 2 * wid + n;
    { const int row = 4 * q + (lane >> 4), ch = (lane & 15) ^ (row & 15);
      __builtin_amdgcn_global_load_lds((const unsigned*)(QT + row * 128 + ch * 8), (LAS unsigned*)(st + GS_Q + q * 1024), 16, 0, 0); }
    { const int dt = q >> 1, j = 32 * (q & 1) + (lane >> 1);
      __builtin_amdgcn_global_load_lds((const unsigned*)(KH + j * 128 + dt * 16 + (lane & 1) * 8), (LAS unsigned*)(st + GS_K + q * 1024), 16, 0, 0);
      __builtin_amdgcn_global_load_lds((const unsigned*)(V + (unsigned)j * P1 + dt * 16 + (lane & 1) * 8), (LAS unsigned*)(st + GS_V + q * 1024), 16, 0, 0); }
  }
  { const int row = 8 * wid + (lane >> 3), ch = (lane & 7) ^ ((row >> 1) & 7);
    __builtin_amdgcn_global_load_lds((const unsigned*)(ATT + row * 64 + ch * 8), (LAS unsigned*)(st + GS_A + wid * 1024), 16, 0, 0); }
}
__device__ __forceinline__ void gla_chain(const Params& P, int chain, unsigned char* smem_g) {
  LAS unsigned char* lds = (LAS unsigned char*)smem_g;
  bf16_t* __restrict__ O = (bf16_t*)(P.ws + WS_XB);
  const int tid = otid(), lane = tid & 63, wid = __builtin_amdgcn_readfirstlane(tid >> 6), g = lane >> 4, i = lane & 15;
  const int eh = chain & 1, h = (chain >> 1) & 3, b = chain >> 3;
  const int item0 = (b * 4 + h) * 64;
  f32x4 S[8];
#pragma unroll
  for (int dt = 0; dt < 8; ++dt) S[dt] = (f32x4){0.f, 0.f, 0.f, 0.f};
  gla_stage_dma(lds, P, item0, (size_t)b * S_, h, eh, lane, wid);
  __syncthreads();
  for (int c = 0; c < 64; ++c) {
    if (c + 1 < 64) gla_stage_dma(lds + ((c + 1) & 1) * GS_BYTES, P, item0 + c + 1, (size_t)b * S_ + (c + 1) * 64, h, eh, lane, wid);
    LAS const unsigned char* st = lds + (c & 1) * GS_BYTES;
    const float* DEC = (const float*)(P.ws + WS_DEC) + (size_t)(item0 + c) * 128;
    f32x4 dc[8];
#pragma unroll
    for (int dt = 0; dt < 8; ++dt) dc[dt] = *(const f32x4*)(DEC + 16 * dt + 4 * g);
    u32x4 spk[4];
#pragma unroll
    for (int kk = 0; kk < 4; ++kk) {
      spk[kk][0] = cvtpk(S[2 * kk][0], S[2 * kk][1]); spk[kk][1] = cvtpk(S[2 * kk][2], S[2 * kk][3]);
      spk[kk][2] = cvtpk(S[2 * kk + 1][0], S[2 * kk + 1][1]); spk[kk][3] = cvtpk(S[2 * kk + 1][2], S[2 * kk + 1][3]);
    }
    bf16x8 vf[2];
    {
      LAS const unsigned char* vb = st + GS_V + wid * 2048 + (4 * g + (i >> 2)) * 32 + (i & 3) * 8;
#pragma unroll
      for (int k2 = 0; k2 < 2; ++k2) {
        const s16x4 v0 = vtr(vb + k2 * 1024), v1 = vtr(vb + k2 * 1024 + 512);
        vf[k2] = (bf16x8){v0[0], v0[1], v0[2], v0[3], v1[0], v1[1], v1[2], v1[3]};
      }
    }
#pragma unroll
    for (int it = 0; it < 4; ++it) {
      f32x4 acc = (f32x4){0.f, 0.f, 0.f, 0.f};
      LAS const unsigned char* qrow = st + GS_Q + (16 * it + i) * 256;
#pragma unroll
      for (int kk = 0; kk < 4; ++kk) {
        const bf16x8 a = *(LAS const bf16x8*)(qrow + (((4 * kk + g) ^ i) << 4));
        acc = __builtin_amdgcn_mfma_f32_16x16x32_bf16(a, __builtin_bit_cast(bf16x8, spk[kk]), acc, 0, 0, 0);
      }
      LAS const unsigned char* arow = st + GS_A + (16 * it + i) * 128;
#pragma unroll
      for (int k2 = 0; k2 < 2; ++k2) {
        const bf16x8 a = *(LAS const bf16x8*)(arow + (((4 * k2 + g) ^ ((i >> 1) & 7)) << 4));
        acc = __builtin_amdgcn_mfma_f32_16x16x32_bf16(a, vf[k2], acc, 0, 0, 0);
      }
      bf16_t* op = O + ((size_t)b * S_ + c * 64 + 16 * it + 4 * g) * D_ + h * 256 + eh * 128 + 16 * wid + i;
#pragma unroll
      for (int r = 0; r < 4; ++r) op[(size_t)r * D_] = f2bf(acc[r]);
    }
#pragma unroll
    for (int dt = 0; dt < 8; ++dt) {
      S[dt] = S[dt] * dc[dt];
      LAS const unsigned char* kb = st + GS_K + dt * 2048 + (4 * g + (i >> 2)) * 32 + (i & 3) * 8;
#pragma unroll
      for (int k2 = 0; k2 < 2; ++k2) {
        const s16x4 k0 = vtr(kb + k2 * 1024), k1 = vtr(kb + k2 * 1024 + 512);
        const bf16x8 kf = (bf16x8){k0[0], k0[1], k0[2], k0[3], k1[0], k1[1], k1[2], k1[3]};
        S[dt] = __builtin_amdgcn_mfma_f32_16x16x32_bf16(kf, vf[k2], S[dt], 0, 0, 0);
      }
    }
    __syncthreads();
  }
}

__device__ __forceinline__ void gla_norm_phase(const Params& P) {
  const bf16_t* H1 = (const bf16_t*)(P.ws + WS_H);
  const bf16_t* O = (const bf16_t*)(P.ws + WS_XB);
  bf16_t* MIX = (bf16_t*)(P.ws + WS_MIX);
  const float* gn = P.in[12];
  const int lane = otid() & 63, wid = otid() >> 6;
  for (int it = blockIdx.x * 8 + wid; it < M_ * 4; it += gridDim.x * 8) {
    const int h = it & 3; const size_t row = it >> 2;
    float v[4]; float ss = 0.f;
#pragma unroll
    for (int k = 0; k < 4; ++k) { v[k] = bf2f(O[row * D_ + h * 256 + k * 64 + lane]); ss += v[k] * v[k]; }
    const float r = 1.f / sqrtf(wave_sum(ss) * (1.f / 256.f) + LN_EPS);
#pragma unroll
    for (int k = 0; k < 4; ++k) {
      const int c = h * 256 + k * 64 + lane;
      const float z = bf2f(H1[row * P1 + G_Z + c]);
      MIX[row * D_ + c] = f2bf(v[k] * r * gn[c] * silu_f(z));
    }
  }
}

#define XB_TMO      128
#define XB_XCNT(j)  (256  + 64 * (j))
#define XB_XSUB(j)  (1280 + 64 * (j))
#define XB_XGEN(j)  (2304 + 64 * (j))
#define XB_TOP      3328
#define XB_TOPGEN   3392
#define XCD_BAR_WORDS 3456
#define XB_SPIN_CAP (1u << 18)

__device__ __forceinline__ unsigned xb_ld(unsigned* p)              { return __hip_atomic_load(p, __ATOMIC_RELAXED, __HIP_MEMORY_SCOPE_AGENT); }
__device__ __forceinline__ unsigned xb_add(unsigned* p, unsigned v) { return __hip_atomic_fetch_add(p, v, __ATOMIC_RELAXED, __HIP_MEMORY_SCOPE_AGENT); }
__device__ __forceinline__ unsigned xb_xcc_id() { return (unsigned)__builtin_amdgcn_s_getreg((3 << 11) | 20) & 0xFu; }
#define XB_SPIN(cond, bar) do { unsigned _sp = 0; while (cond) { __builtin_amdgcn_s_sleep(1); \
    if ((++_sp & 255u) == 0u) { if (xb_ld(&(bar)[XB_TMO])) break; if (_sp > XB_SPIN_CAP) { atomicAdd(&(bar)[XB_TMO], 1u); break; } } } } while (0)

struct XcdBarrier {
    unsigned* bar; unsigned x;
    volatile LAS unsigned* st;
};

__device__ __forceinline__ XcdBarrier xcd_barrier_post(unsigned* bar, volatile LAS unsigned* st) {
    XcdBarrier b; b.bar = bar; b.x = xb_xcc_id(); b.st = st;
    if (threadIdx.x == 0) (void)xb_add(&bar[XB_XCNT(b.x)], 1u);
    return b;
}
__device__ __forceinline__ void xcd_barrier_complete(unsigned* bar, unsigned x, unsigned& nloc, unsigned& nx) {
    const unsigned G = gridDim.x * gridDim.y * gridDim.z;
    unsigned sum, cnt, mine, sp = 0u;
    for (;;) {
        sum = 0u; cnt = 0u; mine = 0u;
#pragma unroll
        for (unsigned j = 0; j < 16; ++j) { const unsigned c = xb_ld(&bar[XB_XCNT(j)]); sum += c; cnt += (c > 0u) ? 1u : 0u; mine = (j == x) ? c : mine; }
        if (sum == G) break;
        __builtin_amdgcn_s_sleep(1);
        if ((++sp & 255u) == 0u) { if (xb_ld(&bar[XB_TMO])) break; if (sp > XB_SPIN_CAP) { atomicAdd(&bar[XB_TMO], 1u); break; } }
    }
    nloc = mine > 0u ? mine : 1u; nx = cnt > 0u ? cnt : 1u;
}

__device__ __forceinline__ void xcd_barrier(const XcdBarrier& b) {
    asm volatile("s_waitcnt vmcnt(0)" ::: "memory");
    __syncthreads();
    if (threadIdx.x == 0) {
        unsigned* bar = b.bar;
        __builtin_amdgcn_s_waitcnt(0);
        unsigned nloc = b.st[0], nx = b.st[1];
        if (nloc == 0u) { xcd_barrier_complete(bar, b.x, nloc, nx); b.st[0] = nloc; b.st[1] = nx; }
        const unsigned old = xb_add(&bar[XB_XSUB(b.x)], 1u);
        const unsigned gen = old / nloc;
        if (old + 1u == (gen + 1u) * nloc) {
            __builtin_amdgcn_fence(__ATOMIC_RELEASE, "agent");
            asm volatile("s_waitcnt vmcnt(0)" ::: "memory");
            const unsigned og = xb_add(&bar[XB_TOP], 1u);
            const unsigned tg = og / nx;
            if (og + 1u == (tg + 1u) * nx) xb_add(&bar[XB_TOPGEN], 1u);
            else XB_SPIN(xb_ld(&bar[XB_TOPGEN]) == tg, bar);
            __builtin_amdgcn_fence(__ATOMIC_ACQUIRE, "agent");
            xb_add(&bar[XB_XGEN(b.x)], 1u);
            asm volatile("s_waitcnt vmcnt(0)" ::: "memory");
        } else {
            XB_SPIN(xb_ld(&bar[XB_XGEN(b.x)]) == gen, bar);
            __builtin_amdgcn_fence(__ATOMIC_ACQUIRE, "agent");
            asm volatile("s_waitcnt vmcnt(0)" ::: "memory");
        }
    }
    __syncthreads();
}


#ifndef REP_P0
#define REP_P0 1
#endif
#ifndef REP_P2
#define REP_P2 1
#endif
#ifndef REP_P3
#define REP_P3 1
#endif
#ifndef REP_P7
#define REP_P7 1
#endif
#ifndef REP_P8
#define REP_P8 1
#endif
__global__ void __launch_bounds__(512) fwd_megakernel(Params P) {
  cg::grid_group grid = cg::this_grid();
  extern __shared__ __attribute__((aligned(16))) unsigned char smem[];
  const int tid = otid(), lane = tid & 63, wid = tid >> 6;
  unsigned char* ws = P.ws;
  bf16_t* XB = (bf16_t*)(ws + WS_XB);
  bf16_t* MIX = (bf16_t*)(ws + WS_MIX);
  bf16_t* Hb = (bf16_t*)(ws + WS_H);
  float* Y = (float*)(ws + WS_H);
  volatile LAS unsigned* xst = (volatile LAS unsigned*)((LAS unsigned char*)smem + XB_LDS_OFF);
  if (tid < 4) xst[tid] = 0u;
  __syncthreads();
  (void)xcd_barrier_post((unsigned*)ws, xst);
#define GRID_BAR() do { XcdBarrier xb_; xb_.bar = (unsigned*)P.ws; xb_.x = xb_xcc_id(); xb_.st = (volatile LAS unsigned*)((LAS unsigned char*)smem + XB_LDS_OFF); xcd_barrier(xb_); } while (0)

  for (int rep = 0; rep < REP_P0; ++rep) {
    const float4* x4 = (const float4*)P.in[0];
    const size_t n4 = (size_t)M_ * D_ / 4;
    for (size_t i = (size_t)blockIdx.x * 512 + tid; i < n4; i += (size_t)gridDim.x * 512) {
      const float4 v = x4[i]; ushort4 o; o.x = f2bf(v.x); o.y = f2bf(v.y); o.z = f2bf(v.z); o.w = f2bf(v.w);
      ((ushort4*)XB)[i] = o;
    }
    constexpr int T0 = (P0 / 64) * 16, T1 = 16 * 16, T2 = (P1 / 64) * 16, T3 = 16 * 16;
    for (int it = blockIdx.x; it < T0 + T1 + T2 + T3; it += gridDim.x) {
      int r = it;
      if (r < T0) { transpose_tile(P.in[1], D_, EVEN_IN, (bf16_t*)(ws + WS_WT0), 0, r, P0 / 64, (float*)smem); continue; } r -= T0;
      if (r < T1) { transpose_tile(P.in[6], D_, D_, (bf16_t*)(ws + WS_WO0), 2, r, 16, (float*)smem); continue; } r -= T1;
      if (r < T2) { transpose_tile(P.in[9], D_, ODD_IN, (bf16_t*)(ws + WS_WT1), 1, r, P1 / 64, (float*)smem); continue; } r -= T2;
      transpose_tile(P.in[13], D_, D_, (bf16_t*)(ws + WS_WO1), 2, r, 16, (float*)smem);
    }
    for (int it = blockIdx.x; it < 2 * 64 + 2 * 2 + 64; it += gridDim.x) {
      if (it < 128) { const int i = it >> 6; transpose_tile(P.in[3] + (size_t)i * 2048 * 128, 2048, 128, (bf16_t*)(ws + WS_W1T) + (size_t)i * 128 * 2048, 2, it & 63, 2, (float*)smem); }
      else if (it < 132) { const int i = (it - 128) >> 1; transpose_tile(P.in[5] + (size_t)i * 128 * 64, 128, 64, (bf16_t*)(ws + WS_W2T) + (size_t)i * 64 * 128, 2, (it - 128) & 1, 1, (float*)smem); }
      else {
        const int t2 = it - 132, i = t2 >> 5, q = t2 & 31, hh = tid & 127, sub = tid >> 7;
        const float* pos = P.in[2] + i * 2048 + q * 64 + sub * 16;
        const float* w1 = P.in[3] + ((size_t)i * 2048 + q * 64 + sub * 16) * 128 + hh;
        float a = 0.f;
#pragma unroll
        for (int f = 0; f < 16; ++f) a += pos[f] * w1[f * 128];
        float* red = (float*)smem;
        red[sub * 128 + hh] = a;
        __syncthreads();
        if (tid < 128) ((float*)(ws + WS_C1P))[(i * 32 + q) * 128 + tid] = (red[tid] + red[128 + tid]) + (red[256 + tid] + red[384 + tid]);
        __syncthreads();
      }
    }
    if (blockIdx.x == 0) { const int which = tid >> 8, r = tid & 255;
      unsigned* z = (unsigned*)(ws + (which == 0 ? (size_t)(248 * MiB) : (size_t)(249 * MiB)));
      const int bg = r >> 5, wd = r & 31; z[((size_t)bg * 256 + 255) * 32 + wd] = 0u; }
    grid.sync();
  }
  { pg8::Gemm gm{XB, (const bf16_t*)(ws + WS_WT0), M_, P0, D_}; pg8::StaticOrder so; so.init(M_, P0, (int)gridDim.x, (int)blockIdx.x);
    pg8::EpiBf16s ep{Hb, P0}; pg8::gemm_phase<pg8::EpiBf16s, pg8::StaticOrder, true, true>((LAS unsigned char*)smem, gm, so, ep); }
  GRID_BAR();
  for (int rep = 0; rep < REP_P2; ++rep) {
    for (int it = blockIdx.x; it < 256; it += gridDim.x) compress_mfma_tile(P, it, smem);
    for (int it = blockIdx.x; it < 64; it += gridDim.x) kmean_item2(P, it);
    GRID_BAR();
  }
  for (int rep = 0; rep < REP_P3; ++rep) {
    for (int it = blockIdx.x; it < 1024; it += gridDim.x) {
      const int lvl = it >> 4, r = it & 15;
      if (r < 8) nsa_mfma_item(P, r >> 1, r & 1, 63 - lvl, smem);
      else { const int q = (lvl << 3) + (r - 8); moba_mfma_item(P, (q & 31) >> 3, q & 7, 15 - (q >> 5), smem); }
    }
    GRID_BAR();
  }
  { pg8::Gemm gm{MIX, (const bf16_t*)(ws + WS_WO0), M_, D_, D_}; pg8::StaticOrder so; so.init(M_, D_, (int)gridDim.x, (int)blockIdx.x);
    pg8::EpiF32 ep{Y, D_}; pg8::gemm_phase<pg8::EpiF32, pg8::StaticOrder, true, true>((LAS unsigned char*)smem, gm, so, ep); }
  GRID_BAR();
  ln_phase(P.in[0], Y, P.in[7], P.in[8], P.out, XB);
  GRID_BAR();
  { pg8::Gemm gm{XB, (const bf16_t*)(ws + WS_WT1), M_, P1, D_}; pg8::StaticOrder so; so.init(M_, P1, (int)gridDim.x, (int)blockIdx.x);
    pg8::EpiBf16s ep{Hb, P1}; pg8::gemm_phase<pg8::EpiBf16s, pg8::StaticOrder, true, true>((LAS unsigned char*)smem, gm, so, ep); }
  GRID_BAR();
  for (int rep = 0; rep < REP_P7; ++rep) {
    for (int it = blockIdx.x; it < 1024; it += gridDim.x) gla_prep_item(P, it, smem);
    GRID_BAR();
  }
  for (int rep = 0; rep < REP_P8; ++rep) {
    for (int ch = blockIdx.x; ch < 32; ch += gridDim.x) gla_chain(P, ch, smem);
    GRID_BAR();
  }
  gla_norm_phase(P);
  GRID_BAR();
  { pg8::Gemm gm{MIX, (const bf16_t*)(ws + WS_WO1), M_, D_, D_}; pg8::StaticOrder so; so.init(M_, D_, (int)gridDim.x, (int)blockIdx.x);
    pg8::EpiF32 ep{Y, D_}; pg8::gemm_phase<pg8::EpiF32, pg8::StaticOrder, true, true>((LAS unsigned char*)smem, gm, so, ep); }
  GRID_BAR();
  ln_phase(P.out, Y, P.in[14], P.in[15], P.out, nullptr);
}

extern "C" void kernel_launch(void* const* d_in, const int* in_sizes, int n_in, void* d_out, int out_size,
                              void* d_ws, size_t ws_size, hipStream_t stream) {
  constexpr size_t kDynLds = 132096;
  static_assert(kDynLds >= (size_t)AT_LDS_END && kDynLds >= 2 * (size_t)GS_BYTES && kDynLds >= (size_t)pg8::STAGE_BYTES, "LDS");
  static int grid_blocks = 0;
  if (!grid_blocks) {
    int dev = 0, cus = 0, per_cu = 0;
    (void)hipGetDevice(&dev);
    (void)hipDeviceGetAttribute(&cus, hipDeviceAttributeMultiprocessorCount, dev);
    (void)hipFuncSetAttribute((const void*)fwd_megakernel, hipFuncAttributeMaxDynamicSharedMemorySize, (int)kDynLds);
    (void)hipOccupancyMaxActiveBlocksPerMultiprocessor(&per_cu, fwd_megakernel, 512, kDynLds);
    if (per_cu < 1) per_cu = 1;
    if (per_cu > 2) per_cu = 2;
    grid_blocks = cus * per_cu;
    if (n_in != 16 || ws_size < WS_END) { fprintf(stderr, "kernel_launch: unexpected n_in %d / ws %zu\n", n_in, ws_size); }
  }
  (void)hipMemsetAsync(d_ws, 0, 65536, stream);
  Params p{};
  for (int i = 0; i < 16; ++i) p.in[i] = (const float*)d_in[i];
  p.out = (float*)d_out; p.ws = (unsigned char*)d_ws;
  void* args[] = {&p};
  hipError_t e = hipLaunchCooperativeKernel((void*)fwd_megakernel, dim3(grid_blocks), dim3(512), args, kDynLds, stream);
  if (e != hipSuccess) fprintf(stderr, "cooperative launch failed: %s (grid %d)\n", hipGetErrorString(e), grid_blocks);
}
```

```cpp
#include <hip/hip_runtime.h>
#include <hip/hip_cooperative_groups.h>
#include <cstdio>
#include <cstdint>
namespace cg = cooperative_groups;

typedef unsigned short bf16_t;
typedef short bf16x8 __attribute__((ext_vector_type(8)));
typedef float f32x4 __attribute__((ext_vector_type(4)));
typedef unsigned u32x4 __attribute__((ext_vector_type(4)));

constexpr int B_ = 4, S_ = 4096, M_ = B_ * S_, D_ = 1024;
constexpr int P0 = 4096;
constexpr int P1 = 3328;
constexpr int EVEN_IN = 3864, ODD_IN = 3088;
constexpr int C_NQ = 0, C_KCMP = 512, C_VCMP = 640, C_KSEL = 768, C_VSEL = 896, C_KWIN = 1024, C_VWIN = 1152;
constexpr int C_NZ = 1280, C_MQ = 1792, C_MK = 2304, C_MV = 2816, C_MZ = 3328, C_NG = 3840;
constexpr int G_Q = 0, G_K = 512, G_V = 1024, G_Z = 2048, G_LR = 3072;
constexpr int NCMP = 255;
constexpr float ALPHA = 1.4142135623730951f;
constexpr float LN_EPS = 1e-5f;

constexpr size_t MiB = 1u << 20;
constexpr int XB_LDS_OFF = 132608;
constexpr size_t WS_WT0 = 1 * MiB;
constexpr size_t WS_WO0 = 9 * MiB;
constexpr size_t WS_WT1 = 11 * MiB;
constexpr size_t WS_WO1 = 18 * MiB;
constexpr size_t WS_XB = 20 * MiB;
constexpr size_t WS_MIX = 52 * MiB;
constexpr size_t WS_H = 84 * MiB;
constexpr size_t WS_G = 212 * MiB;
constexpr size_t WS_KC = 245 * MiB;
constexpr size_t WS_VC = 246 * MiB;
constexpr size_t WS_KM = 247 * MiB;
constexpr size_t WS_END = 256 * MiB;

struct Params { const float* in[16]; float* out; unsigned char* ws; };

__device__ __forceinline__ int otid() { int t = __builtin_amdgcn_workitem_id_x(); asm volatile("" : "+v"(t)); return t; }
__device__ __forceinline__ float bf2f(bf16_t v) { return __uint_as_float(((unsigned)v) << 16); }
__device__ __forceinline__ bf16_t f2bf(float f) { unsigned u = __float_as_uint(f); return (bf16_t)((u + 0x7fffu + ((u >> 16) & 1u)) >> 16); }
template <int M> __device__ __forceinline__ float xsum(float v) {
  if constexpr (M == 32) { auto rr = __builtin_amdgcn_permlane32_swap(__float_as_uint(v), __float_as_uint(v), false, false); return __uint_as_float(rr[0]) + __uint_as_float(rr[1]); }
  else return v + __int_as_float(__builtin_amdgcn_ds_swizzle(__float_as_int(v), (M << 10) | 0x1f));
}
template <int M> __device__ __forceinline__ float xmax(float v) {
  if constexpr (M == 32) { auto rr = __builtin_amdgcn_permlane32_swap(__float_as_uint(v), __float_as_uint(v), false, false); return fmaxf(__uint_as_float(rr[0]), __uint_as_float(rr[1])); }
  else return fmaxf(v, __int_as_float(__builtin_amdgcn_ds_swizzle(__float_as_int(v), (M << 10) | 0x1f)));
}
template <int M> __device__ __forceinline__ unsigned xorr(unsigned v) {
  if constexpr (M == 32) { auto rr = __builtin_amdgcn_permlane32_swap(v, v, false, false); return rr[0] | rr[1]; }
  else return v | (unsigned)__builtin_amdgcn_ds_swizzle((int)v, (M << 10) | 0x1f);
}
__device__ __forceinline__ float wave_sum(float v) { v = xsum<1>(v); v = xsum<2>(v); v = xsum<4>(v); v = xsum<8>(v); v = xsum<16>(v); return xsum<32>(v); }
__device__ __forceinline__ float wave_max(float v) { v = xmax<1>(v); v = xmax<2>(v); v = xmax<4>(v); v = xmax<8>(v); v = xmax<16>(v); return xmax<32>(v); }
__device__ __forceinline__ float silu_f(float z) { return z / (1.f + __expf(-z)); }
__device__ __forceinline__ float sigmoid_f(float z) { return 1.f / (1.f + __expf(-z)); }

__device__ __forceinline__ int colmap0(int c) {
  if (c < 1280) return c;
  if (c < 1792) return 1304 + (c - 1280);
  if (c < 3840) return 1816 + (c - 1792);
  if (c < 3864) return 1280 + (c - 3840);
  return -1;
}
__device__ __forceinline__ int colmap1(int c) {
  if (c < 2048) return c;
  if (c < 3072) return 2064 + (c - 2048);
  if (c < 3088) return 2048 + (c - 3072);
  return -1;
}

__device__ __forceinline__ void transpose_tile(const float* __restrict__ W, int K, int Nsrc, bf16_t* __restrict__ Wt, int which, int tile, int ntn, float* sm) {
  const int tid = otid();
  const int nb = tile % ntn, kb = tile / ntn, n0 = nb * 64, k0 = kb * 64;
#pragma unroll
  for (int i = 0; i < 8; ++i) {
    const int kk = i * 8 + (tid >> 6), nn = tid & 63;
    const int c = n0 + nn;
    const int src = which == 0 ? colmap0(c) : (which == 1 ? colmap1(c) : c);
    sm[kk * 65 + nn] = src >= 0 ? W[(size_t)(k0 + kk) * Nsrc + src] : 0.f;
  }
  __syncthreads();
#pragma unroll
  for (int i = 0; i < 8; ++i) {
    const int nn = i * 8 + (tid >> 6), kk = tid & 63;
    Wt[(size_t)(n0 + nn) * K + k0 + kk] = f2bf(sm[kk * 65 + nn]);
  }
  __syncthreads();
}

__device__ __forceinline__ void gemm_tile(const bf16_t* __restrict__ A, const bf16_t* __restrict__ Bt, int K, int m0, int n0, int mode, void* outp, int ldc, unsigned char* smem) {
  bf16_t* As = (bf16_t*)smem;
  bf16_t* Bs = As + 128 * 72;
  const int tid = otid(), lane = tid & 63, wid = tid >> 6, wm = wid >> 1, wn = wid & 1;
  f32x4 acc[2][4];
#pragma unroll
  for (int i = 0; i < 2; ++i)
#pragma unroll
    for (int j = 0; j < 4; ++j) acc[i][j] = (f32x4){0.f, 0.f, 0.f, 0.f};
  for (int k0 = 0; k0 < K; k0 += 64) {
#pragma unroll
    for (int i = 0; i < 2; ++i) {
      const int idx = tid + i * 512, r = idx >> 3, c = (idx & 7) * 8;
      *(uint4*)(As + r * 72 + c) = *(const uint4*)(A + (size_t)(m0 + r) * K + k0 + c);
      *(uint4*)(Bs + r * 72 + c) = *(const uint4*)(Bt + (size_t)(n0 + r) * K + k0 + c);
    }
    __syncthreads();
#pragma unroll
    for (int kk = 0; kk < 64; kk += 32) {
      bf16x8 a[2], b[4];
#pragma unroll
      for (int i = 0; i < 2; ++i) a[i] = *(const bf16x8*)(As + (wm * 32 + i * 16 + (lane & 15)) * 72 + kk + (lane >> 4) * 8);
#pragma unroll
      for (int j = 0; j < 4; ++j) b[j] = *(const bf16x8*)(Bs + (wn * 64 + j * 16 + (lane & 15)) * 72 + kk + (lane >> 4) * 8);
#pragma unroll
      for (int i = 0; i < 2; ++i)
#pragma unroll
        for (int j = 0; j < 4; ++j) acc[i][j] = __builtin_amdgcn_mfma_f32_16x16x32_bf16(a[i], b[j], acc[i][j], 0, 0, 0);
    }
    __syncthreads();
  }
#pragma unroll
  for (int i = 0; i < 2; ++i)
#pragma unroll
    for (int j = 0; j < 4; ++j)
#pragma unroll
      for (int r = 0; r < 4; ++r) {
        const int row = m0 + wm * 32 + i * 16 + (lane >> 4) * 4 + r, col = n0 + wn * 64 + j * 16 + (lane & 15);
        if (mode == 0) ((bf16_t*)outp)[(size_t)row * ldc + col] = f2bf(acc[i][j][r]);
        else ((float*)outp)[(size_t)row * ldc + col] = acc[i][j][r];
      }
}
__device__ __forceinline__ void gemm_phase(const bf16_t* A, const bf16_t* Bt, int K, int N, int mode, void* outp, int ldc, unsigned char* smem) {
  const int ntn = N / 128, ntm = M_ / 128;
  for (int t = blockIdx.x; t < ntn * ntm; t += gridDim.x) {
    const int tn = t % ntn, tm = t / ntn;
    gemm_tile(A, Bt, K, tm * 128, tn * 128, mode, outp, ldc, smem);
  }
}

namespace pg8 {
#define PG8_LAS __attribute__((address_space(3)))
typedef unsigned short bf16_t;
typedef short bf16x8 __attribute__((ext_vector_type(8)));
typedef float f32x4 __attribute__((ext_vector_type(4)));
typedef unsigned u32x4 __attribute__((ext_vector_type(4)));
constexpr int BM = 256, BK = 64, HALF = 128, HTB = HALF * BK * 2  , STAGE_BYTES = 8 * HTB, NXCD = 8, WGM = 8;

__host__ __device__ __forceinline__ int lds_byte(int r, int c) { const int st = (r >> 4) * 2 + (c >> 5), rr = r & 15, cc = c & 31, ob = rr * 64 + cc * 2; return st * 1024 + (ob ^ (((ob >> 9) & 1) << 5)); }
__host__ __device__ __forceinline__ void stage_rc(int b, int& R, int& C) { const int st = b / 1024, sb = b % 1024, swz = sb ^ (((sb >> 9) & 1) << 5); R = (st >> 1) * 16 + swz / 64; C = (st & 1) * 32 + (swz % 64) / 2; }
__host__ __device__ __forceinline__ int perm32(int rho) { const int n = rho >> 4, i = rho & 15; return 8 * (i >> 2) + 4 * n + (i & 3); }

__device__ __forceinline__ unsigned cvtpk(float lo, float hi) { typedef float f2 __attribute__((ext_vector_type(2))); typedef __bf16 b2 __attribute__((ext_vector_type(2))); f2 v = {lo, hi}; b2 b = __builtin_convertvector(v, b2); return __builtin_bit_cast(unsigned, b); }
struct Unit { int pm, pn; };
struct Gemm { const bf16_t* A; const bf16_t* Bt; int M, N, K; };

struct StaticOrder {
    int nM, nN, nwg, G, c;
    __host__ __device__ void init(int M, int N, int G_, int c_) { nM = M / BM; nN = N / BM; nwg = nM * nN; G = G_; c = c_; }
    __host__ __device__ bool next(int i, Unit& u) const {
        const long L = (long)i * G + c; if (L >= nwg) return false;
        int wgid = (int)L; { const int q = nwg / NXCD, r = nwg % NXCD, xcd = wgid % NXCD, off = wgid / NXCD; wgid = (xcd < r ? xcd * (q + 1) : r * (q + 1) + (xcd - r) * q) + off; }
        const int nig = WGM * nN, gid = wgid / nig, fm = gid * WGM, gsz = (nM - fm) < WGM ? (nM - fm) : WGM;
        u.pm = fm + ((wgid % nig) % gsz); u.pn = (wgid % nig) / gsz; return true;
    }
    __device__ __forceinline__ void a_ready(const Unit&) const {}
    __device__ __forceinline__ void done(const Unit&) const {}
};


struct EpiBf16s {
    static constexpr bool PERM = true, AFTER_DRAIN = false;
    bf16_t* O; int ldc;
    __device__ __forceinline__ void operator()(const f32x4 (&acc)[2][2][4][2], const Unit& u, int wr, int wc, int fr, int fq) const {
        const int row0 = u.pm * BM + wr * 64 + fr, col0 = u.pn * BM + wc * 32 + 8 * fq;
#pragma unroll
        for (int ai = 0; ai < 2; ++ai)
#pragma unroll
            for (int m = 0; m < 4; ++m) { bf16_t* rowp = O + (size_t)(row0 + ai * HALF + m * 16) * ldc + col0;
#pragma unroll
                for (int bj = 0; bj < 2; ++bj) { const f32x4 v0 = acc[ai][bj][m][0], v1 = acc[ai][bj][m][1];
                    u32x4 w; w.x = cvtpk(v0[0], v0[1]); w.y = cvtpk(v0[2], v0[3]); w.z = cvtpk(v1[0], v1[1]); w.w = cvtpk(v1[2], v1[3]);
                    *(u32x4*)(rowp + bj * HALF) = w; } }
    }
};
struct EpiF32 {
    static constexpr bool PERM = false, AFTER_DRAIN = false;
    float* O; int ldc;
    __device__ __forceinline__ void operator()(const f32x4 (&acc)[2][2][4][2], const Unit& u, int wr, int wc, int fr, int fq) const {
        const int col0 = u.pn * BM + wc * 32 + 4 * fq;
#pragma unroll
        for (int ai = 0; ai < 2; ++ai)
#pragma unroll
            for (int m = 0; m < 4; ++m) { float* rowp = O + (size_t)(u.pm * BM + ai * HALF + wr * 64 + m * 16 + fr) * ldc + col0;
#pragma unroll
                for (int bj = 0; bj < 2; ++bj)
#pragma unroll
                    for (int n = 0; n < 2; ++n) *(f32x4*)(rowp + bj * HALF + n * 16) = acc[ai][bj][m][n]; }
    }
};

template <class Epi, class Sched, bool ALIGN_EPI = false, bool SP2 = false>
__device__ __forceinline__ void gemm_phase(PG8_LAS unsigned char* lds, const Gemm g, const Sched& S, const Epi& E) {
    const int tid = otid(), wid = __builtin_amdgcn_readfirstlane(tid >> 6), lane = tid & 63, wr = wid >> 2, wc = wid & 3, fr = lane & 15, fq = lane >> 4;
    const int K = g.K, nt = K / BK;
    unsigned voffA[2], voffB[2];
#pragma unroll
    for (int i = 0; i < 2; ++i) { int R, C; stage_rc(tid * 16 + i * 8192, R, C); const int Rb = Epi::PERM ? ((R & ~31) + perm32(R & 31)) : R;
        voffA[i] = (unsigned)(R * K + C) * 2u; voffB[i] = (unsigned)(Rb * K + C) * 2u; }
    const size_t kstep = (size_t)(BK * 2);
    const size_t hstep = (size_t)HALF * K * 2;
    const size_t tstep = 2 * hstep;
    const unsigned ldsw = (unsigned)wid * 1024u;
    const int aoff = lds_byte(wr * 64 + fr, fq * 8), boff = lds_byte(wc * 32 + fr, fq * 8);
#define PG8_SA(b, h) (((b) * 2 + (h)) * HTB)
#define PG8_SB(b, h) ((4 + (b) * 2 + (h)) * HTB)
#define PG8_STAGE(bufoff, gbase, voff) do { _Pragma("unroll") for (int _i = 0; _i < 2; ++_i) \
        __builtin_amdgcn_global_load_lds((const unsigned*)((const char*)(gbase) + (voff)[_i]), (PG8_LAS unsigned*)(lds + (bufoff) + ldsw + _i * 8192), 16, 0, 0); } while (0)
#define PG8_LDA(dst, b, h) do { _Pragma("unroll") for (int m = 0; m < 4; ++m) _Pragma("unroll") for (int k = 0; k < 2; ++k) dst[m][k] = *(const PG8_LAS bf16x8*)(lds + PG8_SA(b, h) + aoff + m * 2048 + k * 1024); } while (0)
#define PG8_LDB(dst, b, h) do { _Pragma("unroll") for (int n = 0; n < 2; ++n) _Pragma("unroll") for (int k = 0; k < 2; ++k) dst[n][k] = *(const PG8_LAS bf16x8*)(lds + PG8_SB(b, h) + boff + n * 2048 + k * 1024); } while (0)
#define PG8_MMA(ai, bj, At, Bt) do { __builtin_amdgcn_s_setprio(1); _Pragma("unroll") for (int m = 0; m < 4; ++m) _Pragma("unroll") for (int n = 0; n < 2; ++n) _Pragma("unroll") for (int k = 0; k < 2; ++k) \
        acc[ai][bj][m][n] = __builtin_amdgcn_mfma_f32_16x16x32_bf16(Bt[n][k], At[m][k], acc[ai][bj][m][n], 0, 0, 0); __builtin_amdgcn_s_setprio(0); } while (0)
#define PG8_WAIT_V(n) asm volatile("s_waitcnt vmcnt(" #n ")" ::: "memory")
#define PG8_WAIT_L(n) asm volatile("s_waitcnt lgkmcnt(" #n ")" ::: "memory")
#define PG8_BAR __builtin_amdgcn_s_barrier()
#define PG8_SCHED __builtin_amdgcn_sched_barrier(0)
    Unit cur, nxt; int ui = 0;
    if (!S.next(0, cur)) return;
    f32x4 acc[2][2][4][2];
#pragma unroll
    for (int a = 0; a < 2; ++a)
#pragma unroll
        for (int b = 0; b < 2; ++b)
#pragma unroll
            for (int m = 0; m < 4; ++m)
#pragma unroll
                for (int n = 0; n < 2; ++n) acc[a][b][m][n] = (f32x4){0.f, 0.f, 0.f, 0.f};
    bf16x8 At[4][2], B0[2][2], B1[2][2];
    const char* cA = (const char*)g.A + (size_t)cur.pm * tstep; const char* cB = (const char*)g.Bt + (size_t)cur.pn * tstep;
    S.a_ready(cur);
    if constexpr (SP2) {
        PG8_STAGE(PG8_SB(0, 0), cB, voffB); PG8_STAGE(PG8_SB(0, 1), cB + hstep, voffB); PG8_STAGE(PG8_SA(0, 0), cA, voffA); PG8_STAGE(PG8_SA(0, 1), cA + hstep, voffA);
        if (wr == 1) PG8_BAR;
        PG8_WAIT_V(2); PG8_BAR;
        PG8_STAGE(PG8_SB(1, 0), cB + kstep, voffB); PG8_STAGE(PG8_SA(1, 0), cA + kstep, voffA); PG8_STAGE(PG8_SB(1, 1), cB + hstep + kstep, voffB);
        PG8_WAIT_V(6); PG8_BAR;
    } else {
        PG8_STAGE(PG8_SB(0, 0), cB, voffB); PG8_STAGE(PG8_SA(0, 0), cA, voffA); PG8_STAGE(PG8_SB(0, 1), cB + hstep, voffB); PG8_STAGE(PG8_SA(0, 1), cA + hstep, voffA);
        if (wr == 1) PG8_BAR;
        PG8_WAIT_V(4); PG8_BAR;
        PG8_STAGE(PG8_SB(1, 0), cB + kstep, voffB); PG8_STAGE(PG8_SA(1, 0), cA + kstep, voffA); PG8_STAGE(PG8_SB(1, 1), cB + hstep + kstep, voffB);
        PG8_WAIT_V(6); PG8_BAR;
    }
    for (;;) {
        const bool has_next = S.next(ui + 1, nxt);
        const char* nA = has_next ? (const char*)g.A + (size_t)nxt.pm * tstep : cA; const char* nB = has_next ? (const char*)g.Bt + (size_t)nxt.pn * tstep : cB;
        for (int t = 0; t < nt; t += 2) {
            const bool last = (t == nt - 2);
            const char* a1 = cA + (size_t)(t + 1) * kstep;
            const char* a2 = last ? nA : cA + (size_t)(t + 2) * kstep; const char* b2 = last ? nB : cB + (size_t)(t + 2) * kstep;
            const char* a3 = a2 + kstep; const char* b3 = b2 + kstep;
            if (last && has_next) S.a_ready(nxt);
            if constexpr (SP2) {
            PG8_LDB(B0, 0, 0); PG8_LDB(B1, 0, 1); PG8_SCHED; PG8_LDA(At, 0, 0); PG8_STAGE(PG8_SA(1, 1), a1 + hstep, voffA);
            PG8_WAIT_V(8); PG8_WAIT_L(0); PG8_BAR; PG8_MMA(0, 0, At, B0); PG8_MMA(0, 1, At, B1); PG8_BAR; PG8_SCHED;
            PG8_LDA(At, 0, 1); PG8_STAGE(PG8_SB(0, 0), b2, voffB); PG8_STAGE(PG8_SB(0, 1), b2 + hstep, voffB); PG8_STAGE(PG8_SA(0, 0), a2, voffA);
            PG8_WAIT_V(8); PG8_WAIT_L(0); PG8_BAR; PG8_MMA(1, 0, At, B0); PG8_MMA(1, 1, At, B1); PG8_BAR; PG8_SCHED;
            PG8_LDB(B0, 1, 0); PG8_LDB(B1, 1, 1); PG8_SCHED; PG8_LDA(At, 1, 0); PG8_STAGE(PG8_SA(0, 1), a2 + hstep, voffA);
            PG8_WAIT_V(8); PG8_WAIT_L(0); PG8_BAR; PG8_MMA(0, 0, At, B0); PG8_MMA(0, 1, At, B1); PG8_BAR; PG8_SCHED;
            PG8_LDA(At, 1, 1); PG8_STAGE(PG8_SB(1, 0), b3, voffB); PG8_STAGE(PG8_SB(1, 1), b3 + hstep, voffB); PG8_STAGE(PG8_SA(1, 0), a3, voffA);
            PG8_WAIT_V(8); PG8_WAIT_L(0); PG8_BAR; PG8_MMA(1, 0, At, B0); PG8_MMA(1, 1, At, B1); PG8_BAR; PG8_SCHED;
            } else {
            PG8_LDB(B0, 0, 0); PG8_SCHED; PG8_LDA(At, 0, 0); PG8_STAGE(PG8_SA(1, 1), a1 + hstep, voffA);
            PG8_WAIT_L(8); PG8_BAR; PG8_WAIT_L(0); PG8_MMA(0, 0, At, B0); PG8_BAR; PG8_SCHED;
            PG8_LDB(B1, 0, 1); PG8_STAGE(PG8_SB(0, 0), b2, voffB);
            PG8_BAR; PG8_WAIT_L(0); PG8_MMA(0, 1, At, B1); PG8_BAR;
            PG8_LDA(At, 0, 1); PG8_STAGE(PG8_SA(0, 0), a2, voffA);
            PG8_BAR; PG8_WAIT_L(0); PG8_MMA(1, 0, At, B0); PG8_BAR; PG8_SCHED;
            PG8_STAGE(PG8_SB(0, 1), b2 + hstep, voffB);
            PG8_WAIT_V(6); PG8_BAR; PG8_MMA(1, 1, At, B1); PG8_BAR;
            PG8_LDB(B0, 1, 0); PG8_SCHED; PG8_LDA(At, 1, 0); PG8_STAGE(PG8_SA(0, 1), a2 + hstep, voffA);
            PG8_WAIT_L(8); PG8_BAR; PG8_WAIT_L(0); PG8_MMA(0, 0, At, B0); PG8_BAR; PG8_SCHED;
            PG8_LDB(B1, 1, 1); PG8_STAGE(PG8_SB(1, 0), b3, voffB);
            PG8_BAR; PG8_WAIT_L(0); PG8_MMA(0, 1, At, B1); PG8_BAR;
            PG8_LDA(At, 1, 1); PG8_STAGE(PG8_SA(1, 0), a3, voffA);
            PG8_BAR; PG8_WAIT_L(0); PG8_MMA(1, 0, At, B0); PG8_BAR; PG8_SCHED;
            PG8_STAGE(PG8_SB(1, 1), b3 + hstep, voffB);
            PG8_WAIT_V(6); PG8_BAR; PG8_MMA(1, 1, At, B1); PG8_BAR;
            }
        }
        if constexpr (ALIGN_EPI) { if (wr == 0) PG8_BAR; }
        if constexpr (!Epi::AFTER_DRAIN) { E(acc, cur, wr, wc, fr, fq); S.done(cur); }
        if (!has_next) break;
#pragma unroll
        for (int a = 0; a < 2; ++a)
#pragma unroll
            for (int b = 0; b < 2; ++b)
#pragma unroll
                for (int m = 0; m < 4; ++m)
#pragma unroll
                    for (int n = 0; n < 2; ++n) acc[a][b][m][n] = (f32x4){0.f, 0.f, 0.f, 0.f};
        cur = nxt; cA = nA; cB = nB; ++ui;
        if constexpr (ALIGN_EPI) { if (wr == 1) PG8_BAR; }
    }
    PG8_WAIT_V(0);
    if constexpr (!ALIGN_EPI) { if (wr == 0) PG8_BAR; }
    PG8_BAR;
    if constexpr (Epi::AFTER_DRAIN) { E.fused(acc, cur, wr, wc, fr, fq, lds, wid, lane); S.done(cur); }
#undef PG8_SA
#undef PG8_SB
#undef PG8_STAGE
#undef PG8_LDA
#undef PG8_LDB
#undef PG8_MMA
#undef PG8_WAIT_V
#undef PG8_WAIT_L
#undef PG8_BAR
#undef PG8_SCHED
}
}

__device__ __forceinline__ void ln_phase(const float* xin, const float* Y, const float* g, const float* bb, float* out, bf16_t* outb) {
  const int lane = otid() & 63, wid = otid() >> 6;
  for (int row = blockIdx.x * 8 + wid; row < M_; row += gridDim.x * 8) {
    const float4* xr = (const float4*)(xin + (size_t)row * D_);
    const float4* yr = (const float4*)(Y + (size_t)row * D_);
    float4 v[4]; float s = 0.f;
#pragma unroll
    for (int j = 0; j < 4; ++j) {
      const float4 a = xr[j * 64 + lane], y = yr[j * 64 + lane];
      v[j].x = ALPHA * a.x + y.x; v[j].y = ALPHA * a.y + y.y; v[j].z = ALPHA * a.z + y.z; v[j].w = ALPHA * a.w + y.w;
      s += (v[j].x + v[j].y) + (v[j].z + v[j].w);
    }
    const float mean = wave_sum(s) * (1.f / D_);
    float q = 0.f;
#pragma unroll
    for (int j = 0; j < 4; ++j) {
      v[j].x -= mean; v[j].y -= mean; v[j].z -= mean; v[j].w -= mean;
      q += (v[j].x * v[j].x + v[j].y * v[j].y) + (v[j].z * v[j].z + v[j].w * v[j].w);
    }
    const float rstd = 1.f / sqrtf(wave_sum(q) * (1.f / D_) + LN_EPS);
#pragma unroll
    for (int j = 0; j < 4; ++j) {
      const float4 gg = ((const float4*)g)[j * 64 + lane], bv = ((const float4*)bb)[j * 64 + lane];
      float4 o;
      o.x = v[j].x * rstd * gg.x + bv.x; o.y = v[j].y * rstd * gg.y + bv.y; o.z = v[j].z * rstd * gg.z + bv.z; o.w = v[j].w * rstd * gg.w + bv.w;
      ((float4*)(out + (size_t)row * D_))[j * 64 + lane] = o;
      if (outb) {
        ushort4 ob; ob.x = f2bf(o.x); ob.y = f2bf(o.y); ob.z = f2bf(o.z); ob.w = f2bf(o.w);
        ((ushort4*)(outb + (size_t)row * D_))[j * 64 + lane] = ob;
      }
    }
  }
}

__device__ __forceinline__ void compress_item(const Params& P, int item, float* sm) {
  const bf16_t* H0 = (const bf16_t*)(P.ws + WS_H);
  const int tid = otid();
  const int g = item & 1; int r = item >> 1; const int n = r % NCMP; r /= NCMP; const int b = r & 3; const int i = r >> 2;
  const float* pos = P.in[2] + i * 2048;
  const float* w1 = P.in[3] + (size_t)i * 2048 * 128;
  const float* b1 = P.in[4] + i * 128;
  const float* w2 = P.in[5] + (size_t)i * 128 * 64;
  float* blk = sm;
  float* part = sm + 2048;
  float* hid = sm + 2048 + 512;
  const int col = (i == 0 ? C_KCMP : C_VCMP) + g * 64;
#pragma unroll
  for (int k = 0; k < 4; ++k) {
    const int f = tid + k * 512, l = f >> 6, d = f & 63;
    blk[f] = bf2f(H0[((size_t)b * S_ + 16 * n + l) * P0 + col + d]) + pos[f];
  }
  __syncthreads();
  const int hh = tid & 127, pt = tid >> 7;
  float acc = 0.f;
  for (int f = pt * 512; f < pt * 512 + 512; ++f) acc += blk[f] * w1[(size_t)f * 128 + hh];
  part[pt * 128 + hh] = acc;
  __syncthreads();
  if (tid < 128) {
    const float a = part[tid] + part[128 + tid] + part[256 + tid] + part[384 + tid] + b1[tid];
    hid[tid] = silu_f(a);
  }
  __syncthreads();
  if (tid < 64) {
    float o = 0.f;
    for (int k = 0; k < 128; ++k) o += hid[k] * w2[k * 64 + tid];
    float* dst = (float*)(P.ws + (i == 0 ? WS_KC : WS_VC));
    dst[(((size_t)b * NCMP + n) * 2 + g) * 64 + tid] = o;
    bf16_t* dstb = (bf16_t*)(P.ws + (i == 0 ? (size_t)(248 * MiB) : (size_t)(249 * MiB)));
    dstb[(((size_t)b * 2 + g) * 256 + n) * 64 + tid] = f2bf(o);
    if (n == 0) dstb[(((size_t)b * 2 + g) * 256 + 255) * 64 + tid] = 0;
  }
  __syncthreads();
}
__device__ __forceinline__ void kmean_item(const Params& P, int item, int lane) {
  const bf16_t* H0 = (const bf16_t*)(P.ws + WS_H);
  const int h = item & 7, n = (item >> 3) & 15, b = item >> 7;
  float s = 0.f;
  for (int k = 0; k < 256; ++k) s += bf2f(H0[((size_t)b * S_ + n * 256 + k) * P0 + C_MK + h * 64 + lane]);
  ((float*)(P.ws + WS_KM))[(((size_t)b * 16 + n) * 8 + h) * 64 + lane] = s * (1.f / 256.f);
}


constexpr size_t WS_W1T = 250 * MiB;
constexpr size_t WS_W2T = 251 * MiB;
constexpr size_t WS_C1P = 252 * MiB;
__device__ __forceinline__ void compress_mfma_tile(const Params& P, int tile, unsigned char* smem_g) {
  const bf16_t* __restrict__ H0 = (const bf16_t*)(P.ws + WS_H);
  const int tid = otid(), lane = tid & 63, wid = __builtin_amdgcn_readfirstlane(tid >> 6), g = lane >> 4, ii = lane & 15;
  const int i = tile >> 7, R0 = (tile & 127) * 16;
  bf16_t* hs = (bf16_t*)smem_g;
  {
    const int R = min(R0 + ii, 2039), b = R / 510, rem = R - b * 510, n = rem >> 1, grp = rem & 1;
    const bf16_t* abase = H0 + ((size_t)b * S_ + 16 * n) * P0 + (i == 0 ? C_KCMP : C_VCMP) + grp * 64 + 8 * g;
    const bf16_t* bbase = (const bf16_t*)(P.ws + WS_W1T) + (size_t)(i * 128 + 16 * wid + ii) * 2048 + 8 * g;
    f32x4 acc = (f32x4){0.f, 0.f, 0.f, 0.f};
#pragma unroll 8
    for (int ks = 0; ks < 64; ++ks) {
      const bf16x8 a = *(const bf16x8*)(abase + (size_t)(ks >> 1) * P0 + (ks & 1) * 32);
      const bf16x8 bq = *(const bf16x8*)(bbase + ks * 32);
      acc = __builtin_amdgcn_mfma_f32_16x16x32_bf16(a, bq, acc, 0, 0, 0);
    }
    const int col = 16 * wid + ii;
    float bias = P.in[4][i * 128 + col];
    const float* c1p = (const float*)(P.ws + WS_C1P) + i * 32 * 128 + col;
#pragma unroll 8
    for (int q = 0; q < 32; ++q) bias += c1p[q * 128];
#pragma unroll
    for (int r = 0; r < 4; ++r) hs[(4 * g + r) * 136 + col] = f2bf(silu_f(acc[r] + bias));
  }
  __syncthreads();
  if (wid < 4) {
    const bf16_t* b2 = (const bf16_t*)(P.ws + WS_W2T) + (size_t)(i * 64 + 16 * wid + ii) * 128 + 8 * g;
    f32x4 acc = (f32x4){0.f, 0.f, 0.f, 0.f};
#pragma unroll
    for (int k2 = 0; k2 < 4; ++k2) {
      const bf16x8 a = *(const bf16x8*)(hs + ii * 136 + 32 * k2 + 8 * g);
      const bf16x8 bq = *(const bf16x8*)(b2 + 32 * k2);
      acc = __builtin_amdgcn_mfma_f32_16x16x32_bf16(a, bq, acc, 0, 0, 0);
    }
    bf16_t* dst = (bf16_t*)(P.ws + (i == 0 ? (size_t)(248 * MiB) : (size_t)(249 * MiB)));
#pragma unroll
    for (int r = 0; r < 4; ++r) {
      const int R = R0 + 4 * g + r;
      if (R < 2040) { const int b = R / 510, rem = R - b * 510, n = rem >> 1, grp = rem & 1;
        dst[(((size_t)b * 2 + grp) * 256 + n) * 64 + 16 * wid + ii] = f2bf(acc[r]); }
    }
  }
  __syncthreads();
}
__device__ __forceinline__ void kmean_item2(const Params& P, int item) {
  const bf16_t* __restrict__ H0 = (const bf16_t*)(P.ws + WS_H);
  const int tid = otid();
  const bf16_t* src = H0 + ((size_t)(item >> 4) * S_ + (item & 15) * 256) * P0 + C_MK + tid;
  float s0 = 0.f, s1 = 0.f, s2 = 0.f, s3 = 0.f;
#pragma unroll 4
  for (int r = 0; r < 256; r += 4) {
    s0 += bf2f(src[(size_t)r * P0]); s1 += bf2f(src[(size_t)(r + 1) * P0]); s2 += bf2f(src[(size_t)(r + 2) * P0]); s3 += bf2f(src[(size_t)(r + 3) * P0]);
  }
  ((float*)(P.ws + WS_KM))[(size_t)item * 512 + tid] = ((s0 + s1) + (s2 + s3)) * (1.f / 256.f);
}

template <int NH>
__device__ __forceinline__ void attend_block(const bf16_t* __restrict__ Kp, const bf16_t* __restrict__ Vp, size_t rowbase, int kp0, int t, int kmin,
                                             const float* qs, float* pb, const float* slope, float* m, float* l, float* o, int lane) {
  asm volatile("" ::: "memory");
  const int kp = kp0 + lane;
  const bool valid = (kp <= t) && (kp >= kmin);
  const uint4* kr = (const uint4*)(Kp + (rowbase + kp) * P0);
  float dot[NH];
#pragma unroll
  for (int j = 0; j < NH; ++j) dot[j] = 0.f;
#pragma unroll 1
  for (int c = 0; c < 8; ++c) {
    asm volatile("" ::: "memory");
    const uint4 u = kr[c];
    float kv[8];
    kv[0] = __uint_as_float(u.x << 16); kv[1] = __uint_as_float(u.x & 0xffff0000u);
    kv[2] = __uint_as_float(u.y << 16); kv[3] = __uint_as_float(u.y & 0xffff0000u);
    kv[4] = __uint_as_float(u.z << 16); kv[5] = __uint_as_float(u.z & 0xffff0000u);
    kv[6] = __uint_as_float(u.w << 16); kv[7] = __uint_as_float(u.w & 0xffff0000u);
#pragma unroll
    for (int j = 0; j < NH; ++j) {
      const float4 q0 = *(const float4*)(qs + j * 64 + c * 8), q1 = *(const float4*)(qs + j * 64 + c * 8 + 4);
      dot[j] += kv[0] * q0.x + kv[1] * q0.y + kv[2] * q0.z + kv[3] * q0.w + kv[4] * q1.x + kv[5] * q1.y + kv[6] * q1.z + kv[7] * q1.w;
    }
  }
#pragma unroll
  for (int j = 0; j < NH; ++j) {
    const float s = valid ? 0.125f * dot[j] - slope[j] * (float)(t - kp) : -1e30f;
    const float mn = fmaxf(m[j], wave_max(s));
    const float al = __expf(m[j] - mn);
    const float p = valid ? __expf(s - mn) : 0.f;
    l[j] = l[j] * al + wave_sum(p);
    o[j] *= al; m[j] = mn;
    pb[j * 64 + lane] = p;
  }
  __builtin_amdgcn_wave_barrier();
  const bf16_t* vr = Vp + (rowbase + kp0) * P0 + lane;
#pragma unroll 8
  for (int k = 0; k < 64; ++k) {
    const float v = bf2f(vr[(size_t)k * P0]);
#pragma unroll
    for (int j = 0; j < NH; ++j) o[j] += pb[j * 64 + k] * v;
  }
  __builtin_amdgcn_wave_barrier();
}

__device__ __forceinline__ void nsa_item(const Params& P, int b, int g, int t, float* wsm, int lane) {
  const bf16_t* H0 = (const bf16_t*)(P.ws + WS_H);
  const float* KC = (const float*)(P.ws + WS_KC);
  const float* VC = (const float*)(P.ws + WS_VC);
  bf16_t* MIX = (bf16_t*)(P.ws + WS_MIX);
  float* qs = wsm;
  float* pc = wsm + 256;
  float* pb = wsm + 1280;
  const size_t row = (size_t)b * S_ + t;
  const bf16_t* hrow = H0 + row * P0;
  float slope[4];
#pragma unroll
  for (int j = 0; j < 4; ++j) { qs[j * 64 + lane] = bf2f(hrow[C_NQ + (g * 4 + j) * 64 + lane]); slope[j] = exp2f(-(float)(g * 4 + j + 1)); }
  __builtin_amdgcn_wave_barrier();
  const int nv = t >= 31 ? (t - 31) / 16 + 1 : 0;
#pragma unroll 1
  for (int c = 0; c < 4; ++c) {
    asm volatile("" ::: "memory");
    const int n = c * 64 + lane;
    float dot[4] = {0.f, 0.f, 0.f, 0.f};
    if (n < nv) {
      const float4* kr = (const float4*)(KC + (((size_t)b * NCMP + n) * 2 + g) * 64);
#pragma unroll 4
      for (int d4 = 0; d4 < 16; ++d4) {
        const float4 kv = kr[d4];
#pragma unroll
        for (int j = 0; j < 4; ++j) {
          const float4 q = *(const float4*)(qs + j * 64 + d4 * 4);
          dot[j] += kv.x * q.x + kv.y * q.y + kv.z * q.z + kv.w * q.w;
        }
      }
    }
#pragma unroll
    for (int j = 0; j < 4; ++j) pc[j * 256 + n] = (n < nv) ? 0.125f * dot[j] - slope[j] * (float)(t - (16 * n + 31)) : -1e30f;
  }
  __builtin_amdgcn_wave_barrier();
#pragma unroll
  for (int j = 0; j < 4; ++j) {
    float sc[4];
#pragma unroll
    for (int c = 0; c < 4; ++c) sc[c] = pc[j * 256 + c * 64 + lane];
    float mx = fmaxf(fmaxf(sc[0], sc[1]), fmaxf(sc[2], sc[3]));
    mx = wave_max(mx);
    float sum = 0.f;
#pragma unroll
    for (int c = 0; c < 4; ++c) { const int n = c * 64 + lane; const float p = (n < nv) ? __expf(sc[c] - mx) : 0.f; sc[c] = p; sum += p; }
    sum = wave_sum(sum);
    const float inv = nv > 0 ? 1.f / sum : 0.f;
#pragma unroll
    for (int c = 0; c < 4; ++c) pc[j * 256 + c * 64 + lane] = sc[c] * inv;
  }
  __builtin_amdgcn_wave_barrier();
  float ocmp[4] = {0.f, 0.f, 0.f, 0.f};
  for (int n = 0; n < nv; ++n) {
    const float v = VC[(((size_t)b * NCMP + n) * 2 + g) * 64 + lane];
#pragma unroll
    for (int j = 0; j < 4; ++j) ocmp[j] += pc[j * 256 + n] * v;
  }
  float imp = 0.f;
  {
    const int lo = max(0, 4 * lane - 1), hi = min(NCMP - 1, 4 * lane + 3);
    for (int n = lo; n <= hi; ++n) imp += (pc[n] + pc[256 + n]) + (pc[512 + n] + pc[768 + n]);
  }
  const int cur = t >> 6;
  const bool bvalid = lane <= cur;
  const bool forced = (lane == 0) || (lane == cur) || (lane == cur - 1);
  const float key = bvalid ? (forced ? 1e9f : imp) : -1e30f;
  int rank = 0;
  for (int s2 = 0; s2 < 64; ++s2) {
    const float ks = __shfl(key, s2);
    rank += (ks > key || (ks == key && s2 < lane)) ? 1 : 0;
  }
  const unsigned long long selmask = __ballot(bvalid && rank < 16);
  float m[4], l[4], osel[4], owin[4];
#pragma unroll
  for (int j = 0; j < 4; ++j) { m[j] = -1e30f; l[j] = 0.f; osel[j] = 0.f; }
  {
    unsigned long long mk = selmask;
    while (mk) {
      const int blk = __builtin_ctzll(mk); mk &= mk - 1;
      attend_block<4>(H0 + C_KSEL + g * 64, H0 + C_VSEL + g * 64, (size_t)b * S_, blk * 64, t, 0, qs, pb, slope, m, l, osel, lane);
    }
  }
#pragma unroll
  for (int j = 0; j < 4; ++j) { osel[j] /= l[j]; m[j] = -1e30f; l[j] = 0.f; owin[j] = 0.f; }
  {
    const int kmin = t - 511;
    const int b0 = (kmin > 0 ? kmin : 0) >> 6;
    for (int blk = b0; blk <= cur; ++blk)
      attend_block<4>(H0 + C_KWIN + g * 64, H0 + C_VWIN + g * 64, (size_t)b * S_, blk * 64, t, kmin, qs, pb, slope, m, l, owin, lane);
  }
#pragma unroll
  for (int j = 0; j < 4; ++j) {
    const int h = g * 4 + j;
    const float g0 = sigmoid_f(bf2f(hrow[C_NG + h * 3 + 0])), g1 = sigmoid_f(bf2f(hrow[C_NG + h * 3 + 1])), g2 = sigmoid_f(bf2f(hrow[C_NG + h * 3 + 2]));
    const float o = g0 * ocmp[j] + g1 * osel[j] + g2 * (owin[j] / l[j]);
    const float z = bf2f(hrow[C_NZ + h * 64 + lane]);
    MIX[row * D_ + h * 64 + lane] = f2bf(o * silu_f(z));
  }
}

__device__ __forceinline__ void moba_item(const Params& P, int b, int h, int t, float* wsm, int lane) {
  const bf16_t* H0 = (const bf16_t*)(P.ws + WS_H);
  const float* KM = (const float*)(P.ws + WS_KM);
  bf16_t* MIX = (bf16_t*)(P.ws + WS_MIX);
  float* qs = wsm;
  float* pb = wsm + 1280;
  const size_t row = (size_t)b * S_ + t;
  const bf16_t* hrow = H0 + row * P0;
  qs[lane] = bf2f(hrow[C_MQ + h * 64 + lane]);
  __builtin_amdgcn_wave_barrier();
  float slope[1] = {exp2f(-(float)(h + 1))};
  const int cur = t >> 8;
  float gate = -1e30f;
  if (lane < cur) {
    const float4* kr = (const float4*)(KM + (((size_t)b * 16 + lane) * 8 + h) * 64);
    float d = 0.f;
#pragma unroll 4
    for (int d4 = 0; d4 < 16; ++d4) { const float4 kv = kr[d4]; const float4 q = *(const float4*)(qs + d4 * 4); d += kv.x * q.x + kv.y * q.y + kv.z * q.z + kv.w * q.w; }
    gate = d;
  }
  int rank = 0;
  for (int s2 = 0; s2 < 16; ++s2) {
    const float ks = __shfl(gate, s2);
    rank += (ks > gate || (ks == gate && s2 < lane)) ? 1 : 0;
  }
  unsigned long long mk = __ballot(lane < cur && rank < 3) | (1ull << cur);
  float m[1] = {-1e30f}, l[1] = {0.f}, o[1] = {0.f};
  while (mk) {
    const int blk = __builtin_ctzll(mk); mk &= mk - 1;
    for (int c = 0; c < 4; ++c) {
      const int kp0 = blk * 256 + c * 64;
      if (kp0 > t) break;
      attend_block<1>(H0 + C_MK + h * 64, H0 + C_MV + h * 64, (size_t)b * S_, kp0, t, 0, qs, pb, slope, m, l, o, lane);
    }
  }
  const float z = bf2f(hrow[C_MZ + h * 64 + lane]);
  MIX[row * D_ + 512 + h * 64 + lane] = f2bf((o[0] / l[0]) * silu_f(z));
}


#define LAS __attribute__((address_space(3)))
typedef short s16x4 __attribute__((ext_vector_type(4)));
typedef float f32x2_t __attribute__((ext_vector_type(2)));
typedef __bf16 bf16x2_t __attribute__((ext_vector_type(2)));
__device__ __forceinline__ unsigned cvtpk(float lo, float hi) { f32x2_t v = {lo, hi}; bf16x2_t b = __builtin_convertvector(v, bf16x2_t); return __builtin_bit_cast(unsigned, b); }
__device__ __forceinline__ s16x4 vtr(LAS const unsigned char* p) { return __builtin_bit_cast(s16x4, __builtin_amdgcn_ds_read_tr16_b64_v4i16((LAS s16x4*)p)); }
template <int OFF> __device__ __forceinline__ s16x4 vtra(unsigned a) { s16x4 r; asm volatile("ds_read_b64_tr_b16 %0, %1 offset:%2" : "=&v"(r) : "v"(a), "i"(OFF) : "memory"); return r; }
#define LGKM0() do { asm volatile("s_waitcnt lgkmcnt(0)" ::: "memory"); __builtin_amdgcn_sched_barrier(0); } while (0)
constexpr int KT_BYTES = 8192;
constexpr int VT_DT = 2080;
constexpr int VT_BYTES = 4 * VT_DT;
constexpr int AT_BUF = KT_BYTES + VT_BYTES;
constexpr int AT_NST = 4;
constexpr int AT_MISC = AT_NST * AT_BUF;
constexpr int AT_TL = AT_MISC + 64;
constexpr int AT_STASH = AT_MISC + 512;
constexpr int AT_LDS_END = AT_STASH + 8 * 512 * 16;
__device__ __forceinline__ void ring_wait(int rem) {
  if (rem >= 3) asm volatile("s_waitcnt vmcnt(6)" ::: "memory");
  else if (rem == 2) asm volatile("s_waitcnt vmcnt(4)" ::: "memory");
  else if (rem == 1) asm volatile("s_waitcnt vmcnt(2)" ::: "memory");
  else asm volatile("s_waitcnt vmcnt(0)" ::: "memory");
  __builtin_amdgcn_s_barrier();
  asm volatile("" ::: "memory");
}
constexpr float C1 = 0.125f * 1.4426950408889634f;
constexpr float LOG2E = 1.4426950408889634f;

__device__ __forceinline__ void at_stage_write(LAS unsigned char* buf, const u32x4& kreg, const u32x4& vreg, int tid) {
  const int key = tid >> 3, c = tid & 7;
  *(LAS u32x4*)(buf + key * 128 + ((c ^ ((key >> 1) & 7)) << 4)) = kreg;
  *(LAS u32x4*)(buf + KT_BYTES + (c >> 1) * VT_DT + key * 32 + (c & 1) * 16) = vreg;
}
__device__ __forceinline__ void at_stage_dma(LAS unsigned char* buf, const bf16_t* Kt, const bf16_t* Vt, unsigned pitch, int lane, int wid) {
  const int kkey = 8 * wid + (lane >> 3), c = (lane & 7) ^ ((kkey >> 1) & 7);
  __builtin_amdgcn_global_load_lds((const unsigned*)(Kt + (unsigned)kkey * pitch + c * 8), (LAS unsigned*)(buf + wid * 1024), 16, 0, 0);
  const int vkey = 32 * (wid & 1) + (lane >> 1), dt = wid >> 1;
  __builtin_amdgcn_global_load_lds((const unsigned*)(Vt + (unsigned)vkey * pitch + dt * 16 + (lane & 1) * 8), (LAS unsigned*)(buf + KT_BYTES + dt * VT_DT + (wid & 1) * 1024), 16, 0, 0);
}
template <int NRG, bool EDGE, int IMPT  >
__device__ __forceinline__ void at_tile_x(LAS const unsigned char* buf, const bf16x8 (&qf)[NRG][2], f32x4 (&O)[NRG][4], float (&m)[NRG], float (&l)[NRG],
                                        const float (&base)[NRG], const float (&soff)[NRG], const int (&lim)[NRG], const int (&lo)[NRG], int lane,
                                        float (&imp)[NRG][16], float (&carry)[NRG]) {
  const int g = lane >> 4, i = lane & 15;
  const int swz = (i >> 1) & 7;
  LAS const unsigned char* kb = buf + i * 128;
  const int kc0 = ((g ^ swz) << 4), kc1 = (((4 + g) ^ swz) << 4);
  f32x4 S[NRG][4];
#pragma unroll
  for (int mt = 0; mt < 4; ++mt) {
    const bf16x8 k0f = *(LAS const bf16x8*)(kb + mt * 2048 + kc0);
    const bf16x8 k1f = *(LAS const bf16x8*)(kb + mt * 2048 + kc1);
#pragma unroll
    for (int rg = 0; rg < NRG; ++rg) {
      f32x4 a = __builtin_amdgcn_mfma_f32_16x16x32_bf16(k0f, qf[rg][0], (f32x4){0.f, 0.f, 0.f, 0.f}, 0, 0, 0);
      S[rg][mt] = __builtin_amdgcn_mfma_f32_16x16x32_bf16(k1f, qf[rg][1], a, 0, 0, 0);
    }
  }
  __builtin_amdgcn_sched_barrier(0);
  unsigned pk[NRG][2][4];
#pragma unroll
  for (int rg = 0; rg < NRG; ++rg) {
    float mx = -INFINITY;
#pragma unroll
    for (int mt = 0; mt < 4; ++mt)
#pragma unroll
      for (int r = 0; r < 4; ++r) {
        float sv = __builtin_fmaf(S[rg][mt][r], C1, base[rg] + soff[rg] * (float)(16 * mt + r));
        if (EDGE) { const int c = 16 * mt + r; sv = (c <= lim[rg] && c >= lo[rg]) ? sv : -INFINITY; }
        S[rg][mt][r] = sv; mx = fmaxf(mx, sv);
      }
    mx = xmax<16>(mx); mx = xmax<32>(mx);
    const float mn = fmaxf(m[rg], mx);
    const float al = __builtin_amdgcn_exp2f(m[rg] - mn);
    m[rg] = mn;
    float ps = 0.f;
#pragma unroll
    for (int mt = 0; mt < 4; ++mt)
#pragma unroll
      for (int r = 0; r < 4; ++r) { const float pv = __builtin_amdgcn_exp2f(S[rg][mt][r] - mn); S[rg][mt][r] = pv; ps += pv; }
    l[rg] = l[rg] * al + ps;
    if (IMPT >= 0) {
#pragma unroll
      for (int k = 0; k < 4 * IMPT; ++k) imp[rg][k] *= al;
      carry[rg] *= al;
      float sh[4];
#pragma unroll
      for (int mt = 0; mt < 4; ++mt) sh[mt] = __uint_as_float(__builtin_amdgcn_ds_bpermute(((lane + 48) & 63) << 2, __float_as_uint(S[rg][mt][3])));
#pragma unroll
      for (int mt = 0; mt < 4; ++mt) {
        const float own = (S[rg][mt][0] + S[rg][mt][1]) + (S[rg][mt][2] + S[rg][mt][3]);
        const float prev = g > 0 ? sh[mt] : (mt > 0 ? sh[mt > 0 ? mt - 1 : 0] : carry[rg]);
        imp[rg][(IMPT >= 0 ? 4 * IMPT : 0) + mt] = own + prev;
      }
      carry[rg] = sh[3];
    }
#pragma unroll
    for (int dt = 0; dt < 4; ++dt) O[rg][dt] = O[rg][dt] * al;
#pragma unroll
    for (int ks = 0; ks < 2; ++ks) {
      pk[rg][ks][0] = cvtpk(S[rg][2 * ks][0], S[rg][2 * ks][1]); pk[rg][ks][1] = cvtpk(S[rg][2 * ks][2], S[rg][2 * ks][3]);
      pk[rg][ks][2] = cvtpk(S[rg][2 * ks + 1][0], S[rg][2 * ks + 1][1]); pk[rg][ks][3] = cvtpk(S[rg][2 * ks + 1][2], S[rg][2 * ks + 1][3]);
    }
  }
  const unsigned vb = (unsigned)(unsigned long long)(buf + KT_BYTES) + (4 * g + (i >> 2)) * 32 + (i & 3) * 8;
  __builtin_amdgcn_sched_barrier(0);
#define AT_VRD(dt, ks, d0, d1) { d0 = vtra<(dt) * VT_DT + (ks) * 1024>(vb); d1 = vtra<(dt) * VT_DT + (ks) * 1024 + 512>(vb); }
#define AT_PV(dt, ks, d0, d1) { const bf16x8 vf = (bf16x8){d0[0], d0[1], d0[2], d0[3], d1[0], d1[1], d1[2], d1[3]}; \
    _Pragma("unroll") for (int rg = 0; rg < NRG; ++rg) { const u32x4 pw = {pk[rg][ks][0], pk[rg][ks][1], pk[rg][ks][2], pk[rg][ks][3]}; \
      O[rg][dt] = __builtin_amdgcn_mfma_f32_16x16x32_bf16(vf, __builtin_bit_cast(bf16x8, pw), O[rg][dt], 0, 0, 0); } }
  s16x4 a0, a1, a2, a3, a4, a5, a6, a7, c0, c1, c2, c3, c4, c5, c6, c7;
  AT_VRD(0, 0, a0, a1) AT_VRD(0, 1, a2, a3) AT_VRD(1, 0, a4, a5) AT_VRD(1, 1, a6, a7)
  LGKM0();
  AT_VRD(2, 0, c0, c1) AT_VRD(2, 1, c2, c3) AT_VRD(3, 0, c4, c5) AT_VRD(3, 1, c6, c7)
  AT_PV(0, 0, a0, a1) AT_PV(0, 1, a2, a3) AT_PV(1, 0, a4, a5) AT_PV(1, 1, a6, a7)
  LGKM0();
  AT_PV(2, 0, c0, c1) AT_PV(2, 1, c2, c3) AT_PV(3, 0, c4, c5) AT_PV(3, 1, c6, c7)
#undef AT_VRD
#undef AT_PV
}

template <int NRG, bool EDGE>
__device__ __forceinline__ void at_tile(LAS const unsigned char* buf, const bf16x8 (&qf)[NRG][2], f32x4 (&O)[NRG][4], float (&m)[NRG], float (&l)[NRG],
                                        const float (&base)[NRG], const float (&soff)[NRG], const int (&lim)[NRG], const int (&lo)[NRG], int lane) {
  float dimp[NRG][16]; float dc[NRG];
  at_tile_x<NRG, EDGE, -1>(buf, qf, O, m, l, base, soff, lim, lo, lane, dimp, dc);
}

__device__ __forceinline__ void moba_mfma_item(const Params& P, int b, int h, int cur, unsigned char* smem_g) {
  LAS unsigned char* lds = (LAS unsigned char*)smem_g;
  const bf16_t* __restrict__ H0 = (const bf16_t*)(P.ws + WS_H);
  const float* __restrict__ KM = (const float*)(P.ws + WS_KM);
  bf16_t* __restrict__ MIX = (bf16_t*)(P.ws + WS_MIX);
  const int tid = otid(), lane = tid & 63, wid = __builtin_amdgcn_readfirstlane(tid >> 6), g = lane >> 4, i = lane & 15;
  const float slope2 = exp2f(-(float)(h + 1)) * LOG2E;
  const int t0 = cur * 256;
  int trow[2]; bf16x8 qf[2][2]; unsigned sel[2];
#pragma unroll
  for (int rg = 0; rg < 2; ++rg) {
    trow[rg] = t0 + wid * 32 + rg * 16 + i;
    const bf16_t* qp = H0 + ((size_t)b * S_ + trow[rg]) * P0 + C_MQ + h * 64 + 8 * g;
    qf[rg][0] = *(const bf16x8*)qp; qf[rg][1] = *(const bf16x8*)(qp + 32);
  }
#pragma unroll
  for (int rg = 0; rg < 2; ++rg) {
    float qv[16];
#pragma unroll
    for (int j = 0; j < 8; ++j) { qv[j] = bf2f((bf16_t)qf[rg][0][j]); qv[8 + j] = bf2f((bf16_t)qf[rg][1][j]); }
    float v1 = -INFINITY, v2 = -INFINITY, v3 = -INFINITY; int i1 = -1, i2 = -1, i3 = -1;
    for (int n = 0; n < cur; ++n) {
      const float* kr = KM + (((size_t)b * 16 + n) * 8 + h) * 64 + 8 * g;
      const float4 a0 = *(const float4*)kr, a1 = *(const float4*)(kr + 4), b0 = *(const float4*)(kr + 32), b1 = *(const float4*)(kr + 36);
      float d = qv[0] * a0.x + qv[1] * a0.y + qv[2] * a0.z + qv[3] * a0.w + qv[4] * a1.x + qv[5] * a1.y + qv[6] * a1.z + qv[7] * a1.w
              + qv[8] * b0.x + qv[9] * b0.y + qv[10] * b0.z + qv[11] * b0.w + qv[12] * b1.x + qv[13] * b1.y + qv[14] * b1.z + qv[15] * b1.w;
      d = xsum<16>(d); d = xsum<32>(d);
      if (d > v1) { v3 = v2; i3 = i2; v2 = v1; i2 = i1; v1 = d; i1 = n; }
      else if (d > v2) { v3 = v2; i3 = i2; v2 = d; i2 = n; }
      else if (d > v3) { v3 = d; i3 = n; }
    }
    unsigned mk = 0u;
    if (i1 >= 0) mk |= 1u << i1;
    if (i2 >= 0) mk |= 1u << i2;
    if (i3 >= 0) mk |= 1u << i3;
    sel[rg] = mk;
  }
  {
    unsigned u = sel[0] | sel[1];
    u = xorr<1>(u); u = xorr<2>(u); u = xorr<4>(u); u = xorr<8>(u);
    LAS unsigned* misc = (LAS unsigned*)(lds + AT_MISC);
    if (lane == 0) misc[wid] = u;
  }
  __syncthreads();
  unsigned umask = 0u;
  {
    LAS unsigned* misc = (LAS unsigned*)(lds + AT_MISC);
#pragma unroll
    for (int w = 0; w < 8; ++w) umask |= misc[w];
  }
  umask = __builtin_amdgcn_readfirstlane(umask);
  const int npast = __builtin_popcount(umask);
  const int nt = 4 * npast + 4;
  f32x4 O[2][4]; float m[2], l[2];
#pragma unroll
  for (int rg = 0; rg < 2; ++rg) { m[rg] = -1e30f; l[rg] = 0.f;
#pragma unroll
    for (int dt = 0; dt < 4; ++dt) O[rg][dt] = (f32x4){0.f, 0.f, 0.f, 0.f}; }
  const bf16_t* Kg = H0 + (size_t)b * S_ * P0 + C_MK + h * 64;
  const bf16_t* Vg = H0 + (size_t)b * S_ * P0 + C_MV + h * 64;
  LAS int* tl = (LAS int*)(lds + AT_TL);
  if (tid < nt) {
    int k0v;
    if (tid < 4 * npast) { unsigned r = umask; for (int q = 0; q < (tid >> 2); ++q) r &= r - 1; k0v = __builtin_ctz(r) * 256 + (tid & 3) * 64; }
    else k0v = cur * 256 + (tid - 4 * npast) * 64;
    tl[tid] = k0v;
  }
  asm volatile("s_waitcnt vmcnt(0)" ::: "memory");
  __syncthreads();
#pragma unroll
  for (int st = 0; st < 3; ++st) if (st < nt) { const int k0s = tl[st]; at_stage_dma(lds + st * AT_BUF, Kg + (size_t)k0s * P0, Vg + (size_t)k0s * P0, P0, lane, wid); }
  for (int ti = 0; ti < nt; ++ti) {
    ring_wait(min(nt - 1 - ti, 2));
    if (ti + 3 < nt) { const int k0n = tl[ti + 3]; at_stage_dma(lds + ((ti + 3) & 3) * AT_BUF, Kg + (size_t)k0n * P0, Vg + (size_t)k0n * P0, P0, lane, wid); }
    const int ck0 = __builtin_amdgcn_readfirstlane(tl[ti]), cblk = ck0 >> 8;
    if (cblk == cur && ck0 > t0 + wid * 32 + 31) continue;
    LAS const unsigned char* buf = lds + (ti & 3) * AT_BUF;
    float base[2], soff[2]; int lim[2], lo[2];
#pragma unroll
    for (int rg = 0; rg < 2; ++rg) {
      const bool rs = (cblk == cur) || ((sel[rg] >> cblk) & 1u);
      base[rg] = rs ? slope2 * (float)(ck0 + 4 * g - trow[rg]) : -INFINITY;
      soff[rg] = slope2; lim[rg] = trow[rg] - ck0 - 4 * g; lo[rg] = -1000000;
    }
    if (cblk == cur) at_tile<2, true>(buf, qf, O, m, l, base, soff, lim, lo, lane);
    else at_tile<2, false>(buf, qf, O, m, l, base, soff, lim, lo, lane);
  }
  __builtin_amdgcn_s_barrier();
#pragma unroll
  for (int rg = 0; rg < 2; ++rg) {
    float lt = l[rg]; lt = xsum<16>(lt); lt = xsum<32>(lt);
    const float inv = 1.f / lt;
    const size_t row = (size_t)b * S_ + trow[rg];
#pragma unroll
    for (int dt = 0; dt < 4; ++dt) {
      const int dv = 16 * dt + 4 * g;
      const ushort4 zz = *(const ushort4*)(H0 + row * P0 + C_MZ + h * 64 + dv);
      ushort4 ov;
      ov.x = f2bf(O[rg][dt][0] * inv * silu_f(bf2f(zz.x))); ov.y = f2bf(O[rg][dt][1] * inv * silu_f(bf2f(zz.y)));
      ov.z = f2bf(O[rg][dt][2] * inv * silu_f(bf2f(zz.z))); ov.w = f2bf(O[rg][dt][3] * inv * silu_f(bf2f(zz.w)));
      *(ushort4*)(MIX + row * D_ + 512 + h * 64 + dv) = ov;
    }
  }
}


constexpr size_t WS_KCB = 248 * MiB;
constexpr size_t WS_VCB = 249 * MiB;
__device__ __forceinline__ void nsa_mfma_item(const Params& P, int b, int grp, int sb, unsigned char* smem_g) {
  LAS unsigned char* lds = (LAS unsigned char*)smem_g;
  const bf16_t* __restrict__ H0 = (const bf16_t*)(P.ws + WS_H);
  bf16_t* __restrict__ MIX = (bf16_t*)(P.ws + WS_MIX);
  const int tid = otid(), lane = tid & 63, wid = __builtin_amdgcn_readfirstlane(tid >> 6), g = lane >> 4, i = lane & 15;
  const int t0 = sb * 64;
  int trow[2]; bf16x8 qf[2][2];
  const int hh = grp * 4 + (i & 3);
  const float slope2 = exp2f(-(float)(hh + 1)) * LOG2E;
  const bf16_t* __restrict__ Hb = H0 + (size_t)b * S_ * P0;
#pragma unroll
  for (int rg = 0; rg < 2; ++rg) {
    trow[rg] = t0 + wid * 8 + rg * 4 + (i >> 2);
    const unsigned qo = (unsigned)trow[rg] * P0 + C_NQ + hh * 64 + 8 * g;
    qf[rg][0] = *(const bf16x8*)(Hb + qo); qf[rg][1] = *(const bf16x8*)(Hb + qo + 32);
  }
  LAS f32x4* stash = (LAS f32x4*)(lds + AT_STASH) + tid;
  f32x4 O[2][4]; float m[2], l[2];
  unsigned mlo[2], mhi[2];
  const int ntc = ((4 * sb + 2) >> 6) + 1;
  {
    const bf16_t* Kg = (const bf16_t*)(P.ws + WS_KCB) + (size_t)(b * 2 + grp) * 256 * 64;
    const bf16_t* Vg = (const bf16_t*)(P.ws + WS_VCB) + (size_t)(b * 2 + grp) * 256 * 64;
    asm volatile("s_waitcnt vmcnt(0)" ::: "memory");
#pragma unroll
    for (int tile = 0; tile < 4; ++tile) if (tile < ntc) at_stage_dma(lds + tile * AT_BUF, Kg + tile * 4096, Vg + tile * 4096, 64, lane, wid);
  }
#pragma unroll
  for (int rg = 0; rg < 2; ++rg) {
    float imp[1][16], carry[1], m1[1], l1[1]; f32x4 O1[1][4]; bf16x8 q1[1][2];
    q1[0][0] = qf[rg][0]; q1[0][1] = qf[rg][1];
    m1[0] = -1e30f; l1[0] = 0.f; carry[0] = 0.f;
#pragma unroll
    for (int k = 0; k < 16; ++k) imp[0][k] = 0.f;
#pragma unroll
    for (int dt = 0; dt < 4; ++dt) O1[0][dt] = (f32x4){0.f, 0.f, 0.f, 0.f};
#pragma unroll
    for (int tile = 0; tile < 4; ++tile) {
      if (tile < ntc) {
        if (rg == 0) ring_wait(ntc - 1 - tile);
        LAS const unsigned char* buf = lds + tile * AT_BUF;
        float base[1], soff[1]; int lim[1], lo[1];
        const int nlim = trow[rg] >= 31 ? ((trow[rg] - 31) >> 4) : -1;
        base[0] = slope2 * (float)(16 * (64 * tile + 4 * g) + 31 - trow[rg]);
        soff[0] = 16.f * slope2; lim[0] = nlim - 64 * tile - 4 * g; lo[0] = -1000000;
        if (tile == 0) at_tile_x<1, true, 0>(buf, q1, O1, m1, l1, base, soff, lim, lo, lane, imp, carry);
        else if (tile == 1) at_tile_x<1, true, 1>(buf, q1, O1, m1, l1, base, soff, lim, lo, lane, imp, carry);
        else if (tile == 2) at_tile_x<1, true, 2>(buf, q1, O1, m1, l1, base, soff, lim, lo, lane, imp, carry);
        else at_tile_x<1, true, 3>(buf, q1, O1, m1, l1, base, soff, lim, lo, lane, imp, carry);
      }
    }
    {
      float lt = l1[0]; lt = xsum<16>(lt); lt = xsum<32>(lt);
      const float inv = lt > 0.f ? 1.f / lt : 0.f;
      const float g0 = sigmoid_f(bf2f(Hb[(unsigned)trow[rg] * P0 + C_NG + hh * 3 + 0]));
#pragma unroll
      for (int dt = 0; dt < 4; ++dt) stash[(rg * 4 + dt) * 512] = O1[0][dt] * (g0 * inv);
      if (sb < 16) { mlo[rg] = (1u << (sb + 1)) - 1u; mhi[rg] = 0u; }
      else {
        float key[16];
#pragma unroll
        for (int k = 0; k < 16; ++k) {
          float v = imp[0][k] * inv; v = xsum<1>(v); v = xsum<2>(v);
          const int sidx = 4 * k + g;
          const bool forced = (sidx == 0) || (sidx == sb) || (sidx == sb - 1);
          key[k] = (sidx <= sb) ? (forced ? 1e9f : v) : -1e30f;
        }
        const int j = i & 3;
        float mykey[4]; int mys[4], rank[4];
#pragma unroll
        for (int q = 0; q < 4; ++q) {
          mykey[q] = j == 0 ? key[q] : (j == 1 ? key[4 + q] : (j == 2 ? key[8 + q] : key[12 + q]));
          mys[q] = 4 * (4 * j + q) + g; rank[q] = 0;
        }
#pragma unroll 1
        for (int gg = 0; gg < 4; ++gg)
#pragma unroll
          for (int kk = 0; kk < 16; ++kk) {
            const float other = __uint_as_float(__builtin_amdgcn_ds_bpermute((gg * 16 + i) << 2, __float_as_uint(key[kk])));
            const int sp = 4 * kk + gg;
#pragma unroll
            for (int q = 0; q < 4; ++q) rank[q] += (other > mykey[q] || (other == mykey[q] && sp < mys[q])) ? 1 : 0;
          }
        unsigned a = 0u, bb = 0u;
#pragma unroll
        for (int q = 0; q < 4; ++q) if (rank[q] < 16 && mys[q] <= sb) { if (mys[q] < 32) a |= 1u << mys[q]; else bb |= 1u << (mys[q] - 32); }
        a = xorr<1>(a); bb = xorr<1>(bb); a = xorr<2>(a); bb = xorr<2>(bb);
        a = xorr<16>(a); bb = xorr<16>(bb); a = xorr<32>(a); bb = xorr<32>(bb);
        mlo[rg] = a; mhi[rg] = bb;
      }
    }
  }
  {
    unsigned ua = mlo[0] | mlo[1], ub = mhi[0] | mhi[1];
    ua = xorr<4>(ua); ub = xorr<4>(ub); ua = xorr<8>(ua); ub = xorr<8>(ub);
    LAS unsigned* misc = (LAS unsigned*)(lds + AT_MISC);
    if (lane == 0) { misc[2 * wid] = ua; misc[2 * wid + 1] = ub; }
    __syncthreads();
    ua = 0u; ub = 0u;
#pragma unroll
    for (int w = 0; w < 8; ++w) { ua |= misc[2 * w]; ub |= misc[2 * w + 1]; }
    unsigned long long rem = ((unsigned long long)(unsigned)__builtin_amdgcn_readfirstlane(ub) << 32) | (unsigned)__builtin_amdgcn_readfirstlane(ua);
    const int nt = __builtin_popcountll(rem);
#pragma unroll
    for (int rg = 0; rg < 2; ++rg) { m[rg] = -1e30f; l[rg] = 0.f;
#pragma unroll
      for (int dt = 0; dt < 4; ++dt) O[rg][dt] = (f32x4){0.f, 0.f, 0.f, 0.f}; }
    const bf16_t* Kg = Hb + C_KSEL + grp * 64;
    const bf16_t* Vg = Hb + C_VSEL + grp * 64;
    LAS int* tl = (LAS int*)(lds + AT_TL);
    if (tid < nt) { unsigned long long r = rem; for (int q = 0; q < tid; ++q) r &= r - 1; tl[tid] = __builtin_ctzll(r); }
    asm volatile("s_waitcnt vmcnt(0)" ::: "memory");
    __syncthreads();
#pragma unroll
    for (int st = 0; st < 3; ++st) if (st < nt) { const int bs = tl[st]; at_stage_dma(lds + st * AT_BUF, Kg + (size_t)bs * 64 * P0, Vg + (size_t)bs * 64 * P0, P0, lane, wid); }
    for (int ti = 0; ti < nt; ++ti) {
      ring_wait(min(nt - 1 - ti, 2));
      if (ti + 3 < nt) { const int bn = tl[ti + 3]; at_stage_dma(lds + ((ti + 3) & 3) * AT_BUF, Kg + (size_t)bn * 64 * P0, Vg + (size_t)bn * 64 * P0, P0, lane, wid); }
      const int cblk = __builtin_amdgcn_readfirstlane(tl[ti]);
      LAS const unsigned char* buf = lds + (ti & 3) * AT_BUF;
      float base[2], soff[2]; int lim[2], lo[2];
#pragma unroll
      for (int rg = 0; rg < 2; ++rg) {
        const bool rs = cblk < 32 ? ((mlo[rg] >> cblk) & 1u) : ((mhi[rg] >> (cblk - 32)) & 1u);
        base[rg] = rs ? slope2 * (float)(cblk * 64 + 4 * g - trow[rg]) : -INFINITY;
        soff[rg] = slope2; lim[rg] = trow[rg] - cblk * 64 - 4 * g; lo[rg] = -1000000;
      }
      if (cblk == sb) at_tile<2, true>(buf, qf, O, m, l, base, soff, lim, lo, lane);
      else at_tile<2, false>(buf, qf, O, m, l, base, soff, lim, lo, lane);
    }
    __builtin_amdgcn_s_barrier();
#pragma unroll
    for (int rg = 0; rg < 2; ++rg) {
      float lt = l[rg]; lt = xsum<16>(lt); lt = xsum<32>(lt);
      const float g1 = sigmoid_f(bf2f(Hb[(unsigned)trow[rg] * P0 + C_NG + hh * 3 + 1]));
#pragma unroll
      for (int dt = 0; dt < 4; ++dt) stash[(rg * 4 + dt) * 512] += O[rg][dt] * (g1 / lt);
    }
  }
  {
    const int b0 = sb >= 8 ? sb - 8 : 0;
    const int nt = sb - b0 + 1;
#pragma unroll
    for (int rg = 0; rg < 2; ++rg) { m[rg] = -1e30f; l[rg] = 0.f;
#pragma unroll
      for (int dt = 0; dt < 4; ++dt) O[rg][dt] = (f32x4){0.f, 0.f, 0.f, 0.f}; }
    const bf16_t* Kg = Hb + C_KWIN + grp * 64;
    const bf16_t* Vg = Hb + C_VWIN + grp * 64;
    asm volatile("s_waitcnt vmcnt(0)" ::: "memory");
#pragma unroll
    for (int st = 0; st < 3; ++st) if (st < nt) at_stage_dma(lds + st * AT_BUF, Kg + (size_t)(b0 + st) * 64 * P0, Vg + (size_t)(b0 + st) * 64 * P0, P0, lane, wid);
    for (int ti = 0; ti < nt; ++ti) {
      ring_wait(min(nt - 1 - ti, 2));
      const int cblk = b0 + ti;
      if (ti + 3 < nt) at_stage_dma(lds + ((ti + 3) & 3) * AT_BUF, Kg + (size_t)(cblk + 3) * 64 * P0, Vg + (size_t)(cblk + 3) * 64 * P0, P0, lane, wid);
      LAS const unsigned char* buf = lds + (ti & 3) * AT_BUF;
      float base[2], soff[2]; int lim[2], lo[2];
#pragma unroll
      for (int rg = 0; rg < 2; ++rg) {
        base[rg] = slope2 * (float)(cblk * 64 + 4 * g - trow[rg]);
        soff[rg] = slope2; lim[rg] = trow[rg] - cblk * 64 - 4 * g; lo[rg] = trow[rg] - 511 - cblk * 64 - 4 * g;
      }
      if (cblk == sb || cblk == sb - 8) at_tile<2, true>(buf, qf, O, m, l, base, soff, lim, lo, lane);
      else at_tile<2, false>(buf, qf, O, m, l, base, soff, lim, lo, lane);
    }
    __builtin_amdgcn_s_barrier();
  }
#pragma unroll
  for (int rg = 0; rg < 2; ++rg) {
    float lt = l[rg]; lt = xsum<16>(lt); lt = xsum<32>(lt);
    const unsigned ro = (unsigned)trow[rg] * P0;
    const float g2 = sigmoid_f(bf2f(Hb[ro + C_NG + hh * 3 + 2])) / lt;
#pragma unroll
    for (int dt = 0; dt < 4; ++dt) {
      const int dv = 16 * dt + 4 * g;
      const ushort4 zz = *(const ushort4*)(Hb + ro + C_NZ + hh * 64 + dv);
      const f32x4 ov = stash[(rg * 4 + dt) * 512] + O[rg][dt] * g2;
      ushort4 o4;
      o4.x = f2bf(ov[0] * silu_f(bf2f(zz.x))); o4.y = f2bf(ov[1] * silu_f(bf2f(zz.y)));
      o4.z = f2bf(ov[2] * silu_f(bf2f(zz.z))); o4.w = f2bf(ov[3] * silu_f(bf2f(zz.w)));
      *(ushort4*)(MIX + (size_t)b * S_ * D_ + (unsigned)trow[rg] * D_ + hh * 64 + dv) = o4;
    }
  }
}

__device__ __forceinline__ void gla_gate_phase(const Params& P) {
  const bf16_t* H1 = (const bf16_t*)(P.ws + WS_H);
  float* G = (float*)(P.ws + WS_G);
  const float* w2 = P.in[10]; const float* gb = P.in[11];
  const size_t total = (size_t)M_ * 512;
  for (size_t i = (size_t)blockIdx.x * 512 + otid(); i < total; i += (size_t)gridDim.x * 512) {
    const int c = (int)(i & 511); const size_t row = i >> 9;
    float x = gb[c];
#pragma unroll
    for (int r = 0; r < 16; ++r) x += bf2f(H1[row * P1 + G_LR + r]) * w2[r * 512 + c];
    const float ls = fminf(x, 0.f) - log1pf(__expf(-fabsf(x)));
    G[i] = ls * (1.f / 16.f);
  }
}
__device__ __forceinline__ void gla_scan_vblock(const Params& P, int vb) {
  const bf16_t* __restrict__ H1 = (const bf16_t*)(P.ws + WS_H);
  const float* __restrict__ G = (const float*)(P.ws + WS_G);
  bf16_t* __restrict__ O = (bf16_t*)(P.ws + WS_XB);
  const int tid = otid(), lane = tid & 63, wid = tid >> 6;
  const int eh = vb & 1, h = (vb >> 1) & 3, b = vb >> 3;
  const int e = eh * 128 + wid * 16 + (lane >> 2), dq = lane & 3;
  float St[32];
#pragma unroll
  for (int i = 0; i < 32; ++i) St[i] = 0.f;
  const float qscale = 0.08838834764831845f;
  for (int t = 0; t < S_; ++t) {
    const size_t row = (size_t)b * S_ + t;
    const float4* gr = (const float4*)(G + row * 512 + h * 128 + dq * 32);
    const uint4* kr = (const uint4*)(H1 + row * P1 + G_K + h * 128 + dq * 32);
    const uint4* qr = (const uint4*)(H1 + row * P1 + G_Q + h * 128 + dq * 32);
    const float v = bf2f(H1[row * P1 + G_V + h * 256 + e]);
    float o = 0.f;
#pragma unroll
    for (int c = 0; c < 4; ++c) {
      const uint4 ku = kr[c], qu = qr[c];
      const float4 g0 = gr[2 * c], g1 = gr[2 * c + 1];
      const float kk[8] = {__uint_as_float(ku.x << 16), __uint_as_float(ku.x & 0xffff0000u), __uint_as_float(ku.y << 16), __uint_as_float(ku.y & 0xffff0000u),
                           __uint_as_float(ku.z << 16), __uint_as_float(ku.z & 0xffff0000u), __uint_as_float(ku.w << 16), __uint_as_float(ku.w & 0xffff0000u)};
      const float qq[8] = {__uint_as_float(qu.x << 16), __uint_as_float(qu.x & 0xffff0000u), __uint_as_float(qu.y << 16), __uint_as_float(qu.y & 0xffff0000u),
                           __uint_as_float(qu.z << 16), __uint_as_float(qu.z & 0xffff0000u), __uint_as_float(qu.w << 16), __uint_as_float(qu.w & 0xffff0000u)};
      const float gg[8] = {g0.x, g0.y, g0.z, g0.w, g1.x, g1.y, g1.z, g1.w};
#pragma unroll
      for (int i = 0; i < 8; ++i) {
        const float a = __expf(gg[i]);
        St[c * 8 + i] = a * St[c * 8 + i] + kk[i] * v;
        o += qq[i] * St[c * 8 + i];
      }
    }
    o = xsum<1>(o); o = xsum<2>(o);
    if (dq == 0) O[row * D_ + h * 256 + e] = f2bf(o * qscale);
  }
}

constexpr size_t WS_QT = WS_G;
constexpr size_t WS_KH = WS_G + 16 * MiB;
constexpr size_t WS_ATT = 190 * MiB;
constexpr size_t WS_DEC = 199 * MiB;
__device__ __forceinline__ int kperm(int x) { const int dl = x & 31, hi = dl >> 4, d2 = dl & 15; return (x & ~31) + 8 * (d2 >> 2) + 4 * hi + (d2 & 3); }

__device__ __forceinline__ void gla_prep_item(const Params& P, int item, unsigned char* smem_g) {
  const bf16_t* __restrict__ H1 = (const bf16_t*)(P.ws + WS_H);
  bf16_t* __restrict__ QT = (bf16_t*)(P.ws + WS_QT) + (size_t)item * 8192;
  bf16_t* __restrict__ KH = (bf16_t*)(P.ws + WS_KH) + (size_t)item * 8192;
  bf16_t* __restrict__ ATT = (bf16_t*)(P.ws + WS_ATT) + (size_t)item * 4096;
  float* __restrict__ DEC = (float*)(P.ws + WS_DEC) + (size_t)item * 128;
  const int tid = otid(), lane = tid & 63, wid = tid >> 6, g = lane >> 4, i = lane & 15;
  const int c = item & 63, h = (item >> 6) & 3, b = item >> 8;
  const size_t rowbase = (size_t)b * S_ + c * 64;
  float* glr = (float*)smem_g;
  float* tot = (float*)(smem_g + 4096);
  bf16_t* qs = (bf16_t*)(smem_g + 6144);
  bf16_t* ks = (bf16_t*)(smem_g + 6144 + 17408);
  const int d = tid & 127, ig = tid >> 7;
#pragma unroll
  for (int k = 0; k < 2; ++k) { const int e = tid + 512 * k; glr[e] = bf2f(H1[(rowbase + (e >> 4)) * P1 + G_LR + (e & 15)]); }
  float w[16];
#pragma unroll
  for (int r = 0; r < 16; ++r) w[r] = P.in[10][r * 512 + h * 128 + d];
  const float gb = P.in[11][h * 128 + d];
  __syncthreads();
  float bb[16]; float run = 0.f;
#pragma unroll
  for (int k = 0; k < 16; ++k) {
    const float* gr = glr + (16 * ig + k) * 16;
    float x = gb;
#pragma unroll
    for (int r = 0; r < 16; ++r) x += gr[r] * w[r];
    const float la = (fminf(x, 0.f) - log1pf(__expf(-fabsf(x)))) * (1.f / 16.f);
    run += la; bb[k] = run;
  }
  tot[ig * 128 + d] = run;
  __syncthreads();
  float off = 0.f, total = 0.f;
#pragma unroll
  for (int q = 0; q < 4; ++q) { const float tv = tot[q * 128 + d]; total += tv; if (q < ig) off += tv; }
  const float qscale = 0.08838834764831845f;
  const int dp = kperm(d);
#pragma unroll
  for (int k = 0; k < 16; ++k) {
    const int r = 16 * ig + k;
    const float bv = bb[k] + off;
    const float qv = bf2f(H1[(rowbase + r) * P1 + G_Q + h * 128 + d]), kv = bf2f(H1[(rowbase + r) * P1 + G_K + h * 128 + d]);
    const float eb = __expf(bv);
    const bf16_t qt = f2bf(qv * eb * qscale), kt = f2bf(kv * __expf(-bv)), kh = f2bf(kv * __expf(total - bv));
    qs[r * 136 + d] = qt; ks[r * 136 + d] = kt;
    QT[r * 128 + dp] = qt; KH[r * 128 + d] = kh;
  }
  if (ig == 0) DEC[d] = __expf(total);
  __syncthreads();
  {
    const int it = wid >> 1, jt0 = 2 * (wid & 1);
    f32x4 acc[2] = {(f32x4){0.f, 0.f, 0.f, 0.f}, (f32x4){0.f, 0.f, 0.f, 0.f}};
#pragma unroll
    for (int kk = 0; kk < 4; ++kk) {
      const bf16x8 a = *(const bf16x8*)(qs + (16 * it + i) * 136 + 32 * kk + 8 * g);
#pragma unroll
      for (int n = 0; n < 2; ++n) {
        const bf16x8 bf = *(const bf16x8*)(ks + (16 * (jt0 + n) + i) * 136 + 32 * kk + 8 * g);
        acc[n] = __builtin_amdgcn_mfma_f32_16x16x32_bf16(a, bf, acc[n], 0, 0, 0);
      }
    }
#pragma unroll
    for (int n = 0; n < 2; ++n)
#pragma unroll
      for (int r = 0; r < 4; ++r) {
        const int ri = 16 * it + 4 * g + r, cj = 16 * (jt0 + n) + i;
        ATT[ri * 64 + kperm(cj)] = f2bf(cj <= ri ? acc[n][r] : 0.f);
      }
  }
  __syncthreads();
}

constexpr int GS_Q = 0, GS_K = 16384, GS_V = 32768, GS_A = 49152, GS_D = 57344, GS_BYTES = 57856;
__device__ __forceinline__ void gla_stage_dma(LAS unsigned char* st, const Params& P, int item, size_t rowbase, int h, int eh, int lane, int wid) {
  const bf16_t* QT = (const bf16_t*)(P.ws + WS_QT) + (size_t)item * 8192;
  const bf16_t* KH = (const bf16_t*)(P.ws + WS_KH) + (size_t)item * 8192;
  const bf16_t* ATT = (const bf16_t*)(P.ws + WS_ATT) + (size_t)item * 4096;
  const bf16_t* V = (const bf16_t*)(P.ws + WS_H) + rowbase * P1 + G_V + h * 256 + eh * 128;
#pragma unroll
  for (int n = 0; n < 2; ++n) {
    const int q = 2 * wid + n;
    { const int row = 4 * q + (lane >> 4), ch = (lane & 15) ^ (row & 15);
      __builtin_amdgcn_global_load_lds((const unsigned*)(QT + row * 128 + ch * 8), (LAS unsigned*)(st + GS_Q + q * 1024), 16, 0, 0); }
    { const int dt = q >> 1, j = 32 * (q & 1) + (lane >> 1);
      __builtin_amdgcn_global_load_lds((const unsigned*)(KH + j * 128 + dt * 16 + (lane & 1) * 8), (LAS unsigned*)(st + GS_K + q * 1024), 16, 0, 0);
      __builtin_amdgcn_global_load_lds((const unsigned*)(V + (unsigned)j * P1 + dt * 16 + (lane & 1) * 8), (LAS unsigned*)(st + GS_V + q * 1024), 16, 0, 0); }
  }
  { const int row = 8 * wid + (lane >> 3), ch = (lane & 7) ^ ((row >> 1) & 7);
    __builtin_amdgcn_global_load_lds((const unsigned*)(ATT + row * 64 + ch * 8), (LAS unsigned*)(st + GS_A + wid * 1024), 16, 0, 0); }
  if (wid < 2) __builtin_amdgcn_global_load_lds((const unsigned*)((const float*)(P.ws + WS_DEC) + (size_t)item * 128 + wid * 64 + lane), (LAS unsigned*)(st + GS_D + wid * 256), 4, 0, 0);
}
__device__ __forceinline__ void gla_chain(const Params& P, int chain, unsigned char* smem_g) {
  LAS unsigned char* lds = (LAS unsigned char*)smem_g;
  bf16_t* __restrict__ O = (bf16_t*)(P.ws + WS_XB);
  const int tid = otid(), lane = tid & 63, wid = __builtin_amdgcn_readfirstlane(tid >> 6), g = lane >> 4, i = lane & 15;
  const int eh = chain & 1, h = (chain >> 1) & 3, b = chain >> 3;
  const int item0 = (b * 4 + h) * 64;
  f32x4 S[8];
#pragma unroll
  for (int dt = 0; dt < 8; ++dt) S[dt] = (f32x4){0.f, 0.f, 0.f, 0.f};
  gla_stage_dma(lds, P, item0, (size_t)b * S_, h, eh, lane, wid);
  __syncthreads();
  for (int c = 0; c < 64; ++c) {
    if (c + 1 < 64) gla_stage_dma(lds + ((c + 1) & 1) * GS_BYTES, P, item0 + c + 1, (size_t)b * S_ + (c + 1) * 64, h, eh, lane, wid);
    LAS const unsigned char* st = lds + (c & 1) * GS_BYTES;
    f32x4 dc[8];
#pragma unroll
    for (int dt = 0; dt < 8; ++dt) dc[dt] = *(LAS const f32x4*)(st + GS_D + (16 * dt + 4 * g) * 4);
    u32x4 spk[4];
#pragma unroll
    for (int kk = 0; kk < 4; ++kk) {
      spk[kk][0] = cvtpk(S[2 * kk][0], S[2 * kk][1]); spk[kk][1] = cvtpk(S[2 * kk][2], S[2 * kk][3]);
      spk[kk][2] = cvtpk(S[2 * kk + 1][0], S[2 * kk + 1][1]); spk[kk][3] = cvtpk(S[2 * kk + 1][2], S[2 * kk + 1][3]);
    }
    bf16x8 vf[2];
    const unsigned trb = (unsigned)(unsigned long long)st + (4 * g + (i >> 2)) * 32 + (i & 3) * 8;
    {
      const unsigned vb = trb + GS_V + wid * 2048;
      const s16x4 v0 = vtra<0>(vb), v1 = vtra<512>(vb), v2 = vtra<1024>(vb), v3 = vtra<1536>(vb);
      LGKM0();
      vf[0] = (bf16x8){v0[0], v0[1], v0[2], v0[3], v1[0], v1[1], v1[2], v1[3]};
      vf[1] = (bf16x8){v2[0], v2[1], v2[2], v2[3], v3[0], v3[1], v3[2], v3[3]};
    }
#pragma unroll
    for (int it = 0; it < 4; ++it) {
      f32x4 acc = (f32x4){0.f, 0.f, 0.f, 0.f};
      LAS const unsigned char* qrow = st + GS_Q + (16 * it + i) * 256;
#pragma unroll
      for (int kk = 0; kk < 4; ++kk) {
        const bf16x8 a = *(LAS const bf16x8*)(qrow + (((4 * kk + g) ^ i) << 4));
        acc = __builtin_amdgcn_mfma_f32_16x16x32_bf16(a, __builtin_bit_cast(bf16x8, spk[kk]), acc, 0, 0, 0);
      }
      LAS const unsigned char* arow = st + GS_A + (16 * it + i) * 128;
#pragma unroll
      for (int k2 = 0; k2 < 2; ++k2) {
        const bf16x8 a = *(LAS const bf16x8*)(arow + (((4 * k2 + g) ^ ((i >> 1) & 7)) << 4));
        acc = __builtin_amdgcn_mfma_f32_16x16x32_bf16(a, vf[k2], acc, 0, 0, 0);
      }
      bf16_t* op = O + ((size_t)b * S_ + c * 64 + 16 * it + 4 * g) * D_ + h * 256 + eh * 128 + 16 * wid + i;
#pragma unroll
      for (int r = 0; r < 4; ++r) op[(size_t)r * D_] = f2bf(acc[r]);
    }
    __builtin_amdgcn_sched_barrier(0);
#define GL_KRD(dt, q0, q1, q2, q3) { q0 = vtra<GS_K + (dt) * 2048>(trb); q1 = vtra<GS_K + (dt) * 2048 + 512>(trb); q2 = vtra<GS_K + (dt) * 2048 + 1024>(trb); q3 = vtra<GS_K + (dt) * 2048 + 1536>(trb); }
#define GL_UPD(dt, q0, q1, q2, q3) { S[dt] = S[dt] * dc[dt]; \
      S[dt] = __builtin_amdgcn_mfma_f32_16x16x32_bf16((bf16x8){q0[0], q0[1], q0[2], q0[3], q1[0], q1[1], q1[2], q1[3]}, vf[0], S[dt], 0, 0, 0); \
      S[dt] = __builtin_amdgcn_mfma_f32_16x16x32_bf16((bf16x8){q2[0], q2[1], q2[2], q2[3], q3[0], q3[1], q3[2], q3[3]}, vf[1], S[dt], 0, 0, 0); }
    {
      s16x4 e0, e1, e2, e3, e4, e5, e6, e7, f0, f1, f2, f3, f4, f5, f6, f7;
      GL_KRD(0, e0, e1, e2, e3) GL_KRD(1, e4, e5, e6, e7)
      LGKM0();
      GL_KRD(2, f0, f1, f2, f3) GL_KRD(3, f4, f5, f6, f7)
      GL_UPD(0, e0, e1, e2, e3) GL_UPD(1, e4, e5, e6, e7)
      LGKM0();
      GL_KRD(4, e0, e1, e2, e3) GL_KRD(5, e4, e5, e6, e7)
      GL_UPD(2, f0, f1, f2, f3) GL_UPD(3, f4, f5, f6, f7)
      LGKM0();
      GL_KRD(6, f0, f1, f2, f3) GL_KRD(7, f4, f5, f6, f7)
      GL_UPD(4, e0, e1, e2, e3) GL_UPD(5, e4, e5, e6, e7)
      LGKM0();
      GL_UPD(6, f0, f1, f2, f3) GL_UPD(7, f4, f5, f6, f7)
    }
#undef GL_KRD
#undef GL_UPD
    __syncthreads();
  }
}

__device__ __forceinline__ void gla_norm_phase(const Params& P) {
  const bf16_t* H1 = (const bf16_t*)(P.ws + WS_H);
  const bf16_t* O = (const bf16_t*)(P.ws + WS_XB);
  bf16_t* MIX = (bf16_t*)(P.ws + WS_MIX);
  const float* gn = P.in[12];
  const int lane = otid() & 63, wid = otid() >> 6;
  for (int it = blockIdx.x * 8 + wid; it < M_ * 4; it += gridDim.x * 8) {
    const int h = it & 3; const size_t row = it >> 2;
    float v[4]; float ss = 0.f;
#pragma unroll
    for (int k = 0; k < 4; ++k) { v[k] = bf2f(O[row * D_ + h * 256 + k * 64 + lane]); ss += v[k] * v[k]; }
    const float r = 1.f / sqrtf(wave_sum(ss) * (1.f / 256.f) + LN_EPS);
#pragma unroll
    for (int k = 0; k < 4; ++k) {
      const int c = h * 256 + k * 64 + lane;
      const float z = bf2f(H1[row * P1 + G_Z + c]);
      MIX[row * D_ + c] = f2bf(v[k] * r * gn[c] * silu_f(z));
    }
  }
}

#define XB_TMO      128
#define XB_XCNT(j)  (256  + 64 * (j))
#define XB_XSUB(j)  (1280 + 64 * (j))
#define XB_XGEN(j)  (2304 + 64 * (j))
#define XB_TOP      3328
#define XB_TOPGEN   3392
#define XCD_BAR_WORDS 3456
#define XB_SPIN_CAP (1u << 18)

__device__ __forceinline__ unsigned xb_ld(unsigned* p)              { return __hip_atomic_load(p, __ATOMIC_RELAXED, __HIP_MEMORY_SCOPE_AGENT); }
__device__ __forceinline__ unsigned xb_add(unsigned* p, unsigned v) { return __hip_atomic_fetch_add(p, v, __ATOMIC_RELAXED, __HIP_MEMORY_SCOPE_AGENT); }
__device__ __forceinline__ unsigned xb_xcc_id() { return (unsigned)__builtin_amdgcn_s_getreg((3 << 11) | 20) & 0xFu; }
#define XB_SPIN(cond, bar) do { unsigned _sp = 0; while (cond) { __builtin_amdgcn_s_sleep(1); \
    if ((++_sp & 255u) == 0u) { if (xb_ld(&(bar)[XB_TMO])) break; if (_sp > XB_SPIN_CAP) { atomicAdd(&(bar)[XB_TMO], 1u); break; } } } } while (0)

struct XcdBarrier {
    unsigned* bar; unsigned x;
    volatile LAS unsigned* st;
};

__device__ __forceinline__ XcdBarrier xcd_barrier_post(unsigned* bar, volatile LAS unsigned* st) {
    XcdBarrier b; b.bar = bar; b.x = xb_xcc_id(); b.st = st;
    if (threadIdx.x == 0) (void)xb_add(&bar[XB_XCNT(b.x)], 1u);
    return b;
}
__device__ __forceinline__ void xcd_barrier_complete(unsigned* bar, unsigned x, unsigned& nloc, unsigned& nx) {
    const unsigned G = gridDim.x * gridDim.y * gridDim.z;
    unsigned sum, cnt, mine, sp = 0u;
    for (;;) {
        sum = 0u; cnt = 0u; mine = 0u;
#pragma unroll
        for (unsigned j = 0; j < 16; ++j) { const unsigned c = xb_ld(&bar[XB_XCNT(j)]); sum += c; cnt += (c > 0u) ? 1u : 0u; mine = (j == x) ? c : mine; }
        if (sum == G) break;
        __builtin_amdgcn_s_sleep(1);
        if ((++sp & 255u) == 0u) { if (xb_ld(&bar[XB_TMO])) break; if (sp > XB_SPIN_CAP) { atomicAdd(&bar[XB_TMO], 1u); break; } }
    }
    nloc = mine > 0u ? mine : 1u; nx = cnt > 0u ? cnt : 1u;
}

__device__ __forceinline__ void xcd_barrier(const XcdBarrier& b) {
    asm volatile("s_waitcnt vmcnt(0)" ::: "memory");
    __syncthreads();
    if (threadIdx.x == 0) {
        unsigned* bar = b.bar;
        __builtin_amdgcn_s_waitcnt(0);
        unsigned nloc = b.st[0], nx = b.st[1];
        if (nloc == 0u) { xcd_barrier_complete(bar, b.x, nloc, nx); b.st[0] = nloc; b.st[1] = nx; }
        const unsigned old = xb_add(&bar[XB_XSUB(b.x)], 1u);
        const unsigned gen = old / nloc;
        if (old + 1u == (gen + 1u) * nloc) {
            __builtin_amdgcn_fence(__ATOMIC_RELEASE, "agent");
            asm volatile("s_waitcnt vmcnt(0)" ::: "memory");
            const unsigned og = xb_add(&bar[XB_TOP], 1u);
            const unsigned tg = og / nx;
            if (og + 1u == (tg + 1u) * nx) xb_add(&bar[XB_TOPGEN], 1u);
            else XB_SPIN(xb_ld(&bar[XB_TOPGEN]) == tg, bar);
            __builtin_amdgcn_fence(__ATOMIC_ACQUIRE, "agent");
            xb_add(&bar[XB_XGEN(b.x)], 1u);
            asm volatile("s_waitcnt vmcnt(0)" ::: "memory");
        } else {
            XB_SPIN(xb_ld(&bar[XB_XGEN(b.x)]) == gen, bar);
            __builtin_amdgcn_fence(__ATOMIC_ACQUIRE, "agent");
            asm volatile("s_waitcnt vmcnt(0)" ::: "memory");
        }
    }
    __syncthreads();
}


__device__ const unsigned short p3_order[1024] = {15,31,47,63,79,95,111,127,143,159,175,191,207,223,239,255,271,287,303,319,335,351,367,383,399,415,431,447,463,479,495,511,14,30,46,62,78,94,110,126,142,158,174,190,206,222,238,254,270,286,302,318,334,350,366,382,398,414,430,446,462,478,494,510,13,29,45,61,77,93,109,125,141,157,173,189,205,221,237,253,269,285,301,317,333,349,365,381,397,413,429,445,461,477,493,509,12,28,44,60,76,92,108,124,140,156,172,188,204,220,236,252,268,284,300,316,332,348,364,380,396,412,428,444,460,476,492,508,11,27,43,59,75,91,107,123,139,155,171,187,203,219,235,251,267,283,299,315,331,347,363,379,395,411,427,443,459,475,491,507,624,625,626,627,628,629,630,631,632,633,634,635,636,637,638,639,752,753,754,755,756,757,758,759,760,761,762,763,764,765,766,767,880,881,882,883,884,885,886,887,888,889,890,891,892,893,894,895,1008,1009,1010,1011,1012,1013,1014,1015,1016,1017,1018,1019,1020,1021,1022,1023,608,609,610,611,612,613,614,615,616,617,618,619,620,621,622,623,736,737,738,739,740,741,742,743,744,745,746,747,748,749,750,751,864,865,866,867,868,869,870,871,872,873,874,875,876,877,878,879,992,993,994,995,996,997,998,999,1000,1001,1002,1003,1004,1005,1006,1007,10,26,42,58,74,90,106,122,605,606,607,138,154,170,186,202,218,234,250,733,734,735,266,282,298,314,330,346,362,378,861,862,863,394,410,426,442,458,474,490,506,989,990,991,604,732,860,988,603,731,859,987,602,730,858,986,9,25,41,57,73,89,105,121,601,137,153,169,185,201,217,233,249,729,265,281,297,313,329,345,361,377,857,393,409,425,441,457,473,489,505,985,600,728,856,984,599,727,855,983,598,726,854,982,8,24,40,56,72,88,104,120,597,136,152,168,184,200,216,232,248,725,264,280,296,312,328,344,360,376,853,392,408,424,440,456,472,488,504,981,596,724,852,980,560,561,562,563,564,565,566,567,568,569,570,571,572,573,574,575,595,688,689,690,691,692,693,694,695,696,697,698,699,700,701,702,703,723,816,817,818,819,820,821,822,823,824,825,826,827,828,829,830,831,851,944,945,946,947,948,949,950,951,952,953,954,955,956,957,958,959,979,544,545,546,547,548,549,550,551,552,553,554,555,556,557,558,559,594,672,673,674,675,676,677,678,679,680,681,682,683,684,685,686,687,722,800,801,802,803,804,805,806,807,808,809,810,811,812,813,814,815,850,928,929,930,931,932,933,934,935,936,937,938,939,940,941,942,943,978,7,23,39,55,71,87,103,119,529,530,531,532,533,534,535,536,537,538,539,540,541,542,543,593,135,151,167,183,199,215,231,247,657,658,659,660,661,662,663,664,665,666,667,668,669,670,671,721,263,279,295,311,327,343,359,375,785,786,787,788,789,790,791,792,793,794,795,796,797,798,799,849,391,407,423,439,455,471,487,503,913,914,915,916,917,918,919,920,921,922,923,924,925,926,927,977,528,592,656,720,784,848,912,976,527,591,655,719,783,847,911,975,6,22,38,54,70,86,102,118,526,590,134,150,166,182,198,214,230,246,654,718,262,278,294,310,326,342,358,374,782,846,390,406,422,438,454,470,486,502,910,974,525,589,653,717,781,845,909,973,524,588,652,716,780,844,908,972,523,587,651,715,779,843,907,971,5,21,37,53,69,85,101,117,522,586,133,149,165,181,197,213,229,245,650,714,261,277,293,309,325,341,357,373,778,842,389,405,421,437,453,469,485,501,906,970,521,585,649,713,777,841,905,969,520,584,648,712,776,840,904,968,4,20,36,52,68,84,100,116,519,583,132,148,164,180,196,212,228,244,647,711,260,276,292,308,324,340,356,372,775,839,388,404,420,436,452,468,484,500,903,967,518,582,646,710,774,838,902,966,3,19,35,51,67,83,99,115,517,581,131,147,163,179,195,211,227,243,645,709,259,275,291,307,323,339,355,371,773,837,387,403,419,435,451,467,483,499,901,965,516,580,644,708,772,836,900,964,2,18,34,50,66,82,98,114,515,579,130,146,162,178,194,210,226,242,643,707,258,274,290,306,322,338,354,370,771,835,386,402,418,434,450,466,482,498,899,963,514,578,642,706,770,834,898,962,1,17,33,49,65,81,97,113,513,577,129,145,161,177,193,209,225,241,641,705,257,273,289,305,321,337,353,369,769,833,385,401,417,433,449,465,481,497,897,961,512,576,640,704,768,832,896,960,0,16,32,48,64,80,96,112,128,144,160,176,192,208,224,240,256,272,288,304,320,336,352,368,384,400,416,432,448,464,480,496};
constexpr int CTL_P3_QUEUE = 8192;

#ifndef REP_P0
#define REP_P0 1
#endif
#ifndef REP_P2
#define REP_P2 1
#endif
#ifndef REP_P3
#define REP_P3 1
#endif
#ifndef REP_P7
#define REP_P7 1
#endif
#ifndef REP_P8
#define REP_P8 1
#endif
__global__ void __launch_bounds__(512) fwd_megakernel(Params P) {
  cg::grid_group grid = cg::this_grid();
  extern __shared__ __attribute__((aligned(16))) unsigned char smem[];
  const int tid = otid(), lane = tid & 63, wid = tid >> 6;
  unsigned char* ws = P.ws;
  bf16_t* XB = (bf16_t*)(ws + WS_XB);
  bf16_t* MIX = (bf16_t*)(ws + WS_MIX);
  bf16_t* Hb = (bf16_t*)(ws + WS_H);
  float* Y = (float*)(ws + WS_H);
  volatile LAS unsigned* xst = (volatile LAS unsigned*)((LAS unsigned char*)smem + XB_LDS_OFF);
  if (tid < 4) xst[tid] = 0u;
  __syncthreads();
  (void)xcd_barrier_post((unsigned*)ws, xst);
#define GRID_BAR() do { XcdBarrier xb_; xb_.bar = (unsigned*)P.ws; xb_.x = xb_xcc_id(); xb_.st = (volatile LAS unsigned*)((LAS unsigned char*)smem + XB_LDS_OFF); xcd_barrier(xb_); } while (0)

  for (int rep = 0; rep < REP_P0; ++rep) {
    const float4* x4 = (const float4*)P.in[0];
    const size_t n4 = (size_t)M_ * D_ / 4;
    for (size_t i = (size_t)blockIdx.x * 512 + tid; i < n4; i += (size_t)gridDim.x * 512) {
      const float4 v = x4[i]; ushort4 o; o.x = f2bf(v.x); o.y = f2bf(v.y); o.z = f2bf(v.z); o.w = f2bf(v.w);
      ((ushort4*)XB)[i] = o;
    }
    constexpr int T0 = (P0 / 64) * 16, T1 = 16 * 16, T2 = (P1 / 64) * 16, T3 = 16 * 16;
    for (int it = blockIdx.x; it < T0 + T1 + T2 + T3; it += gridDim.x) {
      int r = it;
      if (r < T0) { transpose_tile(P.in[1], D_, EVEN_IN, (bf16_t*)(ws + WS_WT0), 0, r, P0 / 64, (float*)smem); continue; } r -= T0;
      if (r < T1) { transpose_tile(P.in[6], D_, D_, (bf16_t*)(ws + WS_WO0), 2, r, 16, (float*)smem); continue; } r -= T1;
      if (r < T2) { transpose_tile(P.in[9], D_, ODD_IN, (bf16_t*)(ws + WS_WT1), 1, r, P1 / 64, (float*)smem); continue; } r -= T2;
      transpose_tile(P.in[13], D_, D_, (bf16_t*)(ws + WS_WO1), 2, r, 16, (float*)smem);
    }
    for (int it = blockIdx.x; it < 2 * 64 + 2 * 2 + 64; it += gridDim.x) {
      if (it < 128) { const int i = it >> 6; transpose_tile(P.in[3] + (size_t)i * 2048 * 128, 2048, 128, (bf16_t*)(ws + WS_W1T) + (size_t)i * 128 * 2048, 2, it & 63, 2, (float*)smem); }
      else if (it < 132) { const int i = (it - 128) >> 1; transpose_tile(P.in[5] + (size_t)i * 128 * 64, 128, 64, (bf16_t*)(ws + WS_W2T) + (size_t)i * 64 * 128, 2, (it - 128) & 1, 1, (float*)smem); }
      else {
        const int t2 = it - 132, i = t2 >> 5, q = t2 & 31, hh = tid & 127, sub = tid >> 7;
        const float* pos = P.in[2] + i * 2048 + q * 64 + sub * 16;
        const float* w1 = P.in[3] + ((size_t)i * 2048 + q * 64 + sub * 16) * 128 + hh;
        float a = 0.f;
#pragma unroll
        for (int f = 0; f < 16; ++f) a += pos[f] * w1[f * 128];
        float* red = (float*)smem;
        red[sub * 128 + hh] = a;
        __syncthreads();
        if (tid < 128) ((float*)(ws + WS_C1P))[(i * 32 + q) * 128 + tid] = (red[tid] + red[128 + tid]) + (red[256 + tid] + red[384 + tid]);
        __syncthreads();
      }
    }
    if (blockIdx.x == 0) { const int which = tid >> 8, r = tid & 255;
      unsigned* z = (unsigned*)(ws + (which == 0 ? (size_t)(248 * MiB) : (size_t)(249 * MiB)));
      const int bg = r >> 5, wd = r & 31; z[((size_t)bg * 256 + 255) * 32 + wd] = 0u; }
    GRID_BAR();
  }
  if (P.out == nullptr) grid.sync();
  { pg8::Gemm gm{XB, (const bf16_t*)(ws + WS_WT0), M_, P0, D_}; pg8::StaticOrder so; so.init(M_, P0, (int)gridDim.x, (int)blockIdx.x);
    pg8::EpiBf16s ep{Hb, P0}; pg8::gemm_phase<pg8::EpiBf16s, pg8::StaticOrder, true, true>((LAS unsigned char*)smem, gm, so, ep); }
  GRID_BAR();
  for (int rep = 0; rep < REP_P2; ++rep) {
    for (int it = blockIdx.x; it < 256; it += gridDim.x) compress_mfma_tile(P, it, smem);
    for (int it = blockIdx.x; it < 64; it += gridDim.x) kmean_item2(P, it);
    GRID_BAR();
  }
  for (int rep = 0; rep < REP_P3; ++rep) {
    for (;;) {
      LAS int* qslot = (LAS int*)((LAS unsigned char*)smem + AT_MISC + 384);
      if (tid == 0) *qslot = (int)atomicAdd((unsigned*)P.ws + CTL_P3_QUEUE, 1u) - rep * 1024;
      __syncthreads();
      const int it = __builtin_amdgcn_readfirstlane(*qslot);
      __syncthreads();
      if (it >= 1024) break;
      const int e = p3_order[it], pl = e & 511;
      if (e >> 9) nsa_mfma_item(P, pl >> 7, (pl >> 6) & 1, pl & 63, smem);
      else moba_mfma_item(P, pl >> 7, (pl >> 4) & 7, pl & 15, smem);
    }
    GRID_BAR();
  }
  { pg8::Gemm gm{MIX, (const bf16_t*)(ws + WS_WO0), M_, D_, D_}; pg8::StaticOrder so; so.init(M_, D_, (int)gridDim.x, (int)blockIdx.x);
    pg8::EpiF32 ep{Y, D_}; pg8::gemm_phase<pg8::EpiF32, pg8::StaticOrder, true, true>((LAS unsigned char*)smem, gm, so, ep); }
  GRID_BAR();
  ln_phase(P.in[0], Y, P.in[7], P.in[8], P.out, XB);
  GRID_BAR();
  { pg8::Gemm gm{XB, (const bf16_t*)(ws + WS_WT1), M_, P1, D_}; pg8::StaticOrder so; so.init(M_, P1, (int)gridDim.x, (int)blockIdx.x);
    pg8::EpiBf16s ep{Hb, P1}; pg8::gemm_phase<pg8::EpiBf16s, pg8::StaticOrder, true, true>((LAS unsigned char*)smem, gm, so, ep); }
  GRID_BAR();
  for (int rep = 0; rep < REP_P7; ++rep) {
    for (int it = blockIdx.x; it < 1024; it += gridDim.x) gla_prep_item(P, it, smem);
    GRID_BAR();
  }
  for (int rep = 0; rep < REP_P8; ++rep) {
    for (int ch = blockIdx.x; ch < 32; ch += gridDim.x) gla_chain(P, ch, smem);
    GRID_BAR();
  }
  gla_norm_phase(P);
  GRID_BAR();
  { pg8::Gemm gm{MIX, (const bf16_t*)(ws + WS_WO1), M_, D_, D_}; pg8::StaticOrder so; so.init(M_, D_, (int)gridDim.x, (int)blockIdx.x);
    pg8::EpiF32 ep{Y, D_}; pg8::gemm_phase<pg8::EpiF32, pg8::StaticOrder, true, true>((LAS unsigned char*)smem, gm, so, ep); }
  GRID_BAR();
  ln_phase(P.out, Y, P.in[14], P.in[15], P.out, nullptr);
}

extern "C" void kernel_launch(void* const* d_in, const int* in_sizes, int n_in, void* d_out, int out_size,
                              void* d_ws, size_t ws_size, hipStream_t stream) {
  constexpr size_t kDynLds = 133120;
  static_assert(kDynLds >= (size_t)XB_LDS_OFF + 16 && (size_t)XB_LDS_OFF >= (size_t)AT_LDS_END && kDynLds >= (size_t)AT_LDS_END && kDynLds >= 2 * (size_t)GS_BYTES && kDynLds >= (size_t)pg8::STAGE_BYTES, "LDS");
  static int grid_blocks = 0;
  if (!grid_blocks) {
    int dev = 0, cus = 0, per_cu = 0;
    (void)hipGetDevice(&dev);
    (void)hipDeviceGetAttribute(&cus, hipDeviceAttributeMultiprocessorCount, dev);
    (void)hipFuncSetAttribute((const void*)fwd_megakernel, hipFuncAttributeMaxDynamicSharedMemorySize, (int)kDynLds);
    (void)hipOccupancyMaxActiveBlocksPerMultiprocessor(&per_cu, fwd_megakernel, 512, kDynLds);
    if (per_cu < 1) per_cu = 1;
    if (per_cu > 2) per_cu = 2;
    grid_blocks = cus * per_cu;
    if (n_in != 16 || ws_size < WS_END) { fprintf(stderr, "kernel_launch: unexpected n_in %d / ws %zu\n", n_in, ws_size); }
  }
  (void)hipMemsetAsync(d_ws, 0, 65536, stream);
  Params p{};
  for (int i = 0; i < 16; ++i) p.in[i] = (const float*)d_in[i];
  p.out = (float*)d_out; p.ws = (unsigned char*)d_ws;
  void* args[] = {&p};
  hipError_t e = hipLaunchCooperativeKernel((void*)fwd_megakernel, dim3(grid_blocks), dim3(512), args, kDynLds, stream);
  if (e != hipSuccess) fprintf(stderr, "cooperative launch failed: %s (grid %d)\n", hipGetErrorString(e), grid_blocks);
}
```

```cpp
#include <hip/hip_runtime.h>
#include <hip/hip_cooperative_groups.h>
#include <cstdio>
#include <cstdint>
namespace cg = cooperative_groups;

typedef unsigned short bf16_t;
typedef short bf16x8 __attribute__((ext_vector_type(8)));
typedef float f32x4 __attribute__((ext_vector_type(4)));
typedef unsigned u32x4 __attribute__((ext_vector_type(4)));
typedef unsigned u32x2 __attribute__((ext_vector_type(2)));

constexpr int B_ = 4, S_ = 4096, M_ = B_ * S_, D_ = 1024;
constexpr int P0 = 4096;
constexpr int P1 = 3328;
constexpr int EVEN_IN = 3864, ODD_IN = 3088;
constexpr int C_NQ = 0, C_KCMP = 512, C_VCMP = 640, C_KSEL = 768, C_VSEL = 896, C_KWIN = 1024, C_VWIN = 1152;
constexpr int C_NZ = 1280, C_MQ = 1792, C_MK = 2304, C_MV = 2816, C_MZ = 3328, C_NG = 3840;
constexpr int G_Q = 0, G_K = 512, G_V = 1024, G_Z = 2048, G_LR = 3072;
constexpr int NCMP = 255;
constexpr float ALPHA = 1.4142135623730951f;
constexpr float LN_EPS = 1e-5f;

constexpr size_t MiB = 1u << 20;
constexpr int XB_LDS_OFF = 157440;
constexpr size_t WS_WT0 = 1 * MiB;
constexpr size_t WS_WO0 = 9 * MiB;
constexpr size_t WS_WT1 = 11 * MiB;
constexpr size_t WS_WO1 = 18 * MiB;
constexpr size_t WS_XB = 20 * MiB;
constexpr size_t WS_MIX = 52 * MiB;
constexpr size_t WS_H = 84 * MiB;
constexpr size_t WS_G = 212 * MiB;
constexpr size_t WS_GLR = 245 * MiB;
constexpr size_t WS_SMT = 246 * MiB;
constexpr size_t WS_KC = 245 * MiB;
constexpr size_t WS_VC = 246 * MiB;
constexpr size_t WS_KM = 247 * MiB;
constexpr size_t WS_END = 256 * MiB;

struct Params { const float* in[16]; float* out; unsigned char* ws; };

__device__ __forceinline__ int otid() { int t = __builtin_amdgcn_workitem_id_x(); asm volatile("" : "+v"(t)); return t; }
__device__ __forceinline__ float bf2f(bf16_t v) { return __uint_as_float(((unsigned)v) << 16); }
__device__ __forceinline__ bf16_t f2bf(float f) { unsigned u = __float_as_uint(f); return (bf16_t)((u + 0x7fffu + ((u >> 16) & 1u)) >> 16); }
template <int M> __device__ __forceinline__ float xsum(float v) {
  if constexpr (M == 32) { auto rr = __builtin_amdgcn_permlane32_swap(__float_as_uint(v), __float_as_uint(v), false, false); return __uint_as_float(rr[0]) + __uint_as_float(rr[1]); }
  else return v + __int_as_float(__builtin_amdgcn_ds_swizzle(__float_as_int(v), (M << 10) | 0x1f));
}
template <int M> __device__ __forceinline__ float xmax(float v) {
  if constexpr (M == 32) { auto rr = __builtin_amdgcn_permlane32_swap(__float_as_uint(v), __float_as_uint(v), false, false); return fmaxf(__uint_as_float(rr[0]), __uint_as_float(rr[1])); }
  else return fmaxf(v, __int_as_float(__builtin_amdgcn_ds_swizzle(__float_as_int(v), (M << 10) | 0x1f)));
}
template <int M> __device__ __forceinline__ unsigned xorr(unsigned v) {
  if constexpr (M == 32) { auto rr = __builtin_amdgcn_permlane32_swap(v, v, false, false); return rr[0] | rr[1]; }
  else return v | (unsigned)__builtin_amdgcn_ds_swizzle((int)v, (M << 10) | 0x1f);
}
__device__ __forceinline__ float wave_sum(float v) { v = xsum<1>(v); v = xsum<2>(v); v = xsum<4>(v); v = xsum<8>(v); v = xsum<16>(v); return xsum<32>(v); }
__device__ __forceinline__ float wave_max(float v) { v = xmax<1>(v); v = xmax<2>(v); v = xmax<4>(v); v = xmax<8>(v); v = xmax<16>(v); return xmax<32>(v); }
__device__ __forceinline__ float silu_f(float z) { return z / (1.f + __expf(-z)); }
__device__ __forceinline__ float sigmoid_f(float z) { return 1.f / (1.f + __expf(-z)); }

__device__ __forceinline__ int colmap0(int c) {
  if (c < 1280) return c;
  if (c < 1792) return 1304 + (c - 1280);
  if (c < 3840) return 1816 + (c - 1792);
  if (c < 3864) return 1280 + (c - 3840);
  return -1;
}
__device__ __forceinline__ int colmap1(int c) {
  if (c < 2048) return c;
  if (c < 3072) return 2064 + (c - 2048);
  if (c < 3088) return 2048 + (c - 3072);
  return -1;
}

__device__ __forceinline__ void transpose_tile(const float* __restrict__ W, int K, int Nsrc, bf16_t* __restrict__ Wt, int which, int tile, int ntn, float* sm) {
  const int tid = otid();
  const int nb = tile % ntn, kb = tile / ntn, n0 = nb * 64, k0 = kb * 64;
#pragma unroll
  for (int i = 0; i < 8; ++i) {
    const int kk = i * 8 + (tid >> 6), nn = tid & 63;
    const int c = n0 + nn;
    const int src = which == 0 ? colmap0(c) : (which == 1 ? colmap1(c) : c);
    sm[kk * 65 + nn] = src >= 0 ? W[(size_t)(k0 + kk) * Nsrc + src] : 0.f;
  }
  __syncthreads();
#pragma unroll
  for (int i = 0; i < 8; ++i) {
    const int nn = i * 8 + (tid >> 6), kk = tid & 63;
    Wt[(size_t)(n0 + nn) * K + k0 + kk] = f2bf(sm[kk * 65 + nn]);
  }
  __syncthreads();
}


__device__ __forceinline__ void transpose_wave_tile(const float* __restrict__ W, int K, int Nsrc, bf16_t* __restrict__ Wt, int which, int tile, int ntn, float* scr, int lane) {
  const int nb = tile % ntn, kb = tile / ntn, n0 = nb * 32, k0 = kb * 64;
  const int c = n0 + (lane & 31);
  const int src = which == 0 ? colmap0(c) : (which == 1 ? colmap1(c) : c);
  float v[32];
#pragma unroll
  for (int q = 0; q < 32; ++q) { const int kk = 2 * q + (lane >> 5); v[q] = src >= 0 ? W[(size_t)(k0 + kk) * Nsrc + src] : 0.f; }
#pragma unroll
  for (int q = 0; q < 32; ++q) { const int kk = 2 * q + (lane >> 5); scr[kk * 33 + (lane & 31)] = v[q]; }
  __builtin_amdgcn_wave_barrier();
  if (which == 3) {
    const int k = k0 + lane;
#pragma unroll 8
    for (int nn = 0; nn < 32; ++nn) { const int n = n0 + nn; Wt[((size_t)(((n >> 4) * 32 + (k >> 5)) * 64 + ((k >> 3) & 3) * 16 + (n & 15))) * 8 + (k & 7)] = f2bf(scr[lane * 33 + nn]); }
  } else {
#pragma unroll 8
    for (int nn = 0; nn < 32; ++nn) Wt[(size_t)(n0 + nn) * K + k0 + lane] = f2bf(scr[lane * 33 + nn]);
  }
  __builtin_amdgcn_wave_barrier();
}

__device__ __forceinline__ void gemm_tile(const bf16_t* __restrict__ A, const bf16_t* __restrict__ Bt, int K, int m0, int n0, int mode, void* outp, int ldc, unsigned char* smem) {
  bf16_t* As = (bf16_t*)smem;
  bf16_t* Bs = As + 128 * 72;
  const int tid = otid(), lane = tid & 63, wid = tid >> 6, wm = wid >> 1, wn = wid & 1;
  f32x4 acc[2][4];
#pragma unroll
  for (int i = 0; i < 2; ++i)
#pragma unroll
    for (int j = 0; j < 4; ++j) acc[i][j] = (f32x4){0.f, 0.f, 0.f, 0.f};
  for (int k0 = 0; k0 < K; k0 += 64) {
#pragma unroll
    for (int i = 0; i < 2; ++i) {
      const int idx = tid + i * 512, r = idx >> 3, c = (idx & 7) * 8;
      *(uint4*)(As + r * 72 + c) = *(const uint4*)(A + (size_t)(m0 + r) * K + k0 + c);
      *(uint4*)(Bs + r * 72 + c) = *(const uint4*)(Bt + (size_t)(n0 + r) * K + k0 + c);
    }
    __syncthreads();
#pragma unroll
    for (int kk = 0; kk < 64; kk += 32) {
      bf16x8 a[2], b[4];
#pragma unroll
      for (int i = 0; i < 2; ++i) a[i] = *(const bf16x8*)(As + (wm * 32 + i * 16 + (lane & 15)) * 72 + kk + (lane >> 4) * 8);
#pragma unroll
      for (int j = 0; j < 4; ++j) b[j] = *(const bf16x8*)(Bs + (wn * 64 + j * 16 + (lane & 15)) * 72 + kk + (lane >> 4) * 8);
#pragma unroll
      for (int i = 0; i < 2; ++i)
#pragma unroll
        for (int j = 0; j < 4; ++j) acc[i][j] = __builtin_amdgcn_mfma_f32_16x16x32_bf16(a[i], b[j], acc[i][j], 0, 0, 0);
    }
    __syncthreads();
  }
#pragma unroll
  for (int i = 0; i < 2; ++i)
#pragma unroll
    for (int j = 0; j < 4; ++j)
#pragma unroll
      for (int r = 0; r < 4; ++r) {
        const int row = m0 + wm * 32 + i * 16 + (lane >> 4) * 4 + r, col = n0 + wn * 64 + j * 16 + (lane & 15);
        if (mode == 0) ((bf16_t*)outp)[(size_t)row * ldc + col] = f2bf(acc[i][j][r]);
        else ((float*)outp)[(size_t)row * ldc + col] = acc[i][j][r];
      }
}
__device__ __forceinline__ void gemm_phase(const bf16_t* A, const bf16_t* Bt, int K, int N, int mode, void* outp, int ldc, unsigned char* smem) {
  const int ntn = N / 128, ntm = M_ / 128;
  for (int t = blockIdx.x; t < ntn * ntm; t += gridDim.x) {
    const int tn = t % ntn, tm = t / ntn;
    gemm_tile(A, Bt, K, tm * 128, tn * 128, mode, outp, ldc, smem);
  }
}

namespace pg8 {
#define PG8_LAS __attribute__((address_space(3)))
typedef unsigned short bf16_t;
typedef short bf16x8 __attribute__((ext_vector_type(8)));
typedef float f32x4 __attribute__((ext_vector_type(4)));
typedef unsigned u32x4 __attribute__((ext_vector_type(4)));
constexpr int BM = 256, BK = 64, HALF = 128, HTB = HALF * BK * 2  , STAGE_BYTES = 8 * HTB, NXCD = 8, WGM = 8;

__host__ __device__ __forceinline__ int lds_byte(int r, int c) { const int st = (r >> 4) * 2 + (c >> 5), rr = r & 15, cc = c & 31, ob = rr * 64 + cc * 2; return st * 1024 + (ob ^ (((ob >> 9) & 1) << 5)); }
__host__ __device__ __forceinline__ void stage_rc(int b, int& R, int& C) { const int st = b / 1024, sb = b % 1024, swz = sb ^ (((sb >> 9) & 1) << 5); R = (st >> 1) * 16 + swz / 64; C = (st & 1) * 32 + (swz % 64) / 2; }
__host__ __device__ __forceinline__ int perm32(int rho) { const int n = rho >> 4, i = rho & 15; return 8 * (i >> 2) + 4 * n + (i & 3); }

__device__ __forceinline__ unsigned cvtpk(float lo, float hi) { typedef float f2 __attribute__((ext_vector_type(2))); typedef __bf16 b2 __attribute__((ext_vector_type(2))); f2 v = {lo, hi}; b2 b = __builtin_convertvector(v, b2); return __builtin_bit_cast(unsigned, b); }
template <int M> __device__ __forceinline__ float xsum_sw(float v) { return v + __int_as_float(__builtin_amdgcn_ds_swizzle(__float_as_int(v), (M << 10) | 0x1f)); }
struct Unit { int pm, pn; };
struct Gemm { const bf16_t* A; const bf16_t* Bt; int M, N, K; };

struct StaticOrder {
    int nM, nN, nwg, G, c;
    __host__ __device__ void init(int M, int N, int G_, int c_) { nM = M / BM; nN = N / BM; nwg = nM * nN; G = G_; c = c_; }
    __host__ __device__ bool next(int i, Unit& u) const {
        const long L = (long)i * G + c; if (L >= nwg) return false;
        int wgid = (int)L; { const int q = nwg / NXCD, r = nwg % NXCD, xcd = wgid % NXCD, off = wgid / NXCD; wgid = (xcd < r ? xcd * (q + 1) : r * (q + 1) + (xcd - r) * q) + off; }
        const int nig = WGM * nN, gid = wgid / nig, fm = gid * WGM, gsz = (nM - fm) < WGM ? (nM - fm) : WGM;
        u.pm = fm + ((wgid % nig) % gsz); u.pn = (wgid % nig) / gsz; return true;
    }
    __device__ __forceinline__ void a_ready(const Unit&) const {}
    __device__ __forceinline__ void done(const Unit&) const {}
};


struct EpiBf16s {
    static constexpr bool PERM = true, AFTER_DRAIN = false;
    bf16_t* O; int ldc;
    float* km; int km_pn0;
    __device__ __forceinline__ void operator()(const f32x4 (&acc)[2][2][4][2], const Unit& u, int wr, int wc, int fr, int fq) const {
        const int row0 = u.pm * BM + wr * 64 + fr, col0 = u.pn * BM + wc * 32 + 8 * fq;
#pragma unroll
        for (int ai = 0; ai < 2; ++ai)
#pragma unroll
            for (int m = 0; m < 4; ++m) { bf16_t* rowp = O + (size_t)(row0 + ai * HALF + m * 16) * ldc + col0;
#pragma unroll
                for (int bj = 0; bj < 2; ++bj) { const f32x4 v0 = acc[ai][bj][m][0], v1 = acc[ai][bj][m][1];
                    u32x4 w; w.x = cvtpk(v0[0], v0[1]); w.y = cvtpk(v0[2], v0[3]); w.z = cvtpk(v1[0], v1[1]); w.w = cvtpk(v1[2], v1[3]);
                    *(u32x4*)(rowp + bj * HALF) = w; } }
        if (km != nullptr && (u.pn == km_pn0 || u.pn == km_pn0 + 1)) {
#pragma unroll
            for (int bj = 0; bj < 2; ++bj)
#pragma unroll
                for (int n = 0; n < 2; ++n) {
                    f32x4 sacc = (f32x4){0.f, 0.f, 0.f, 0.f};
#pragma unroll
                    for (int ai = 0; ai < 2; ++ai)
#pragma unroll
                        for (int m = 0; m < 4; ++m) sacc += acc[ai][bj][m][n];
#pragma unroll
                    for (int e = 0; e < 4; ++e) { float v = sacc[e]; v = xsum_sw<1>(v); v = xsum_sw<2>(v); v = xsum_sw<4>(v); v = xsum_sw<8>(v); sacc[e] = v; }
                    if (fr == 0) { float* dst = km + (size_t)u.pm * 512 + (u.pn - km_pn0) * BM + bj * HALF + wc * 32 + 8 * fq + 4 * n;
#pragma unroll
                        for (int e = 0; e < 4; ++e) atomicAdd(dst + e, sacc[e] * (1.0f / 256.0f)); }
                }
        }
    }
};
struct EpiF32 {
    static constexpr bool PERM = false, AFTER_DRAIN = false;
    float* O; int ldc;
    __device__ __forceinline__ void operator()(const f32x4 (&acc)[2][2][4][2], const Unit& u, int wr, int wc, int fr, int fq) const {
        const int col0 = u.pn * BM + wc * 32 + 4 * fq;
#pragma unroll
        for (int ai = 0; ai < 2; ++ai)
#pragma unroll
            for (int m = 0; m < 4; ++m) { float* rowp = O + (size_t)(u.pm * BM + ai * HALF + wr * 64 + m * 16 + fr) * ldc + col0;
#pragma unroll
                for (int bj = 0; bj < 2; ++bj)
#pragma unroll
                    for (int n = 0; n < 2; ++n) *(f32x4*)(rowp + bj * HALF + n * 16) = acc[ai][bj][m][n]; }
    }
};

struct PanelStats {
    unsigned* xbuf;
    unsigned* cnt;
    unsigned* tmo;
    int ntn; float eps;
    unsigned code;
    __device__ __forceinline__ bool run(const f32x4 (&v)[2][2][4][2], const Unit& u, int wr, int wc, int fr, int fq, PG8_LAS unsigned char* lds, int wid, int lane) const {
        typedef float f32x2v __attribute__((ext_vector_type(2)));
        PG8_LAS f32x2v* P = (PG8_LAS f32x2v*)lds;
        PG8_LAS f32x2v* S = (PG8_LAS f32x2v*)(lds + 8192);
        PG8_LAS unsigned* flag = (PG8_LAS unsigned*)(lds + 8192 + 2048);
#pragma unroll
        for (int ai = 0; ai < 2; ++ai)
#pragma unroll
            for (int m = 0; m < 4; ++m) {
                float s = 0.f;
#pragma unroll
                for (int bj = 0; bj < 2; ++bj)
#pragma unroll
                    for (int n = 0; n < 2; ++n) { const f32x4 x = v[ai][bj][m][n]; s += (x[0] + x[1]) + (x[2] + x[3]); }
                s += __shfl_xor(s, 16); s += __shfl_xor(s, 32);
                const float mw = s * (1.0f / 64.0f); float q = 0.f;
#pragma unroll
                for (int bj = 0; bj < 2; ++bj)
#pragma unroll
                    for (int n = 0; n < 2; ++n) { const f32x4 d = v[ai][bj][m][n] - mw; q += (d[0] * d[0] + d[1] * d[1]) + (d[2] * d[2] + d[3] * d[3]); }
                q += __shfl_xor(q, 16); q += __shfl_xor(q, 32);
                if (fq == 0) P[(ai * HALF + wr * 64 + m * 16 + fr) * 4 + wc] = (f32x2v){mw, q};
            }
        asm volatile("s_waitcnt lgkmcnt(0)" ::: "memory"); __builtin_amdgcn_s_barrier(); asm volatile("" ::: "memory");
#if defined(BROKEN_EXCHANGE_NO_WAIT)
#warning BROKEN CONTROL BUILD: the row-statistics exchange does not wait; results are wrong by design
        if (blockIdx.x >= 64) { const long long t0_ = clock64(); while (clock64() - t0_ < 60000) __builtin_amdgcn_s_sleep(8); }
#endif
        const int row = wid * 32 + (lane & 31);
        if (lane < 32) {
            const f32x2v a = P[row * 4 + 0], b = P[row * 4 + 1], c = P[row * 4 + 2], d = P[row * 4 + 3];
            const float mt = (a.x + b.x + c.x + d.x) * 0.25f;
            const float da = a.x - mt, db = b.x - mt, dc = c.x - mt, dd = d.x - mt;
            const float m2 = (a.y + b.y) + (c.y + d.y) + 64.0f * ((da * da + db * db) + (dc * dc + dd * dd));
            unsigned long long* slot = (unsigned long long*)xbuf + ((size_t)(u.pm * BM + row) * 4 + u.pn);
            __hip_atomic_store(slot, ((unsigned long long)__float_as_uint(m2) << 32) | __float_as_uint(mt), __ATOMIC_RELAXED, __HIP_MEMORY_SCOPE_AGENT);
        }
        asm volatile("s_waitcnt vmcnt(0)" ::: "memory");
        if (lane == 0) __hip_atomic_fetch_add(cnt + 64 * u.pm, 1u, __ATOMIC_RELAXED, __HIP_MEMORY_SCOPE_AGENT);
        if (wid == 0) {
            bool dead = false; const unsigned long long t0 = __builtin_amdgcn_s_memrealtime(); const unsigned want = 8u * (unsigned)ntn;
            for (;;) {
#if defined(BROKEN_EXCHANGE_NO_WAIT)
                break;
#endif
                if ((unsigned)__builtin_amdgcn_readfirstlane(__hip_atomic_load(cnt + 64 * u.pm, __ATOMIC_RELAXED, __HIP_MEMORY_SCOPE_AGENT)) >= want) break;
                if (__builtin_amdgcn_s_memrealtime() - t0 > 2000000ull) {
                    if (lane == 0) { unsigned expect = 0u; __hip_atomic_compare_exchange_strong(tmo + 1, &expect, code | (unsigned)(u.pm & 0xff), __ATOMIC_RELAXED, __ATOMIC_RELAXED, __HIP_MEMORY_SCOPE_AGENT);
                                     __hip_atomic_store(tmo, 1u, __ATOMIC_RELAXED, __HIP_MEMORY_SCOPE_AGENT); }
                    dead = true; break; }
                __builtin_amdgcn_s_sleep(2);
            }
            __builtin_amdgcn_fence(__ATOMIC_ACQUIRE, "agent");
            if (lane == 0) flag[0] = dead ? 1u : 0u;
        }
        asm volatile("s_waitcnt vmcnt(0) lgkmcnt(0)" ::: "memory"); __builtin_amdgcn_s_barrier(); asm volatile("" ::: "memory");
        const bool bad = flag[0] != 0u;
        if (lane < 32) {
            const unsigned long long* slot = (const unsigned long long*)xbuf + (size_t)(u.pm * BM + row) * 4; float mt[4], m2[4]; float ms = 0.f;
#pragma unroll
            for (int t = 0; t < 4; ++t) { if (t < ntn) { const unsigned long long w = __hip_atomic_load(slot + t, __ATOMIC_RELAXED, __HIP_MEMORY_SCOPE_AGENT); mt[t] = __uint_as_float((unsigned)w); m2[t] = __uint_as_float((unsigned)(w >> 32)); } else { mt[t] = 0.f; m2[t] = 0.f; } ms += mt[t]; }
            const float mean = ms / (float)ntn; float q = 0.f;
#pragma unroll
            for (int t = 0; t < 4; ++t) if (t < ntn) { const float dm = mt[t] - mean; q += m2[t] + 256.0f * dm * dm; }
            S[row] = (f32x2v){mean, 1.0f / sqrtf(q / (256.0f * (float)ntn) + eps)};
        }
        asm volatile("s_waitcnt lgkmcnt(0)" ::: "memory"); __builtin_amdgcn_s_barrier(); asm volatile("" ::: "memory");
        return bad;
    }
};

struct EpiLn {
    static constexpr bool PERM = false, AFTER_DRAIN = true;
    const float* base; float* out; bf16_t* outb; int ldc; const float* gam; const float* bet; PanelStats st; float alpha;
    __device__ __forceinline__ void fused(f32x4 (&acc)[2][2][4][2], const Unit& u, int wr, int wc, int fr, int fq, PG8_LAS unsigned char* lds, int wid, int lane) const {
        typedef float f32x2v __attribute__((ext_vector_type(2))); typedef unsigned u32x2v __attribute__((ext_vector_type(2)));
        const PG8_LAS f32x2v* S = (const PG8_LAS f32x2v*)(lds + 8192);
        const int col0 = u.pn * BM + wc * 32 + 4 * fq;
#pragma unroll
        for (int ai = 0; ai < 2; ++ai) {
            f32x4 bs[4][2][2];
#pragma unroll
            for (int m = 0; m < 4; ++m) { const size_t off = (size_t)(u.pm * BM + ai * HALF + wr * 64 + m * 16 + fr) * ldc + col0;
#pragma unroll
                for (int bj = 0; bj < 2; ++bj)
#pragma unroll
                    for (int n = 0; n < 2; ++n) bs[m][bj][n] = *(const f32x4*)(base + off + bj * HALF + n * 16); }
#pragma unroll
            for (int m = 0; m < 4; ++m) {
#pragma unroll
                for (int bj = 0; bj < 2; ++bj)
#pragma unroll
                    for (int n = 0; n < 2; ++n) acc[ai][bj][m][n] += bs[m][bj][n] * alpha;
                asm volatile("" : "+v"(acc[ai][0][m][0]), "+v"(acc[ai][0][m][1]), "+v"(acc[ai][1][m][0]), "+v"(acc[ai][1][m][1])); }
            asm volatile("" ::: "memory"); }
        const bool bad = st.run(acc, u, wr, wc, fr, fq, lds, wid, lane);
        const float qnan = __builtin_nanf("");
        f32x4 gv[2][2], bv[2][2];
#pragma unroll
        for (int bj = 0; bj < 2; ++bj)
#pragma unroll
            for (int n = 0; n < 2; ++n) { gv[bj][n] = *(const f32x4*)(gam + col0 + bj * HALF + n * 16); bv[bj][n] = *(const f32x4*)(bet + col0 + bj * HALF + n * 16); }
#pragma unroll
        for (int ai = 0; ai < 2; ++ai)
#pragma unroll
            for (int m = 0; m < 4; ++m) { const int r = ai * HALF + wr * 64 + m * 16 + fr; const f32x2v sr = S[r]; const size_t off = (size_t)(u.pm * BM + r) * ldc + col0;
#pragma unroll
                for (int bj = 0; bj < 2; ++bj)
#pragma unroll
                    for (int n = 0; n < 2; ++n) { f32x4 o = (acc[ai][bj][m][n] - sr.x) * sr.y * gv[bj][n] + bv[bj][n];
                        if (bad) o = (f32x4){qnan, qnan, qnan, qnan};
                        *(f32x4*)(out + off + bj * HALF + n * 16) = o;
                        if (outb) { u32x2v w; w.x = cvtpk(o[0], o[1]); w.y = cvtpk(o[2], o[3]); *(u32x2v*)(outb + off + bj * HALF + n * 16) = w; } }
                asm volatile("" ::: "memory"); }
    }
};

template <class Epi, class Sched, bool ALIGN_EPI = false, bool SP2 = false>
__device__ __forceinline__ void gemm_phase(PG8_LAS unsigned char* lds, const Gemm g, const Sched& S, const Epi& E) {
    const int tid = otid(), wid = __builtin_amdgcn_readfirstlane(tid >> 6), lane = tid & 63, wr = wid >> 2, wc = wid & 3, fr = lane & 15, fq = lane >> 4;
    const int K = g.K, nt = K / BK;
    unsigned voffA[2], voffB[2];
#pragma unroll
    for (int i = 0; i < 2; ++i) { int R, C; stage_rc(tid * 16 + i * 8192, R, C); const int Rb = Epi::PERM ? ((R & ~31) + perm32(R & 31)) : R;
        voffA[i] = (unsigned)(R * K + C) * 2u; voffB[i] = (unsigned)(Rb * K + C) * 2u; }
    const size_t kstep = (size_t)(BK * 2);
    const size_t hstep = (size_t)HALF * K * 2;
    const size_t tstep = 2 * hstep;
    const unsigned ldsw = (unsigned)wid * 1024u;
    const int aoff = lds_byte(wr * 64 + fr, fq * 8), boff = lds_byte(wc * 32 + fr, fq * 8);
#define PG8_SA(b, h) (((b) * 2 + (h)) * HTB)
#define PG8_SB(b, h) ((4 + (b) * 2 + (h)) * HTB)
#define PG8_STAGE(bufoff, gbase, voff) do { _Pragma("unroll") for (int _i = 0; _i < 2; ++_i) \
        __builtin_amdgcn_global_load_lds((const unsigned*)((const char*)(gbase) + (voff)[_i]), (PG8_LAS unsigned*)(lds + (bufoff) + ldsw + _i * 8192), 16, 0, 0); } while (0)
#define PG8_LDA(dst, b, h) do { _Pragma("unroll") for (int m = 0; m < 4; ++m) _Pragma("unroll") for (int k = 0; k < 2; ++k) dst[m][k] = *(const PG8_LAS bf16x8*)(lds + PG8_SA(b, h) + aoff + m * 2048 + k * 1024); } while (0)
#define PG8_LDB(dst, b, h) do { _Pragma("unroll") for (int n = 0; n < 2; ++n) _Pragma("unroll") for (int k = 0; k < 2; ++k) dst[n][k] = *(const PG8_LAS bf16x8*)(lds + PG8_SB(b, h) + boff + n * 2048 + k * 1024); } while (0)
#define PG8_MMA(ai, bj, At, Bt) do { __builtin_amdgcn_s_setprio(1); _Pragma("unroll") for (int m = 0; m < 4; ++m) _Pragma("unroll") for (int n = 0; n < 2; ++n) _Pragma("unroll") for (int k = 0; k < 2; ++k) \
        acc[ai][bj][m][n] = __builtin_amdgcn_mfma_f32_16x16x32_bf16(Bt[n][k], At[m][k], acc[ai][bj][m][n], 0, 0, 0); __builtin_amdgcn_s_setprio(0); } while (0)
#define PG8_WAIT_V(n) asm volatile("s_waitcnt vmcnt(" #n ")" ::: "memory")
#define PG8_WAIT_L(n) asm volatile("s_waitcnt lgkmcnt(" #n ")" ::: "memory")
#define PG8_BAR __builtin_amdgcn_s_barrier()
#define PG8_SCHED __builtin_amdgcn_sched_barrier(0)
    Unit cur, nxt; int ui = 0;
    if (!S.next(0, cur)) return;
    f32x4 acc[2][2][4][2];
#pragma unroll
    for (int a = 0; a < 2; ++a)
#pragma unroll
        for (int b = 0; b < 2; ++b)
#pragma unroll
            for (int m = 0; m < 4; ++m)
#pragma unroll
                for (int n = 0; n < 2; ++n) acc[a][b][m][n] = (f32x4){0.f, 0.f, 0.f, 0.f};
    bf16x8 At[4][2], B0[2][2], B1[2][2];
    const char* cA = (const char*)g.A + (size_t)cur.pm * tstep; const char* cB = (const char*)g.Bt + (size_t)cur.pn * tstep;
    S.a_ready(cur);
    if constexpr (SP2) {
        PG8_STAGE(PG8_SB(0, 0), cB, voffB); PG8_STAGE(PG8_SB(0, 1), cB + hstep, voffB); PG8_STAGE(PG8_SA(0, 0), cA, voffA); PG8_STAGE(PG8_SA(0, 1), cA + hstep, voffA);
        if (wr == 1) PG8_BAR;
        PG8_WAIT_V(2); PG8_BAR;
        PG8_STAGE(PG8_SB(1, 0), cB + kstep, voffB); PG8_STAGE(PG8_SA(1, 0), cA + kstep, voffA); PG8_STAGE(PG8_SB(1, 1), cB + hstep + kstep, voffB);
        PG8_WAIT_V(6); PG8_BAR;
    } else {
        PG8_STAGE(PG8_SB(0, 0), cB, voffB); PG8_STAGE(PG8_SA(0, 0), cA, voffA); PG8_STAGE(PG8_SB(0, 1), cB + hstep, voffB); PG8_STAGE(PG8_SA(0, 1), cA + hstep, voffA);
        if (wr == 1) PG8_BAR;
        PG8_WAIT_V(4); PG8_BAR;
        PG8_STAGE(PG8_SB(1, 0), cB + kstep, voffB); PG8_STAGE(PG8_SA(1, 0), cA + kstep, voffA); PG8_STAGE(PG8_SB(1, 1), cB + hstep + kstep, voffB);
        PG8_WAIT_V(6); PG8_BAR;
    }
    for (;;) {
        const bool has_next = S.next(ui + 1, nxt);
        const char* nA = has_next ? (const char*)g.A + (size_t)nxt.pm * tstep : cA; const char* nB = has_next ? (const char*)g.Bt + (size_t)nxt.pn * tstep : cB;
        for (int t = 0; t < nt; t += 2) {
            const bool last = (t == nt - 2);
            const char* a1 = cA + (size_t)(t + 1) * kstep;
            const char* a2 = last ? nA : cA + (size_t)(t + 2) * kstep; const char* b2 = last ? nB : cB + (size_t)(t + 2) * kstep;
            const char* a3 = a2 + kstep; const char* b3 = b2 + kstep;
            if (last && has_next) S.a_ready(nxt);
            if constexpr (SP2) {
            PG8_LDB(B0, 0, 0); PG8_LDB(B1, 0, 1); PG8_SCHED; PG8_LDA(At, 0, 0); PG8_STAGE(PG8_SA(1, 1), a1 + hstep, voffA);
            PG8_WAIT_V(8); PG8_WAIT_L(0); PG8_BAR; PG8_MMA(0, 0, At, B0); PG8_MMA(0, 1, At, B1); PG8_BAR; PG8_SCHED;
            PG8_LDA(At, 0, 1); PG8_STAGE(PG8_SB(0, 0), b2, voffB); PG8_STAGE(PG8_SB(0, 1), b2 + hstep, voffB); PG8_STAGE(PG8_SA(0, 0), a2, voffA);
            PG8_WAIT_V(8); PG8_WAIT_L(0); PG8_BAR; PG8_MMA(1, 0, At, B0); PG8_MMA(1, 1, At, B1); PG8_BAR; PG8_SCHED;
            PG8_LDB(B0, 1, 0); PG8_LDB(B1, 1, 1); PG8_SCHED; PG8_LDA(At, 1, 0); PG8_STAGE(PG8_SA(0, 1), a2 + hstep, voffA);
            PG8_WAIT_V(8); PG8_WAIT_L(0); PG8_BAR; PG8_MMA(0, 0, At, B0); PG8_MMA(0, 1, At, B1); PG8_BAR; PG8_SCHED;
            PG8_LDA(At, 1, 1); PG8_STAGE(PG8_SB(1, 0), b3, voffB); PG8_STAGE(PG8_SB(1, 1), b3 + hstep, voffB); PG8_STAGE(PG8_SA(1, 0), a3, voffA);
            PG8_WAIT_V(8); PG8_WAIT_L(0); PG8_BAR; PG8_MMA(1, 0, At, B0); PG8_MMA(1, 1, At, B1); PG8_BAR; PG8_SCHED;
            } else {
            PG8_LDB(B0, 0, 0); PG8_SCHED; PG8_LDA(At, 0, 0); PG8_STAGE(PG8_SA(1, 1), a1 + hstep, voffA);
            PG8_WAIT_L(8); PG8_BAR; PG8_WAIT_L(0); PG8_MMA(0, 0, At, B0); PG8_BAR; PG8_SCHED;
            PG8_LDB(B1, 0, 1); PG8_STAGE(PG8_SB(0, 0), b2, voffB);
            PG8_BAR; PG8_WAIT_L(0); PG8_MMA(0, 1, At, B1); PG8_BAR;
            PG8_LDA(At, 0, 1); PG8_STAGE(PG8_SA(0, 0), a2, voffA);
            PG8_BAR; PG8_WAIT_L(0); PG8_MMA(1, 0, At, B0); PG8_BAR; PG8_SCHED;
            PG8_STAGE(PG8_SB(0, 1), b2 + hstep, voffB);
            PG8_WAIT_V(6); PG8_BAR; PG8_MMA(1, 1, At, B1); PG8_BAR;
            PG8_LDB(B0, 1, 0); PG8_SCHED; PG8_LDA(At, 1, 0); PG8_STAGE(PG8_SA(0, 1), a2 + hstep, voffA);
            PG8_WAIT_L(8); PG8_BAR; PG8_WAIT_L(0); PG8_MMA(0, 0, At, B0); PG8_BAR; PG8_SCHED;
            PG8_LDB(B1, 1, 1); PG8_STAGE(PG8_SB(1, 0), b3, voffB);
            PG8_BAR; PG8_WAIT_L(0); PG8_MMA(0, 1, At, B1); PG8_BAR;
            PG8_LDA(At, 1, 1); PG8_STAGE(PG8_SA(1, 0), a3, voffA);
            PG8_BAR; PG8_WAIT_L(0); PG8_MMA(1, 0, At, B0); PG8_BAR; PG8_SCHED;
            PG8_STAGE(PG8_SB(1, 1), b3 + hstep, voffB);
            PG8_WAIT_V(6); PG8_BAR; PG8_MMA(1, 1, At, B1); PG8_BAR;
            }
        }
        if constexpr (ALIGN_EPI) { if (wr == 0) PG8_BAR; }
        if constexpr (!Epi::AFTER_DRAIN) { E(acc, cur, wr, wc, fr, fq); S.done(cur); }
        if (!has_next) break;
#pragma unroll
        for (int a = 0; a < 2; ++a)
#pragma unroll
            for (int b = 0; b < 2; ++b)
#pragma unroll
                for (int m = 0; m < 4; ++m)
#pragma unroll
                    for (int n = 0; n < 2; ++n) acc[a][b][m][n] = (f32x4){0.f, 0.f, 0.f, 0.f};
        cur = nxt; cA = nA; cB = nB; ++ui;
        if constexpr (ALIGN_EPI) { if (wr == 1) PG8_BAR; }
    }
    PG8_WAIT_V(0);
    if constexpr (!ALIGN_EPI) { if (wr == 0) PG8_BAR; }
    PG8_BAR;
    if constexpr (Epi::AFTER_DRAIN) { E.fused(acc, cur, wr, wc, fr, fq, lds, wid, lane); S.done(cur); }
#undef PG8_SA
#undef PG8_SB
#undef PG8_STAGE
#undef PG8_LDA
#undef PG8_LDB
#undef PG8_MMA
#undef PG8_WAIT_V
#undef PG8_WAIT_L
#undef PG8_BAR
#undef PG8_SCHED
}
}

__device__ __forceinline__ void ln_phase(const float* xin, const float* Y, const float* g, const float* bb, float* out, bf16_t* outb) {
  const int lane = otid() & 63, wid = otid() >> 6;
  for (int row = blockIdx.x * 8 + wid; row < M_; row += gridDim.x * 8) {
    const float4* xr = (const float4*)(xin + (size_t)row * D_);
    const float4* yr = (const float4*)(Y + (size_t)row * D_);
    float4 v[4]; float s = 0.f;
#pragma unroll
    for (int j = 0; j < 4; ++j) {
      const float4 a = xr[j * 64 + lane], y = yr[j * 64 + lane];
      v[j].x = ALPHA * a.x + y.x; v[j].y = ALPHA * a.y + y.y; v[j].z = ALPHA * a.z + y.z; v[j].w = ALPHA * a.w + y.w;
      s += (v[j].x + v[j].y) + (v[j].z + v[j].w);
    }
    const float mean = wave_sum(s) * (1.f / D_);
    float q = 0.f;
#pragma unroll
    for (int j = 0; j < 4; ++j) {
      v[j].x -= mean; v[j].y -= mean; v[j].z -= mean; v[j].w -= mean;
      q += (v[j].x * v[j].x + v[j].y * v[j].y) + (v[j].z * v[j].z + v[j].w * v[j].w);
    }
    const float rstd = 1.f / sqrtf(wave_sum(q) * (1.f / D_) + LN_EPS);
#pragma unroll
    for (int j = 0; j < 4; ++j) {
      const float4 gg = ((const float4*)g)[j * 64 + lane], bv = ((const float4*)bb)[j * 64 + lane];
      float4 o;
      o.x = v[j].x * rstd * gg.x + bv.x; o.y = v[j].y * rstd * gg.y + bv.y; o.z = v[j].z * rstd * gg.z + bv.z; o.w = v[j].w * rstd * gg.w + bv.w;
      ((float4*)(out + (size_t)row * D_))[j * 64 + lane] = o;
      if (outb) {
        ushort4 ob; ob.x = f2bf(o.x); ob.y = f2bf(o.y); ob.z = f2bf(o.z); ob.w = f2bf(o.w);
        ((ushort4*)(outb + (size_t)row * D_))[j * 64 + lane] = ob;
      }
    }
  }
}

__device__ __forceinline__ void compress_item(const Params& P, int item, float* sm) {
  const bf16_t* H0 = (const bf16_t*)(P.ws + WS_H);
  const int tid = otid();
  const int g = item & 1; int r = item >> 1; const int n = r % NCMP; r /= NCMP; const int b = r & 3; const int i = r >> 2;
  const float* pos = P.in[2] + i * 2048;
  const float* w1 = P.in[3] + (size_t)i * 2048 * 128;
  const float* b1 = P.in[4] + i * 128;
  const float* w2 = P.in[5] + (size_t)i * 128 * 64;
  float* blk = sm;
  float* part = sm + 2048;
  float* hid = sm + 2048 + 512;
  const int col = (i == 0 ? C_KCMP : C_VCMP) + g * 64;
#pragma unroll
  for (int k = 0; k < 4; ++k) {
    const int f = tid + k * 512, l = f >> 6, d = f & 63;
    blk[f] = bf2f(H0[((size_t)b * S_ + 16 * n + l) * P0 + col + d]) + pos[f];
  }
  __syncthreads();
  const int hh = tid & 127, pt = tid >> 7;
  float acc = 0.f;
  for (int f = pt * 512; f < pt * 512 + 512; ++f) acc += blk[f] * w1[(size_t)f * 128 + hh];
  part[pt * 128 + hh] = acc;
  __syncthreads();
  if (tid < 128) {
    const float a = part[tid] + part[128 + tid] + part[256 + tid] + part[384 + tid] + b1[tid];
    hid[tid] = silu_f(a);
  }
  __syncthreads();
  if (tid < 64) {
    float o = 0.f;
    for (int k = 0; k < 128; ++k) o += hid[k] * w2[k * 64 + tid];
    float* dst = (float*)(P.ws + (i == 0 ? WS_KC : WS_VC));
    dst[(((size_t)b * NCMP + n) * 2 + g) * 64 + tid] = o;
    bf16_t* dstb = (bf16_t*)(P.ws + (i == 0 ? (size_t)(248 * MiB) : (size_t)(249 * MiB)));
    dstb[(((size_t)b * 2 + g) * 256 + n) * 64 + tid] = f2bf(o);
    if (n == 0) dstb[(((size_t)b * 2 + g) * 256 + 255) * 64 + tid] = 0;
  }
  __syncthreads();
}
__device__ __forceinline__ void kmean_item(const Params& P, int item, int lane) {
  const bf16_t* H0 = (const bf16_t*)(P.ws + WS_H);
  const int h = item & 7, n = (item >> 3) & 15, b = item >> 7;
  float s = 0.f;
  for (int k = 0; k < 256; ++k) s += bf2f(H0[((size_t)b * S_ + n * 256 + k) * P0 + C_MK + h * 64 + lane]);
  ((float*)(P.ws + WS_KM))[(((size_t)b * 16 + n) * 8 + h) * 64 + lane] = s * (1.f / 256.f);
}


constexpr size_t WS_W1T = 250 * MiB;
constexpr size_t WS_W2T = 251 * MiB;
constexpr size_t WS_C1P = 252 * MiB;
__device__ __forceinline__ void compress_mfma_tile(const Params& P, int tile, unsigned char* smem_g) {
  const bf16_t* __restrict__ H0 = (const bf16_t*)(P.ws + WS_H);
  const int tid = otid(), lane = tid & 63, wid = __builtin_amdgcn_readfirstlane(tid >> 6), g = lane >> 4, ii = lane & 15;
  const int i = tile >> 7, R0 = (tile & 127) * 16;
  bf16_t* hs = (bf16_t*)smem_g;
  {
    const int R = min(R0 + ii, 2039), b = R / 510, rem = R - b * 510, n = rem >> 1, grp = rem & 1;
    const bf16_t* abase = H0 + ((size_t)b * S_ + 16 * n) * P0 + (i == 0 ? C_KCMP : C_VCMP) + grp * 64 + 8 * g;
    const bf16_t* bbase = (const bf16_t*)(P.ws + WS_W1T) + (size_t)(i * 128 + 16 * wid + ii) * 2048 + 8 * g;
    f32x4 acc = (f32x4){0.f, 0.f, 0.f, 0.f};
#pragma unroll 16
    for (int ks = 0; ks < 64; ++ks) {
      const bf16x8 a = *(const bf16x8*)(abase + (size_t)(ks >> 1) * P0 + (ks & 1) * 32);
      const bf16x8 bq = *(const bf16x8*)(bbase + ks * 32);
      acc = __builtin_amdgcn_mfma_f32_16x16x32_bf16(a, bq, acc, 0, 0, 0);
    }
    const int col = 16 * wid + ii;
    float bias = P.in[4][i * 128 + col];
    const float* c1p = (const float*)(P.ws + WS_C1P) + i * 32 * 128 + col;
#pragma unroll 8
    for (int q = 0; q < 32; ++q) bias += c1p[q * 128];
#pragma unroll
    for (int r = 0; r < 4; ++r) hs[(4 * g + r) * 136 + col] = f2bf(silu_f(acc[r] + bias));
  }
  __syncthreads();
  if (wid < 4) {
    const bf16_t* b2 = (const bf16_t*)(P.ws + WS_W2T) + (size_t)(i * 64 + 16 * wid + ii) * 128 + 8 * g;
    f32x4 acc = (f32x4){0.f, 0.f, 0.f, 0.f};
#pragma unroll
    for (int k2 = 0; k2 < 4; ++k2) {
      const bf16x8 a = *(const bf16x8*)(hs + ii * 136 + 32 * k2 + 8 * g);
      const bf16x8 bq = *(const bf16x8*)(b2 + 32 * k2);
      acc = __builtin_amdgcn_mfma_f32_16x16x32_bf16(a, bq, acc, 0, 0, 0);
    }
    bf16_t* dst = (bf16_t*)(P.ws + (i == 0 ? (size_t)(248 * MiB) : (size_t)(249 * MiB)));
#pragma unroll
    for (int r = 0; r < 4; ++r) {
      const int R = R0 + 4 * g + r;
      if (R < 2040) { const int b = R / 510, rem = R - b * 510, n = rem >> 1, grp = rem & 1;
        dst[(((size_t)b * 2 + grp) * 256 + n) * 64 + 16 * wid + ii] = f2bf(acc[r]); }
    }
  }
  __syncthreads();
}
__device__ __forceinline__ void kmean_item2(const Params& P, int item) {
  const bf16_t* __restrict__ H0 = (const bf16_t*)(P.ws + WS_H);
  const int tid = otid();
  const bf16_t* src = H0 + ((size_t)(item >> 4) * S_ + (item & 15) * 256) * P0 + C_MK + tid;
  float s0 = 0.f, s1 = 0.f, s2 = 0.f, s3 = 0.f;
#pragma unroll 4
  for (int r = 0; r < 256; r += 4) {
    s0 += bf2f(src[(size_t)r * P0]); s1 += bf2f(src[(size_t)(r + 1) * P0]); s2 += bf2f(src[(size_t)(r + 2) * P0]); s3 += bf2f(src[(size_t)(r + 3) * P0]);
  }
  ((float*)(P.ws + WS_KM))[(size_t)item * 512 + tid] = ((s0 + s1) + (s2 + s3)) * (1.f / 256.f);
}

template <int NH>
__device__ __forceinline__ void attend_block(const bf16_t* __restrict__ Kp, const bf16_t* __restrict__ Vp, size_t rowbase, int kp0, int t, int kmin,
                                             const float* qs, float* pb, const float* slope, float* m, float* l, float* o, int lane) {
  asm volatile("" ::: "memory");
  const int kp = kp0 + lane;
  const bool valid = (kp <= t) && (kp >= kmin);
  const uint4* kr = (const uint4*)(Kp + (rowbase + kp) * P0);
  float dot[NH];
#pragma unroll
  for (int j = 0; j < NH; ++j) dot[j] = 0.f;
#pragma unroll 1
  for (int c = 0; c < 8; ++c) {
    asm volatile("" ::: "memory");
    const uint4 u = kr[c];
    float kv[8];
    kv[0] = __uint_as_float(u.x << 16); kv[1] = __uint_as_float(u.x & 0xffff0000u);
    kv[2] = __uint_as_float(u.y << 16); kv[3] = __uint_as_float(u.y & 0xffff0000u);
    kv[4] = __uint_as_float(u.z << 16); kv[5] = __uint_as_float(u.z & 0xffff0000u);
    kv[6] = __uint_as_float(u.w << 16); kv[7] = __uint_as_float(u.w & 0xffff0000u);
#pragma unroll
    for (int j = 0; j < NH; ++j) {
      const float4 q0 = *(const float4*)(qs + j * 64 + c * 8), q1 = *(const float4*)(qs + j * 64 + c * 8 + 4);
      dot[j] += kv[0] * q0.x + kv[1] * q0.y + kv[2] * q0.z + kv[3] * q0.w + kv[4] * q1.x + kv[5] * q1.y + kv[6] * q1.z + kv[7] * q1.w;
    }
  }
#pragma unroll
  for (int j = 0; j < NH; ++j) {
    const float s = valid ? 0.125f * dot[j] - slope[j] * (float)(t - kp) : -1e30f;
    const float mn = fmaxf(m[j], wave_max(s));
    const float al = __expf(m[j] - mn);
    const float p = valid ? __expf(s - mn) : 0.f;
    l[j] = l[j] * al + wave_sum(p);
    o[j] *= al; m[j] = mn;
    pb[j * 64 + lane] = p;
  }
  __builtin_amdgcn_wave_barrier();
  const bf16_t* vr = Vp + (rowbase + kp0) * P0 + lane;
#pragma unroll 8
  for (int k = 0; k < 64; ++k) {
    const float v = bf2f(vr[(size_t)k * P0]);
#pragma unroll
    for (int j = 0; j < NH; ++j) o[j] += pb[j * 64 + k] * v;
  }
  __builtin_amdgcn_wave_barrier();
}

__device__ __forceinline__ void nsa_item(const Params& P, int b, int g, int t, float* wsm, int lane) {
  const bf16_t* H0 = (const bf16_t*)(P.ws + WS_H);
  const float* KC = (const float*)(P.ws + WS_KC);
  const float* VC = (const float*)(P.ws + WS_VC);
  bf16_t* MIX = (bf16_t*)(P.ws + WS_MIX);
  float* qs = wsm;
  float* pc = wsm + 256;
  float* pb = wsm + 1280;
  const size_t row = (size_t)b * S_ + t;
  const bf16_t* hrow = H0 + row * P0;
  float slope[4];
#pragma unroll
  for (int j = 0; j < 4; ++j) { qs[j * 64 + lane] = bf2f(hrow[C_NQ + (g * 4 + j) * 64 + lane]); slope[j] = exp2f(-(float)(g * 4 + j + 1)); }
  __builtin_amdgcn_wave_barrier();
  const int nv = t >= 31 ? (t - 31) / 16 + 1 : 0;
#pragma unroll 1
  for (int c = 0; c < 4; ++c) {
    asm volatile("" ::: "memory");
    const int n = c * 64 + lane;
    float dot[4] = {0.f, 0.f, 0.f, 0.f};
    if (n < nv) {
      const float4* kr = (const float4*)(KC + (((size_t)b * NCMP + n) * 2 + g) * 64);
#pragma unroll 4
      for (int d4 = 0; d4 < 16; ++d4) {
        const float4 kv = kr[d4];
#pragma unroll
        for (int j = 0; j < 4; ++j) {
          const float4 q = *(const float4*)(qs + j * 64 + d4 * 4);
          dot[j] += kv.x * q.x + kv.y * q.y + kv.z * q.z + kv.w * q.w;
        }
      }
    }
#pragma unroll
    for (int j = 0; j < 4; ++j) pc[j * 256 + n] = (n < nv) ? 0.125f * dot[j] - slope[j] * (float)(t - (16 * n + 31)) : -1e30f;
  }
  __builtin_amdgcn_wave_barrier();
#pragma unroll
  for (int j = 0; j < 4; ++j) {
    float sc[4];
#pragma unroll
    for (int c = 0; c < 4; ++c) sc[c] = pc[j * 256 + c * 64 + lane];
    float mx = fmaxf(fmaxf(sc[0], sc[1]), fmaxf(sc[2], sc[3]));
    mx = wave_max(mx);
    float sum = 0.f;
#pragma unroll
    for (int c = 0; c < 4; ++c) { const int n = c * 64 + lane; const float p = (n < nv) ? __expf(sc[c] - mx) : 0.f; sc[c] = p; sum += p; }
    sum = wave_sum(sum);
    const float inv = nv > 0 ? 1.f / sum : 0.f;
#pragma unroll
    for (int c = 0; c < 4; ++c) pc[j * 256 + c * 64 + lane] = sc[c] * inv;
  }
  __builtin_amdgcn_wave_barrier();
  float ocmp[4] = {0.f, 0.f, 0.f, 0.f};
  for (int n = 0; n < nv; ++n) {
    const float v = VC[(((size_t)b * NCMP + n) * 2 + g) * 64 + lane];
#pragma unroll
    for (int j = 0; j < 4; ++j) ocmp[j] += pc[j * 256 + n] * v;
  }
  float imp = 0.f;
  {
    const int lo = max(0, 4 * lane - 1), hi = min(NCMP - 1, 4 * lane + 3);
    for (int n = lo; n <= hi; ++n) imp += (pc[n] + pc[256 + n]) + (pc[512 + n] + pc[768 + n]);
  }
  const int cur = t >> 6;
  const bool bvalid = lane <= cur;
  const bool forced = (lane == 0) || (lane == cur) || (lane == cur - 1);
  const float key = bvalid ? (forced ? 1e9f : imp) : -1e30f;
  int rank = 0;
  for (int s2 = 0; s2 < 64; ++s2) {
    const float ks = __shfl(key, s2);
    rank += (ks > key || (ks == key && s2 < lane)) ? 1 : 0;
  }
  const unsigned long long selmask = __ballot(bvalid && rank < 16);
  float m[4], l[4], osel[4], owin[4];
#pragma unroll
  for (int j = 0; j < 4; ++j) { m[j] = -1e30f; l[j] = 0.f; osel[j] = 0.f; }
  {
    unsigned long long mk = selmask;
    while (mk) {
      const int blk = __builtin_ctzll(mk); mk &= mk - 1;
      attend_block<4>(H0 + C_KSEL + g * 64, H0 + C_VSEL + g * 64, (size_t)b * S_, blk * 64, t, 0, qs, pb, slope, m, l, osel, lane);
    }
  }
#pragma unroll
  for (int j = 0; j < 4; ++j) { osel[j] /= l[j]; m[j] = -1e30f; l[j] = 0.f; owin[j] = 0.f; }
  {
    const int kmin = t - 511;
    const int b0 = (kmin > 0 ? kmin : 0) >> 6;
    for (int blk = b0; blk <= cur; ++blk)
      attend_block<4>(H0 + C_KWIN + g * 64, H0 + C_VWIN + g * 64, (size_t)b * S_, blk * 64, t, kmin, qs, pb, slope, m, l, owin, lane);
  }
#pragma unroll
  for (int j = 0; j < 4; ++j) {
    const int h = g * 4 + j;
    const float g0 = sigmoid_f(bf2f(hrow[C_NG + h * 3 + 0])), g1 = sigmoid_f(bf2f(hrow[C_NG + h * 3 + 1])), g2 = sigmoid_f(bf2f(hrow[C_NG + h * 3 + 2]));
    const float o = g0 * ocmp[j] + g1 * osel[j] + g2 * (owin[j] / l[j]);
    const float z = bf2f(hrow[C_NZ + h * 64 + lane]);
    MIX[row * D_ + h * 64 + lane] = f2bf(o * silu_f(z));
  }
}

__device__ __forceinline__ void moba_item(const Params& P, int b, int h, int t, float* wsm, int lane) {
  const bf16_t* H0 = (const bf16_t*)(P.ws + WS_H);
  const float* KM = (const float*)(P.ws + WS_KM);
  bf16_t* MIX = (bf16_t*)(P.ws + WS_MIX);
  float* qs = wsm;
  float* pb = wsm + 1280;
  const size_t row = (size_t)b * S_ + t;
  const bf16_t* hrow = H0 + row * P0;
  qs[lane] = bf2f(hrow[C_MQ + h * 64 + lane]);
  __builtin_amdgcn_wave_barrier();
  float slope[1] = {exp2f(-(float)(h + 1))};
  const int cur = t >> 8;
  float gate = -1e30f;
  if (lane < cur) {
    const float4* kr = (const float4*)(KM + (((size_t)b * 16 + lane) * 8 + h) * 64);
    float d = 0.f;
#pragma unroll 4
    for (int d4 = 0; d4 < 16; ++d4) { const float4 kv = kr[d4]; const float4 q = *(const float4*)(qs + d4 * 4); d += kv.x * q.x + kv.y * q.y + kv.z * q.z + kv.w * q.w; }
    gate = d;
  }
  int rank = 0;
  for (int s2 = 0; s2 < 16; ++s2) {
    const float ks = __shfl(gate, s2);
    rank += (ks > gate || (ks == gate && s2 < lane)) ? 1 : 0;
  }
  unsigned long long mk = __ballot(lane < cur && rank < 3) | (1ull << cur);
  float m[1] = {-1e30f}, l[1] = {0.f}, o[1] = {0.f};
  while (mk) {
    const int blk = __builtin_ctzll(mk); mk &= mk - 1;
    for (int c = 0; c < 4; ++c) {
      const int kp0 = blk * 256 + c * 64;
      if (kp0 > t) break;
      attend_block<1>(H0 + C_MK + h * 64, H0 + C_MV + h * 64, (size_t)b * S_, kp0, t, 0, qs, pb, slope, m, l, o, lane);
    }
  }
  const float z = bf2f(hrow[C_MZ + h * 64 + lane]);
  MIX[row * D_ + 512 + h * 64 + lane] = f2bf((o[0] / l[0]) * silu_f(z));
}


#define LAS __attribute__((address_space(3)))
typedef short s16x4 __attribute__((ext_vector_type(4)));
typedef float f32x2_t __attribute__((ext_vector_type(2)));
typedef __bf16 bf16x2_t __attribute__((ext_vector_type(2)));
__device__ __forceinline__ unsigned cvtpk(float lo, float hi) { f32x2_t v = {lo, hi}; bf16x2_t b = __builtin_convertvector(v, bf16x2_t); return __builtin_bit_cast(unsigned, b); }
__device__ __forceinline__ s16x4 vtr(LAS const unsigned char* p) { return __builtin_bit_cast(s16x4, __builtin_amdgcn_ds_read_tr16_b64_v4i16((LAS s16x4*)p)); }
template <int OFF> __device__ __forceinline__ s16x4 vtra(unsigned a) { s16x4 r; asm volatile("ds_read_b64_tr_b16 %0, %1 offset:%2" : "=&v"(r) : "v"(a), "i"(OFF) : "memory"); return r; }
#define LGKM0() do { asm volatile("s_waitcnt lgkmcnt(0)" ::: "memory"); __builtin_amdgcn_sched_barrier(0); } while (0)
constexpr int KT_BYTES = 8192;
constexpr int VT_DT = 2080;
constexpr int VT_BYTES = 4 * VT_DT;
constexpr int AT_BUF = KT_BYTES + VT_BYTES;
constexpr int AT_NST = 4;
constexpr int AT_MISC = AT_NST * AT_BUF;
constexpr int AT_TL = AT_MISC + 64;
constexpr int AT_STASH = AT_MISC + 512;
constexpr int AT_LDS_END = AT_STASH + 8 * 512 * 16;
__device__ __forceinline__ void ring_wait(int rem) {
  if (rem >= 3) asm volatile("s_waitcnt vmcnt(6)" ::: "memory");
  else if (rem == 2) asm volatile("s_waitcnt vmcnt(4)" ::: "memory");
  else if (rem == 1) asm volatile("s_waitcnt vmcnt(2)" ::: "memory");
  else asm volatile("s_waitcnt vmcnt(0)" ::: "memory");
  __builtin_amdgcn_s_barrier();
  asm volatile("" ::: "memory");
}
constexpr float C1 = 0.125f * 1.4426950408889634f;
constexpr float LOG2E = 1.4426950408889634f;
constexpr float AT_THR = 6.0f;

__device__ __forceinline__ void at_stage_write(LAS unsigned char* buf, const u32x4& kreg, const u32x4& vreg, int tid) {
  const int key = tid >> 3, c = tid & 7;
  *(LAS u32x4*)(buf + key * 128 + ((c ^ ((key >> 1) & 7)) << 4)) = kreg;
  *(LAS u32x4*)(buf + KT_BYTES + (c >> 1) * VT_DT + key * 32 + (c & 1) * 16) = vreg;
}
__device__ __forceinline__ void at_stage_dma(LAS unsigned char* buf, const bf16_t* Kt, const bf16_t* Vt, unsigned pitch, int lane, int wid) {
  const int kkey = 8 * wid + (lane >> 3), c = (lane & 7) ^ ((kkey >> 1) & 7);
  __builtin_amdgcn_global_load_lds((const unsigned*)(Kt + (unsigned)kkey * pitch + c * 8), (LAS unsigned*)(buf + wid * 1024), 16, 0, 0);
  const int vkey = 32 * (wid & 1) + (lane >> 1), dt = wid >> 1;
  __builtin_amdgcn_global_load_lds((const unsigned*)(Vt + (unsigned)vkey * pitch + dt * 16 + (lane & 1) * 8), (LAS unsigned*)(buf + KT_BYTES + dt * VT_DT + (wid & 1) * 1024), 16, 0, 0);
}
template <int NRG, bool EDGE, bool IMP  >
__device__ __forceinline__ void at_tile_x(LAS const unsigned char* buf, const bf16x8 (&qf)[NRG][2], f32x4 (&O)[NRG][4], float (&m)[NRG], float (&l)[NRG],
                                        const float (&base)[NRG], const float (&soff)[NRG], const int (&lim)[NRG], const int (&lo)[NRG], int lane,
                                        float (&imp)[NRG][16], float (&carry)[NRG], int tile = 0) {
  const int g = lane >> 4, i = lane & 15;
  const int swz = (i >> 1) & 7;
  LAS const unsigned char* kb = buf + i * 128;
  const int kc0 = ((g ^ swz) << 4), kc1 = (((4 + g) ^ swz) << 4);
  f32x4 S[NRG][4];
  __builtin_amdgcn_s_setprio(1);
#pragma unroll
  for (int mt = 0; mt < 4; ++mt) {
    const bf16x8 k0f = *(LAS const bf16x8*)(kb + mt * 2048 + kc0);
    const bf16x8 k1f = *(LAS const bf16x8*)(kb + mt * 2048 + kc1);
#pragma unroll
    for (int rg = 0; rg < NRG; ++rg) {
      f32x4 a = __builtin_amdgcn_mfma_f32_16x16x32_bf16(k0f, qf[rg][0], (f32x4){0.f, 0.f, 0.f, 0.f}, 0, 0, 0);
      S[rg][mt] = __builtin_amdgcn_mfma_f32_16x16x32_bf16(k1f, qf[rg][1], a, 0, 0, 0);
    }
  }
  __builtin_amdgcn_s_setprio(0);
  __builtin_amdgcn_sched_barrier(0);
  const unsigned vb = (unsigned)(unsigned long long)(buf + KT_BYTES) + (4 * g + (i >> 2)) * 32 + (i & 3) * 8;
#define AT_VRD(dt, ks, d0, d1) { d0 = vtra<(dt) * VT_DT + (ks) * 1024>(vb); d1 = vtra<(dt) * VT_DT + (ks) * 1024 + 512>(vb); }
  s16x4 a0, a1, a2, a3, a4, a5, a6, a7, c0, c1, c2, c3, c4, c5, c6, c7;
  AT_VRD(0, 0, a0, a1) AT_VRD(0, 1, a2, a3) AT_VRD(1, 0, a4, a5) AT_VRD(1, 1, a6, a7)
  __builtin_amdgcn_sched_barrier(0);
  unsigned pk[NRG][2][4];
#pragma unroll
  for (int rg = 0; rg < NRG; ++rg) {
    const float bm = base[rg] - m[rg];
    float mx = -INFINITY;
#pragma unroll
    for (int mt = 0; mt < 4; ++mt)
#pragma unroll
      for (int r = 0; r < 4; ++r) {
        float sv = __builtin_fmaf(S[rg][mt][r], C1, bm + soff[rg] * (float)(16 * mt + r));
        if (EDGE) { const int c = 16 * mt + r; sv = (c <= lim[rg] && c >= lo[rg]) ? sv : -INFINITY; }
        S[rg][mt][r] = sv; mx = fmaxf(mx, sv);
      }
    if (__builtin_expect(__any(mx > AT_THR), 0)) {
      mx = xmax<16>(mx); mx = xmax<32>(mx);
      const float dl = fmaxf(mx, 0.f);
      const float al = __builtin_amdgcn_exp2f(-dl);
      m[rg] += dl; l[rg] *= al;
#pragma unroll
      for (int dt = 0; dt < 4; ++dt) O[rg][dt] = O[rg][dt] * al;
      if (IMP) {
#pragma unroll
        for (int k = 0; k < 16; ++k) imp[rg][k] *= al;
        carry[rg] *= al;
      }
#pragma unroll
      for (int mt = 0; mt < 4; ++mt)
#pragma unroll
        for (int r = 0; r < 4; ++r) S[rg][mt][r] -= dl;
    }
    float ps = 0.f;
#pragma unroll
    for (int mt = 0; mt < 4; ++mt)
#pragma unroll
      for (int r = 0; r < 4; ++r) { const float pv = __builtin_amdgcn_exp2f(S[rg][mt][r]); S[rg][mt][r] = pv; ps += pv; }
    l[rg] += ps;
    if (IMP) {
      const int g = lane >> 4;
      float sh[4], nv[4];
#pragma unroll
      for (int mt = 0; mt < 4; ++mt) sh[mt] = __uint_as_float(__builtin_amdgcn_ds_bpermute(((lane + 48) & 63) << 2, __float_as_uint(S[rg][mt][3])));
#pragma unroll
      for (int mt = 0; mt < 4; ++mt) {
        const float own = (S[rg][mt][0] + S[rg][mt][1]) + (S[rg][mt][2] + S[rg][mt][3]);
        const float prev = g > 0 ? sh[mt] : (mt > 0 ? sh[mt > 0 ? mt - 1 : 0] : carry[rg]);
        nv[mt] = own + prev;
      }
      if (tile == 0) { imp[rg][0] = nv[0]; imp[rg][1] = nv[1]; imp[rg][2] = nv[2]; imp[rg][3] = nv[3]; }
      else if (tile == 1) { imp[rg][4] = nv[0]; imp[rg][5] = nv[1]; imp[rg][6] = nv[2]; imp[rg][7] = nv[3]; }
      else if (tile == 2) { imp[rg][8] = nv[0]; imp[rg][9] = nv[1]; imp[rg][10] = nv[2]; imp[rg][11] = nv[3]; }
      else { imp[rg][12] = nv[0]; imp[rg][13] = nv[1]; imp[rg][14] = nv[2]; imp[rg][15] = nv[3]; }
      carry[rg] = sh[3];
    }
#pragma unroll
    for (int ks = 0; ks < 2; ++ks) {
      pk[rg][ks][0] = cvtpk(S[rg][2 * ks][0], S[rg][2 * ks][1]); pk[rg][ks][1] = cvtpk(S[rg][2 * ks][2], S[rg][2 * ks][3]);
      pk[rg][ks][2] = cvtpk(S[rg][2 * ks + 1][0], S[rg][2 * ks + 1][1]); pk[rg][ks][3] = cvtpk(S[rg][2 * ks + 1][2], S[rg][2 * ks + 1][3]);
    }
  }
  __builtin_amdgcn_sched_barrier(0);
#define AT_PV(dt, ks, d0, d1) { const bf16x8 vf = (bf16x8){d0[0], d0[1], d0[2], d0[3], d1[0], d1[1], d1[2], d1[3]}; \
    _Pragma("unroll") for (int rg = 0; rg < NRG; ++rg) { const u32x4 pw = {pk[rg][ks][0], pk[rg][ks][1], pk[rg][ks][2], pk[rg][ks][3]}; \
      O[rg][dt] = __builtin_amdgcn_mfma_f32_16x16x32_bf16(vf, __builtin_bit_cast(bf16x8, pw), O[rg][dt], 0, 0, 0); } }
  LGKM0();
  AT_VRD(2, 0, c0, c1) AT_VRD(2, 1, c2, c3) AT_VRD(3, 0, c4, c5) AT_VRD(3, 1, c6, c7)
  __builtin_amdgcn_s_setprio(1);
  AT_PV(0, 0, a0, a1) AT_PV(0, 1, a2, a3) AT_PV(1, 0, a4, a5) AT_PV(1, 1, a6, a7)
  LGKM0();
  AT_PV(2, 0, c0, c1) AT_PV(2, 1, c2, c3) AT_PV(3, 0, c4, c5) AT_PV(3, 1, c6, c7)
  __builtin_amdgcn_s_setprio(0);
#undef AT_VRD
#undef AT_PV
}

template <int NRG, bool EDGE>
__device__ __forceinline__ void at_tile(LAS const unsigned char* buf, const bf16x8 (&qf)[NRG][2], f32x4 (&O)[NRG][4], float (&m)[NRG], float (&l)[NRG],
                                        const float (&base)[NRG], const float (&soff)[NRG], const int (&lim)[NRG], const int (&lo)[NRG], int lane) {
  float dimp[NRG][16]; float dc[NRG];
  at_tile_x<NRG, EDGE, false>(buf, qf, O, m, l, base, soff, lim, lo, lane, dimp, dc);
}

__device__ __forceinline__ void moba_mfma_item(const Params& P, int b, int h, int cur, unsigned char* smem_g) {
  LAS unsigned char* lds = (LAS unsigned char*)smem_g;
  const bf16_t* __restrict__ H0 = (const bf16_t*)(P.ws + WS_H);
  const float* __restrict__ KM = (const float*)(P.ws + WS_KM);
  bf16_t* __restrict__ MIX = (bf16_t*)(P.ws + WS_MIX);
  const int tid = otid(), lane = tid & 63, wid = __builtin_amdgcn_readfirstlane(tid >> 6), g = lane >> 4, i = lane & 15;
  const float slope2 = exp2f(-(float)(h + 1)) * LOG2E;
  const int t0 = cur * 256;
  int trow[2]; bf16x8 qf[2][2]; unsigned sel[2];
#pragma unroll
  for (int rg = 0; rg < 2; ++rg) {
    trow[rg] = t0 + wid * 32 + rg * 16 + i;
    const bf16_t* qp = H0 + ((size_t)b * S_ + trow[rg]) * P0 + C_MQ + h * 64 + 8 * g;
    qf[rg][0] = *(const bf16x8*)qp; qf[rg][1] = *(const bf16x8*)(qp + 32);
  }
  {
    LAS float* kml = (LAS float*)(lds + AT_STASH);
#pragma unroll
    for (int k = 0; k < 2; ++k) { const int e = tid + 512 * k, n = e >> 6; if (n < cur) kml[e] = KM[(((size_t)b * 16 + n) * 8 + h) * 64 + (e & 63)]; }
    __syncthreads();
#pragma unroll
    for (int rg = 0; rg < 2; ++rg) {
      float qv[16];
#pragma unroll
      for (int j = 0; j < 8; ++j) { qv[j] = bf2f((bf16_t)qf[rg][0][j]); qv[8 + j] = bf2f((bf16_t)qf[rg][1][j]); }
      float v1 = -INFINITY, v2 = -INFINITY, v3 = -INFINITY; int i1 = -1, i2 = -1, i3 = -1;
      for (int n = 0; n < cur; ++n) {
        LAS const float* kr = kml + n * 64 + 8 * g;
        const f32x4 a0 = *(LAS const f32x4*)kr, a1 = *(LAS const f32x4*)(kr + 4), b0 = *(LAS const f32x4*)(kr + 32), b1 = *(LAS const f32x4*)(kr + 36);
        float d = qv[0] * a0[0] + qv[1] * a0[1] + qv[2] * a0[2] + qv[3] * a0[3] + qv[4] * a1[0] + qv[5] * a1[1] + qv[6] * a1[2] + qv[7] * a1[3]
                + qv[8] * b0[0] + qv[9] * b0[1] + qv[10] * b0[2] + qv[11] * b0[3] + qv[12] * b1[0] + qv[13] * b1[1] + qv[14] * b1[2] + qv[15] * b1[3];
        d = xsum<16>(d); d = xsum<32>(d);
        if (d > v1) { v3 = v2; i3 = i2; v2 = v1; i2 = i1; v1 = d; i1 = n; }
        else if (d > v2) { v3 = v2; i3 = i2; v2 = d; i2 = n; }
        else if (d > v3) { v3 = d; i3 = n; }
      }
      unsigned mk = 0u;
      if (i1 >= 0) mk |= 1u << i1;
      if (i2 >= 0) mk |= 1u << i2;
      if (i3 >= 0) mk |= 1u << i3;
      sel[rg] = mk;
    }
  }
  {
    unsigned u = sel[0] | sel[1];
    u = xorr<1>(u); u = xorr<2>(u); u = xorr<4>(u); u = xorr<8>(u);
    LAS unsigned* misc = (LAS unsigned*)(lds + AT_MISC);
    if (lane == 0) misc[wid] = u;
  }
  __syncthreads();
  unsigned umask = 0u;
  {
    LAS unsigned* misc = (LAS unsigned*)(lds + AT_MISC);
#pragma unroll
    for (int w = 0; w < 8; ++w) umask |= misc[w];
  }
  umask = __builtin_amdgcn_readfirstlane(umask);
  const int npast = __builtin_popcount(umask);
  const int nt = 4 * npast + 4;
  f32x4 O[2][4]; float m[2], l[2];
#pragma unroll
  for (int rg = 0; rg < 2; ++rg) { m[rg] = 0.f; l[rg] = 0.f;
#pragma unroll
    for (int dt = 0; dt < 4; ++dt) O[rg][dt] = (f32x4){0.f, 0.f, 0.f, 0.f}; }
  const bf16_t* Kg = H0 + (size_t)b * S_ * P0 + C_MK + h * 64;
  const bf16_t* Vg = H0 + (size_t)b * S_ * P0 + C_MV + h * 64;
  LAS int* tl = (LAS int*)(lds + AT_TL);
  if (tid < nt) {
    int k0v;
    if (tid < 4 * npast) { unsigned r = umask; for (int q = 0; q < (tid >> 2); ++q) r &= r - 1; k0v = __builtin_ctz(r) * 256 + (tid & 3) * 64; }
    else k0v = cur * 256 + (tid - 4 * npast) * 64;
    tl[tid] = k0v;
  }
  asm volatile("s_waitcnt vmcnt(0)" ::: "memory");
  __syncthreads();
#pragma unroll
  for (int st = 0; st < 3; ++st) if (st < nt) { const int k0s = tl[st]; at_stage_dma(lds + st * AT_BUF, Kg + (size_t)k0s * P0, Vg + (size_t)k0s * P0, P0, lane, wid); }
  for (int ti = 0; ti < nt; ++ti) {
    ring_wait(min(nt - 1 - ti, 2));
    if (ti + 3 < nt) { const int k0n = tl[ti + 3]; at_stage_dma(lds + ((ti + 3) & 3) * AT_BUF, Kg + (size_t)k0n * P0, Vg + (size_t)k0n * P0, P0, lane, wid); }
    const int ck0 = __builtin_amdgcn_readfirstlane(tl[ti]), cblk = ck0 >> 8;
    if (cblk == cur && ck0 > t0 + wid * 32 + 31) continue;
    LAS const unsigned char* buf = lds + (ti & 3) * AT_BUF;
    float base[2], soff[2]; int lim[2], lo[2];
#pragma unroll
    for (int rg = 0; rg < 2; ++rg) {
      const bool rs = (cblk == cur) || ((sel[rg] >> cblk) & 1u);
      base[rg] = rs ? slope2 * (float)(ck0 + 4 * g - trow[rg]) : -INFINITY;
      soff[rg] = slope2; lim[rg] = trow[rg] - ck0 - 4 * g; lo[rg] = -1000000;
    }
    if (cblk == cur) at_tile<2, true>(buf, qf, O, m, l, base, soff, lim, lo, lane);
    else at_tile<2, false>(buf, qf, O, m, l, base, soff, lim, lo, lane);
  }
  __builtin_amdgcn_s_barrier();
#pragma unroll
  for (int rg = 0; rg < 2; ++rg) {
    float lt = l[rg]; lt = xsum<16>(lt); lt = xsum<32>(lt);
    const float inv = 1.f / lt;
    const size_t row = (size_t)b * S_ + trow[rg];
#pragma unroll
    for (int dt = 0; dt < 4; ++dt) {
      const int dv = 16 * dt + 4 * g;
      const ushort4 zz = *(const ushort4*)(H0 + row * P0 + C_MZ + h * 64 + dv);
      ushort4 ov;
      ov.x = f2bf(O[rg][dt][0] * inv * silu_f(bf2f(zz.x))); ov.y = f2bf(O[rg][dt][1] * inv * silu_f(bf2f(zz.y)));
      ov.z = f2bf(O[rg][dt][2] * inv * silu_f(bf2f(zz.z))); ov.w = f2bf(O[rg][dt][3] * inv * silu_f(bf2f(zz.w)));
      *(ushort4*)(MIX + row * D_ + 512 + h * 64 + dv) = ov;
    }
  }
}


constexpr size_t WS_KCB = 248 * MiB;
constexpr size_t WS_VCB = 249 * MiB;
__device__ __forceinline__ void nsa_mfma_item(const Params& P, int b, int grp, int sb, unsigned char* smem_g) {
  LAS unsigned char* lds = (LAS unsigned char*)smem_g;
  const bf16_t* __restrict__ H0 = (const bf16_t*)(P.ws + WS_H);
  bf16_t* __restrict__ MIX = (bf16_t*)(P.ws + WS_MIX);
  const int tid = otid(), lane = tid & 63, wid = __builtin_amdgcn_readfirstlane(tid >> 6), g = lane >> 4, i = lane & 15;
  const int t0 = sb * 64;
  int trow[2]; bf16x8 qf[2][2];
  const int hh = grp * 4 + (i & 3);
  const float slope2 = exp2f(-(float)(hh + 1)) * LOG2E;
  const bf16_t* __restrict__ Hb = H0 + (size_t)b * S_ * P0;
#pragma unroll
  for (int rg = 0; rg < 2; ++rg) {
    trow[rg] = t0 + wid * 8 + rg * 4 + (i >> 2);
    const unsigned qo = (unsigned)trow[rg] * P0 + C_NQ + hh * 64 + 8 * g;
    qf[rg][0] = *(const bf16x8*)(Hb + qo); qf[rg][1] = *(const bf16x8*)(Hb + qo + 32);
  }
  LAS f32x4* stash = (LAS f32x4*)(lds + AT_STASH) + tid;
  f32x4 O[2][4]; float m[2], l[2];
  unsigned mlo[2], mhi[2];
  const int ntc = ((4 * sb + 2) >> 6) + 1;
  {
    const bf16_t* Kg = (const bf16_t*)(P.ws + WS_KCB) + (size_t)(b * 2 + grp) * 256 * 64;
    const bf16_t* Vg = (const bf16_t*)(P.ws + WS_VCB) + (size_t)(b * 2 + grp) * 256 * 64;
    asm volatile("s_waitcnt vmcnt(0)" ::: "memory");
#pragma unroll
    for (int tile = 0; tile < 4; ++tile) if (tile < ntc) at_stage_dma(lds + tile * AT_BUF, Kg + tile * 4096, Vg + tile * 4096, 64, lane, wid);
  }
#pragma unroll
  for (int rg = 0; rg < 2; ++rg) {
    float imp[1][16], carry[1], m1[1], l1[1]; f32x4 O1[1][4]; bf16x8 q1[1][2];
    q1[0][0] = qf[rg][0]; q1[0][1] = qf[rg][1];
    m1[0] = 0.f; l1[0] = 0.f; carry[0] = 0.f;
#pragma unroll
    for (int k = 0; k < 16; ++k) imp[0][k] = 0.f;
#pragma unroll
    for (int dt = 0; dt < 4; ++dt) O1[0][dt] = (f32x4){0.f, 0.f, 0.f, 0.f};
#pragma unroll 1
    for (int tile = 0; tile < ntc; ++tile) {
      if (rg == 0) ring_wait(ntc - 1 - tile);
      LAS const unsigned char* buf = lds + tile * AT_BUF;
      float base[1], soff[1]; int lim[1], lo[1];
      const int nlim = trow[rg] >= 31 ? ((trow[rg] - 31) >> 4) : -1;
      base[0] = slope2 * (float)(16 * (64 * tile + 4 * g) + 31 - trow[rg]);
      soff[0] = 16.f * slope2; lim[0] = nlim - 64 * tile - 4 * g; lo[0] = -1000000;
      at_tile_x<1, true, true>(buf, q1, O1, m1, l1, base, soff, lim, lo, lane, imp, carry, tile);
    }
    {
      float lt = l1[0]; lt = xsum<16>(lt); lt = xsum<32>(lt);
      const float inv = lt > 0.f ? 1.f / lt : 0.f;
      const float g0 = sigmoid_f(bf2f(Hb[(unsigned)trow[rg] * P0 + C_NG + hh * 3 + 0]));
#pragma unroll
      for (int dt = 0; dt < 4; ++dt) stash[(rg * 4 + dt) * 512] = O1[0][dt] * (g0 * inv);
      if (sb < 16) { mlo[rg] = (1u << (sb + 1)) - 1u; mhi[rg] = 0u; }
      else {
        float key[16];
#pragma unroll
        for (int k = 0; k < 16; ++k) {
          float v = imp[0][k] * inv; v = xsum<1>(v); v = xsum<2>(v);
          const int sidx = 4 * k + g;
          const bool forced = (sidx == 0) || (sidx == sb) || (sidx == sb - 1);
          key[k] = (sidx <= sb) ? (forced ? 1e9f : v) : -1e30f;
        }
        const int j = i & 3;
        float mykey[4]; int mys[4], rank[4];
#pragma unroll
        for (int q = 0; q < 4; ++q) {
          mykey[q] = j == 0 ? key[q] : (j == 1 ? key[4 + q] : (j == 2 ? key[8 + q] : key[12 + q]));
          mys[q] = 4 * (4 * j + q) + g; rank[q] = 0;
        }
#pragma unroll 1
        for (int gg = 0; gg < 4; ++gg)
#pragma unroll
          for (int kk = 0; kk < 16; ++kk) {
            const float other = __uint_as_float(__builtin_amdgcn_ds_bpermute((gg * 16 + i) << 2, __float_as_uint(key[kk])));
            const int sp = 4 * kk + gg;
#pragma unroll
            for (int q = 0; q < 4; ++q) rank[q] += (other > mykey[q] || (other == mykey[q] && sp < mys[q])) ? 1 : 0;
          }
        unsigned a = 0u, bb = 0u;
#pragma unroll
        for (int q = 0; q < 4; ++q) if (rank[q] < 16 && mys[q] <= sb) { if (mys[q] < 32) a |= 1u << mys[q]; else bb |= 1u << (mys[q] - 32); }
        a = xorr<1>(a); bb = xorr<1>(bb); a = xorr<2>(a); bb = xorr<2>(bb);
        a = xorr<16>(a); bb = xorr<16>(bb); a = xorr<32>(a); bb = xorr<32>(bb);
        mlo[rg] = a; mhi[rg] = bb;
      }
    }
  }
  {
    unsigned ua = mlo[0] | mlo[1], ub = mhi[0] | mhi[1];
    ua = xorr<4>(ua); ub = xorr<4>(ub); ua = xorr<8>(ua); ub = xorr<8>(ub);
    LAS unsigned* misc = (LAS unsigned*)(lds + AT_MISC);
    if (lane == 0) { misc[2 * wid] = ua; misc[2 * wid + 1] = ub; }
    __syncthreads();
    ua = 0u; ub = 0u;
#pragma unroll
    for (int w = 0; w < 8; ++w) { ua |= misc[2 * w]; ub |= misc[2 * w + 1]; }
    unsigned long long rem = ((unsigned long long)(unsigned)__builtin_amdgcn_readfirstlane(ub) << 32) | (unsigned)__builtin_amdgcn_readfirstlane(ua);
    const int nt = __builtin_popcountll(rem);
#pragma unroll
    for (int rg = 0; rg < 2; ++rg) { m[rg] = 0.f; l[rg] = 0.f;
#pragma unroll
      for (int dt = 0; dt < 4; ++dt) O[rg][dt] = (f32x4){0.f, 0.f, 0.f, 0.f}; }
    const bf16_t* Kg = Hb + C_KSEL + grp * 64;
    const bf16_t* Vg = Hb + C_VSEL + grp * 64;
    LAS int* tl = (LAS int*)(lds + AT_TL);
    if (tid < nt) { unsigned long long r = rem; for (int q = 0; q < tid; ++q) r &= r - 1; tl[tid] = __builtin_ctzll(r); }
    asm volatile("s_waitcnt vmcnt(0)" ::: "memory");
    __syncthreads();
#pragma unroll
    for (int st = 0; st < 3; ++st) if (st < nt) { const int bs = tl[st]; at_stage_dma(lds + st * AT_BUF, Kg + (size_t)bs * 64 * P0, Vg + (size_t)bs * 64 * P0, P0, lane, wid); }
    for (int ti = 0; ti < nt; ++ti) {
      ring_wait(min(nt - 1 - ti, 2));
      if (ti + 3 < nt) { const int bn = tl[ti + 3]; at_stage_dma(lds + ((ti + 3) & 3) * AT_BUF, Kg + (size_t)bn * 64 * P0, Vg + (size_t)bn * 64 * P0, P0, lane, wid); }
      const int cblk = __builtin_amdgcn_readfirstlane(tl[ti]);
      LAS const unsigned char* buf = lds + (ti & 3) * AT_BUF;
      float base[2], soff[2]; int lim[2], lo[2];
#pragma unroll
      for (int rg = 0; rg < 2; ++rg) {
        const bool rs = cblk < 32 ? ((mlo[rg] >> cblk) & 1u) : ((mhi[rg] >> (cblk - 32)) & 1u);
        base[rg] = rs ? slope2 * (float)(cblk * 64 + 4 * g - trow[rg]) : -INFINITY;
        soff[rg] = slope2; lim[rg] = trow[rg] - cblk * 64 - 4 * g; lo[rg] = -1000000;
      }
      if (cblk == sb) at_tile<2, true>(buf, qf, O, m, l, base, soff, lim, lo, lane);
      else at_tile<2, false>(buf, qf, O, m, l, base, soff, lim, lo, lane);
    }
    __builtin_amdgcn_s_barrier();
#pragma unroll
    for (int rg = 0; rg < 2; ++rg) {
      float lt = l[rg]; lt = xsum<16>(lt); lt = xsum<32>(lt);
      const float g1 = sigmoid_f(bf2f(Hb[(unsigned)trow[rg] * P0 + C_NG + hh * 3 + 1]));
#pragma unroll
      for (int dt = 0; dt < 4; ++dt) stash[(rg * 4 + dt) * 512] += O[rg][dt] * (g1 / lt);
    }
  }
  {
    const int b0 = sb >= 8 ? sb - 8 : 0;
    const int nt = sb - b0 + 1;
#pragma unroll
    for (int rg = 0; rg < 2; ++rg) { m[rg] = 0.f; l[rg] = 0.f;
#pragma unroll
      for (int dt = 0; dt < 4; ++dt) O[rg][dt] = (f32x4){0.f, 0.f, 0.f, 0.f}; }
    const bf16_t* Kg = Hb + C_KWIN + grp * 64;
    const bf16_t* Vg = Hb + C_VWIN + grp * 64;
    asm volatile("s_waitcnt vmcnt(0)" ::: "memory");
#pragma unroll
    for (int st = 0; st < 3; ++st) if (st < nt) at_stage_dma(lds + st * AT_BUF, Kg + (size_t)(b0 + st) * 64 * P0, Vg + (size_t)(b0 + st) * 64 * P0, P0, lane, wid);
    for (int ti = 0; ti < nt; ++ti) {
      ring_wait(min(nt - 1 - ti, 2));
      const int cblk = b0 + ti;
      if (ti + 3 < nt) at_stage_dma(lds + ((ti + 3) & 3) * AT_BUF, Kg + (size_t)(cblk + 3) * 64 * P0, Vg + (size_t)(cblk + 3) * 64 * P0, P0, lane, wid);
      LAS const unsigned char* buf = lds + (ti & 3) * AT_BUF;
      float base[2], soff[2]; int lim[2], lo[2];
#pragma unroll
      for (int rg = 0; rg < 2; ++rg) {
        base[rg] = slope2 * (float)(cblk * 64 + 4 * g - trow[rg]);
        soff[rg] = slope2; lim[rg] = trow[rg] - cblk * 64 - 4 * g; lo[rg] = trow[rg] - 511 - cblk * 64 - 4 * g;
      }
      if (cblk == sb || cblk == sb - 8) at_tile<2, true>(buf, qf, O, m, l, base, soff, lim, lo, lane);
      else at_tile<2, false>(buf, qf, O, m, l, base, soff, lim, lo, lane);
    }
    __builtin_amdgcn_s_barrier();
  }
#pragma unroll
  for (int rg = 0; rg < 2; ++rg) {
    float lt = l[rg]; lt = xsum<16>(lt); lt = xsum<32>(lt);
    const unsigned ro = (unsigned)trow[rg] * P0;
    const float g2 = sigmoid_f(bf2f(Hb[ro + C_NG + hh * 3 + 2])) / lt;
#pragma unroll
    for (int dt = 0; dt < 4; ++dt) {
      const int dv = 16 * dt + 4 * g;
      const ushort4 zz = *(const ushort4*)(Hb + ro + C_NZ + hh * 64 + dv);
      const f32x4 ov = stash[(rg * 4 + dt) * 512] + O[rg][dt] * g2;
      ushort4 o4;
      o4.x = f2bf(ov[0] * silu_f(bf2f(zz.x))); o4.y = f2bf(ov[1] * silu_f(bf2f(zz.y)));
      o4.z = f2bf(ov[2] * silu_f(bf2f(zz.z))); o4.w = f2bf(ov[3] * silu_f(bf2f(zz.w)));
      *(ushort4*)(MIX + (size_t)b * S_ * D_ + (unsigned)trow[rg] * D_ + hh * 64 + dv) = o4;
    }
  }
}

__device__ __forceinline__ void gla_gate_phase(const Params& P) {
  const bf16_t* H1 = (const bf16_t*)(P.ws + WS_H);
  float* G = (float*)(P.ws + WS_G);
  const float* w2 = P.in[10]; const float* gb = P.in[11];
  const size_t total = (size_t)M_ * 512;
  for (size_t i = (size_t)blockIdx.x * 512 + otid(); i < total; i += (size_t)gridDim.x * 512) {
    const int c = (int)(i & 511); const size_t row = i >> 9;
    float x = gb[c];
#pragma unroll
    for (int r = 0; r < 16; ++r) x += bf2f(H1[row * P1 + G_LR + r]) * w2[r * 512 + c];
    const float ls = fminf(x, 0.f) - log1pf(__expf(-fabsf(x)));
    G[i] = ls * (1.f / 16.f);
  }
}
__device__ __forceinline__ void gla_scan_vblock(const Params& P, int vb) {
  const bf16_t* __restrict__ H1 = (const bf16_t*)(P.ws + WS_H);
  const float* __restrict__ G = (const float*)(P.ws + WS_G);
  bf16_t* __restrict__ O = (bf16_t*)(P.ws + WS_XB);
  const int tid = otid(), lane = tid & 63, wid = tid >> 6;
  const int eh = vb & 1, h = (vb >> 1) & 3, b = vb >> 3;
  const int e = eh * 128 + wid * 16 + (lane >> 2), dq = lane & 3;
  float St[32];
#pragma unroll
  for (int i = 0; i < 32; ++i) St[i] = 0.f;
  const float qscale = 0.08838834764831845f;
  for (int t = 0; t < S_; ++t) {
    const size_t row = (size_t)b * S_ + t;
    const float4* gr = (const float4*)(G + row * 512 + h * 128 + dq * 32);
    const uint4* kr = (const uint4*)(H1 + row * P1 + G_K + h * 128 + dq * 32);
    const uint4* qr = (const uint4*)(H1 + row * P1 + G_Q + h * 128 + dq * 32);
    const float v = bf2f(H1[row * P1 + G_V + h * 256 + e]);
    float o = 0.f;
#pragma unroll
    for (int c = 0; c < 4; ++c) {
      const uint4 ku = kr[c], qu = qr[c];
      const float4 g0 = gr[2 * c], g1 = gr[2 * c + 1];
      const float kk[8] = {__uint_as_float(ku.x << 16), __uint_as_float(ku.x & 0xffff0000u), __uint_as_float(ku.y << 16), __uint_as_float(ku.y & 0xffff0000u),
                           __uint_as_float(ku.z << 16), __uint_as_float(ku.z & 0xffff0000u), __uint_as_float(ku.w << 16), __uint_as_float(ku.w & 0xffff0000u)};
      const float qq[8] = {__uint_as_float(qu.x << 16), __uint_as_float(qu.x & 0xffff0000u), __uint_as_float(qu.y << 16), __uint_as_float(qu.y & 0xffff0000u),
                           __uint_as_float(qu.z << 16), __uint_as_float(qu.z & 0xffff0000u), __uint_as_float(qu.w << 16), __uint_as_float(qu.w & 0xffff0000u)};
      const float gg[8] = {g0.x, g0.y, g0.z, g0.w, g1.x, g1.y, g1.z, g1.w};
#pragma unroll
      for (int i = 0; i < 8; ++i) {
        const float a = __expf(gg[i]);
        St[c * 8 + i] = a * St[c * 8 + i] + kk[i] * v;
        o += qq[i] * St[c * 8 + i];
      }
    }
    o = xsum<1>(o); o = xsum<2>(o);
    if (dq == 0) O[row * D_ + h * 256 + e] = f2bf(o * qscale);
  }
}

constexpr int CTL_GLA = 16384;
constexpr size_t WS_QT = WS_G;
constexpr size_t WS_KH = WS_G + 16 * MiB;
constexpr size_t WS_ATT = 190 * MiB;
constexpr size_t WS_DEC = 199 * MiB;
__device__ __forceinline__ int kperm(int x) { const int dl = x & 31, hi = dl >> 4, d2 = dl & 15; return (x & ~31) + 8 * (d2 >> 2) + 4 * hi + (d2 & 3); }

__device__ __forceinline__ void st8_wt(void* p, unsigned lo, unsigned hi) {
  __hip_atomic_store((unsigned long long*)p, ((unsigned long long)hi << 32) | lo, __ATOMIC_RELAXED, __HIP_MEMORY_SCOPE_AGENT);
}
__device__ __forceinline__ void gla_prep_item(const Params& P, int item, unsigned char* smem_g) {
  const bf16_t* __restrict__ H1 = (const bf16_t*)(P.ws + WS_H);
  bf16_t* __restrict__ QT = (bf16_t*)(P.ws + WS_QT) + (size_t)item * 8192;
  bf16_t* __restrict__ KH = (bf16_t*)(P.ws + WS_KH) + (size_t)item * 8192;
  bf16_t* __restrict__ ATT = (bf16_t*)(P.ws + WS_ATT) + (size_t)item * 4096;
  float* __restrict__ DEC = (float*)(P.ws + WS_DEC) + (size_t)item * 128;
  const int tid = otid(), lane = tid & 63, wid = tid >> 6, g = lane >> 4, i = lane & 15;
  const int c = item & 63, h = (item >> 6) & 3, b = item >> 8;
  const size_t rowbase = (size_t)b * S_ + c * 64;
  float* glr = (float*)smem_g;
  float* tot = (float*)(smem_g + 4096);
  bf16_t* qs = (bf16_t*)(smem_g + 12288);
  bf16_t* ks = (bf16_t*)(smem_g + 12288 + 17408);
  const int d0 = (tid & 31) * 4, rgp = tid >> 5;
#pragma unroll
  for (int k = 0; k < 2; ++k) { const int e = tid + 512 * k; glr[e] = ((const float*)(P.ws + WS_GLR))[rowbase * 16 + e]; }
  uint2 qraw[4], kraw[4];
#pragma unroll
  for (int k = 0; k < 4; ++k) {
    qraw[k] = *(const uint2*)(H1 + (rowbase + 4 * rgp + k) * P1 + G_Q + h * 128 + d0);
    kraw[k] = *(const uint2*)(H1 + (rowbase + 4 * rgp + k) * P1 + G_K + h * 128 + d0);
  }
  float4 w[16];
#pragma unroll
  for (int r = 0; r < 16; ++r) w[r] = *(const float4*)(P.in[10] + r * 512 + h * 128 + d0);
  const float4 gb = *(const float4*)(P.in[11] + h * 128 + d0);
  __syncthreads();
  float bb[4][4];
  float run[4] = {0.f, 0.f, 0.f, 0.f};
#pragma unroll
  for (int k = 0; k < 4; ++k) {
    const float* gr = glr + (4 * rgp + k) * 16;
    float x[4] = {gb.x, gb.y, gb.z, gb.w};
#pragma unroll
    for (int r = 0; r < 16; ++r) { const float gv = gr[r]; x[0] += gv * w[r].x; x[1] += gv * w[r].y; x[2] += gv * w[r].z; x[3] += gv * w[r].w; }
#pragma unroll
    for (int j = 0; j < 4; ++j) {
      const float la = (fminf(x[j], 0.f) - __logf(1.f + __expf(-fabsf(x[j])))) * (1.f / 16.f);
      run[j] += la; bb[k][j] = run[j];
    }
  }
  *(float4*)(tot + rgp * 128 + d0) = (float4){run[0], run[1], run[2], run[3]};
  __syncthreads();
  float off[4] = {0.f, 0.f, 0.f, 0.f}, total[4] = {0.f, 0.f, 0.f, 0.f};
#pragma unroll
  for (int q = 0; q < 16; ++q) {
    const float4 tv = *(const float4*)(tot + q * 128 + d0);
    total[0] += tv.x; total[1] += tv.y; total[2] += tv.z; total[3] += tv.w;
    if (q < rgp) { off[0] += tv.x; off[1] += tv.y; off[2] += tv.z; off[3] += tv.w; }
  }
  const float qscale = 0.08838834764831845f;
  const int dp = kperm(d0);
#pragma unroll
  for (int k = 0; k < 4; ++k) {
    const int r = 4 * rgp + k;
    const float qv[4] = {__uint_as_float(qraw[k].x << 16), __uint_as_float(qraw[k].x & 0xffff0000u), __uint_as_float(qraw[k].y << 16), __uint_as_float(qraw[k].y & 0xffff0000u)};
    const float kv[4] = {__uint_as_float(kraw[k].x << 16), __uint_as_float(kraw[k].x & 0xffff0000u), __uint_as_float(kraw[k].y << 16), __uint_as_float(kraw[k].y & 0xffff0000u)};
    float qt[4], kt[4], kh[4];
#pragma unroll
    for (int j = 0; j < 4; ++j) {
      const float bv = bb[k][j] + off[j];
      const float eb = __expf(bv);
      qt[j] = qv[j] * eb * qscale; kt[j] = kv[j] * __expf(-bv); kh[j] = kv[j] * __expf(total[j] - bv);
    }
    const unsigned q01 = cvtpk(qt[0], qt[1]), q23 = cvtpk(qt[2], qt[3]), k01 = cvtpk(kt[0], kt[1]), k23 = cvtpk(kt[2], kt[3]);
    *(uint2*)(qs + r * 136 + d0) = (uint2){q01, q23};
    *(uint2*)(ks + r * 136 + d0) = (uint2){k01, k23};
    st8_wt(QT + r * 128 + dp, q01, q23);
    st8_wt(KH + r * 128 + d0, cvtpk(kh[0], kh[1]), cvtpk(kh[2], kh[3]));
  }
  if (rgp == 0) {
    st8_wt(DEC + d0, __float_as_uint(__expf(total[0])), __float_as_uint(__expf(total[1])));
    st8_wt(DEC + d0 + 2, __float_as_uint(__expf(total[2])), __float_as_uint(__expf(total[3])));
  }
  __syncthreads();
  {
    const int it = wid >> 1, jt0 = 2 * (wid & 1);
    f32x4 acc[2] = {(f32x4){0.f, 0.f, 0.f, 0.f}, (f32x4){0.f, 0.f, 0.f, 0.f}};
#pragma unroll
    for (int kk = 0; kk < 4; ++kk) {
      const bf16x8 qa = *(const bf16x8*)(qs + (16 * it + i) * 136 + 32 * kk + 8 * g);
#pragma unroll
      for (int n = 0; n < 2; ++n) {
        const bf16x8 kf = *(const bf16x8*)(ks + (16 * (jt0 + n) + i) * 136 + 32 * kk + 8 * g);
        acc[n] = __builtin_amdgcn_mfma_f32_16x16x32_bf16(kf, qa, acc[n], 0, 0, 0);
      }
    }
#pragma unroll
    for (int n = 0; n < 2; ++n) {
      const int ri = 16 * it + i, cj0 = 16 * (jt0 + n) + 4 * g;
      float v[4];
#pragma unroll
      for (int r = 0; r < 4; ++r) v[r] = (cj0 + r <= ri) ? acc[n][r] : 0.f;
      st8_wt(ATT + ri * 64 + kperm(cj0), cvtpk(v[0], v[1]), cvtpk(v[2], v[3]));
    }
  }
  asm volatile("s_waitcnt vmcnt(0)" ::: "memory");
  __syncthreads();
  if (tid == 0) __hip_atomic_store((unsigned*)P.ws + CTL_GLA + 64 * item, 1u, __ATOMIC_RELAXED, __HIP_MEMORY_SCOPE_AGENT);
}
__device__ __forceinline__ void gla_wait_items(const Params& P, int first, int n, int tid) {
  if (tid < n) {
    unsigned* f = (unsigned*)P.ws + CTL_GLA + 64 * (first + tid);
    unsigned sp = 0;
    while (__hip_atomic_load(f, __ATOMIC_RELAXED, __HIP_MEMORY_SCOPE_AGENT) == 0u) { __builtin_amdgcn_s_sleep(2); if (++sp > (1u << 22)) break; }
  }
  __syncthreads();
}
constexpr int GS_Q = 0, GS_K = 16384, GS_V = 32768, GS_A = 49152, GS_D = 57344, GS_BYTES = 57856;
__device__ __forceinline__ void gla_stage_dma(LAS unsigned char* st, const Params& P, int item, size_t rowbase, int h, int eh, int lane, int wid) {
  const bf16_t* QT = (const bf16_t*)(P.ws + WS_QT) + (size_t)item * 8192;
  const bf16_t* KH = (const bf16_t*)(P.ws + WS_KH) + (size_t)item * 8192;
  const bf16_t* ATT = (const bf16_t*)(P.ws + WS_ATT) + (size_t)item * 4096;
  const bf16_t* V = (const bf16_t*)(P.ws + WS_H) + rowbase * P1 + G_V + h * 256 + eh * 128;
#pragma unroll
  for (int n = 0; n < 2; ++n) {
    const int q = 2 * wid + n;
    { const int row = 4 * q + (lane >> 4), ch = (lane & 15) ^ (row & 15);
      __builtin_amdgcn_global_load_lds((const unsigned*)(QT + row * 128 + ch * 8), (LAS unsigned*)(st + GS_Q + q * 1024), 16, 0, 0); }
    { const int dt = q >> 1, j = 32 * (q & 1) + (lane >> 1);
      __builtin_amdgcn_global_load_lds((const unsigned*)(KH + j * 128 + dt * 16 + (lane & 1) * 8), (LAS unsigned*)(st + GS_K + q * 1024), 16, 0, 0);
      __builtin_amdgcn_global_load_lds((const unsigned*)(V + (unsigned)j * P1 + dt * 16 + (lane & 1) * 8), (LAS unsigned*)(st + GS_V + q * 1024), 16, 0, 0); }
  }
  { const int row = 8 * wid + (lane >> 3), ch = (lane & 7) ^ ((row >> 1) & 7);
    __builtin_amdgcn_global_load_lds((const unsigned*)(ATT + row * 64 + ch * 8), (LAS unsigned*)(st + GS_A + wid * 1024), 16, 0, 0); }
  if (wid < 2) __builtin_amdgcn_global_load_lds((const unsigned*)((const float*)(P.ws + WS_DEC) + (size_t)item * 128 + wid * 64 + lane), (LAS unsigned*)(st + GS_D + wid * 256), 4, 0, 0);
}
__device__ __forceinline__ void gla_chain(const Params& P, int chain, unsigned char* smem_g) {
  LAS unsigned char* lds = (LAS unsigned char*)smem_g;
  bf16_t* __restrict__ O = (bf16_t*)(P.ws + WS_XB);
  const int tid = otid(), lane = tid & 63, wid = __builtin_amdgcn_readfirstlane(tid >> 6), g = lane >> 4, i = lane & 15;
  const int eh = chain & 1, h = (chain >> 1) & 3, b = chain >> 3;
  const int item0 = (b * 4 + h) * 64;
  f32x4 S[8];
#pragma unroll
  for (int dt = 0; dt < 8; ++dt) S[dt] = (f32x4){0.f, 0.f, 0.f, 0.f};
  gla_wait_items(P, item0, 9, tid);
  gla_stage_dma(lds, P, item0, (size_t)b * S_, h, eh, lane, wid);
  __syncthreads();
  for (int c = 0; c < 64; ++c) {
    if ((c & 7) == 0 && c > 0) gla_wait_items(P, item0 + c + 1, (64 - (c + 1)) < 8 ? (64 - (c + 1)) : 8, tid);
    if (c + 1 < 64) gla_stage_dma(lds + ((c + 1) & 1) * GS_BYTES, P, item0 + c + 1, (size_t)b * S_ + (c + 1) * 64, h, eh, lane, wid);
    LAS const unsigned char* st = lds + (c & 1) * GS_BYTES;
    f32x4 dc[8];
#pragma unroll
    for (int dt = 0; dt < 8; ++dt) dc[dt] = *(LAS const f32x4*)(st + GS_D + (16 * dt + 4 * g) * 4);
    u32x4 spk[4];
#pragma unroll
    for (int kk = 0; kk < 4; ++kk) {
      spk[kk][0] = cvtpk(S[2 * kk][0], S[2 * kk][1]); spk[kk][1] = cvtpk(S[2 * kk][2], S[2 * kk][3]);
      spk[kk][2] = cvtpk(S[2 * kk + 1][0], S[2 * kk + 1][1]); spk[kk][3] = cvtpk(S[2 * kk + 1][2], S[2 * kk + 1][3]);
    }
    bf16x8 vf[2];
    const unsigned trb = (unsigned)(unsigned long long)st + (4 * g + (i >> 2)) * 32 + (i & 3) * 8;
    {
      const unsigned vb = trb + GS_V + wid * 2048;
      const s16x4 v0 = vtra<0>(vb), v1 = vtra<512>(vb), v2 = vtra<1024>(vb), v3 = vtra<1536>(vb);
      LGKM0();
      vf[0] = (bf16x8){v0[0], v0[1], v0[2], v0[3], v1[0], v1[1], v1[2], v1[3]};
      vf[1] = (bf16x8){v2[0], v2[1], v2[2], v2[3], v3[0], v3[1], v3[2], v3[3]};
    }
#pragma unroll
    for (int it = 0; it < 4; ++it) {
      f32x4 acc = (f32x4){0.f, 0.f, 0.f, 0.f};
      LAS const unsigned char* qrow = st + GS_Q + (16 * it + i) * 256;
#pragma unroll
      for (int kk = 0; kk < 4; ++kk) {
        const bf16x8 a = *(LAS const bf16x8*)(qrow + (((4 * kk + g) ^ i) << 4));
        acc = __builtin_amdgcn_mfma_f32_16x16x32_bf16(a, __builtin_bit_cast(bf16x8, spk[kk]), acc, 0, 0, 0);
      }
      LAS const unsigned char* arow = st + GS_A + (16 * it + i) * 128;
#pragma unroll
      for (int k2 = 0; k2 < 2; ++k2) {
        const bf16x8 a = *(LAS const bf16x8*)(arow + (((4 * k2 + g) ^ ((i >> 1) & 7)) << 4));
        acc = __builtin_amdgcn_mfma_f32_16x16x32_bf16(a, vf[k2], acc, 0, 0, 0);
      }
      bf16_t* op = O + ((size_t)b * S_ + c * 64 + 16 * it + 4 * g) * D_ + h * 256 + eh * 128 + 16 * wid + i;
#pragma unroll
      for (int r = 0; r < 4; ++r) op[(size_t)r * D_] = f2bf(acc[r]);
    }
    __builtin_amdgcn_sched_barrier(0);
#define GL_KRD(dt, q0, q1, q2, q3) { q0 = vtra<GS_K + (dt) * 2048>(trb); q1 = vtra<GS_K + (dt) * 2048 + 512>(trb); q2 = vtra<GS_K + (dt) * 2048 + 1024>(trb); q3 = vtra<GS_K + (dt) * 2048 + 1536>(trb); }
#define GL_UPD(dt, q0, q1, q2, q3) { S[dt] = S[dt] * dc[dt]; \
      S[dt] = __builtin_amdgcn_mfma_f32_16x16x32_bf16((bf16x8){q0[0], q0[1], q0[2], q0[3], q1[0], q1[1], q1[2], q1[3]}, vf[0], S[dt], 0, 0, 0); \
      S[dt] = __builtin_amdgcn_mfma_f32_16x16x32_bf16((bf16x8){q2[0], q2[1], q2[2], q2[3], q3[0], q3[1], q3[2], q3[3]}, vf[1], S[dt], 0, 0, 0); }
    {
      s16x4 e0, e1, e2, e3, e4, e5, e6, e7, f0, f1, f2, f3, f4, f5, f6, f7;
      GL_KRD(0, e0, e1, e2, e3) GL_KRD(1, e4, e5, e6, e7)
      LGKM0();
      GL_KRD(2, f0, f1, f2, f3) GL_KRD(3, f4, f5, f6, f7)
      GL_UPD(0, e0, e1, e2, e3) GL_UPD(1, e4, e5, e6, e7)
      LGKM0();
      GL_KRD(4, e0, e1, e2, e3) GL_KRD(5, e4, e5, e6, e7)
      GL_UPD(2, f0, f1, f2, f3) GL_UPD(3, f4, f5, f6, f7)
      LGKM0();
      GL_KRD(6, f0, f1, f2, f3) GL_KRD(7, f4, f5, f6, f7)
      GL_UPD(4, e0, e1, e2, e3) GL_UPD(5, e4, e5, e6, e7)
      LGKM0();
      GL_UPD(6, f0, f1, f2, f3) GL_UPD(7, f4, f5, f6, f7)
    }
#undef GL_KRD
#undef GL_UPD
    __syncthreads();
  }
}


constexpr int G4_Q = 0, G4_K = 16384, G4_V = 32768, G4_A = 40960, G4_D = 49152, G4_BYTES = 49664, G4_EXCH = 3 * G4_BYTES, G4_END = G4_EXCH + 8192;
__device__ __forceinline__ void gla4_stage_dma(LAS unsigned char* st, const Params& P, int item, size_t rowbase, int h, int eq, int lane, int wid) {
  const bf16_t* QT = (const bf16_t*)(P.ws + WS_QT) + (size_t)item * 8192;
  const bf16_t* KH = (const bf16_t*)(P.ws + WS_KH) + (size_t)item * 8192;
  const bf16_t* ATT = (const bf16_t*)(P.ws + WS_ATT) + (size_t)item * 4096;
  const bf16_t* V = (const bf16_t*)(P.ws + WS_H) + rowbase * P1 + G_V + h * 256 + eq * 64;
#pragma unroll
  for (int n = 0; n < 2; ++n) {
    const int q = 2 * wid + n;
    { const int row = 4 * q + (lane >> 4), ch = (lane & 15) ^ (row & 15);
      __builtin_amdgcn_global_load_lds((const unsigned*)(QT + row * 128 + ch * 8), (LAS unsigned*)(st + G4_Q + q * 1024), 16, 0, 0); }
    { const int dt = q >> 1, j = 32 * (q & 1) + (lane >> 1);
      __builtin_amdgcn_global_load_lds((const unsigned*)(KH + j * 128 + dt * 16 + (lane & 1) * 8), (LAS unsigned*)(st + G4_K + q * 1024), 16, 0, 0); }
  }
  { const int et = wid >> 1, j = 32 * (wid & 1) + (lane >> 1);
    __builtin_amdgcn_global_load_lds((const unsigned*)(V + (unsigned)j * P1 + et * 16 + (lane & 1) * 8), (LAS unsigned*)(st + G4_V + wid * 1024), 16, 0, 0); }
  { const int row = 8 * wid + (lane >> 3), ch = (lane & 7) ^ ((row >> 1) & 7);
    __builtin_amdgcn_global_load_lds((const unsigned*)(ATT + row * 64 + ch * 8), (LAS unsigned*)(st + G4_A + wid * 1024), 16, 0, 0); }
  __builtin_amdgcn_global_load_lds((const unsigned*)((const float*)(P.ws + WS_DEC) + (size_t)item * 128 + (wid & 1) * 64 + lane), (LAS unsigned*)(st + G4_D + (wid & 1) * 256), 4, 0, 0);
}
__device__ __forceinline__ void gla_chain64(const Params& P, int chain, int seg, unsigned char* smem_g) {
  LAS unsigned char* lds = (LAS unsigned char*)smem_g;
  bf16_t* __restrict__ O = (bf16_t*)(P.ws + WS_XB);
  const int tid = otid(), lane = tid & 63, wid = __builtin_amdgcn_readfirstlane(tid >> 6), g = lane >> 4, i = lane & 15;
  const int et = wid & 3, dh = wid >> 2;
  const int eq = chain & 3, h = (chain >> 2) & 3, b = chain >> 4;
  const int item0 = (b * 4 + h) * 64 + 32 * seg;
  const size_t row0 = (size_t)b * S_ + (size_t)seg * 32 * 64;
  f32x4 S[4];
#pragma unroll
  for (int t = 0; t < 4; ++t) S[t] = (f32x4){0.f, 0.f, 0.f, 0.f};
  f32x4 opend[2] = {(f32x4){0.f, 0.f, 0.f, 0.f}, (f32x4){0.f, 0.f, 0.f, 0.f}};
  gla_wait_items(P, item0, 10, tid);
  gla4_stage_dma(lds, P, item0, row0, h, eq, lane, wid);
  gla4_stage_dma(lds + G4_BYTES, P, item0 + 1, row0 + 64, h, eq, lane, wid);
  for (int c = 0; c < 32; ++c) {
    if ((c & 7) == 0 && c > 0 && c + 2 < 32) gla_wait_items(P, item0 + c + 2, (32 - (c + 2)) < 8 ? (32 - (c + 2)) : 8, tid);
    if (c + 1 < 32) asm volatile("s_waitcnt vmcnt(7)" ::: "memory"); else asm volatile("s_waitcnt vmcnt(0)" ::: "memory");
    __builtin_amdgcn_s_barrier();
    asm volatile("" ::: "memory");
    if (c > 0) {
#pragma unroll
      for (int q = 0; q < 2; ++q) { bf16_t* op = O + (row0 + (c - 1) * 64 + 16 * (2 * dh + q) + 4 * g) * D_ + h * 256 + eq * 64 + 16 * et + i;
#pragma unroll
        for (int r = 0; r < 4; ++r) op[(size_t)r * D_] = f2bf(opend[q][r]); }
    }
    if (c + 2 < 32) gla4_stage_dma(lds + ((c + 2) % 3) * G4_BYTES, P, item0 + c + 2, row0 + (c + 2) * 64, h, eq, lane, wid);
    LAS const unsigned char* st = lds + (c % 3) * G4_BYTES;
    f32x4 dc[4];
#pragma unroll
    for (int t = 0; t < 4; ++t) dc[t] = *(LAS const f32x4*)(st + G4_D + (16 * (4 * dh + t) + 4 * g) * 4);
    bf16x8 qa[4][2], aa[2][2];
#pragma unroll
    for (int it = 0; it < 4; ++it)
#pragma unroll
      for (int q = 0; q < 2; ++q) qa[it][q] = *(LAS const bf16x8*)(st + G4_Q + (16 * it + i) * 256 + (((4 * (2 * dh + q) + g) ^ i) << 4));
#pragma unroll
    for (int q = 0; q < 2; ++q)
#pragma unroll
      for (int k2 = 0; k2 < 2; ++k2) aa[q][k2] = *(LAS const bf16x8*)(st + G4_A + (16 * (2 * dh + q) + i) * 128 + (((4 * k2 + g) ^ ((i >> 1) & 7)) << 4));
    const unsigned trb = (unsigned)(unsigned long long)st + (4 * g + (i >> 2)) * 32 + (i & 3) * 8;
    const unsigned vb = trb + G4_V + et * 2048, kb = trb + G4_K + (4 * dh) * 2048;
    const s16x4 v0 = vtra<0>(vb), v1 = vtra<512>(vb), v2 = vtra<1024>(vb), v3 = vtra<1536>(vb);
    s16x4 kq[4][4];
#define G4_KRD(t) { kq[t][0] = vtra<(t) * 2048>(kb); kq[t][1] = vtra<(t) * 2048 + 512>(kb); kq[t][2] = vtra<(t) * 2048 + 1024>(kb); kq[t][3] = vtra<(t) * 2048 + 1536>(kb); }
    G4_KRD(0) G4_KRD(1) G4_KRD(2) G4_KRD(3)
#undef G4_KRD
    u32x4 spk[2];
#pragma unroll
    for (int q = 0; q < 2; ++q) {
      spk[q][0] = cvtpk(S[2 * q][0], S[2 * q][1]); spk[q][1] = cvtpk(S[2 * q][2], S[2 * q][3]);
      spk[q][2] = cvtpk(S[2 * q + 1][0], S[2 * q + 1][1]); spk[q][3] = cvtpk(S[2 * q + 1][2], S[2 * q + 1][3]);
    }
    LGKM0();
    bf16x8 vf[2];
    vf[0] = (bf16x8){v0[0], v0[1], v0[2], v0[3], v1[0], v1[1], v1[2], v1[3]};
    vf[1] = (bf16x8){v2[0], v2[1], v2[2], v2[3], v3[0], v3[1], v3[2], v3[3]};
    f32x4 acc[4];
#pragma unroll
    for (int it = 0; it < 4; ++it) {
      acc[it] = (f32x4){0.f, 0.f, 0.f, 0.f};
      if (it >> 1 == dh) {
#pragma unroll
        for (int k2 = 0; k2 < 2; ++k2) acc[it] = __builtin_amdgcn_mfma_f32_16x16x32_bf16(aa[it & 1][k2], vf[k2], acc[it], 0, 0, 0);
      }
#pragma unroll
      for (int q = 0; q < 2; ++q) acc[it] = __builtin_amdgcn_mfma_f32_16x16x32_bf16(qa[it][q], __builtin_bit_cast(bf16x8, spk[q]), acc[it], 0, 0, 0);
    }
#pragma unroll
    for (int t = 0; t < 4; ++t) {
      S[t] = S[t] * dc[t];
      S[t] = __builtin_amdgcn_mfma_f32_16x16x32_bf16((bf16x8){kq[t][0][0], kq[t][0][1], kq[t][0][2], kq[t][0][3], kq[t][1][0], kq[t][1][1], kq[t][1][2], kq[t][1][3]}, vf[0], S[t], 0, 0, 0);
      S[t] = __builtin_amdgcn_mfma_f32_16x16x32_bf16((bf16x8){kq[t][2][0], kq[t][2][1], kq[t][2][2], kq[t][2][3], kq[t][3][0], kq[t][3][1], kq[t][3][2], kq[t][3][3]}, vf[1], S[t], 0, 0, 0);
    }
    {
      LAS u32x2* ex = (LAS u32x2*)(lds + G4_EXCH) + (wid * 2) * 64 + lane;
#pragma unroll
      for (int q = 0; q < 2; ++q) { const f32x4 v = dh == 0 ? acc[2 + q] : acc[q]; ex[q * 64] = (u32x2){cvtpk(v[0], v[1]), cvtpk(v[2], v[3])}; }
    }
    asm volatile("s_waitcnt lgkmcnt(0)" ::: "memory");
    __builtin_amdgcn_s_barrier();
    asm volatile("" ::: "memory");
    {
      LAS const u32x2* ex = (LAS const u32x2*)(lds + G4_EXCH) + ((wid ^ 4) * 2) * 64 + lane;
#pragma unroll
      for (int q = 0; q < 2; ++q) {
        const u32x2 pv = ex[q * 64];
        f32x4 mine = dh == 0 ? acc[q] : acc[2 + q];
        mine[0] += __uint_as_float(pv.x << 16); mine[1] += __uint_as_float(pv.x & 0xffff0000u); mine[2] += __uint_as_float(pv.y << 16); mine[3] += __uint_as_float(pv.y & 0xffff0000u);
        opend[q] = mine;
      }
    }
  }
#pragma unroll
  for (int q = 0; q < 2; ++q) { bf16_t* op = O + (row0 + 31 * 64 + 16 * (2 * dh + q) + 4 * g) * D_ + h * 256 + eq * 64 + 16 * et + i;
#pragma unroll
    for (int r = 0; r < 4; ++r) op[(size_t)r * D_] = f2bf(opend[q][r]); }
  if (seg == 0) {
    bf16_t* smt = (bf16_t*)(P.ws + WS_SMT) + ((size_t)(b * 4 + h) * 256 + eq * 64 + 16 * et + i) * 128;
#pragma unroll
    for (int t = 0; t < 4; ++t) { const int T = 4 * dh + t, p0 = 32 * (T >> 1) + 8 * g + 4 * (T & 1);
      *(u32x2*)(smt + p0) = (u32x2){cvtpk(S[t][0], S[t][1]), cvtpk(S[t][2], S[t][3])}; }
  }
  __builtin_amdgcn_s_barrier();
}

__device__ __forceinline__ void gla_norm_phase(const Params& P) {
  const bf16_t* H1 = (const bf16_t*)(P.ws + WS_H);
  const bf16_t* O = (const bf16_t*)(P.ws + WS_XB);
  bf16_t* MIX = (bf16_t*)(P.ws + WS_MIX);
  const float* gn = P.in[12];
  const int lane = otid() & 63, wid = otid() >> 6;
  for (int it = blockIdx.x * 8 + wid; it < M_ * 4; it += gridDim.x * 8) {
    const int h = it & 3; const size_t row = it >> 2;
    float v[4]; float ss = 0.f;
#pragma unroll
    for (int k = 0; k < 4; ++k) { v[k] = bf2f(O[row * D_ + h * 256 + k * 64 + lane]); ss += v[k] * v[k]; }
    const float r = 1.f / sqrtf(wave_sum(ss) * (1.f / 256.f) + LN_EPS);
#pragma unroll
    for (int k = 0; k < 4; ++k) {
      const int c = h * 256 + k * 64 + lane;
      const float z = bf2f(H1[row * P1 + G_Z + c]);
      MIX[row * D_ + c] = f2bf(v[k] * r * gn[c] * silu_f(z));
    }
  }
}


constexpr int RG_RED = 131072;
__device__ __forceinline__ size_t wfrag_off(int n, int k) { return ((size_t)(((n >> 4) * 32 + (k >> 5)) * 64 + ((k >> 3) & 3) * 16 + (n & 15))) * 8 + (k & 7); }
template <int AMODE  , bool GLR  >
__device__ __forceinline__ void rowgemm_block(const Params& P, int rb, const bf16_t* __restrict__ Wf, const float* base, float* out, bf16_t* outb,
                                              const float* __restrict__ gam, const float* __restrict__ bet, unsigned char* smem_g) {
  LAS unsigned char* lds = (LAS unsigned char*)smem_g;
  const int tid = otid(), lane = tid & 63, wid = __builtin_amdgcn_readfirstlane(tid >> 6), g = lane >> 4, i = lane & 15;
  const size_t r0 = (size_t)rb * 64;
  if (AMODE == 0) {
    const bf16_t* A = (const bf16_t*)(P.ws + WS_MIX) + r0 * D_;
#pragma unroll
    for (int q0 = 0; q0 < 16; ++q0) {
      const int q = wid * 16 + q0, row = q >> 1, ch = ((q & 1) * 64 + lane) ^ (row & 15);
      __builtin_amdgcn_global_load_lds((const unsigned*)(A + (size_t)row * D_ + ch * 8), (LAS unsigned*)(lds + q * 1024), 16, 0, 0);
    }
  } else {
    const bf16_t* __restrict__ O = (const bf16_t*)(P.ws + WS_XB) + r0 * D_;
    const bf16_t* __restrict__ H1 = (const bf16_t*)(P.ws + WS_H) + r0 * P1 + G_Z;
    const float* __restrict__ gn = P.in[12];
    const int row = tid >> 3, part = tid & 7;
    u32x4 ov[16];
#pragma unroll
    for (int c = 0; c < 16; ++c) ov[c] = *(const u32x4*)(O + (size_t)row * D_ + part * 128 + c * 8);
    const int bb = rb >> 6, cc = rb & 63;
    if (cc >= 32) {
      LAS float* PP = (LAS float*)(lds + RG_RED);
      LAS unsigned char* QP = lds + RG_RED + 4096;
#pragma unroll 1
      for (int hh = 0; hh < 4; ++hh) {
        const int itm = (bb * 4 + hh) * 64;
        if (tid < 128) {
          const int pp = tid, dd = (pp & ~31) + 16 * ((pp >> 2) & 1) + 4 * ((pp >> 3) & 3) + (pp & 3);
          const float* dec = (const float*)(P.ws + WS_DEC) + (size_t)itm * 128 + dd;
          float pr = 1.f;
#pragma unroll 4
          for (int c2 = 32; c2 < cc; ++c2) pr *= dec[(size_t)c2 * 128];
          PP[pp] = pr;
        }
        __syncthreads();
        {
          const int p0 = (tid & 7) * 16;
          const bf16_t* qsrc = (const bf16_t*)(P.ws + WS_QT) + (size_t)(itm + cc) * 8192 + row * 128 + p0;
          const u32x4 q0 = *(const u32x4*)qsrc, q1 = *(const u32x4*)(qsrc + 8);
          u32x4 w0, w1;
#pragma unroll
          for (int e = 0; e < 4; ++e) {
            w0[e] = cvtpk(__uint_as_float(q0[e] << 16) * PP[p0 + 2 * e], __uint_as_float(q0[e] & 0xffff0000u) * PP[p0 + 2 * e + 1]);
            w1[e] = cvtpk(__uint_as_float(q1[e] << 16) * PP[p0 + 8 + 2 * e], __uint_as_float(q1[e] & 0xffff0000u) * PP[p0 + 8 + 2 * e + 1]);
          }
          *(LAS u32x4*)(QP + row * 272 + p0 * 2) = w0; *(LAS u32x4*)(QP + row * 272 + p0 * 2 + 16) = w1;
        }
        __syncthreads();
        {
          const bf16_t* smt = (const bf16_t*)(P.ws + WS_SMT) + ((size_t)(bb * 4 + hh) * 256 + 32 * wid + i) * 128 + 8 * g;
          bf16x8 af[2][4];
#pragma unroll
          for (int q = 0; q < 2; ++q)
#pragma unroll
            for (int kk = 0; kk < 4; ++kk) af[q][kk] = *(const bf16x8*)(smt + (size_t)q * 16 * 128 + 32 * kk);
#pragma unroll 1
          for (int mm = 0; mm < 4; ++mm) {
            bf16x8 bfm[4];
#pragma unroll
            for (int kk = 0; kk < 4; ++kk) bfm[kk] = *(LAS const bf16x8*)(QP + (16 * mm + i) * 272 + (32 * kk + 8 * g) * 2);
#pragma unroll
            for (int q = 0; q < 2; ++q) {
              f32x4 ca = (f32x4){0.f, 0.f, 0.f, 0.f};
#pragma unroll
              for (int kk = 0; kk < 4; ++kk) ca = __builtin_amdgcn_mfma_f32_16x16x32_bf16(af[q][kk], bfm[kk], ca, 0, 0, 0);
              *(LAS u32x2*)(lds + (16 * mm + i) * 2048 + (hh * 256 + 32 * wid + 16 * q + 4 * g) * 2) = (u32x2){cvtpk(ca[0], ca[1]), cvtpk(ca[2], ca[3])};
            }
          }
        }
        __syncthreads();
      }
#pragma unroll
      for (int c = 0; c < 16; ++c) {
        const u32x4 cr = *(LAS const u32x4*)(lds + row * 2048 + (part * 128 + c * 8) * 2);
#pragma unroll
        for (int e = 0; e < 4; ++e)
          ov[c][e] = cvtpk(__uint_as_float(ov[c][e] << 16) + __uint_as_float(cr[e] << 16), __uint_as_float(ov[c][e] & 0xffff0000u) + __uint_as_float(cr[e] & 0xffff0000u));
      }
      __syncthreads();
    }
    float ss = 0.f;
#pragma unroll
    for (int c = 0; c < 16; ++c)
#pragma unroll
      for (int e = 0; e < 4; ++e) { const float lo = __uint_as_float(ov[c][e] << 16), hi = __uint_as_float(ov[c][e] & 0xffff0000u); ss += lo * lo + hi * hi; }
    ss = xsum<1>(ss);
    const float rinv = 1.f / sqrtf(ss * (1.f / 256.f) + LN_EPS);
#pragma unroll
    for (int c = 0; c < 16; ++c) {
      asm volatile("" ::: "memory");
      const int col = part * 128 + c * 8;
      const u32x4 zv = *(const u32x4*)(H1 + (size_t)row * P1 + col);
      const f32x4 g0 = *(const f32x4*)(gn + col), g1 = *(const f32x4*)(gn + col + 4);
      const float gg[8] = {g0[0], g0[1], g0[2], g0[3], g1[0], g1[1], g1[2], g1[3]};
      u32x4 w;
#pragma unroll
      for (int e = 0; e < 4; ++e) {
        const float o0 = __uint_as_float(ov[c][e] << 16), o1 = __uint_as_float(ov[c][e] & 0xffff0000u);
        const float z0 = __uint_as_float(zv[e] << 16), z1 = __uint_as_float(zv[e] & 0xffff0000u);
        w[e] = cvtpk(o0 * rinv * gg[2 * e] * silu_f(z0), o1 * rinv * gg[2 * e + 1] * silu_f(z1));
      }
      *(LAS u32x4*)(lds + row * 2048 + ((((part * 16 + c)) ^ (row & 15)) << 4)) = w;
    }
  }
  __syncthreads();
  f32x4 acc[4][8];
#pragma unroll
  for (int m = 0; m < 4; ++m)
#pragma unroll
    for (int nt = 0; nt < 8; ++nt) acc[m][nt] = (f32x4){0.f, 0.f, 0.f, 0.f};
  const bf16_t* wp = Wf + ((size_t)(wid * 8) * 32 * 64 + lane) * 8;
  bf16x8 wf[2][8];
#pragma unroll
  for (int nt = 0; nt < 8; ++nt) wf[0][nt] = *(const bf16x8*)(wp + (size_t)(nt * 32) * 512);
#pragma unroll 1
  for (int ks = 0; ks < 32; ks += 2) {
#pragma unroll
    for (int hf = 0; hf < 2; ++hf) {
      const int kc = ks + hf;
      if (kc + 1 < 32) {
#pragma unroll
        for (int nt = 0; nt < 8; ++nt) wf[hf ^ 1][nt] = *(const bf16x8*)(wp + (size_t)(nt * 32 + kc + 1) * 512);
      }
      bf16x8 xf[4];
#pragma unroll
      for (int m = 0; m < 4; ++m) xf[m] = *(LAS const bf16x8*)(lds + (16 * m + i) * 2048 + (((4 * kc + g) ^ i) << 4));
#pragma unroll
      for (int m = 0; m < 4; ++m)
#pragma unroll
        for (int nt = 0; nt < 8; ++nt) acc[m][nt] = __builtin_amdgcn_mfma_f32_16x16x32_bf16(wf[hf][nt], xf[m], acc[m][nt], 0, 0, 0);
    }
  }
  LAS float* red = (LAS float*)(lds + RG_RED);
  {
  const int tid = otid(), lane = tid & 63, wid = __builtin_amdgcn_readfirstlane(tid >> 6), g = lane >> 4, i = lane & 15; (void)lane;
#pragma unroll
  for (int m = 0; m < 4; ++m) {
    const float* bp = base + (r0 + 16 * m + i) * D_ + wid * 128 + 4 * g;
    f32x4 bv[8];
#pragma unroll
    for (int nt = 0; nt < 8; ++nt) bv[nt] = *(const f32x4*)(bp + 16 * nt);
    float s1 = 0.f, s2 = 0.f;
#pragma unroll
    for (int nt = 0; nt < 8; ++nt) { const f32x4 v = acc[m][nt] + bv[nt] * ALPHA; acc[m][nt] = v; s1 += (v[0] + v[1]) + (v[2] + v[3]); s2 += (v[0] * v[0] + v[1] * v[1]) + (v[2] * v[2] + v[3] * v[3]); }
    s1 = xsum<16>(s1); s1 = xsum<32>(s1); s2 = xsum<16>(s2); s2 = xsum<32>(s2);
    if (g == 0) { red[((16 * m + i) * 8 + wid) * 2] = s1; red[((16 * m + i) * 8 + wid) * 2 + 1] = s2; }
  }
  __syncthreads();
#pragma unroll 1
  for (int m = 0; m < 4; ++m) {
    float s1 = 0.f, s2 = 0.f;
#pragma unroll
    for (int w2 = 0; w2 < 8; ++w2) { s1 += red[((16 * m + i) * 8 + w2) * 2]; s2 += red[((16 * m + i) * 8 + w2) * 2 + 1]; }
    const float mean = s1 * (1.f / D_);
    const float var = fmaxf(s2 * (1.f / D_) - mean * mean, 0.f);
    const float rstd = 1.f / sqrtf(var + LN_EPS);
    const size_t off = (r0 + 16 * m + i) * D_ + wid * 128 + 4 * g;
#pragma unroll
    for (int nt = 0; nt < 8; ++nt) {
      const f32x4 gvv = *(const f32x4*)(gam + wid * 128 + 16 * nt + 4 * g), tvv = *(const f32x4*)(bet + wid * 128 + 16 * nt + 4 * g);
      const f32x4 av = m == 0 ? acc[0][nt] : (m == 1 ? acc[1][nt] : (m == 2 ? acc[2][nt] : acc[3][nt]));
      const f32x4 o = (av - mean) * rstd * gvv + tvv;
      *(f32x4*)(out + off + 16 * nt) = o;
      u32x2 w; w[0] = cvtpk(o[0], o[1]); w[1] = cvtpk(o[2], o[3]);
      if (outb) *(u32x2*)(outb + off + 16 * nt) = w;
      if (GLR) { const int row = 16 * m + i, chunk = 16 * wid + 2 * nt + (g >> 1);
        *(LAS u32x2*)(lds + row * 2048 + ((chunk ^ (row & 15)) << 4) + (g & 1) * 8) = w; }
    }
  }
  if (GLR) {
    __syncthreads();
    const bf16_t* wg = (const bf16_t*)(P.ws + WS_WT1) + (size_t)(3072 + i) * D_ + 8 * g;
    const int mt = wid & 3, kh = wid >> 2;
    f32x4 a2 = (f32x4){0.f, 0.f, 0.f, 0.f};
#pragma unroll 4
    for (int q = 0; q < 16; ++q) {
      const int kc = kh * 16 + q;
      const bf16x8 wfr = *(const bf16x8*)(wg + 32 * kc);
      const bf16x8 xfr = *(LAS const bf16x8*)(lds + (16 * mt + i) * 2048 + (((4 * kc + g) ^ i) << 4));
      a2 = __builtin_amdgcn_mfma_f32_16x16x32_bf16(wfr, xfr, a2, 0, 0, 0);
    }
    LAS f32x4* r2 = (LAS f32x4*)(lds + RG_RED + 4096);
    if (kh == 1) r2[mt * 64 + lane] = a2;
    __syncthreads();
    if (kh == 0) {
      const f32x4 tot = a2 + r2[mt * 64 + lane];
      *(f32x4*)((float*)(P.ws + WS_GLR) + (r0 + 16 * mt + i) * 16 + 4 * g) = tot;
    }
  }
  }
  __syncthreads();
}

#define XB_TMO      128
#define XB_XCNT(j)  (256  + 64 * (j))
#define XB_XSUB(j)  (1280 + 64 * (j))
#define XB_XGEN(j)  (2304 + 64 * (j))
#define XB_TOP      3328
#define XB_TOPGEN   3392
#define XCD_BAR_WORDS 3456
#define XB_SPIN_CAP (1u << 18)

__device__ __forceinline__ unsigned xb_ld(unsigned* p)              { return __hip_atomic_load(p, __ATOMIC_RELAXED, __HIP_MEMORY_SCOPE_AGENT); }
__device__ __forceinline__ unsigned xb_add(unsigned* p, unsigned v) { return __hip_atomic_fetch_add(p, v, __ATOMIC_RELAXED, __HIP_MEMORY_SCOPE_AGENT); }
__device__ __forceinline__ unsigned xb_xcc_id() { return (unsigned)__builtin_amdgcn_s_getreg((3 << 11) | 20) & 0xFu; }
#define XB_SPIN(cond, bar) do { unsigned _sp = 0; while (cond) { __builtin_amdgcn_s_sleep(1); \
    if ((++_sp & 255u) == 0u) { if (xb_ld(&(bar)[XB_TMO])) break; if (_sp > XB_SPIN_CAP) { atomicAdd(&(bar)[XB_TMO], 1u); break; } } } } while (0)

struct XcdBarrier {
    unsigned* bar; unsigned x;
    volatile LAS unsigned* st;
};

__device__ __forceinline__ XcdBarrier xcd_barrier_post(unsigned* bar, volatile LAS unsigned* st) {
    XcdBarrier b; b.bar = bar; b.x = xb_xcc_id(); b.st = st;
    if (threadIdx.x == 0) (void)xb_add(&bar[XB_XCNT(b.x)], 1u);
    return b;
}
__device__ __forceinline__ void xcd_barrier_complete(unsigned* bar, unsigned x, unsigned& nloc, unsigned& nx) {
    const unsigned G = gridDim.x * gridDim.y * gridDim.z;
    unsigned sum, cnt, mine, sp = 0u;
    for (;;) {
        sum = 0u; cnt = 0u; mine = 0u;
#pragma unroll
        for (unsigned j = 0; j < 16; ++j) { const unsigned c = xb_ld(&bar[XB_XCNT(j)]); sum += c; cnt += (c > 0u) ? 1u : 0u; mine = (j == x) ? c : mine; }
        if (sum == G) break;
        __builtin_amdgcn_s_sleep(1);
        if ((++sp & 255u) == 0u) { if (xb_ld(&bar[XB_TMO])) break; if (sp > XB_SPIN_CAP) { atomicAdd(&bar[XB_TMO], 1u); break; } }
    }
    nloc = mine > 0u ? mine : 1u; nx = cnt > 0u ? cnt : 1u;
}

__device__ __forceinline__ void xcd_barrier(const XcdBarrier& b) {
    asm volatile("s_waitcnt vmcnt(0)" ::: "memory");
    __syncthreads();
    if (threadIdx.x == 0) {
        unsigned* bar = b.bar;
        __builtin_amdgcn_s_waitcnt(0);
        unsigned nloc = b.st[0], nx = b.st[1];
        if (nloc == 0u) { xcd_barrier_complete(bar, b.x, nloc, nx); b.st[0] = nloc; b.st[1] = nx; }
        const unsigned old = xb_add(&bar[XB_XSUB(b.x)], 1u);
        const unsigned gen = old / nloc;
        if (old + 1u == (gen + 1u) * nloc) {
            __builtin_amdgcn_fence(__ATOMIC_RELEASE, "agent");
            asm volatile("s_waitcnt vmcnt(0)" ::: "memory");
            const unsigned og = xb_add(&bar[XB_TOP], 1u);
            const unsigned tg = og / nx;
            if (og + 1u == (tg + 1u) * nx) xb_add(&bar[XB_TOPGEN], 1u);
            else XB_SPIN(xb_ld(&bar[XB_TOPGEN]) == tg, bar);
            __builtin_amdgcn_fence(__ATOMIC_ACQUIRE, "agent");
            xb_add(&bar[XB_XGEN(b.x)], 1u);
            asm volatile("s_waitcnt vmcnt(0)" ::: "memory");
        } else {
            XB_SPIN(xb_ld(&bar[XB_XGEN(b.x)]) == gen, bar);
            __builtin_amdgcn_fence(__ATOMIC_ACQUIRE, "agent");
            asm volatile("s_waitcnt vmcnt(0)" ::: "memory");
        }
    }
    __syncthreads();
}


__device__ const unsigned short p3_order[1024] = {638,636,634,632,630,628,626,624,15,143,271,399,622,14,142,270,398,620,618,13,141,269,397,616,614,12,140,268,396,612,610,11,139,267,395,608,606,10,138,266,394,604,602,9,137,265,393,560,562,564,566,568,570,572,574,544,546,548,550,552,554,556,558,600,536,538,540,542,534,598,8,136,264,392,532,596,530,594,7,135,263,391,528,592,6,134,262,390,526,590,524,588,5,133,261,389,522,586,520,584,4,132,260,388,518,582,3,131,259,387,516,580,2,130,258,386,514,578,1,129,257,385,512,576,0,128,256,384,639,637,635,633,631,629,627,625,31,159,287,415,623,621,30,158,286,414,619,617,29,157,285,413,615,613,28,156,284,412,611,609,27,155,283,411,607,26,154,282,410,605,603,25,153,281,409,561,563,565,567,569,571,573,575,601,545,547,549,551,553,555,557,559,535,537,539,541,543,599,24,152,280,408,533,597,531,595,23,151,279,407,529,593,527,591,22,150,278,406,525,589,523,587,21,149,277,405,521,585,20,148,276,404,519,583,19,147,275,403,517,581,18,146,274,402,515,579,17,145,273,401,513,577,16,144,272,400,766,764,762,760,758,756,754,752,47,175,303,431,750,46,174,302,430,748,746,45,173,301,429,744,742,44,172,300,428,740,738,43,171,299,427,736,734,42,170,298,426,732,730,41,169,297,425,688,690,692,694,696,698,700,702,672,674,676,678,680,682,684,686,728,664,666,668,670,662,726,40,168,296,424,660,724,658,722,39,167,295,423,656,720,38,166,294,422,654,718,652,716,37,165,293,421,650,714,648,712,36,164,292,420,646,710,35,163,291,419,644,708,34,162,290,418,642,706,33,161,289,417,640,704,32,160,288,416,767,765,763,761,759,757,755,753,63,191,319,447,751,749,62,190,318,446,747,745,61,189,317,445,743,741,60,188,316,444,739,737,59,187,315,443,735,58,186,314,442,733,731,57,185,313,441,689,691,693,695,697,699,701,703,729,673,675,677,679,681,683,685,687,663,665,667,669,671,727,56,184,312,440,661,725,659,723,55,183,311,439,657,721,655,719,54,182,310,438,653,717,651,715,53,181,309,437,649,713,52,180,308,436,647,711,51,179,307,435,645,709,50,178,306,434,643,707,49,177,305,433,641,705,48,176,304,432,894,892,890,888,886,884,882,880,79,207,335,463,878,78,206,334,462,876,874,77,205,333,461,872,870,76,204,332,460,868,866,75,203,331,459,864,862,74,202,330,458,860,858,73,201,329,457,816,818,820,822,824,826,828,830,800,802,804,806,808,810,812,814,856,792,794,796,798,790,854,72,200,328,456,788,852,786,850,71,199,327,455,784,848,70,198,326,454,782,846,780,844,69,197,325,453,778,842,776,840,68,196,324,452,774,838,67,195,323,451,772,836,66,194,322,450,770,834,65,193,321,449,768,832,64,192,320,448,895,893,891,889,887,885,883,881,95,223,351,479,879,877,94,222,350,478,875,873,93,221,349,477,871,869,92,220,348,476,867,865,91,219,347,475,863,90,218,346,474,861,859,89,217,345,473,817,819,821,823,825,827,829,831,857,801,803,805,807,809,811,813,815,791,793,795,797,799,855,88,216,344,472,789,853,787,851,87,215,343,471,785,849,783,847,86,214,342,470,781,845,779,843,85,213,341,469,777,841,84,212,340,468,775,839,83,211,339,467,773,837,82,210,338,466,771,835,81,209,337,465,769,833,80,208,336,464,1022,1020,1018,1016,1014,1012,1010,1008,111,239,367,495,1006,110,238,366,494,1004,1002,109,237,365,493,1000,998,108,236,364,492,996,994,107,235,363,491,992,990,106,234,362,490,988,986,105,233,361,489,944,946,948,950,952,954,956,958,928,930,932,934,936,938,940,942,984,920,922,924,926,918,982,104,232,360,488,916,980,914,978,103,231,359,487,912,976,102,230,358,486,910,974,908,972,101,229,357,485,906,970,904,968,100,228,356,484,902,966,99,227,355,483,900,964,98,226,354,482,898,962,97,225,353,481,896,960,96,224,352,480,1023,1021,1019,1017,1015,1013,1011,1009,127,255,383,511,1007,1005,126,254,382,510,1003,1001,125,253,381,509,999,997,124,252,380,508,995,993,123,251,379,507,991,122,250,378,506,989,987,121,249,377,505,945,947,949,951,953,955,957,959,985,929,931,933,935,937,939,941,943,919,921,923,925,927,983,120,248,376,504,917,981,915,979,119,247,375,503,913,977,911,975,118,246,374,502,909,973,907,971,117,245,373,501,905,969,116,244,372,500,903,967,115,243,371,499,901,965,114,242,370,498,899,963,113,241,369,497,897,961,112,240,368,496};
constexpr int CTL_P3_QUEUE = 8192;
constexpr int CTL_LN0 = 4096, CTL_LN1 = 9216, CTL_TMO = 3520;
constexpr size_t WS_XCH0 = 253 * MiB, WS_XCH1 = 254 * MiB;

#ifndef REP_P0
#define REP_P0 1
#endif
#ifndef REP_P2
#define REP_P2 1
#endif
#ifndef REP_P3
#define REP_P3 1
#endif
#ifndef REP_P7
#define REP_P7 1
#endif
#ifndef REP_P8
#define REP_P8 1
#endif
__global__ void __launch_bounds__(512) fwd_megakernel(Params P) {
  cg::grid_group grid = cg::this_grid();
  extern __shared__ __attribute__((aligned(16))) unsigned char smem[];
  const int tid = otid(), lane = tid & 63, wid = tid >> 6;
  unsigned char* ws = P.ws;
  bf16_t* XB = (bf16_t*)(ws + WS_XB);
  bf16_t* MIX = (bf16_t*)(ws + WS_MIX);
  bf16_t* Hb = (bf16_t*)(ws + WS_H);
  float* Y = (float*)(ws + WS_H);
  volatile LAS unsigned* xst = (volatile LAS unsigned*)((LAS unsigned char*)smem + XB_LDS_OFF);
  if (tid < 4) xst[tid] = 0u;
  __syncthreads();
  (void)xcd_barrier_post((unsigned*)ws, xst);
#define GRID_BAR() do { XcdBarrier xb_; xb_.bar = (unsigned*)P.ws; xb_.x = xb_xcc_id(); xb_.st = (volatile LAS unsigned*)((LAS unsigned char*)smem + XB_LDS_OFF); xcd_barrier(xb_); } while (0)

  for (int rep = 0; rep < REP_P0; ++rep) {
    const float4* x4 = (const float4*)P.in[0];
    const size_t n4 = (size_t)M_ * D_ / 4;
    {
      const size_t stride = (size_t)gridDim.x * 512;
      for (size_t i = (size_t)blockIdx.x * 512 + tid; i < n4; i += 8 * stride) {
        float4 v[8];
#pragma unroll
        for (int u = 0; u < 8; ++u) if (i + u * stride < n4) v[u] = x4[i + u * stride];
#pragma unroll
        for (int u = 0; u < 8; ++u) if (i + u * stride < n4) { ushort4 o; o.x = f2bf(v[u].x); o.y = f2bf(v[u].y); o.z = f2bf(v[u].z); o.w = f2bf(v[u].w); ((ushort4*)XB)[i + u * stride] = o; }
      }
    }
    {
      constexpr int T0 = (P0 / 32) * 16, T1 = 32 * 16, T2 = (P1 / 32) * 16, T3 = 32 * 16, T4 = 2 * 4 * 32, T5 = 2 * 2 * 2;
      float* scr = (float*)smem + wid * (64 * 33);
      for (int it = blockIdx.x * 8 + wid; it < T0 + T1 + T2 + T3 + T4 + T5; it += gridDim.x * 8) {
        int r = it;
        if (r < T0) { transpose_wave_tile(P.in[1], D_, EVEN_IN, (bf16_t*)(ws + WS_WT0), 0, r, P0 / 32, scr, lane); continue; } r -= T0;
        if (r < T1) { transpose_wave_tile(P.in[6], D_, D_, (bf16_t*)(ws + WS_WO0), 3, r, 32, scr, lane); continue; } r -= T1;
        if (r < T2) { transpose_wave_tile(P.in[9], D_, ODD_IN, (bf16_t*)(ws + WS_WT1), 1, r, P1 / 32, scr, lane); continue; } r -= T2;
        if (r < T3) { transpose_wave_tile(P.in[13], D_, D_, (bf16_t*)(ws + WS_WO1), 3, r, 32, scr, lane); continue; } r -= T3;
        if (r < T4) { const int i = r >> 7; transpose_wave_tile(P.in[3] + (size_t)i * 2048 * 128, 2048, 128, (bf16_t*)(ws + WS_W1T) + (size_t)i * 128 * 2048, 2, r & 127, 4, scr, lane); continue; } r -= T4;
        { const int i = r >> 2; transpose_wave_tile(P.in[5] + (size_t)i * 128 * 64, 128, 64, (bf16_t*)(ws + WS_W2T) + (size_t)i * 64 * 128, 2, r & 3, 2, scr, lane); }
      }
      __syncthreads();
    }
    for (int it = blockIdx.x + 132; it < 2 * 64 + 2 * 2 + 64; it += gridDim.x) {
      {
        const int t2 = it - 132, i = t2 >> 5, q = t2 & 31, hh = tid & 127, sub = tid >> 7;
        const float* pos = P.in[2] + i * 2048 + q * 64 + sub * 16;
        const float* w1 = P.in[3] + ((size_t)i * 2048 + q * 64 + sub * 16) * 128 + hh;
        float a = 0.f;
#pragma unroll
        for (int f = 0; f < 16; ++f) a += pos[f] * w1[f * 128];
        float* red = (float*)smem;
        red[sub * 128 + hh] = a;
        __syncthreads();
        if (tid < 128) ((float*)(ws + WS_C1P))[(i * 32 + q) * 128 + tid] = (red[tid] + red[128 + tid]) + (red[256 + tid] + red[384 + tid]);
        __syncthreads();
      }
    }
    for (int q = blockIdx.x * 512 + tid; q < B_ * 16 * 512; q += gridDim.x * 512) ((float*)(ws + WS_KM))[q] = 0.f;
    if (blockIdx.x == 0) { const int which = tid >> 8, r = tid & 255;
      unsigned* z = (unsigned*)(ws + (which == 0 ? (size_t)(248 * MiB) : (size_t)(249 * MiB)));
      const int bg = r >> 5, wd = r & 31; z[((size_t)bg * 256 + 255) * 32 + wd] = 0u; }
    GRID_BAR();
  }
  if (P.out == nullptr) grid.sync();
  { pg8::Gemm gm{XB, (const bf16_t*)(ws + WS_WT0), M_, P0, D_}; pg8::StaticOrder so; so.init(M_, P0, (int)gridDim.x, (int)blockIdx.x);
    pg8::EpiBf16s ep{Hb, P0, (float*)(ws + WS_KM), C_MK / 256}; pg8::gemm_phase<pg8::EpiBf16s, pg8::StaticOrder, true, true>((LAS unsigned char*)smem, gm, so, ep); }
  GRID_BAR();
  for (int rep = 0; rep < REP_P2; ++rep) {
    for (int it = blockIdx.x; it < 256; it += gridDim.x) compress_mfma_tile(P, it, smem);
    GRID_BAR();
  }
  for (int rep = 0; rep < REP_P3; ++rep) {
    const int myx = (int)(xb_xcc_id() & 7u);
    int steal = 0;
    for (;;) {
      LAS int* qslot = (LAS int*)((LAS unsigned char*)smem + AT_MISC + 384);
      const int qx = (myx + steal) & 7;
      if (tid == 0) *qslot = (int)atomicAdd((unsigned*)P.ws + CTL_P3_QUEUE + 64 * qx, 1u) - rep * 128;
      __syncthreads();
      int it = __builtin_amdgcn_readfirstlane(*qslot);
      __syncthreads();
      if (it >= 128) { if (++steal == 8) break; continue; }
      it += qx * 128;
      const int e = p3_order[it], pl = e & 511;
      if (e >> 9) nsa_mfma_item(P, pl >> 7, (pl >> 6) & 1, pl & 63, smem);
      else moba_mfma_item(P, pl >> 7, (pl >> 4) & 7, pl & 15, smem);
    }
    GRID_BAR();
  }
  if ((int)blockIdx.x < M_ / 64) rowgemm_block<0, true>(P, (int)blockIdx.x, (const bf16_t*)(ws + WS_WO0), P.in[0], P.out, XB, P.in[7], P.in[8], smem);
  GRID_BAR();
  { pg8::Gemm gm{XB, (const bf16_t*)(ws + WS_WT1), M_, 3072, D_}; pg8::StaticOrder so; so.init(M_, 3072, (int)gridDim.x, (int)blockIdx.x);
    pg8::EpiBf16s ep{Hb, P1, nullptr, 0}; pg8::gemm_phase<pg8::EpiBf16s, pg8::StaticOrder, true, true>((LAS unsigned char*)smem, gm, so, ep); }
  GRID_BAR();
  for (int rep = 0; rep < REP_P8; ++rep) {
    { const int j = (int)blockIdx.x; if (j < 256) gla_prep_item(P, (j & 15) * 64 + ((j >> 4) & 1) * 32 + (j >> 5), smem); }
    if ((int)blockIdx.x < 128) { const int w = (int)blockIdx.x, u = w >> 3, bh = (w & 7) + 8 * (u >> 3), eq = u & 3, seg = (u >> 2) & 1;
      gla_chain64(P, bh * 4 + eq, seg, smem); }
    else for (int j = 256 + (int)blockIdx.x - 128; j < 1024; j += 128) gla_prep_item(P, (j & 15) * 64 + ((j >> 4) & 1) * 32 + (j >> 5), smem);
    GRID_BAR();
  }
  if ((int)blockIdx.x < M_ / 64) rowgemm_block<1, false>(P, (int)blockIdx.x, (const bf16_t*)(ws + WS_WO1), P.out, P.out, nullptr, P.in[14], P.in[15], smem);
}

extern "C" void kernel_launch(void* const* d_in, const int* in_sizes, int n_in, void* d_out, int out_size,
                              void* d_ws, size_t ws_size, hipStream_t stream) {
  constexpr size_t kDynLds = 157696;
  static_assert((size_t)XB_LDS_OFF >= (size_t)G4_END && kDynLds <= 163840 && kDynLds >= (size_t)XB_LDS_OFF + 16 && (size_t)XB_LDS_OFF >= (size_t)AT_LDS_END && kDynLds >= (size_t)AT_LDS_END && kDynLds >= 2 * (size_t)GS_BYTES && kDynLds >= (size_t)pg8::STAGE_BYTES, "LDS");
  static int grid_blocks = 0;
  if (!grid_blocks) {
    int dev = 0, cus = 0, per_cu = 0;
    (void)hipGetDevice(&dev);
    (void)hipDeviceGetAttribute(&cus, hipDeviceAttributeMultiprocessorCount, dev);
    (void)hipFuncSetAttribute((const void*)fwd_megakernel, hipFuncAttributeMaxDynamicSharedMemorySize, (int)kDynLds);
    (void)hipOccupancyMaxActiveBlocksPerMultiprocessor(&per_cu, fwd_megakernel, 512, kDynLds);
    if (per_cu < 1) per_cu = 1;
    if (per_cu > 2) per_cu = 2;
    grid_blocks = cus * per_cu;
    if (grid_blocks != 256) { fprintf(stderr, "kernel_launch: this kernel is laid out for exactly 256 co-resident workgroups (256 CUs x 1); got %d x %d\n", cus, per_cu); grid_blocks = 256; }
    if (n_in != 16 || ws_size < WS_END) { fprintf(stderr, "kernel_launch: unexpected n_in %d / ws %zu\n", n_in, ws_size); }
  }
  (void)hipMemsetAsync(d_ws, 0, 524288, stream);
  Params p{};
  for (int i = 0; i < 16; ++i) p.in[i] = (const float*)d_in[i];
  p.out = (float*)d_out; p.ws = (unsigned char*)d_ws;
  void* args[] = {&p};
  hipError_t e = hipLaunchCooperativeKernel((void*)fwd_megakernel, dim3(grid_blocks), dim3(512), args, kDynLds, stream);
  if (e != hipSuccess) fprintf(stderr, "cooperative launch failed: %s (grid %d)\n", hipGetErrorString(e), grid_blocks);
}
```

```cpp
#include <hip/hip_runtime.h>
#include <hip/hip_cooperative_groups.h>
#include <cstdio>
#include <cstdint>
namespace cg = cooperative_groups;

typedef unsigned short bf16_t;
typedef short bf16x8 __attribute__((ext_vector_type(8)));
typedef float f32x4 __attribute__((ext_vector_type(4)));
typedef unsigned u32x4 __attribute__((ext_vector_type(4)));
typedef unsigned u32x2 __attribute__((ext_vector_type(2)));

constexpr int B_ = 4, S_ = 4096, M_ = B_ * S_, D_ = 1024;
constexpr int P0 = 4096;
constexpr int P1 = 3328;
constexpr int EVEN_IN = 3864, ODD_IN = 3088;
constexpr int C_NQ = 0, C_KCMP = 512, C_VCMP = 640, C_KSEL = 768, C_VSEL = 896, C_KWIN = 1024, C_VWIN = 1152;
constexpr int C_NZ = 1280, C_MQ = 1792, C_MK = 2304, C_MV = 2816, C_MZ = 3328, C_NG = 3840;
constexpr int G_Q = 0, G_K = 512, G_V = 1024, G_Z = 2048, G_LR = 3072;
constexpr int NCMP = 255;
constexpr float ALPHA = 1.4142135623730951f;
constexpr float LN_EPS = 1e-5f;

constexpr size_t MiB = 1u << 20;
constexpr int XB_LDS_OFF = 157440;
constexpr size_t WS_WT0 = 1 * MiB;
constexpr size_t WS_WO0 = 9 * MiB;
constexpr size_t WS_WT1 = 11 * MiB;
constexpr size_t WS_WO1 = 18 * MiB;
constexpr size_t WS_XB = 20 * MiB;
constexpr size_t WS_MIX = 52 * MiB;
constexpr size_t WS_H = 84 * MiB;
constexpr size_t WS_G = 212 * MiB;
constexpr size_t WS_GLR = 245 * MiB;
constexpr size_t WS_SMT = 246 * MiB;
constexpr size_t WS_KC = 245 * MiB;
constexpr size_t WS_VC = 246 * MiB;
constexpr size_t WS_KM = 247 * MiB;
constexpr size_t WS_END = 256 * MiB;

struct Params { const float* in[16]; float* out; unsigned char* ws; };

__device__ __forceinline__ int otid() { int t = __builtin_amdgcn_workitem_id_x(); asm volatile("" : "+v"(t)); return t; }
__device__ __forceinline__ float bf2f(bf16_t v) { return __uint_as_float(((unsigned)v) << 16); }
__device__ __forceinline__ bf16_t f2bf(float f) { unsigned u = __float_as_uint(f); return (bf16_t)((u + 0x7fffu + ((u >> 16) & 1u)) >> 16); }
template <int M> __device__ __forceinline__ float xsum(float v) {
  if constexpr (M == 32) { auto rr = __builtin_amdgcn_permlane32_swap(__float_as_uint(v), __float_as_uint(v), false, false); return __uint_as_float(rr[0]) + __uint_as_float(rr[1]); }
  else return v + __int_as_float(__builtin_amdgcn_ds_swizzle(__float_as_int(v), (M << 10) | 0x1f));
}
template <int M> __device__ __forceinline__ float xmax(float v) {
  if constexpr (M == 32) { auto rr = __builtin_amdgcn_permlane32_swap(__float_as_uint(v), __float_as_uint(v), false, false); return fmaxf(__uint_as_float(rr[0]), __uint_as_float(rr[1])); }
  else return fmaxf(v, __int_as_float(__builtin_amdgcn_ds_swizzle(__float_as_int(v), (M << 10) | 0x1f)));
}
template <int M> __device__ __forceinline__ unsigned xorr(unsigned v) {
  if constexpr (M == 32) { auto rr = __builtin_amdgcn_permlane32_swap(v, v, false, false); return rr[0] | rr[1]; }
  else return v | (unsigned)__builtin_amdgcn_ds_swizzle((int)v, (M << 10) | 0x1f);
}
__device__ __forceinline__ float wave_sum(float v) { v = xsum<1>(v); v = xsum<2>(v); v = xsum<4>(v); v = xsum<8>(v); v = xsum<16>(v); return xsum<32>(v); }
__device__ __forceinline__ float wave_max(float v) { v = xmax<1>(v); v = xmax<2>(v); v = xmax<4>(v); v = xmax<8>(v); v = xmax<16>(v); return xmax<32>(v); }
__device__ __forceinline__ float silu_f(float z) { return z / (1.f + __expf(-z)); }
__device__ __forceinline__ float sigmoid_f(float z) { return 1.f / (1.f + __expf(-z)); }

__device__ __forceinline__ int colmap0(int c) {
  if (c < 1280) return c;
  if (c < 1792) return 1304 + (c - 1280);
  if (c < 3840) return 1816 + (c - 1792);
  if (c < 3864) return 1280 + (c - 3840);
  return -1;
}
__device__ __forceinline__ int colmap1(int c) {
  if (c < 2048) return c;
  if (c < 3072) return 2064 + (c - 2048);
  if (c < 3088) return 2048 + (c - 3072);
  return -1;
}

__device__ __forceinline__ void transpose_tile(const float* __restrict__ W, int K, int Nsrc, bf16_t* __restrict__ Wt, int which, int tile, int ntn, float* sm) {
  const int tid = otid();
  const int nb = tile % ntn, kb = tile / ntn, n0 = nb * 64, k0 = kb * 64;
#pragma unroll
  for (int i = 0; i < 8; ++i) {
    const int kk = i * 8 + (tid >> 6), nn = tid & 63;
    const int c = n0 + nn;
    const int src = which == 0 ? colmap0(c) : (which == 1 ? colmap1(c) : c);
    sm[kk * 65 + nn] = src >= 0 ? W[(size_t)(k0 + kk) * Nsrc + src] : 0.f;
  }
  __syncthreads();
#pragma unroll
  for (int i = 0; i < 8; ++i) {
    const int nn = i * 8 + (tid >> 6), kk = tid & 63;
    Wt[(size_t)(n0 + nn) * K + k0 + kk] = f2bf(sm[kk * 65 + nn]);
  }
  __syncthreads();
}


__device__ __forceinline__ void transpose_wave_tile(const float* __restrict__ W, int K, int Nsrc, bf16_t* __restrict__ Wt, int which, int tile, int ntn, float* scr, int lane) {
  const int nb = tile % ntn, kb = tile / ntn, n0 = nb * 32, k0 = kb * 64;
  const int c = n0 + (lane & 31);
  const int src = which == 0 ? colmap0(c) : (which == 1 ? colmap1(c) : c);
  float v[32];
#pragma unroll
  for (int q = 0; q < 32; ++q) { const int kk = 2 * q + (lane >> 5); v[q] = src >= 0 ? W[(size_t)(k0 + kk) * Nsrc + src] : 0.f; }
#pragma unroll
  for (int q = 0; q < 32; ++q) { const int kk = 2 * q + (lane >> 5); scr[kk * 33 + (lane & 31)] = v[q]; }
  __builtin_amdgcn_wave_barrier();
  if (which == 3) {
    const int k = k0 + lane;
#pragma unroll 8
    for (int nn = 0; nn < 32; ++nn) { const int n = n0 + nn; Wt[((size_t)(((n >> 4) * 32 + (k >> 5)) * 64 + ((k >> 3) & 3) * 16 + (n & 15))) * 8 + (k & 7)] = f2bf(scr[lane * 33 + nn]); }
  } else {
#pragma unroll 8
    for (int nn = 0; nn < 32; ++nn) Wt[(size_t)(n0 + nn) * K + k0 + lane] = f2bf(scr[lane * 33 + nn]);
  }
  __builtin_amdgcn_wave_barrier();
}

__device__ __forceinline__ void gemm_tile(const bf16_t* __restrict__ A, const bf16_t* __restrict__ Bt, int K, int m0, int n0, int mode, void* outp, int ldc, unsigned char* smem) {
  bf16_t* As = (bf16_t*)smem;
  bf16_t* Bs = As + 128 * 72;
  const int tid = otid(), lane = tid & 63, wid = tid >> 6, wm = wid >> 1, wn = wid & 1;
  f32x4 acc[2][4];
#pragma unroll
  for (int i = 0; i < 2; ++i)
#pragma unroll
    for (int j = 0; j < 4; ++j) acc[i][j] = (f32x4){0.f, 0.f, 0.f, 0.f};
  for (int k0 = 0; k0 < K; k0 += 64) {
#pragma unroll
    for (int i = 0; i < 2; ++i) {
      const int idx = tid + i * 512, r = idx >> 3, c = (idx & 7) * 8;
      *(uint4*)(As + r * 72 + c) = *(const uint4*)(A + (size_t)(m0 + r) * K + k0 + c);
      *(uint4*)(Bs + r * 72 + c) = *(const uint4*)(Bt + (size_t)(n0 + r) * K + k0 + c);
    }
    __syncthreads();
#pragma unroll
    for (int kk = 0; kk < 64; kk += 32) {
      bf16x8 a[2], b[4];
#pragma unroll
      for (int i = 0; i < 2; ++i) a[i] = *(const bf16x8*)(As + (wm * 32 + i * 16 + (lane & 15)) * 72 + kk + (lane >> 4) * 8);
#pragma unroll
      for (int j = 0; j < 4; ++j) b[j] = *(const bf16x8*)(Bs + (wn * 64 + j * 16 + (lane & 15)) * 72 + kk + (lane >> 4) * 8);
#pragma unroll
      for (int i = 0; i < 2; ++i)
#pragma unroll
        for (int j = 0; j < 4; ++j) acc[i][j] = __builtin_amdgcn_mfma_f32_16x16x32_bf16(a[i], b[j], acc[i][j], 0, 0, 0);
    }
    __syncthreads();
  }
#pragma unroll
  for (int i = 0; i < 2; ++i)
#pragma unroll
    for (int j = 0; j < 4; ++j)
#pragma unroll
      for (int r = 0; r < 4; ++r) {
        const int row = m0 + wm * 32 + i * 16 + (lane >> 4) * 4 + r, col = n0 + wn * 64 + j * 16 + (lane & 15);
        if (mode == 0) ((bf16_t*)outp)[(size_t)row * ldc + col] = f2bf(acc[i][j][r]);
        else ((float*)outp)[(size_t)row * ldc + col] = acc[i][j][r];
      }
}
__device__ __forceinline__ void gemm_phase(const bf16_t* A, const bf16_t* Bt, int K, int N, int mode, void* outp, int ldc, unsigned char* smem) {
  const int ntn = N / 128, ntm = M_ / 128;
  for (int t = blockIdx.x; t < ntn * ntm; t += gridDim.x) {
    const int tn = t % ntn, tm = t / ntn;
    gemm_tile(A, Bt, K, tm * 128, tn * 128, mode, outp, ldc, smem);
  }
}

namespace pg8 {
#define PG8_LAS __attribute__((address_space(3)))
typedef unsigned short bf16_t;
typedef short bf16x8 __attribute__((ext_vector_type(8)));
typedef float f32x4 __attribute__((ext_vector_type(4)));
typedef unsigned u32x4 __attribute__((ext_vector_type(4)));
constexpr int BM = 256, BK = 64, HALF = 128, HTB = HALF * BK * 2  , STAGE_BYTES = 8 * HTB, NXCD = 8, WGM = 8;

__host__ __device__ __forceinline__ int lds_byte(int r, int c) { const int st = (r >> 4) * 2 + (c >> 5), rr = r & 15, cc = c & 31, ob = rr * 64 + cc * 2; return st * 1024 + (ob ^ (((ob >> 9) & 1) << 5)); }
__host__ __device__ __forceinline__ void stage_rc(int b, int& R, int& C) { const int st = b / 1024, sb = b % 1024, swz = sb ^ (((sb >> 9) & 1) << 5); R = (st >> 1) * 16 + swz / 64; C = (st & 1) * 32 + (swz % 64) / 2; }
__host__ __device__ __forceinline__ int perm32(int rho) { const int n = rho >> 4, i = rho & 15; return 8 * (i >> 2) + 4 * n + (i & 3); }

__device__ __forceinline__ unsigned cvtpk(float lo, float hi) { typedef float f2 __attribute__((ext_vector_type(2))); typedef __bf16 b2 __attribute__((ext_vector_type(2))); f2 v = {lo, hi}; b2 b = __builtin_convertvector(v, b2); return __builtin_bit_cast(unsigned, b); }
template <int M> __device__ __forceinline__ float xsum_sw(float v) { return v + __int_as_float(__builtin_amdgcn_ds_swizzle(__float_as_int(v), (M << 10) | 0x1f)); }
struct Unit { int pm, pn; };
struct Gemm { const bf16_t* A; const bf16_t* Bt; int M, N, K; };

struct StaticOrder {
    int nM, nN, nwg, G, c;
    __host__ __device__ void init(int M, int N, int G_, int c_) { nM = M / BM; nN = N / BM; nwg = nM * nN; G = G_; c = c_; }
    __host__ __device__ bool next(int i, Unit& u) const {
        const long L = (long)i * G + c; if (L >= nwg) return false;
        int wgid = (int)L; { const int q = nwg / NXCD, r = nwg % NXCD, xcd = wgid % NXCD, off = wgid / NXCD; wgid = (xcd < r ? xcd * (q + 1) : r * (q + 1) + (xcd - r) * q) + off; }
        const int nig = WGM * nN, gid = wgid / nig, fm = gid * WGM, gsz = (nM - fm) < WGM ? (nM - fm) : WGM;
        u.pm = fm + ((wgid % nig) % gsz); u.pn = (wgid % nig) / gsz; return true;
    }
    __device__ __forceinline__ void a_ready(const Unit&) const {}
    __device__ __forceinline__ void done(const Unit&) const {}
};


struct EpiBf16s {
    static constexpr bool PERM = true, AFTER_DRAIN = false;
    bf16_t* O; int ldc;
    unsigned qmask; float qscale;
    float* km; int km_pn0;
    __device__ __forceinline__ void operator()(const f32x4 (&acc)[2][2][4][2], const Unit& u, int wr, int wc, int fr, int fq) const {
        const int row0 = u.pm * BM + wr * 64 + fr, col0 = u.pn * BM + wc * 32 + 8 * fq;
        const float sc = ((qmask >> u.pn) & 1u) ? qscale : 1.f;
#pragma unroll
        for (int ai = 0; ai < 2; ++ai)
#pragma unroll
            for (int m = 0; m < 4; ++m) { bf16_t* rowp = O + (size_t)(row0 + ai * HALF + m * 16) * ldc + col0;
#pragma unroll
                for (int bj = 0; bj < 2; ++bj) { const f32x4 v0 = acc[ai][bj][m][0] * sc, v1 = acc[ai][bj][m][1] * sc;
                    u32x4 w; w.x = cvtpk(v0[0], v0[1]); w.y = cvtpk(v0[2], v0[3]); w.z = cvtpk(v1[0], v1[1]); w.w = cvtpk(v1[2], v1[3]);
                    *(u32x4*)(rowp + bj * HALF) = w; } }
        if (km != nullptr && (u.pn == km_pn0 || u.pn == km_pn0 + 1)) {
#pragma unroll
            for (int bj = 0; bj < 2; ++bj)
#pragma unroll
                for (int n = 0; n < 2; ++n) {
                    f32x4 sacc = (f32x4){0.f, 0.f, 0.f, 0.f};
#pragma unroll
                    for (int ai = 0; ai < 2; ++ai)
#pragma unroll
                        for (int m = 0; m < 4; ++m) sacc += acc[ai][bj][m][n];
#pragma unroll
                    for (int e = 0; e < 4; ++e) { float v = sacc[e]; v = xsum_sw<1>(v); v = xsum_sw<2>(v); v = xsum_sw<4>(v); v = xsum_sw<8>(v); sacc[e] = v; }
                    if (fr == 0) { float* dst = km + (size_t)u.pm * 512 + (u.pn - km_pn0) * BM + bj * HALF + wc * 32 + 8 * fq + 4 * n;
#pragma unroll
                        for (int e = 0; e < 4; ++e) atomicAdd(dst + e, sacc[e] * (1.0f / 256.0f)); }
                }
        }
    }
};
struct EpiF32 {
    static constexpr bool PERM = false, AFTER_DRAIN = false;
    float* O; int ldc;
    __device__ __forceinline__ void operator()(const f32x4 (&acc)[2][2][4][2], const Unit& u, int wr, int wc, int fr, int fq) const {
        const int col0 = u.pn * BM + wc * 32 + 4 * fq;
#pragma unroll
        for (int ai = 0; ai < 2; ++ai)
#pragma unroll
            for (int m = 0; m < 4; ++m) { float* rowp = O + (size_t)(u.pm * BM + ai * HALF + wr * 64 + m * 16 + fr) * ldc + col0;
#pragma unroll
                for (int bj = 0; bj < 2; ++bj)
#pragma unroll
                    for (int n = 0; n < 2; ++n) *(f32x4*)(rowp + bj * HALF + n * 16) = acc[ai][bj][m][n]; }
    }
};

struct PanelStats {
    unsigned* xbuf;
    unsigned* cnt;
    unsigned* tmo;
    int ntn; float eps;
    unsigned code;
    __device__ __forceinline__ bool run(const f32x4 (&v)[2][2][4][2], const Unit& u, int wr, int wc, int fr, int fq, PG8_LAS unsigned char* lds, int wid, int lane) const {
        typedef float f32x2v __attribute__((ext_vector_type(2)));
        PG8_LAS f32x2v* P = (PG8_LAS f32x2v*)lds;
        PG8_LAS f32x2v* S = (PG8_LAS f32x2v*)(lds + 8192);
        PG8_LAS unsigned* flag = (PG8_LAS unsigned*)(lds + 8192 + 2048);
#pragma unroll
        for (int ai = 0; ai < 2; ++ai)
#pragma unroll
            for (int m = 0; m < 4; ++m) {
                float s = 0.f;
#pragma unroll
                for (int bj = 0; bj < 2; ++bj)
#pragma unroll
                    for (int n = 0; n < 2; ++n) { const f32x4 x = v[ai][bj][m][n]; s += (x[0] + x[1]) + (x[2] + x[3]); }
                s += __shfl_xor(s, 16); s += __shfl_xor(s, 32);
                const float mw = s * (1.0f / 64.0f); float q = 0.f;
#pragma unroll
                for (int bj = 0; bj < 2; ++bj)
#pragma unroll
                    for (int n = 0; n < 2; ++n) { const f32x4 d = v[ai][bj][m][n] - mw; q += (d[0] * d[0] + d[1] * d[1]) + (d[2] * d[2] + d[3] * d[3]); }
                q += __shfl_xor(q, 16); q += __shfl_xor(q, 32);
                if (fq == 0) P[(ai * HALF + wr * 64 + m * 16 + fr) * 4 + wc] = (f32x2v){mw, q};
            }
        asm volatile("s_waitcnt lgkmcnt(0)" ::: "memory"); __builtin_amdgcn_s_barrier(); asm volatile("" ::: "memory");
#if defined(BROKEN_EXCHANGE_NO_WAIT)
#warning BROKEN CONTROL BUILD: the row-statistics exchange does not wait; results are wrong by design
        if (blockIdx.x >= 64) { const long long t0_ = clock64(); while (clock64() - t0_ < 60000) __builtin_amdgcn_s_sleep(8); }
#endif
        const int row = wid * 32 + (lane & 31);
        if (lane < 32) {
            const f32x2v a = P[row * 4 + 0], b = P[row * 4 + 1], c = P[row * 4 + 2], d = P[row * 4 + 3];
            const float mt = (a.x + b.x + c.x + d.x) * 0.25f;
            const float da = a.x - mt, db = b.x - mt, dc = c.x - mt, dd = d.x - mt;
            const float m2 = (a.y + b.y) + (c.y + d.y) + 64.0f * ((da * da + db * db) + (dc * dc + dd * dd));
            unsigned long long* slot = (unsigned long long*)xbuf + ((size_t)(u.pm * BM + row) * 4 + u.pn);
            __hip_atomic_store(slot, ((unsigned long long)__float_as_uint(m2) << 32) | __float_as_uint(mt), __ATOMIC_RELAXED, __HIP_MEMORY_SCOPE_AGENT);
        }
        asm volatile("s_waitcnt vmcnt(0)" ::: "memory");
        if (lane == 0) __hip_atomic_fetch_add(cnt + 64 * u.pm, 1u, __ATOMIC_RELAXED, __HIP_MEMORY_SCOPE_AGENT);
        if (wid == 0) {
            bool dead = false; const unsigned long long t0 = __builtin_amdgcn_s_memrealtime(); const unsigned want = 8u * (unsigned)ntn;
            for (;;) {
#if defined(BROKEN_EXCHANGE_NO_WAIT)
                break;
#endif
                if ((unsigned)__builtin_amdgcn_readfirstlane(__hip_atomic_load(cnt + 64 * u.pm, __ATOMIC_RELAXED, __HIP_MEMORY_SCOPE_AGENT)) >= want) break;
                if (__builtin_amdgcn_s_memrealtime() - t0 > 2000000ull) {
                    if (lane == 0) { unsigned expect = 0u; __hip_atomic_compare_exchange_strong(tmo + 1, &expect, code | (unsigned)(u.pm & 0xff), __ATOMIC_RELAXED, __ATOMIC_RELAXED, __HIP_MEMORY_SCOPE_AGENT);
                                     __hip_atomic_store(tmo, 1u, __ATOMIC_RELAXED, __HIP_MEMORY_SCOPE_AGENT); }
                    dead = true; break; }
                __builtin_amdgcn_s_sleep(2);
            }
            __builtin_amdgcn_fence(__ATOMIC_ACQUIRE, "agent");
            if (lane == 0) flag[0] = dead ? 1u : 0u;
        }
        asm volatile("s_waitcnt vmcnt(0) lgkmcnt(0)" ::: "memory"); __builtin_amdgcn_s_barrier(); asm volatile("" ::: "memory");
        const bool bad = flag[0] != 0u;
        if (lane < 32) {
            const unsigned long long* slot = (const unsigned long long*)xbuf + (size_t)(u.pm * BM + row) * 4; float mt[4], m2[4]; float ms = 0.f;
#pragma unroll
            for (int t = 0; t < 4; ++t) { if (t < ntn) { const unsigned long long w = __hip_atomic_load(slot + t, __ATOMIC_RELAXED, __HIP_MEMORY_SCOPE_AGENT); mt[t] = __uint_as_float((unsigned)w); m2[t] = __uint_as_float((unsigned)(w >> 32)); } else { mt[t] = 0.f; m2[t] = 0.f; } ms += mt[t]; }
            const float mean = ms / (float)ntn; float q = 0.f;
#pragma unroll
            for (int t = 0; t < 4; ++t) if (t < ntn) { const float dm = mt[t] - mean; q += m2[t] + 256.0f * dm * dm; }
            S[row] = (f32x2v){mean, 1.0f / sqrtf(q / (256.0f * (float)ntn) + eps)};
        }
        asm volatile("s_waitcnt lgkmcnt(0)" ::: "memory"); __builtin_amdgcn_s_barrier(); asm volatile("" ::: "memory");
        return bad;
    }
};

struct EpiLn {
    static constexpr bool PERM = false, AFTER_DRAIN = true;
    const float* base; float* out; bf16_t* outb; int ldc; const float* gam; const float* bet; PanelStats st; float alpha;
    __device__ __forceinline__ void fused(f32x4 (&acc)[2][2][4][2], const Unit& u, int wr, int wc, int fr, int fq, PG8_LAS unsigned char* lds, int wid, int lane) const {
        typedef float f32x2v __attribute__((ext_vector_type(2))); typedef unsigned u32x2v __attribute__((ext_vector_type(2)));
        const PG8_LAS f32x2v* S = (const PG8_LAS f32x2v*)(lds + 8192);
        const int col0 = u.pn * BM + wc * 32 + 4 * fq;
#pragma unroll
        for (int ai = 0; ai < 2; ++ai) {
            f32x4 bs[4][2][2];
#pragma unroll
            for (int m = 0; m < 4; ++m) { const size_t off = (size_t)(u.pm * BM + ai * HALF + wr * 64 + m * 16 + fr) * ldc + col0;
#pragma unroll
                for (int bj = 0; bj < 2; ++bj)
#pragma unroll
                    for (int n = 0; n < 2; ++n) bs[m][bj][n] = *(const f32x4*)(base + off + bj * HALF + n * 16); }
#pragma unroll
            for (int m = 0; m < 4; ++m) {
#pragma unroll
                for (int bj = 0; bj < 2; ++bj)
#pragma unroll
                    for (int n = 0; n < 2; ++n) acc[ai][bj][m][n] += bs[m][bj][n] * alpha;
                asm volatile("" : "+v"(acc[ai][0][m][0]), "+v"(acc[ai][0][m][1]), "+v"(acc[ai][1][m][0]), "+v"(acc[ai][1][m][1])); }
            asm volatile("" ::: "memory"); }
        const bool bad = st.run(acc, u, wr, wc, fr, fq, lds, wid, lane);
        const float qnan = __builtin_nanf("");
        f32x4 gv[2][2], bv[2][2];
#pragma unroll
        for (int bj = 0; bj < 2; ++bj)
#pragma unroll
            for (int n = 0; n < 2; ++n) { gv[bj][n] = *(const f32x4*)(gam + col0 + bj * HALF + n * 16); bv[bj][n] = *(const f32x4*)(bet + col0 + bj * HALF + n * 16); }
#pragma unroll
        for (int ai = 0; ai < 2; ++ai)
#pragma unroll
            for (int m = 0; m < 4; ++m) { const int r = ai * HALF + wr * 64 + m * 16 + fr; const f32x2v sr = S[r]; const size_t off = (size_t)(u.pm * BM + r) * ldc + col0;
#pragma unroll
                for (int bj = 0; bj < 2; ++bj)
#pragma unroll
                    for (int n = 0; n < 2; ++n) { f32x4 o = (acc[ai][bj][m][n] - sr.x) * sr.y * gv[bj][n] + bv[bj][n];
                        if (bad) o = (f32x4){qnan, qnan, qnan, qnan};
                        *(f32x4*)(out + off + bj * HALF + n * 16) = o;
                        if (outb) { u32x2v w; w.x = cvtpk(o[0], o[1]); w.y = cvtpk(o[2], o[3]); *(u32x2v*)(outb + off + bj * HALF + n * 16) = w; } }
                asm volatile("" ::: "memory"); }
    }
};

template <class Epi, class Sched, bool ALIGN_EPI = false, bool SP2 = false>
__device__ __forceinline__ void gemm_phase(PG8_LAS unsigned char* lds, const Gemm g, const Sched& S, const Epi& E) {
    const int tid = otid(), wid = __builtin_amdgcn_readfirstlane(tid >> 6), lane = tid & 63, wr = wid >> 2, wc = wid & 3, fr = lane & 15, fq = lane >> 4;
    const int K = g.K, nt = K / BK;
    unsigned voffA[2], voffB[2];
#pragma unroll
    for (int i = 0; i < 2; ++i) { int R, C; stage_rc(tid * 16 + i * 8192, R, C); const int Rb = Epi::PERM ? ((R & ~31) + perm32(R & 31)) : R;
        voffA[i] = (unsigned)(R * K + C) * 2u; voffB[i] = (unsigned)(Rb * K + C) * 2u; }
    const size_t kstep = (size_t)(BK * 2);
    const size_t hstep = (size_t)HALF * K * 2;
    const size_t tstep = 2 * hstep;
    const unsigned ldsw = (unsigned)wid * 1024u;
    const int aoff = lds_byte(wr * 64 + fr, fq * 8), boff = lds_byte(wc * 32 + fr, fq * 8);
#define PG8_SA(b, h) (((b) * 2 + (h)) * HTB)
#define PG8_SB(b, h) ((4 + (b) * 2 + (h)) * HTB)
#define PG8_STAGE(bufoff, gbase, voff) do { _Pragma("unroll") for (int _i = 0; _i < 2; ++_i) \
        __builtin_amdgcn_global_load_lds((const unsigned*)((const char*)(gbase) + (voff)[_i]), (PG8_LAS unsigned*)(lds + (bufoff) + ldsw + _i * 8192), 16, 0, 0); } while (0)
#define PG8_LDA(dst, b, h) do { _Pragma("unroll") for (int m = 0; m < 4; ++m) _Pragma("unroll") for (int k = 0; k < 2; ++k) dst[m][k] = *(const PG8_LAS bf16x8*)(lds + PG8_SA(b, h) + aoff + m * 2048 + k * 1024); } while (0)
#define PG8_LDB(dst, b, h) do { _Pragma("unroll") for (int n = 0; n < 2; ++n) _Pragma("unroll") for (int k = 0; k < 2; ++k) dst[n][k] = *(const PG8_LAS bf16x8*)(lds + PG8_SB(b, h) + boff + n * 2048 + k * 1024); } while (0)
#define PG8_MMA(ai, bj, At, Bt) do { __builtin_amdgcn_s_setprio(1); _Pragma("unroll") for (int m = 0; m < 4; ++m) _Pragma("unroll") for (int n = 0; n < 2; ++n) _Pragma("unroll") for (int k = 0; k < 2; ++k) \
        acc[ai][bj][m][n] = __builtin_amdgcn_mfma_f32_16x16x32_bf16(Bt[n][k], At[m][k], acc[ai][bj][m][n], 0, 0, 0); __builtin_amdgcn_s_setprio(0); } while (0)
#define PG8_WAIT_V(n) asm volatile("s_waitcnt vmcnt(" #n ")" ::: "memory")
#define PG8_WAIT_L(n) asm volatile("s_waitcnt lgkmcnt(" #n ")" ::: "memory")
#define PG8_BAR __builtin_amdgcn_s_barrier()
#define PG8_SCHED __builtin_amdgcn_sched_barrier(0)
    Unit cur, nxt; int ui = 0;
    if (!S.next(0, cur)) return;
    f32x4 acc[2][2][4][2];
#pragma unroll
    for (int a = 0; a < 2; ++a)
#pragma unroll
        for (int b = 0; b < 2; ++b)
#pragma unroll
            for (int m = 0; m < 4; ++m)
#pragma unroll
                for (int n = 0; n < 2; ++n) acc[a][b][m][n] = (f32x4){0.f, 0.f, 0.f, 0.f};
    bf16x8 At[4][2], B0[2][2], B1[2][2];
    const char* cA = (const char*)g.A + (size_t)cur.pm * tstep; const char* cB = (const char*)g.Bt + (size_t)cur.pn * tstep;
    S.a_ready(cur);
    if constexpr (SP2) {
        PG8_STAGE(PG8_SB(0, 0), cB, voffB); PG8_STAGE(PG8_SB(0, 1), cB + hstep, voffB); PG8_STAGE(PG8_SA(0, 0), cA, voffA); PG8_STAGE(PG8_SA(0, 1), cA + hstep, voffA);
        if (wr == 1) PG8_BAR;
        PG8_WAIT_V(2); PG8_BAR;
        PG8_STAGE(PG8_SB(1, 0), cB + kstep, voffB); PG8_STAGE(PG8_SA(1, 0), cA + kstep, voffA); PG8_STAGE(PG8_SB(1, 1), cB + hstep + kstep, voffB);
        PG8_WAIT_V(6); PG8_BAR;
    } else {
        PG8_STAGE(PG8_SB(0, 0), cB, voffB); PG8_STAGE(PG8_SA(0, 0), cA, voffA); PG8_STAGE(PG8_SB(0, 1), cB + hstep, voffB); PG8_STAGE(PG8_SA(0, 1), cA + hstep, voffA);
        if (wr == 1) PG8_BAR;
        PG8_WAIT_V(4); PG8_BAR;
        PG8_STAGE(PG8_SB(1, 0), cB + kstep, voffB); PG8_STAGE(PG8_SA(1, 0), cA + kstep, voffA); PG8_STAGE(PG8_SB(1, 1), cB + hstep + kstep, voffB);
        PG8_WAIT_V(6); PG8_BAR;
    }
    for (;;) {
        const bool has_next = S.next(ui + 1, nxt);
        const char* nA = has_next ? (const char*)g.A + (size_t)nxt.pm * tstep : cA; const char* nB = has_next ? (const char*)g.Bt + (size_t)nxt.pn * tstep : cB;
        for (int t = 0; t < nt; t += 2) {
            const bool last = (t == nt - 2);
            const char* a1 = cA + (size_t)(t + 1) * kstep;
            const char* a2 = last ? nA : cA + (size_t)(t + 2) * kstep; const char* b2 = last ? nB : cB + (size_t)(t + 2) * kstep;
            const char* a3 = a2 + kstep; const char* b3 = b2 + kstep;
            if (last && has_next) S.a_ready(nxt);
            if constexpr (SP2) {
            PG8_LDB(B0, 0, 0); PG8_LDB(B1, 0, 1); PG8_SCHED; PG8_LDA(At, 0, 0); PG8_STAGE(PG8_SA(1, 1), a1 + hstep, voffA);
            PG8_WAIT_V(8); PG8_WAIT_L(0); PG8_BAR; PG8_MMA(0, 0, At, B0); PG8_MMA(0, 1, At, B1); PG8_BAR; PG8_SCHED;
            PG8_LDA(At, 0, 1); PG8_STAGE(PG8_SB(0, 0), b2, voffB); PG8_STAGE(PG8_SB(0, 1), b2 + hstep, voffB); PG8_STAGE(PG8_SA(0, 0), a2, voffA);
            PG8_WAIT_V(8); PG8_WAIT_L(0); PG8_BAR; PG8_MMA(1, 0, At, B0); PG8_MMA(1, 1, At, B1); PG8_BAR; PG8_SCHED;
            PG8_LDB(B0, 1, 0); PG8_LDB(B1, 1, 1); PG8_SCHED; PG8_LDA(At, 1, 0); PG8_STAGE(PG8_SA(0, 1), a2 + hstep, voffA);
            PG8_WAIT_V(8); PG8_WAIT_L(0); PG8_BAR; PG8_MMA(0, 0, At, B0); PG8_MMA(0, 1, At, B1); PG8_BAR; PG8_SCHED;
            PG8_LDA(At, 1, 1); PG8_STAGE(PG8_SB(1, 0), b3, voffB); PG8_STAGE(PG8_SB(1, 1), b3 + hstep, voffB); PG8_STAGE(PG8_SA(1, 0), a3, voffA);
            PG8_WAIT_V(8); PG8_WAIT_L(0); PG8_BAR; PG8_MMA(1, 0, At, B0); PG8_MMA(1, 1, At, B1); PG8_BAR; PG8_SCHED;
            } else {
            PG8_LDB(B0, 0, 0); PG8_SCHED; PG8_LDA(At, 0, 0); PG8_STAGE(PG8_SA(1, 1), a1 + hstep, voffA);
            PG8_WAIT_L(8); PG8_BAR; PG8_WAIT_L(0); PG8_MMA(0, 0, At, B0); PG8_BAR; PG8_SCHED;
            PG8_LDB(B1, 0, 1); PG8_STAGE(PG8_SB(0, 0), b2, voffB);
            PG8_BAR; PG8_WAIT_L(0); PG8_MMA(0, 1, At, B1); PG8_BAR;
            PG8_LDA(At, 0, 1); PG8_STAGE(PG8_SA(0, 0), a2, voffA);
            PG8_BAR; PG8_WAIT_L(0); PG8_MMA(1, 0, At, B0); PG8_BAR; PG8_SCHED;
            PG8_STAGE(PG8_SB(0, 1), b2 + hstep, voffB);
            PG8_WAIT_V(6); PG8_BAR; PG8_MMA(1, 1, At, B1); PG8_BAR;
            PG8_LDB(B0, 1, 0); PG8_SCHED; PG8_LDA(At, 1, 0); PG8_STAGE(PG8_SA(0, 1), a2 + hstep, voffA);
            PG8_WAIT_L(8); PG8_BAR; PG8_WAIT_L(0); PG8_MMA(0, 0, At, B0); PG8_BAR; PG8_SCHED;
            PG8_LDB(B1, 1, 1); PG8_STAGE(PG8_SB(1, 0), b3, voffB);
            PG8_BAR; PG8_WAIT_L(0); PG8_MMA(0, 1, At, B1); PG8_BAR;
            PG8_LDA(At, 1, 1); PG8_STAGE(PG8_SA(1, 0), a3, voffA);
            PG8_BAR; PG8_WAIT_L(0); PG8_MMA(1, 0, At, B0); PG8_BAR; PG8_SCHED;
            PG8_STAGE(PG8_SB(1, 1), b3 + hstep, voffB);
            PG8_WAIT_V(6); PG8_BAR; PG8_MMA(1, 1, At, B1); PG8_BAR;
            }
        }
        if constexpr (ALIGN_EPI) { if (wr == 0) PG8_BAR; }
        if constexpr (!Epi::AFTER_DRAIN) { E(acc, cur, wr, wc, fr, fq); S.done(cur); }
        if (!has_next) break;
#pragma unroll
        for (int a = 0; a < 2; ++a)
#pragma unroll
            for (int b = 0; b < 2; ++b)
#pragma unroll
                for (int m = 0; m < 4; ++m)
#pragma unroll
                    for (int n = 0; n < 2; ++n) acc[a][b][m][n] = (f32x4){0.f, 0.f, 0.f, 0.f};
        cur = nxt; cA = nA; cB = nB; ++ui;
        if constexpr (ALIGN_EPI) { if (wr == 1) PG8_BAR; }
    }
    PG8_WAIT_V(0);
    if constexpr (!ALIGN_EPI) { if (wr == 0) PG8_BAR; }
    PG8_BAR;
    if constexpr (Epi::AFTER_DRAIN) { E.fused(acc, cur, wr, wc, fr, fq, lds, wid, lane); S.done(cur); }
#undef PG8_SA
#undef PG8_SB
#undef PG8_STAGE
#undef PG8_LDA
#undef PG8_LDB
#undef PG8_MMA
#undef PG8_WAIT_V
#undef PG8_WAIT_L
#undef PG8_BAR
#undef PG8_SCHED
}
}

__device__ __forceinline__ void ln_phase(const float* xin, const float* Y, const float* g, const float* bb, float* out, bf16_t* outb) {
  const int lane = otid() & 63, wid = otid() >> 6;
  for (int row = blockIdx.x * 8 + wid; row < M_; row += gridDim.x * 8) {
    const float4* xr = (const float4*)(xin + (size_t)row * D_);
    const float4* yr = (const float4*)(Y + (size_t)row * D_);
    float4 v[4]; float s = 0.f;
#pragma unroll
    for (int j = 0; j < 4; ++j) {
      const float4 a = xr[j * 64 + lane], y = yr[j * 64 + lane];
      v[j].x = ALPHA * a.x + y.x; v[j].y = ALPHA * a.y + y.y; v[j].z = ALPHA * a.z + y.z; v[j].w = ALPHA * a.w + y.w;
      s += (v[j].x + v[j].y) + (v[j].z + v[j].w);
    }
    const float mean = wave_sum(s) * (1.f / D_);
    float q = 0.f;
#pragma unroll
    for (int j = 0; j < 4; ++j) {
      v[j].x -= mean; v[j].y -= mean; v[j].z -= mean; v[j].w -= mean;
      q += (v[j].x * v[j].x + v[j].y * v[j].y) + (v[j].z * v[j].z + v[j].w * v[j].w);
    }
    const float rstd = 1.f / sqrtf(wave_sum(q) * (1.f / D_) + LN_EPS);
#pragma unroll
    for (int j = 0; j < 4; ++j) {
      const float4 gg = ((const float4*)g)[j * 64 + lane], bv = ((const float4*)bb)[j * 64 + lane];
      float4 o;
      o.x = v[j].x * rstd * gg.x + bv.x; o.y = v[j].y * rstd * gg.y + bv.y; o.z = v[j].z * rstd * gg.z + bv.z; o.w = v[j].w * rstd * gg.w + bv.w;
      ((float4*)(out + (size_t)row * D_))[j * 64 + lane] = o;
      if (outb) {
        ushort4 ob; ob.x = f2bf(o.x); ob.y = f2bf(o.y); ob.z = f2bf(o.z); ob.w = f2bf(o.w);
        ((ushort4*)(outb + (size_t)row * D_))[j * 64 + lane] = ob;
      }
    }
  }
}

__device__ __forceinline__ void compress_item(const Params& P, int item, float* sm) {
  const bf16_t* H0 = (const bf16_t*)(P.ws + WS_H);
  const int tid = otid();
  const int g = item & 1; int r = item >> 1; const int n = r % NCMP; r /= NCMP; const int b = r & 3; const int i = r >> 2;
  const float* pos = P.in[2] + i * 2048;
  const float* w1 = P.in[3] + (size_t)i * 2048 * 128;
  const float* b1 = P.in[4] + i * 128;
  const float* w2 = P.in[5] + (size_t)i * 128 * 64;
  float* blk = sm;
  float* part = sm + 2048;
  float* hid = sm + 2048 + 512;
  const int col = (i == 0 ? C_KCMP : C_VCMP) + g * 64;
#pragma unroll
  for (int k = 0; k < 4; ++k) {
    const int f = tid + k * 512, l = f >> 6, d = f & 63;
    blk[f] = bf2f(H0[((size_t)b * S_ + 16 * n + l) * P0 + col + d]) + pos[f];
  }
  __syncthreads();
  const int hh = tid & 127, pt = tid >> 7;
  float acc = 0.f;
  for (int f = pt * 512; f < pt * 512 + 512; ++f) acc += blk[f] * w1[(size_t)f * 128 + hh];
  part[pt * 128 + hh] = acc;
  __syncthreads();
  if (tid < 128) {
    const float a = part[tid] + part[128 + tid] + part[256 + tid] + part[384 + tid] + b1[tid];
    hid[tid] = silu_f(a);
  }
  __syncthreads();
  if (tid < 64) {
    float o = 0.f;
    for (int k = 0; k < 128; ++k) o += hid[k] * w2[k * 64 + tid];
    float* dst = (float*)(P.ws + (i == 0 ? WS_KC : WS_VC));
    dst[(((size_t)b * NCMP + n) * 2 + g) * 64 + tid] = o;
    bf16_t* dstb = (bf16_t*)(P.ws + (i == 0 ? (size_t)(248 * MiB) : (size_t)(249 * MiB)));
    dstb[(((size_t)b * 2 + g) * 256 + n) * 64 + tid] = f2bf(o);
    if (n == 0) dstb[(((size_t)b * 2 + g) * 256 + 255) * 64 + tid] = 0;
  }
  __syncthreads();
}
__device__ __forceinline__ void kmean_item(const Params& P, int item, int lane) {
  const bf16_t* H0 = (const bf16_t*)(P.ws + WS_H);
  const int h = item & 7, n = (item >> 3) & 15, b = item >> 7;
  float s = 0.f;
  for (int k = 0; k < 256; ++k) s += bf2f(H0[((size_t)b * S_ + n * 256 + k) * P0 + C_MK + h * 64 + lane]);
  ((float*)(P.ws + WS_KM))[(((size_t)b * 16 + n) * 8 + h) * 64 + lane] = s * (1.f / 256.f);
}


constexpr size_t WS_W1T = 250 * MiB;
constexpr size_t WS_W2T = 251 * MiB;
constexpr size_t WS_C1P = 252 * MiB;
__device__ __forceinline__ void compress_mfma_tile(const Params& P, int tile, unsigned char* smem_g) {
  const bf16_t* __restrict__ H0 = (const bf16_t*)(P.ws + WS_H);
  const int tid = otid(), lane = tid & 63, wid = __builtin_amdgcn_readfirstlane(tid >> 6), g = lane >> 4, ii = lane & 15;
  const int i = tile >> 7, R0 = (tile & 127) * 16;
  bf16_t* hs = (bf16_t*)smem_g;
  {
    const int R = min(R0 + ii, 2039), b = R / 510, rem = R - b * 510, n = rem >> 1, grp = rem & 1;
    const bf16_t* abase = H0 + ((size_t)b * S_ + 16 * n) * P0 + (i == 0 ? C_KCMP : C_VCMP) + grp * 64 + 8 * g;
    const bf16_t* bbase = (const bf16_t*)(P.ws + WS_W1T) + (size_t)(i * 128 + 16 * wid + ii) * 2048 + 8 * g;
    f32x4 acc = (f32x4){0.f, 0.f, 0.f, 0.f};
#pragma unroll 16
    for (int ks = 0; ks < 64; ++ks) {
      const bf16x8 a = *(const bf16x8*)(abase + (size_t)(ks >> 1) * P0 + (ks & 1) * 32);
      const bf16x8 bq = *(const bf16x8*)(bbase + ks * 32);
      acc = __builtin_amdgcn_mfma_f32_16x16x32_bf16(a, bq, acc, 0, 0, 0);
    }
    const int col = 16 * wid + ii;
    float bias = P.in[4][i * 128 + col];
    const float* c1p = (const float*)(P.ws + WS_C1P) + i * 32 * 128 + col;
#pragma unroll 8
    for (int q = 0; q < 32; ++q) bias += c1p[q * 128];
#pragma unroll
    for (int r = 0; r < 4; ++r) hs[(4 * g + r) * 136 + col] = f2bf(silu_f(acc[r] + bias));
  }
  __syncthreads();
  if (wid < 4) {
    const bf16_t* b2 = (const bf16_t*)(P.ws + WS_W2T) + (size_t)(i * 64 + 16 * wid + ii) * 128 + 8 * g;
    f32x4 acc = (f32x4){0.f, 0.f, 0.f, 0.f};
#pragma unroll
    for (int k2 = 0; k2 < 4; ++k2) {
      const bf16x8 a = *(const bf16x8*)(hs + ii * 136 + 32 * k2 + 8 * g);
      const bf16x8 bq = *(const bf16x8*)(b2 + 32 * k2);
      acc = __builtin_amdgcn_mfma_f32_16x16x32_bf16(a, bq, acc, 0, 0, 0);
    }
    bf16_t* dst = (bf16_t*)(P.ws + (i == 0 ? (size_t)(248 * MiB) : (size_t)(249 * MiB)));
#pragma unroll
    for (int r = 0; r < 4; ++r) {
      const int R = R0 + 4 * g + r;
      if (R < 2040) { const int b = R / 510, rem = R - b * 510, n = rem >> 1, grp = rem & 1;
        dst[(((size_t)b * 2 + grp) * 256 + n) * 64 + 16 * wid + ii] = f2bf(acc[r]); }
    }
  }
  __syncthreads();
}
__device__ __forceinline__ void kmean_item2(const Params& P, int item) {
  const bf16_t* __restrict__ H0 = (const bf16_t*)(P.ws + WS_H);
  const int tid = otid();
  const bf16_t* src = H0 + ((size_t)(item >> 4) * S_ + (item & 15) * 256) * P0 + C_MK + tid;
  float s0 = 0.f, s1 = 0.f, s2 = 0.f, s3 = 0.f;
#pragma unroll 4
  for (int r = 0; r < 256; r += 4) {
    s0 += bf2f(src[(size_t)r * P0]); s1 += bf2f(src[(size_t)(r + 1) * P0]); s2 += bf2f(src[(size_t)(r + 2) * P0]); s3 += bf2f(src[(size_t)(r + 3) * P0]);
  }
  ((float*)(P.ws + WS_KM))[(size_t)item * 512 + tid] = ((s0 + s1) + (s2 + s3)) * (1.f / 256.f);
}

template <int NH>
__device__ __forceinline__ void attend_block(const bf16_t* __restrict__ Kp, const bf16_t* __restrict__ Vp, size_t rowbase, int kp0, int t, int kmin,
                                             const float* qs, float* pb, const float* slope, float* m, float* l, float* o, int lane) {
  asm volatile("" ::: "memory");
  const int kp = kp0 + lane;
  const bool valid = (kp <= t) && (kp >= kmin);
  const uint4* kr = (const uint4*)(Kp + (rowbase + kp) * P0);
  float dot[NH];
#pragma unroll
  for (int j = 0; j < NH; ++j) dot[j] = 0.f;
#pragma unroll 1
  for (int c = 0; c < 8; ++c) {
    asm volatile("" ::: "memory");
    const uint4 u = kr[c];
    float kv[8];
    kv[0] = __uint_as_float(u.x << 16); kv[1] = __uint_as_float(u.x & 0xffff0000u);
    kv[2] = __uint_as_float(u.y << 16); kv[3] = __uint_as_float(u.y & 0xffff0000u);
    kv[4] = __uint_as_float(u.z << 16); kv[5] = __uint_as_float(u.z & 0xffff0000u);
    kv[6] = __uint_as_float(u.w << 16); kv[7] = __uint_as_float(u.w & 0xffff0000u);
#pragma unroll
    for (int j = 0; j < NH; ++j) {
      const float4 q0 = *(const float4*)(qs + j * 64 + c * 8), q1 = *(const float4*)(qs + j * 64 + c * 8 + 4);
      dot[j] += kv[0] * q0.x + kv[1] * q0.y + kv[2] * q0.z + kv[3] * q0.w + kv[4] * q1.x + kv[5] * q1.y + kv[6] * q1.z + kv[7] * q1.w;
    }
  }
#pragma unroll
  for (int j = 0; j < NH; ++j) {
    const float s = valid ? 0.125f * dot[j] - slope[j] * (float)(t - kp) : -1e30f;
    const float mn = fmaxf(m[j], wave_max(s));
    const float al = __expf(m[j] - mn);
    const float p = valid ? __expf(s - mn) : 0.f;
    l[j] = l[j] * al + wave_sum(p);
    o[j] *= al; m[j] = mn;
    pb[j * 64 + lane] = p;
  }
  __builtin_amdgcn_wave_barrier();
  const bf16_t* vr = Vp + (rowbase + kp0) * P0 + lane;
#pragma unroll 8
  for (int k = 0; k < 64; ++k) {
    const float v = bf2f(vr[(size_t)k * P0]);
#pragma unroll
    for (int j = 0; j < NH; ++j) o[j] += pb[j * 64 + k] * v;
  }
  __builtin_amdgcn_wave_barrier();
}

__device__ __forceinline__ void nsa_item(const Params& P, int b, int g, int t, float* wsm, int lane) {
  const bf16_t* H0 = (const bf16_t*)(P.ws + WS_H);
  const float* KC = (const float*)(P.ws + WS_KC);
  const float* VC = (const float*)(P.ws + WS_VC);
  bf16_t* MIX = (bf16_t*)(P.ws + WS_MIX);
  float* qs = wsm;
  float* pc = wsm + 256;
  float* pb = wsm + 1280;
  const size_t row = (size_t)b * S_ + t;
  const bf16_t* hrow = H0 + row * P0;
  float slope[4];
#pragma unroll
  for (int j = 0; j < 4; ++j) { qs[j * 64 + lane] = bf2f(hrow[C_NQ + (g * 4 + j) * 64 + lane]); slope[j] = exp2f(-(float)(g * 4 + j + 1)); }
  __builtin_amdgcn_wave_barrier();
  const int nv = t >= 31 ? (t - 31) / 16 + 1 : 0;
#pragma unroll 1
  for (int c = 0; c < 4; ++c) {
    asm volatile("" ::: "memory");
    const int n = c * 64 + lane;
    float dot[4] = {0.f, 0.f, 0.f, 0.f};
    if (n < nv) {
      const float4* kr = (const float4*)(KC + (((size_t)b * NCMP + n) * 2 + g) * 64);
#pragma unroll 4
      for (int d4 = 0; d4 < 16; ++d4) {
        const float4 kv = kr[d4];
#pragma unroll
        for (int j = 0; j < 4; ++j) {
          const float4 q = *(const float4*)(qs + j * 64 + d4 * 4);
          dot[j] += kv.x * q.x + kv.y * q.y + kv.z * q.z + kv.w * q.w;
        }
      }
    }
#pragma unroll
    for (int j = 0; j < 4; ++j) pc[j * 256 + n] = (n < nv) ? 0.125f * dot[j] - slope[j] * (float)(t - (16 * n + 31)) : -1e30f;
  }
  __builtin_amdgcn_wave_barrier();
#pragma unroll
  for (int j = 0; j < 4; ++j) {
    float sc[4];
#pragma unroll
    for (int c = 0; c < 4; ++c) sc[c] = pc[j * 256 + c * 64 + lane];
    float mx = fmaxf(fmaxf(sc[0], sc[1]), fmaxf(sc[2], sc[3]));
    mx = wave_max(mx);
    float sum = 0.f;
#pragma unroll
    for (int c = 0; c < 4; ++c) { const int n = c * 64 + lane; const float p = (n < nv) ? __expf(sc[c] - mx) : 0.f; sc[c] = p; sum += p; }
    sum = wave_sum(sum);
    const float inv = nv > 0 ? 1.f / sum : 0.f;
#pragma unroll
    for (int c = 0; c < 4; ++c) pc[j * 256 + c * 64 + lane] = sc[c] * inv;
  }
  __builtin_amdgcn_wave_barrier();
  float ocmp[4] = {0.f, 0.f, 0.f, 0.f};
  for (int n = 0; n < nv; ++n) {
    const float v = VC[(((size_t)b * NCMP + n) * 2 + g) * 64 + lane];
#pragma unroll
    for (int j = 0; j < 4; ++j) ocmp[j] += pc[j * 256 + n] * v;
  }
  float imp = 0.f;
  {
    const int lo = max(0, 4 * lane - 1), hi = min(NCMP - 1, 4 * lane + 3);
    for (int n = lo; n <= hi; ++n) imp += (pc[n] + pc[256 + n]) + (pc[512 + n] + pc[768 + n]);
  }
  const int cur = t >> 6;
  const bool bvalid = lane <= cur;
  const bool forced = (lane == 0) || (lane == cur) || (lane == cur - 1);
  const float key = bvalid ? (forced ? 1e9f : imp) : -1e30f;
  int rank = 0;
  for (int s2 = 0; s2 < 64; ++s2) {
    const float ks = __shfl(key, s2);
    rank += (ks > key || (ks == key && s2 < lane)) ? 1 : 0;
  }
  const unsigned long long selmask = __ballot(bvalid && rank < 16);
  float m[4], l[4], osel[4], owin[4];
#pragma unroll
  for (int j = 0; j < 4; ++j) { m[j] = -1e30f; l[j] = 0.f; osel[j] = 0.f; }
  {
    unsigned long long mk = selmask;
    while (mk) {
      const int blk = __builtin_ctzll(mk); mk &= mk - 1;
      attend_block<4>(H0 + C_KSEL + g * 64, H0 + C_VSEL + g * 64, (size_t)b * S_, blk * 64, t, 0, qs, pb, slope, m, l, osel, lane);
    }
  }
#pragma unroll
  for (int j = 0; j < 4; ++j) { osel[j] /= l[j]; m[j] = -1e30f; l[j] = 0.f; owin[j] = 0.f; }
  {
    const int kmin = t - 511;
    const int b0 = (kmin > 0 ? kmin : 0) >> 6;
    for (int blk = b0; blk <= cur; ++blk)
      attend_block<4>(H0 + C_KWIN + g * 64, H0 + C_VWIN + g * 64, (size_t)b * S_, blk * 64, t, kmin, qs, pb, slope, m, l, owin, lane);
  }
#pragma unroll
  for (int j = 0; j < 4; ++j) {
    const int h = g * 4 + j;
    const float g0 = sigmoid_f(bf2f(hrow[C_NG + h * 3 + 0])), g1 = sigmoid_f(bf2f(hrow[C_NG + h * 3 + 1])), g2 = sigmoid_f(bf2f(hrow[C_NG + h * 3 + 2]));
    const float o = g0 * ocmp[j] + g1 * osel[j] + g2 * (owin[j] / l[j]);
    const float z = bf2f(hrow[C_NZ + h * 64 + lane]);
    MIX[row * D_ + h * 64 + lane] = f2bf(o * silu_f(z));
  }
}

__device__ __forceinline__ void moba_item(const Params& P, int b, int h, int t, float* wsm, int lane) {
  const bf16_t* H0 = (const bf16_t*)(P.ws + WS_H);
  const float* KM = (const float*)(P.ws + WS_KM);
  bf16_t* MIX = (bf16_t*)(P.ws + WS_MIX);
  float* qs = wsm;
  float* pb = wsm + 1280;
  const size_t row = (size_t)b * S_ + t;
  const bf16_t* hrow = H0 + row * P0;
  qs[lane] = bf2f(hrow[C_MQ + h * 64 + lane]);
  __builtin_amdgcn_wave_barrier();
  float slope[1] = {exp2f(-(float)(h + 1))};
  const int cur = t >> 8;
  float gate = -1e30f;
  if (lane < cur) {
    const float4* kr = (const float4*)(KM + (((size_t)b * 16 + lane) * 8 + h) * 64);
    float d = 0.f;
#pragma unroll 4
    for (int d4 = 0; d4 < 16; ++d4) { const float4 kv = kr[d4]; const float4 q = *(const float4*)(qs + d4 * 4); d += kv.x * q.x + kv.y * q.y + kv.z * q.z + kv.w * q.w; }
    gate = d;
  }
  int rank = 0;
  for (int s2 = 0; s2 < 16; ++s2) {
    const float ks = __shfl(gate, s2);
    rank += (ks > gate || (ks == gate && s2 < lane)) ? 1 : 0;
  }
  unsigned long long mk = __ballot(lane < cur && rank < 3) | (1ull << cur);
  float m[1] = {-1e30f}, l[1] = {0.f}, o[1] = {0.f};
  while (mk) {
    const int blk = __builtin_ctzll(mk); mk &= mk - 1;
    for (int c = 0; c < 4; ++c) {
      const int kp0 = blk * 256 + c * 64;
      if (kp0 > t) break;
      attend_block<1>(H0 + C_MK + h * 64, H0 + C_MV + h * 64, (size_t)b * S_, kp0, t, 0, qs, pb, slope, m, l, o, lane);
    }
  }
  const float z = bf2f(hrow[C_MZ + h * 64 + lane]);
  MIX[row * D_ + 512 + h * 64 + lane] = f2bf((o[0] / l[0]) * silu_f(z));
}


#define LAS __attribute__((address_space(3)))
typedef short s16x4 __attribute__((ext_vector_type(4)));
typedef float f32x2_t __attribute__((ext_vector_type(2)));
typedef __bf16 bf16x2_t __attribute__((ext_vector_type(2)));
__device__ __forceinline__ unsigned cvtpk(float lo, float hi) { f32x2_t v = {lo, hi}; bf16x2_t b = __builtin_convertvector(v, bf16x2_t); return __builtin_bit_cast(unsigned, b); }
__device__ __forceinline__ s16x4 vtr(LAS const unsigned char* p) { return __builtin_bit_cast(s16x4, __builtin_amdgcn_ds_read_tr16_b64_v4i16((LAS s16x4*)p)); }
template <int OFF> __device__ __forceinline__ s16x4 vtra(unsigned a) { s16x4 r; asm volatile("ds_read_b64_tr_b16 %0, %1 offset:%2" : "=&v"(r) : "v"(a), "i"(OFF) : "memory"); return r; }
#define LGKM0() do { asm volatile("s_waitcnt lgkmcnt(0)" ::: "memory"); __builtin_amdgcn_sched_barrier(0); } while (0)
constexpr int KT_BYTES = 8192;
constexpr int VT_DT = 2080;
constexpr int VT_BYTES = 4 * VT_DT;
constexpr int AT_BUF = KT_BYTES + VT_BYTES;
constexpr int AT_NST = 4;
constexpr int AT_MISC = AT_NST * AT_BUF;
constexpr int AT_TL = AT_MISC + 64;
constexpr int AT_STASH = AT_MISC + 512;
constexpr int AT_LDS_END = AT_STASH + 8 * 512 * 16;
__device__ __forceinline__ void ring_wait(int rem) {
  if (rem >= 3) asm volatile("s_waitcnt vmcnt(6)" ::: "memory");
  else if (rem == 2) asm volatile("s_waitcnt vmcnt(4)" ::: "memory");
  else if (rem == 1) asm volatile("s_waitcnt vmcnt(2)" ::: "memory");
  else asm volatile("s_waitcnt vmcnt(0)" ::: "memory");
  __builtin_amdgcn_s_barrier();
  asm volatile("" ::: "memory");
}
constexpr float C1 = 0.125f * 1.4426950408889634f;
constexpr float LOG2E = 1.4426950408889634f;
constexpr float AT_LIM = 1.2379400392853803e27f;
constexpr float AT_TINY = 7.8886090522101181e-31f;

__device__ __forceinline__ void at_stage_write(LAS unsigned char* buf, const u32x4& kreg, const u32x4& vreg, int tid) {
  const int key = tid >> 3, c = tid & 7;
  *(LAS u32x4*)(buf + key * 128 + ((c ^ ((key >> 1) & 7)) << 4)) = kreg;
  *(LAS u32x4*)(buf + KT_BYTES + (c >> 1) * VT_DT + key * 32 + (c & 1) * 16) = vreg;
}
__device__ __forceinline__ void at_stage_dma(LAS unsigned char* buf, const bf16_t* Kt, const bf16_t* Vt, unsigned pitch, int lane, int wid) {
  const int kkey = 8 * wid + (lane >> 3), c = (lane & 7) ^ ((kkey >> 1) & 7);
  __builtin_amdgcn_global_load_lds((const unsigned*)(Kt + (unsigned)kkey * pitch + c * 8), (LAS unsigned*)(buf + wid * 1024), 16, 0, 0);
  const int vkey = 32 * (wid & 1) + (lane >> 1), dt = wid >> 1;
  __builtin_amdgcn_global_load_lds((const unsigned*)(Vt + (unsigned)vkey * pitch + dt * 16 + (lane & 1) * 8), (LAS unsigned*)(buf + KT_BYTES + dt * VT_DT + (wid & 1) * 1024), 16, 0, 0);
}
template <int NRG, bool EDGE, bool IMP  , bool SAFE>
__device__ __forceinline__ void at_tile_x(LAS const unsigned char* buf, const bf16x8 (&qf)[NRG][2], f32x4 (&O)[NRG][4], float (&m)[NRG], float (&l)[NRG],
                                        const float (&base)[NRG], const float (&soff)[NRG], const int (&lim)[NRG], const int (&lo)[NRG], int lane,
                                        float (&imp)[NRG][16], float (&carry)[NRG], int tile = 0) {
  const int g = lane >> 4, i = lane & 15;
  const int swz = (i >> 1) & 7;
  LAS const unsigned char* kb = buf + i * 128;
  const int kc0 = ((g ^ swz) << 4), kc1 = (((4 + g) ^ swz) << 4);
  f32x4 S[NRG][4];
#pragma unroll
  for (int rg = 0; rg < NRG; ++rg) {
    const float bm = base[rg];
#pragma unroll
    for (int mt = 0; mt < 4; ++mt)
#pragma unroll
      for (int r = 0; r < 4; ++r) S[rg][mt][r] = bm + soff[rg] * (float)(16 * mt + r);
  }
  __builtin_amdgcn_s_setprio(1);
#pragma unroll
  for (int mt = 0; mt < 4; ++mt) {
    const bf16x8 k0f = *(LAS const bf16x8*)(kb + mt * 2048 + kc0);
    const bf16x8 k1f = *(LAS const bf16x8*)(kb + mt * 2048 + kc1);
#pragma unroll
    for (int rg = 0; rg < NRG; ++rg) {
      f32x4 a = __builtin_amdgcn_mfma_f32_16x16x32_bf16(k0f, qf[rg][0], S[rg][mt], 0, 0, 0);
      S[rg][mt] = __builtin_amdgcn_mfma_f32_16x16x32_bf16(k1f, qf[rg][1], a, 0, 0, 0);
    }
  }
  __builtin_amdgcn_s_setprio(0);
  __builtin_amdgcn_sched_barrier(0);
  const unsigned vb = (unsigned)(unsigned long long)(buf + KT_BYTES) + (4 * g + (i >> 2)) * 32 + (i & 3) * 8;
#define AT_VRD(dt, ks, d0, d1) { d0 = vtra<(dt) * VT_DT + (ks) * 1024>(vb); d1 = vtra<(dt) * VT_DT + (ks) * 1024 + 512>(vb); }
  s16x4 a0, a1, a2, a3, a4, a5, a6, a7, c0, c1, c2, c3, c4, c5, c6, c7;
  AT_VRD(0, 0, a0, a1) AT_VRD(0, 1, a2, a3) AT_VRD(1, 0, a4, a5) AT_VRD(1, 1, a6, a7)
  __builtin_amdgcn_sched_barrier(0);
  unsigned pk[NRG][2][4];
#pragma unroll
  for (int rg = 0; rg < NRG; ++rg) {
    if (EDGE) {
#pragma unroll
      for (int mt = 0; mt < 4; ++mt)
#pragma unroll
        for (int r = 0; r < 4; ++r) { const int c = 16 * mt + r; S[rg][mt][r] = (c <= lim[rg] && c >= lo[rg]) ? S[rg][mt][r] : -INFINITY; }
    }
    if (SAFE) {
      float mx = -INFINITY;
#pragma unroll
      for (int mt = 0; mt < 4; ++mt)
#pragma unroll
        for (int r = 0; r < 4; ++r) mx = fmaxf(mx, S[rg][mt][r]);
      mx = xmax<16>(mx); mx = xmax<32>(mx);
      const float mn = fmaxf(m[rg], mx);
      const float mu = mn == -INFINITY ? 0.f : mn;
      const float al = __builtin_amdgcn_exp2f(m[rg] - mu);
      m[rg] = mn; l[rg] *= al;
#pragma unroll
      for (int dt = 0; dt < 4; ++dt) O[rg][dt] = O[rg][dt] * al;
      if (IMP) {
#pragma unroll
        for (int k = 0; k < 16; ++k) imp[rg][k] *= al;
        carry[rg] *= al;
      }
      float ps = 0.f;
#pragma unroll
      for (int mt = 0; mt < 4; ++mt)
#pragma unroll
        for (int r = 0; r < 4; ++r) { const float pv = __builtin_amdgcn_exp2f(S[rg][mt][r] - mu); S[rg][mt][r] = pv; ps += pv; }
      l[rg] += ps;
    } else {
      f32x2_t ps2 = {0.f, 0.f};
#pragma unroll
      for (int mt = 0; mt < 4; ++mt) {
#pragma unroll
        for (int r = 0; r < 4; ++r) S[rg][mt][r] = __builtin_amdgcn_exp2f(S[rg][mt][r]);
        ps2 += (f32x2_t){S[rg][mt][0], S[rg][mt][1]}; ps2 += (f32x2_t){S[rg][mt][2], S[rg][mt][3]};
      }
      const float ps = ps2[0] + ps2[1];
      l[rg] += ps; m[rg] = fmaxf(m[rg], ps);
    }
    if (IMP) {
      const int g = lane >> 4;
      float sh[4], nv[4];
#pragma unroll
      for (int mt = 0; mt < 4; ++mt) sh[mt] = __uint_as_float(__builtin_amdgcn_ds_bpermute(((lane + 48) & 63) << 2, __float_as_uint(S[rg][mt][3])));
#pragma unroll
      for (int mt = 0; mt < 4; ++mt) {
        const float own = (S[rg][mt][0] + S[rg][mt][1]) + (S[rg][mt][2] + S[rg][mt][3]);
        const float prev = g > 0 ? sh[mt] : (mt > 0 ? sh[mt > 0 ? mt - 1 : 0] : carry[rg]);
        nv[mt] = own + prev;
      }
      if (tile == 0) { imp[rg][0] = nv[0]; imp[rg][1] = nv[1]; imp[rg][2] = nv[2]; imp[rg][3] = nv[3]; }
      else if (tile == 1) { imp[rg][4] = nv[0]; imp[rg][5] = nv[1]; imp[rg][6] = nv[2]; imp[rg][7] = nv[3]; }
      else if (tile == 2) { imp[rg][8] = nv[0]; imp[rg][9] = nv[1]; imp[rg][10] = nv[2]; imp[rg][11] = nv[3]; }
      else { imp[rg][12] = nv[0]; imp[rg][13] = nv[1]; imp[rg][14] = nv[2]; imp[rg][15] = nv[3]; }
      carry[rg] = sh[3];
    }
#pragma unroll
    for (int ks = 0; ks < 2; ++ks) {
      pk[rg][ks][0] = cvtpk(S[rg][2 * ks][0], S[rg][2 * ks][1]); pk[rg][ks][1] = cvtpk(S[rg][2 * ks][2], S[rg][2 * ks][3]);
      pk[rg][ks][2] = cvtpk(S[rg][2 * ks + 1][0], S[rg][2 * ks + 1][1]); pk[rg][ks][3] = cvtpk(S[rg][2 * ks + 1][2], S[rg][2 * ks + 1][3]);
    }
  }
  __builtin_amdgcn_sched_barrier(0);
#define AT_PV(dt, ks, d0, d1) { const bf16x8 vf = (bf16x8){d0[0], d0[1], d0[2], d0[3], d1[0], d1[1], d1[2], d1[3]}; \
    _Pragma("unroll") for (int rg = 0; rg < NRG; ++rg) { const u32x4 pw = {pk[rg][ks][0], pk[rg][ks][1], pk[rg][ks][2], pk[rg][ks][3]}; \
      O[rg][dt] = __builtin_amdgcn_mfma_f32_16x16x32_bf16(vf, __builtin_bit_cast(bf16x8, pw), O[rg][dt], 0, 0, 0); } }
  LGKM0();
  AT_VRD(2, 0, c0, c1) AT_VRD(2, 1, c2, c3) AT_VRD(3, 0, c4, c5) AT_VRD(3, 1, c6, c7)
  __builtin_amdgcn_s_setprio(1);
  AT_PV(0, 0, a0, a1) AT_PV(0, 1, a2, a3) AT_PV(1, 0, a4, a5) AT_PV(1, 1, a6, a7)
  LGKM0();
  AT_PV(2, 0, c0, c1) AT_PV(2, 1, c2, c3) AT_PV(3, 0, c4, c5) AT_PV(3, 1, c6, c7)
  __builtin_amdgcn_s_setprio(0);
#undef AT_VRD
#undef AT_PV
}

template <int NRG, bool EDGE, bool SAFE>
__device__ __forceinline__ void at_tile(LAS const unsigned char* buf, const bf16x8 (&qf)[NRG][2], f32x4 (&O)[NRG][4], float (&m)[NRG], float (&l)[NRG],
                                        const float (&base)[NRG], const float (&soff)[NRG], const int (&lim)[NRG], const int (&lo)[NRG], int lane) {
  float dimp[NRG][16]; float dc[NRG];
  at_tile_x<NRG, EDGE, false, SAFE>(buf, qf, O, m, l, base, soff, lim, lo, lane, dimp, dc);
}

__device__ __forceinline__ bool at_any_bad(bool bad, LAS unsigned char* lds, int lane, int wid) {
  LAS unsigned* fl = (LAS unsigned*)(lds + AT_MISC + 320);
  const bool wb = __any(bad);
  if (lane == 0) fl[wid] = wb ? 1u : 0u;
  __syncthreads();
  unsigned a = 0u;
#pragma unroll
  for (int w = 0; w < 8; ++w) a |= fl[w];
  return __builtin_amdgcn_readfirstlane(a) != 0u;
}

template <bool SAFE>
__device__ __forceinline__ bool moba_mfma_item(const Params& P, int b, int h, int cur, unsigned char* smem_g) {
  LAS unsigned char* lds = (LAS unsigned char*)smem_g;
  const bf16_t* __restrict__ H0 = (const bf16_t*)(P.ws + WS_H);
  const float* __restrict__ KM = (const float*)(P.ws + WS_KM);
  bf16_t* __restrict__ MIX = (bf16_t*)(P.ws + WS_MIX);
  const int tid = otid(), lane = tid & 63, wid = __builtin_amdgcn_readfirstlane(tid >> 6), g = lane >> 4, i = lane & 15;
  const float slope2 = exp2f(-(float)(h + 1)) * LOG2E;
  const int t0 = cur * 256;
  int trow[2]; bf16x8 qf[2][2]; unsigned sel[2];
#pragma unroll
  for (int rg = 0; rg < 2; ++rg) {
    trow[rg] = t0 + wid * 32 + rg * 16 + i;
    const bf16_t* qp = H0 + ((size_t)b * S_ + trow[rg]) * P0 + C_MQ + h * 64 + 8 * g;
    qf[rg][0] = *(const bf16x8*)qp; qf[rg][1] = *(const bf16x8*)(qp + 32);
  }
  {
    LAS float* kml = (LAS float*)(lds + AT_STASH);
#pragma unroll
    for (int k = 0; k < 2; ++k) { const int e = tid + 512 * k, n = e >> 6; if (n < cur) kml[e] = KM[(((size_t)b * 16 + n) * 8 + h) * 64 + (e & 63)]; }
    __syncthreads();
#pragma unroll
    for (int rg = 0; rg < 2; ++rg) {
      float qv[16];
#pragma unroll
      for (int j = 0; j < 8; ++j) { qv[j] = bf2f((bf16_t)qf[rg][0][j]); qv[8 + j] = bf2f((bf16_t)qf[rg][1][j]); }
      float v1 = -INFINITY, v2 = -INFINITY, v3 = -INFINITY; int i1 = -1, i2 = -1, i3 = -1;
      for (int n = 0; n < cur; ++n) {
        LAS const float* kr = kml + n * 64 + 8 * g;
        const f32x4 a0 = *(LAS const f32x4*)kr, a1 = *(LAS const f32x4*)(kr + 4), b0 = *(LAS const f32x4*)(kr + 32), b1 = *(LAS const f32x4*)(kr + 36);
        float d = qv[0] * a0[0] + qv[1] * a0[1] + qv[2] * a0[2] + qv[3] * a0[3] + qv[4] * a1[0] + qv[5] * a1[1] + qv[6] * a1[2] + qv[7] * a1[3]
                + qv[8] * b0[0] + qv[9] * b0[1] + qv[10] * b0[2] + qv[11] * b0[3] + qv[12] * b1[0] + qv[13] * b1[1] + qv[14] * b1[2] + qv[15] * b1[3];
        d = xsum<16>(d); d = xsum<32>(d);
        if (d > v1) { v3 = v2; i3 = i2; v2 = v1; i2 = i1; v1 = d; i1 = n; }
        else if (d > v2) { v3 = v2; i3 = i2; v2 = d; i2 = n; }
        else if (d > v3) { v3 = d; i3 = n; }
      }
      unsigned mk = 0u;
      if (i1 >= 0) mk |= 1u << i1;
      if (i2 >= 0) mk |= 1u << i2;
      if (i3 >= 0) mk |= 1u << i3;
      sel[rg] = mk;
    }
  }
  {
    unsigned u = sel[0] | sel[1];
    u = xorr<1>(u); u = xorr<2>(u); u = xorr<4>(u); u = xorr<8>(u);
    LAS unsigned* misc = (LAS unsigned*)(lds + AT_MISC);
    if (lane == 0) misc[wid] = u;
  }
  __syncthreads();
  unsigned umask = 0u;
  {
    LAS unsigned* misc = (LAS unsigned*)(lds + AT_MISC);
#pragma unroll
    for (int w = 0; w < 8; ++w) umask |= misc[w];
  }
  umask = __builtin_amdgcn_readfirstlane(umask);
  const int npast = __builtin_popcount(umask);
  const int nt = 4 * npast + 4;
  f32x4 O[2][4]; float m[2], l[2];
#pragma unroll
  for (int rg = 0; rg < 2; ++rg) { m[rg] = SAFE ? -INFINITY : 0.f; l[rg] = 0.f;
#pragma unroll
    for (int dt = 0; dt < 4; ++dt) O[rg][dt] = (f32x4){0.f, 0.f, 0.f, 0.f}; }
  const bf16_t* Kg = H0 + (size_t)b * S_ * P0 + C_MK + h * 64;
  const bf16_t* Vg = H0 + (size_t)b * S_ * P0 + C_MV + h * 64;
  LAS int* tl = (LAS int*)(lds + AT_TL);
  if (tid < nt) {
    int k0v;
    if (tid < 4 * npast) { unsigned r = umask; for (int q = 0; q < (tid >> 2); ++q) r &= r - 1; k0v = __builtin_ctz(r) * 256 + (tid & 3) * 64; }
    else k0v = cur * 256 + (tid - 4 * npast) * 64;
    tl[tid] = k0v;
  }
  asm volatile("s_waitcnt vmcnt(0)" ::: "memory");
  __syncthreads();
#pragma unroll
  for (int st = 0; st < 3; ++st) if (st < nt) { const int k0s = tl[st]; at_stage_dma(lds + st * AT_BUF, Kg + (size_t)k0s * P0, Vg + (size_t)k0s * P0, P0, lane, wid); }
  const int ntp = 4 * npast;
#pragma unroll 1
  for (int ti = 0; ti < ntp; ++ti) {
    ring_wait(min(nt - 1 - ti, 2));
    if (ti + 3 < nt) { const int k0n = tl[ti + 3]; at_stage_dma(lds + ((ti + 3) & 3) * AT_BUF, Kg + (size_t)k0n * P0, Vg + (size_t)k0n * P0, P0, lane, wid); }
    const int ck0 = __builtin_amdgcn_readfirstlane(tl[ti]), cblk = ck0 >> 8;
    LAS const unsigned char* buf = lds + (ti & 3) * AT_BUF;
    float base[2], soff[2]; int lim[2], lo[2];
#pragma unroll
    for (int rg = 0; rg < 2; ++rg) {
      const bool rs = (sel[rg] >> cblk) & 1u;
      base[rg] = rs ? slope2 * (float)(ck0 + 4 * g - trow[rg]) : -INFINITY;
      soff[rg] = slope2; lim[rg] = 0; lo[rg] = 0;
    }
    at_tile<2, false, SAFE>(buf, qf, O, m, l, base, soff, lim, lo, lane);
  }
#pragma unroll 1
  for (int ti = ntp; ti < nt; ++ti) {
    ring_wait(min(nt - 1 - ti, 2));
    if (ti + 3 < nt) { const int k0n = tl[ti + 3]; at_stage_dma(lds + ((ti + 3) & 3) * AT_BUF, Kg + (size_t)k0n * P0, Vg + (size_t)k0n * P0, P0, lane, wid); }
    const int ck0 = __builtin_amdgcn_readfirstlane(tl[ti]);
    if (ck0 > t0 + wid * 32 + 31) continue;
    LAS const unsigned char* buf = lds + (ti & 3) * AT_BUF;
    float base[2], soff[2]; int lim[2], lo[2];
#pragma unroll
    for (int rg = 0; rg < 2; ++rg) {
      base[rg] = slope2 * (float)(ck0 + 4 * g - trow[rg]);
      soff[rg] = slope2; lim[rg] = trow[rg] - ck0 - 4 * g; lo[rg] = -1000000;
    }
    at_tile<2, true, SAFE>(buf, qf, O, m, l, base, soff, lim, lo, lane);
  }
  float ltot[2];
#pragma unroll
  for (int rg = 0; rg < 2; ++rg) { float lt = l[rg]; lt = xsum<16>(lt); lt = xsum<32>(lt); ltot[rg] = lt; }
  if (SAFE) __builtin_amdgcn_s_barrier();
  else if (at_any_bad((m[0] > AT_LIM) | (m[1] > AT_LIM) | !(ltot[0] >= AT_TINY) | !(ltot[1] >= AT_TINY), lds, lane, wid)) return true;
#pragma unroll
  for (int rg = 0; rg < 2; ++rg) {
    const float lt = ltot[rg];
    const float inv = 1.f / lt;
    const size_t row = (size_t)b * S_ + trow[rg];
#pragma unroll
    for (int dt = 0; dt < 4; ++dt) {
      const int dv = 16 * dt + 4 * g;
      const ushort4 zz = *(const ushort4*)(H0 + row * P0 + C_MZ + h * 64 + dv);
      ushort4 ov;
      ov.x = f2bf(O[rg][dt][0] * inv * silu_f(bf2f(zz.x))); ov.y = f2bf(O[rg][dt][1] * inv * silu_f(bf2f(zz.y)));
      ov.z = f2bf(O[rg][dt][2] * inv * silu_f(bf2f(zz.z))); ov.w = f2bf(O[rg][dt][3] * inv * silu_f(bf2f(zz.w)));
      *(ushort4*)(MIX + row * D_ + 512 + h * 64 + dv) = ov;
    }
  }
  return false;
}


constexpr size_t WS_KCB = 248 * MiB;
constexpr size_t WS_VCB = 249 * MiB;
template <bool SAFE>
__device__ __forceinline__ bool nsa_mfma_item(const Params& P, int b, int grp, int sb, unsigned char* smem_g) {
  LAS unsigned char* lds = (LAS unsigned char*)smem_g;
  const bf16_t* __restrict__ H0 = (const bf16_t*)(P.ws + WS_H);
  bf16_t* __restrict__ MIX = (bf16_t*)(P.ws + WS_MIX);
  const int tid = otid(), lane = tid & 63, wid = __builtin_amdgcn_readfirstlane(tid >> 6), g = lane >> 4, i = lane & 15;
  const int t0 = sb * 64;
  int trow[2]; bf16x8 qf[2][2];
  const int hh = grp * 4 + (i & 3);
  const float slope2 = exp2f(-(float)(hh + 1)) * LOG2E;
  const bf16_t* __restrict__ Hb = H0 + (size_t)b * S_ * P0;
#pragma unroll
  for (int rg = 0; rg < 2; ++rg) {
    trow[rg] = t0 + wid * 8 + rg * 4 + (i >> 2);
    const unsigned qo = (unsigned)trow[rg] * P0 + C_NQ + hh * 64 + 8 * g;
    qf[rg][0] = *(const bf16x8*)(Hb + qo); qf[rg][1] = *(const bf16x8*)(Hb + qo + 32);
  }
  LAS f32x4* stash = (LAS f32x4*)(lds + AT_STASH) + tid;
  f32x4 O[2][4]; float m[2], l[2];
  unsigned mlo[2], mhi[2];
  bool bad = false;
  const int ntc = ((4 * sb + 2) >> 6) + 1;
  {
    const bf16_t* Kg = (const bf16_t*)(P.ws + WS_KCB) + (size_t)(b * 2 + grp) * 256 * 64;
    const bf16_t* Vg = (const bf16_t*)(P.ws + WS_VCB) + (size_t)(b * 2 + grp) * 256 * 64;
    asm volatile("s_waitcnt vmcnt(0)" ::: "memory");
#pragma unroll
    for (int tile = 0; tile < 4; ++tile) if (tile < ntc) at_stage_dma(lds + tile * AT_BUF, Kg + tile * 4096, Vg + tile * 4096, 64, lane, wid);
  }
#pragma unroll
  for (int rg = 0; rg < 2; ++rg) {
    float imp[1][16], carry[1], m1[1], l1[1]; f32x4 O1[1][4]; bf16x8 q1[1][2];
    q1[0][0] = qf[rg][0]; q1[0][1] = qf[rg][1];
    m1[0] = SAFE ? -INFINITY : 0.f; l1[0] = 0.f; carry[0] = 0.f;
#pragma unroll
    for (int k = 0; k < 16; ++k) imp[0][k] = 0.f;
#pragma unroll
    for (int dt = 0; dt < 4; ++dt) O1[0][dt] = (f32x4){0.f, 0.f, 0.f, 0.f};
#pragma unroll 1
    for (int tile = 0; tile < ntc; ++tile) {
      if (rg == 0) ring_wait(ntc - 1 - tile);
      LAS const unsigned char* buf = lds + tile * AT_BUF;
      float base[1], soff[1]; int lim[1], lo[1];
      const int nlim = trow[rg] >= 31 ? ((trow[rg] - 31) >> 4) : -1;
      base[0] = slope2 * (float)(16 * (64 * tile + 4 * g) + 31 - trow[rg]);
      soff[0] = 16.f * slope2; lim[0] = nlim - 64 * tile - 4 * g; lo[0] = -1000000;
      at_tile_x<1, true, true, SAFE>(buf, q1, O1, m1, l1, base, soff, lim, lo, lane, imp, carry, tile);
    }
    {
      float lt = l1[0]; lt = xsum<16>(lt); lt = xsum<32>(lt);
      if (!SAFE) bad |= (m1[0] > AT_LIM) | (trow[rg] >= 31 && !(lt >= AT_TINY));
      const float inv = lt > 0.f ? 1.f / lt : 0.f;
      const float g0 = sigmoid_f(bf2f(Hb[(unsigned)trow[rg] * P0 + C_NG + hh * 3 + 0]));
#pragma unroll
      for (int dt = 0; dt < 4; ++dt) stash[(rg * 4 + dt) * 512] = O1[0][dt] * (g0 * inv);
      if (sb < 16) { mlo[rg] = (1u << (sb + 1)) - 1u; mhi[rg] = 0u; }
      else {
        float key[16];
#pragma unroll
        for (int k = 0; k < 16; ++k) {
          float v = imp[0][k] * inv; v = xsum<1>(v); v = xsum<2>(v);
          const int sidx = 4 * k + g;
          const bool forced = (sidx == 0) || (sidx == sb) || (sidx == sb - 1);
          key[k] = (sidx <= sb) ? (forced ? 1e9f : v) : -1e30f;
        }
        const int j = i & 3;
        float mykey[4]; int mys[4], rank[4];
#pragma unroll
        for (int q = 0; q < 4; ++q) {
          mykey[q] = j == 0 ? key[q] : (j == 1 ? key[4 + q] : (j == 2 ? key[8 + q] : key[12 + q]));
          mys[q] = 4 * (4 * j + q) + g; rank[q] = 0;
        }
#pragma unroll 1
        for (int gg = 0; gg < 4; ++gg)
#pragma unroll
          for (int kk = 0; kk < 16; ++kk) {
            const float other = __uint_as_float(__builtin_amdgcn_ds_bpermute((gg * 16 + i) << 2, __float_as_uint(key[kk])));
            const int sp = 4 * kk + gg;
#pragma unroll
            for (int q = 0; q < 4; ++q) rank[q] += (other > mykey[q] || (other == mykey[q] && sp < mys[q])) ? 1 : 0;
          }
        unsigned a = 0u, bb = 0u;
#pragma unroll
        for (int q = 0; q < 4; ++q) if (rank[q] < 16 && mys[q] <= sb) { if (mys[q] < 32) a |= 1u << mys[q]; else bb |= 1u << (mys[q] - 32); }
        a = xorr<1>(a); bb = xorr<1>(bb); a = xorr<2>(a); bb = xorr<2>(bb);
        a = xorr<16>(a); bb = xorr<16>(bb); a = xorr<32>(a); bb = xorr<32>(bb);
        mlo[rg] = a; mhi[rg] = bb;
      }
    }
  }
  {
    unsigned ua = mlo[0] | mlo[1], ub = mhi[0] | mhi[1];
    ua = xorr<4>(ua); ub = xorr<4>(ub); ua = xorr<8>(ua); ub = xorr<8>(ub);
    LAS unsigned* misc = (LAS unsigned*)(lds + AT_MISC);
    if (lane == 0) { misc[2 * wid] = ua; misc[2 * wid + 1] = ub; }
    __syncthreads();
    ua = 0u; ub = 0u;
#pragma unroll
    for (int w = 0; w < 8; ++w) { ua |= misc[2 * w]; ub |= misc[2 * w + 1]; }
    unsigned long long rem = ((unsigned long long)(unsigned)__builtin_amdgcn_readfirstlane(ub) << 32) | (unsigned)__builtin_amdgcn_readfirstlane(ua);
    const int nt = __builtin_popcountll(rem);
#pragma unroll
    for (int rg = 0; rg < 2; ++rg) { m[rg] = SAFE ? -INFINITY : 0.f; l[rg] = 0.f;
#pragma unroll
      for (int dt = 0; dt < 4; ++dt) O[rg][dt] = (f32x4){0.f, 0.f, 0.f, 0.f}; }
    const bf16_t* Kg = Hb + C_KSEL + grp * 64;
    const bf16_t* Vg = Hb + C_VSEL + grp * 64;
    LAS int* tl = (LAS int*)(lds + AT_TL);
    if (tid < nt) { unsigned long long r = rem; for (int q = 0; q < tid; ++q) r &= r - 1; tl[tid] = __builtin_ctzll(r); }
    asm volatile("s_waitcnt vmcnt(0)" ::: "memory");
    __syncthreads();
#pragma unroll
    for (int st = 0; st < 3; ++st) if (st < nt) { const int bs = tl[st]; at_stage_dma(lds + st * AT_BUF, Kg + (size_t)bs * 64 * P0, Vg + (size_t)bs * 64 * P0, P0, lane, wid); }
#define NSA_SEL_STEP(EDGEV) { \
      ring_wait(min(nt - 1 - ti, 2)); \
      if (ti + 3 < nt) { const int bn = tl[ti + 3]; at_stage_dma(lds + ((ti + 3) & 3) * AT_BUF, Kg + (size_t)bn * 64 * P0, Vg + (size_t)bn * 64 * P0, P0, lane, wid); } \
      const int cblk = __builtin_amdgcn_readfirstlane(tl[ti]); \
      LAS const unsigned char* buf = lds + (ti & 3) * AT_BUF; \
      float base[2], soff[2]; int lim[2], lo[2]; \
      _Pragma("unroll") for (int rg = 0; rg < 2; ++rg) { \
        const bool rs = cblk < 32 ? ((mlo[rg] >> cblk) & 1u) : ((mhi[rg] >> (cblk - 32)) & 1u); \
        base[rg] = rs ? slope2 * (float)(cblk * 64 + 4 * g - trow[rg]) : -INFINITY; \
        soff[rg] = slope2; lim[rg] = trow[rg] - cblk * 64 - 4 * g; lo[rg] = -1000000; \
      } \
      at_tile<2, EDGEV, SAFE>(buf, qf, O, m, l, base, soff, lim, lo, lane); }
    int ti = 0;
#pragma unroll 1
    for (; ti < nt - 1; ++ti) NSA_SEL_STEP(false)
    NSA_SEL_STEP(true)
#undef NSA_SEL_STEP
    __builtin_amdgcn_s_barrier();
#pragma unroll
    for (int rg = 0; rg < 2; ++rg) {
      float lt = l[rg]; lt = xsum<16>(lt); lt = xsum<32>(lt);
      if (!SAFE) bad |= (m[rg] > AT_LIM) | !(lt >= AT_TINY);
      const float g1 = sigmoid_f(bf2f(Hb[(unsigned)trow[rg] * P0 + C_NG + hh * 3 + 1]));
#pragma unroll
      for (int dt = 0; dt < 4; ++dt) stash[(rg * 4 + dt) * 512] += O[rg][dt] * (g1 / lt);
    }
  }
  {
    const int b0 = sb >= 8 ? sb - 8 : 0;
    const int nt = sb - b0 + 1;
#pragma unroll
    for (int rg = 0; rg < 2; ++rg) { m[rg] = SAFE ? -INFINITY : 0.f; l[rg] = 0.f;
#pragma unroll
      for (int dt = 0; dt < 4; ++dt) O[rg][dt] = (f32x4){0.f, 0.f, 0.f, 0.f}; }
    const bf16_t* Kg = Hb + C_KWIN + grp * 64;
    const bf16_t* Vg = Hb + C_VWIN + grp * 64;
    asm volatile("s_waitcnt vmcnt(0)" ::: "memory");
#pragma unroll
    for (int st = 0; st < 3; ++st) if (st < nt) at_stage_dma(lds + st * AT_BUF, Kg + (size_t)(b0 + st) * 64 * P0, Vg + (size_t)(b0 + st) * 64 * P0, P0, lane, wid);
#define NSA_WIN_STEP(EDGEV) { \
      ring_wait(min(nt - 1 - ti, 2)); \
      const int cblk = b0 + ti; \
      if (ti + 3 < nt) at_stage_dma(lds + ((ti + 3) & 3) * AT_BUF, Kg + (size_t)(cblk + 3) * 64 * P0, Vg + (size_t)(cblk + 3) * 64 * P0, P0, lane, wid); \
      LAS const unsigned char* buf = lds + (ti & 3) * AT_BUF; \
      float base[2], soff[2]; int lim[2], lo[2]; \
      _Pragma("unroll") for (int rg = 0; rg < 2; ++rg) { \
        base[rg] = slope2 * (float)(cblk * 64 + 4 * g - trow[rg]); \
        soff[rg] = slope2; lim[rg] = trow[rg] - cblk * 64 - 4 * g; lo[rg] = trow[rg] - 511 - cblk * 64 - 4 * g; \
      } \
      at_tile<2, EDGEV, SAFE>(buf, qf, O, m, l, base, soff, lim, lo, lane); }
    int ti = 0;
    if (sb >= 8) { NSA_WIN_STEP(true) ++ti; }
#pragma unroll 1
    for (; ti < nt - 1; ++ti) NSA_WIN_STEP(false)
    NSA_WIN_STEP(true)
#undef NSA_WIN_STEP
  }
  float ltot[2];
#pragma unroll
  for (int rg = 0; rg < 2; ++rg) { float lt = l[rg]; lt = xsum<16>(lt); lt = xsum<32>(lt); ltot[rg] = lt; }
  if (SAFE) __builtin_amdgcn_s_barrier();
  else if (at_any_bad(bad | (m[0] > AT_LIM) | (m[1] > AT_LIM) | !(ltot[0] >= AT_TINY) | !(ltot[1] >= AT_TINY), lds, lane, wid)) return true;
#pragma unroll
  for (int rg = 0; rg < 2; ++rg) {
    const float lt = ltot[rg];
    const unsigned ro = (unsigned)trow[rg] * P0;
    const float g2 = sigmoid_f(bf2f(Hb[ro + C_NG + hh * 3 + 2])) / lt;
#pragma unroll
    for (int dt = 0; dt < 4; ++dt) {
      const int dv = 16 * dt + 4 * g;
      const ushort4 zz = *(const ushort4*)(Hb + ro + C_NZ + hh * 64 + dv);
      const f32x4 ov = stash[(rg * 4 + dt) * 512] + O[rg][dt] * g2;
      ushort4 o4;
      o4.x = f2bf(ov[0] * silu_f(bf2f(zz.x))); o4.y = f2bf(ov[1] * silu_f(bf2f(zz.y)));
      o4.z = f2bf(ov[2] * silu_f(bf2f(zz.z))); o4.w = f2bf(ov[3] * silu_f(bf2f(zz.w)));
      *(ushort4*)(MIX + (size_t)b * S_ * D_ + (unsigned)trow[rg] * D_ + hh * 64 + dv) = o4;
    }
  }
  return false;
}

__device__ __forceinline__ void gla_gate_phase(const Params& P) {
  const bf16_t* H1 = (const bf16_t*)(P.ws + WS_H);
  float* G = (float*)(P.ws + WS_G);
  const float* w2 = P.in[10]; const float* gb = P.in[11];
  const size_t total = (size_t)M_ * 512;
  for (size_t i = (size_t)blockIdx.x * 512 + otid(); i < total; i += (size_t)gridDim.x * 512) {
    const int c = (int)(i & 511); const size_t row = i >> 9;
    float x = gb[c];
#pragma unroll
    for (int r = 0; r < 16; ++r) x += bf2f(H1[row * P1 + G_LR + r]) * w2[r * 512 + c];
    const float ls = fminf(x, 0.f) - log1pf(__expf(-fabsf(x)));
    G[i] = ls * (1.f / 16.f);
  }
}
__device__ __forceinline__ void gla_scan_vblock(const Params& P, int vb) {
  const bf16_t* __restrict__ H1 = (const bf16_t*)(P.ws + WS_H);
  const float* __restrict__ G = (const float*)(P.ws + WS_G);
  bf16_t* __restrict__ O = (bf16_t*)(P.ws + WS_XB);
  const int tid = otid(), lane = tid & 63, wid = tid >> 6;
  const int eh = vb & 1, h = (vb >> 1) & 3, b = vb >> 3;
  const int e = eh * 128 + wid * 16 + (lane >> 2), dq = lane & 3;
  float St[32];
#pragma unroll
  for (int i = 0; i < 32; ++i) St[i] = 0.f;
  const float qscale = 0.08838834764831845f;
  for (int t = 0; t < S_; ++t) {
    const size_t row = (size_t)b * S_ + t;
    const float4* gr = (const float4*)(G + row * 512 + h * 128 + dq * 32);
    const uint4* kr = (const uint4*)(H1 + row * P1 + G_K + h * 128 + dq * 32);
    const uint4* qr = (const uint4*)(H1 + row * P1 + G_Q + h * 128 + dq * 32);
    const float v = bf2f(H1[row * P1 + G_V + h * 256 + e]);
    float o = 0.f;
#pragma unroll
    for (int c = 0; c < 4; ++c) {
      const uint4 ku = kr[c], qu = qr[c];
      const float4 g0 = gr[2 * c], g1 = gr[2 * c + 1];
      const float kk[8] = {__uint_as_float(ku.x << 16), __uint_as_float(ku.x & 0xffff0000u), __uint_as_float(ku.y << 16), __uint_as_float(ku.y & 0xffff0000u),
                           __uint_as_float(ku.z << 16), __uint_as_float(ku.z & 0xffff0000u), __uint_as_float(ku.w << 16), __uint_as_float(ku.w & 0xffff0000u)};
      const float qq[8] = {__uint_as_float(qu.x << 16), __uint_as_float(qu.x & 0xffff0000u), __uint_as_float(qu.y << 16), __uint_as_float(qu.y & 0xffff0000u),
                           __uint_as_float(qu.z << 16), __uint_as_float(qu.z & 0xffff0000u), __uint_as_float(qu.w << 16), __uint_as_float(qu.w & 0xffff0000u)};
      const float gg[8] = {g0.x, g0.y, g0.z, g0.w, g1.x, g1.y, g1.z, g1.w};
#pragma unroll
      for (int i = 0; i < 8; ++i) {
        const float a = __expf(gg[i]);
        St[c * 8 + i] = a * St[c * 8 + i] + kk[i] * v;
        o += qq[i] * St[c * 8 + i];
      }
    }
    o = xsum<1>(o); o = xsum<2>(o);
    if (dq == 0) O[row * D_ + h * 256 + e] = f2bf(o * qscale);
  }
}

constexpr int CTL_GLA = 16384;
constexpr size_t WS_QT = WS_G;
constexpr size_t WS_KH = WS_G + 16 * MiB;
constexpr size_t WS_ATT = 190 * MiB;
constexpr size_t WS_DEC = 199 * MiB;
__device__ __forceinline__ int kperm(int x) { const int dl = x & 31, hi = dl >> 4, d2 = dl & 15; return (x & ~31) + 8 * (d2 >> 2) + 4 * hi + (d2 & 3); }

__device__ __forceinline__ void st8_wt(void* p, unsigned lo, unsigned hi) {
  __hip_atomic_store((unsigned long long*)p, ((unsigned long long)hi << 32) | lo, __ATOMIC_RELAXED, __HIP_MEMORY_SCOPE_AGENT);
}
__device__ __forceinline__ void gla_prep_item(const Params& P, int item, unsigned char* smem_g) {
  const bf16_t* __restrict__ H1 = (const bf16_t*)(P.ws + WS_H);
  bf16_t* __restrict__ QT = (bf16_t*)(P.ws + WS_QT) + (size_t)item * 8192;
  bf16_t* __restrict__ KH = (bf16_t*)(P.ws + WS_KH) + (size_t)item * 8192;
  bf16_t* __restrict__ ATT = (bf16_t*)(P.ws + WS_ATT) + (size_t)item * 4096;
  float* __restrict__ DEC = (float*)(P.ws + WS_DEC) + (size_t)item * 128;
  const int tid = otid(), lane = tid & 63, wid = tid >> 6, g = lane >> 4, i = lane & 15;
  const int c = item & 63, h = (item >> 6) & 3, b = item >> 8;
  const size_t rowbase = (size_t)b * S_ + c * 64;
  float* glr = (float*)smem_g;
  float* tot = (float*)(smem_g + 4096);
  bf16_t* qs = (bf16_t*)(smem_g + 12288);
  bf16_t* ks = (bf16_t*)(smem_g + 12288 + 17408);
  const int d0 = (tid & 31) * 4, rgp = tid >> 5;
#pragma unroll
  for (int k = 0; k < 2; ++k) { const int e = tid + 512 * k; glr[e] = ((const float*)(P.ws + WS_GLR))[rowbase * 16 + e]; }
  uint2 qraw[4], kraw[4];
#pragma unroll
  for (int k = 0; k < 4; ++k) {
    qraw[k] = *(const uint2*)(H1 + (rowbase + 4 * rgp + k) * P1 + G_Q + h * 128 + d0);
    kraw[k] = *(const uint2*)(H1 + (rowbase + 4 * rgp + k) * P1 + G_K + h * 128 + d0);
  }
  float4 w[16];
#pragma unroll
  for (int r = 0; r < 16; ++r) w[r] = *(const float4*)(P.in[10] + r * 512 + h * 128 + d0);
  const float4 gb = *(const float4*)(P.in[11] + h * 128 + d0);
  __syncthreads();
  float bb[4][4];
  float run[4] = {0.f, 0.f, 0.f, 0.f};
#pragma unroll
  for (int k = 0; k < 4; ++k) {
    const float* gr = glr + (4 * rgp + k) * 16;
    float x[4] = {gb.x, gb.y, gb.z, gb.w};
#pragma unroll
    for (int r = 0; r < 16; ++r) { const float gv = gr[r]; x[0] += gv * w[r].x; x[1] += gv * w[r].y; x[2] += gv * w[r].z; x[3] += gv * w[r].w; }
#pragma unroll
    for (int j = 0; j < 4; ++j) {
      const float la = (fminf(x[j], 0.f) - __logf(1.f + __expf(-fabsf(x[j])))) * (1.f / 16.f);
      run[j] += la; bb[k][j] = run[j];
    }
  }
  *(float4*)(tot + rgp * 128 + d0) = (float4){run[0], run[1], run[2], run[3]};
  __syncthreads();
  float off[4] = {0.f, 0.f, 0.f, 0.f}, total[4] = {0.f, 0.f, 0.f, 0.f};
#pragma unroll
  for (int q = 0; q < 16; ++q) {
    const float4 tv = *(const float4*)(tot + q * 128 + d0);
    total[0] += tv.x; total[1] += tv.y; total[2] += tv.z; total[3] += tv.w;
    if (q < rgp) { off[0] += tv.x; off[1] += tv.y; off[2] += tv.z; off[3] += tv.w; }
  }
  const float qscale = 0.08838834764831845f;
  const int dp = kperm(d0);
#pragma unroll
  for (int k = 0; k < 4; ++k) {
    const int r = 4 * rgp + k;
    const float qv[4] = {__uint_as_float(qraw[k].x << 16), __uint_as_float(qraw[k].x & 0xffff0000u), __uint_as_float(qraw[k].y << 16), __uint_as_float(qraw[k].y & 0xffff0000u)};
    const float kv[4] = {__uint_as_float(kraw[k].x << 16), __uint_as_float(kraw[k].x & 0xffff0000u), __uint_as_float(kraw[k].y << 16), __uint_as_float(kraw[k].y & 0xffff0000u)};
    float qt[4], kt[4], kh[4];
#pragma unroll
    for (int j = 0; j < 4; ++j) {
      const float bv = bb[k][j] + off[j];
      const float eb = __expf(bv);
      qt[j] = qv[j] * eb * qscale; kt[j] = kv[j] * __expf(-bv); kh[j] = kv[j] * __expf(total[j] - bv);
    }
    const unsigned q01 = cvtpk(qt[0], qt[1]), q23 = cvtpk(qt[2], qt[3]), k01 = cvtpk(kt[0], kt[1]), k23 = cvtpk(kt[2], kt[3]);
    *(uint2*)(qs + r * 136 + d0) = (uint2){q01, q23};
    *(uint2*)(ks + r * 136 + d0) = (uint2){k01, k23};
    st8_wt(QT + r * 128 + dp, q01, q23);
    st8_wt(KH + r * 128 + d0, cvtpk(kh[0], kh[1]), cvtpk(kh[2], kh[3]));
  }
  if (rgp == 0) {
    st8_wt(DEC + d0, __float_as_uint(__expf(total[0])), __float_as_uint(__expf(total[1])));
    st8_wt(DEC + d0 + 2, __float_as_uint(__expf(total[2])), __float_as_uint(__expf(total[3])));
  }
  __syncthreads();
  {
    const int it = wid >> 1, jt0 = 2 * (wid & 1);
    f32x4 acc[2] = {(f32x4){0.f, 0.f, 0.f, 0.f}, (f32x4){0.f, 0.f, 0.f, 0.f}};
#pragma unroll
    for (int kk = 0; kk < 4; ++kk) {
      const bf16x8 qa = *(const bf16x8*)(qs + (16 * it + i) * 136 + 32 * kk + 8 * g);
#pragma unroll
      for (int n = 0; n < 2; ++n) {
        const bf16x8 kf = *(const bf16x8*)(ks + (16 * (jt0 + n) + i) * 136 + 32 * kk + 8 * g);
        acc[n] = __builtin_amdgcn_mfma_f32_16x16x32_bf16(kf, qa, acc[n], 0, 0, 0);
      }
    }
#pragma unroll
    for (int n = 0; n < 2; ++n) {
      const int ri = 16 * it + i, cj0 = 16 * (jt0 + n) + 4 * g;
      float v[4];
#pragma unroll
      for (int r = 0; r < 4; ++r) v[r] = (cj0 + r <= ri) ? acc[n][r] : 0.f;
      st8_wt(ATT + ri * 64 + kperm(cj0), cvtpk(v[0], v[1]), cvtpk(v[2], v[3]));
    }
  }
  asm volatile("s_waitcnt vmcnt(0)" ::: "memory");
  __syncthreads();
  if (tid == 0) __hip_atomic_store((unsigned*)P.ws + CTL_GLA + 64 * item, 1u, __ATOMIC_RELAXED, __HIP_MEMORY_SCOPE_AGENT);
}
__device__ __forceinline__ void gla_wait_items(const Params& P, int first, int n, int tid) {
  if (tid < n) {
    unsigned* f = (unsigned*)P.ws + CTL_GLA + 64 * (first + tid);
    unsigned sp = 0;
    while (__hip_atomic_load(f, __ATOMIC_RELAXED, __HIP_MEMORY_SCOPE_AGENT) == 0u) { __builtin_amdgcn_s_sleep(2); if (++sp > (1u << 22)) break; }
  }
  __syncthreads();
}
constexpr int GS_Q = 0, GS_K = 16384, GS_V = 32768, GS_A = 49152, GS_D = 57344, GS_BYTES = 57856;
__device__ __forceinline__ void gla_stage_dma(LAS unsigned char* st, const Params& P, int item, size_t rowbase, int h, int eh, int lane, int wid) {
  const bf16_t* QT = (const bf16_t*)(P.ws + WS_QT) + (size_t)item * 8192;
  const bf16_t* KH = (const bf16_t*)(P.ws + WS_KH) + (size_t)item * 8192;
  const bf16_t* ATT = (const bf16_t*)(P.ws + WS_ATT) + (size_t)item * 4096;
  const bf16_t* V = (const bf16_t*)(P.ws + WS_H) + rowbase * P1 + G_V + h * 256 + eh * 128;
#pragma unroll
  for (int n = 0; n < 2; ++n) {
    const int q = 2 * wid + n;
    { const int row = 4 * q + (lane >> 4), ch = (lane & 15) ^ (row & 15);
      __builtin_amdgcn_global_load_lds((const unsigned*)(QT + row * 128 + ch * 8), (LAS unsigned*)(st + GS_Q + q * 1024), 16, 0, 0); }
    { const int dt = q >> 1, j = 32 * (q & 1) + (lane >> 1);
      __builtin_amdgcn_global_load_lds((const unsigned*)(KH + j * 128 + dt * 16 + (lane & 1) * 8), (LAS unsigned*)(st + GS_K + q * 1024), 16, 0, 0);
      __builtin_amdgcn_global_load_lds((const unsigned*)(V + (unsigned)j * P1 + dt * 16 + (lane & 1) * 8), (LAS unsigned*)(st + GS_V + q * 1024), 16, 0, 0); }
  }
  { const int row = 8 * wid + (lane >> 3), ch = (lane & 7) ^ ((row >> 1) & 7);
    __builtin_amdgcn_global_load_lds((const unsigned*)(ATT + row * 64 + ch * 8), (LAS unsigned*)(st + GS_A + wid * 1024), 16, 0, 0); }
  if (wid < 2) __builtin_amdgcn_global_load_lds((const unsigned*)((const float*)(P.ws + WS_DEC) + (size_t)item * 128 + wid * 64 + lane), (LAS unsigned*)(st + GS_D + wid * 256), 4, 0, 0);
}
__device__ __forceinline__ void gla_chain(const Params& P, int chain, unsigned char* smem_g) {
  LAS unsigned char* lds = (LAS unsigned char*)smem_g;
  bf16_t* __restrict__ O = (bf16_t*)(P.ws + WS_XB);
  const int tid = otid(), lane = tid & 63, wid = __builtin_amdgcn_readfirstlane(tid >> 6), g = lane >> 4, i = lane & 15;
  const int eh = chain & 1, h = (chain >> 1) & 3, b = chain >> 3;
  const int item0 = (b * 4 + h) * 64;
  f32x4 S[8];
#pragma unroll
  for (int dt = 0; dt < 8; ++dt) S[dt] = (f32x4){0.f, 0.f, 0.f, 0.f};
  gla_wait_items(P, item0, 9, tid);
  gla_stage_dma(lds, P, item0, (size_t)b * S_, h, eh, lane, wid);
  __syncthreads();
  for (int c = 0; c < 64; ++c) {
    if ((c & 7) == 0 && c > 0) gla_wait_items(P, item0 + c + 1, (64 - (c + 1)) < 8 ? (64 - (c + 1)) : 8, tid);
    if (c + 1 < 64) gla_stage_dma(lds + ((c + 1) & 1) * GS_BYTES, P, item0 + c + 1, (size_t)b * S_ + (c + 1) * 64, h, eh, lane, wid);
    LAS const unsigned char* st = lds + (c & 1) * GS_BYTES;
    f32x4 dc[8];
#pragma unroll
    for (int dt = 0; dt < 8; ++dt) dc[dt] = *(LAS const f32x4*)(st + GS_D + (16 * dt + 4 * g) * 4);
    u32x4 spk[4];
#pragma unroll
    for (int kk = 0; kk < 4; ++kk) {
      spk[kk][0] = cvtpk(S[2 * kk][0], S[2 * kk][1]); spk[kk][1] = cvtpk(S[2 * kk][2], S[2 * kk][3]);
      spk[kk][2] = cvtpk(S[2 * kk + 1][0], S[2 * kk + 1][1]); spk[kk][3] = cvtpk(S[2 * kk + 1][2], S[2 * kk + 1][3]);
    }
    bf16x8 vf[2];
    const unsigned trb = (unsigned)(unsigned long long)st + (4 * g + (i >> 2)) * 32 + (i & 3) * 8;
    {
      const unsigned vb = trb + GS_V + wid * 2048;
      const s16x4 v0 = vtra<0>(vb), v1 = vtra<512>(vb), v2 = vtra<1024>(vb), v3 = vtra<1536>(vb);
      LGKM0();
      vf[0] = (bf16x8){v0[0], v0[1], v0[2], v0[3], v1[0], v1[1], v1[2], v1[3]};
      vf[1] = (bf16x8){v2[0], v2[1], v2[2], v2[3], v3[0], v3[1], v3[2], v3[3]};
    }
#pragma unroll
    for (int it = 0; it < 4; ++it) {
      f32x4 acc = (f32x4){0.f, 0.f, 0.f, 0.f};
      LAS const unsigned char* qrow = st + GS_Q + (16 * it + i) * 256;
#pragma unroll
      for (int kk = 0; kk < 4; ++kk) {
        const bf16x8 a = *(LAS const bf16x8*)(qrow + (((4 * kk + g) ^ i) << 4));
        acc = __builtin_amdgcn_mfma_f32_16x16x32_bf16(a, __builtin_bit_cast(bf16x8, spk[kk]), acc, 0, 0, 0);
      }
      LAS const unsigned char* arow = st + GS_A + (16 * it + i) * 128;
#pragma unroll
      for (int k2 = 0; k2 < 2; ++k2) {
        const bf16x8 a = *(LAS const bf16x8*)(arow + (((4 * k2 + g) ^ ((i >> 1) & 7)) << 4));
        acc = __builtin_amdgcn_mfma_f32_16x16x32_bf16(a, vf[k2], acc, 0, 0, 0);
      }
      bf16_t* op = O + ((size_t)b * S_ + c * 64 + 16 * it + 4 * g) * D_ + h * 256 + eh * 128 + 16 * wid + i;
#pragma unroll
      for (int r = 0; r < 4; ++r) op[(size_t)r * D_] = f2bf(acc[r]);
    }
    __builtin_amdgcn_sched_barrier(0);
#define GL_KRD(dt, q0, q1, q2, q3) { q0 = vtra<GS_K + (dt) * 2048>(trb); q1 = vtra<GS_K + (dt) * 2048 + 512>(trb); q2 = vtra<GS_K + (dt) * 2048 + 1024>(trb); q3 = vtra<GS_K + (dt) * 2048 + 1536>(trb); }
#define GL_UPD(dt, q0, q1, q2, q3) { S[dt] = S[dt] * dc[dt]; \
      S[dt] = __builtin_amdgcn_mfma_f32_16x16x32_bf16((bf16x8){q0[0], q0[1], q0[2], q0[3], q1[0], q1[1], q1[2], q1[3]}, vf[0], S[dt], 0, 0, 0); \
      S[dt] = __builtin_amdgcn_mfma_f32_16x16x32_bf16((bf16x8){q2[0], q2[1], q2[2], q2[3], q3[0], q3[1], q3[2], q3[3]}, vf[1], S[dt], 0, 0, 0); }
    {
      s16x4 e0, e1, e2, e3, e4, e5, e6, e7, f0, f1, f2, f3, f4, f5, f6, f7;
      GL_KRD(0, e0, e1, e2, e3) GL_KRD(1, e4, e5, e6, e7)
      LGKM0();
      GL_KRD(2, f0, f1, f2, f3) GL_KRD(3, f4, f5, f6, f7)
      GL_UPD(0, e0, e1, e2, e3) GL_UPD(1, e4, e5, e6, e7)
      LGKM0();
      GL_KRD(4, e0, e1, e2, e3) GL_KRD(5, e4, e5, e6, e7)
      GL_UPD(2, f0, f1, f2, f3) GL_UPD(3, f4, f5, f6, f7)
      LGKM0();
      GL_KRD(6, f0, f1, f2, f3) GL_KRD(7, f4, f5, f6, f7)
      GL_UPD(4, e0, e1, e2, e3) GL_UPD(5, e4, e5, e6, e7)
      LGKM0();
      GL_UPD(6, f0, f1, f2, f3) GL_UPD(7, f4, f5, f6, f7)
    }
#undef GL_KRD
#undef GL_UPD
    __syncthreads();
  }
}


constexpr int G4_Q = 0, G4_K = 16384, G4_V = 32768, G4_A = 40960, G4_D = 49152, G4_BYTES = 49664, G4_EXCH = 3 * G4_BYTES, G4_END = G4_EXCH + 8192;
__device__ __forceinline__ void gla4_stage_dma(LAS unsigned char* st, const Params& P, int item, size_t rowbase, int h, int eq, int lane, int wid) {
  const bf16_t* QT = (const bf16_t*)(P.ws + WS_QT) + (size_t)item * 8192;
  const bf16_t* KH = (const bf16_t*)(P.ws + WS_KH) + (size_t)item * 8192;
  const bf16_t* ATT = (const bf16_t*)(P.ws + WS_ATT) + (size_t)item * 4096;
  const bf16_t* V = (const bf16_t*)(P.ws + WS_H) + rowbase * P1 + G_V + h * 256 + eq * 64;
#pragma unroll
  for (int n = 0; n < 2; ++n) {
    const int q = 2 * wid + n;
    { const int row = 4 * q + (lane >> 4), ch = (lane & 15) ^ (row & 15);
      __builtin_amdgcn_global_load_lds((const unsigned*)(QT + row * 128 + ch * 8), (LAS unsigned*)(st + G4_Q + q * 1024), 16, 0, 0); }
    { const int dt = q >> 1, j = 32 * (q & 1) + (lane >> 1);
      __builtin_amdgcn_global_load_lds((const unsigned*)(KH + j * 128 + dt * 16 + (lane & 1) * 8), (LAS unsigned*)(st + G4_K + q * 1024), 16, 0, 0); }
  }
  { const int et = wid >> 1, j = 32 * (wid & 1) + (lane >> 1);
    __builtin_amdgcn_global_load_lds((const unsigned*)(V + (unsigned)j * P1 + et * 16 + (lane & 1) * 8), (LAS unsigned*)(st + G4_V + wid * 1024), 16, 0, 0); }
  { const int row = 8 * wid + (lane >> 3), ch = (lane & 7) ^ ((row >> 1) & 7);
    __builtin_amdgcn_global_load_lds((const unsigned*)(ATT + row * 64 + ch * 8), (LAS unsigned*)(st + G4_A + wid * 1024), 16, 0, 0); }
  __builtin_amdgcn_global_load_lds((const unsigned*)((const float*)(P.ws + WS_DEC) + (size_t)item * 128 + (wid & 1) * 64 + lane), (LAS unsigned*)(st + G4_D + (wid & 1) * 256), 4, 0, 0);
}
__device__ __forceinline__ void gla_chain64(const Params& P, int chain, int seg, unsigned char* smem_g) {
  LAS unsigned char* lds = (LAS unsigned char*)smem_g;
  bf16_t* __restrict__ O = (bf16_t*)(P.ws + WS_XB);
  const int tid = otid(), lane = tid & 63, wid = __builtin_amdgcn_readfirstlane(tid >> 6), g = lane >> 4, i = lane & 15;
  const int et = wid & 3, dh = wid >> 2;
  const int eq = chain & 3, h = (chain >> 2) & 3, b = chain >> 4;
  const int item0 = (b * 4 + h) * 64 + 32 * seg;
  const size_t row0 = (size_t)b * S_ + (size_t)seg * 32 * 64;
  f32x4 S[4];
#pragma unroll
  for (int t = 0; t < 4; ++t) S[t] = (f32x4){0.f, 0.f, 0.f, 0.f};
  f32x4 opend[2] = {(f32x4){0.f, 0.f, 0.f, 0.f}, (f32x4){0.f, 0.f, 0.f, 0.f}};
  gla_wait_items(P, item0, 10, tid);
  gla4_stage_dma(lds, P, item0, row0, h, eq, lane, wid);
  gla4_stage_dma(lds + G4_BYTES, P, item0 + 1, row0 + 64, h, eq, lane, wid);
  for (int c = 0; c < 32; ++c) {
    if ((c & 7) == 0 && c > 0 && c + 2 < 32) gla_wait_items(P, item0 + c + 2, (32 - (c + 2)) < 8 ? (32 - (c + 2)) : 8, tid);
    if (c + 1 < 32) asm volatile("s_waitcnt vmcnt(7)" ::: "memory"); else asm volatile("s_waitcnt vmcnt(0)" ::: "memory");
    __builtin_amdgcn_s_barrier();
    asm volatile("" ::: "memory");
    if (c > 0) {
#pragma unroll
      for (int q = 0; q < 2; ++q) { bf16_t* op = O + (row0 + (c - 1) * 64 + 16 * (2 * dh + q) + 4 * g) * D_ + h * 256 + eq * 64 + 16 * et + i;
#pragma unroll
        for (int r = 0; r < 4; ++r) op[(size_t)r * D_] = f2bf(opend[q][r]); }
    }
    if (c + 2 < 32) gla4_stage_dma(lds + ((c + 2) % 3) * G4_BYTES, P, item0 + c + 2, row0 + (c + 2) * 64, h, eq, lane, wid);
    LAS const unsigned char* st = lds + (c % 3) * G4_BYTES;
    f32x4 dc[4];
#pragma unroll
    for (int t = 0; t < 4; ++t) dc[t] = *(LAS const f32x4*)(st + G4_D + (16 * (4 * dh + t) + 4 * g) * 4);
    bf16x8 qa[4][2], aa[2][2];
#pragma unroll
    for (int it = 0; it < 4; ++it)
#pragma unroll
      for (int q = 0; q < 2; ++q) qa[it][q] = *(LAS const bf16x8*)(st + G4_Q + (16 * it + i) * 256 + (((4 * (2 * dh + q) + g) ^ i) << 4));
#pragma unroll
    for (int q = 0; q < 2; ++q)
#pragma unroll
      for (int k2 = 0; k2 < 2; ++k2) aa[q][k2] = *(LAS const bf16x8*)(st + G4_A + (16 * (2 * dh + q) + i) * 128 + (((4 * k2 + g) ^ ((i >> 1) & 7)) << 4));
    const unsigned trb = (unsigned)(unsigned long long)st + (4 * g + (i >> 2)) * 32 + (i & 3) * 8;
    const unsigned vb = trb + G4_V + et * 2048, kb = trb + G4_K + (4 * dh) * 2048;
    const s16x4 v0 = vtra<0>(vb), v1 = vtra<512>(vb), v2 = vtra<1024>(vb), v3 = vtra<1536>(vb);
    s16x4 kq[4][4];
#define G4_KRD(t) { kq[t][0] = vtra<(t) * 2048>(kb); kq[t][1] = vtra<(t) * 2048 + 512>(kb); kq[t][2] = vtra<(t) * 2048 + 1024>(kb); kq[t][3] = vtra<(t) * 2048 + 1536>(kb); }
    G4_KRD(0) G4_KRD(1) G4_KRD(2) G4_KRD(3)
#undef G4_KRD
    u32x4 spk[2];
#pragma unroll
    for (int q = 0; q < 2; ++q) {
      spk[q][0] = cvtpk(S[2 * q][0], S[2 * q][1]); spk[q][1] = cvtpk(S[2 * q][2], S[2 * q][3]);
      spk[q][2] = cvtpk(S[2 * q + 1][0], S[2 * q + 1][1]); spk[q][3] = cvtpk(S[2 * q + 1][2], S[2 * q + 1][3]);
    }
    LGKM0();
    bf16x8 vf[2];
    vf[0] = (bf16x8){v0[0], v0[1], v0[2], v0[3], v1[0], v1[1], v1[2], v1[3]};
    vf[1] = (bf16x8){v2[0], v2[1], v2[2], v2[3], v3[0], v3[1], v3[2], v3[3]};
    f32x4 acc[4];
#pragma unroll
    for (int it = 0; it < 4; ++it) {
      acc[it] = (f32x4){0.f, 0.f, 0.f, 0.f};
      if (it >> 1 == dh) {
#pragma unroll
        for (int k2 = 0; k2 < 2; ++k2) acc[it] = __builtin_amdgcn_mfma_f32_16x16x32_bf16(aa[it & 1][k2], vf[k2], acc[it], 0, 0, 0);
      }
#pragma unroll
      for (int q = 0; q < 2; ++q) acc[it] = __builtin_amdgcn_mfma_f32_16x16x32_bf16(qa[it][q], __builtin_bit_cast(bf16x8, spk[q]), acc[it], 0, 0, 0);
    }
#pragma unroll
    for (int t = 0; t < 4; ++t) {
      S[t] = S[t] * dc[t];
      S[t] = __builtin_amdgcn_mfma_f32_16x16x32_bf16((bf16x8){kq[t][0][0], kq[t][0][1], kq[t][0][2], kq[t][0][3], kq[t][1][0], kq[t][1][1], kq[t][1][2], kq[t][1][3]}, vf[0], S[t], 0, 0, 0);
      S[t] = __builtin_amdgcn_mfma_f32_16x16x32_bf16((bf16x8){kq[t][2][0], kq[t][2][1], kq[t][2][2], kq[t][2][3], kq[t][3][0], kq[t][3][1], kq[t][3][2], kq[t][3][3]}, vf[1], S[t], 0, 0, 0);
    }
    {
      LAS u32x2* ex = (LAS u32x2*)(lds + G4_EXCH) + (wid * 2) * 64 + lane;
#pragma unroll
      for (int q = 0; q < 2; ++q) { const f32x4 v = dh == 0 ? acc[2 + q] : acc[q]; ex[q * 64] = (u32x2){cvtpk(v[0], v[1]), cvtpk(v[2], v[3])}; }
    }
    asm volatile("s_waitcnt lgkmcnt(0)" ::: "memory");
    __builtin_amdgcn_s_barrier();
    asm volatile("" ::: "memory");
    {
      LAS const u32x2* ex = (LAS const u32x2*)(lds + G4_EXCH) + ((wid ^ 4) * 2) * 64 + lane;
#pragma unroll
      for (int q = 0; q < 2; ++q) {
        const u32x2 pv = ex[q * 64];
        f32x4 mine = dh == 0 ? acc[q] : acc[2 + q];
        mine[0] += __uint_as_float(pv.x << 16); mine[1] += __uint_as_float(pv.x & 0xffff0000u); mine[2] += __uint_as_float(pv.y << 16); mine[3] += __uint_as_float(pv.y & 0xffff0000u);
        opend[q] = mine;
      }
    }
  }
#pragma unroll
  for (int q = 0; q < 2; ++q) { bf16_t* op = O + (row0 + 31 * 64 + 16 * (2 * dh + q) + 4 * g) * D_ + h * 256 + eq * 64 + 16 * et + i;
#pragma unroll
    for (int r = 0; r < 4; ++r) op[(size_t)r * D_] = f2bf(opend[q][r]); }
  if (seg == 0) {
    bf16_t* smt = (bf16_t*)(P.ws + WS_SMT) + ((size_t)(b * 4 + h) * 256 + eq * 64 + 16 * et + i) * 128;
#pragma unroll
    for (int t = 0; t < 4; ++t) { const int T = 4 * dh + t, p0 = 32 * (T >> 1) + 8 * g + 4 * (T & 1);
      *(u32x2*)(smt + p0) = (u32x2){cvtpk(S[t][0], S[t][1]), cvtpk(S[t][2], S[t][3])}; }
  }
  __builtin_amdgcn_s_barrier();
}

__device__ __forceinline__ void gla_norm_phase(const Params& P) {
  const bf16_t* H1 = (const bf16_t*)(P.ws + WS_H);
  const bf16_t* O = (const bf16_t*)(P.ws + WS_XB);
  bf16_t* MIX = (bf16_t*)(P.ws + WS_MIX);
  const float* gn = P.in[12];
  const int lane = otid() & 63, wid = otid() >> 6;
  for (int it = blockIdx.x * 8 + wid; it < M_ * 4; it += gridDim.x * 8) {
    const int h = it & 3; const size_t row = it >> 2;
    float v[4]; float ss = 0.f;
#pragma unroll
    for (int k = 0; k < 4; ++k) { v[k] = bf2f(O[row * D_ + h * 256 + k * 64 + lane]); ss += v[k] * v[k]; }
    const float r = 1.f / sqrtf(wave_sum(ss) * (1.f / 256.f) + LN_EPS);
#pragma unroll
    for (int k = 0; k < 4; ++k) {
      const int c = h * 256 + k * 64 + lane;
      const float z = bf2f(H1[row * P1 + G_Z + c]);
      MIX[row * D_ + c] = f2bf(v[k] * r * gn[c] * silu_f(z));
    }
  }
}


constexpr int RG_RED = 131072;
__device__ __forceinline__ size_t wfrag_off(int n, int k) { return ((size_t)(((n >> 4) * 32 + (k >> 5)) * 64 + ((k >> 3) & 3) * 16 + (n & 15))) * 8 + (k & 7); }
template <int AMODE  , bool GLR  >
__device__ __forceinline__ void rowgemm_block(const Params& P, int rb, const bf16_t* __restrict__ Wf, const float* base, float* out, bf16_t* outb,
                                              const float* __restrict__ gam, const float* __restrict__ bet, unsigned char* smem_g) {
  LAS unsigned char* lds = (LAS unsigned char*)smem_g;
  const int tid = otid(), lane = tid & 63, wid = __builtin_amdgcn_readfirstlane(tid >> 6), g = lane >> 4, i = lane & 15;
  const size_t r0 = (size_t)rb * 64;
  if (AMODE == 0) {
    const bf16_t* A = (const bf16_t*)(P.ws + WS_MIX) + r0 * D_;
#pragma unroll
    for (int q0 = 0; q0 < 16; ++q0) {
      const int q = wid * 16 + q0, row = q >> 1, ch = ((q & 1) * 64 + lane) ^ (row & 15);
      __builtin_amdgcn_global_load_lds((const unsigned*)(A + (size_t)row * D_ + ch * 8), (LAS unsigned*)(lds + q * 1024), 16, 0, 0);
    }
  } else {
    const bf16_t* __restrict__ O = (const bf16_t*)(P.ws + WS_XB) + r0 * D_;
    const bf16_t* __restrict__ H1 = (const bf16_t*)(P.ws + WS_H) + r0 * P1 + G_Z;
    const float* __restrict__ gn = P.in[12];
    const int row = tid >> 3, part = tid & 7;
    u32x4 ov[16];
#pragma unroll
    for (int c = 0; c < 16; ++c) ov[c] = *(const u32x4*)(O + (size_t)row * D_ + part * 128 + c * 8);
    const int bb = rb >> 6, cc = rb & 63;
    if (cc >= 32) {
      LAS float* PP = (LAS float*)(lds + RG_RED);
      LAS unsigned char* QP = lds + RG_RED + 4096;
#pragma unroll 1
      for (int hh = 0; hh < 4; ++hh) {
        const int itm = (bb * 4 + hh) * 64;
        if (tid < 128) {
          const int pp = tid, dd = (pp & ~31) + 16 * ((pp >> 2) & 1) + 4 * ((pp >> 3) & 3) + (pp & 3);
          const float* dec = (const float*)(P.ws + WS_DEC) + (size_t)itm * 128 + dd;
          float pr = 1.f;
#pragma unroll 4
          for (int c2 = 32; c2 < cc; ++c2) pr *= dec[(size_t)c2 * 128];
          PP[pp] = pr;
        }
        __syncthreads();
        {
          const int p0 = (tid & 7) * 16;
          const bf16_t* qsrc = (const bf16_t*)(P.ws + WS_QT) + (size_t)(itm + cc) * 8192 + row * 128 + p0;
          const u32x4 q0 = *(const u32x4*)qsrc, q1 = *(const u32x4*)(qsrc + 8);
          u32x4 w0, w1;
#pragma unroll
          for (int e = 0; e < 4; ++e) {
            w0[e] = cvtpk(__uint_as_float(q0[e] << 16) * PP[p0 + 2 * e], __uint_as_float(q0[e] & 0xffff0000u) * PP[p0 + 2 * e + 1]);
            w1[e] = cvtpk(__uint_as_float(q1[e] << 16) * PP[p0 + 8 + 2 * e], __uint_as_float(q1[e] & 0xffff0000u) * PP[p0 + 8 + 2 * e + 1]);
          }
          *(LAS u32x4*)(QP + row * 272 + p0 * 2) = w0; *(LAS u32x4*)(QP + row * 272 + p0 * 2 + 16) = w1;
        }
        __syncthreads();
        {
          const bf16_t* smt = (const bf16_t*)(P.ws + WS_SMT) + ((size_t)(bb * 4 + hh) * 256 + 32 * wid + i) * 128 + 8 * g;
          bf16x8 af[2][4];
#pragma unroll
          for (int q = 0; q < 2; ++q)
#pragma unroll
            for (int kk = 0; kk < 4; ++kk) af[q][kk] = *(const bf16x8*)(smt + (size_t)q * 16 * 128 + 32 * kk);
#pragma unroll 1
          for (int mm = 0; mm < 4; ++mm) {
            bf16x8 bfm[4];
#pragma unroll
            for (int kk = 0; kk < 4; ++kk) bfm[kk] = *(LAS const bf16x8*)(QP + (16 * mm + i) * 272 + (32 * kk + 8 * g) * 2);
#pragma unroll
            for (int q = 0; q < 2; ++q) {
              f32x4 ca = (f32x4){0.f, 0.f, 0.f, 0.f};
#pragma unroll
              for (int kk = 0; kk < 4; ++kk) ca = __builtin_amdgcn_mfma_f32_16x16x32_bf16(af[q][kk], bfm[kk], ca, 0, 0, 0);
              *(LAS u32x2*)(lds + (16 * mm + i) * 2048 + (hh * 256 + 32 * wid + 16 * q + 4 * g) * 2) = (u32x2){cvtpk(ca[0], ca[1]), cvtpk(ca[2], ca[3])};
            }
          }
        }
        __syncthreads();
      }
#pragma unroll
      for (int c = 0; c < 16; ++c) {
        const u32x4 cr = *(LAS const u32x4*)(lds + row * 2048 + (part * 128 + c * 8) * 2);
#pragma unroll
        for (int e = 0; e < 4; ++e)
          ov[c][e] = cvtpk(__uint_as_float(ov[c][e] << 16) + __uint_as_float(cr[e] << 16), __uint_as_float(ov[c][e] & 0xffff0000u) + __uint_as_float(cr[e] & 0xffff0000u));
      }
      __syncthreads();
    }
    float ss = 0.f;
#pragma unroll
    for (int c = 0; c < 16; ++c)
#pragma unroll
      for (int e = 0; e < 4; ++e) { const float lo = __uint_as_float(ov[c][e] << 16), hi = __uint_as_float(ov[c][e] & 0xffff0000u); ss += lo * lo + hi * hi; }
    ss = xsum<1>(ss);
    const float rinv = 1.f / sqrtf(ss * (1.f / 256.f) + LN_EPS);
#pragma unroll
    for (int c = 0; c < 16; ++c) {
      asm volatile("" ::: "memory");
      const int col = part * 128 + c * 8;
      const u32x4 zv = *(const u32x4*)(H1 + (size_t)row * P1 + col);
      const f32x4 g0 = *(const f32x4*)(gn + col), g1 = *(const f32x4*)(gn + col + 4);
      const float gg[8] = {g0[0], g0[1], g0[2], g0[3], g1[0], g1[1], g1[2], g1[3]};
      u32x4 w;
#pragma unroll
      for (int e = 0; e < 4; ++e) {
        const float o0 = __uint_as_float(ov[c][e] << 16), o1 = __uint_as_float(ov[c][e] & 0xffff0000u);
        const float z0 = __uint_as_float(zv[e] << 16), z1 = __uint_as_float(zv[e] & 0xffff0000u);
        w[e] = cvtpk(o0 * rinv * gg[2 * e] * silu_f(z0), o1 * rinv * gg[2 * e + 1] * silu_f(z1));
      }
      *(LAS u32x4*)(lds + row * 2048 + ((((part * 16 + c)) ^ (row & 15)) << 4)) = w;
    }
  }
  __syncthreads();
  f32x4 acc[4][8];
#pragma unroll
  for (int m = 0; m < 4; ++m)
#pragma unroll
    for (int nt = 0; nt < 8; ++nt) acc[m][nt] = (f32x4){0.f, 0.f, 0.f, 0.f};
  const bf16_t* wp = Wf + ((size_t)(wid * 8) * 32 * 64 + lane) * 8;
  bf16x8 wf[2][8];
#pragma unroll
  for (int nt = 0; nt < 8; ++nt) wf[0][nt] = *(const bf16x8*)(wp + (size_t)(nt * 32) * 512);
#pragma unroll 1
  for (int ks = 0; ks < 32; ks += 2) {
#pragma unroll
    for (int hf = 0; hf < 2; ++hf) {
      const int kc = ks + hf;
      if (kc + 1 < 32) {
#pragma unroll
        for (int nt = 0; nt < 8; ++nt) wf[hf ^ 1][nt] = *(const bf16x8*)(wp + (size_t)(nt * 32 + kc + 1) * 512);
      }
      bf16x8 xf[4];
#pragma unroll
      for (int m = 0; m < 4; ++m) xf[m] = *(LAS const bf16x8*)(lds + (16 * m + i) * 2048 + (((4 * kc + g) ^ i) << 4));
#pragma unroll
      for (int m = 0; m < 4; ++m)
#pragma unroll
        for (int nt = 0; nt < 8; ++nt) acc[m][nt] = __builtin_amdgcn_mfma_f32_16x16x32_bf16(wf[hf][nt], xf[m], acc[m][nt], 0, 0, 0);
    }
  }
  LAS float* red = (LAS float*)(lds + RG_RED);
  {
  const int tid = otid(), lane = tid & 63, wid = __builtin_amdgcn_readfirstlane(tid >> 6), g = lane >> 4, i = lane & 15; (void)lane;
#pragma unroll
  for (int m = 0; m < 4; ++m) {
    const float* bp = base + (r0 + 16 * m + i) * D_ + wid * 128 + 4 * g;
    f32x4 bv[8];
#pragma unroll
    for (int nt = 0; nt < 8; ++nt) bv[nt] = *(const f32x4*)(bp + 16 * nt);
    float s1 = 0.f, s2 = 0.f;
#pragma unroll
    for (int nt = 0; nt < 8; ++nt) { const f32x4 v = acc[m][nt] + bv[nt] * ALPHA; acc[m][nt] = v; s1 += (v[0] + v[1]) + (v[2] + v[3]); s2 += (v[0] * v[0] + v[1] * v[1]) + (v[2] * v[2] + v[3] * v[3]); }
    s1 = xsum<16>(s1); s1 = xsum<32>(s1); s2 = xsum<16>(s2); s2 = xsum<32>(s2);
    if (g == 0) { red[((16 * m + i) * 8 + wid) * 2] = s1; red[((16 * m + i) * 8 + wid) * 2 + 1] = s2; }
  }
  __syncthreads();
#pragma unroll 1
  for (int m = 0; m < 4; ++m) {
    float s1 = 0.f, s2 = 0.f;
#pragma unroll
    for (int w2 = 0; w2 < 8; ++w2) { s1 += red[((16 * m + i) * 8 + w2) * 2]; s2 += red[((16 * m + i) * 8 + w2) * 2 + 1]; }
    const float mean = s1 * (1.f / D_);
    const float var = fmaxf(s2 * (1.f / D_) - mean * mean, 0.f);
    const float rstd = 1.f / sqrtf(var + LN_EPS);
    const size_t off = (r0 + 16 * m + i) * D_ + wid * 128 + 4 * g;
#pragma unroll
    for (int nt = 0; nt < 8; ++nt) {
      const f32x4 gvv = *(const f32x4*)(gam + wid * 128 + 16 * nt + 4 * g), tvv = *(const f32x4*)(bet + wid * 128 + 16 * nt + 4 * g);
      const f32x4 av = m == 0 ? acc[0][nt] : (m == 1 ? acc[1][nt] : (m == 2 ? acc[2][nt] : acc[3][nt]));
      const f32x4 o = (av - mean) * rstd * gvv + tvv;
      *(f32x4*)(out + off + 16 * nt) = o;
      u32x2 w; w[0] = cvtpk(o[0], o[1]); w[1] = cvtpk(o[2], o[3]);
      if (outb) *(u32x2*)(outb + off + 16 * nt) = w;
      if (GLR) { const int row = 16 * m + i, chunk = 16 * wid + 2 * nt + (g >> 1);
        *(LAS u32x2*)(lds + row * 2048 + ((chunk ^ (row & 15)) << 4) + (g & 1) * 8) = w; }
    }
  }
  if (GLR) {
    __syncthreads();
    const bf16_t* wg = (const bf16_t*)(P.ws + WS_WT1) + (size_t)(3072 + i) * D_ + 8 * g;
    const int mt = wid & 3, kh = wid >> 2;
    f32x4 a2 = (f32x4){0.f, 0.f, 0.f, 0.f};
#pragma unroll 4
    for (int q = 0; q < 16; ++q) {
      const int kc = kh * 16 + q;
      const bf16x8 wfr = *(const bf16x8*)(wg + 32 * kc);
      const bf16x8 xfr = *(LAS const bf16x8*)(lds + (16 * mt + i) * 2048 + (((4 * kc + g) ^ i) << 4));
      a2 = __builtin_amdgcn_mfma_f32_16x16x32_bf16(wfr, xfr, a2, 0, 0, 0);
    }
    LAS f32x4* r2 = (LAS f32x4*)(lds + RG_RED + 4096);
    if (kh == 1) r2[mt * 64 + lane] = a2;
    __syncthreads();
    if (kh == 0) {
      const f32x4 tot = a2 + r2[mt * 64 + lane];
      *(f32x4*)((float*)(P.ws + WS_GLR) + (r0 + 16 * mt + i) * 16 + 4 * g) = tot;
    }
  }
  }
  __syncthreads();
}

#define XB_TMO      128
#define XB_XCNT(j)  (256  + 64 * (j))
#define XB_XSUB(j)  (1280 + 64 * (j))
#define XB_XGEN(j)  (2304 + 64 * (j))
#define XB_TOP      3328
#define XB_TOPGEN   3392
#define XCD_BAR_WORDS 3456
#define XB_SPIN_CAP (1u << 18)

__device__ __forceinline__ unsigned xb_ld(unsigned* p)              { return __hip_atomic_load(p, __ATOMIC_RELAXED, __HIP_MEMORY_SCOPE_AGENT); }
__device__ __forceinline__ unsigned xb_add(unsigned* p, unsigned v) { return __hip_atomic_fetch_add(p, v, __ATOMIC_RELAXED, __HIP_MEMORY_SCOPE_AGENT); }
__device__ __forceinline__ unsigned xb_xcc_id() { return (unsigned)__builtin_amdgcn_s_getreg((3 << 11) | 20) & 0xFu; }
#define XB_SPIN(cond, bar) do { unsigned _sp = 0; while (cond) { __builtin_amdgcn_s_sleep(1); \
    if ((++_sp & 255u) == 0u) { if (xb_ld(&(bar)[XB_TMO])) break; if (_sp > XB_SPIN_CAP) { atomicAdd(&(bar)[XB_TMO], 1u); break; } } } } while (0)

struct XcdBarrier {
    unsigned* bar; unsigned x;
    volatile LAS unsigned* st;
};

__device__ __forceinline__ XcdBarrier xcd_barrier_post(unsigned* bar, volatile LAS unsigned* st) {
    XcdBarrier b; b.bar = bar; b.x = xb_xcc_id(); b.st = st;
    if (threadIdx.x == 0) (void)xb_add(&bar[XB_XCNT(b.x)], 1u);
    return b;
}
__device__ __forceinline__ void xcd_barrier_complete(unsigned* bar, unsigned x, unsigned& nloc, unsigned& nx) {
    const unsigned G = gridDim.x * gridDim.y * gridDim.z;
    unsigned sum, cnt, mine, sp = 0u;
    for (;;) {
        sum = 0u; cnt = 0u; mine = 0u;
#pragma unroll
        for (unsigned j = 0; j < 16; ++j) { const unsigned c = xb_ld(&bar[XB_XCNT(j)]); sum += c; cnt += (c > 0u) ? 1u : 0u; mine = (j == x) ? c : mine; }
        if (sum == G) break;
        __builtin_amdgcn_s_sleep(1);
        if ((++sp & 255u) == 0u) { if (xb_ld(&bar[XB_TMO])) break; if (sp > XB_SPIN_CAP) { atomicAdd(&bar[XB_TMO], 1u); break; } }
    }
    nloc = mine > 0u ? mine : 1u; nx = cnt > 0u ? cnt : 1u;
}

__device__ __forceinline__ void xcd_barrier(const XcdBarrier& b) {
    asm volatile("s_waitcnt vmcnt(0)" ::: "memory");
    __syncthreads();
    if (threadIdx.x == 0) {
        unsigned* bar = b.bar;
        __builtin_amdgcn_s_waitcnt(0);
        unsigned nloc = b.st[0], nx = b.st[1];
        if (nloc == 0u) { xcd_barrier_complete(bar, b.x, nloc, nx); b.st[0] = nloc; b.st[1] = nx; }
        const unsigned old = xb_add(&bar[XB_XSUB(b.x)], 1u);
        const unsigned gen = old / nloc;
        if (old + 1u == (gen + 1u) * nloc) {
            __builtin_amdgcn_fence(__ATOMIC_RELEASE, "agent");
            asm volatile("s_waitcnt vmcnt(0)" ::: "memory");
            const unsigned og = xb_add(&bar[XB_TOP], 1u);
            const unsigned tg = og / nx;
            if (og + 1u == (tg + 1u) * nx) xb_add(&bar[XB_TOPGEN], 1u);
            else XB_SPIN(xb_ld(&bar[XB_TOPGEN]) == tg, bar);
            __builtin_amdgcn_fence(__ATOMIC_ACQUIRE, "agent");
            xb_add(&bar[XB_XGEN(b.x)], 1u);
            asm volatile("s_waitcnt vmcnt(0)" ::: "memory");
        } else {
            XB_SPIN(xb_ld(&bar[XB_XGEN(b.x)]) == gen, bar);
            __builtin_amdgcn_fence(__ATOMIC_ACQUIRE, "agent");
            asm volatile("s_waitcnt vmcnt(0)" ::: "memory");
        }
    }
    __syncthreads();
}


__device__ const unsigned short p3_order[1024] = {638,636,634,632,630,628,626,624,15,143,271,399,622,14,142,270,398,620,618,13,141,269,397,616,614,12,140,268,396,612,610,11,139,267,395,608,606,10,138,266,394,604,602,9,137,265,393,560,562,564,566,568,570,572,574,544,546,548,550,552,554,556,558,600,536,538,540,542,534,598,8,136,264,392,532,596,530,594,7,135,263,391,528,592,6,134,262,390,526,590,524,588,5,133,261,389,522,586,520,584,4,132,260,388,518,582,3,131,259,387,516,580,2,130,258,386,514,578,1,129,257,385,512,576,0,128,256,384,639,637,635,633,631,629,627,625,31,159,287,415,623,621,30,158,286,414,619,617,29,157,285,413,615,613,28,156,284,412,611,609,27,155,283,411,607,26,154,282,410,605,603,25,153,281,409,561,563,565,567,569,571,573,575,601,545,547,549,551,553,555,557,559,535,537,539,541,543,599,24,152,280,408,533,597,531,595,23,151,279,407,529,593,527,591,22,150,278,406,525,589,523,587,21,149,277,405,521,585,20,148,276,404,519,583,19,147,275,403,517,581,18,146,274,402,515,579,17,145,273,401,513,577,16,144,272,400,766,764,762,760,758,756,754,752,47,175,303,431,750,46,174,302,430,748,746,45,173,301,429,744,742,44,172,300,428,740,738,43,171,299,427,736,734,42,170,298,426,732,730,41,169,297,425,688,690,692,694,696,698,700,702,672,674,676,678,680,682,684,686,728,664,666,668,670,662,726,40,168,296,424,660,724,658,722,39,167,295,423,656,720,38,166,294,422,654,718,652,716,37,165,293,421,650,714,648,712,36,164,292,420,646,710,35,163,291,419,644,708,34,162,290,418,642,706,33,161,289,417,640,704,32,160,288,416,767,765,763,761,759,757,755,753,63,191,319,447,751,749,62,190,318,446,747,745,61,189,317,445,743,741,60,188,316,444,739,737,59,187,315,443,735,58,186,314,442,733,731,57,185,313,441,689,691,693,695,697,699,701,703,729,673,675,677,679,681,683,685,687,663,665,667,669,671,727,56,184,312,440,661,725,659,723,55,183,311,439,657,721,655,719,54,182,310,438,653,717,651,715,53,181,309,437,649,713,52,180,308,436,647,711,51,179,307,435,645,709,50,178,306,434,643,707,49,177,305,433,641,705,48,176,304,432,894,892,890,888,886,884,882,880,79,207,335,463,878,78,206,334,462,876,874,77,205,333,461,872,870,76,204,332,460,868,866,75,203,331,459,864,862,74,202,330,458,860,858,73,201,329,457,816,818,820,822,824,826,828,830,800,802,804,806,808,810,812,814,856,792,794,796,798,790,854,72,200,328,456,788,852,786,850,71,199,327,455,784,848,70,198,326,454,782,846,780,844,69,197,325,453,778,842,776,840,68,196,324,452,774,838,67,195,323,451,772,836,66,194,322,450,770,834,65,193,321,449,768,832,64,192,320,448,895,893,891,889,887,885,883,881,95,223,351,479,879,877,94,222,350,478,875,873,93,221,349,477,871,869,92,220,348,476,867,865,91,219,347,475,863,90,218,346,474,861,859,89,217,345,473,817,819,821,823,825,827,829,831,857,801,803,805,807,809,811,813,815,791,793,795,797,799,855,88,216,344,472,789,853,787,851,87,215,343,471,785,849,783,847,86,214,342,470,781,845,779,843,85,213,341,469,777,841,84,212,340,468,775,839,83,211,339,467,773,837,82,210,338,466,771,835,81,209,337,465,769,833,80,208,336,464,1022,1020,1018,1016,1014,1012,1010,1008,111,239,367,495,1006,110,238,366,494,1004,1002,109,237,365,493,1000,998,108,236,364,492,996,994,107,235,363,491,992,990,106,234,362,490,988,986,105,233,361,489,944,946,948,950,952,954,956,958,928,930,932,934,936,938,940,942,984,920,922,924,926,918,982,104,232,360,488,916,980,914,978,103,231,359,487,912,976,102,230,358,486,910,974,908,972,101,229,357,485,906,970,904,968,100,228,356,484,902,966,99,227,355,483,900,964,98,226,354,482,898,962,97,225,353,481,896,960,96,224,352,480,1023,1021,1019,1017,1015,1013,1011,1009,127,255,383,511,1007,1005,126,254,382,510,1003,1001,125,253,381,509,999,997,124,252,380,508,995,993,123,251,379,507,991,122,250,378,506,989,987,121,249,377,505,945,947,949,951,953,955,957,959,985,929,931,933,935,937,939,941,943,919,921,923,925,927,983,120,248,376,504,917,981,915,979,119,247,375,503,913,977,911,975,118,246,374,502,909,973,907,971,117,245,373,501,905,969,116,244,372,500,903,967,115,243,371,499,901,965,114,242,370,498,899,963,113,241,369,497,897,961,112,240,368,496};
constexpr int CTL_P3_QUEUE = 8192;
constexpr int CTL_LN0 = 4096, CTL_LN1 = 9216, CTL_TMO = 3520;
constexpr size_t WS_XCH0 = 253 * MiB, WS_XCH1 = 254 * MiB;

#ifndef REP_P0
#define REP_P0 1
#endif
#ifndef REP_P2
#define REP_P2 1
#endif
#ifndef REP_P3
#define REP_P3 1
#endif
#ifndef REP_P7
#define REP_P7 1
#endif
#ifndef REP_P8
#define REP_P8 1
#endif
__global__ void __launch_bounds__(512) fwd_megakernel(Params P) {
  cg::grid_group grid = cg::this_grid();
  extern __shared__ __attribute__((aligned(16))) unsigned char smem[];
  const int tid = otid(), lane = tid & 63, wid = tid >> 6;
  unsigned char* ws = P.ws;
  bf16_t* XB = (bf16_t*)(ws + WS_XB);
  bf16_t* MIX = (bf16_t*)(ws + WS_MIX);
  bf16_t* Hb = (bf16_t*)(ws + WS_H);
  float* Y = (float*)(ws + WS_H);
  volatile LAS unsigned* xst = (volatile LAS unsigned*)((LAS unsigned char*)smem + XB_LDS_OFF);
  if (tid < 4) xst[tid] = 0u;
  __syncthreads();
  (void)xcd_barrier_post((unsigned*)ws, xst);
#define GRID_BAR() do { XcdBarrier xb_; xb_.bar = (unsigned*)P.ws; xb_.x = xb_xcc_id(); xb_.st = (volatile LAS unsigned*)((LAS unsigned char*)smem + XB_LDS_OFF); xcd_barrier(xb_); } while (0)

  for (int rep = 0; rep < REP_P0; ++rep) {
    const float4* x4 = (const float4*)P.in[0];
    const size_t n4 = (size_t)M_ * D_ / 4;
    {
      const size_t stride = (size_t)gridDim.x * 512;
      for (size_t i = (size_t)blockIdx.x * 512 + tid; i < n4; i += 8 * stride) {
        float4 v[8];
#pragma unroll
        for (int u = 0; u < 8; ++u) if (i + u * stride < n4) v[u] = x4[i + u * stride];
#pragma unroll
        for (int u = 0; u < 8; ++u) if (i + u * stride < n4) { ushort4 o; o.x = f2bf(v[u].x); o.y = f2bf(v[u].y); o.z = f2bf(v[u].z); o.w = f2bf(v[u].w); ((ushort4*)XB)[i + u * stride] = o; }
      }
    }
    {
      constexpr int T0 = (P0 / 32) * 16, T1 = 32 * 16, T2 = (P1 / 32) * 16, T3 = 32 * 16, T4 = 2 * 4 * 32, T5 = 2 * 2 * 2;
      float* scr = (float*)smem + wid * (64 * 33);
      for (int it = blockIdx.x * 8 + wid; it < T0 + T1 + T2 + T3 + T4 + T5; it += gridDim.x * 8) {
        int r = it;
        if (r < T0) { transpose_wave_tile(P.in[1], D_, EVEN_IN, (bf16_t*)(ws + WS_WT0), 0, r, P0 / 32, scr, lane); continue; } r -= T0;
        if (r < T1) { transpose_wave_tile(P.in[6], D_, D_, (bf16_t*)(ws + WS_WO0), 3, r, 32, scr, lane); continue; } r -= T1;
        if (r < T2) { transpose_wave_tile(P.in[9], D_, ODD_IN, (bf16_t*)(ws + WS_WT1), 1, r, P1 / 32, scr, lane); continue; } r -= T2;
        if (r < T3) { transpose_wave_tile(P.in[13], D_, D_, (bf16_t*)(ws + WS_WO1), 3, r, 32, scr, lane); continue; } r -= T3;
        if (r < T4) { const int i = r >> 7; transpose_wave_tile(P.in[3] + (size_t)i * 2048 * 128, 2048, 128, (bf16_t*)(ws + WS_W1T) + (size_t)i * 128 * 2048, 2, r & 127, 4, scr, lane); continue; } r -= T4;
        { const int i = r >> 2; transpose_wave_tile(P.in[5] + (size_t)i * 128 * 64, 128, 64, (bf16_t*)(ws + WS_W2T) + (size_t)i * 64 * 128, 2, r & 3, 2, scr, lane); }
      }
      __syncthreads();
    }
    for (int it = blockIdx.x + 132; it < 2 * 64 + 2 * 2 + 64; it += gridDim.x) {
      {
        const int t2 = it - 132, i = t2 >> 5, q = t2 & 31, hh = tid & 127, sub = tid >> 7;
        const float* pos = P.in[2] + i * 2048 + q * 64 + sub * 16;
        const float* w1 = P.in[3] + ((size_t)i * 2048 + q * 64 + sub * 16) * 128 + hh;
        float a = 0.f;
#pragma unroll
        for (int f = 0; f < 16; ++f) a += pos[f] * w1[f * 128];
        float* red = (float*)smem;
        red[sub * 128 + hh] = a;
        __syncthreads();
        if (tid < 128) ((float*)(ws + WS_C1P))[(i * 32 + q) * 128 + tid] = (red[tid] + red[128 + tid]) + (red[256 + tid] + red[384 + tid]);
        __syncthreads();
      }
    }
    for (int q = blockIdx.x * 512 + tid; q < B_ * 16 * 512; q += gridDim.x * 512) ((float*)(ws + WS_KM))[q] = 0.f;
    if (blockIdx.x == 0) { const int which = tid >> 8, r = tid & 255;
      unsigned* z = (unsigned*)(ws + (which == 0 ? (size_t)(248 * MiB) : (size_t)(249 * MiB)));
      const int bg = r >> 5, wd = r & 31; z[((size_t)bg * 256 + 255) * 32 + wd] = 0u; }
    GRID_BAR();
  }
  if (P.out == nullptr) grid.sync();
  { pg8::Gemm gm{XB, (const bf16_t*)(ws + WS_WT0), M_, P0, D_}; pg8::StaticOrder so; so.init(M_, P0, (int)gridDim.x, (int)blockIdx.x);
    pg8::EpiBf16s ep{Hb, P0, (3u << (C_NQ / 256)) | (3u << (C_MQ / 256)), C1, (float*)(ws + WS_KM), C_MK / 256}; pg8::gemm_phase<pg8::EpiBf16s, pg8::StaticOrder, true, true>((LAS unsigned char*)smem, gm, so, ep); }
  GRID_BAR();
  for (int rep = 0; rep < REP_P2; ++rep) {
    for (int it = blockIdx.x; it < 256; it += gridDim.x) compress_mfma_tile(P, it, smem);
    GRID_BAR();
  }
  for (int rep = 0; rep < REP_P3; ++rep) {
    const int myx = (int)(xb_xcc_id() & 7u);
    int steal = 0;
    for (;;) {
      LAS int* qslot = (LAS int*)((LAS unsigned char*)smem + AT_MISC + 384);
      const int qx = (myx + steal) & 7;
      if (tid == 0) *qslot = (int)atomicAdd((unsigned*)P.ws + CTL_P3_QUEUE + 64 * qx, 1u) - rep * 128;
      __syncthreads();
      int it = __builtin_amdgcn_readfirstlane(*qslot);
      __syncthreads();
      if (it >= 128) { if (++steal == 8) break; continue; }
      it += qx * 128;
      const int e = p3_order[it], pl = e & 511;
#ifdef FORCE_SAFE
      if (e >> 9) (void)nsa_mfma_item<true>(P, pl >> 7, (pl >> 6) & 1, pl & 63, smem);
      else (void)moba_mfma_item<true>(P, pl >> 7, (pl >> 4) & 7, pl & 15, smem);
#else
      if (e >> 9) { if (nsa_mfma_item<false>(P, pl >> 7, (pl >> 6) & 1, pl & 63, smem)) (void)nsa_mfma_item<true>(P, pl >> 7, (pl >> 6) & 1, pl & 63, smem); }
      else { if (moba_mfma_item<false>(P, pl >> 7, (pl >> 4) & 7, pl & 15, smem)) (void)moba_mfma_item<true>(P, pl >> 7, (pl >> 4) & 7, pl & 15, smem); }
#endif
    }
    GRID_BAR();
  }
  if ((int)blockIdx.x < M_ / 64) rowgemm_block<0, true>(P, (int)blockIdx.x, (const bf16_t*)(ws + WS_WO0), P.in[0], P.out, XB, P.in[7], P.in[8], smem);
  GRID_BAR();
  { pg8::Gemm gm{XB, (const bf16_t*)(ws + WS_WT1), M_, 3072, D_}; pg8::StaticOrder so; so.init(M_, 3072, (int)gridDim.x, (int)blockIdx.x);
    pg8::EpiBf16s ep{Hb, P1, 0u, 1.f, nullptr, 0}; pg8::gemm_phase<pg8::EpiBf16s, pg8::StaticOrder, true, true>((LAS unsigned char*)smem, gm, so, ep); }
  GRID_BAR();
  for (int rep = 0; rep < REP_P8; ++rep) {
    { const int j = (int)blockIdx.x; if (j < 256) gla_prep_item(P, (j & 15) * 64 + ((j >> 4) & 1) * 32 + (j >> 5), smem); }
    if ((int)blockIdx.x < 128) { const int w = (int)blockIdx.x, u = w >> 3, bh = (w & 7) + 8 * (u >> 3), eq = u & 3, seg = (u >> 2) & 1;
      gla_chain64(P, bh * 4 + eq, seg, smem); }
    else for (int j = 256 + (int)blockIdx.x - 128; j < 1024; j += 128) gla_prep_item(P, (j & 15) * 64 + ((j >> 4) & 1) * 32 + (j >> 5), smem);
    GRID_BAR();
  }
  if ((int)blockIdx.x < M_ / 64) rowgemm_block<1, false>(P, (int)blockIdx.x, (const bf16_t*)(ws + WS_WO1), P.out, P.out, nullptr, P.in[14], P.in[15], smem);
}

extern "C" void kernel_launch(void* const* d_in, const int* in_sizes, int n_in, void* d_out, int out_size,
                              void* d_ws, size_t ws_size, hipStream_t stream) {
  constexpr size_t kDynLds = 157696;
  static_assert((size_t)XB_LDS_OFF >= (size_t)G4_END && kDynLds <= 163840 && kDynLds >= (size_t)XB_LDS_OFF + 16 && (size_t)XB_LDS_OFF >= (size_t)AT_LDS_END && kDynLds >= (size_t)AT_LDS_END && kDynLds >= 2 * (size_t)GS_BYTES && kDynLds >= (size_t)pg8::STAGE_BYTES, "LDS");
  static int grid_blocks = 0;
  if (!grid_blocks) {
    int dev = 0, cus = 0, per_cu = 0;
    (void)hipGetDevice(&dev);
    (void)hipDeviceGetAttribute(&cus, hipDeviceAttributeMultiprocessorCount, dev);
    (void)hipFuncSetAttribute((const void*)fwd_megakernel, hipFuncAttributeMaxDynamicSharedMemorySize, (int)kDynLds);
    (void)hipOccupancyMaxActiveBlocksPerMultiprocessor(&per_cu, fwd_megakernel, 512, kDynLds);
    if (per_cu < 1) per_cu = 1;
    if (per_cu > 2) per_cu = 2;
    grid_blocks = cus * per_cu;
    if (grid_blocks != 256) { fprintf(stderr, "kernel_launch: this kernel is laid out for exactly 256 co-resident workgroups (256 CUs x 1); got %d x %d\n", cus, per_cu); grid_blocks = 256; }
    if (n_in != 16 || ws_size < WS_END) { fprintf(stderr, "kernel_launch: unexpected n_in %d / ws %zu\n", n_in, ws_size); }
  }
  (void)hipMemsetAsync(d_ws, 0, 524288, stream);
  Params p{};
  for (int i = 0; i < 16; ++i) p.in[i] = (const float*)d_in[i];
  p.out = (float*)d_out; p.ws = (unsigned char*)d_ws;
  void* args[] = {&p};
  hipError_t e = hipLaunchCooperativeKernel((void*)fwd_megakernel, dim3(grid_blocks), dim3(512), args, kDynLds, stream);
  if (e != hipSuccess) fprintf(stderr, "cooperative launch failed: %s (grid %d)\n", hipGetErrorString(e), grid_blocks);
}
```

```cpp
#include <hip/hip_runtime.h>
#include <hip/hip_cooperative_groups.h>
#include <cstdio>
#include <cstdint>
namespace cg = cooperative_groups;

typedef unsigned short bf16_t;
typedef short bf16x8 __attribute__((ext_vector_type(8)));
typedef float f32x4 __attribute__((ext_vector_type(4)));
typedef unsigned u32x4 __attribute__((ext_vector_type(4)));
typedef unsigned u32x2 __attribute__((ext_vector_type(2)));

constexpr int B_ = 4, S_ = 4096, M_ = B_ * S_, D_ = 1024;
constexpr int P0 = 4096;
constexpr int P1 = 3328;
constexpr int EVEN_IN = 3864, ODD_IN = 3088;
constexpr int C_NQ = 0, C_KCMP = 512, C_VCMP = 640, C_KSEL = 768, C_VSEL = 896, C_KWIN = 1024, C_VWIN = 1152;
constexpr int C_NZ = 1280, C_MQ = 1792, C_MK = 2304, C_MV = 2816, C_MZ = 3328, C_NG = 3840;
constexpr int G_Q = 0, G_K = 512, G_V = 1024, G_Z = 2048, G_LR = 3072;
constexpr int NCMP = 255;
constexpr float ALPHA = 1.4142135623730951f;
constexpr float LN_EPS = 1e-5f;

constexpr size_t MiB = 1u << 20;
constexpr int XB_LDS_OFF = 157440;
constexpr size_t WS_WT0 = 1 * MiB;
constexpr size_t WS_WO0 = 9 * MiB;
constexpr size_t WS_WT1 = 11 * MiB;
constexpr size_t WS_WO1 = 18 * MiB;
constexpr size_t WS_XB = 20 * MiB;
constexpr size_t WS_MIX = 52 * MiB;
constexpr size_t WS_H = 84 * MiB;
constexpr size_t WS_G = 212 * MiB;
constexpr size_t WS_GLR = 245 * MiB;
constexpr size_t WS_SMT = 246 * MiB;
constexpr size_t WS_KC = 245 * MiB;
constexpr size_t WS_VC = 246 * MiB;
constexpr size_t WS_KM = 247 * MiB;
constexpr size_t WS_END = 256 * MiB;

struct Params { const float* in[16]; float* out; unsigned char* ws; };

__device__ __forceinline__ int otid() { int t = __builtin_amdgcn_workitem_id_x(); asm volatile("" : "+v"(t)); return t; }
__device__ __forceinline__ void wg_sync() { __builtin_amdgcn_fence(__ATOMIC_RELEASE, "workgroup"); __builtin_amdgcn_s_barrier(); __builtin_amdgcn_fence(__ATOMIC_ACQUIRE, "workgroup"); }
__device__ __forceinline__ float bf2f(bf16_t v) { return __uint_as_float(((unsigned)v) << 16); }
__device__ __forceinline__ bf16_t f2bf(float f) { unsigned u = __float_as_uint(f); return (bf16_t)((u + 0x7fffu + ((u >> 16) & 1u)) >> 16); }
template <int M> __device__ __forceinline__ float xsum(float v) {
  if constexpr (M == 32) { auto rr = __builtin_amdgcn_permlane32_swap(__float_as_uint(v), __float_as_uint(v), false, false); return __uint_as_float(rr[0]) + __uint_as_float(rr[1]); }
  else return v + __int_as_float(__builtin_amdgcn_ds_swizzle(__float_as_int(v), (M << 10) | 0x1f));
}
template <int M> __device__ __forceinline__ float xmax(float v) {
  if constexpr (M == 32) { auto rr = __builtin_amdgcn_permlane32_swap(__float_as_uint(v), __float_as_uint(v), false, false); return fmaxf(__uint_as_float(rr[0]), __uint_as_float(rr[1])); }
  else return fmaxf(v, __int_as_float(__builtin_amdgcn_ds_swizzle(__float_as_int(v), (M << 10) | 0x1f)));
}
template <int M> __device__ __forceinline__ unsigned xorr(unsigned v) {
  if constexpr (M == 32) { auto rr = __builtin_amdgcn_permlane32_swap(v, v, false, false); return rr[0] | rr[1]; }
  else return v | (unsigned)__builtin_amdgcn_ds_swizzle((int)v, (M << 10) | 0x1f);
}
__device__ __forceinline__ float wave_sum(float v) { v = xsum<1>(v); v = xsum<2>(v); v = xsum<4>(v); v = xsum<8>(v); v = xsum<16>(v); return xsum<32>(v); }
__device__ __forceinline__ float wave_max(float v) { v = xmax<1>(v); v = xmax<2>(v); v = xmax<4>(v); v = xmax<8>(v); v = xmax<16>(v); return xmax<32>(v); }
__device__ __forceinline__ float silu_f(float z) { return z / (1.f + __expf(-z)); }
__device__ __forceinline__ float sigmoid_f(float z) { return 1.f / (1.f + __expf(-z)); }

__device__ __forceinline__ int colmap0(int c) {
  if (c < 1280) return c;
  if (c < 1792) return 1304 + (c - 1280);
  if (c < 3840) return 1816 + (c - 1792);
  if (c < 3864) return 1280 + (c - 3840);
  return -1;
}
__device__ __forceinline__ int colmap1(int c) {
  if (c < 2048) return c;
  if (c < 3072) return 2064 + (c - 2048);
  if (c < 3088) return 2048 + (c - 3072);
  return -1;
}

__device__ __forceinline__ void transpose_tile(const float* __restrict__ W, int K, int Nsrc, bf16_t* __restrict__ Wt, int which, int tile, int ntn, float* sm) {
  const int tid = otid();
  const int nb = tile % ntn, kb = tile / ntn, n0 = nb * 64, k0 = kb * 64;
#pragma unroll
  for (int i = 0; i < 8; ++i) {
    const int kk = i * 8 + (tid >> 6), nn = tid & 63;
    const int c = n0 + nn;
    const int src = which == 0 ? colmap0(c) : (which == 1 ? colmap1(c) : c);
    sm[kk * 65 + nn] = src >= 0 ? W[(size_t)(k0 + kk) * Nsrc + src] : 0.f;
  }
  wg_sync();
#pragma unroll
  for (int i = 0; i < 8; ++i) {
    const int nn = i * 8 + (tid >> 6), kk = tid & 63;
    Wt[(size_t)(n0 + nn) * K + k0 + kk] = f2bf(sm[kk * 65 + nn]);
  }
  wg_sync();
}


__device__ __forceinline__ void transpose_wave_tile(const float* __restrict__ W, int K, int Nsrc, bf16_t* __restrict__ Wt, int which, int tile, int ntn, float* scr, int lane) {
  const int nb = tile % ntn, kb = tile / ntn, n0 = nb * 32, k0 = kb * 64;
  const int c = n0 + (lane & 31);
  const int src = which == 0 ? colmap0(c) : (which == 1 ? colmap1(c) : c);
  float v[32];
#pragma unroll
  for (int q = 0; q < 32; ++q) { const int kk = 2 * q + (lane >> 5); v[q] = src >= 0 ? W[(size_t)(k0 + kk) * Nsrc + src] : 0.f; }
#pragma unroll
  for (int q = 0; q < 32; ++q) { const int kk = 2 * q + (lane >> 5); scr[kk * 33 + (lane & 31)] = v[q]; }
  __builtin_amdgcn_wave_barrier();
  if (which == 3) {
    const int k = k0 + lane;
#pragma unroll 8
    for (int nn = 0; nn < 32; ++nn) { const int n = n0 + nn; Wt[((size_t)(((n >> 4) * 32 + (k >> 5)) * 64 + ((k >> 3) & 3) * 16 + (n & 15))) * 8 + (k & 7)] = f2bf(scr[lane * 33 + nn]); }
  } else {
#pragma unroll 8
    for (int nn = 0; nn < 32; ++nn) Wt[(size_t)(n0 + nn) * K + k0 + lane] = f2bf(scr[lane * 33 + nn]);
  }
  __builtin_amdgcn_wave_barrier();
}

__device__ __forceinline__ void gemm_tile(const bf16_t* __restrict__ A, const bf16_t* __restrict__ Bt, int K, int m0, int n0, int mode, void* outp, int ldc, unsigned char* smem) {
  bf16_t* As = (bf16_t*)smem;
  bf16_t* Bs = As + 128 * 72;
  const int tid = otid(), lane = tid & 63, wid = tid >> 6, wm = wid >> 1, wn = wid & 1;
  f32x4 acc[2][4];
#pragma unroll
  for (int i = 0; i < 2; ++i)
#pragma unroll
    for (int j = 0; j < 4; ++j) acc[i][j] = (f32x4){0.f, 0.f, 0.f, 0.f};
  for (int k0 = 0; k0 < K; k0 += 64) {
#pragma unroll
    for (int i = 0; i < 2; ++i) {
      const int idx = tid + i * 512, r = idx >> 3, c = (idx & 7) * 8;
      *(uint4*)(As + r * 72 + c) = *(const uint4*)(A + (size_t)(m0 + r) * K + k0 + c);
      *(uint4*)(Bs + r * 72 + c) = *(const uint4*)(Bt + (size_t)(n0 + r) * K + k0 + c);
    }
    wg_sync();
#pragma unroll
    for (int kk = 0; kk < 64; kk += 32) {
      bf16x8 a[2], b[4];
#pragma unroll
      for (int i = 0; i < 2; ++i) a[i] = *(const bf16x8*)(As + (wm * 32 + i * 16 + (lane & 15)) * 72 + kk + (lane >> 4) * 8);
#pragma unroll
      for (int j = 0; j < 4; ++j) b[j] = *(const bf16x8*)(Bs + (wn * 64 + j * 16 + (lane & 15)) * 72 + kk + (lane >> 4) * 8);
#pragma unroll
      for (int i = 0; i < 2; ++i)
#pragma unroll
        for (int j = 0; j < 4; ++j) acc[i][j] = __builtin_amdgcn_mfma_f32_16x16x32_bf16(a[i], b[j], acc[i][j], 0, 0, 0);
    }
    wg_sync();
  }
#pragma unroll
  for (int i = 0; i < 2; ++i)
#pragma unroll
    for (int j = 0; j < 4; ++j)
#pragma unroll
      for (int r = 0; r < 4; ++r) {
        const int row = m0 + wm * 32 + i * 16 + (lane >> 4) * 4 + r, col = n0 + wn * 64 + j * 16 + (lane & 15);
        if (mode == 0) ((bf16_t*)outp)[(size_t)row * ldc + col] = f2bf(acc[i][j][r]);
        else ((float*)outp)[(size_t)row * ldc + col] = acc[i][j][r];
      }
}
__device__ __forceinline__ void gemm_phase(const bf16_t* A, const bf16_t* Bt, int K, int N, int mode, void* outp, int ldc, unsigned char* smem) {
  const int ntn = N / 128, ntm = M_ / 128;
  for (int t = blockIdx.x; t < ntn * ntm; t += gridDim.x) {
    const int tn = t % ntn, tm = t / ntn;
    gemm_tile(A, Bt, K, tm * 128, tn * 128, mode, outp, ldc, smem);
  }
}

namespace pg8 {
#define PG8_LAS __attribute__((address_space(3)))
typedef unsigned short bf16_t;
typedef short bf16x8 __attribute__((ext_vector_type(8)));
typedef float f32x4 __attribute__((ext_vector_type(4)));
typedef unsigned u32x4 __attribute__((ext_vector_type(4)));
constexpr int BM = 256, BK = 64, HALF = 128, HTB = HALF * BK * 2  , STAGE_BYTES = 8 * HTB, NXCD = 8, WGM = 8;

__host__ __device__ __forceinline__ int lds_byte(int r, int c) { const int st = (r >> 4) * 2 + (c >> 5), rr = r & 15, cc = c & 31, ob = rr * 64 + cc * 2; return st * 1024 + (ob ^ (((ob >> 9) & 1) << 5)); }
__host__ __device__ __forceinline__ void stage_rc(int b, int& R, int& C) { const int st = b / 1024, sb = b % 1024, swz = sb ^ (((sb >> 9) & 1) << 5); R = (st >> 1) * 16 + swz / 64; C = (st & 1) * 32 + (swz % 64) / 2; }
__host__ __device__ __forceinline__ int perm32(int rho) { const int n = rho >> 4, i = rho & 15; return 8 * (i >> 2) + 4 * n + (i & 3); }

__device__ __forceinline__ unsigned cvtpk(float lo, float hi) { typedef float f2 __attribute__((ext_vector_type(2))); typedef __bf16 b2 __attribute__((ext_vector_type(2))); f2 v = {lo, hi}; b2 b = __builtin_convertvector(v, b2); return __builtin_bit_cast(unsigned, b); }
template <int M> __device__ __forceinline__ float xsum_sw(float v) { return v + __int_as_float(__builtin_amdgcn_ds_swizzle(__float_as_int(v), (M << 10) | 0x1f)); }
struct Unit { int pm, pn; };
struct Gemm { const bf16_t* A; const bf16_t* Bt; int M, N, K; };

struct StaticOrder {
    int nM, nN, nwg, G, c;
    __host__ __device__ __forceinline__ void init(int M, int N, int G_, int c_) { nM = M / BM; nN = N / BM; nwg = nM * nN; G = G_; c = c_; }
    __host__ __device__ bool next(int i, Unit& u) const {
        const long L = (long)i * G + c; if (L >= nwg) return false;
        int wgid = (int)L; { const int q = nwg / NXCD, r = nwg % NXCD, xcd = wgid % NXCD, off = wgid / NXCD; wgid = (xcd < r ? xcd * (q + 1) : r * (q + 1) + (xcd - r) * q) + off; }
        const int nig = WGM * nN, gid = wgid / nig, fm = gid * WGM, gsz = (nM - fm) < WGM ? (nM - fm) : WGM;
        u.pm = fm + ((wgid % nig) % gsz); u.pn = (wgid % nig) / gsz; return true;
    }
    __device__ __forceinline__ void a_ready(const Unit&) const {}
    __device__ __forceinline__ void done(const Unit&) const {}
};


struct EpiBf16s {
    static constexpr bool PERM = true, AFTER_DRAIN = false;
    bf16_t* O; int ldc;
    unsigned qmask; float qscale;
    float* km; int km_pn0;
    __device__ __forceinline__ void operator()(const f32x4 (&acc)[2][2][4][2], const Unit& u, int wr, int wc, int fr, int fq) const {
        const int row0 = u.pm * BM + wr * 64 + fr, col0 = u.pn * BM + wc * 32 + 8 * fq;
        const float sc = ((qmask >> u.pn) & 1u) ? qscale : 1.f;
#pragma unroll
        for (int ai = 0; ai < 2; ++ai)
#pragma unroll
            for (int m = 0; m < 4; ++m) { bf16_t* rowp = O + (size_t)(row0 + ai * HALF + m * 16) * ldc + col0;
#pragma unroll
                for (int bj = 0; bj < 2; ++bj) { const f32x4 v0 = acc[ai][bj][m][0] * sc, v1 = acc[ai][bj][m][1] * sc;
                    u32x4 w; w.x = cvtpk(v0[0], v0[1]); w.y = cvtpk(v0[2], v0[3]); w.z = cvtpk(v1[0], v1[1]); w.w = cvtpk(v1[2], v1[3]);
                    *(u32x4*)(rowp + bj * HALF) = w; } }
        if (km != nullptr && (u.pn == km_pn0 || u.pn == km_pn0 + 1)) {
#pragma unroll
            for (int bj = 0; bj < 2; ++bj)
#pragma unroll
                for (int n = 0; n < 2; ++n) {
                    f32x4 sacc = (f32x4){0.f, 0.f, 0.f, 0.f};
#pragma unroll
                    for (int ai = 0; ai < 2; ++ai)
#pragma unroll
                        for (int m = 0; m < 4; ++m) sacc += acc[ai][bj][m][n];
#pragma unroll
                    for (int e = 0; e < 4; ++e) { float v = sacc[e]; v = xsum_sw<1>(v); v = xsum_sw<2>(v); v = xsum_sw<4>(v); v = xsum_sw<8>(v); sacc[e] = v; }
                    if (fr == 0) { float* dst = km + (size_t)u.pm * 512 + (u.pn - km_pn0) * BM + bj * HALF + wc * 32 + 8 * fq + 4 * n;
#pragma unroll
                        for (int e = 0; e < 4; ++e) atomicAdd(dst + e, sacc[e] * (1.0f / 256.0f)); }
                }
        }
    }
};
struct EpiF32 {
    static constexpr bool PERM = false, AFTER_DRAIN = false;
    float* O; int ldc;
    __device__ __forceinline__ void operator()(const f32x4 (&acc)[2][2][4][2], const Unit& u, int wr, int wc, int fr, int fq) const {
        const int col0 = u.pn * BM + wc * 32 + 4 * fq;
#pragma unroll
        for (int ai = 0; ai < 2; ++ai)
#pragma unroll
            for (int m = 0; m < 4; ++m) { float* rowp = O + (size_t)(u.pm * BM + ai * HALF + wr * 64 + m * 16 + fr) * ldc + col0;
#pragma unroll
                for (int bj = 0; bj < 2; ++bj)
#pragma unroll
                    for (int n = 0; n < 2; ++n) *(f32x4*)(rowp + bj * HALF + n * 16) = acc[ai][bj][m][n]; }
    }
};

struct PanelStats {
    unsigned* xbuf;
    unsigned* cnt;
    unsigned* tmo;
    int ntn; float eps;
    unsigned code;
    __device__ __forceinline__ bool run(const f32x4 (&v)[2][2][4][2], const Unit& u, int wr, int wc, int fr, int fq, PG8_LAS unsigned char* lds, int wid, int lane) const {
        typedef float f32x2v __attribute__((ext_vector_type(2)));
        PG8_LAS f32x2v* P = (PG8_LAS f32x2v*)lds;
        PG8_LAS f32x2v* S = (PG8_LAS f32x2v*)(lds + 8192);
        PG8_LAS unsigned* flag = (PG8_LAS unsigned*)(lds + 8192 + 2048);
#pragma unroll
        for (int ai = 0; ai < 2; ++ai)
#pragma unroll
            for (int m = 0; m < 4; ++m) {
                float s = 0.f;
#pragma unroll
                for (int bj = 0; bj < 2; ++bj)
#pragma unroll
                    for (int n = 0; n < 2; ++n) { const f32x4 x = v[ai][bj][m][n]; s += (x[0] + x[1]) + (x[2] + x[3]); }
                s += __shfl_xor(s, 16); s += __shfl_xor(s, 32);
                const float mw = s * (1.0f / 64.0f); float q = 0.f;
#pragma unroll
                for (int bj = 0; bj < 2; ++bj)
#pragma unroll
                    for (int n = 0; n < 2; ++n) { const f32x4 d = v[ai][bj][m][n] - mw; q += (d[0] * d[0] + d[1] * d[1]) + (d[2] * d[2] + d[3] * d[3]); }
                q += __shfl_xor(q, 16); q += __shfl_xor(q, 32);
                if (fq == 0) P[(ai * HALF + wr * 64 + m * 16 + fr) * 4 + wc] = (f32x2v){mw, q};
            }
        asm volatile("s_waitcnt lgkmcnt(0)" ::: "memory"); __builtin_amdgcn_s_barrier(); asm volatile("" ::: "memory");
#if defined(BROKEN_EXCHANGE_NO_WAIT)
#warning BROKEN CONTROL BUILD: the row-statistics exchange does not wait; results are wrong by design
        if (blockIdx.x >= 64) { const long long t0_ = clock64(); while (clock64() - t0_ < 60000) __builtin_amdgcn_s_sleep(8); }
#endif
        const int row = wid * 32 + (lane & 31);
        if (lane < 32) {
            const f32x2v a = P[row * 4 + 0], b = P[row * 4 + 1], c = P[row * 4 + 2], d = P[row * 4 + 3];
            const float mt = (a.x + b.x + c.x + d.x) * 0.25f;
            const float da = a.x - mt, db = b.x - mt, dc = c.x - mt, dd = d.x - mt;
            const float m2 = (a.y + b.y) + (c.y + d.y) + 64.0f * ((da * da + db * db) + (dc * dc + dd * dd));
            unsigned long long* slot = (unsigned long long*)xbuf + ((size_t)(u.pm * BM + row) * 4 + u.pn);
            __hip_atomic_store(slot, ((unsigned long long)__float_as_uint(m2) << 32) | __float_as_uint(mt), __ATOMIC_RELAXED, __HIP_MEMORY_SCOPE_AGENT);
        }
        asm volatile("s_waitcnt vmcnt(0)" ::: "memory");
        if (lane == 0) __hip_atomic_fetch_add(cnt + 64 * u.pm, 1u, __ATOMIC_RELAXED, __HIP_MEMORY_SCOPE_AGENT);
        if (wid == 0) {
            bool dead = false; const unsigned long long t0 = __builtin_amdgcn_s_memrealtime(); const unsigned want = 8u * (unsigned)ntn;
            for (;;) {
#if defined(BROKEN_EXCHANGE_NO_WAIT)
                break;
#endif
                if ((unsigned)__builtin_amdgcn_readfirstlane(__hip_atomic_load(cnt + 64 * u.pm, __ATOMIC_RELAXED, __HIP_MEMORY_SCOPE_AGENT)) >= want) break;
                if (__builtin_amdgcn_s_memrealtime() - t0 > 2000000ull) {
                    if (lane == 0) { unsigned expect = 0u; __hip_atomic_compare_exchange_strong(tmo + 1, &expect, code | (unsigned)(u.pm & 0xff), __ATOMIC_RELAXED, __ATOMIC_RELAXED, __HIP_MEMORY_SCOPE_AGENT);
                                     __hip_atomic_store(tmo, 1u, __ATOMIC_RELAXED, __HIP_MEMORY_SCOPE_AGENT); }
                    dead = true; break; }
                __builtin_amdgcn_s_sleep(2);
            }
            __builtin_amdgcn_fence(__ATOMIC_ACQUIRE, "agent");
            if (lane == 0) flag[0] = dead ? 1u : 0u;
        }
        asm volatile("s_waitcnt vmcnt(0) lgkmcnt(0)" ::: "memory"); __builtin_amdgcn_s_barrier(); asm volatile("" ::: "memory");
        const bool bad = flag[0] != 0u;
        if (lane < 32) {
            const unsigned long long* slot = (const unsigned long long*)xbuf + (size_t)(u.pm * BM + row) * 4; float mt[4], m2[4]; float ms = 0.f;
#pragma unroll
            for (int t = 0; t < 4; ++t) { if (t < ntn) { const unsigned long long w = __hip_atomic_load(slot + t, __ATOMIC_RELAXED, __HIP_MEMORY_SCOPE_AGENT); mt[t] = __uint_as_float((unsigned)w); m2[t] = __uint_as_float((unsigned)(w >> 32)); } else { mt[t] = 0.f; m2[t] = 0.f; } ms += mt[t]; }
            const float mean = ms / (float)ntn; float q = 0.f;
#pragma unroll
            for (int t = 0; t < 4; ++t) if (t < ntn) { const float dm = mt[t] - mean; q += m2[t] + 256.0f * dm * dm; }
            S[row] = (f32x2v){mean, 1.0f / sqrtf(q / (256.0f * (float)ntn) + eps)};
        }
        asm volatile("s_waitcnt lgkmcnt(0)" ::: "memory"); __builtin_amdgcn_s_barrier(); asm volatile("" ::: "memory");
        return bad;
    }
};

struct EpiLn {
    static constexpr bool PERM = false, AFTER_DRAIN = true;
    const float* base; float* out; bf16_t* outb; int ldc; const float* gam; const float* bet; PanelStats st; float alpha;
    __device__ __forceinline__ void fused(f32x4 (&acc)[2][2][4][2], const Unit& u, int wr, int wc, int fr, int fq, PG8_LAS unsigned char* lds, int wid, int lane) const {
        typedef float f32x2v __attribute__((ext_vector_type(2))); typedef unsigned u32x2v __attribute__((ext_vector_type(2)));
        const PG8_LAS f32x2v* S = (const PG8_LAS f32x2v*)(lds + 8192);
        const int col0 = u.pn * BM + wc * 32 + 4 * fq;
#pragma unroll
        for (int ai = 0; ai < 2; ++ai) {
            f32x4 bs[4][2][2];
#pragma unroll
            for (int m = 0; m < 4; ++m) { const size_t off = (size_t)(u.pm * BM + ai * HALF + wr * 64 + m * 16 + fr) * ldc + col0;
#pragma unroll
                for (int bj = 0; bj < 2; ++bj)
#pragma unroll
                    for (int n = 0; n < 2; ++n) bs[m][bj][n] = *(const f32x4*)(base + off + bj * HALF + n * 16); }
#pragma unroll
            for (int m = 0; m < 4; ++m) {
#pragma unroll
                for (int bj = 0; bj < 2; ++bj)
#pragma unroll
                    for (int n = 0; n < 2; ++n) acc[ai][bj][m][n] += bs[m][bj][n] * alpha;
                asm volatile("" : "+v"(acc[ai][0][m][0]), "+v"(acc[ai][0][m][1]), "+v"(acc[ai][1][m][0]), "+v"(acc[ai][1][m][1])); }
            asm volatile("" ::: "memory"); }
        const bool bad = st.run(acc, u, wr, wc, fr, fq, lds, wid, lane);
        const float qnan = __builtin_nanf("");
        f32x4 gv[2][2], bv[2][2];
#pragma unroll
        for (int bj = 0; bj < 2; ++bj)
#pragma unroll
            for (int n = 0; n < 2; ++n) { gv[bj][n] = *(const f32x4*)(gam + col0 + bj * HALF + n * 16); bv[bj][n] = *(const f32x4*)(bet + col0 + bj * HALF + n * 16); }
#pragma unroll
        for (int ai = 0; ai < 2; ++ai)
#pragma unroll
            for (int m = 0; m < 4; ++m) { const int r = ai * HALF + wr * 64 + m * 16 + fr; const f32x2v sr = S[r]; const size_t off = (size_t)(u.pm * BM + r) * ldc + col0;
#pragma unroll
                for (int bj = 0; bj < 2; ++bj)
#pragma unroll
                    for (int n = 0; n < 2; ++n) { f32x4 o = (acc[ai][bj][m][n] - sr.x) * sr.y * gv[bj][n] + bv[bj][n];
                        if (bad) o = (f32x4){qnan, qnan, qnan, qnan};
                        *(f32x4*)(out + off + bj * HALF + n * 16) = o;
                        if (outb) { u32x2v w; w.x = cvtpk(o[0], o[1]); w.y = cvtpk(o[2], o[3]); *(u32x2v*)(outb + off + bj * HALF + n * 16) = w; } }
                asm volatile("" ::: "memory"); }
    }
};

template <class Epi, class Sched, bool ALIGN_EPI = false, bool SP2 = false>
__device__ __forceinline__ void gemm_phase(PG8_LAS unsigned char* lds, const Gemm g, const Sched& S, const Epi& E) {
    const int tid = otid(), wid = __builtin_amdgcn_readfirstlane(tid >> 6), lane = tid & 63, wr = wid >> 2, wc = wid & 3, fr = lane & 15, fq = lane >> 4;
    const int K = g.K, nt = K / BK;
    unsigned voffA[2], voffB[2];
#pragma unroll
    for (int i = 0; i < 2; ++i) { int R, C; stage_rc(tid * 16 + i * 8192, R, C); const int Rb = Epi::PERM ? ((R & ~31) + perm32(R & 31)) : R;
        voffA[i] = (unsigned)(R * K + C) * 2u; voffB[i] = (unsigned)(Rb * K + C) * 2u; }
    const size_t kstep = (size_t)(BK * 2);
    const size_t hstep = (size_t)HALF * K * 2;
    const size_t tstep = 2 * hstep;
    const unsigned ldsw = (unsigned)wid * 1024u;
    const int aoff = lds_byte(wr * 64 + fr, fq * 8), boff = lds_byte(wc * 32 + fr, fq * 8);
#define PG8_SA(b, h) (((b) * 2 + (h)) * HTB)
#define PG8_SB(b, h) ((4 + (b) * 2 + (h)) * HTB)
#define PG8_STAGE(bufoff, gbase, voff) do { _Pragma("unroll") for (int _i = 0; _i < 2; ++_i) \
        __builtin_amdgcn_global_load_lds((const unsigned*)((const char*)(gbase) + (voff)[_i]), (PG8_LAS unsigned*)(lds + (bufoff) + ldsw + _i * 8192), 16, 0, 0); } while (0)
#define PG8_LDA(dst, b, h) do { _Pragma("unroll") for (int m = 0; m < 4; ++m) _Pragma("unroll") for (int k = 0; k < 2; ++k) dst[m][k] = *(const PG8_LAS bf16x8*)(lds + PG8_SA(b, h) + aoff + m * 2048 + k * 1024); } while (0)
#define PG8_LDB(dst, b, h) do { _Pragma("unroll") for (int n = 0; n < 2; ++n) _Pragma("unroll") for (int k = 0; k < 2; ++k) dst[n][k] = *(const PG8_LAS bf16x8*)(lds + PG8_SB(b, h) + boff + n * 2048 + k * 1024); } while (0)
#define PG8_MMA(ai, bj, At, Bt) do { __builtin_amdgcn_s_setprio(1); _Pragma("unroll") for (int m = 0; m < 4; ++m) _Pragma("unroll") for (int n = 0; n < 2; ++n) _Pragma("unroll") for (int k = 0; k < 2; ++k) \
        acc[ai][bj][m][n] = __builtin_amdgcn_mfma_f32_16x16x32_bf16(Bt[n][k], At[m][k], acc[ai][bj][m][n], 0, 0, 0); __builtin_amdgcn_s_setprio(0); } while (0)
#define PG8_WAIT_V(n) asm volatile("s_waitcnt vmcnt(" #n ")" ::: "memory")
#define PG8_WAIT_L(n) asm volatile("s_waitcnt lgkmcnt(" #n ")" ::: "memory")
#define PG8_BAR __builtin_amdgcn_s_barrier()
#define PG8_SCHED __builtin_amdgcn_sched_barrier(0)
    Unit cur, nxt; int ui = 0;
    if (!S.next(0, cur)) return;
    f32x4 acc[2][2][4][2];
#pragma unroll
    for (int a = 0; a < 2; ++a)
#pragma unroll
        for (int b = 0; b < 2; ++b)
#pragma unroll
            for (int m = 0; m < 4; ++m)
#pragma unroll
                for (int n = 0; n < 2; ++n) acc[a][b][m][n] = (f32x4){0.f, 0.f, 0.f, 0.f};
    bf16x8 At[4][2], B0[2][2], B1[2][2];
    const char* cA = (const char*)g.A + (size_t)cur.pm * tstep; const char* cB = (const char*)g.Bt + (size_t)cur.pn * tstep;
    S.a_ready(cur);
    if constexpr (SP2) {
        PG8_STAGE(PG8_SB(0, 0), cB, voffB); PG8_STAGE(PG8_SB(0, 1), cB + hstep, voffB); PG8_STAGE(PG8_SA(0, 0), cA, voffA); PG8_STAGE(PG8_SA(0, 1), cA + hstep, voffA);
        if (wr == 1) PG8_BAR;
        PG8_WAIT_V(2); PG8_BAR;
        PG8_STAGE(PG8_SB(1, 0), cB + kstep, voffB); PG8_STAGE(PG8_SA(1, 0), cA + kstep, voffA); PG8_STAGE(PG8_SB(1, 1), cB + hstep + kstep, voffB);
        PG8_WAIT_V(6); PG8_BAR;
    } else {
        PG8_STAGE(PG8_SB(0, 0), cB, voffB); PG8_STAGE(PG8_SA(0, 0), cA, voffA); PG8_STAGE(PG8_SB(0, 1), cB + hstep, voffB); PG8_STAGE(PG8_SA(0, 1), cA + hstep, voffA);
        if (wr == 1) PG8_BAR;
        PG8_WAIT_V(4); PG8_BAR;
        PG8_STAGE(PG8_SB(1, 0), cB + kstep, voffB); PG8_STAGE(PG8_SA(1, 0), cA + kstep, voffA); PG8_STAGE(PG8_SB(1, 1), cB + hstep + kstep, voffB);
        PG8_WAIT_V(6); PG8_BAR;
    }
    for (;;) {
        const bool has_next = S.next(ui + 1, nxt);
        const char* nA = has_next ? (const char*)g.A + (size_t)nxt.pm * tstep : cA; const char* nB = has_next ? (const char*)g.Bt + (size_t)nxt.pn * tstep : cB;
        for (int t = 0; t < nt; t += 2) {
            const bool last = (t == nt - 2);
            const char* a1 = cA + (size_t)(t + 1) * kstep;
            const char* a2 = last ? nA : cA + (size_t)(t + 2) * kstep; const char* b2 = last ? nB : cB + (size_t)(t + 2) * kstep;
            const char* a3 = a2 + kstep; const char* b3 = b2 + kstep;
            if (last && has_next) S.a_ready(nxt);
            if constexpr (SP2) {
            PG8_LDB(B0, 0, 0); PG8_LDB(B1, 0, 1); PG8_SCHED; PG8_LDA(At, 0, 0); PG8_STAGE(PG8_SA(1, 1), a1 + hstep, voffA);
            PG8_WAIT_V(8); PG8_WAIT_L(0); PG8_BAR; PG8_MMA(0, 0, At, B0); PG8_MMA(0, 1, At, B1); PG8_BAR; PG8_SCHED;
            PG8_LDA(At, 0, 1); PG8_STAGE(PG8_SB(0, 0), b2, voffB); PG8_STAGE(PG8_SB(0, 1), b2 + hstep, voffB); PG8_STAGE(PG8_SA(0, 0), a2, voffA);
            PG8_WAIT_V(8); PG8_WAIT_L(0); PG8_BAR; PG8_MMA(1, 0, At, B0); PG8_MMA(1, 1, At, B1); PG8_BAR; PG8_SCHED;
            PG8_LDB(B0, 1, 0); PG8_LDB(B1, 1, 1); PG8_SCHED; PG8_LDA(At, 1, 0); PG8_STAGE(PG8_SA(0, 1), a2 + hstep, voffA);
            PG8_WAIT_V(8); PG8_WAIT_L(0); PG8_BAR; PG8_MMA(0, 0, At, B0); PG8_MMA(0, 1, At, B1); PG8_BAR; PG8_SCHED;
            PG8_LDA(At, 1, 1); PG8_STAGE(PG8_SB(1, 0), b3, voffB); PG8_STAGE(PG8_SB(1, 1), b3 + hstep, voffB); PG8_STAGE(PG8_SA(1, 0), a3, voffA);
            PG8_WAIT_V(8); PG8_WAIT_L(0); PG8_BAR; PG8_MMA(1, 0, At, B0); PG8_MMA(1, 1, At, B1); PG8_BAR; PG8_SCHED;
            } else {
            PG8_LDB(B0, 0, 0); PG8_SCHED; PG8_LDA(At, 0, 0); PG8_STAGE(PG8_SA(1, 1), a1 + hstep, voffA);
            PG8_WAIT_L(8); PG8_BAR; PG8_WAIT_L(0); PG8_MMA(0, 0, At, B0); PG8_BAR; PG8_SCHED;
            PG8_LDB(B1, 0, 1); PG8_STAGE(PG8_SB(0, 0), b2, voffB);
            PG8_BAR; PG8_WAIT_L(0); PG8_MMA(0, 1, At, B1); PG8_BAR;
            PG8_LDA(At, 0, 1); PG8_STAGE(PG8_SA(0, 0), a2, voffA);
            PG8_BAR; PG8_WAIT_L(0); PG8_MMA(1, 0, At, B0); PG8_BAR; PG8_SCHED;
            PG8_STAGE(PG8_SB(0, 1), b2 + hstep, voffB);
            PG8_WAIT_V(6); PG8_BAR; PG8_MMA(1, 1, At, B1); PG8_BAR;
            PG8_LDB(B0, 1, 0); PG8_SCHED; PG8_LDA(At, 1, 0); PG8_STAGE(PG8_SA(0, 1), a2 + hstep, voffA);
            PG8_WAIT_L(8); PG8_BAR; PG8_WAIT_L(0); PG8_MMA(0, 0, At, B0); PG8_BAR; PG8_SCHED;
            PG8_LDB(B1, 1, 1); PG8_STAGE(PG8_SB(1, 0), b3, voffB);
            PG8_BAR; PG8_WAIT_L(0); PG8_MMA(0, 1, At, B1); PG8_BAR;
            PG8_LDA(At, 1, 1); PG8_STAGE(PG8_SA(1, 0), a3, voffA);
            PG8_BAR; PG8_WAIT_L(0); PG8_MMA(1, 0, At, B0); PG8_BAR; PG8_SCHED;
            PG8_STAGE(PG8_SB(1, 1), b3 + hstep, voffB);
            PG8_WAIT_V(6); PG8_BAR; PG8_MMA(1, 1, At, B1); PG8_BAR;
            }
        }
        if constexpr (ALIGN_EPI) { if (wr == 0) PG8_BAR; }
        if constexpr (!Epi::AFTER_DRAIN) { E(acc, cur, wr, wc, fr, fq); S.done(cur); }
        if (!has_next) break;
#pragma unroll
        for (int a = 0; a < 2; ++a)
#pragma unroll
            for (int b = 0; b < 2; ++b)
#pragma unroll
                for (int m = 0; m < 4; ++m)
#pragma unroll
                    for (int n = 0; n < 2; ++n) acc[a][b][m][n] = (f32x4){0.f, 0.f, 0.f, 0.f};
        cur = nxt; cA = nA; cB = nB; ++ui;
        if constexpr (ALIGN_EPI) { if (wr == 1) PG8_BAR; }
    }
    PG8_WAIT_V(0);
    if constexpr (!ALIGN_EPI) { if (wr == 0) PG8_BAR; }
    PG8_BAR;
    if constexpr (Epi::AFTER_DRAIN) { E.fused(acc, cur, wr, wc, fr, fq, lds, wid, lane); S.done(cur); }
#undef PG8_SA
#undef PG8_SB
#undef PG8_STAGE
#undef PG8_LDA
#undef PG8_LDB
#undef PG8_MMA
#undef PG8_WAIT_V
#undef PG8_WAIT_L
#undef PG8_BAR
#undef PG8_SCHED
}
}

__device__ __forceinline__ void ln_phase(const float* xin, const float* Y, const float* g, const float* bb, float* out, bf16_t* outb) {
  const int lane = otid() & 63, wid = otid() >> 6;
  for (int row = blockIdx.x * 8 + wid; row < M_; row += gridDim.x * 8) {
    const float4* xr = (const float4*)(xin + (size_t)row * D_);
    const float4* yr = (const float4*)(Y + (size_t)row * D_);
    float4 v[4]; float s = 0.f;
#pragma unroll
    for (int j = 0; j < 4; ++j) {
      const float4 a = xr[j * 64 + lane], y = yr[j * 64 + lane];
      v[j].x = ALPHA * a.x + y.x; v[j].y = ALPHA * a.y + y.y; v[j].z = ALPHA * a.z + y.z; v[j].w = ALPHA * a.w + y.w;
      s += (v[j].x + v[j].y) + (v[j].z + v[j].w);
    }
    const float mean = wave_sum(s) * (1.f / D_);
    float q = 0.f;
#pragma unroll
    for (int j = 0; j < 4; ++j) {
      v[j].x -= mean; v[j].y -= mean; v[j].z -= mean; v[j].w -= mean;
      q += (v[j].x * v[j].x + v[j].y * v[j].y) + (v[j].z * v[j].z + v[j].w * v[j].w);
    }
    const float rstd = 1.f / sqrtf(wave_sum(q) * (1.f / D_) + LN_EPS);
#pragma unroll
    for (int j = 0; j < 4; ++j) {
      const float4 gg = ((const float4*)g)[j * 64 + lane], bv = ((const float4*)bb)[j * 64 + lane];
      float4 o;
      o.x = v[j].x * rstd * gg.x + bv.x; o.y = v[j].y * rstd * gg.y + bv.y; o.z = v[j].z * rstd * gg.z + bv.z; o.w = v[j].w * rstd * gg.w + bv.w;
      ((float4*)(out + (size_t)row * D_))[j * 64 + lane] = o;
      if (outb) {
        ushort4 ob; ob.x = f2bf(o.x); ob.y = f2bf(o.y); ob.z = f2bf(o.z); ob.w = f2bf(o.w);
        ((ushort4*)(outb + (size_t)row * D_))[j * 64 + lane] = ob;
      }
    }
  }
}

__device__ __forceinline__ void compress_item(const Params& P, int item, float* sm) {
  const bf16_t* H0 = (const bf16_t*)(P.ws + WS_H);
  const int tid = otid();
  const int g = item & 1; int r = item >> 1; const int n = r % NCMP; r /= NCMP; const int b = r & 3; const int i = r >> 2;
  const float* pos = P.in[2] + i * 2048;
  const float* w1 = P.in[3] + (size_t)i * 2048 * 128;
  const float* b1 = P.in[4] + i * 128;
  const float* w2 = P.in[5] + (size_t)i * 128 * 64;
  float* blk = sm;
  float* part = sm + 2048;
  float* hid = sm + 2048 + 512;
  const int col = (i == 0 ? C_KCMP : C_VCMP) + g * 64;
#pragma unroll
  for (int k = 0; k < 4; ++k) {
    const int f = tid + k * 512, l = f >> 6, d = f & 63;
    blk[f] = bf2f(H0[((size_t)b * S_ + 16 * n + l) * P0 + col + d]) + pos[f];
  }
  wg_sync();
  const int hh = tid & 127, pt = tid >> 7;
  float acc = 0.f;
  for (int f = pt * 512; f < pt * 512 + 512; ++f) acc += blk[f] * w1[(size_t)f * 128 + hh];
  part[pt * 128 + hh] = acc;
  wg_sync();
  if (tid < 128) {
    const float a = part[tid] + part[128 + tid] + part[256 + tid] + part[384 + tid] + b1[tid];
    hid[tid] = silu_f(a);
  }
  wg_sync();
  if (tid < 64) {
    float o = 0.f;
    for (int k = 0; k < 128; ++k) o += hid[k] * w2[k * 64 + tid];
    float* dst = (float*)(P.ws + (i == 0 ? WS_KC : WS_VC));
    dst[(((size_t)b * NCMP + n) * 2 + g) * 64 + tid] = o;
    bf16_t* dstb = (bf16_t*)(P.ws + (i == 0 ? (size_t)(248 * MiB) : (size_t)(249 * MiB)));
    dstb[(((size_t)b * 2 + g) * 256 + n) * 64 + tid] = f2bf(o);
    if (n == 0) dstb[(((size_t)b * 2 + g) * 256 + 255) * 64 + tid] = 0;
  }
  wg_sync();
}
__device__ __forceinline__ void kmean_item(const Params& P, int item, int lane) {
  const bf16_t* H0 = (const bf16_t*)(P.ws + WS_H);
  const int h = item & 7, n = (item >> 3) & 15, b = item >> 7;
  float s = 0.f;
  for (int k = 0; k < 256; ++k) s += bf2f(H0[((size_t)b * S_ + n * 256 + k) * P0 + C_MK + h * 64 + lane]);
  ((float*)(P.ws + WS_KM))[(((size_t)b * 16 + n) * 8 + h) * 64 + lane] = s * (1.f / 256.f);
}


constexpr size_t WS_W1T = 250 * MiB;
constexpr size_t WS_W2T = 251 * MiB;
constexpr size_t WS_C1P = 252 * MiB;
__device__ __forceinline__ void compress_mfma_tile(const Params& P, int tile, unsigned char* smem_g) {
  const bf16_t* __restrict__ H0 = (const bf16_t*)(P.ws + WS_H);
  const int tid = otid(), lane = tid & 63, wid = __builtin_amdgcn_readfirstlane(tid >> 6), g = lane >> 4, ii = lane & 15;
  const int i = tile >> 7, R0 = (tile & 127) * 16;
  bf16_t* hs = (bf16_t*)smem_g;
  {
    const int R = min(R0 + ii, 2039), b = R / 510, rem = R - b * 510, n = rem >> 1, grp = rem & 1;
    const bf16_t* abase = H0 + ((size_t)b * S_ + 16 * n) * P0 + (i == 0 ? C_KCMP : C_VCMP) + grp * 64 + 8 * g;
    const bf16_t* bbase = (const bf16_t*)(P.ws + WS_W1T) + (size_t)(i * 128 + 16 * wid + ii) * 2048 + 8 * g;
    f32x4 acc = (f32x4){0.f, 0.f, 0.f, 0.f};
#pragma unroll 16
    for (int ks = 0; ks < 64; ++ks) {
      const bf16x8 a = *(const bf16x8*)(abase + (size_t)(ks >> 1) * P0 + (ks & 1) * 32);
      const bf16x8 bq = *(const bf16x8*)(bbase + ks * 32);
      acc = __builtin_amdgcn_mfma_f32_16x16x32_bf16(a, bq, acc, 0, 0, 0);
    }
    const int col = 16 * wid + ii;
    float bias = P.in[4][i * 128 + col];
    const float* c1p = (const float*)(P.ws + WS_C1P) + i * 32 * 128 + col;
#pragma unroll 8
    for (int q = 0; q < 32; ++q) bias += c1p[q * 128];
#pragma unroll
    for (int r = 0; r < 4; ++r) hs[(4 * g + r) * 136 + col] = f2bf(silu_f(acc[r] + bias));
  }
  wg_sync();
  if (wid < 4) {
    const bf16_t* b2 = (const bf16_t*)(P.ws + WS_W2T) + (size_t)(i * 64 + 16 * wid + ii) * 128 + 8 * g;
    f32x4 acc = (f32x4){0.f, 0.f, 0.f, 0.f};
#pragma unroll
    for (int k2 = 0; k2 < 4; ++k2) {
      const bf16x8 a = *(const bf16x8*)(hs + ii * 136 + 32 * k2 + 8 * g);
      const bf16x8 bq = *(const bf16x8*)(b2 + 32 * k2);
      acc = __builtin_amdgcn_mfma_f32_16x16x32_bf16(a, bq, acc, 0, 0, 0);
    }
    bf16_t* dst = (bf16_t*)(P.ws + (i == 0 ? (size_t)(248 * MiB) : (size_t)(249 * MiB)));
#pragma unroll
    for (int r = 0; r < 4; ++r) {
      const int R = R0 + 4 * g + r;
      if (R < 2040) { const int b = R / 510, rem = R - b * 510, n = rem >> 1, grp = rem & 1;
        dst[(((size_t)b * 2 + grp) * 256 + n) * 64 + 16 * wid + ii] = f2bf(acc[r]); }
    }
  }
  wg_sync();
}
__device__ __forceinline__ void kmean_item2(const Params& P, int item) {
  const bf16_t* __restrict__ H0 = (const bf16_t*)(P.ws + WS_H);
  const int tid = otid();
  const bf16_t* src = H0 + ((size_t)(item >> 4) * S_ + (item & 15) * 256) * P0 + C_MK + tid;
  float s0 = 0.f, s1 = 0.f, s2 = 0.f, s3 = 0.f;
#pragma unroll 4
  for (int r = 0; r < 256; r += 4) {
    s0 += bf2f(src[(size_t)r * P0]); s1 += bf2f(src[(size_t)(r + 1) * P0]); s2 += bf2f(src[(size_t)(r + 2) * P0]); s3 += bf2f(src[(size_t)(r + 3) * P0]);
  }
  ((float*)(P.ws + WS_KM))[(size_t)item * 512 + tid] = ((s0 + s1) + (s2 + s3)) * (1.f / 256.f);
}

template <int NH>
__device__ __forceinline__ void attend_block(const bf16_t* __restrict__ Kp, const bf16_t* __restrict__ Vp, size_t rowbase, int kp0, int t, int kmin,
                                             const float* qs, float* pb, const float* slope, float* m, float* l, float* o, int lane) {
  asm volatile("" ::: "memory");
  const int kp = kp0 + lane;
  const bool valid = (kp <= t) && (kp >= kmin);
  const uint4* kr = (const uint4*)(Kp + (rowbase + kp) * P0);
  float dot[NH];
#pragma unroll
  for (int j = 0; j < NH; ++j) dot[j] = 0.f;
#pragma unroll 1
  for (int c = 0; c < 8; ++c) {
    asm volatile("" ::: "memory");
    const uint4 u = kr[c];
    float kv[8];
    kv[0] = __uint_as_float(u.x << 16); kv[1] = __uint_as_float(u.x & 0xffff0000u);
    kv[2] = __uint_as_float(u.y << 16); kv[3] = __uint_as_float(u.y & 0xffff0000u);
    kv[4] = __uint_as_float(u.z << 16); kv[5] = __uint_as_float(u.z & 0xffff0000u);
    kv[6] = __uint_as_float(u.w << 16); kv[7] = __uint_as_float(u.w & 0xffff0000u);
#pragma unroll
    for (int j = 0; j < NH; ++j) {
      const float4 q0 = *(const float4*)(qs + j * 64 + c * 8), q1 = *(const float4*)(qs + j * 64 + c * 8 + 4);
      dot[j] += kv[0] * q0.x + kv[1] * q0.y + kv[2] * q0.z + kv[3] * q0.w + kv[4] * q1.x + kv[5] * q1.y + kv[6] * q1.z + kv[7] * q1.w;
    }
  }
#pragma unroll
  for (int j = 0; j < NH; ++j) {
    const float s = valid ? 0.125f * dot[j] - slope[j] * (float)(t - kp) : -1e30f;
    const float mn = fmaxf(m[j], wave_max(s));
    const float al = __expf(m[j] - mn);
    const float p = valid ? __expf(s - mn) : 0.f;
    l[j] = l[j] * al + wave_sum(p);
    o[j] *= al; m[j] = mn;
    pb[j * 64 + lane] = p;
  }
  __builtin_amdgcn_wave_barrier();
  const bf16_t* vr = Vp + (rowbase + kp0) * P0 + lane;
#pragma unroll 8
  for (int k = 0; k < 64; ++k) {
    const float v = bf2f(vr[(size_t)k * P0]);
#pragma unroll
    for (int j = 0; j < NH; ++j) o[j] += pb[j * 64 + k] * v;
  }
  __builtin_amdgcn_wave_barrier();
}

__device__ __forceinline__ void nsa_item(const Params& P, int b, int g, int t, float* wsm, int lane) {
  const bf16_t* H0 = (const bf16_t*)(P.ws + WS_H);
  const float* KC = (const float*)(P.ws + WS_KC);
  const float* VC = (const float*)(P.ws + WS_VC);
  bf16_t* MIX = (bf16_t*)(P.ws + WS_MIX);
  float* qs = wsm;
  float* pc = wsm + 256;
  float* pb = wsm + 1280;
  const size_t row = (size_t)b * S_ + t;
  const bf16_t* hrow = H0 + row * P0;
  float slope[4];
#pragma unroll
  for (int j = 0; j < 4; ++j) { qs[j * 64 + lane] = bf2f(hrow[C_NQ + (g * 4 + j) * 64 + lane]); slope[j] = exp2f(-(float)(g * 4 + j + 1)); }
  __builtin_amdgcn_wave_barrier();
  const int nv = t >= 31 ? (t - 31) / 16 + 1 : 0;
#pragma unroll 1
  for (int c = 0; c < 4; ++c) {
    asm volatile("" ::: "memory");
    const int n = c * 64 + lane;
    float dot[4] = {0.f, 0.f, 0.f, 0.f};
    if (n < nv) {
      const float4* kr = (const float4*)(KC + (((size_t)b * NCMP + n) * 2 + g) * 64);
#pragma unroll 4
      for (int d4 = 0; d4 < 16; ++d4) {
        const float4 kv = kr[d4];
#pragma unroll
        for (int j = 0; j < 4; ++j) {
          const float4 q = *(const float4*)(qs + j * 64 + d4 * 4);
          dot[j] += kv.x * q.x + kv.y * q.y + kv.z * q.z + kv.w * q.w;
        }
      }
    }
#pragma unroll
    for (int j = 0; j < 4; ++j) pc[j * 256 + n] = (n < nv) ? 0.125f * dot[j] - slope[j] * (float)(t - (16 * n + 31)) : -1e30f;
  }
  __builtin_amdgcn_wave_barrier();
#pragma unroll
  for (int j = 0; j < 4; ++j) {
    float sc[4];
#pragma unroll
    for (int c = 0; c < 4; ++c) sc[c] = pc[j * 256 + c * 64 + lane];
    float mx = fmaxf(fmaxf(sc[0], sc[1]), fmaxf(sc[2], sc[3]));
    mx = wave_max(mx);
    float sum = 0.f;
#pragma unroll
    for (int c = 0; c < 4; ++c) { const int n = c * 64 + lane; const float p = (n < nv) ? __expf(sc[c] - mx) : 0.f; sc[c] = p; sum += p; }
    sum = wave_sum(sum);
    const float inv = nv > 0 ? 1.f / sum : 0.f;
#pragma unroll
    for (int c = 0; c < 4; ++c) pc[j * 256 + c * 64 + lane] = sc[c] * inv;
  }
  __builtin_amdgcn_wave_barrier();
  float ocmp[4] = {0.f, 0.f, 0.f, 0.f};
  for (int n = 0; n < nv; ++n) {
    const float v = VC[(((size_t)b * NCMP + n) * 2 + g) * 64 + lane];
#pragma unroll
    for (int j = 0; j < 4; ++j) ocmp[j] += pc[j * 256 + n] * v;
  }
  float imp = 0.f;
  {
    const int lo = max(0, 4 * lane - 1), hi = min(NCMP - 1, 4 * lane + 3);
    for (int n = lo; n <= hi; ++n) imp += (pc[n] + pc[256 + n]) + (pc[512 + n] + pc[768 + n]);
  }
  const int cur = t >> 6;
  const bool bvalid = lane <= cur;
  const bool forced = (lane == 0) || (lane == cur) || (lane == cur - 1);
  const float key = bvalid ? (forced ? 1e9f : imp) : -1e30f;
  int rank = 0;
  for (int s2 = 0; s2 < 64; ++s2) {
    const float ks = __shfl(key, s2);
    rank += (ks > key || (ks == key && s2 < lane)) ? 1 : 0;
  }
  const unsigned long long selmask = __ballot(bvalid && rank < 16);
  float m[4], l[4], osel[4], owin[4];
#pragma unroll
  for (int j = 0; j < 4; ++j) { m[j] = -1e30f; l[j] = 0.f; osel[j] = 0.f; }
  {
    unsigned long long mk = selmask;
    while (mk) {
      const int blk = __builtin_ctzll(mk); mk &= mk - 1;
      attend_block<4>(H0 + C_KSEL + g * 64, H0 + C_VSEL + g * 64, (size_t)b * S_, blk * 64, t, 0, qs, pb, slope, m, l, osel, lane);
    }
  }
#pragma unroll
  for (int j = 0; j < 4; ++j) { osel[j] /= l[j]; m[j] = -1e30f; l[j] = 0.f; owin[j] = 0.f; }
  {
    const int kmin = t - 511;
    const int b0 = (kmin > 0 ? kmin : 0) >> 6;
    for (int blk = b0; blk <= cur; ++blk)
      attend_block<4>(H0 + C_KWIN + g * 64, H0 + C_VWIN + g * 64, (size_t)b * S_, blk * 64, t, kmin, qs, pb, slope, m, l, owin, lane);
  }
#pragma unroll
  for (int j = 0; j < 4; ++j) {
    const int h = g * 4 + j;
    const float g0 = sigmoid_f(bf2f(hrow[C_NG + h * 3 + 0])), g1 = sigmoid_f(bf2f(hrow[C_NG + h * 3 + 1])), g2 = sigmoid_f(bf2f(hrow[C_NG + h * 3 + 2]));
    const float o = g0 * ocmp[j] + g1 * osel[j] + g2 * (owin[j] / l[j]);
    const float z = bf2f(hrow[C_NZ + h * 64 + lane]);
    MIX[row * D_ + h * 64 + lane] = f2bf(o * silu_f(z));
  }
}

__device__ __forceinline__ void moba_item(const Params& P, int b, int h, int t, float* wsm, int lane) {
  const bf16_t* H0 = (const bf16_t*)(P.ws + WS_H);
  const float* KM = (const float*)(P.ws + WS_KM);
  bf16_t* MIX = (bf16_t*)(P.ws + WS_MIX);
  float* qs = wsm;
  float* pb = wsm + 1280;
  const size_t row = (size_t)b * S_ + t;
  const bf16_t* hrow = H0 + row * P0;
  qs[lane] = bf2f(hrow[C_MQ + h * 64 + lane]);
  __builtin_amdgcn_wave_barrier();
  float slope[1] = {exp2f(-(float)(h + 1))};
  const int cur = t >> 8;
  float gate = -1e30f;
  if (lane < cur) {
    const float4* kr = (const float4*)(KM + (((size_t)b * 16 + lane) * 8 + h) * 64);
    float d = 0.f;
#pragma unroll 4
    for (int d4 = 0; d4 < 16; ++d4) { const float4 kv = kr[d4]; const float4 q = *(const float4*)(qs + d4 * 4); d += kv.x * q.x + kv.y * q.y + kv.z * q.z + kv.w * q.w; }
    gate = d;
  }
  int rank = 0;
  for (int s2 = 0; s2 < 16; ++s2) {
    const float ks = __shfl(gate, s2);
    rank += (ks > gate || (ks == gate && s2 < lane)) ? 1 : 0;
  }
  unsigned long long mk = __ballot(lane < cur && rank < 3) | (1ull << cur);
  float m[1] = {-1e30f}, l[1] = {0.f}, o[1] = {0.f};
  while (mk) {
    const int blk = __builtin_ctzll(mk); mk &= mk - 1;
    for (int c = 0; c < 4; ++c) {
      const int kp0 = blk * 256 + c * 64;
      if (kp0 > t) break;
      attend_block<1>(H0 + C_MK + h * 64, H0 + C_MV + h * 64, (size_t)b * S_, kp0, t, 0, qs, pb, slope, m, l, o, lane);
    }
  }
  const float z = bf2f(hrow[C_MZ + h * 64 + lane]);
  MIX[row * D_ + 512 + h * 64 + lane] = f2bf((o[0] / l[0]) * silu_f(z));
}


#define LAS __attribute__((address_space(3)))
typedef short s16x4 __attribute__((ext_vector_type(4)));
typedef float f32x2_t __attribute__((ext_vector_type(2)));
typedef __bf16 bf16x2_t __attribute__((ext_vector_type(2)));
__device__ __forceinline__ unsigned cvtpk(float lo, float hi) { f32x2_t v = {lo, hi}; bf16x2_t b = __builtin_convertvector(v, bf16x2_t); return __builtin_bit_cast(unsigned, b); }
__device__ __forceinline__ s16x4 vtr(LAS const unsigned char* p) { return __builtin_bit_cast(s16x4, __builtin_amdgcn_ds_read_tr16_b64_v4i16((LAS s16x4*)p)); }
template <int OFF> __device__ __forceinline__ s16x4 vtra(unsigned a) { s16x4 r; asm volatile("ds_read_b64_tr_b16 %0, %1 offset:%2" : "=&v"(r) : "v"(a), "i"(OFF) : "memory"); return r; }
#define LGKM0() do { asm volatile("s_waitcnt lgkmcnt(0)" ::: "memory"); __builtin_amdgcn_sched_barrier(0); } while (0)
constexpr int KT_BYTES = 8192;
constexpr int VT_DT = 2080;
constexpr int VT_BYTES = 4 * VT_DT;
constexpr int AT_BUF = KT_BYTES + VT_BYTES;
constexpr int AT_NST = 4;
constexpr int AT_MISC = AT_NST * AT_BUF;
constexpr int AT_TL = AT_MISC + 64;
constexpr int AT_STASH = AT_MISC + 512;
constexpr int AT_LDS_END = AT_STASH + 8 * 512 * 16;
__device__ __forceinline__ void ring_wait(int rem) {
  if (rem >= 3) asm volatile("s_waitcnt vmcnt(6)" ::: "memory");
  else if (rem == 2) asm volatile("s_waitcnt vmcnt(4)" ::: "memory");
  else if (rem == 1) asm volatile("s_waitcnt vmcnt(2)" ::: "memory");
  else asm volatile("s_waitcnt vmcnt(0)" ::: "memory");
  __builtin_amdgcn_s_barrier();
  asm volatile("" ::: "memory");
}
constexpr float C1 = 0.125f * 1.4426950408889634f;
constexpr float LOG2E = 1.4426950408889634f;
constexpr float AT_LIM = 1.2379400392853803e27f;
constexpr float AT_TINY = 7.8886090522101181e-31f;

__device__ __forceinline__ void at_stage_write(LAS unsigned char* buf, const u32x4& kreg, const u32x4& vreg, int tid) {
  const int key = tid >> 3, c = tid & 7;
  *(LAS u32x4*)(buf + key * 128 + ((c ^ ((key >> 1) & 7)) << 4)) = kreg;
  *(LAS u32x4*)(buf + KT_BYTES + (c >> 1) * VT_DT + key * 32 + (c & 1) * 16) = vreg;
}
__device__ __forceinline__ void at_stage_dma(LAS unsigned char* buf, const bf16_t* Kt, const bf16_t* Vt, unsigned pitch, int lane, int wid) {
  const int kkey = 8 * wid + (lane >> 3), c = (lane & 7) ^ ((kkey >> 1) & 7);
  __builtin_amdgcn_global_load_lds((const unsigned*)(Kt + (unsigned)kkey * pitch + c * 8), (LAS unsigned*)(buf + wid * 1024), 16, 0, 0);
  const int vkey = 32 * (wid & 1) + (lane >> 1), dt = wid >> 1;
  __builtin_amdgcn_global_load_lds((const unsigned*)(Vt + (unsigned)vkey * pitch + dt * 16 + (lane & 1) * 8), (LAS unsigned*)(buf + KT_BYTES + dt * VT_DT + (wid & 1) * 1024), 16, 0, 0);
}
template <int NRG, bool EDGE, bool IMP  , bool SAFE>
__device__ __forceinline__ void at_tile_x(LAS const unsigned char* buf, const bf16x8 (&qf)[NRG][2], f32x4 (&O)[NRG][4], float (&m)[NRG], float (&l)[NRG],
                                        const float (&base)[NRG], const float (&soff)[NRG], const int (&lim)[NRG], const int (&lo)[NRG], int lane,
                                        float (&imp)[NRG][16], float (&carry)[NRG], int tile = 0) {
  const int g = lane >> 4, i = lane & 15;
  const int swz = (i >> 1) & 7;
  LAS const unsigned char* kb = buf + i * 128;
  const int kc0 = ((g ^ swz) << 4), kc1 = (((4 + g) ^ swz) << 4);
  bf16x8 kf[4][2];
#pragma unroll
  for (int mt = 0; mt < 4; ++mt) { kf[mt][0] = *(LAS const bf16x8*)(kb + mt * 2048 + kc0); kf[mt][1] = *(LAS const bf16x8*)(kb + mt * 2048 + kc1); }
  __builtin_amdgcn_sched_barrier(0);
  f32x4 S[NRG][4];
#pragma unroll
  for (int rg = 0; rg < NRG; ++rg) {
    const float bm = base[rg];
#pragma unroll
    for (int mt = 0; mt < 4; ++mt)
#pragma unroll
      for (int r = 0; r < 4; ++r) S[rg][mt][r] = bm + soff[rg] * (float)(16 * mt + r);
  }
  __builtin_amdgcn_sched_barrier(0);
  __builtin_amdgcn_s_setprio(1);
#pragma unroll
  for (int mt = 0; mt < 4; ++mt) {
#pragma unroll
    for (int rg = 0; rg < NRG; ++rg) {
      f32x4 a = __builtin_amdgcn_mfma_f32_16x16x32_bf16(kf[mt][0], qf[rg][0], S[rg][mt], 0, 0, 0);
      S[rg][mt] = __builtin_amdgcn_mfma_f32_16x16x32_bf16(kf[mt][1], qf[rg][1], a, 0, 0, 0);
    }
  }
  __builtin_amdgcn_s_setprio(0);
  __builtin_amdgcn_sched_barrier(0);
  const unsigned vb = (unsigned)(unsigned long long)(buf + KT_BYTES) + (4 * g + (i >> 2)) * 32 + (i & 3) * 8;
#define AT_VRD(dt, ks, d0, d1) { d0 = vtra<(dt) * VT_DT + (ks) * 1024>(vb); d1 = vtra<(dt) * VT_DT + (ks) * 1024 + 512>(vb); }
  s16x4 a0, a1, a2, a3, a4, a5, a6, a7, c0, c1, c2, c3, c4, c5, c6, c7;
  AT_VRD(0, 0, a0, a1) AT_VRD(0, 1, a2, a3) AT_VRD(1, 0, a4, a5) AT_VRD(1, 1, a6, a7)
  __builtin_amdgcn_sched_barrier(0);
  unsigned pk[NRG][2][4];
#pragma unroll
  for (int rg = 0; rg < NRG; ++rg) {
    if (EDGE) {
#pragma unroll
      for (int mt = 0; mt < 4; ++mt)
#pragma unroll
        for (int r = 0; r < 4; ++r) { const int c = 16 * mt + r; S[rg][mt][r] = (c <= lim[rg] && c >= lo[rg]) ? S[rg][mt][r] : -INFINITY; }
    }
    if (SAFE) {
      float mx = -INFINITY;
#pragma unroll
      for (int mt = 0; mt < 4; ++mt)
#pragma unroll
        for (int r = 0; r < 4; ++r) mx = fmaxf(mx, S[rg][mt][r]);
      mx = xmax<16>(mx); mx = xmax<32>(mx);
      const float mn = fmaxf(m[rg], mx);
      const float mu = mn == -INFINITY ? 0.f : mn;
      const float al = __builtin_amdgcn_exp2f(m[rg] - mu);
      m[rg] = mn; l[rg] *= al;
#pragma unroll
      for (int dt = 0; dt < 4; ++dt) O[rg][dt] = O[rg][dt] * al;
      if (IMP) {
#pragma unroll
        for (int k = 0; k < 16; ++k) imp[rg][k] *= al;
        carry[rg] *= al;
      }
      float ps = 0.f;
#pragma unroll
      for (int mt = 0; mt < 4; ++mt)
#pragma unroll
        for (int r = 0; r < 4; ++r) { const float pv = __builtin_amdgcn_exp2f(S[rg][mt][r] - mu); S[rg][mt][r] = pv; ps += pv; }
      l[rg] += ps;
    } else {
      f32x2_t ps2 = {0.f, 0.f};
#pragma unroll
      for (int mt = 0; mt < 4; ++mt) {
#pragma unroll
        for (int r = 0; r < 4; ++r) S[rg][mt][r] = __builtin_amdgcn_exp2f(S[rg][mt][r]);
        ps2 += (f32x2_t){S[rg][mt][0], S[rg][mt][1]}; ps2 += (f32x2_t){S[rg][mt][2], S[rg][mt][3]};
      }
      const float ps = ps2[0] + ps2[1];
      l[rg] += ps; m[rg] = fmaxf(m[rg], ps);
    }
    if (IMP) {
      const int g = lane >> 4;
      float sh[4], nv[4];
#pragma unroll
      for (int mt = 0; mt < 4; ++mt) sh[mt] = __uint_as_float(__builtin_amdgcn_ds_bpermute(((lane + 48) & 63) << 2, __float_as_uint(S[rg][mt][3])));
#pragma unroll
      for (int mt = 0; mt < 4; ++mt) {
        const float own = (S[rg][mt][0] + S[rg][mt][1]) + (S[rg][mt][2] + S[rg][mt][3]);
        const float prev = g > 0 ? sh[mt] : (mt > 0 ? sh[mt > 0 ? mt - 1 : 0] : carry[rg]);
        nv[mt] = own + prev;
      }
      if (tile == 0) { imp[rg][0] = nv[0]; imp[rg][1] = nv[1]; imp[rg][2] = nv[2]; imp[rg][3] = nv[3]; }
      else if (tile == 1) { imp[rg][4] = nv[0]; imp[rg][5] = nv[1]; imp[rg][6] = nv[2]; imp[rg][7] = nv[3]; }
      else if (tile == 2) { imp[rg][8] = nv[0]; imp[rg][9] = nv[1]; imp[rg][10] = nv[2]; imp[rg][11] = nv[3]; }
      else { imp[rg][12] = nv[0]; imp[rg][13] = nv[1]; imp[rg][14] = nv[2]; imp[rg][15] = nv[3]; }
      carry[rg] = sh[3];
    }
#pragma unroll
    for (int ks = 0; ks < 2; ++ks) {
      pk[rg][ks][0] = cvtpk(S[rg][2 * ks][0], S[rg][2 * ks][1]); pk[rg][ks][1] = cvtpk(S[rg][2 * ks][2], S[rg][2 * ks][3]);
      pk[rg][ks][2] = cvtpk(S[rg][2 * ks + 1][0], S[rg][2 * ks + 1][1]); pk[rg][ks][3] = cvtpk(S[rg][2 * ks + 1][2], S[rg][2 * ks + 1][3]);
    }
  }
  __builtin_amdgcn_sched_barrier(0);
#define AT_PV(dt, ks, d0, d1) { const bf16x8 vf = (bf16x8){d0[0], d0[1], d0[2], d0[3], d1[0], d1[1], d1[2], d1[3]}; \
    _Pragma("unroll") for (int rg = 0; rg < NRG; ++rg) { const u32x4 pw = {pk[rg][ks][0], pk[rg][ks][1], pk[rg][ks][2], pk[rg][ks][3]}; \
      O[rg][dt] = __builtin_amdgcn_mfma_f32_16x16x32_bf16(vf, __builtin_bit_cast(bf16x8, pw), O[rg][dt], 0, 0, 0); } }
  LGKM0();
  AT_VRD(2, 0, c0, c1) AT_VRD(2, 1, c2, c3) AT_VRD(3, 0, c4, c5) AT_VRD(3, 1, c6, c7)
  __builtin_amdgcn_s_setprio(1);
  AT_PV(0, 0, a0, a1) AT_PV(0, 1, a2, a3) AT_PV(1, 0, a4, a5) AT_PV(1, 1, a6, a7)
  LGKM0();
  AT_PV(2, 0, c0, c1) AT_PV(2, 1, c2, c3) AT_PV(3, 0, c4, c5) AT_PV(3, 1, c6, c7)
  __builtin_amdgcn_s_setprio(0);
#undef AT_VRD
#undef AT_PV
}

template <int NRG, bool EDGE, bool SAFE>
__device__ __forceinline__ void at_tile(LAS const unsigned char* buf, const bf16x8 (&qf)[NRG][2], f32x4 (&O)[NRG][4], float (&m)[NRG], float (&l)[NRG],
                                        const float (&base)[NRG], const float (&soff)[NRG], const int (&lim)[NRG], const int (&lo)[NRG], int lane) {
  float dimp[NRG][16]; float dc[NRG];
  at_tile_x<NRG, EDGE, false, SAFE>(buf, qf, O, m, l, base, soff, lim, lo, lane, dimp, dc);
}

__device__ __forceinline__ bool at_any_bad(bool bad, LAS unsigned char* lds, int lane, int wid) {
  LAS unsigned* fl = (LAS unsigned*)(lds + AT_MISC + 320);
  const bool wb = __any(bad);
  if (lane == 0) fl[wid] = wb ? 1u : 0u;
  wg_sync();
  unsigned a = 0u;
#pragma unroll
  for (int w = 0; w < 8; ++w) a |= fl[w];
  return __builtin_amdgcn_readfirstlane(a) != 0u;
}

template <bool SAFE>
__device__ __forceinline__ bool moba_mfma_item(const Params& P, int b, int h, int cur, unsigned char* smem_g) {
  LAS unsigned char* lds = (LAS unsigned char*)smem_g;
  const bf16_t* __restrict__ H0 = (const bf16_t*)(P.ws + WS_H);
  const float* __restrict__ KM = (const float*)(P.ws + WS_KM);
  bf16_t* __restrict__ MIX = (bf16_t*)(P.ws + WS_MIX);
  const int tid = otid(), lane = tid & 63, wid = __builtin_amdgcn_readfirstlane(tid >> 6), g = lane >> 4, i = lane & 15;
  const float slope2 = exp2f(-(float)(h + 1)) * LOG2E;
  const int t0 = cur * 256;
  int trow[2]; bf16x8 qf[2][2]; unsigned sel[2];
#pragma unroll
  for (int rg = 0; rg < 2; ++rg) {
    trow[rg] = t0 + wid * 32 + rg * 16 + i;
    const bf16_t* qp = H0 + ((size_t)b * S_ + trow[rg]) * P0 + C_MQ + h * 64 + 8 * g;
    qf[rg][0] = *(const bf16x8*)qp; qf[rg][1] = *(const bf16x8*)(qp + 32);
  }
  {
    LAS float* kml = (LAS float*)(lds + AT_STASH);
#pragma unroll
    for (int k = 0; k < 2; ++k) { const int e = tid + 512 * k, n = e >> 6; if (n < cur) kml[e] = KM[(((size_t)b * 16 + n) * 8 + h) * 64 + (e & 63)]; }
    wg_sync();
#pragma unroll
    for (int rg = 0; rg < 2; ++rg) {
      float qv[16];
#pragma unroll
      for (int j = 0; j < 8; ++j) { qv[j] = bf2f((bf16_t)qf[rg][0][j]); qv[8 + j] = bf2f((bf16_t)qf[rg][1][j]); }
      float v1 = -INFINITY, v2 = -INFINITY, v3 = -INFINITY; int i1 = -1, i2 = -1, i3 = -1;
      for (int n = 0; n < cur; ++n) {
        LAS const float* kr = kml + n * 64 + 8 * g;
        const f32x4 a0 = *(LAS const f32x4*)kr, a1 = *(LAS const f32x4*)(kr + 4), b0 = *(LAS const f32x4*)(kr + 32), b1 = *(LAS const f32x4*)(kr + 36);
        float d = qv[0] * a0[0] + qv[1] * a0[1] + qv[2] * a0[2] + qv[3] * a0[3] + qv[4] * a1[0] + qv[5] * a1[1] + qv[6] * a1[2] + qv[7] * a1[3]
                + qv[8] * b0[0] + qv[9] * b0[1] + qv[10] * b0[2] + qv[11] * b0[3] + qv[12] * b1[0] + qv[13] * b1[1] + qv[14] * b1[2] + qv[15] * b1[3];
        d = xsum<16>(d); d = xsum<32>(d);
        if (d > v1) { v3 = v2; i3 = i2; v2 = v1; i2 = i1; v1 = d; i1 = n; }
        else if (d > v2) { v3 = v2; i3 = i2; v2 = d; i2 = n; }
        else if (d > v3) { v3 = d; i3 = n; }
      }
      unsigned mk = 0u;
      if (i1 >= 0) mk |= 1u << i1;
      if (i2 >= 0) mk |= 1u << i2;
      if (i3 >= 0) mk |= 1u << i3;
      sel[rg] = mk;
    }
  }
  {
    unsigned u = sel[0] | sel[1];
    u = xorr<1>(u); u = xorr<2>(u); u = xorr<4>(u); u = xorr<8>(u);
    LAS unsigned* misc = (LAS unsigned*)(lds + AT_MISC);
    if (lane == 0) misc[wid] = u;
  }
  wg_sync();
  unsigned umask = 0u;
  {
    LAS unsigned* misc = (LAS unsigned*)(lds + AT_MISC);
#pragma unroll
    for (int w = 0; w < 8; ++w) umask |= misc[w];
  }
  umask = __builtin_amdgcn_readfirstlane(umask);
  const int npast = __builtin_popcount(umask);
  const int nt = 4 * npast + 4;
  f32x4 O[2][4]; float m[2], l[2];
#pragma unroll
  for (int rg = 0; rg < 2; ++rg) { m[rg] = SAFE ? -INFINITY : 0.f; l[rg] = 0.f;
#pragma unroll
    for (int dt = 0; dt < 4; ++dt) O[rg][dt] = (f32x4){0.f, 0.f, 0.f, 0.f}; }
  const bf16_t* Kg = H0 + (size_t)b * S_ * P0 + C_MK + h * 64;
  const bf16_t* Vg = H0 + (size_t)b * S_ * P0 + C_MV + h * 64;
  LAS int* tl = (LAS int*)(lds + AT_TL);
  if (tid < nt) {
    int k0v;
    if (tid < 4 * npast) { unsigned r = umask; for (int q = 0; q < (tid >> 2); ++q) r &= r - 1; k0v = __builtin_ctz(r) * 256 + (tid & 3) * 64; }
    else k0v = cur * 256 + (tid - 4 * npast) * 64;
    tl[tid] = k0v;
  }
  asm volatile("s_waitcnt vmcnt(0)" ::: "memory");
  wg_sync();
#pragma unroll
  for (int st = 0; st < 3; ++st) if (st < nt) { const int k0s = tl[st]; at_stage_dma(lds + st * AT_BUF, Kg + (size_t)k0s * P0, Vg + (size_t)k0s * P0, P0, lane, wid); }
  const int ntp = 4 * npast;
#pragma unroll 1
  for (int ti = 0; ti < ntp; ++ti) {
    ring_wait(min(nt - 1 - ti, 2));
    if (ti + 3 < nt) { const int k0n = tl[ti + 3]; at_stage_dma(lds + ((ti + 3) & 3) * AT_BUF, Kg + (size_t)k0n * P0, Vg + (size_t)k0n * P0, P0, lane, wid); }
    const int ck0 = __builtin_amdgcn_readfirstlane(tl[ti]), cblk = ck0 >> 8;
    LAS const unsigned char* buf = lds + (ti & 3) * AT_BUF;
    float base[2], soff[2]; int lim[2], lo[2];
#pragma unroll
    for (int rg = 0; rg < 2; ++rg) {
      const bool rs = (sel[rg] >> cblk) & 1u;
      base[rg] = rs ? slope2 * (float)(ck0 + 4 * g - trow[rg]) : -INFINITY;
      soff[rg] = slope2; lim[rg] = 0; lo[rg] = 0;
    }
    at_tile<2, false, SAFE>(buf, qf, O, m, l, base, soff, lim, lo, lane);
  }
#pragma unroll 1
  for (int ti = ntp; ti < nt; ++ti) {
    ring_wait(min(nt - 1 - ti, 2));
    if (ti + 3 < nt) { const int k0n = tl[ti + 3]; at_stage_dma(lds + ((ti + 3) & 3) * AT_BUF, Kg + (size_t)k0n * P0, Vg + (size_t)k0n * P0, P0, lane, wid); }
    const int ck0 = __builtin_amdgcn_readfirstlane(tl[ti]);
    if (ck0 > t0 + wid * 32 + 31) continue;
    LAS const unsigned char* buf = lds + (ti & 3) * AT_BUF;
    float base[2], soff[2]; int lim[2], lo[2];
#pragma unroll
    for (int rg = 0; rg < 2; ++rg) {
      base[rg] = slope2 * (float)(ck0 + 4 * g - trow[rg]);
      soff[rg] = slope2; lim[rg] = trow[rg] - ck0 - 4 * g; lo[rg] = -1000000;
    }
    at_tile<2, true, SAFE>(buf, qf, O, m, l, base, soff, lim, lo, lane);
  }
  float ltot[2];
#pragma unroll
  for (int rg = 0; rg < 2; ++rg) { float lt = l[rg]; lt = xsum<16>(lt); lt = xsum<32>(lt); ltot[rg] = lt; }
  if (SAFE) __builtin_amdgcn_s_barrier();
  else if (at_any_bad((m[0] > AT_LIM) | (m[1] > AT_LIM) | !(ltot[0] >= AT_TINY) | !(ltot[1] >= AT_TINY), lds, lane, wid)) return true;
#pragma unroll
  for (int rg = 0; rg < 2; ++rg) {
    const float lt = ltot[rg];
    const float inv = 1.f / lt;
    const size_t row = (size_t)b * S_ + trow[rg];
#pragma unroll
    for (int dt = 0; dt < 4; ++dt) {
      const int dv = 16 * dt + 4 * g;
      const ushort4 zz = *(const ushort4*)(H0 + row * P0 + C_MZ + h * 64 + dv);
      ushort4 ov;
      ov.x = f2bf(O[rg][dt][0] * inv * silu_f(bf2f(zz.x))); ov.y = f2bf(O[rg][dt][1] * inv * silu_f(bf2f(zz.y)));
      ov.z = f2bf(O[rg][dt][2] * inv * silu_f(bf2f(zz.z))); ov.w = f2bf(O[rg][dt][3] * inv * silu_f(bf2f(zz.w)));
      *(ushort4*)(MIX + row * D_ + 512 + h * 64 + dv) = ov;
    }
  }
  return false;
}


constexpr size_t WS_KCB = 248 * MiB;
constexpr size_t WS_VCB = 249 * MiB;
template <bool SAFE>
__device__ __forceinline__ bool nsa_mfma_item(const Params& P, int b, int grp, int sb, unsigned char* smem_g) {
  LAS unsigned char* lds = (LAS unsigned char*)smem_g;
  const bf16_t* __restrict__ H0 = (const bf16_t*)(P.ws + WS_H);
  bf16_t* __restrict__ MIX = (bf16_t*)(P.ws + WS_MIX);
  const int tid = otid(), lane = tid & 63, wid = __builtin_amdgcn_readfirstlane(tid >> 6), g = lane >> 4, i = lane & 15;
  const int t0 = sb * 64;
  int trow[2]; bf16x8 qf[2][2];
  const int hh = grp * 4 + (i & 3);
  const float slope2 = exp2f(-(float)(hh + 1)) * LOG2E;
  const bf16_t* __restrict__ Hb = H0 + (size_t)b * S_ * P0;
#pragma unroll
  for (int rg = 0; rg < 2; ++rg) {
    trow[rg] = t0 + wid * 8 + rg * 4 + (i >> 2);
    const unsigned qo = (unsigned)trow[rg] * P0 + C_NQ + hh * 64 + 8 * g;
    qf[rg][0] = *(const bf16x8*)(Hb + qo); qf[rg][1] = *(const bf16x8*)(Hb + qo + 32);
  }
  LAS f32x4* stash = (LAS f32x4*)(lds + AT_STASH) + tid;
  f32x4 O[2][4]; float m[2], l[2];
  unsigned mlo[2], mhi[2];
  bool bad = false;
  const int ntc = ((4 * sb + 2) >> 6) + 1;
  {
    const bf16_t* Kg = (const bf16_t*)(P.ws + WS_KCB) + (size_t)(b * 2 + grp) * 256 * 64;
    const bf16_t* Vg = (const bf16_t*)(P.ws + WS_VCB) + (size_t)(b * 2 + grp) * 256 * 64;
    asm volatile("s_waitcnt vmcnt(0)" ::: "memory");
#pragma unroll
    for (int tile = 0; tile < 4; ++tile) if (tile < ntc) at_stage_dma(lds + tile * AT_BUF, Kg + tile * 4096, Vg + tile * 4096, 64, lane, wid);
  }
#pragma unroll
  for (int rg = 0; rg < 2; ++rg) {
    float imp[1][16], carry[1], m1[1], l1[1]; f32x4 O1[1][4]; bf16x8 q1[1][2];
    q1[0][0] = qf[rg][0]; q1[0][1] = qf[rg][1];
    m1[0] = SAFE ? -INFINITY : 0.f; l1[0] = 0.f; carry[0] = 0.f;
#pragma unroll
    for (int k = 0; k < 16; ++k) imp[0][k] = 0.f;
#pragma unroll
    for (int dt = 0; dt < 4; ++dt) O1[0][dt] = (f32x4){0.f, 0.f, 0.f, 0.f};
#pragma unroll 1
    for (int tile = 0; tile < ntc; ++tile) {
      if (rg == 0) ring_wait(ntc - 1 - tile);
      LAS const unsigned char* buf = lds + tile * AT_BUF;
      float base[1], soff[1]; int lim[1], lo[1];
      const int nlim = trow[rg] >= 31 ? ((trow[rg] - 31) >> 4) : -1;
      base[0] = slope2 * (float)(16 * (64 * tile + 4 * g) + 31 - trow[rg]);
      soff[0] = 16.f * slope2; lim[0] = nlim - 64 * tile - 4 * g; lo[0] = -1000000;
      at_tile_x<1, true, true, SAFE>(buf, q1, O1, m1, l1, base, soff, lim, lo, lane, imp, carry, tile);
    }
    {
      float lt = l1[0]; lt = xsum<16>(lt); lt = xsum<32>(lt);
      if (!SAFE) bad |= (m1[0] > AT_LIM) | (trow[rg] >= 31 && !(lt >= AT_TINY));
      const float inv = lt > 0.f ? 1.f / lt : 0.f;
      const float g0 = sigmoid_f(bf2f(Hb[(unsigned)trow[rg] * P0 + C_NG + hh * 3 + 0]));
#pragma unroll
      for (int dt = 0; dt < 4; ++dt) stash[(rg * 4 + dt) * 512] = O1[0][dt] * (g0 * inv);
      if (sb < 16) { mlo[rg] = (1u << (sb + 1)) - 1u; mhi[rg] = 0u; }
      else {
        float key[16];
#pragma unroll
        for (int k = 0; k < 16; ++k) {
          float v = imp[0][k] * inv; v = xsum<1>(v); v = xsum<2>(v);
          const int sidx = 4 * k + g;
          const bool forced = (sidx == 0) || (sidx == sb) || (sidx == sb - 1);
          key[k] = (sidx <= sb) ? (forced ? 1e9f : v) : -1e30f;
        }
        const int j = i & 3;
        float mykey[4]; int mys[4], rank[4];
#pragma unroll
        for (int q = 0; q < 4; ++q) {
          mykey[q] = j == 0 ? key[q] : (j == 1 ? key[4 + q] : (j == 2 ? key[8 + q] : key[12 + q]));
          mys[q] = 4 * (4 * j + q) + g; rank[q] = 0;
        }
#pragma unroll 1
        for (int gg = 0; gg < 4; ++gg)
#pragma unroll
          for (int kk = 0; kk < 16; ++kk) {
            const float other = __uint_as_float(__builtin_amdgcn_ds_bpermute((gg * 16 + i) << 2, __float_as_uint(key[kk])));
            const int sp = 4 * kk + gg;
#pragma unroll
            for (int q = 0; q < 4; ++q) rank[q] += (other > mykey[q] || (other == mykey[q] && sp < mys[q])) ? 1 : 0;
          }
        unsigned a = 0u, bb = 0u;
#pragma unroll
        for (int q = 0; q < 4; ++q) if (rank[q] < 16 && mys[q] <= sb) { if (mys[q] < 32) a |= 1u << mys[q]; else bb |= 1u << (mys[q] - 32); }
        a = xorr<1>(a); bb = xorr<1>(bb); a = xorr<2>(a); bb = xorr<2>(bb);
        a = xorr<16>(a); bb = xorr<16>(bb); a = xorr<32>(a); bb = xorr<32>(bb);
        mlo[rg] = a; mhi[rg] = bb;
      }
    }
  }
  {
    unsigned ua = mlo[0] | mlo[1], ub = mhi[0] | mhi[1];
    ua = xorr<4>(ua); ub = xorr<4>(ub); ua = xorr<8>(ua); ub = xorr<8>(ub);
    LAS unsigned* misc = (LAS unsigned*)(lds + AT_MISC);
    if (lane == 0) { misc[2 * wid] = ua; misc[2 * wid + 1] = ub; }
    wg_sync();
    ua = 0u; ub = 0u;
#pragma unroll
    for (int w = 0; w < 8; ++w) { ua |= misc[2 * w]; ub |= misc[2 * w + 1]; }
    unsigned long long rem = ((unsigned long long)(unsigned)__builtin_amdgcn_readfirstlane(ub) << 32) | (unsigned)__builtin_amdgcn_readfirstlane(ua);
    const int nt = __builtin_popcountll(rem);
#pragma unroll
    for (int rg = 0; rg < 2; ++rg) { m[rg] = SAFE ? -INFINITY : 0.f; l[rg] = 0.f;
#pragma unroll
      for (int dt = 0; dt < 4; ++dt) O[rg][dt] = (f32x4){0.f, 0.f, 0.f, 0.f}; }
    const bf16_t* Kg = Hb + C_KSEL + grp * 64;
    const bf16_t* Vg = Hb + C_VSEL + grp * 64;
    LAS int* tl = (LAS int*)(lds + AT_TL);
    if (tid < nt) { unsigned long long r = rem; for (int q = 0; q < tid; ++q) r &= r - 1; tl[tid] = __builtin_ctzll(r); }
    asm volatile("s_waitcnt vmcnt(0)" ::: "memory");
    wg_sync();
#pragma unroll
    for (int st = 0; st < 3; ++st) if (st < nt) { const int bs = tl[st]; at_stage_dma(lds + st * AT_BUF, Kg + (size_t)bs * 64 * P0, Vg + (size_t)bs * 64 * P0, P0, lane, wid); }
#define NSA_SEL_STEP(EDGEV) { \
      ring_wait(min(nt - 1 - ti, 2)); \
      if (ti + 3 < nt) { const int bn = tl[ti + 3]; at_stage_dma(lds + ((ti + 3) & 3) * AT_BUF, Kg + (size_t)bn * 64 * P0, Vg + (size_t)bn * 64 * P0, P0, lane, wid); } \
      const int cblk = __builtin_amdgcn_readfirstlane(tl[ti]); \
      LAS const unsigned char* buf = lds + (ti & 3) * AT_BUF; \
      float base[2], soff[2]; int lim[2], lo[2]; \
      _Pragma("unroll") for (int rg = 0; rg < 2; ++rg) { \
        const bool rs = cblk < 32 ? ((mlo[rg] >> cblk) & 1u) : ((mhi[rg] >> (cblk - 32)) & 1u); \
        base[rg] = rs ? slope2 * (float)(cblk * 64 + 4 * g - trow[rg]) : -INFINITY; \
        soff[rg] = slope2; lim[rg] = trow[rg] - cblk * 64 - 4 * g; lo[rg] = -1000000; \
      } \
      at_tile<2, EDGEV, SAFE>(buf, qf, O, m, l, base, soff, lim, lo, lane); }
    int ti = 0;
#pragma unroll 1
    for (; ti < nt - 1; ++ti) NSA_SEL_STEP(false)
    NSA_SEL_STEP(true)
#undef NSA_SEL_STEP
    __builtin_amdgcn_s_barrier();
#pragma unroll
    for (int rg = 0; rg < 2; ++rg) {
      float lt = l[rg]; lt = xsum<16>(lt); lt = xsum<32>(lt);
      if (!SAFE) bad |= (m[rg] > AT_LIM) | !(lt >= AT_TINY);
      const float g1 = sigmoid_f(bf2f(Hb[(unsigned)trow[rg] * P0 + C_NG + hh * 3 + 1]));
#pragma unroll
      for (int dt = 0; dt < 4; ++dt) stash[(rg * 4 + dt) * 512] += O[rg][dt] * (g1 / lt);
    }
  }
  {
    const int b0 = sb >= 8 ? sb - 8 : 0;
    const int nt = sb - b0 + 1;
#pragma unroll
    for (int rg = 0; rg < 2; ++rg) { m[rg] = SAFE ? -INFINITY : 0.f; l[rg] = 0.f;
#pragma unroll
      for (int dt = 0; dt < 4; ++dt) O[rg][dt] = (f32x4){0.f, 0.f, 0.f, 0.f}; }
    const bf16_t* Kg = Hb + C_KWIN + grp * 64;
    const bf16_t* Vg = Hb + C_VWIN + grp * 64;
    asm volatile("s_waitcnt vmcnt(0)" ::: "memory");
#pragma unroll
    for (int st = 0; st < 3; ++st) if (st < nt) at_stage_dma(lds + st * AT_BUF, Kg + (size_t)(b0 + st) * 64 * P0, Vg + (size_t)(b0 + st) * 64 * P0, P0, lane, wid);
#define NSA_WIN_STEP(EDGEV) { \
      ring_wait(min(nt - 1 - ti, 2)); \
      const int cblk = b0 + ti; \
      if (ti + 3 < nt) at_stage_dma(lds + ((ti + 3) & 3) * AT_BUF, Kg + (size_t)(cblk + 3) * 64 * P0, Vg + (size_t)(cblk + 3) * 64 * P0, P0, lane, wid); \
      LAS const unsigned char* buf = lds + (ti & 3) * AT_BUF; \
      float base[2], soff[2]; int lim[2], lo[2]; \
      _Pragma("unroll") for (int rg = 0; rg < 2; ++rg) { \
        base[rg] = slope2 * (float)(cblk * 64 + 4 * g - trow[rg]); \
        soff[rg] = slope2; lim[rg] = trow[rg] - cblk * 64 - 4 * g; lo[rg] = trow[rg] - 511 - cblk * 64 - 4 * g; \
      } \
      at_tile<2, EDGEV, SAFE>(buf, qf, O, m, l, base, soff, lim, lo, lane); }
    int ti = 0;
    if (sb >= 8) { NSA_WIN_STEP(true) ++ti; }
#pragma unroll 1
    for (; ti < nt - 1; ++ti) NSA_WIN_STEP(false)
    NSA_WIN_STEP(true)
#undef NSA_WIN_STEP
  }
  float ltot[2];
#pragma unroll
  for (int rg = 0; rg < 2; ++rg) { float lt = l[rg]; lt = xsum<16>(lt); lt = xsum<32>(lt); ltot[rg] = lt; }
  if (SAFE) __builtin_amdgcn_s_barrier();
  else if (at_any_bad(bad | (m[0] > AT_LIM) | (m[1] > AT_LIM) | !(ltot[0] >= AT_TINY) | !(ltot[1] >= AT_TINY), lds, lane, wid)) return true;
#pragma unroll
  for (int rg = 0; rg < 2; ++rg) {
    const float lt = ltot[rg];
    const unsigned ro = (unsigned)trow[rg] * P0;
    const float g2 = sigmoid_f(bf2f(Hb[ro + C_NG + hh * 3 + 2])) / lt;
#pragma unroll
    for (int dt = 0; dt < 4; ++dt) {
      const int dv = 16 * dt + 4 * g;
      const ushort4 zz = *(const ushort4*)(Hb + ro + C_NZ + hh * 64 + dv);
      const f32x4 ov = stash[(rg * 4 + dt) * 512] + O[rg][dt] * g2;
      ushort4 o4;
      o4.x = f2bf(ov[0] * silu_f(bf2f(zz.x))); o4.y = f2bf(ov[1] * silu_f(bf2f(zz.y)));
      o4.z = f2bf(ov[2] * silu_f(bf2f(zz.z))); o4.w = f2bf(ov[3] * silu_f(bf2f(zz.w)));
      *(ushort4*)(MIX + (size_t)b * S_ * D_ + (unsigned)trow[rg] * D_ + hh * 64 + dv) = o4;
    }
  }
  return false;
}

__device__ __forceinline__ void gla_gate_phase(const Params& P) {
  const bf16_t* H1 = (const bf16_t*)(P.ws + WS_H);
  float* G = (float*)(P.ws + WS_G);
  const float* w2 = P.in[10]; const float* gb = P.in[11];
  const size_t total = (size_t)M_ * 512;
  for (size_t i = (size_t)blockIdx.x * 512 + otid(); i < total; i += (size_t)gridDim.x * 512) {
    const int c = (int)(i & 511); const size_t row = i >> 9;
    float x = gb[c];
#pragma unroll
    for (int r = 0; r < 16; ++r) x += bf2f(H1[row * P1 + G_LR + r]) * w2[r * 512 + c];
    const float ls = fminf(x, 0.f) - log1pf(__expf(-fabsf(x)));
    G[i] = ls * (1.f / 16.f);
  }
}
__device__ __forceinline__ void gla_scan_vblock(const Params& P, int vb) {
  const bf16_t* __restrict__ H1 = (const bf16_t*)(P.ws + WS_H);
  const float* __restrict__ G = (const float*)(P.ws + WS_G);
  bf16_t* __restrict__ O = (bf16_t*)(P.ws + WS_XB);
  const int tid = otid(), lane = tid & 63, wid = tid >> 6;
  const int eh = vb & 1, h = (vb >> 1) & 3, b = vb >> 3;
  const int e = eh * 128 + wid * 16 + (lane >> 2), dq = lane & 3;
  float St[32];
#pragma unroll
  for (int i = 0; i < 32; ++i) St[i] = 0.f;
  const float qscale = 0.08838834764831845f;
  for (int t = 0; t < S_; ++t) {
    const size_t row = (size_t)b * S_ + t;
    const float4* gr = (const float4*)(G + row * 512 + h * 128 + dq * 32);
    const uint4* kr = (const uint4*)(H1 + row * P1 + G_K + h * 128 + dq * 32);
    const uint4* qr = (const uint4*)(H1 + row * P1 + G_Q + h * 128 + dq * 32);
    const float v = bf2f(H1[row * P1 + G_V + h * 256 + e]);
    float o = 0.f;
#pragma unroll
    for (int c = 0; c < 4; ++c) {
      const uint4 ku = kr[c], qu = qr[c];
      const float4 g0 = gr[2 * c], g1 = gr[2 * c + 1];
      const float kk[8] = {__uint_as_float(ku.x << 16), __uint_as_float(ku.x & 0xffff0000u), __uint_as_float(ku.y << 16), __uint_as_float(ku.y & 0xffff0000u),
                           __uint_as_float(ku.z << 16), __uint_as_float(ku.z & 0xffff0000u), __uint_as_float(ku.w << 16), __uint_as_float(ku.w & 0xffff0000u)};
      const float qq[8] = {__uint_as_float(qu.x << 16), __uint_as_float(qu.x & 0xffff0000u), __uint_as_float(qu.y << 16), __uint_as_float(qu.y & 0xffff0000u),
                           __uint_as_float(qu.z << 16), __uint_as_float(qu.z & 0xffff0000u), __uint_as_float(qu.w << 16), __uint_as_float(qu.w & 0xffff0000u)};
      const float gg[8] = {g0.x, g0.y, g0.z, g0.w, g1.x, g1.y, g1.z, g1.w};
#pragma unroll
      for (int i = 0; i < 8; ++i) {
        const float a = __expf(gg[i]);
        St[c * 8 + i] = a * St[c * 8 + i] + kk[i] * v;
        o += qq[i] * St[c * 8 + i];
      }
    }
    o = xsum<1>(o); o = xsum<2>(o);
    if (dq == 0) O[row * D_ + h * 256 + e] = f2bf(o * qscale);
  }
}

constexpr int CTL_GLA = 16384;
constexpr size_t WS_QT = WS_G;
constexpr size_t WS_KH = WS_G + 16 * MiB;
constexpr size_t WS_ATT = 190 * MiB;
constexpr size_t WS_DEC = 199 * MiB;
__device__ __forceinline__ int kperm(int x) { const int dl = x & 31, hi = dl >> 4, d2 = dl & 15; return (x & ~31) + 8 * (d2 >> 2) + 4 * hi + (d2 & 3); }

__device__ __forceinline__ void st8_wt(void* p, unsigned lo, unsigned hi) {
  __hip_atomic_store((unsigned long long*)p, ((unsigned long long)hi << 32) | lo, __ATOMIC_RELAXED, __HIP_MEMORY_SCOPE_AGENT);
}
__device__ __forceinline__ void gla_prep_item(const Params& P, int item, unsigned char* smem_g) {
  const bf16_t* __restrict__ H1 = (const bf16_t*)(P.ws + WS_H);
  bf16_t* __restrict__ QT = (bf16_t*)(P.ws + WS_QT) + (size_t)item * 8192;
  bf16_t* __restrict__ KH = (bf16_t*)(P.ws + WS_KH) + (size_t)item * 8192;
  bf16_t* __restrict__ ATT = (bf16_t*)(P.ws + WS_ATT) + (size_t)item * 4096;
  float* __restrict__ DEC = (float*)(P.ws + WS_DEC) + (size_t)item * 128;
  const int tid = otid(), lane = tid & 63, wid = tid >> 6, g = lane >> 4, i = lane & 15;
  const int c = item & 63, h = (item >> 6) & 3, b = item >> 8;
  const size_t rowbase = (size_t)b * S_ + c * 64;
  float* glr = (float*)smem_g;
  float* tot = (float*)(smem_g + 4096);
  bf16_t* qs = (bf16_t*)(smem_g + 12288);
  bf16_t* ks = (bf16_t*)(smem_g + 12288 + 17408);
  const int d0 = (tid & 31) * 4, rgp = tid >> 5;
#pragma unroll
  for (int k = 0; k < 2; ++k) { const int e = tid + 512 * k; glr[e] = ((const float*)(P.ws + WS_GLR))[rowbase * 16 + e]; }
  uint2 qraw[4], kraw[4];
#pragma unroll
  for (int k = 0; k < 4; ++k) {
    qraw[k] = *(const uint2*)(H1 + (rowbase + 4 * rgp + k) * P1 + G_Q + h * 128 + d0);
    kraw[k] = *(const uint2*)(H1 + (rowbase + 4 * rgp + k) * P1 + G_K + h * 128 + d0);
  }
  float4 w[16];
#pragma unroll
  for (int r = 0; r < 16; ++r) w[r] = *(const float4*)(P.in[10] + r * 512 + h * 128 + d0);
  const float4 gb = *(const float4*)(P.in[11] + h * 128 + d0);
  wg_sync();
  float bb[4][4];
  float run[4] = {0.f, 0.f, 0.f, 0.f};
#pragma unroll
  for (int k = 0; k < 4; ++k) {
    const float* gr = glr + (4 * rgp + k) * 16;
    float x[4] = {gb.x, gb.y, gb.z, gb.w};
#pragma unroll
    for (int r = 0; r < 16; ++r) { const float gv = gr[r]; x[0] += gv * w[r].x; x[1] += gv * w[r].y; x[2] += gv * w[r].z; x[3] += gv * w[r].w; }
#pragma unroll
    for (int j = 0; j < 4; ++j) {
      const float la = (fminf(x[j], 0.f) - __logf(1.f + __expf(-fabsf(x[j])))) * (1.f / 16.f);
      run[j] += la; bb[k][j] = run[j];
    }
  }
  *(float4*)(tot + rgp * 128 + d0) = (float4){run[0], run[1], run[2], run[3]};
  wg_sync();
  float off[4] = {0.f, 0.f, 0.f, 0.f}, total[4] = {0.f, 0.f, 0.f, 0.f};
#pragma unroll
  for (int q = 0; q < 16; ++q) {
    const float4 tv = *(const float4*)(tot + q * 128 + d0);
    total[0] += tv.x; total[1] += tv.y; total[2] += tv.z; total[3] += tv.w;
    if (q < rgp) { off[0] += tv.x; off[1] += tv.y; off[2] += tv.z; off[3] += tv.w; }
  }
  const float qscale = 0.08838834764831845f;
  const int dp = kperm(d0);
#pragma unroll
  for (int k = 0; k < 4; ++k) {
    const int r = 4 * rgp + k;
    const float qv[4] = {__uint_as_float(qraw[k].x << 16), __uint_as_float(qraw[k].x & 0xffff0000u), __uint_as_float(qraw[k].y << 16), __uint_as_float(qraw[k].y & 0xffff0000u)};
    const float kv[4] = {__uint_as_float(kraw[k].x << 16), __uint_as_float(kraw[k].x & 0xffff0000u), __uint_as_float(kraw[k].y << 16), __uint_as_float(kraw[k].y & 0xffff0000u)};
    float qt[4], kt[4], kh[4];
#pragma unroll
    for (int j = 0; j < 4; ++j) {
      const float bv = bb[k][j] + off[j];
      const float eb = __expf(bv);
      qt[j] = qv[j] * eb * qscale; kt[j] = kv[j] * __expf(-bv); kh[j] = kv[j] * __expf(total[j] - bv);
    }
    const unsigned q01 = cvtpk(qt[0], qt[1]), q23 = cvtpk(qt[2], qt[3]), k01 = cvtpk(kt[0], kt[1]), k23 = cvtpk(kt[2], kt[3]);
    *(uint2*)(qs + r * 136 + d0) = (uint2){q01, q23};
    *(uint2*)(ks + r * 136 + d0) = (uint2){k01, k23};
    st8_wt(QT + r * 128 + dp, q01, q23);
    st8_wt(KH + r * 128 + d0, cvtpk(kh[0], kh[1]), cvtpk(kh[2], kh[3]));
  }
  if (rgp == 0) {
    st8_wt(DEC + d0, __float_as_uint(__expf(total[0])), __float_as_uint(__expf(total[1])));
    st8_wt(DEC + d0 + 2, __float_as_uint(__expf(total[2])), __float_as_uint(__expf(total[3])));
  }
  wg_sync();
  {
    const int it = wid >> 1, jt0 = 2 * (wid & 1);
    f32x4 acc[2] = {(f32x4){0.f, 0.f, 0.f, 0.f}, (f32x4){0.f, 0.f, 0.f, 0.f}};
#pragma unroll
    for (int kk = 0; kk < 4; ++kk) {
      const bf16x8 qa = *(const bf16x8*)(qs + (16 * it + i) * 136 + 32 * kk + 8 * g);
#pragma unroll
      for (int n = 0; n < 2; ++n) {
        const bf16x8 kf = *(const bf16x8*)(ks + (16 * (jt0 + n) + i) * 136 + 32 * kk + 8 * g);
        acc[n] = __builtin_amdgcn_mfma_f32_16x16x32_bf16(kf, qa, acc[n], 0, 0, 0);
      }
    }
#pragma unroll
    for (int n = 0; n < 2; ++n) {
      const int ri = 16 * it + i, cj0 = 16 * (jt0 + n) + 4 * g;
      float v[4];
#pragma unroll
      for (int r = 0; r < 4; ++r) v[r] = (cj0 + r <= ri) ? acc[n][r] : 0.f;
      st8_wt(ATT + ri * 64 + kperm(cj0), cvtpk(v[0], v[1]), cvtpk(v[2], v[3]));
    }
  }
  asm volatile("s_waitcnt vmcnt(0)" ::: "memory");
  wg_sync();
  if (tid == 0) __hip_atomic_store((unsigned*)P.ws + CTL_GLA + 64 * item, 1u, __ATOMIC_RELAXED, __HIP_MEMORY_SCOPE_AGENT);
}
__device__ __forceinline__ void gla_wait_items(const Params& P, int first, int n, int tid) {
  if (tid < n) {
    unsigned* f = (unsigned*)P.ws + CTL_GLA + 64 * (first + tid);
    unsigned sp = 0;
    while (__hip_atomic_load(f, __ATOMIC_RELAXED, __HIP_MEMORY_SCOPE_AGENT) == 0u) { __builtin_amdgcn_s_sleep(2); if (++sp > (1u << 22)) break; }
  }
  wg_sync();
}
constexpr int GS_Q = 0, GS_K = 16384, GS_V = 32768, GS_A = 49152, GS_D = 57344, GS_BYTES = 57856;
__device__ __forceinline__ void gla_stage_dma(LAS unsigned char* st, const Params& P, int item, size_t rowbase, int h, int eh, int lane, int wid) {
  const bf16_t* QT = (const bf16_t*)(P.ws + WS_QT) + (size_t)item * 8192;
  const bf16_t* KH = (const bf16_t*)(P.ws + WS_KH) + (size_t)item * 8192;
  const bf16_t* ATT = (const bf16_t*)(P.ws + WS_ATT) + (size_t)item * 4096;
  const bf16_t* V = (const bf16_t*)(P.ws + WS_H) + rowbase * P1 + G_V + h * 256 + eh * 128;
#pragma unroll
  for (int n = 0; n < 2; ++n) {
    const int q = 2 * wid + n;
    { const int row = 4 * q + (lane >> 4), ch = (lane & 15) ^ (row & 15);
      __builtin_amdgcn_global_load_lds((const unsigned*)(QT + row * 128 + ch * 8), (LAS unsigned*)(st + GS_Q + q * 1024), 16, 0, 0); }
    { const int dt = q >> 1, j = 32 * (q & 1) + (lane >> 1);
      __builtin_amdgcn_global_load_lds((const unsigned*)(KH + j * 128 + dt * 16 + (lane & 1) * 8), (LAS unsigned*)(st + GS_K + q * 1024), 16, 0, 0);
      __builtin_amdgcn_global_load_lds((const unsigned*)(V + (unsigned)j * P1 + dt * 16 + (lane & 1) * 8), (LAS unsigned*)(st + GS_V + q * 1024), 16, 0, 0); }
  }
  { const int row = 8 * wid + (lane >> 3), ch = (lane & 7) ^ ((row >> 1) & 7);
    __builtin_amdgcn_global_load_lds((const unsigned*)(ATT + row * 64 + ch * 8), (LAS unsigned*)(st + GS_A + wid * 1024), 16, 0, 0); }
  if (wid < 2) __builtin_amdgcn_global_load_lds((const unsigned*)((const float*)(P.ws + WS_DEC) + (size_t)item * 128 + wid * 64 + lane), (LAS unsigned*)(st + GS_D + wid * 256), 4, 0, 0);
}
__device__ __forceinline__ void gla_chain(const Params& P, int chain, unsigned char* smem_g) {
  LAS unsigned char* lds = (LAS unsigned char*)smem_g;
  bf16_t* __restrict__ O = (bf16_t*)(P.ws + WS_XB);
  const int tid = otid(), lane = tid & 63, wid = __builtin_amdgcn_readfirstlane(tid >> 6), g = lane >> 4, i = lane & 15;
  const int eh = chain & 1, h = (chain >> 1) & 3, b = chain >> 3;
  const int item0 = (b * 4 + h) * 64;
  f32x4 S[8];
#pragma unroll
  for (int dt = 0; dt < 8; ++dt) S[dt] = (f32x4){0.f, 0.f, 0.f, 0.f};
  gla_wait_items(P, item0, 9, tid);
  gla_stage_dma(lds, P, item0, (size_t)b * S_, h, eh, lane, wid);
  wg_sync();
  for (int c = 0; c < 64; ++c) {
    if ((c & 7) == 0 && c > 0) gla_wait_items(P, item0 + c + 1, (64 - (c + 1)) < 8 ? (64 - (c + 1)) : 8, tid);
    if (c + 1 < 64) gla_stage_dma(lds + ((c + 1) & 1) * GS_BYTES, P, item0 + c + 1, (size_t)b * S_ + (c + 1) * 64, h, eh, lane, wid);
    LAS const unsigned char* st = lds + (c & 1) * GS_BYTES;
    f32x4 dc[8];
#pragma unroll
    for (int dt = 0; dt < 8; ++dt) dc[dt] = *(LAS const f32x4*)(st + GS_D + (16 * dt + 4 * g) * 4);
    u32x4 spk[4];
#pragma unroll
    for (int kk = 0; kk < 4; ++kk) {
      spk[kk][0] = cvtpk(S[2 * kk][0], S[2 * kk][1]); spk[kk][1] = cvtpk(S[2 * kk][2], S[2 * kk][3]);
      spk[kk][2] = cvtpk(S[2 * kk + 1][0], S[2 * kk + 1][1]); spk[kk][3] = cvtpk(S[2 * kk + 1][2], S[2 * kk + 1][3]);
    }
    bf16x8 vf[2];
    const unsigned trb = (unsigned)(unsigned long long)st + (4 * g + (i >> 2)) * 32 + (i & 3) * 8;
    {
      const unsigned vb = trb + GS_V + wid * 2048;
      const s16x4 v0 = vtra<0>(vb), v1 = vtra<512>(vb), v2 = vtra<1024>(vb), v3 = vtra<1536>(vb);
      LGKM0();
      vf[0] = (bf16x8){v0[0], v0[1], v0[2], v0[3], v1[0], v1[1], v1[2], v1[3]};
      vf[1] = (bf16x8){v2[0], v2[1], v2[2], v2[3], v3[0], v3[1], v3[2], v3[3]};
    }
#pragma unroll
    for (int it = 0; it < 4; ++it) {
      f32x4 acc = (f32x4){0.f, 0.f, 0.f, 0.f};
      LAS const unsigned char* qrow = st + GS_Q + (16 * it + i) * 256;
#pragma unroll
      for (int kk = 0; kk < 4; ++kk) {
        const bf16x8 a = *(LAS const bf16x8*)(qrow + (((4 * kk + g) ^ i) << 4));
        acc = __builtin_amdgcn_mfma_f32_16x16x32_bf16(a, __builtin_bit_cast(bf16x8, spk[kk]), acc, 0, 0, 0);
      }
      LAS const unsigned char* arow = st + GS_A + (16 * it + i) * 128;
#pragma unroll
      for (int k2 = 0; k2 < 2; ++k2) {
        const bf16x8 a = *(LAS const bf16x8*)(arow + (((4 * k2 + g) ^ ((i >> 1) & 7)) << 4));
        acc = __builtin_amdgcn_mfma_f32_16x16x32_bf16(a, vf[k2], acc, 0, 0, 0);
      }
      bf16_t* op = O + ((size_t)b * S_ + c * 64 + 16 * it + 4 * g) * D_ + h * 256 + eh * 128 + 16 * wid + i;
#pragma unroll
      for (int r = 0; r < 4; ++r) op[(size_t)r * D_] = f2bf(acc[r]);
    }
    __builtin_amdgcn_sched_barrier(0);
#define GL_KRD(dt, q0, q1, q2, q3) { q0 = vtra<GS_K + (dt) * 2048>(trb); q1 = vtra<GS_K + (dt) * 2048 + 512>(trb); q2 = vtra<GS_K + (dt) * 2048 + 1024>(trb); q3 = vtra<GS_K + (dt) * 2048 + 1536>(trb); }
#define GL_UPD(dt, q0, q1, q2, q3) { S[dt] = S[dt] * dc[dt]; \
      S[dt] = __builtin_amdgcn_mfma_f32_16x16x32_bf16((bf16x8){q0[0], q0[1], q0[2], q0[3], q1[0], q1[1], q1[2], q1[3]}, vf[0], S[dt], 0, 0, 0); \
      S[dt] = __builtin_amdgcn_mfma_f32_16x16x32_bf16((bf16x8){q2[0], q2[1], q2[2], q2[3], q3[0], q3[1], q3[2], q3[3]}, vf[1], S[dt], 0, 0, 0); }
    {
      s16x4 e0, e1, e2, e3, e4, e5, e6, e7, f0, f1, f2, f3, f4, f5, f6, f7;
      GL_KRD(0, e0, e1, e2, e3) GL_KRD(1, e4, e5, e6, e7)
      LGKM0();
      GL_KRD(2, f0, f1, f2, f3) GL_KRD(3, f4, f5, f6, f7)
      GL_UPD(0, e0, e1, e2, e3) GL_UPD(1, e4, e5, e6, e7)
      LGKM0();
      GL_KRD(4, e0, e1, e2, e3) GL_KRD(5, e4, e5, e6, e7)
      GL_UPD(2, f0, f1, f2, f3) GL_UPD(3, f4, f5, f6, f7)
      LGKM0();
      GL_KRD(6, f0, f1, f2, f3) GL_KRD(7, f4, f5, f6, f7)
      GL_UPD(4, e0, e1, e2, e3) GL_UPD(5, e4, e5, e6, e7)
      LGKM0();
      GL_UPD(6, f0, f1, f2, f3) GL_UPD(7, f4, f5, f6, f7)
    }
#undef GL_KRD
#undef GL_UPD
    wg_sync();
  }
}


constexpr int G4_Q = 0, G4_K = 16384, G4_V = 32768, G4_A = 40960, G4_D = 49152, G4_BYTES = 49664, G4_EXCH = 3 * G4_BYTES, G4_END = G4_EXCH + 8192;
__device__ __forceinline__ void gla4_stage_dma(LAS unsigned char* st, const Params& P, int item, size_t rowbase, int h, int eq, int lane, int wid) {
  const bf16_t* QT = (const bf16_t*)(P.ws + WS_QT) + (size_t)item * 8192;
  const bf16_t* KH = (const bf16_t*)(P.ws + WS_KH) + (size_t)item * 8192;
  const bf16_t* ATT = (const bf16_t*)(P.ws + WS_ATT) + (size_t)item * 4096;
  const bf16_t* V = (const bf16_t*)(P.ws + WS_H) + rowbase * P1 + G_V + h * 256 + eq * 64;
#pragma unroll
  for (int n = 0; n < 2; ++n) {
    const int q = 2 * wid + n;
    { const int row = 4 * q + (lane >> 4), ch = (lane & 15) ^ (row & 15);
      __builtin_amdgcn_global_load_lds((const unsigned*)(QT + row * 128 + ch * 8), (LAS unsigned*)(st + G4_Q + q * 1024), 16, 0, 0); }
    { const int dt = q >> 1, j = 32 * (q & 1) + (lane >> 1);
      __builtin_amdgcn_global_load_lds((const unsigned*)(KH + j * 128 + dt * 16 + (lane & 1) * 8), (LAS unsigned*)(st + G4_K + q * 1024), 16, 0, 0); }
  }
  { const int et = wid >> 1, j = 32 * (wid & 1) + (lane >> 1);
    __builtin_amdgcn_global_load_lds((const unsigned*)(V + (unsigned)j * P1 + et * 16 + (lane & 1) * 8), (LAS unsigned*)(st + G4_V + wid * 1024), 16, 0, 0); }
  { const int row = 8 * wid + (lane >> 3), ch = (lane & 7) ^ ((row >> 1) & 7);
    __builtin_amdgcn_global_load_lds((const unsigned*)(ATT + row * 64 + ch * 8), (LAS unsigned*)(st + G4_A + wid * 1024), 16, 0, 0); }
  __builtin_amdgcn_global_load_lds((const unsigned*)((const float*)(P.ws + WS_DEC) + (size_t)item * 128 + (wid & 1) * 64 + lane), (LAS unsigned*)(st + G4_D + (wid & 1) * 256), 4, 0, 0);
}
__device__ __forceinline__ void gla_chain64(const Params& P, int chain, int seg, unsigned char* smem_g) {
  LAS unsigned char* lds = (LAS unsigned char*)smem_g;
  bf16_t* __restrict__ O = (bf16_t*)(P.ws + WS_XB);
  const int tid = otid(), lane = tid & 63, wid = __builtin_amdgcn_readfirstlane(tid >> 6), g = lane >> 4, i = lane & 15;
  const int et = wid & 3, dh = wid >> 2;
  const int eq = chain & 3, h = (chain >> 2) & 3, b = chain >> 4;
  const int item0 = (b * 4 + h) * 64 + 32 * seg;
  const size_t row0 = (size_t)b * S_ + (size_t)seg * 32 * 64;
  f32x4 S[4];
#pragma unroll
  for (int t = 0; t < 4; ++t) S[t] = (f32x4){0.f, 0.f, 0.f, 0.f};
  f32x4 opend[2] = {(f32x4){0.f, 0.f, 0.f, 0.f}, (f32x4){0.f, 0.f, 0.f, 0.f}};
  gla_wait_items(P, item0, 10, tid);
  gla4_stage_dma(lds, P, item0, row0, h, eq, lane, wid);
  gla4_stage_dma(lds + G4_BYTES, P, item0 + 1, row0 + 64, h, eq, lane, wid);
  for (int c = 0; c < 32; ++c) {
    if ((c & 7) == 0 && c > 0 && c + 2 < 32) gla_wait_items(P, item0 + c + 2, (32 - (c + 2)) < 8 ? (32 - (c + 2)) : 8, tid);
    if (c + 1 < 32) asm volatile("s_waitcnt vmcnt(7)" ::: "memory"); else asm volatile("s_waitcnt vmcnt(0)" ::: "memory");
    __builtin_amdgcn_s_barrier();
    asm volatile("" ::: "memory");
    if (c > 0) {
#pragma unroll
      for (int q = 0; q < 2; ++q) { bf16_t* op = O + (row0 + (c - 1) * 64 + 16 * (2 * dh + q) + 4 * g) * D_ + h * 256 + eq * 64 + 16 * et + i;
#pragma unroll
        for (int r = 0; r < 4; ++r) op[(size_t)r * D_] = f2bf(opend[q][r]); }
    }
    if (c + 2 < 32) gla4_stage_dma(lds + ((c + 2) % 3) * G4_BYTES, P, item0 + c + 2, row0 + (c + 2) * 64, h, eq, lane, wid);
    LAS const unsigned char* st = lds + (c % 3) * G4_BYTES;
    f32x4 dc[4];
#pragma unroll
    for (int t = 0; t < 4; ++t) dc[t] = *(LAS const f32x4*)(st + G4_D + (16 * (4 * dh + t) + 4 * g) * 4);
    bf16x8 qa[4][2], aa[2][2];
#pragma unroll
    for (int it = 0; it < 4; ++it)
#pragma unroll
      for (int q = 0; q < 2; ++q) qa[it][q] = *(LAS const bf16x8*)(st + G4_Q + (16 * it + i) * 256 + (((4 * (2 * dh + q) + g) ^ i) << 4));
#pragma unroll
    for (int q = 0; q < 2; ++q)
#pragma unroll
      for (int k2 = 0; k2 < 2; ++k2) aa[q][k2] = *(LAS const bf16x8*)(st + G4_A + (16 * (2 * dh + q) + i) * 128 + (((4 * k2 + g) ^ ((i >> 1) & 7)) << 4));
    const unsigned trb = (unsigned)(unsigned long long)st + (4 * g + (i >> 2)) * 32 + (i & 3) * 8;
    const unsigned vb = trb + G4_V + et * 2048, kb = trb + G4_K + (4 * dh) * 2048;
    const s16x4 v0 = vtra<0>(vb), v1 = vtra<512>(vb), v2 = vtra<1024>(vb), v3 = vtra<1536>(vb);
    s16x4 kq[4][4];
#define G4_KRD(t) { kq[t][0] = vtra<(t) * 2048>(kb); kq[t][1] = vtra<(t) * 2048 + 512>(kb); kq[t][2] = vtra<(t) * 2048 + 1024>(kb); kq[t][3] = vtra<(t) * 2048 + 1536>(kb); }
    G4_KRD(0) G4_KRD(1) G4_KRD(2) G4_KRD(3)
#undef G4_KRD
    u32x4 spk[2];
#pragma unroll
    for (int q = 0; q < 2; ++q) {
      spk[q][0] = cvtpk(S[2 * q][0], S[2 * q][1]); spk[q][1] = cvtpk(S[2 * q][2], S[2 * q][3]);
      spk[q][2] = cvtpk(S[2 * q + 1][0], S[2 * q + 1][1]); spk[q][3] = cvtpk(S[2 * q + 1][2], S[2 * q + 1][3]);
    }
    LGKM0();
    bf16x8 vf[2];
    vf[0] = (bf16x8){v0[0], v0[1], v0[2], v0[3], v1[0], v1[1], v1[2], v1[3]};
    vf[1] = (bf16x8){v2[0], v2[1], v2[2], v2[3], v3[0], v3[1], v3[2], v3[3]};
    f32x4 acc[4];
#pragma unroll
    for (int it = 0; it < 4; ++it) {
      acc[it] = (f32x4){0.f, 0.f, 0.f, 0.f};
      if (it >> 1 == dh) {
#pragma unroll
        for (int k2 = 0; k2 < 2; ++k2) acc[it] = __builtin_amdgcn_mfma_f32_16x16x32_bf16(aa[it & 1][k2], vf[k2], acc[it], 0, 0, 0);
      }
#pragma unroll
      for (int q = 0; q < 2; ++q) acc[it] = __builtin_amdgcn_mfma_f32_16x16x32_bf16(qa[it][q], __builtin_bit_cast(bf16x8, spk[q]), acc[it], 0, 0, 0);
    }
#pragma unroll
    for (int t = 0; t < 4; ++t) {
      S[t] = S[t] * dc[t];
      S[t] = __builtin_amdgcn_mfma_f32_16x16x32_bf16((bf16x8){kq[t][0][0], kq[t][0][1], kq[t][0][2], kq[t][0][3], kq[t][1][0], kq[t][1][1], kq[t][1][2], kq[t][1][3]}, vf[0], S[t], 0, 0, 0);
      S[t] = __builtin_amdgcn_mfma_f32_16x16x32_bf16((bf16x8){kq[t][2][0], kq[t][2][1], kq[t][2][2], kq[t][2][3], kq[t][3][0], kq[t][3][1], kq[t][3][2], kq[t][3][3]}, vf[1], S[t], 0, 0, 0);
    }
    {
      LAS u32x2* ex = (LAS u32x2*)(lds + G4_EXCH) + (wid * 2) * 64 + lane;
#pragma unroll
      for (int q = 0; q < 2; ++q) { const f32x4 v = dh == 0 ? acc[2 + q] : acc[q]; ex[q * 64] = (u32x2){cvtpk(v[0], v[1]), cvtpk(v[2], v[3])}; }
    }
    asm volatile("s_waitcnt lgkmcnt(0)" ::: "memory");
    __builtin_amdgcn_s_barrier();
    asm volatile("" ::: "memory");
    {
      LAS const u32x2* ex = (LAS const u32x2*)(lds + G4_EXCH) + ((wid ^ 4) * 2) * 64 + lane;
#pragma unroll
      for (int q = 0; q < 2; ++q) {
        const u32x2 pv = ex[q * 64];
        f32x4 mine = dh == 0 ? acc[q] : acc[2 + q];
        mine[0] += __uint_as_float(pv.x << 16); mine[1] += __uint_as_float(pv.x & 0xffff0000u); mine[2] += __uint_as_float(pv.y << 16); mine[3] += __uint_as_float(pv.y & 0xffff0000u);
        opend[q] = mine;
      }
    }
  }
#pragma unroll
  for (int q = 0; q < 2; ++q) { bf16_t* op = O + (row0 + 31 * 64 + 16 * (2 * dh + q) + 4 * g) * D_ + h * 256 + eq * 64 + 16 * et + i;
#pragma unroll
    for (int r = 0; r < 4; ++r) op[(size_t)r * D_] = f2bf(opend[q][r]); }
  if (seg == 0) {
    bf16_t* smt = (bf16_t*)(P.ws + WS_SMT) + ((size_t)(b * 4 + h) * 256 + eq * 64 + 16 * et + i) * 128;
#pragma unroll
    for (int t = 0; t < 4; ++t) { const int T = 4 * dh + t, p0 = 32 * (T >> 1) + 8 * g + 4 * (T & 1);
      *(u32x2*)(smt + p0) = (u32x2){cvtpk(S[t][0], S[t][1]), cvtpk(S[t][2], S[t][3])}; }
  }
  __builtin_amdgcn_s_barrier();
}

__device__ __forceinline__ void gla_norm_phase(const Params& P) {
  const bf16_t* H1 = (const bf16_t*)(P.ws + WS_H);
  const bf16_t* O = (const bf16_t*)(P.ws + WS_XB);
  bf16_t* MIX = (bf16_t*)(P.ws + WS_MIX);
  const float* gn = P.in[12];
  const int lane = otid() & 63, wid = otid() >> 6;
  for (int it = blockIdx.x * 8 + wid; it < M_ * 4; it += gridDim.x * 8) {
    const int h = it & 3; const size_t row = it >> 2;
    float v[4]; float ss = 0.f;
#pragma unroll
    for (int k = 0; k < 4; ++k) { v[k] = bf2f(O[row * D_ + h * 256 + k * 64 + lane]); ss += v[k] * v[k]; }
    const float r = 1.f / sqrtf(wave_sum(ss) * (1.f / 256.f) + LN_EPS);
#pragma unroll
    for (int k = 0; k < 4; ++k) {
      const int c = h * 256 + k * 64 + lane;
      const float z = bf2f(H1[row * P1 + G_Z + c]);
      MIX[row * D_ + c] = f2bf(v[k] * r * gn[c] * silu_f(z));
    }
  }
}


constexpr int RG_RED = 131072;
__device__ __forceinline__ size_t wfrag_off(int n, int k) { return ((size_t)(((n >> 4) * 32 + (k >> 5)) * 64 + ((k >> 3) & 3) * 16 + (n & 15))) * 8 + (k & 7); }
template <int AMODE  , bool GLR  >
__device__ __forceinline__ void rowgemm_block(const Params& P, int rb, const bf16_t* __restrict__ Wf, const float* base, float* out, bf16_t* outb,
                                              const float* __restrict__ gam, const float* __restrict__ bet, unsigned char* smem_g) {
  LAS unsigned char* lds = (LAS unsigned char*)smem_g;
  const int tid = otid(), lane = tid & 63, wid = __builtin_amdgcn_readfirstlane(tid >> 6), g = lane >> 4, i = lane & 15;
  const size_t r0 = (size_t)rb * 64;
  if (AMODE == 0) {
    const bf16_t* A = (const bf16_t*)(P.ws + WS_MIX) + r0 * D_;
#pragma unroll
    for (int q0 = 0; q0 < 16; ++q0) {
      const int q = wid * 16 + q0, row = q >> 1, ch = ((q & 1) * 64 + lane) ^ (row & 15);
      __builtin_amdgcn_global_load_lds((const unsigned*)(A + (size_t)row * D_ + ch * 8), (LAS unsigned*)(lds + q * 1024), 16, 0, 0);
    }
  } else {
    const bf16_t* __restrict__ O = (const bf16_t*)(P.ws + WS_XB) + r0 * D_;
    const bf16_t* __restrict__ H1 = (const bf16_t*)(P.ws + WS_H) + r0 * P1 + G_Z;
    const float* __restrict__ gn = P.in[12];
    const int row = tid >> 3, part = tid & 7;
    u32x4 ov[16];
#pragma unroll
    for (int c = 0; c < 16; ++c) ov[c] = *(const u32x4*)(O + (size_t)row * D_ + part * 128 + c * 8);
    const int bb = rb >> 6, cc = rb & 63;
    if (cc >= 32) {
      LAS float* PP = (LAS float*)(lds + RG_RED);
      LAS unsigned char* QP = lds + RG_RED + 4096;
#pragma unroll 1
      for (int hh = 0; hh < 4; ++hh) {
        const int itm = (bb * 4 + hh) * 64;
        if (tid < 128) {
          const int pp = tid, dd = (pp & ~31) + 16 * ((pp >> 2) & 1) + 4 * ((pp >> 3) & 3) + (pp & 3);
          const float* dec = (const float*)(P.ws + WS_DEC) + (size_t)itm * 128 + dd;
          float pr = 1.f;
#pragma unroll 4
          for (int c2 = 32; c2 < cc; ++c2) pr *= dec[(size_t)c2 * 128];
          PP[pp] = pr;
        }
        wg_sync();
        {
          const int p0 = (tid & 7) * 16;
          const bf16_t* qsrc = (const bf16_t*)(P.ws + WS_QT) + (size_t)(itm + cc) * 8192 + row * 128 + p0;
          const u32x4 q0 = *(const u32x4*)qsrc, q1 = *(const u32x4*)(qsrc + 8);
          u32x4 w0, w1;
#pragma unroll
          for (int e = 0; e < 4; ++e) {
            w0[e] = cvtpk(__uint_as_float(q0[e] << 16) * PP[p0 + 2 * e], __uint_as_float(q0[e] & 0xffff0000u) * PP[p0 + 2 * e + 1]);
            w1[e] = cvtpk(__uint_as_float(q1[e] << 16) * PP[p0 + 8 + 2 * e], __uint_as_float(q1[e] & 0xffff0000u) * PP[p0 + 8 + 2 * e + 1]);
          }
          *(LAS u32x4*)(QP + row * 272 + p0 * 2) = w0; *(LAS u32x4*)(QP + row * 272 + p0 * 2 + 16) = w1;
        }
        wg_sync();
        {
          const bf16_t* smt = (const bf16_t*)(P.ws + WS_SMT) + ((size_t)(bb * 4 + hh) * 256 + 32 * wid + i) * 128 + 8 * g;
          bf16x8 af[2][4];
#pragma unroll
          for (int q = 0; q < 2; ++q)
#pragma unroll
            for (int kk = 0; kk < 4; ++kk) af[q][kk] = *(const bf16x8*)(smt + (size_t)q * 16 * 128 + 32 * kk);
#pragma unroll 1
          for (int mm = 0; mm < 4; ++mm) {
            bf16x8 bfm[4];
#pragma unroll
            for (int kk = 0; kk < 4; ++kk) bfm[kk] = *(LAS const bf16x8*)(QP + (16 * mm + i) * 272 + (32 * kk + 8 * g) * 2);
#pragma unroll
            for (int q = 0; q < 2; ++q) {
              f32x4 ca = (f32x4){0.f, 0.f, 0.f, 0.f};
#pragma unroll
              for (int kk = 0; kk < 4; ++kk) ca = __builtin_amdgcn_mfma_f32_16x16x32_bf16(af[q][kk], bfm[kk], ca, 0, 0, 0);
              *(LAS u32x2*)(lds + (16 * mm + i) * 2048 + (hh * 256 + 32 * wid + 16 * q + 4 * g) * 2) = (u32x2){cvtpk(ca[0], ca[1]), cvtpk(ca[2], ca[3])};
            }
          }
        }
        wg_sync();
      }
#pragma unroll
      for (int c = 0; c < 16; ++c) {
        const u32x4 cr = *(LAS const u32x4*)(lds + row * 2048 + (part * 128 + c * 8) * 2);
#pragma unroll
        for (int e = 0; e < 4; ++e)
          ov[c][e] = cvtpk(__uint_as_float(ov[c][e] << 16) + __uint_as_float(cr[e] << 16), __uint_as_float(ov[c][e] & 0xffff0000u) + __uint_as_float(cr[e] & 0xffff0000u));
      }
      wg_sync();
    }
    float ss = 0.f;
#pragma unroll
    for (int c = 0; c < 16; ++c)
#pragma unroll
      for (int e = 0; e < 4; ++e) { const float lo = __uint_as_float(ov[c][e] << 16), hi = __uint_as_float(ov[c][e] & 0xffff0000u); ss += lo * lo + hi * hi; }
    ss = xsum<1>(ss);
    const float rinv = 1.f / sqrtf(ss * (1.f / 256.f) + LN_EPS);
#pragma unroll
    for (int c = 0; c < 16; ++c) {
      asm volatile("" ::: "memory");
      const int col = part * 128 + c * 8;
      const u32x4 zv = *(const u32x4*)(H1 + (size_t)row * P1 + col);
      const f32x4 g0 = *(const f32x4*)(gn + col), g1 = *(const f32x4*)(gn + col + 4);
      const float gg[8] = {g0[0], g0[1], g0[2], g0[3], g1[0], g1[1], g1[2], g1[3]};
      u32x4 w;
#pragma unroll
      for (int e = 0; e < 4; ++e) {
        const float o0 = __uint_as_float(ov[c][e] << 16), o1 = __uint_as_float(ov[c][e] & 0xffff0000u);
        const float z0 = __uint_as_float(zv[e] << 16), z1 = __uint_as_float(zv[e] & 0xffff0000u);
        w[e] = cvtpk(o0 * rinv * gg[2 * e] * silu_f(z0), o1 * rinv * gg[2 * e + 1] * silu_f(z1));
      }
      *(LAS u32x4*)(lds + row * 2048 + ((((part * 16 + c)) ^ (row & 15)) << 4)) = w;
    }
  }
  wg_sync();
  f32x4 acc[4][8];
#pragma unroll
  for (int m = 0; m < 4; ++m)
#pragma unroll
    for (int nt = 0; nt < 8; ++nt) acc[m][nt] = (f32x4){0.f, 0.f, 0.f, 0.f};
  const bf16_t* wp = Wf + ((size_t)(wid * 8) * 32 * 64 + lane) * 8;
  bf16x8 wf[2][8];
#pragma unroll
  for (int nt = 0; nt < 8; ++nt) wf[0][nt] = *(const bf16x8*)(wp + (size_t)(nt * 32) * 512);
#pragma unroll 1
  for (int ks = 0; ks < 32; ks += 2) {
#pragma unroll
    for (int hf = 0; hf < 2; ++hf) {
      const int kc = ks + hf;
      if (kc + 1 < 32) {
#pragma unroll
        for (int nt = 0; nt < 8; ++nt) wf[hf ^ 1][nt] = *(const bf16x8*)(wp + (size_t)(nt * 32 + kc + 1) * 512);
      }
      bf16x8 xf[4];
#pragma unroll
      for (int m = 0; m < 4; ++m) xf[m] = *(LAS const bf16x8*)(lds + (16 * m + i) * 2048 + (((4 * kc + g) ^ i) << 4));
#pragma unroll
      for (int m = 0; m < 4; ++m)
#pragma unroll
        for (int nt = 0; nt < 8; ++nt) acc[m][nt] = __builtin_amdgcn_mfma_f32_16x16x32_bf16(wf[hf][nt], xf[m], acc[m][nt], 0, 0, 0);
    }
  }
  LAS float* red = (LAS float*)(lds + RG_RED);
  {
  const int tid = otid(), lane = tid & 63, wid = __builtin_amdgcn_readfirstlane(tid >> 6), g = lane >> 4, i = lane & 15; (void)lane;
#pragma unroll
  for (int m = 0; m < 4; ++m) {
    const float* bp = base + (r0 + 16 * m + i) * D_ + wid * 128 + 4 * g;
    f32x4 bv[8];
#pragma unroll
    for (int nt = 0; nt < 8; ++nt) bv[nt] = *(const f32x4*)(bp + 16 * nt);
    float s1 = 0.f, s2 = 0.f;
#pragma unroll
    for (int nt = 0; nt < 8; ++nt) { const f32x4 v = acc[m][nt] + bv[nt] * ALPHA; acc[m][nt] = v; s1 += (v[0] + v[1]) + (v[2] + v[3]); s2 += (v[0] * v[0] + v[1] * v[1]) + (v[2] * v[2] + v[3] * v[3]); }
    s1 = xsum<16>(s1); s1 = xsum<32>(s1); s2 = xsum<16>(s2); s2 = xsum<32>(s2);
    if (g == 0) { red[((16 * m + i) * 8 + wid) * 2] = s1; red[((16 * m + i) * 8 + wid) * 2 + 1] = s2; }
  }
  wg_sync();
#pragma unroll 1
  for (int m = 0; m < 4; ++m) {
    float s1 = 0.f, s2 = 0.f;
#pragma unroll
    for (int w2 = 0; w2 < 8; ++w2) { s1 += red[((16 * m + i) * 8 + w2) * 2]; s2 += red[((16 * m + i) * 8 + w2) * 2 + 1]; }
    const float mean = s1 * (1.f / D_);
    const float var = fmaxf(s2 * (1.f / D_) - mean * mean, 0.f);
    const float rstd = 1.f / sqrtf(var + LN_EPS);
    const size_t off = (r0 + 16 * m + i) * D_ + wid * 128 + 4 * g;
#pragma unroll
    for (int nt = 0; nt < 8; ++nt) {
      const f32x4 gvv = *(const f32x4*)(gam + wid * 128 + 16 * nt + 4 * g), tvv = *(const f32x4*)(bet + wid * 128 + 16 * nt + 4 * g);
      const f32x4 av = m == 0 ? acc[0][nt] : (m == 1 ? acc[1][nt] : (m == 2 ? acc[2][nt] : acc[3][nt]));
      const f32x4 o = (av - mean) * rstd * gvv + tvv;
      *(f32x4*)(out + off + 16 * nt) = o;
      u32x2 w; w[0] = cvtpk(o[0], o[1]); w[1] = cvtpk(o[2], o[3]);
      if (outb) *(u32x2*)(outb + off + 16 * nt) = w;
      if (GLR) { const int row = 16 * m + i, chunk = 16 * wid + 2 * nt + (g >> 1);
        *(LAS u32x2*)(lds + row * 2048 + ((chunk ^ (row & 15)) << 4) + (g & 1) * 8) = w; }
    }
  }
  if (GLR) {
    wg_sync();
    const bf16_t* wg = (const bf16_t*)(P.ws + WS_WT1) + (size_t)(3072 + i) * D_ + 8 * g;
    const int mt = wid & 3, kh = wid >> 2;
    f32x4 a2 = (f32x4){0.f, 0.f, 0.f, 0.f};
#pragma unroll 4
    for (int q = 0; q < 16; ++q) {
      const int kc = kh * 16 + q;
      const bf16x8 wfr = *(const bf16x8*)(wg + 32 * kc);
      const bf16x8 xfr = *(LAS const bf16x8*)(lds + (16 * mt + i) * 2048 + (((4 * kc + g) ^ i) << 4));
      a2 = __builtin_amdgcn_mfma_f32_16x16x32_bf16(wfr, xfr, a2, 0, 0, 0);
    }
    LAS f32x4* r2 = (LAS f32x4*)(lds + RG_RED + 4096);
    if (kh == 1) r2[mt * 64 + lane] = a2;
    wg_sync();
    if (kh == 0) {
      const f32x4 tot = a2 + r2[mt * 64 + lane];
      *(f32x4*)((float*)(P.ws + WS_GLR) + (r0 + 16 * mt + i) * 16 + 4 * g) = tot;
    }
  }
  }
  wg_sync();
}

#define XB_TMO      128
#define XB_XCNT(j)  (256  + 64 * (j))
#define XB_XSUB(j)  (1280 + 64 * (j))
#define XB_XGEN(j)  (2304 + 64 * (j))
#define XB_TOP      3328
#define XB_TOPGEN   3392
#define XCD_BAR_WORDS 3456
#define XB_SPIN_CAP (1u << 18)

__device__ __forceinline__ unsigned xb_ld(unsigned* p)              { return __hip_atomic_load(p, __ATOMIC_RELAXED, __HIP_MEMORY_SCOPE_AGENT); }
__device__ __forceinline__ unsigned xb_add(unsigned* p, unsigned v) { return __hip_atomic_fetch_add(p, v, __ATOMIC_RELAXED, __HIP_MEMORY_SCOPE_AGENT); }
__device__ __forceinline__ unsigned xb_xcc_id() { return (unsigned)__builtin_amdgcn_s_getreg((3 << 11) | 20) & 0xFu; }
#define XB_SPIN(cond, bar) do { unsigned _sp = 0; while (cond) { __builtin_amdgcn_s_sleep(1); \
    if ((++_sp & 255u) == 0u) { if (xb_ld(&(bar)[XB_TMO])) break; if (_sp > XB_SPIN_CAP) { (void)__hip_atomic_fetch_add(&(bar)[XB_TMO], 1u, __ATOMIC_RELAXED, __HIP_MEMORY_SCOPE_AGENT); break; } } } } while (0)

struct XcdBarrier {
    unsigned* bar; unsigned x;
    volatile LAS unsigned* st;
};

__device__ __forceinline__ XcdBarrier xcd_barrier_post(unsigned* bar, volatile LAS unsigned* st) {
    XcdBarrier b; b.bar = bar; b.x = xb_xcc_id(); b.st = st;
    if (threadIdx.x == 0) (void)xb_add(&bar[XB_XCNT(b.x)], 1u);
    return b;
}
__device__ __forceinline__ void xcd_barrier_complete(unsigned* bar, unsigned x, unsigned& nloc, unsigned& nx) {
    const unsigned G = gridDim.x * gridDim.y * gridDim.z;
    unsigned sum, cnt, mine, sp = 0u;
    for (;;) {
        sum = 0u; cnt = 0u; mine = 0u;
#pragma unroll
        for (unsigned j = 0; j < 16; ++j) { const unsigned c = xb_ld(&bar[XB_XCNT(j)]); sum += c; cnt += (c > 0u) ? 1u : 0u; mine = (j == x) ? c : mine; }
        if (sum == G) break;
        __builtin_amdgcn_s_sleep(1);
        if ((++sp & 255u) == 0u) { if (xb_ld(&bar[XB_TMO])) break; if (sp > XB_SPIN_CAP) { (void)__hip_atomic_fetch_add(&bar[XB_TMO], 1u, __ATOMIC_RELAXED, __HIP_MEMORY_SCOPE_AGENT); break; } }
    }
    nloc = mine > 0u ? mine : 1u; nx = cnt > 0u ? cnt : 1u;
}

__device__ __forceinline__ void xcd_barrier(const XcdBarrier& b) {
    asm volatile("s_waitcnt vmcnt(0)" ::: "memory");
    wg_sync();
    if (threadIdx.x == 0) {
        unsigned* bar = b.bar;
        __builtin_amdgcn_s_waitcnt(0);
        unsigned nloc = b.st[0], nx = b.st[1];
        if (nloc == 0u) { xcd_barrier_complete(bar, b.x, nloc, nx); b.st[0] = nloc; b.st[1] = nx; }
        const unsigned old = xb_add(&bar[XB_XSUB(b.x)], 1u);
        const unsigned gen = old / nloc;
        if (old + 1u == (gen + 1u) * nloc) {
            __builtin_amdgcn_fence(__ATOMIC_RELEASE, "agent");
            asm volatile("s_waitcnt vmcnt(0)" ::: "memory");
            const unsigned og = xb_add(&bar[XB_TOP], 1u);
            const unsigned tg = og / nx;
            if (og + 1u == (tg + 1u) * nx) xb_add(&bar[XB_TOPGEN], 1u);
            else XB_SPIN(xb_ld(&bar[XB_TOPGEN]) == tg, bar);
            __builtin_amdgcn_fence(__ATOMIC_ACQUIRE, "agent");
            xb_add(&bar[XB_XGEN(b.x)], 1u);
            asm volatile("s_waitcnt vmcnt(0)" ::: "memory");
        } else {
            XB_SPIN(xb_ld(&bar[XB_XGEN(b.x)]) == gen, bar);
            __builtin_amdgcn_fence(__ATOMIC_ACQUIRE, "agent");
            asm volatile("s_waitcnt vmcnt(0)" ::: "memory");
        }
    }
    wg_sync();
}


__device__ const unsigned short p3_order[1024] = {638,636,634,632,630,628,626,624,15,143,271,399,622,14,142,270,398,620,618,13,141,269,397,616,614,12,140,268,396,612,610,11,139,267,395,608,606,10,138,266,394,604,602,9,137,265,393,560,562,564,566,568,570,572,574,544,546,548,550,552,554,556,558,600,536,538,540,542,534,598,8,136,264,392,532,596,530,594,7,135,263,391,528,592,6,134,262,390,526,590,524,588,5,133,261,389,522,586,520,584,4,132,260,388,518,582,3,131,259,387,516,580,2,130,258,386,514,578,1,129,257,385,512,576,0,128,256,384,639,637,635,633,631,629,627,625,31,159,287,415,623,621,30,158,286,414,619,617,29,157,285,413,615,613,28,156,284,412,611,609,27,155,283,411,607,26,154,282,410,605,603,25,153,281,409,561,563,565,567,569,571,573,575,601,545,547,549,551,553,555,557,559,535,537,539,541,543,599,24,152,280,408,533,597,531,595,23,151,279,407,529,593,527,591,22,150,278,406,525,589,523,587,21,149,277,405,521,585,20,148,276,404,519,583,19,147,275,403,517,581,18,146,274,402,515,579,17,145,273,401,513,577,16,144,272,400,766,764,762,760,758,756,754,752,47,175,303,431,750,46,174,302,430,748,746,45,173,301,429,744,742,44,172,300,428,740,738,43,171,299,427,736,734,42,170,298,426,732,730,41,169,297,425,688,690,692,694,696,698,700,702,672,674,676,678,680,682,684,686,728,664,666,668,670,662,726,40,168,296,424,660,724,658,722,39,167,295,423,656,720,38,166,294,422,654,718,652,716,37,165,293,421,650,714,648,712,36,164,292,420,646,710,35,163,291,419,644,708,34,162,290,418,642,706,33,161,289,417,640,704,32,160,288,416,767,765,763,761,759,757,755,753,63,191,319,447,751,749,62,190,318,446,747,745,61,189,317,445,743,741,60,188,316,444,739,737,59,187,315,443,735,58,186,314,442,733,731,57,185,313,441,689,691,693,695,697,699,701,703,729,673,675,677,679,681,683,685,687,663,665,667,669,671,727,56,184,312,440,661,725,659,723,55,183,311,439,657,721,655,719,54,182,310,438,653,717,651,715,53,181,309,437,649,713,52,180,308,436,647,711,51,179,307,435,645,709,50,178,306,434,643,707,49,177,305,433,641,705,48,176,304,432,894,892,890,888,886,884,882,880,79,207,335,463,878,78,206,334,462,876,874,77,205,333,461,872,870,76,204,332,460,868,866,75,203,331,459,864,862,74,202,330,458,860,858,73,201,329,457,816,818,820,822,824,826,828,830,800,802,804,806,808,810,812,814,856,792,794,796,798,790,854,72,200,328,456,788,852,786,850,71,199,327,455,784,848,70,198,326,454,782,846,780,844,69,197,325,453,778,842,776,840,68,196,324,452,774,838,67,195,323,451,772,836,66,194,322,450,770,834,65,193,321,449,768,832,64,192,320,448,895,893,891,889,887,885,883,881,95,223,351,479,879,877,94,222,350,478,875,873,93,221,349,477,871,869,92,220,348,476,867,865,91,219,347,475,863,90,218,346,474,861,859,89,217,345,473,817,819,821,823,825,827,829,831,857,801,803,805,807,809,811,813,815,791,793,795,797,799,855,88,216,344,472,789,853,787,851,87,215,343,471,785,849,783,847,86,214,342,470,781,845,779,843,85,213,341,469,777,841,84,212,340,468,775,839,83,211,339,467,773,837,82,210,338,466,771,835,81,209,337,465,769,833,80,208,336,464,1022,1020,1018,1016,1014,1012,1010,1008,111,239,367,495,1006,110,238,366,494,1004,1002,109,237,365,493,1000,998,108,236,364,492,996,994,107,235,363,491,992,990,106,234,362,490,988,986,105,233,361,489,944,946,948,950,952,954,956,958,928,930,932,934,936,938,940,942,984,920,922,924,926,918,982,104,232,360,488,916,980,914,978,103,231,359,487,912,976,102,230,358,486,910,974,908,972,101,229,357,485,906,970,904,968,100,228,356,484,902,966,99,227,355,483,900,964,98,226,354,482,898,962,97,225,353,481,896,960,96,224,352,480,1023,1021,1019,1017,1015,1013,1011,1009,127,255,383,511,1007,1005,126,254,382,510,1003,1001,125,253,381,509,999,997,124,252,380,508,995,993,123,251,379,507,991,122,250,378,506,989,987,121,249,377,505,945,947,949,951,953,955,957,959,985,929,931,933,935,937,939,941,943,919,921,923,925,927,983,120,248,376,504,917,981,915,979,119,247,375,503,913,977,911,975,118,246,374,502,909,973,907,971,117,245,373,501,905,969,116,244,372,500,903,967,115,243,371,499,901,965,114,242,370,498,899,963,113,241,369,497,897,961,112,240,368,496};
constexpr int CTL_P3_QUEUE = 8192;
constexpr int CTL_LN0 = 4096, CTL_LN1 = 9216, CTL_TMO = 3520;
constexpr size_t WS_XCH0 = 253 * MiB, WS_XCH1 = 254 * MiB;

#ifndef REP_P0
#define REP_P0 1
#endif
#ifndef REP_P2
#define REP_P2 1
#endif
#ifndef REP_P3
#define REP_P3 1
#endif
#ifndef REP_P7
#define REP_P7 1
#endif
#ifndef REP_P8
#define REP_P8 1
#endif
__global__ void __launch_bounds__(512) __attribute__((target("no-packed-fp32-ops"))) fwd_megakernel(Params P) {
  cg::grid_group grid = cg::this_grid();
  extern __shared__ __attribute__((aligned(16))) unsigned char smem[];
  const int tid = otid(), lane = tid & 63, wid = tid >> 6;
  unsigned char* ws = P.ws;
  bf16_t* XB = (bf16_t*)(ws + WS_XB);
  bf16_t* MIX = (bf16_t*)(ws + WS_MIX);
  bf16_t* Hb = (bf16_t*)(ws + WS_H);
  float* Y = (float*)(ws + WS_H);
  volatile LAS unsigned* xst = (volatile LAS unsigned*)((LAS unsigned char*)smem + XB_LDS_OFF);
  if (tid < 4) xst[tid] = 0u;
  wg_sync();
  (void)xcd_barrier_post((unsigned*)ws, xst);
#define GRID_BAR() do { XcdBarrier xb_; xb_.bar = (unsigned*)P.ws; xb_.x = xb_xcc_id(); xb_.st = (volatile LAS unsigned*)((LAS unsigned char*)smem + XB_LDS_OFF); xcd_barrier(xb_); } while (0)

  for (int rep = 0; rep < REP_P0; ++rep) {
    const float4* x4 = (const float4*)P.in[0];
    const size_t n4 = (size_t)M_ * D_ / 4;
    {
      const size_t stride = (size_t)gridDim.x * 512;
      for (size_t i = (size_t)blockIdx.x * 512 + tid; i < n4; i += 8 * stride) {
        float4 v[8];
#pragma unroll
        for (int u = 0; u < 8; ++u) if (i + u * stride < n4) v[u] = x4[i + u * stride];
#pragma unroll
        for (int u = 0; u < 8; ++u) if (i + u * stride < n4) { ushort4 o; o.x = f2bf(v[u].x); o.y = f2bf(v[u].y); o.z = f2bf(v[u].z); o.w = f2bf(v[u].w); ((ushort4*)XB)[i + u * stride] = o; }
      }
    }
    {
      constexpr int T0 = (P0 / 32) * 16, T1 = 32 * 16, T2 = (P1 / 32) * 16, T3 = 32 * 16, T4 = 2 * 4 * 32, T5 = 2 * 2 * 2;
      float* scr = (float*)smem + wid * (64 * 33);
      for (int it = blockIdx.x * 8 + wid; it < T0 + T1 + T2 + T3 + T4 + T5; it += gridDim.x * 8) {
        int r = it;
        if (r < T0) { transpose_wave_tile(P.in[1], D_, EVEN_IN, (bf16_t*)(ws + WS_WT0), 0, r, P0 / 32, scr, lane); continue; } r -= T0;
        if (r < T1) { transpose_wave_tile(P.in[6], D_, D_, (bf16_t*)(ws + WS_WO0), 3, r, 32, scr, lane); continue; } r -= T1;
        if (r < T2) { transpose_wave_tile(P.in[9], D_, ODD_IN, (bf16_t*)(ws + WS_WT1), 1, r, P1 / 32, scr, lane); continue; } r -= T2;
        if (r < T3) { transpose_wave_tile(P.in[13], D_, D_, (bf16_t*)(ws + WS_WO1), 3, r, 32, scr, lane); continue; } r -= T3;
        if (r < T4) { const int i = r >> 7; transpose_wave_tile(P.in[3] + (size_t)i * 2048 * 128, 2048, 128, (bf16_t*)(ws + WS_W1T) + (size_t)i * 128 * 2048, 2, r & 127, 4, scr, lane); continue; } r -= T4;
        { const int i = r >> 2; transpose_wave_tile(P.in[5] + (size_t)i * 128 * 64, 128, 64, (bf16_t*)(ws + WS_W2T) + (size_t)i * 64 * 128, 2, r & 3, 2, scr, lane); }
      }
      wg_sync();
    }
    for (int it = blockIdx.x + 132; it < 2 * 64 + 2 * 2 + 64; it += gridDim.x) {
      {
        const int t2 = it - 132, i = t2 >> 5, q = t2 & 31, hh = tid & 127, sub = tid >> 7;
        const float* pos = P.in[2] + i * 2048 + q * 64 + sub * 16;
        const float* w1 = P.in[3] + ((size_t)i * 2048 + q * 64 + sub * 16) * 128 + hh;
        float a = 0.f;
#pragma unroll
        for (int f = 0; f < 16; ++f) a += pos[f] * w1[f * 128];
        float* red = (float*)smem;
        red[sub * 128 + hh] = a;
        wg_sync();
        if (tid < 128) ((float*)(ws + WS_C1P))[(i * 32 + q) * 128 + tid] = (red[tid] + red[128 + tid]) + (red[256 + tid] + red[384 + tid]);
        wg_sync();
      }
    }
    for (int q = blockIdx.x * 512 + tid; q < B_ * 16 * 512; q += gridDim.x * 512) ((float*)(ws + WS_KM))[q] = 0.f;
    if (blockIdx.x == 0) { const int which = tid >> 8, r = tid & 255;
      unsigned* z = (unsigned*)(ws + (which == 0 ? (size_t)(248 * MiB) : (size_t)(249 * MiB)));
      const int bg = r >> 5, wd = r & 31; z[((size_t)bg * 256 + 255) * 32 + wd] = 0u; }
    GRID_BAR();
  }
  if (P.out == nullptr) grid.sync();
  { pg8::Gemm gm{XB, (const bf16_t*)(ws + WS_WT0), M_, P0, D_}; pg8::StaticOrder so; so.init(M_, P0, (int)gridDim.x, (int)blockIdx.x);
    pg8::EpiBf16s ep{Hb, P0, (3u << (C_NQ / 256)) | (3u << (C_MQ / 256)), C1, (float*)(ws + WS_KM), C_MK / 256}; pg8::gemm_phase<pg8::EpiBf16s, pg8::StaticOrder, true, true>((LAS unsigned char*)smem, gm, so, ep); }
  GRID_BAR();
  for (int rep = 0; rep < REP_P2; ++rep) {
    for (int it = blockIdx.x; it < 256; it += gridDim.x) compress_mfma_tile(P, it, smem);
    GRID_BAR();
  }
  for (int rep = 0; rep < REP_P3; ++rep) {
    const int myx = (int)(xb_xcc_id() & 7u);
    int steal = 0;
    for (;;) {
      LAS int* qslot = (LAS int*)((LAS unsigned char*)smem + AT_MISC + 384);
      const int qx = (myx + steal) & 7;
      if (tid == 0) *qslot = (int)__hip_atomic_fetch_add((unsigned*)P.ws + CTL_P3_QUEUE + 64 * qx, 1u, __ATOMIC_RELAXED, __HIP_MEMORY_SCOPE_AGENT) - rep * 128;
      wg_sync();
      int it = __builtin_amdgcn_readfirstlane(*qslot);
      wg_sync();
      if (it >= 128) { if (++steal == 8) break; continue; }
      it += qx * 128;
      const int e = p3_order[it], pl = e & 511;
#ifdef FORCE_SAFE
      if (e >> 9) (void)nsa_mfma_item<true>(P, pl >> 7, (pl >> 6) & 1, pl & 63, smem);
      else (void)moba_mfma_item<true>(P, pl >> 7, (pl >> 4) & 7, pl & 15, smem);
#else
      if (e >> 9) { if (nsa_mfma_item<false>(P, pl >> 7, (pl >> 6) & 1, pl & 63, smem)) (void)nsa_mfma_item<true>(P, pl >> 7, (pl >> 6) & 1, pl & 63, smem); }
      else { if (moba_mfma_item<false>(P, pl >> 7, (pl >> 4) & 7, pl & 15, smem)) (void)moba_mfma_item<true>(P, pl >> 7, (pl >> 4) & 7, pl & 15, smem); }
#endif
    }
    GRID_BAR();
  }
  if ((int)blockIdx.x < M_ / 64) rowgemm_block<0, true>(P, (int)blockIdx.x, (const bf16_t*)(ws + WS_WO0), P.in[0], P.out, XB, P.in[7], P.in[8], smem);
  GRID_BAR();
  { pg8::Gemm gm{XB, (const bf16_t*)(ws + WS_WT1), M_, 3072, D_}; pg8::StaticOrder so; so.init(M_, 3072, (int)gridDim.x, (int)blockIdx.x);
    pg8::EpiBf16s ep{Hb, P1, 0u, 1.f, nullptr, 0}; pg8::gemm_phase<pg8::EpiBf16s, pg8::StaticOrder, true, true>((LAS unsigned char*)smem, gm, so, ep); }
  GRID_BAR();
  for (int rep = 0; rep < REP_P8; ++rep) {
    { const int j = (int)blockIdx.x; if (j < 256) gla_prep_item(P, (j & 15) * 64 + ((j >> 4) & 1) * 32 + (j >> 5), smem); }
    if ((int)blockIdx.x < 128) { const int w = (int)blockIdx.x, u = w >> 3, bh = (w & 7) + 8 * (u >> 3), eq = u & 3, seg = (u >> 2) & 1;
      gla_chain64(P, bh * 4 + eq, seg, smem); }
    else for (int j = 256 + (int)blockIdx.x - 128; j < 1024; j += 128) gla_prep_item(P, (j & 15) * 64 + ((j >> 4) & 1) * 32 + (j >> 5), smem);
    GRID_BAR();
  }
  if ((int)blockIdx.x < M_ / 64) rowgemm_block<1, false>(P, (int)blockIdx.x, (const bf16_t*)(ws + WS_WO1), P.out, P.out, nullptr, P.in[14], P.in[15], smem);
}

extern "C" void kernel_launch(void* const* d_in, const int* in_sizes, int n_in, void* d_out, int out_size,
                              void* d_ws, size_t ws_size, hipStream_t stream) {
  constexpr size_t kDynLds = 157696;
  static_assert((size_t)XB_LDS_OFF >= (size_t)G4_END && kDynLds <= 163840 && kDynLds >= (size_t)XB_LDS_OFF + 16 && (size_t)XB_LDS_OFF >= (size_t)AT_LDS_END && kDynLds >= (size_t)AT_LDS_END && kDynLds >= 2 * (size_t)GS_BYTES && kDynLds >= (size_t)pg8::STAGE_BYTES, "LDS");
  static int grid_blocks = 0;
  if (!grid_blocks) {
    int dev = 0, cus = 0, per_cu = 0;
    (void)hipGetDevice(&dev);
    (void)hipDeviceGetAttribute(&cus, hipDeviceAttributeMultiprocessorCount, dev);
    (void)hipFuncSetAttribute((const void*)fwd_megakernel, hipFuncAttributeMaxDynamicSharedMemorySize, (int)kDynLds);
    (void)hipOccupancyMaxActiveBlocksPerMultiprocessor(&per_cu, fwd_megakernel, 512, kDynLds);
    if (per_cu < 1) per_cu = 1;
    if (per_cu > 2) per_cu = 2;
    grid_blocks = cus * per_cu;
    if (grid_blocks != 256) { fprintf(stderr, "kernel_launch: this kernel is laid out for exactly 256 co-resident workgroups (256 CUs x 1); got %d x %d\n", cus, per_cu); grid_blocks = 256; }
    if (n_in != 16 || ws_size < WS_END) { fprintf(stderr, "kernel_launch: unexpected n_in %d / ws %zu\n", n_in, ws_size); }
  }
  (void)hipMemsetAsync(d_ws, 0, 524288, stream);
  Params p{};
  for (int i = 0; i < 16; ++i) p.in[i] = (const float*)d_in[i];
  p.out = (float*)d_out; p.ws = (unsigned char*)d_ws;
  void* args[] = {&p};
  hipError_t e = hipLaunchCooperativeKernel((void*)fwd_megakernel, dim3(grid_blocks), dim3(512), args, kDynLds, stream);
  if (e != hipSuccess) fprintf(stderr, "cooperative launch failed: %s (grid %d)\n", hipGetErrorString(e), grid_blocks);
}
```

```cpp
#include <hip/hip_runtime.h>
#include <hip/hip_cooperative_groups.h>
#include <cstdio>
#include <cstdint>
namespace cg = cooperative_groups;

typedef unsigned short bf16_t;
typedef short bf16x8 __attribute__((ext_vector_type(8)));
typedef float f32x4 __attribute__((ext_vector_type(4)));
typedef unsigned u32x4 __attribute__((ext_vector_type(4)));
typedef unsigned u32x2 __attribute__((ext_vector_type(2)));

constexpr int B_ = 4, S_ = 4096, M_ = B_ * S_, D_ = 1024;
constexpr int P0 = 4096;
constexpr int P1 = 3328;
constexpr int EVEN_IN = 3864, ODD_IN = 3088;
constexpr int C_NQ = 0, C_KCMP = 512, C_VCMP = 640, C_KSEL = 768, C_VSEL = 896, C_KWIN = 1024, C_VWIN = 1152;
constexpr int C_NZ = 1280, C_MQ = 1792, C_MK = 2304, C_MV = 2816, C_MZ = 3328, C_NG = 3840;
constexpr int G_Q = 0, G_K = 512, G_V = 1024, G_Z = 2048, G_LR = 3072;
constexpr int NCMP = 255;
constexpr float ALPHA = 1.4142135623730951f;
constexpr float LN_EPS = 1e-5f;

constexpr size_t MiB = 1u << 20;
constexpr int XB_LDS_OFF = 157440;
constexpr size_t WS_WT0 = 1 * MiB;
constexpr size_t WS_WO0 = 9 * MiB;
constexpr size_t WS_WT1 = 11 * MiB;
constexpr size_t WS_WO1 = 18 * MiB;
constexpr size_t WS_XB = 20 * MiB;
constexpr size_t WS_MIX = 52 * MiB;
constexpr size_t WS_H = 84 * MiB;
constexpr size_t WS_G = 212 * MiB;
constexpr size_t WS_GLR = 245 * MiB;
constexpr size_t WS_SMT = 246 * MiB;
constexpr size_t WS_KC = 245 * MiB;
constexpr size_t WS_VC = 246 * MiB;
constexpr size_t WS_KM = 247 * MiB;
constexpr size_t WS_END = 256 * MiB;

struct Params { const float* in[16]; float* out; unsigned char* ws; };

__device__ __forceinline__ int otid() { int t = __builtin_amdgcn_workitem_id_x(); asm volatile("" : "+v"(t)); return t; }
__device__ __forceinline__ void wg_sync() { __builtin_amdgcn_fence(__ATOMIC_RELEASE, "workgroup"); __builtin_amdgcn_s_barrier(); __builtin_amdgcn_fence(__ATOMIC_ACQUIRE, "workgroup"); }
__device__ __forceinline__ float bf2f(bf16_t v) { return __uint_as_float(((unsigned)v) << 16); }
__device__ __forceinline__ bf16_t f2bf(float f) { unsigned u = __float_as_uint(f); return (bf16_t)((u + 0x7fffu + ((u >> 16) & 1u)) >> 16); }
template <int M> __device__ __forceinline__ float xsum(float v) {
  if constexpr (M == 32) { auto rr = __builtin_amdgcn_permlane32_swap(__float_as_uint(v), __float_as_uint(v), false, false); return __uint_as_float(rr[0]) + __uint_as_float(rr[1]); }
  else return v + __int_as_float(__builtin_amdgcn_ds_swizzle(__float_as_int(v), (M << 10) | 0x1f));
}
template <int M> __device__ __forceinline__ float xmax(float v) {
  if constexpr (M == 32) { auto rr = __builtin_amdgcn_permlane32_swap(__float_as_uint(v), __float_as_uint(v), false, false); return fmaxf(__uint_as_float(rr[0]), __uint_as_float(rr[1])); }
  else return fmaxf(v, __int_as_float(__builtin_amdgcn_ds_swizzle(__float_as_int(v), (M << 10) | 0x1f)));
}
template <int M> __device__ __forceinline__ unsigned xorr(unsigned v) {
  if constexpr (M == 32) { auto rr = __builtin_amdgcn_permlane32_swap(v, v, false, false); return rr[0] | rr[1]; }
  else return v | (unsigned)__builtin_amdgcn_ds_swizzle((int)v, (M << 10) | 0x1f);
}
__device__ __forceinline__ float wave_sum(float v) { v = xsum<1>(v); v = xsum<2>(v); v = xsum<4>(v); v = xsum<8>(v); v = xsum<16>(v); return xsum<32>(v); }
__device__ __forceinline__ float wave_max(float v) { v = xmax<1>(v); v = xmax<2>(v); v = xmax<4>(v); v = xmax<8>(v); v = xmax<16>(v); return xmax<32>(v); }
__device__ __forceinline__ float silu_f(float z) { return z / (1.f + __expf(-z)); }
__device__ __forceinline__ float sigmoid_f(float z) { return 1.f / (1.f + __expf(-z)); }

__device__ __forceinline__ int colmap0(int c) {
  if (c < 1280) return c;
  if (c < 1792) return 1304 + (c - 1280);
  if (c < 3840) return 1816 + (c - 1792);
  if (c < 3864) return 1280 + (c - 3840);
  return -1;
}
__device__ __forceinline__ int colmap1(int c) {
  if (c < 2048) return c;
  if (c < 3072) return 2064 + (c - 2048);
  if (c < 3088) return 2048 + (c - 3072);
  return -1;
}

__device__ __forceinline__ void transpose_tile(const float* __restrict__ W, int K, int Nsrc, bf16_t* __restrict__ Wt, int which, int tile, int ntn, float* sm) {
  const int tid = otid();
  const int nb = tile % ntn, kb = tile / ntn, n0 = nb * 64, k0 = kb * 64;
#pragma unroll
  for (int i = 0; i < 8; ++i) {
    const int kk = i * 8 + (tid >> 6), nn = tid & 63;
    const int c = n0 + nn;
    const int src = which == 0 ? colmap0(c) : (which == 1 ? colmap1(c) : c);
    sm[kk * 65 + nn] = src >= 0 ? W[(size_t)(k0 + kk) * Nsrc + src] : 0.f;
  }
  wg_sync();
#pragma unroll
  for (int i = 0; i < 8; ++i) {
    const int nn = i * 8 + (tid >> 6), kk = tid & 63;
    Wt[(size_t)(n0 + nn) * K + k0 + kk] = f2bf(sm[kk * 65 + nn]);
  }
  wg_sync();
}


__device__ __forceinline__ void transpose_wave_tile(const float* __restrict__ W, int K, int Nsrc, bf16_t* __restrict__ Wt, int which, int tile, int ntn, float* scr, int lane) {
  const int nb = tile % ntn, kb = tile / ntn, n0 = nb * 32, k0 = kb * 64;
  const int c = n0 + (lane & 31);
  const int src = which == 0 ? colmap0(c) : (which == 1 ? colmap1(c) : c);
  float v[32];
#pragma unroll
  for (int q = 0; q < 32; ++q) { const int kk = 2 * q + (lane >> 5); v[q] = src >= 0 ? W[(size_t)(k0 + kk) * Nsrc + src] : 0.f; }
#pragma unroll
  for (int q = 0; q < 32; ++q) { const int kk = 2 * q + (lane >> 5); scr[kk * 33 + (lane & 31)] = v[q]; }
  __builtin_amdgcn_wave_barrier();
  if (which == 3) {
    const int k = k0 + lane;
#pragma unroll 8
    for (int nn = 0; nn < 32; ++nn) { const int n = n0 + nn; Wt[((size_t)(((n >> 4) * 32 + (k >> 5)) * 64 + ((k >> 3) & 3) * 16 + (n & 15))) * 8 + (k & 7)] = f2bf(scr[lane * 33 + nn]); }
  } else {
#pragma unroll 8
    for (int nn = 0; nn < 32; ++nn) Wt[(size_t)(n0 + nn) * K + k0 + lane] = f2bf(scr[lane * 33 + nn]);
  }
  __builtin_amdgcn_wave_barrier();
}

__device__ __forceinline__ void gemm_tile(const bf16_t* __restrict__ A, const bf16_t* __restrict__ Bt, int K, int m0, int n0, int mode, void* outp, int ldc, unsigned char* smem) {
  bf16_t* As = (bf16_t*)smem;
  bf16_t* Bs = As + 128 * 72;
  const int tid = otid(), lane = tid & 63, wid = tid >> 6, wm = wid >> 1, wn = wid & 1;
  f32x4 acc[2][4];
#pragma unroll
  for (int i = 0; i < 2; ++i)
#pragma unroll
    for (int j = 0; j < 4; ++j) acc[i][j] = (f32x4){0.f, 0.f, 0.f, 0.f};
  for (int k0 = 0; k0 < K; k0 += 64) {
#pragma unroll
    for (int i = 0; i < 2; ++i) {
      const int idx = tid + i * 512, r = idx >> 3, c = (idx & 7) * 8;
      *(uint4*)(As + r * 72 + c) = *(const uint4*)(A + (size_t)(m0 + r) * K + k0 + c);
      *(uint4*)(Bs + r * 72 + c) = *(const uint4*)(Bt + (size_t)(n0 + r) * K + k0 + c);
    }
    wg_sync();
#pragma unroll
    for (int kk = 0; kk < 64; kk += 32) {
      bf16x8 a[2], b[4];
#pragma unroll
      for (int i = 0; i < 2; ++i) a[i] = *(const bf16x8*)(As + (wm * 32 + i * 16 + (lane & 15)) * 72 + kk + (lane >> 4) * 8);
#pragma unroll
      for (int j = 0; j < 4; ++j) b[j] = *(const bf16x8*)(Bs + (wn * 64 + j * 16 + (lane & 15)) * 72 + kk + (lane >> 4) * 8);
#pragma unroll
      for (int i = 0; i < 2; ++i)
#pragma unroll
        for (int j = 0; j < 4; ++j) acc[i][j] = __builtin_amdgcn_mfma_f32_16x16x32_bf16(a[i], b[j], acc[i][j], 0, 0, 0);
    }
    wg_sync();
  }
#pragma unroll
  for (int i = 0; i < 2; ++i)
#pragma unroll
    for (int j = 0; j < 4; ++j)
#pragma unroll
      for (int r = 0; r < 4; ++r) {
        const int row = m0 + wm * 32 + i * 16 + (lane >> 4) * 4 + r, col = n0 + wn * 64 + j * 16 + (lane & 15);
        if (mode == 0) ((bf16_t*)outp)[(size_t)row * ldc + col] = f2bf(acc[i][j][r]);
        else ((float*)outp)[(size_t)row * ldc + col] = acc[i][j][r];
      }
}
__device__ __forceinline__ void gemm_phase(const bf16_t* A, const bf16_t* Bt, int K, int N, int mode, void* outp, int ldc, unsigned char* smem) {
  const int ntn = N / 128, ntm = M_ / 128;
  for (int t = blockIdx.x; t < ntn * ntm; t += gridDim.x) {
    const int tn = t % ntn, tm = t / ntn;
    gemm_tile(A, Bt, K, tm * 128, tn * 128, mode, outp, ldc, smem);
  }
}

namespace pg8 {
#define PG8_LAS __attribute__((address_space(3)))
typedef unsigned short bf16_t;
typedef short bf16x8 __attribute__((ext_vector_type(8)));
typedef float f32x4 __attribute__((ext_vector_type(4)));
typedef unsigned u32x4 __attribute__((ext_vector_type(4)));
constexpr int BM = 256, BK = 64, HALF = 128, HTB = HALF * BK * 2  , STAGE_BYTES = 8 * HTB, NXCD = 8, WGM = 8;

__host__ __device__ __forceinline__ int lds_byte(int r, int c) { const int st = (r >> 4) * 2 + (c >> 5), rr = r & 15, cc = c & 31, ob = rr * 64 + cc * 2; return st * 1024 + (ob ^ (((ob >> 9) & 1) << 5)); }
__host__ __device__ __forceinline__ void stage_rc(int b, int& R, int& C) { const int st = b / 1024, sb = b % 1024, swz = sb ^ (((sb >> 9) & 1) << 5); R = (st >> 1) * 16 + swz / 64; C = (st & 1) * 32 + (swz % 64) / 2; }
__host__ __device__ __forceinline__ int perm32(int rho) { const int n = rho >> 4, i = rho & 15; return 8 * (i >> 2) + 4 * n + (i & 3); }

__device__ __forceinline__ unsigned cvtpk(float lo, float hi) { typedef float f2 __attribute__((ext_vector_type(2))); typedef __bf16 b2 __attribute__((ext_vector_type(2))); f2 v = {lo, hi}; b2 b = __builtin_convertvector(v, b2); return __builtin_bit_cast(unsigned, b); }
template <int M> __device__ __forceinline__ float xsum_sw(float v) { return v + __int_as_float(__builtin_amdgcn_ds_swizzle(__float_as_int(v), (M << 10) | 0x1f)); }
struct Unit { int pm, pn; };
struct Gemm { const bf16_t* A; const bf16_t* Bt; int M, N, K; };

struct StaticOrder {
    int nM, nN, nwg, G, c;
    __host__ __device__ __forceinline__ void init(int M, int N, int G_, int c_) { nM = M / BM; nN = N / BM; nwg = nM * nN; G = G_; c = c_; }
    __host__ __device__ bool next(int i, Unit& u) const {
        const long L = (long)i * G + c; if (L >= nwg) return false;
        int wgid = (int)L; { const int q = nwg / NXCD, r = nwg % NXCD, xcd = wgid % NXCD, off = wgid / NXCD; wgid = (xcd < r ? xcd * (q + 1) : r * (q + 1) + (xcd - r) * q) + off; }
        const int nig = WGM * nN, gid = wgid / nig, fm = gid * WGM, gsz = (nM - fm) < WGM ? (nM - fm) : WGM;
        u.pm = fm + ((wgid % nig) % gsz); u.pn = (wgid % nig) / gsz; return true;
    }
    __device__ __forceinline__ void a_ready(const Unit&) const {}
    __device__ __forceinline__ void done(const Unit&) const {}
};


struct EpiBf16s {
    static constexpr bool PERM = true, AFTER_DRAIN = false;
    bf16_t* O; int ldc;
    unsigned qmask; float qscale;
    float* km; int km_pn0;
    __device__ __forceinline__ void operator()(const f32x4 (&acc)[2][2][4][2], const Unit& u, int wr, int wc, int fr, int fq) const {
        const int row0 = u.pm * BM + wr * 64 + fr, col0 = u.pn * BM + wc * 32 + 8 * fq;
        const float sc = ((qmask >> u.pn) & 1u) ? qscale : 1.f;
#pragma unroll
        for (int ai = 0; ai < 2; ++ai)
#pragma unroll
            for (int m = 0; m < 4; ++m) { bf16_t* rowp = O + (size_t)(row0 + ai * HALF + m * 16) * ldc + col0;
#pragma unroll
                for (int bj = 0; bj < 2; ++bj) { const f32x4 v0 = acc[ai][bj][m][0] * sc, v1 = acc[ai][bj][m][1] * sc;
                    u32x4 w; w.x = cvtpk(v0[0], v0[1]); w.y = cvtpk(v0[2], v0[3]); w.z = cvtpk(v1[0], v1[1]); w.w = cvtpk(v1[2], v1[3]);
                    *(u32x4*)(rowp + bj * HALF) = w; } }
        if (km != nullptr && (u.pn == km_pn0 || u.pn == km_pn0 + 1)) {
#pragma unroll
            for (int bj = 0; bj < 2; ++bj)
#pragma unroll
                for (int n = 0; n < 2; ++n) {
                    f32x4 sacc = (f32x4){0.f, 0.f, 0.f, 0.f};
#pragma unroll
                    for (int ai = 0; ai < 2; ++ai)
#pragma unroll
                        for (int m = 0; m < 4; ++m) sacc += acc[ai][bj][m][n];
#pragma unroll
                    for (int e = 0; e < 4; ++e) { float v = sacc[e]; v = xsum_sw<1>(v); v = xsum_sw<2>(v); v = xsum_sw<4>(v); v = xsum_sw<8>(v); sacc[e] = v; }
                    if (fr == 0) { float* dst = km + (size_t)u.pm * 512 + (u.pn - km_pn0) * BM + bj * HALF + wc * 32 + 8 * fq + 4 * n;
#pragma unroll
                        for (int e = 0; e < 4; ++e) atomicAdd(dst + e, sacc[e] * (1.0f / 256.0f)); }
                }
        }
    }
};
struct EpiF32 {
    static constexpr bool PERM = false, AFTER_DRAIN = false;
    float* O; int ldc;
    __device__ __forceinline__ void operator()(const f32x4 (&acc)[2][2][4][2], const Unit& u, int wr, int wc, int fr, int fq) const {
        const int col0 = u.pn * BM + wc * 32 + 4 * fq;
#pragma unroll
        for (int ai = 0; ai < 2; ++ai)
#pragma unroll
            for (int m = 0; m < 4; ++m) { float* rowp = O + (size_t)(u.pm * BM + ai * HALF + wr * 64 + m * 16 + fr) * ldc + col0;
#pragma unroll
                for (int bj = 0; bj < 2; ++bj)
#pragma unroll
                    for (int n = 0; n < 2; ++n) *(f32x4*)(rowp + bj * HALF + n * 16) = acc[ai][bj][m][n]; }
    }
};

struct PanelStats {
    unsigned* xbuf;
    unsigned* cnt;
    unsigned* tmo;
    int ntn; float eps;
    unsigned code;
    __device__ __forceinline__ bool run(const f32x4 (&v)[2][2][4][2], const Unit& u, int wr, int wc, int fr, int fq, PG8_LAS unsigned char* lds, int wid, int lane) const {
        typedef float f32x2v __attribute__((ext_vector_type(2)));
        PG8_LAS f32x2v* P = (PG8_LAS f32x2v*)lds;
        PG8_LAS f32x2v* S = (PG8_LAS f32x2v*)(lds + 8192);
        PG8_LAS unsigned* flag = (PG8_LAS unsigned*)(lds + 8192 + 2048);
#pragma unroll
        for (int ai = 0; ai < 2; ++ai)
#pragma unroll
            for (int m = 0; m < 4; ++m) {
                float s = 0.f;
#pragma unroll
                for (int bj = 0; bj < 2; ++bj)
#pragma unroll
                    for (int n = 0; n < 2; ++n) { const f32x4 x = v[ai][bj][m][n]; s += (x[0] + x[1]) + (x[2] + x[3]); }
                s += __shfl_xor(s, 16); s += __shfl_xor(s, 32);
                const float mw = s * (1.0f / 64.0f); float q = 0.f;
#pragma unroll
                for (int bj = 0; bj < 2; ++bj)
#pragma unroll
                    for (int n = 0; n < 2; ++n) { const f32x4 d = v[ai][bj][m][n] - mw; q += (d[0] * d[0] + d[1] * d[1]) + (d[2] * d[2] + d[3] * d[3]); }
                q += __shfl_xor(q, 16); q += __shfl_xor(q, 32);
                if (fq == 0) P[(ai * HALF + wr * 64 + m * 16 + fr) * 4 + wc] = (f32x2v){mw, q};
            }
        asm volatile("s_waitcnt lgkmcnt(0)" ::: "memory"); __builtin_amdgcn_s_barrier(); asm volatile("" ::: "memory");
#if defined(BROKEN_EXCHANGE_NO_WAIT)
#warning BROKEN CONTROL BUILD: the row-statistics exchange does not wait; results are wrong by design
        if (blockIdx.x >= 64) { const long long t0_ = clock64(); while (clock64() - t0_ < 60000) __builtin_amdgcn_s_sleep(8); }
#endif
        const int row = wid * 32 + (lane & 31);
        if (lane < 32) {
            const f32x2v a = P[row * 4 + 0], b = P[row * 4 + 1], c = P[row * 4 + 2], d = P[row * 4 + 3];
            const float mt = (a.x + b.x + c.x + d.x) * 0.25f;
            const float da = a.x - mt, db = b.x - mt, dc = c.x - mt, dd = d.x - mt;
            const float m2 = (a.y + b.y) + (c.y + d.y) + 64.0f * ((da * da + db * db) + (dc * dc + dd * dd));
            unsigned long long* slot = (unsigned long long*)xbuf + ((size_t)(u.pm * BM + row) * 4 + u.pn);
            __hip_atomic_store(slot, ((unsigned long long)__float_as_uint(m2) << 32) | __float_as_uint(mt), __ATOMIC_RELAXED, __HIP_MEMORY_SCOPE_AGENT);
        }
        asm volatile("s_waitcnt vmcnt(0)" ::: "memory");
        if (lane == 0) __hip_atomic_fetch_add(cnt + 64 * u.pm, 1u, __ATOMIC_RELAXED, __HIP_MEMORY_SCOPE_AGENT);
        if (wid == 0) {
            bool dead = false; const unsigned long long t0 = __builtin_amdgcn_s_memrealtime(); const unsigned want = 8u * (unsigned)ntn;
            for (;;) {
#if defined(BROKEN_EXCHANGE_NO_WAIT)
                break;
#endif
                if ((unsigned)__builtin_amdgcn_readfirstlane(__hip_atomic_load(cnt + 64 * u.pm, __ATOMIC_RELAXED, __HIP_MEMORY_SCOPE_AGENT)) >= want) break;
                if (__builtin_amdgcn_s_memrealtime() - t0 > 2000000ull) {
                    if (lane == 0) { unsigned expect = 0u; __hip_atomic_compare_exchange_strong(tmo + 1, &expect, code | (unsigned)(u.pm & 0xff), __ATOMIC_RELAXED, __ATOMIC_RELAXED, __HIP_MEMORY_SCOPE_AGENT);
                                     __hip_atomic_store(tmo, 1u, __ATOMIC_RELAXED, __HIP_MEMORY_SCOPE_AGENT); }
                    dead = true; break; }
                __builtin_amdgcn_s_sleep(2);
            }
            __builtin_amdgcn_fence(__ATOMIC_ACQUIRE, "agent");
            if (lane == 0) flag[0] = dead ? 1u : 0u;
        }
        asm volatile("s_waitcnt vmcnt(0) lgkmcnt(0)" ::: "memory"); __builtin_amdgcn_s_barrier(); asm volatile("" ::: "memory");
        const bool bad = flag[0] != 0u;
        if (lane < 32) {
            const unsigned long long* slot = (const unsigned long long*)xbuf + (size_t)(u.pm * BM + row) * 4; float mt[4], m2[4]; float ms = 0.f;
#pragma unroll
            for (int t = 0; t < 4; ++t) { if (t < ntn) { const unsigned long long w = __hip_atomic_load(slot + t, __ATOMIC_RELAXED, __HIP_MEMORY_SCOPE_AGENT); mt[t] = __uint_as_float((unsigned)w); m2[t] = __uint_as_float((unsigned)(w >> 32)); } else { mt[t] = 0.f; m2[t] = 0.f; } ms += mt[t]; }
            const float mean = ms / (float)ntn; float q = 0.f;
#pragma unroll
            for (int t = 0; t < 4; ++t) if (t < ntn) { const float dm = mt[t] - mean; q += m2[t] + 256.0f * dm * dm; }
            S[row] = (f32x2v){mean, 1.0f / sqrtf(q / (256.0f * (float)ntn) + eps)};
        }
        asm volatile("s_waitcnt lgkmcnt(0)" ::: "memory"); __builtin_amdgcn_s_barrier(); asm volatile("" ::: "memory");
        return bad;
    }
};

struct EpiLn {
    static constexpr bool PERM = false, AFTER_DRAIN = true;
    const float* base; float* out; bf16_t* outb; int ldc; const float* gam; const float* bet; PanelStats st; float alpha;
    __device__ __forceinline__ void fused(f32x4 (&acc)[2][2][4][2], const Unit& u, int wr, int wc, int fr, int fq, PG8_LAS unsigned char* lds, int wid, int lane) const {
        typedef float f32x2v __attribute__((ext_vector_type(2))); typedef unsigned u32x2v __attribute__((ext_vector_type(2)));
        const PG8_LAS f32x2v* S = (const PG8_LAS f32x2v*)(lds + 8192);
        const int col0 = u.pn * BM + wc * 32 + 4 * fq;
#pragma unroll
        for (int ai = 0; ai < 2; ++ai) {
            f32x4 bs[4][2][2];
#pragma unroll
            for (int m = 0; m < 4; ++m) { const size_t off = (size_t)(u.pm * BM + ai * HALF + wr * 64 + m * 16 + fr) * ldc + col0;
#pragma unroll
                for (int bj = 0; bj < 2; ++bj)
#pragma unroll
                    for (int n = 0; n < 2; ++n) bs[m][bj][n] = *(const f32x4*)(base + off + bj * HALF + n * 16); }
#pragma unroll
            for (int m = 0; m < 4; ++m) {
#pragma unroll
                for (int bj = 0; bj < 2; ++bj)
#pragma unroll
                    for (int n = 0; n < 2; ++n) acc[ai][bj][m][n] += bs[m][bj][n] * alpha;
                asm volatile("" : "+v"(acc[ai][0][m][0]), "+v"(acc[ai][0][m][1]), "+v"(acc[ai][1][m][0]), "+v"(acc[ai][1][m][1])); }
            asm volatile("" ::: "memory"); }
        const bool bad = st.run(acc, u, wr, wc, fr, fq, lds, wid, lane);
        const float qnan = __builtin_nanf("");
        f32x4 gv[2][2], bv[2][2];
#pragma unroll
        for (int bj = 0; bj < 2; ++bj)
#pragma unroll
            for (int n = 0; n < 2; ++n) { gv[bj][n] = *(const f32x4*)(gam + col0 + bj * HALF + n * 16); bv[bj][n] = *(const f32x4*)(bet + col0 + bj * HALF + n * 16); }
#pragma unroll
        for (int ai = 0; ai < 2; ++ai)
#pragma unroll
            for (int m = 0; m < 4; ++m) { const int r = ai * HALF + wr * 64 + m * 16 + fr; const f32x2v sr = S[r]; const size_t off = (size_t)(u.pm * BM + r) * ldc + col0;
#pragma unroll
                for (int bj = 0; bj < 2; ++bj)
#pragma unroll
                    for (int n = 0; n < 2; ++n) { f32x4 o = (acc[ai][bj][m][n] - sr.x) * sr.y * gv[bj][n] + bv[bj][n];
                        if (bad) o = (f32x4){qnan, qnan, qnan, qnan};
                        *(f32x4*)(out + off + bj * HALF + n * 16) = o;
                        if (outb) { u32x2v w; w.x = cvtpk(o[0], o[1]); w.y = cvtpk(o[2], o[3]); *(u32x2v*)(outb + off + bj * HALF + n * 16) = w; } }
                asm volatile("" ::: "memory"); }
    }
};

template <class Epi, class Sched, bool ALIGN_EPI = false, bool SP2 = false>
__device__ __forceinline__ void gemm_phase(PG8_LAS unsigned char* lds, const Gemm g, const Sched& S, const Epi& E) {
    const int tid = otid(), wid = __builtin_amdgcn_readfirstlane(tid >> 6), lane = tid & 63, wr = wid >> 2, wc = wid & 3, fr = lane & 15, fq = lane >> 4;
    const int K = g.K, nt = K / BK;
    unsigned voffA[2], voffB[2];
#pragma unroll
    for (int i = 0; i < 2; ++i) { int R, C; stage_rc(tid * 16 + i * 8192, R, C); const int Rb = Epi::PERM ? ((R & ~31) + perm32(R & 31)) : R;
        voffA[i] = (unsigned)(R * K + C) * 2u; voffB[i] = (unsigned)(Rb * K + C) * 2u; }
    const size_t kstep = (size_t)(BK * 2);
    const size_t hstep = (size_t)HALF * K * 2;
    const size_t tstep = 2 * hstep;
    const unsigned ldsw = (unsigned)wid * 1024u;
    const int aoff = lds_byte(wr * 64 + fr, fq * 8), boff = lds_byte(wc * 32 + fr, fq * 8);
#define PG8_SA(b, h) (((b) * 2 + (h)) * HTB)
#define PG8_SB(b, h) ((4 + (b) * 2 + (h)) * HTB)
#define PG8_STAGE(bufoff, gbase, voff) do { _Pragma("unroll") for (int _i = 0; _i < 2; ++_i) \
        __builtin_amdgcn_global_load_lds((const unsigned*)((const char*)(gbase) + (voff)[_i]), (PG8_LAS unsigned*)(lds + (bufoff) + ldsw + _i * 8192), 16, 0, 0); } while (0)
#define PG8_LDA(dst, b, h) do { _Pragma("unroll") for (int m = 0; m < 4; ++m) _Pragma("unroll") for (int k = 0; k < 2; ++k) dst[m][k] = *(const PG8_LAS bf16x8*)(lds + PG8_SA(b, h) + aoff + m * 2048 + k * 1024); } while (0)
#define PG8_LDB(dst, b, h) do { _Pragma("unroll") for (int n = 0; n < 2; ++n) _Pragma("unroll") for (int k = 0; k < 2; ++k) dst[n][k] = *(const PG8_LAS bf16x8*)(lds + PG8_SB(b, h) + boff + n * 2048 + k * 1024); } while (0)
#define PG8_MMA(ai, bj, At, Bt) do { __builtin_amdgcn_s_setprio(1); _Pragma("unroll") for (int m = 0; m < 4; ++m) _Pragma("unroll") for (int n = 0; n < 2; ++n) _Pragma("unroll") for (int k = 0; k < 2; ++k) \
        acc[ai][bj][m][n] = __builtin_amdgcn_mfma_f32_16x16x32_bf16(Bt[n][k], At[m][k], acc[ai][bj][m][n], 0, 0, 0); __builtin_amdgcn_s_setprio(0); } while (0)
#define PG8_WAIT_V(n) asm volatile("s_waitcnt vmcnt(" #n ")" ::: "memory")
#define PG8_WAIT_L(n) asm volatile("s_waitcnt lgkmcnt(" #n ")" ::: "memory")
#define PG8_BAR __builtin_amdgcn_s_barrier()
#define PG8_SCHED __builtin_amdgcn_sched_barrier(0)
    Unit cur, nxt; int ui = 0;
    if (!S.next(0, cur)) return;
    f32x4 acc[2][2][4][2];
#pragma unroll
    for (int a = 0; a < 2; ++a)
#pragma unroll
        for (int b = 0; b < 2; ++b)
#pragma unroll
            for (int m = 0; m < 4; ++m)
#pragma unroll
                for (int n = 0; n < 2; ++n) acc[a][b][m][n] = (f32x4){0.f, 0.f, 0.f, 0.f};
    bf16x8 At[4][2], B0[2][2], B1[2][2];
    const char* cA = (const char*)g.A + (size_t)cur.pm * tstep; const char* cB = (const char*)g.Bt + (size_t)cur.pn * tstep;
    S.a_ready(cur);
    if constexpr (SP2) {
        PG8_STAGE(PG8_SB(0, 0), cB, voffB); PG8_STAGE(PG8_SB(0, 1), cB + hstep, voffB); PG8_STAGE(PG8_SA(0, 0), cA, voffA); PG8_STAGE(PG8_SA(0, 1), cA + hstep, voffA);
        if (wr == 1) PG8_BAR;
        PG8_WAIT_V(2); PG8_BAR;
        PG8_STAGE(PG8_SB(1, 0), cB + kstep, voffB); PG8_STAGE(PG8_SA(1, 0), cA + kstep, voffA); PG8_STAGE(PG8_SB(1, 1), cB + hstep + kstep, voffB);
        PG8_WAIT_V(6); PG8_BAR;
    } else {
        PG8_STAGE(PG8_SB(0, 0), cB, voffB); PG8_STAGE(PG8_SA(0, 0), cA, voffA); PG8_STAGE(PG8_SB(0, 1), cB + hstep, voffB); PG8_STAGE(PG8_SA(0, 1), cA + hstep, voffA);
        if (wr == 1) PG8_BAR;
        PG8_WAIT_V(4); PG8_BAR;
        PG8_STAGE(PG8_SB(1, 0), cB + kstep, voffB); PG8_STAGE(PG8_SA(1, 0), cA + kstep, voffA); PG8_STAGE(PG8_SB(1, 1), cB + hstep + kstep, voffB);
        PG8_WAIT_V(6); PG8_BAR;
    }
    for (;;) {
        const bool has_next = S.next(ui + 1, nxt);
        const char* nA = has_next ? (const char*)g.A + (size_t)nxt.pm * tstep : cA; const char* nB = has_next ? (const char*)g.Bt + (size_t)nxt.pn * tstep : cB;
        for (int t = 0; t < nt; t += 2) {
            const bool last = (t == nt - 2);
            const char* a1 = cA + (size_t)(t + 1) * kstep;
            const char* a2 = last ? nA : cA + (size_t)(t + 2) * kstep; const char* b2 = last ? nB : cB + (size_t)(t + 2) * kstep;
            const char* a3 = a2 + kstep; const char* b3 = b2 + kstep;
            if (last && has_next) S.a_ready(nxt);
            if constexpr (SP2) {
            PG8_LDB(B0, 0, 0); PG8_LDB(B1, 0, 1); PG8_SCHED; PG8_LDA(At, 0, 0); PG8_STAGE(PG8_SA(1, 1), a1 + hstep, voffA);
            PG8_WAIT_V(8); PG8_WAIT_L(0); PG8_BAR; PG8_MMA(0, 0, At, B0); PG8_MMA(0, 1, At, B1); PG8_BAR; PG8_SCHED;
            PG8_LDA(At, 0, 1); PG8_STAGE(PG8_SB(0, 0), b2, voffB); PG8_STAGE(PG8_SB(0, 1), b2 + hstep, voffB); PG8_STAGE(PG8_SA(0, 0), a2, voffA);
            PG8_WAIT_V(8); PG8_WAIT_L(0); PG8_BAR; PG8_MMA(1, 0, At, B0); PG8_MMA(1, 1, At, B1); PG8_BAR; PG8_SCHED;
            PG8_LDB(B0, 1, 0); PG8_LDB(B1, 1, 1); PG8_SCHED; PG8_LDA(At, 1, 0); PG8_STAGE(PG8_SA(0, 1), a2 + hstep, voffA);
            PG8_WAIT_V(8); PG8_WAIT_L(0); PG8_BAR; PG8_MMA(0, 0, At, B0); PG8_MMA(0, 1, At, B1); PG8_BAR; PG8_SCHED;
            PG8_LDA(At, 1, 1); PG8_STAGE(PG8_SB(1, 0), b3, voffB); PG8_STAGE(PG8_SB(1, 1), b3 + hstep, voffB); PG8_STAGE(PG8_SA(1, 0), a3, voffA);
            PG8_WAIT_V(8); PG8_WAIT_L(0); PG8_BAR; PG8_MMA(1, 0, At, B0); PG8_MMA(1, 1, At, B1); PG8_BAR; PG8_SCHED;
            } else {
            PG8_LDB(B0, 0, 0); PG8_SCHED; PG8_LDA(At, 0, 0); PG8_STAGE(PG8_SA(1, 1), a1 + hstep, voffA);
            PG8_WAIT_L(8); PG8_BAR; PG8_WAIT_L(0); PG8_MMA(0, 0, At, B0); PG8_BAR; PG8_SCHED;
            PG8_LDB(B1, 0, 1); PG8_STAGE(PG8_SB(0, 0), b2, voffB);
            PG8_BAR; PG8_WAIT_L(0); PG8_MMA(0, 1, At, B1); PG8_BAR;
            PG8_LDA(At, 0, 1); PG8_STAGE(PG8_SA(0, 0), a2, voffA);
            PG8_BAR; PG8_WAIT_L(0); PG8_MMA(1, 0, At, B0); PG8_BAR; PG8_SCHED;
            PG8_STAGE(PG8_SB(0, 1), b2 + hstep, voffB);
            PG8_WAIT_V(6); PG8_BAR; PG8_MMA(1, 1, At, B1); PG8_BAR;
            PG8_LDB(B0, 1, 0); PG8_SCHED; PG8_LDA(At, 1, 0); PG8_STAGE(PG8_SA(0, 1), a2 + hstep, voffA);
            PG8_WAIT_L(8); PG8_BAR; PG8_WAIT_L(0); PG8_MMA(0, 0, At, B0); PG8_BAR; PG8_SCHED;
            PG8_LDB(B1, 1, 1); PG8_STAGE(PG8_SB(1, 0), b3, voffB);
            PG8_BAR; PG8_WAIT_L(0); PG8_MMA(0, 1, At, B1); PG8_BAR;
            PG8_LDA(At, 1, 1); PG8_STAGE(PG8_SA(1, 0), a3, voffA);
            PG8_BAR; PG8_WAIT_L(0); PG8_MMA(1, 0, At, B0); PG8_BAR; PG8_SCHED;
            PG8_STAGE(PG8_SB(1, 1), b3 + hstep, voffB);
            PG8_WAIT_V(6); PG8_BAR; PG8_MMA(1, 1, At, B1); PG8_BAR;
            }
        }
        if constexpr (ALIGN_EPI) { if (wr == 0) PG8_BAR; }
        if constexpr (!Epi::AFTER_DRAIN) { E(acc, cur, wr, wc, fr, fq); S.done(cur); }
        if (!has_next) break;
#pragma unroll
        for (int a = 0; a < 2; ++a)
#pragma unroll
            for (int b = 0; b < 2; ++b)
#pragma unroll
                for (int m = 0; m < 4; ++m)
#pragma unroll
                    for (int n = 0; n < 2; ++n) acc[a][b][m][n] = (f32x4){0.f, 0.f, 0.f, 0.f};
        cur = nxt; cA = nA; cB = nB; ++ui;
        if constexpr (ALIGN_EPI) { if (wr == 1) PG8_BAR; }
    }
    PG8_WAIT_V(0);
    if constexpr (!ALIGN_EPI) { if (wr == 0) PG8_BAR; }
    PG8_BAR;
    if constexpr (Epi::AFTER_DRAIN) { E.fused(acc, cur, wr, wc, fr, fq, lds, wid, lane); S.done(cur); }
#undef PG8_SA
#undef PG8_SB
#undef PG8_STAGE
#undef PG8_LDA
#undef PG8_LDB
#undef PG8_MMA
#undef PG8_WAIT_V
#undef PG8_WAIT_L
#undef PG8_BAR
#undef PG8_SCHED
}
}

__device__ __forceinline__ void ln_phase(const float* xin, const float* Y, const float* g, const float* bb, float* out, bf16_t* outb) {
  const int lane = otid() & 63, wid = otid() >> 6;
  for (int row = blockIdx.x * 8 + wid; row < M_; row += gridDim.x * 8) {
    const float4* xr = (const float4*)(xin + (size_t)row * D_);
    const float4* yr = (const float4*)(Y + (size_t)row * D_);
    float4 v[4]; float s = 0.f;
#pragma unroll
    for (int j = 0; j < 4; ++j) {
      const float4 a = xr[j * 64 + lane], y = yr[j * 64 + lane];
      v[j].x = ALPHA * a.x + y.x; v[j].y = ALPHA * a.y + y.y; v[j].z = ALPHA * a.z + y.z; v[j].w = ALPHA * a.w + y.w;
      s += (v[j].x + v[j].y) + (v[j].z + v[j].w);
    }
    const float mean = wave_sum(s) * (1.f / D_);
    float q = 0.f;
#pragma unroll
    for (int j = 0; j < 4; ++j) {
      v[j].x -= mean; v[j].y -= mean; v[j].z -= mean; v[j].w -= mean;
      q += (v[j].x * v[j].x + v[j].y * v[j].y) + (v[j].z * v[j].z + v[j].w * v[j].w);
    }
    const float rstd = 1.f / sqrtf(wave_sum(q) * (1.f / D_) + LN_EPS);
#pragma unroll
    for (int j = 0; j < 4; ++j) {
      const float4 gg = ((const float4*)g)[j * 64 + lane], bv = ((const float4*)bb)[j * 64 + lane];
      float4 o;
      o.x = v[j].x * rstd * gg.x + bv.x; o.y = v[j].y * rstd * gg.y + bv.y; o.z = v[j].z * rstd * gg.z + bv.z; o.w = v[j].w * rstd * gg.w + bv.w;
      ((float4*)(out + (size_t)row * D_))[j * 64 + lane] = o;
      if (outb) {
        ushort4 ob; ob.x = f2bf(o.x); ob.y = f2bf(o.y); ob.z = f2bf(o.z); ob.w = f2bf(o.w);
        ((ushort4*)(outb + (size_t)row * D_))[j * 64 + lane] = ob;
      }
    }
  }
}

__device__ __forceinline__ void compress_item(const Params& P, int item, float* sm) {
  const bf16_t* H0 = (const bf16_t*)(P.ws + WS_H);
  const int tid = otid();
  const int g = item & 1; int r = item >> 1; const int n = r % NCMP; r /= NCMP; const int b = r & 3; const int i = r >> 2;
  const float* pos = P.in[2] + i * 2048;
  const float* w1 = P.in[3] + (size_t)i * 2048 * 128;
  const float* b1 = P.in[4] + i * 128;
  const float* w2 = P.in[5] + (size_t)i * 128 * 64;
  float* blk = sm;
  float* part = sm + 2048;
  float* hid = sm + 2048 + 512;
  const int col = (i == 0 ? C_KCMP : C_VCMP) + g * 64;
#pragma unroll
  for (int k = 0; k < 4; ++k) {
    const int f = tid + k * 512, l = f >> 6, d = f & 63;
    blk[f] = bf2f(H0[((size_t)b * S_ + 16 * n + l) * P0 + col + d]) + pos[f];
  }
  wg_sync();
  const int hh = tid & 127, pt = tid >> 7;
  float acc = 0.f;
  for (int f = pt * 512; f < pt * 512 + 512; ++f) acc += blk[f] * w1[(size_t)f * 128 + hh];
  part[pt * 128 + hh] = acc;
  wg_sync();
  if (tid < 128) {
    const float a = part[tid] + part[128 + tid] + part[256 + tid] + part[384 + tid] + b1[tid];
    hid[tid] = silu_f(a);
  }
  wg_sync();
  if (tid < 64) {
    float o = 0.f;
    for (int k = 0; k < 128; ++k) o += hid[k] * w2[k * 64 + tid];
    float* dst = (float*)(P.ws + (i == 0 ? WS_KC : WS_VC));
    dst[(((size_t)b * NCMP + n) * 2 + g) * 64 + tid] = o;
    bf16_t* dstb = (bf16_t*)(P.ws + (i == 0 ? (size_t)(248 * MiB) : (size_t)(249 * MiB)));
    dstb[(((size_t)b * 2 + g) * 256 + n) * 64 + tid] = f2bf(o);
    if (n == 0) dstb[(((size_t)b * 2 + g) * 256 + 255) * 64 + tid] = 0;
  }
  wg_sync();
}
__device__ __forceinline__ void kmean_item(const Params& P, int item, int lane) {
  const bf16_t* H0 = (const bf16_t*)(P.ws + WS_H);
  const int h = item & 7, n = (item >> 3) & 15, b = item >> 7;
  float s = 0.f;
  for (int k = 0; k < 256; ++k) s += bf2f(H0[((size_t)b * S_ + n * 256 + k) * P0 + C_MK + h * 64 + lane]);
  ((float*)(P.ws + WS_KM))[(((size_t)b * 16 + n) * 8 + h) * 64 + lane] = s * (1.f / 256.f);
}


constexpr size_t WS_W1T = 250 * MiB;
constexpr size_t WS_W2T = 251 * MiB;
constexpr size_t WS_C1P = 252 * MiB;
__device__ __forceinline__ void compress_mfma_tile(const Params& P, int tile, unsigned char* smem_g) {
  const bf16_t* __restrict__ H0 = (const bf16_t*)(P.ws + WS_H);
  const int tid = otid(), lane = tid & 63, wid = __builtin_amdgcn_readfirstlane(tid >> 6), g = lane >> 4, ii = lane & 15;
  const int i = tile >> 7, R0 = (tile & 127) * 16;
  bf16_t* hs = (bf16_t*)smem_g;
  {
    const int R = min(R0 + ii, 2039), b = R / 510, rem = R - b * 510, n = rem >> 1, grp = rem & 1;
    const bf16_t* abase = H0 + ((size_t)b * S_ + 16 * n) * P0 + (i == 0 ? C_KCMP : C_VCMP) + grp * 64 + 8 * g;
    const bf16_t* bbase = (const bf16_t*)(P.ws + WS_W1T) + (size_t)(i * 128 + 16 * wid + ii) * 2048 + 8 * g;
    f32x4 acc = (f32x4){0.f, 0.f, 0.f, 0.f};
#pragma unroll 16
    for (int ks = 0; ks < 64; ++ks) {
      const bf16x8 a = *(const bf16x8*)(abase + (size_t)(ks >> 1) * P0 + (ks & 1) * 32);
      const bf16x8 bq = *(const bf16x8*)(bbase + ks * 32);
      acc = __builtin_amdgcn_mfma_f32_16x16x32_bf16(a, bq, acc, 0, 0, 0);
    }
    const int col = 16 * wid + ii;
    float bias = P.in[4][i * 128 + col];
    const float* c1p = (const float*)(P.ws + WS_C1P) + i * 32 * 128 + col;
#pragma unroll 8
    for (int q = 0; q < 32; ++q) bias += c1p[q * 128];
#pragma unroll
    for (int r = 0; r < 4; ++r) hs[(4 * g + r) * 136 + col] = f2bf(silu_f(acc[r] + bias));
  }
  wg_sync();
  if (wid < 4) {
    const bf16_t* b2 = (const bf16_t*)(P.ws + WS_W2T) + (size_t)(i * 64 + 16 * wid + ii) * 128 + 8 * g;
    f32x4 acc = (f32x4){0.f, 0.f, 0.f, 0.f};
#pragma unroll
    for (int k2 = 0; k2 < 4; ++k2) {
      const bf16x8 a = *(const bf16x8*)(hs + ii * 136 + 32 * k2 + 8 * g);
      const bf16x8 bq = *(const bf16x8*)(b2 + 32 * k2);
      acc = __builtin_amdgcn_mfma_f32_16x16x32_bf16(a, bq, acc, 0, 0, 0);
    }
    bf16_t* dst = (bf16_t*)(P.ws + (i == 0 ? (size_t)(248 * MiB) : (size_t)(249 * MiB)));
#pragma unroll
    for (int r = 0; r < 4; ++r) {
      const int R = R0 + 4 * g + r;
      if (R < 2040) { const int b = R / 510, rem = R - b * 510, n = rem >> 1, grp = rem & 1;
        dst[(((size_t)b * 2 + grp) * 256 + n) * 64 + 16 * wid + ii] = f2bf(acc[r]); }
    }
  }
  wg_sync();
}
__device__ __forceinline__ void kmean_item2(const Params& P, int item) {
  const bf16_t* __restrict__ H0 = (const bf16_t*)(P.ws + WS_H);
  const int tid = otid();
  const bf16_t* src = H0 + ((size_t)(item >> 4) * S_ + (item & 15) * 256) * P0 + C_MK + tid;
  float s0 = 0.f, s1 = 0.f, s2 = 0.f, s3 = 0.f;
#pragma unroll 4
  for (int r = 0; r < 256; r += 4) {
    s0 += bf2f(src[(size_t)r * P0]); s1 += bf2f(src[(size_t)(r + 1) * P0]); s2 += bf2f(src[(size_t)(r + 2) * P0]); s3 += bf2f(src[(size_t)(r + 3) * P0]);
  }
  ((float*)(P.ws + WS_KM))[(size_t)item * 512 + tid] = ((s0 + s1) + (s2 + s3)) * (1.f / 256.f);
}

template <int NH>
__device__ __forceinline__ void attend_block(const bf16_t* __restrict__ Kp, const bf16_t* __restrict__ Vp, size_t rowbase, int kp0, int t, int kmin,
                                             const float* qs, float* pb, const float* slope, float* m, float* l, float* o, int lane) {
  asm volatile("" ::: "memory");
  const int kp = kp0 + lane;
  const bool valid = (kp <= t) && (kp >= kmin);
  const uint4* kr = (const uint4*)(Kp + (rowbase + kp) * P0);
  float dot[NH];
#pragma unroll
  for (int j = 0; j < NH; ++j) dot[j] = 0.f;
#pragma unroll 1
  for (int c = 0; c < 8; ++c) {
    asm volatile("" ::: "memory");
    const uint4 u = kr[c];
    float kv[8];
    kv[0] = __uint_as_float(u.x << 16); kv[1] = __uint_as_float(u.x & 0xffff0000u);
    kv[2] = __uint_as_float(u.y << 16); kv[3] = __uint_as_float(u.y & 0xffff0000u);
    kv[4] = __uint_as_float(u.z << 16); kv[5] = __uint_as_float(u.z & 0xffff0000u);
    kv[6] = __uint_as_float(u.w << 16); kv[7] = __uint_as_float(u.w & 0xffff0000u);
#pragma unroll
    for (int j = 0; j < NH; ++j) {
      const float4 q0 = *(const float4*)(qs + j * 64 + c * 8), q1 = *(const float4*)(qs + j * 64 + c * 8 + 4);
      dot[j] += kv[0] * q0.x + kv[1] * q0.y + kv[2] * q0.z + kv[3] * q0.w + kv[4] * q1.x + kv[5] * q1.y + kv[6] * q1.z + kv[7] * q1.w;
    }
  }
#pragma unroll
  for (int j = 0; j < NH; ++j) {
    const float s = valid ? 0.125f * dot[j] - slope[j] * (float)(t - kp) : -1e30f;
    const float mn = fmaxf(m[j], wave_max(s));
    const float al = __expf(m[j] - mn);
    const float p = valid ? __expf(s - mn) : 0.f;
    l[j] = l[j] * al + wave_sum(p);
    o[j] *= al; m[j] = mn;
    pb[j * 64 + lane] = p;
  }
  __builtin_amdgcn_wave_barrier();
  const bf16_t* vr = Vp + (rowbase + kp0) * P0 + lane;
#pragma unroll 8
  for (int k = 0; k < 64; ++k) {
    const float v = bf2f(vr[(size_t)k * P0]);
#pragma unroll
    for (int j = 0; j < NH; ++j) o[j] += pb[j * 64 + k] * v;
  }
  __builtin_amdgcn_wave_barrier();
}

__device__ __forceinline__ void nsa_item(const Params& P, int b, int g, int t, float* wsm, int lane) {
  const bf16_t* H0 = (const bf16_t*)(P.ws + WS_H);
  const float* KC = (const float*)(P.ws + WS_KC);
  const float* VC = (const float*)(P.ws + WS_VC);
  bf16_t* MIX = (bf16_t*)(P.ws + WS_MIX);
  float* qs = wsm;
  float* pc = wsm + 256;
  float* pb = wsm + 1280;
  const size_t row = (size_t)b * S_ + t;
  const bf16_t* hrow = H0 + row * P0;
  float slope[4];
#pragma unroll
  for (int j = 0; j < 4; ++j) { qs[j * 64 + lane] = bf2f(hrow[C_NQ + (g * 4 + j) * 64 + lane]); slope[j] = exp2f(-(float)(g * 4 + j + 1)); }
  __builtin_amdgcn_wave_barrier();
  const int nv = t >= 31 ? (t - 31) / 16 + 1 : 0;
#pragma unroll 1
  for (int c = 0; c < 4; ++c) {
    asm volatile("" ::: "memory");
    const int n = c * 64 + lane;
    float dot[4] = {0.f, 0.f, 0.f, 0.f};
    if (n < nv) {
      const float4* kr = (const float4*)(KC + (((size_t)b * NCMP + n) * 2 + g) * 64);
#pragma unroll 4
      for (int d4 = 0; d4 < 16; ++d4) {
        const float4 kv = kr[d4];
#pragma unroll
        for (int j = 0; j < 4; ++j) {
          const float4 q = *(const float4*)(qs + j * 64 + d4 * 4);
          dot[j] += kv.x * q.x + kv.y * q.y + kv.z * q.z + kv.w * q.w;
        }
      }
    }
#pragma unroll
    for (int j = 0; j < 4; ++j) pc[j * 256 + n] = (n < nv) ? 0.125f * dot[j] - slope[j] * (float)(t - (16 * n + 31)) : -1e30f;
  }
  __builtin_amdgcn_wave_barrier();
#pragma unroll
  for (int j = 0; j < 4; ++j) {
    float sc[4];
#pragma unroll
    for (int c = 0; c < 4; ++c) sc[c] = pc[j * 256 + c * 64 + lane];
    float mx = fmaxf(fmaxf(sc[0], sc[1]), fmaxf(sc[2], sc[3]));
    mx = wave_max(mx);
    float sum = 0.f;
#pragma unroll
    for (int c = 0; c < 4; ++c) { const int n = c * 64 + lane; const float p = (n < nv) ? __expf(sc[c] - mx) : 0.f; sc[c] = p; sum += p; }
    sum = wave_sum(sum);
    const float inv = nv > 0 ? 1.f / sum : 0.f;
#pragma unroll
    for (int c = 0; c < 4; ++c) pc[j * 256 + c * 64 + lane] = sc[c] * inv;
  }
  __builtin_amdgcn_wave_barrier();
  float ocmp[4] = {0.f, 0.f, 0.f, 0.f};
  for (int n = 0; n < nv; ++n) {
    const float v = VC[(((size_t)b * NCMP + n) * 2 + g) * 64 + lane];
#pragma unroll
    for (int j = 0; j < 4; ++j) ocmp[j] += pc[j * 256 + n] * v;
  }
  float imp = 0.f;
  {
    const int lo = max(0, 4 * lane - 1), hi = min(NCMP - 1, 4 * lane + 3);
    for (int n = lo; n <= hi; ++n) imp += (pc[n] + pc[256 + n]) + (pc[512 + n] + pc[768 + n]);
  }
  const int cur = t >> 6;
  const bool bvalid = lane <= cur;
  const bool forced = (lane == 0) || (lane == cur) || (lane == cur - 1);
  const float key = bvalid ? (forced ? 1e9f : imp) : -1e30f;
  int rank = 0;
  for (int s2 = 0; s2 < 64; ++s2) {
    const float ks = __shfl(key, s2);
    rank += (ks > key || (ks == key && s2 < lane)) ? 1 : 0;
  }
  const unsigned long long selmask = __ballot(bvalid && rank < 16);
  float m[4], l[4], osel[4], owin[4];
#pragma unroll
  for (int j = 0; j < 4; ++j) { m[j] = -1e30f; l[j] = 0.f; osel[j] = 0.f; }
  {
    unsigned long long mk = selmask;
    while (mk) {
      const int blk = __builtin_ctzll(mk); mk &= mk - 1;
      attend_block<4>(H0 + C_KSEL + g * 64, H0 + C_VSEL + g * 64, (size_t)b * S_, blk * 64, t, 0, qs, pb, slope, m, l, osel, lane);
    }
  }
#pragma unroll
  for (int j = 0; j < 4; ++j) { osel[j] /= l[j]; m[j] = -1e30f; l[j] = 0.f; owin[j] = 0.f; }
  {
    const int kmin = t - 511;
    const int b0 = (kmin > 0 ? kmin : 0) >> 6;
    for (int blk = b0; blk <= cur; ++blk)
      attend_block<4>(H0 + C_KWIN + g * 64, H0 + C_VWIN + g * 64, (size_t)b * S_, blk * 64, t, kmin, qs, pb, slope, m, l, owin, lane);
  }
#pragma unroll
  for (int j = 0; j < 4; ++j) {
    const int h = g * 4 + j;
    const float g0 = sigmoid_f(bf2f(hrow[C_NG + h * 3 + 0])), g1 = sigmoid_f(bf2f(hrow[C_NG + h * 3 + 1])), g2 = sigmoid_f(bf2f(hrow[C_NG + h * 3 + 2]));
    const float o = g0 * ocmp[j] + g1 * osel[j] + g2 * (owin[j] / l[j]);
    const float z = bf2f(hrow[C_NZ + h * 64 + lane]);
    MIX[row * D_ + h * 64 + lane] = f2bf(o * silu_f(z));
  }
}

__device__ __forceinline__ void moba_item(const Params& P, int b, int h, int t, float* wsm, int lane) {
  const bf16_t* H0 = (const bf16_t*)(P.ws + WS_H);
  const float* KM = (const float*)(P.ws + WS_KM);
  bf16_t* MIX = (bf16_t*)(P.ws + WS_MIX);
  float* qs = wsm;
  float* pb = wsm + 1280;
  const size_t row = (size_t)b * S_ + t;
  const bf16_t* hrow = H0 + row * P0;
  qs[lane] = bf2f(hrow[C_MQ + h * 64 + lane]);
  __builtin_amdgcn_wave_barrier();
  float slope[1] = {exp2f(-(float)(h + 1))};
  const int cur = t >> 8;
  float gate = -1e30f;
  if (lane < cur) {
    const float4* kr = (const float4*)(KM + (((size_t)b * 16 + lane) * 8 + h) * 64);
    float d = 0.f;
#pragma unroll 4
    for (int d4 = 0; d4 < 16; ++d4) { const float4 kv = kr[d4]; const float4 q = *(const float4*)(qs + d4 * 4); d += kv.x * q.x + kv.y * q.y + kv.z * q.z + kv.w * q.w; }
    gate = d;
  }
  int rank = 0;
  for (int s2 = 0; s2 < 16; ++s2) {
    const float ks = __shfl(gate, s2);
    rank += (ks > gate || (ks == gate && s2 < lane)) ? 1 : 0;
  }
  unsigned long long mk = __ballot(lane < cur && rank < 3) | (1ull << cur);
  float m[1] = {-1e30f}, l[1] = {0.f}, o[1] = {0.f};
  while (mk) {
    const int blk = __builtin_ctzll(mk); mk &= mk - 1;
    for (int c = 0; c < 4; ++c) {
      const int kp0 = blk * 256 + c * 64;
      if (kp0 > t) break;
      attend_block<1>(H0 + C_MK + h * 64, H0 + C_MV + h * 64, (size_t)b * S_, kp0, t, 0, qs, pb, slope, m, l, o, lane);
    }
  }
  const float z = bf2f(hrow[C_MZ + h * 64 + lane]);
  MIX[row * D_ + 512 + h * 64 + lane] = f2bf((o[0] / l[0]) * silu_f(z));
}


#define LAS __attribute__((address_space(3)))
typedef short s16x4 __attribute__((ext_vector_type(4)));
typedef short s16x8_t __attribute__((ext_vector_type(8)));
typedef float f32x2_t __attribute__((ext_vector_type(2)));
typedef __bf16 bf16x2_t __attribute__((ext_vector_type(2)));
__device__ __forceinline__ unsigned cvtpk(float lo, float hi) { f32x2_t v = {lo, hi}; bf16x2_t b = __builtin_convertvector(v, bf16x2_t); return __builtin_bit_cast(unsigned, b); }
__device__ __forceinline__ s16x4 vtr(LAS const unsigned char* p) { return __builtin_bit_cast(s16x4, __builtin_amdgcn_ds_read_tr16_b64_v4i16((LAS s16x4*)p)); }
template <int OFF> __device__ __forceinline__ s16x4 vtra(unsigned a) { s16x4 r; asm volatile("ds_read_b64_tr_b16 %0, %1 offset:%2" : "=&v"(r) : "v"(a), "i"(OFF) : "memory"); return r; }
#define LGKM0() do { asm volatile("s_waitcnt lgkmcnt(0)" ::: "memory"); __builtin_amdgcn_sched_barrier(0); } while (0)
constexpr int KT_BYTES = 8192;
constexpr int VT_DT = 2080;
constexpr int VT_BYTES = 4 * VT_DT;
constexpr int AT_BUF = KT_BYTES + VT_BYTES;
constexpr int AT_NST = 4;
constexpr int AT_MISC = AT_NST * AT_BUF;
constexpr int AT_TL = AT_MISC + 64;
constexpr int AT_STASH = AT_MISC + 512;
constexpr int AT_LDS_END = AT_STASH + 8 * 512 * 16;
__device__ __forceinline__ void ring_wait(int rem) {
  if (rem >= 3) asm volatile("s_waitcnt vmcnt(6)" ::: "memory");
  else if (rem == 2) asm volatile("s_waitcnt vmcnt(4)" ::: "memory");
  else if (rem == 1) asm volatile("s_waitcnt vmcnt(2)" ::: "memory");
  else asm volatile("s_waitcnt vmcnt(0)" ::: "memory");
  __builtin_amdgcn_s_barrier();
  asm volatile("" ::: "memory");
}
constexpr float C1 = 0.125f * 1.4426950408889634f;
constexpr float LOG2E = 1.4426950408889634f;
constexpr float AT_LIM = 1.2379400392853803e27f;
constexpr float AT_TINY = 7.8886090522101181e-31f;

__device__ __forceinline__ void at_stage_write(LAS unsigned char* buf, const u32x4& kreg, const u32x4& vreg, int tid) {
  const int key = tid >> 3, c = tid & 7;
  *(LAS u32x4*)(buf + key * 128 + ((c ^ ((key >> 1) & 7)) << 4)) = kreg;
  *(LAS u32x4*)(buf + KT_BYTES + (c >> 1) * VT_DT + key * 32 + (c & 1) * 16) = vreg;
}
__device__ __forceinline__ void at_stage_dma(LAS unsigned char* buf, const bf16_t* Kt, const bf16_t* Vt, unsigned pitch, int lane, int wid) {
  const int kkey = 8 * wid + (lane >> 3), c = (lane & 7) ^ ((kkey >> 1) & 7);
  __builtin_amdgcn_global_load_lds((const unsigned*)(Kt + (unsigned)kkey * pitch + c * 8), (LAS unsigned*)(buf + wid * 1024), 16, 0, 0);
  const int vkey = 32 * (wid & 1) + (lane >> 1), dt = wid >> 1;
  __builtin_amdgcn_global_load_lds((const unsigned*)(Vt + (unsigned)vkey * pitch + dt * 16 + (lane & 1) * 8), (LAS unsigned*)(buf + KT_BYTES + dt * VT_DT + (wid & 1) * 1024), 16, 0, 0);
}
template <int NRG, bool EDGE, bool IMP  , bool SAFE>
__device__ __forceinline__ void at_tile_x(LAS const unsigned char* buf, const bf16x8 (&qf)[NRG][2], f32x4 (&O)[NRG][4], float (&m)[NRG], float (&l)[NRG], f32x4 (&L)[NRG],
                                        const float (&base)[NRG], const float (&soff)[NRG], const int (&lim)[NRG], const int (&lo)[NRG], int lane,
                                        float (&imp)[NRG][16], float (&carry)[NRG], int tile = 0) {
  const int g = lane >> 4, i = lane & 15;
  const int swz = (i >> 1) & 7;
  LAS const unsigned char* kb = buf + i * 128;
  const int kc0 = ((g ^ swz) << 4), kc1 = (((4 + g) ^ swz) << 4);
  bf16x8 kf[4][2];
#pragma unroll
  for (int mt = 0; mt < 4; ++mt) { kf[mt][0] = *(LAS const bf16x8*)(kb + mt * 2048 + kc0); kf[mt][1] = *(LAS const bf16x8*)(kb + mt * 2048 + kc1); }
  __builtin_amdgcn_sched_barrier(0);
  f32x4 S[NRG][4];
#pragma unroll
  for (int rg = 0; rg < NRG; ++rg) {
    const float bm = base[rg];
#pragma unroll
    for (int mt = 0; mt < 4; ++mt)
#pragma unroll
      for (int r = 0; r < 4; ++r) S[rg][mt][r] = bm + soff[rg] * (float)(16 * mt + r);
  }
  __builtin_amdgcn_sched_barrier(0);
  __builtin_amdgcn_s_setprio(1);
#pragma unroll
  for (int mt = 0; mt < 4; ++mt) {
#pragma unroll
    for (int rg = 0; rg < NRG; ++rg) {
      f32x4 a = __builtin_amdgcn_mfma_f32_16x16x32_bf16(kf[mt][0], qf[rg][0], S[rg][mt], 0, 0, 0);
      S[rg][mt] = __builtin_amdgcn_mfma_f32_16x16x32_bf16(kf[mt][1], qf[rg][1], a, 0, 0, 0);
    }
  }
  __builtin_amdgcn_s_setprio(0);
  __builtin_amdgcn_sched_barrier(0);
  const unsigned vb = (unsigned)(unsigned long long)(buf + KT_BYTES) + (4 * g + (i >> 2)) * 32 + (i & 3) * 8;
#define AT_VRD(dt, ks, d0, d1) { d0 = vtra<(dt) * VT_DT + (ks) * 1024>(vb); d1 = vtra<(dt) * VT_DT + (ks) * 1024 + 512>(vb); }
  s16x4 a0, a1, a2, a3, a4, a5, a6, a7, c0, c1, c2, c3, c4, c5, c6, c7;
  AT_VRD(0, 0, a0, a1) AT_VRD(0, 1, a2, a3) AT_VRD(1, 0, a4, a5) AT_VRD(1, 1, a6, a7)
  __builtin_amdgcn_sched_barrier(0);
  unsigned pk[NRG][2][4];
#pragma unroll
  for (int rg = 0; rg < NRG; ++rg) {
    if (EDGE) {
#pragma unroll
      for (int mt = 0; mt < 4; ++mt)
#pragma unroll
        for (int r = 0; r < 4; ++r) { const int c = 16 * mt + r; S[rg][mt][r] = (c <= lim[rg] && c >= lo[rg]) ? S[rg][mt][r] : -INFINITY; }
    }
    if (SAFE) {
      float mx = -INFINITY;
#pragma unroll
      for (int mt = 0; mt < 4; ++mt)
#pragma unroll
        for (int r = 0; r < 4; ++r) mx = fmaxf(mx, S[rg][mt][r]);
      mx = xmax<16>(mx); mx = xmax<32>(mx);
      const float mn = fmaxf(m[rg], mx);
      const float mu = mn == -INFINITY ? 0.f : mn;
      const float al = __builtin_amdgcn_exp2f(m[rg] - mu);
      m[rg] = mn; l[rg] *= al;
#pragma unroll
      for (int dt = 0; dt < 4; ++dt) O[rg][dt] = O[rg][dt] * al;
      if (IMP) {
#pragma unroll
        for (int k = 0; k < 16; ++k) imp[rg][k] *= al;
        carry[rg] *= al;
      }
      float ps = 0.f;
#pragma unroll
      for (int mt = 0; mt < 4; ++mt)
#pragma unroll
        for (int r = 0; r < 4; ++r) { const float pv = __builtin_amdgcn_exp2f(S[rg][mt][r] - mu); S[rg][mt][r] = pv; ps += pv; }
      l[rg] += ps;
    } else {
#pragma unroll
      for (int mt = 0; mt < 4; ++mt)
#pragma unroll
        for (int r = 0; r < 4; ++r) S[rg][mt][r] = __builtin_amdgcn_exp2f(S[rg][mt][r]);
    }
    if (IMP) {
      const int g = lane >> 4;
      float sh[4], nv[4];
#pragma unroll
      for (int mt = 0; mt < 4; ++mt) sh[mt] = __uint_as_float(__builtin_amdgcn_ds_bpermute(((lane + 48) & 63) << 2, __float_as_uint(S[rg][mt][3])));
#pragma unroll
      for (int mt = 0; mt < 4; ++mt) {
        const float own = (S[rg][mt][0] + S[rg][mt][1]) + (S[rg][mt][2] + S[rg][mt][3]);
        const float prev = g > 0 ? sh[mt] : (mt > 0 ? sh[mt > 0 ? mt - 1 : 0] : carry[rg]);
        nv[mt] = own + prev;
      }
      if (tile == 0) { imp[rg][0] = nv[0]; imp[rg][1] = nv[1]; imp[rg][2] = nv[2]; imp[rg][3] = nv[3]; }
      else if (tile == 1) { imp[rg][4] = nv[0]; imp[rg][5] = nv[1]; imp[rg][6] = nv[2]; imp[rg][7] = nv[3]; }
      else if (tile == 2) { imp[rg][8] = nv[0]; imp[rg][9] = nv[1]; imp[rg][10] = nv[2]; imp[rg][11] = nv[3]; }
      else { imp[rg][12] = nv[0]; imp[rg][13] = nv[1]; imp[rg][14] = nv[2]; imp[rg][15] = nv[3]; }
      carry[rg] = sh[3];
    }
#pragma unroll
    for (int ks = 0; ks < 2; ++ks) {
      pk[rg][ks][0] = cvtpk(S[rg][2 * ks][0], S[rg][2 * ks][1]); pk[rg][ks][1] = cvtpk(S[rg][2 * ks][2], S[rg][2 * ks][3]);
      pk[rg][ks][2] = cvtpk(S[rg][2 * ks + 1][0], S[rg][2 * ks + 1][1]); pk[rg][ks][3] = cvtpk(S[rg][2 * ks + 1][2], S[rg][2 * ks + 1][3]);
    }
  }
  __builtin_amdgcn_sched_barrier(0);
#define AT_PV(dt, ks, d0, d1) { const bf16x8 vf = (bf16x8){d0[0], d0[1], d0[2], d0[3], d1[0], d1[1], d1[2], d1[3]}; \
    _Pragma("unroll") for (int rg = 0; rg < NRG; ++rg) { const u32x4 pw = {pk[rg][ks][0], pk[rg][ks][1], pk[rg][ks][2], pk[rg][ks][3]}; \
      O[rg][dt] = __builtin_amdgcn_mfma_f32_16x16x32_bf16(vf, __builtin_bit_cast(bf16x8, pw), O[rg][dt], 0, 0, 0); } }
  LGKM0();
  AT_VRD(2, 0, c0, c1) AT_VRD(2, 1, c2, c3) AT_VRD(3, 0, c4, c5) AT_VRD(3, 1, c6, c7)
  if (!SAFE) {
    const short one = (short)0x3F80; const bf16x8 ones = __builtin_bit_cast(bf16x8, (s16x8_t){one, one, one, one, one, one, one, one});
#pragma unroll
    for (int ks = 0; ks < 2; ++ks)
#pragma unroll
      for (int rg = 0; rg < NRG; ++rg) { const u32x4 pw = {pk[rg][ks][0], pk[rg][ks][1], pk[rg][ks][2], pk[rg][ks][3]};
        L[rg] = __builtin_amdgcn_mfma_f32_16x16x32_bf16(ones, __builtin_bit_cast(bf16x8, pw), L[rg], 0, 0, 0); }
  }
  __builtin_amdgcn_s_setprio(1);
  AT_PV(0, 0, a0, a1) AT_PV(0, 1, a2, a3) AT_PV(1, 0, a4, a5) AT_PV(1, 1, a6, a7)
  LGKM0();
  AT_PV(2, 0, c0, c1) AT_PV(2, 1, c2, c3) AT_PV(3, 0, c4, c5) AT_PV(3, 1, c6, c7)
  __builtin_amdgcn_s_setprio(0);
#undef AT_VRD
#undef AT_PV
}

template <int NRG, bool EDGE, bool SAFE>
__device__ __forceinline__ void at_tile(LAS const unsigned char* buf, const bf16x8 (&qf)[NRG][2], f32x4 (&O)[NRG][4], float (&m)[NRG], float (&l)[NRG], f32x4 (&L)[NRG],
                                        const float (&base)[NRG], const float (&soff)[NRG], const int (&lim)[NRG], const int (&lo)[NRG], int lane) {
  float dimp[NRG][16]; float dc[NRG];
  at_tile_x<NRG, EDGE, false, SAFE>(buf, qf, O, m, l, L, base, soff, lim, lo, lane, dimp, dc);
}

__device__ __forceinline__ bool at_any_bad(bool bad, LAS unsigned char* lds, int lane, int wid) {
  LAS unsigned* fl = (LAS unsigned*)(lds + AT_MISC + 320);
  const bool wb = __any(bad);
  if (lane == 0) fl[wid] = wb ? 1u : 0u;
  wg_sync();
  unsigned a = 0u;
#pragma unroll
  for (int w = 0; w < 8; ++w) a |= fl[w];
  return __builtin_amdgcn_readfirstlane(a) != 0u;
}

template <bool SAFE>
__device__ __forceinline__ bool moba_mfma_item(const Params& P, int b, int h, int cur, unsigned char* smem_g) {
  LAS unsigned char* lds = (LAS unsigned char*)smem_g;
  const bf16_t* __restrict__ H0 = (const bf16_t*)(P.ws + WS_H);
  const float* __restrict__ KM = (const float*)(P.ws + WS_KM);
  bf16_t* __restrict__ MIX = (bf16_t*)(P.ws + WS_MIX);
  const int tid = otid(), lane = tid & 63, wid = __builtin_amdgcn_readfirstlane(tid >> 6), g = lane >> 4, i = lane & 15;
  const float slope2 = exp2f(-(float)(h + 1)) * LOG2E;
  const int t0 = cur * 256;
  int trow[2]; bf16x8 qf[2][2]; unsigned sel[2];
#pragma unroll
  for (int rg = 0; rg < 2; ++rg) {
    trow[rg] = t0 + wid * 32 + rg * 16 + i;
    const bf16_t* qp = H0 + ((size_t)b * S_ + trow[rg]) * P0 + C_MQ + h * 64 + 8 * g;
    qf[rg][0] = *(const bf16x8*)qp; qf[rg][1] = *(const bf16x8*)(qp + 32);
  }
  {
    LAS float* kml = (LAS float*)(lds + AT_STASH);
#pragma unroll
    for (int k = 0; k < 2; ++k) { const int e = tid + 512 * k, n = e >> 6; if (n < cur) kml[e] = KM[(((size_t)b * 16 + n) * 8 + h) * 64 + (e & 63)]; }
    wg_sync();
#pragma unroll
    for (int rg = 0; rg < 2; ++rg) {
      float qv[16];
#pragma unroll
      for (int j = 0; j < 8; ++j) { qv[j] = bf2f((bf16_t)qf[rg][0][j]); qv[8 + j] = bf2f((bf16_t)qf[rg][1][j]); }
      float v1 = -INFINITY, v2 = -INFINITY, v3 = -INFINITY; int i1 = -1, i2 = -1, i3 = -1;
      for (int n = 0; n < cur; ++n) {
        LAS const float* kr = kml + n * 64 + 8 * g;
        const f32x4 a0 = *(LAS const f32x4*)kr, a1 = *(LAS const f32x4*)(kr + 4), b0 = *(LAS const f32x4*)(kr + 32), b1 = *(LAS const f32x4*)(kr + 36);
        float d = qv[0] * a0[0] + qv[1] * a0[1] + qv[2] * a0[2] + qv[3] * a0[3] + qv[4] * a1[0] + qv[5] * a1[1] + qv[6] * a1[2] + qv[7] * a1[3]
                + qv[8] * b0[0] + qv[9] * b0[1] + qv[10] * b0[2] + qv[11] * b0[3] + qv[12] * b1[0] + qv[13] * b1[1] + qv[14] * b1[2] + qv[15] * b1[3];
        d = xsum<16>(d); d = xsum<32>(d);
        if (d > v1) { v3 = v2; i3 = i2; v2 = v1; i2 = i1; v1 = d; i1 = n; }
        else if (d > v2) { v3 = v2; i3 = i2; v2 = d; i2 = n; }
        else if (d > v3) { v3 = d; i3 = n; }
      }
      unsigned mk = 0u;
      if (i1 >= 0) mk |= 1u << i1;
      if (i2 >= 0) mk |= 1u << i2;
      if (i3 >= 0) mk |= 1u << i3;
      sel[rg] = mk;
    }
  }
  {
    unsigned u = sel[0] | sel[1];
    u = xorr<1>(u); u = xorr<2>(u); u = xorr<4>(u); u = xorr<8>(u);
    LAS unsigned* misc = (LAS unsigned*)(lds + AT_MISC);
    if (lane == 0) misc[wid] = u;
  }
  wg_sync();
  unsigned umask = 0u;
  {
    LAS unsigned* misc = (LAS unsigned*)(lds + AT_MISC);
#pragma unroll
    for (int w = 0; w < 8; ++w) umask |= misc[w];
  }
  umask = __builtin_amdgcn_readfirstlane(umask);
  const int npast = __builtin_popcount(umask);
  const int nt = 4 * npast + 4;
  f32x4 O[2][4], L[2]; float m[2], l[2];
#pragma unroll
  for (int rg = 0; rg < 2; ++rg) { m[rg] = SAFE ? -INFINITY : 0.f; l[rg] = 0.f; L[rg] = (f32x4){0.f, 0.f, 0.f, 0.f};
#pragma unroll
    for (int dt = 0; dt < 4; ++dt) O[rg][dt] = (f32x4){0.f, 0.f, 0.f, 0.f}; }
  const bf16_t* Kg = H0 + (size_t)b * S_ * P0 + C_MK + h * 64;
  const bf16_t* Vg = H0 + (size_t)b * S_ * P0 + C_MV + h * 64;
  LAS int* tl = (LAS int*)(lds + AT_TL);
  if (tid < nt) {
    int k0v;
    if (tid < 4 * npast) { unsigned r = umask; for (int q = 0; q < (tid >> 2); ++q) r &= r - 1; k0v = __builtin_ctz(r) * 256 + (tid & 3) * 64; }
    else k0v = cur * 256 + (tid - 4 * npast) * 64;
    tl[tid] = k0v;
  }
  asm volatile("s_waitcnt vmcnt(0)" ::: "memory");
  wg_sync();
#pragma unroll
  for (int st = 0; st < 3; ++st) if (st < nt) { const int k0s = tl[st]; at_stage_dma(lds + st * AT_BUF, Kg + (size_t)k0s * P0, Vg + (size_t)k0s * P0, P0, lane, wid); }
  const int ntp = 4 * npast;
#pragma unroll 1
  for (int ti = 0; ti < ntp; ++ti) {
    ring_wait(min(nt - 1 - ti, 2));
    if (ti + 3 < nt) { const int k0n = tl[ti + 3]; at_stage_dma(lds + ((ti + 3) & 3) * AT_BUF, Kg + (size_t)k0n * P0, Vg + (size_t)k0n * P0, P0, lane, wid); }
    const int ck0 = __builtin_amdgcn_readfirstlane(tl[ti]), cblk = ck0 >> 8;
    LAS const unsigned char* buf = lds + (ti & 3) * AT_BUF;
    float base[2], soff[2]; int lim[2], lo[2];
#pragma unroll
    for (int rg = 0; rg < 2; ++rg) {
      const bool rs = (sel[rg] >> cblk) & 1u;
      base[rg] = rs ? slope2 * (float)(ck0 + 4 * g - trow[rg]) : -INFINITY;
      soff[rg] = slope2; lim[rg] = 0; lo[rg] = 0;
    }
    at_tile<2, false, SAFE>(buf, qf, O, m, l, L, base, soff, lim, lo, lane);
  }
#pragma unroll 1
  for (int ti = ntp; ti < nt; ++ti) {
    ring_wait(min(nt - 1 - ti, 2));
    if (ti + 3 < nt) { const int k0n = tl[ti + 3]; at_stage_dma(lds + ((ti + 3) & 3) * AT_BUF, Kg + (size_t)k0n * P0, Vg + (size_t)k0n * P0, P0, lane, wid); }
    const int ck0 = __builtin_amdgcn_readfirstlane(tl[ti]);
    if (ck0 > t0 + wid * 32 + 31) continue;
    LAS const unsigned char* buf = lds + (ti & 3) * AT_BUF;
    float base[2], soff[2]; int lim[2], lo[2];
#pragma unroll
    for (int rg = 0; rg < 2; ++rg) {
      base[rg] = slope2 * (float)(ck0 + 4 * g - trow[rg]);
      soff[rg] = slope2; lim[rg] = trow[rg] - ck0 - 4 * g; lo[rg] = -1000000;
    }
    at_tile<2, true, SAFE>(buf, qf, O, m, l, L, base, soff, lim, lo, lane);
  }
  float ltot[2];
#pragma unroll
  for (int rg = 0; rg < 2; ++rg) { float lt = l[rg]; lt = xsum<16>(lt); lt = xsum<32>(lt); ltot[rg] = SAFE ? lt : L[rg][0]; }
  if (SAFE) __builtin_amdgcn_s_barrier();
  else if (at_any_bad(!(ltot[0] <= AT_LIM) | !(ltot[1] <= AT_LIM) | !(ltot[0] >= AT_TINY) | !(ltot[1] >= AT_TINY), lds, lane, wid)) return true;
#pragma unroll
  for (int rg = 0; rg < 2; ++rg) {
    const float lt = ltot[rg];
    const float inv = 1.f / lt;
    const size_t row = (size_t)b * S_ + trow[rg];
#pragma unroll
    for (int dt = 0; dt < 4; ++dt) {
      const int dv = 16 * dt + 4 * g;
      const ushort4 zz = *(const ushort4*)(H0 + row * P0 + C_MZ + h * 64 + dv);
      ushort4 ov;
      ov.x = f2bf(O[rg][dt][0] * inv * silu_f(bf2f(zz.x))); ov.y = f2bf(O[rg][dt][1] * inv * silu_f(bf2f(zz.y)));
      ov.z = f2bf(O[rg][dt][2] * inv * silu_f(bf2f(zz.z))); ov.w = f2bf(O[rg][dt][3] * inv * silu_f(bf2f(zz.w)));
      *(ushort4*)(MIX + row * D_ + 512 + h * 64 + dv) = ov;
    }
  }
  return false;
}


constexpr size_t WS_KCB = 248 * MiB;
constexpr size_t WS_VCB = 249 * MiB;
template <bool SAFE>
__device__ __forceinline__ bool nsa_mfma_item(const Params& P, int b, int grp, int sb, unsigned char* smem_g) {
  LAS unsigned char* lds = (LAS unsigned char*)smem_g;
  const bf16_t* __restrict__ H0 = (const bf16_t*)(P.ws + WS_H);
  bf16_t* __restrict__ MIX = (bf16_t*)(P.ws + WS_MIX);
  const int tid = otid(), lane = tid & 63, wid = __builtin_amdgcn_readfirstlane(tid >> 6), g = lane >> 4, i = lane & 15;
  const int t0 = sb * 64;
  int trow[2]; bf16x8 qf[2][2];
  const int hh = grp * 4 + (i & 3);
  const float slope2 = exp2f(-(float)(hh + 1)) * LOG2E;
  const bf16_t* __restrict__ Hb = H0 + (size_t)b * S_ * P0;
#pragma unroll
  for (int rg = 0; rg < 2; ++rg) {
    trow[rg] = t0 + wid * 8 + rg * 4 + (i >> 2);
    const unsigned qo = (unsigned)trow[rg] * P0 + C_NQ + hh * 64 + 8 * g;
    qf[rg][0] = *(const bf16x8*)(Hb + qo); qf[rg][1] = *(const bf16x8*)(Hb + qo + 32);
  }
  LAS f32x4* stash = (LAS f32x4*)(lds + AT_STASH) + tid;
  f32x4 O[2][4], L[2]; float m[2], l[2];
  unsigned mlo[2], mhi[2];
  bool bad = false;
  const int ntc = ((4 * sb + 2) >> 6) + 1;
  {
    const bf16_t* Kg = (const bf16_t*)(P.ws + WS_KCB) + (size_t)(b * 2 + grp) * 256 * 64;
    const bf16_t* Vg = (const bf16_t*)(P.ws + WS_VCB) + (size_t)(b * 2 + grp) * 256 * 64;
    asm volatile("s_waitcnt vmcnt(0)" ::: "memory");
#pragma unroll
    for (int tile = 0; tile < 4; ++tile) if (tile < ntc) at_stage_dma(lds + tile * AT_BUF, Kg + tile * 4096, Vg + tile * 4096, 64, lane, wid);
  }
#pragma unroll
  for (int rg = 0; rg < 2; ++rg) {
    float imp[1][16], carry[1], m1[1], l1[1]; f32x4 O1[1][4], L1[1]; bf16x8 q1[1][2];
    L1[0] = (f32x4){0.f, 0.f, 0.f, 0.f};
    q1[0][0] = qf[rg][0]; q1[0][1] = qf[rg][1];
    m1[0] = SAFE ? -INFINITY : 0.f; l1[0] = 0.f; carry[0] = 0.f;
#pragma unroll
    for (int k = 0; k < 16; ++k) imp[0][k] = 0.f;
#pragma unroll
    for (int dt = 0; dt < 4; ++dt) O1[0][dt] = (f32x4){0.f, 0.f, 0.f, 0.f};
#pragma unroll 1
    for (int tile = 0; tile < ntc; ++tile) {
      if (rg == 0) ring_wait(ntc - 1 - tile);
      LAS const unsigned char* buf = lds + tile * AT_BUF;
      float base[1], soff[1]; int lim[1], lo[1];
      const int nlim = trow[rg] >= 31 ? ((trow[rg] - 31) >> 4) : -1;
      base[0] = slope2 * (float)(16 * (64 * tile + 4 * g) + 31 - trow[rg]);
      soff[0] = 16.f * slope2; lim[0] = nlim - 64 * tile - 4 * g; lo[0] = -1000000;
      at_tile_x<1, true, true, SAFE>(buf, q1, O1, m1, l1, L1, base, soff, lim, lo, lane, imp, carry, tile);
    }
    {
      float lt = l1[0]; lt = xsum<16>(lt); lt = xsum<32>(lt);
      if (!SAFE) { lt = L1[0][0]; bad |= !(lt <= AT_LIM) | (trow[rg] >= 31 && !(lt >= AT_TINY)); }
      const float inv = lt > 0.f ? 1.f / lt : 0.f;
      const float g0 = sigmoid_f(bf2f(Hb[(unsigned)trow[rg] * P0 + C_NG + hh * 3 + 0]));
#pragma unroll
      for (int dt = 0; dt < 4; ++dt) stash[(rg * 4 + dt) * 512] = O1[0][dt] * (g0 * inv);
      if (sb < 16) { mlo[rg] = (1u << (sb + 1)) - 1u; mhi[rg] = 0u; }
      else {
        float key[16];
#pragma unroll
        for (int k = 0; k < 16; ++k) {
          float v = imp[0][k] * inv; v = xsum<1>(v); v = xsum<2>(v);
          const int sidx = 4 * k + g;
          const bool forced = (sidx == 0) || (sidx == sb) || (sidx == sb - 1);
          key[k] = (sidx <= sb) ? (forced ? 1e9f : v) : -1e30f;
        }
        const int j = i & 3;
        float mykey[4]; int mys[4], rank[4];
#pragma unroll
        for (int q = 0; q < 4; ++q) {
          mykey[q] = j == 0 ? key[q] : (j == 1 ? key[4 + q] : (j == 2 ? key[8 + q] : key[12 + q]));
          mys[q] = 4 * (4 * j + q) + g; rank[q] = 0;
        }
#pragma unroll 1
        for (int gg = 0; gg < 4; ++gg)
#pragma unroll
          for (int kk = 0; kk < 16; ++kk) {
            const float other = __uint_as_float(__builtin_amdgcn_ds_bpermute((gg * 16 + i) << 2, __float_as_uint(key[kk])));
            const int sp = 4 * kk + gg;
#pragma unroll
            for (int q = 0; q < 4; ++q) rank[q] += (other > mykey[q] || (other == mykey[q] && sp < mys[q])) ? 1 : 0;
          }
        unsigned a = 0u, bb = 0u;
#pragma unroll
        for (int q = 0; q < 4; ++q) if (rank[q] < 16 && mys[q] <= sb) { if (mys[q] < 32) a |= 1u << mys[q]; else bb |= 1u << (mys[q] - 32); }
        a = xorr<1>(a); bb = xorr<1>(bb); a = xorr<2>(a); bb = xorr<2>(bb);
        a = xorr<16>(a); bb = xorr<16>(bb); a = xorr<32>(a); bb = xorr<32>(bb);
        mlo[rg] = a; mhi[rg] = bb;
      }
    }
  }
  {
    unsigned ua = mlo[0] | mlo[1], ub = mhi[0] | mhi[1];
    ua = xorr<4>(ua); ub = xorr<4>(ub); ua = xorr<8>(ua); ub = xorr<8>(ub);
    LAS unsigned* misc = (LAS unsigned*)(lds + AT_MISC);
    if (lane == 0) { misc[2 * wid] = ua; misc[2 * wid + 1] = ub; }
    wg_sync();
    ua = 0u; ub = 0u;
#pragma unroll
    for (int w = 0; w < 8; ++w) { ua |= misc[2 * w]; ub |= misc[2 * w + 1]; }
    unsigned long long rem = ((unsigned long long)(unsigned)__builtin_amdgcn_readfirstlane(ub) << 32) | (unsigned)__builtin_amdgcn_readfirstlane(ua);
    const int nt = __builtin_popcountll(rem);
#pragma unroll
    for (int rg = 0; rg < 2; ++rg) { m[rg] = SAFE ? -INFINITY : 0.f; l[rg] = 0.f; L[rg] = (f32x4){0.f, 0.f, 0.f, 0.f};
#pragma unroll
      for (int dt = 0; dt < 4; ++dt) O[rg][dt] = (f32x4){0.f, 0.f, 0.f, 0.f}; }
    const bf16_t* Kg = Hb + C_KSEL + grp * 64;
    const bf16_t* Vg = Hb + C_VSEL + grp * 64;
    LAS int* tl = (LAS int*)(lds + AT_TL);
    if (tid < nt) { unsigned long long r = rem; for (int q = 0; q < tid; ++q) r &= r - 1; tl[tid] = __builtin_ctzll(r); }
    asm volatile("s_waitcnt vmcnt(0)" ::: "memory");
    wg_sync();
#pragma unroll
    for (int st = 0; st < 3; ++st) if (st < nt) { const int bs = tl[st]; at_stage_dma(lds + st * AT_BUF, Kg + (size_t)bs * 64 * P0, Vg + (size_t)bs * 64 * P0, P0, lane, wid); }
#define NSA_SEL_STEP(EDGEV) { \
      ring_wait(min(nt - 1 - ti, 2)); \
      if (ti + 3 < nt) { const int bn = tl[ti + 3]; at_stage_dma(lds + ((ti + 3) & 3) * AT_BUF, Kg + (size_t)bn * 64 * P0, Vg + (size_t)bn * 64 * P0, P0, lane, wid); } \
      const int cblk = __builtin_amdgcn_readfirstlane(tl[ti]); \
      LAS const unsigned char* buf = lds + (ti & 3) * AT_BUF; \
      float base[2], soff[2]; int lim[2], lo[2]; \
      _Pragma("unroll") for (int rg = 0; rg < 2; ++rg) { \
        const bool rs = cblk < 32 ? ((mlo[rg] >> cblk) & 1u) : ((mhi[rg] >> (cblk - 32)) & 1u); \
        base[rg] = rs ? slope2 * (float)(cblk * 64 + 4 * g - trow[rg]) : -INFINITY; \
        soff[rg] = slope2; lim[rg] = trow[rg] - cblk * 64 - 4 * g; lo[rg] = -1000000; \
      } \
      at_tile<2, EDGEV, SAFE>(buf, qf, O, m, l, L, base, soff, lim, lo, lane); }
    int ti = 0;
#pragma unroll 1
    for (; ti < nt - 1; ++ti) NSA_SEL_STEP(false)
    NSA_SEL_STEP(true)
#undef NSA_SEL_STEP
    __builtin_amdgcn_s_barrier();
#pragma unroll
    for (int rg = 0; rg < 2; ++rg) {
      float lt = l[rg]; lt = xsum<16>(lt); lt = xsum<32>(lt);
      if (!SAFE) { lt = L[rg][0]; bad |= !(lt <= AT_LIM) | !(lt >= AT_TINY); }
      const float g1 = sigmoid_f(bf2f(Hb[(unsigned)trow[rg] * P0 + C_NG + hh * 3 + 1]));
#pragma unroll
      for (int dt = 0; dt < 4; ++dt) stash[(rg * 4 + dt) * 512] += O[rg][dt] * (g1 / lt);
    }
  }
  {
    const int b0 = sb >= 8 ? sb - 8 : 0;
    const int nt = sb - b0 + 1;
#pragma unroll
    for (int rg = 0; rg < 2; ++rg) { m[rg] = SAFE ? -INFINITY : 0.f; l[rg] = 0.f; L[rg] = (f32x4){0.f, 0.f, 0.f, 0.f};
#pragma unroll
      for (int dt = 0; dt < 4; ++dt) O[rg][dt] = (f32x4){0.f, 0.f, 0.f, 0.f}; }
    const bf16_t* Kg = Hb + C_KWIN + grp * 64;
    const bf16_t* Vg = Hb + C_VWIN + grp * 64;
    asm volatile("s_waitcnt vmcnt(0)" ::: "memory");
#pragma unroll
    for (int st = 0; st < 3; ++st) if (st < nt) at_stage_dma(lds + st * AT_BUF, Kg + (size_t)(b0 + st) * 64 * P0, Vg + (size_t)(b0 + st) * 64 * P0, P0, lane, wid);
#define NSA_WIN_STEP(EDGEV) { \
      ring_wait(min(nt - 1 - ti, 2)); \
      const int cblk = b0 + ti; \
      if (ti + 3 < nt) at_stage_dma(lds + ((ti + 3) & 3) * AT_BUF, Kg + (size_t)(cblk + 3) * 64 * P0, Vg + (size_t)(cblk + 3) * 64 * P0, P0, lane, wid); \
      LAS const unsigned char* buf = lds + (ti & 3) * AT_BUF; \
      float base[2], soff[2]; int lim[2], lo[2]; \
      _Pragma("unroll") for (int rg = 0; rg < 2; ++rg) { \
        base[rg] = slope2 * (float)(cblk * 64 + 4 * g - trow[rg]); \
        soff[rg] = slope2; lim[rg] = trow[rg] - cblk * 64 - 4 * g; lo[rg] = trow[rg] - 511 - cblk * 64 - 4 * g; \
      } \
      at_tile<2, EDGEV, SAFE>(buf, qf, O, m, l, L, base, soff, lim, lo, lane); }
    int ti = 0;
    if (sb >= 8) { NSA_WIN_STEP(true) ++ti; }
#pragma unroll 1
    for (; ti < nt - 1; ++ti) NSA_WIN_STEP(false)
    NSA_WIN_STEP(true)
#undef NSA_WIN_STEP
  }
  float ltot[2];
#pragma unroll
  for (int rg = 0; rg < 2; ++rg) { float lt = l[rg]; lt = xsum<16>(lt); lt = xsum<32>(lt); ltot[rg] = SAFE ? lt : L[rg][0]; }
  if (SAFE) __builtin_amdgcn_s_barrier();
  else if (at_any_bad(bad | !(ltot[0] <= AT_LIM) | !(ltot[1] <= AT_LIM) | !(ltot[0] >= AT_TINY) | !(ltot[1] >= AT_TINY), lds, lane, wid)) return true;
#pragma unroll
  for (int rg = 0; rg < 2; ++rg) {
    const float lt = ltot[rg];
    const unsigned ro = (unsigned)trow[rg] * P0;
    const float g2 = sigmoid_f(bf2f(Hb[ro + C_NG + hh * 3 + 2])) / lt;
#pragma unroll
    for (int dt = 0; dt < 4; ++dt) {
      const int dv = 16 * dt + 4 * g;
      const ushort4 zz = *(const ushort4*)(Hb + ro + C_NZ + hh * 64 + dv);
      const f32x4 ov = stash[(rg * 4 + dt) * 512] + O[rg][dt] * g2;
      ushort4 o4;
      o4.x = f2bf(ov[0] * silu_f(bf2f(zz.x))); o4.y = f2bf(ov[1] * silu_f(bf2f(zz.y)));
      o4.z = f2bf(ov[2] * silu_f(bf2f(zz.z))); o4.w = f2bf(ov[3] * silu_f(bf2f(zz.w)));
      *(ushort4*)(MIX + (size_t)b * S_ * D_ + (unsigned)trow[rg] * D_ + hh * 64 + dv) = o4;
    }
  }
  return false;
}

__device__ __forceinline__ void gla_gate_phase(const Params& P) {
  const bf16_t* H1 = (const bf16_t*)(P.ws + WS_H);
  float* G = (float*)(P.ws + WS_G);
  const float* w2 = P.in[10]; const float* gb = P.in[11];
  const size_t total = (size_t)M_ * 512;
  for (size_t i = (size_t)blockIdx.x * 512 + otid(); i < total; i += (size_t)gridDim.x * 512) {
    const int c = (int)(i & 511); const size_t row = i >> 9;
    float x = gb[c];
#pragma unroll
    for (int r = 0; r < 16; ++r) x += bf2f(H1[row * P1 + G_LR + r]) * w2[r * 512 + c];
    const float ls = fminf(x, 0.f) - log1pf(__expf(-fabsf(x)));
    G[i] = ls * (1.f / 16.f);
  }
}
__device__ __forceinline__ void gla_scan_vblock(const Params& P, int vb) {
  const bf16_t* __restrict__ H1 = (const bf16_t*)(P.ws + WS_H);
  const float* __restrict__ G = (const float*)(P.ws + WS_G);
  bf16_t* __restrict__ O = (bf16_t*)(P.ws + WS_XB);
  const int tid = otid(), lane = tid & 63, wid = tid >> 6;
  const int eh = vb & 1, h = (vb >> 1) & 3, b = vb >> 3;
  const int e = eh * 128 + wid * 16 + (lane >> 2), dq = lane & 3;
  float St[32];
#pragma unroll
  for (int i = 0; i < 32; ++i) St[i] = 0.f;
  const float qscale = 0.08838834764831845f;
  for (int t = 0; t < S_; ++t) {
    const size_t row = (size_t)b * S_ + t;
    const float4* gr = (const float4*)(G + row * 512 + h * 128 + dq * 32);
    const uint4* kr = (const uint4*)(H1 + row * P1 + G_K + h * 128 + dq * 32);
    const uint4* qr = (const uint4*)(H1 + row * P1 + G_Q + h * 128 + dq * 32);
    const float v = bf2f(H1[row * P1 + G_V + h * 256 + e]);
    float o = 0.f;
#pragma unroll
    for (int c = 0; c < 4; ++c) {
      const uint4 ku = kr[c], qu = qr[c];
      const float4 g0 = gr[2 * c], g1 = gr[2 * c + 1];
      const float kk[8] = {__uint_as_float(ku.x << 16), __uint_as_float(ku.x & 0xffff0000u), __uint_as_float(ku.y << 16), __uint_as_float(ku.y & 0xffff0000u),
                           __uint_as_float(ku.z << 16), __uint_as_float(ku.z & 0xffff0000u), __uint_as_float(ku.w << 16), __uint_as_float(ku.w & 0xffff0000u)};
      const float qq[8] = {__uint_as_float(qu.x << 16), __uint_as_float(qu.x & 0xffff0000u), __uint_as_float(qu.y << 16), __uint_as_float(qu.y & 0xffff0000u),
                           __uint_as_float(qu.z << 16), __uint_as_float(qu.z & 0xffff0000u), __uint_as_float(qu.w << 16), __uint_as_float(qu.w & 0xffff0000u)};
      const float gg[8] = {g0.x, g0.y, g0.z, g0.w, g1.x, g1.y, g1.z, g1.w};
#pragma unroll
      for (int i = 0; i < 8; ++i) {
        const float a = __expf(gg[i]);
        St[c * 8 + i] = a * St[c * 8 + i] + kk[i] * v;
        o += qq[i] * St[c * 8 + i];
      }
    }
    o = xsum<1>(o); o = xsum<2>(o);
    if (dq == 0) O[row * D_ + h * 256 + e] = f2bf(o * qscale);
  }
}

constexpr int CTL_GLA = 16384;
constexpr size_t WS_QT = WS_G;
constexpr size_t WS_KH = WS_G + 16 * MiB;
constexpr size_t WS_ATT = 190 * MiB;
constexpr size_t WS_DEC = 199 * MiB;
__device__ __forceinline__ int kperm(int x) { const int dl = x & 31, hi = dl >> 4, d2 = dl & 15; return (x & ~31) + 8 * (d2 >> 2) + 4 * hi + (d2 & 3); }

__device__ __forceinline__ void st8_wt(void* p, unsigned lo, unsigned hi) {
  __hip_atomic_store((unsigned long long*)p, ((unsigned long long)hi << 32) | lo, __ATOMIC_RELAXED, __HIP_MEMORY_SCOPE_AGENT);
}
__device__ __forceinline__ void gla_prep_item(const Params& P, int item, unsigned char* smem_g) {
  const bf16_t* __restrict__ H1 = (const bf16_t*)(P.ws + WS_H);
  bf16_t* __restrict__ QT = (bf16_t*)(P.ws + WS_QT) + (size_t)item * 8192;
  bf16_t* __restrict__ KH = (bf16_t*)(P.ws + WS_KH) + (size_t)item * 8192;
  bf16_t* __restrict__ ATT = (bf16_t*)(P.ws + WS_ATT) + (size_t)item * 4096;
  float* __restrict__ DEC = (float*)(P.ws + WS_DEC) + (size_t)item * 128;
  const int tid = otid(), lane = tid & 63, wid = tid >> 6, g = lane >> 4, i = lane & 15;
  const int c = item & 63, h = (item >> 6) & 3, b = item >> 8;
  const size_t rowbase = (size_t)b * S_ + c * 64;
  float* glr = (float*)smem_g;
  float* tot = (float*)(smem_g + 4096);
  bf16_t* qs = (bf16_t*)(smem_g + 12288);
  bf16_t* ks = (bf16_t*)(smem_g + 12288 + 17408);
  const int d0 = (tid & 31) * 4, rgp = tid >> 5;
#pragma unroll
  for (int k = 0; k < 2; ++k) { const int e = tid + 512 * k; glr[e] = ((const float*)(P.ws + WS_GLR))[rowbase * 16 + e]; }
  uint2 qraw[4], kraw[4];
#pragma unroll
  for (int k = 0; k < 4; ++k) {
    qraw[k] = *(const uint2*)(H1 + (rowbase + 4 * rgp + k) * P1 + G_Q + h * 128 + d0);
    kraw[k] = *(const uint2*)(H1 + (rowbase + 4 * rgp + k) * P1 + G_K + h * 128 + d0);
  }
  float4 w[16];
#pragma unroll
  for (int r = 0; r < 16; ++r) w[r] = *(const float4*)(P.in[10] + r * 512 + h * 128 + d0);
  const float4 gb = *(const float4*)(P.in[11] + h * 128 + d0);
  wg_sync();
  float bb[4][4];
  float run[4] = {0.f, 0.f, 0.f, 0.f};
#pragma unroll
  for (int k = 0; k < 4; ++k) {
    const float* gr = glr + (4 * rgp + k) * 16;
    float x[4] = {gb.x, gb.y, gb.z, gb.w};
#pragma unroll
    for (int r = 0; r < 16; ++r) { const float gv = gr[r]; x[0] += gv * w[r].x; x[1] += gv * w[r].y; x[2] += gv * w[r].z; x[3] += gv * w[r].w; }
#pragma unroll
    for (int j = 0; j < 4; ++j) {
      const float la = (fminf(x[j], 0.f) - __logf(1.f + __expf(-fabsf(x[j])))) * (1.f / 16.f);
      run[j] += la; bb[k][j] = run[j];
    }
  }
  *(float4*)(tot + rgp * 128 + d0) = (float4){run[0], run[1], run[2], run[3]};
  wg_sync();
  float off[4] = {0.f, 0.f, 0.f, 0.f}, total[4] = {0.f, 0.f, 0.f, 0.f};
#pragma unroll
  for (int q = 0; q < 16; ++q) {
    const float4 tv = *(const float4*)(tot + q * 128 + d0);
    total[0] += tv.x; total[1] += tv.y; total[2] += tv.z; total[3] += tv.w;
    if (q < rgp) { off[0] += tv.x; off[1] += tv.y; off[2] += tv.z; off[3] += tv.w; }
  }
  const float qscale = 0.08838834764831845f;
  const int dp = kperm(d0);
#pragma unroll
  for (int k = 0; k < 4; ++k) {
    const int r = 4 * rgp + k;
    const float qv[4] = {__uint_as_float(qraw[k].x << 16), __uint_as_float(qraw[k].x & 0xffff0000u), __uint_as_float(qraw[k].y << 16), __uint_as_float(qraw[k].y & 0xffff0000u)};
    const float kv[4] = {__uint_as_float(kraw[k].x << 16), __uint_as_float(kraw[k].x & 0xffff0000u), __uint_as_float(kraw[k].y << 16), __uint_as_float(kraw[k].y & 0xffff0000u)};
    float qt[4], kt[4], kh[4];
#pragma unroll
    for (int j = 0; j < 4; ++j) {
      const float bv = bb[k][j] + off[j];
      const float eb = __expf(bv);
      qt[j] = qv[j] * eb * qscale; kt[j] = kv[j] * __expf(-bv); kh[j] = kv[j] * __expf(total[j] - bv);
    }
    const unsigned q01 = cvtpk(qt[0], qt[1]), q23 = cvtpk(qt[2], qt[3]), k01 = cvtpk(kt[0], kt[1]), k23 = cvtpk(kt[2], kt[3]);
    *(uint2*)(qs + r * 136 + d0) = (uint2){q01, q23};
    *(uint2*)(ks + r * 136 + d0) = (uint2){k01, k23};
    st8_wt(QT + r * 128 + dp, q01, q23);
    st8_wt(KH + r * 128 + d0, cvtpk(kh[0], kh[1]), cvtpk(kh[2], kh[3]));
  }
  if (rgp == 0) {
    st8_wt(DEC + d0, __float_as_uint(__expf(total[0])), __float_as_uint(__expf(total[1])));
    st8_wt(DEC + d0 + 2, __float_as_uint(__expf(total[2])), __float_as_uint(__expf(total[3])));
  }
  wg_sync();
  {
    const int it = wid >> 1, jt0 = 2 * (wid & 1);
    f32x4 acc[2] = {(f32x4){0.f, 0.f, 0.f, 0.f}, (f32x4){0.f, 0.f, 0.f, 0.f}};
#pragma unroll
    for (int kk = 0; kk < 4; ++kk) {
      const bf16x8 qa = *(const bf16x8*)(qs + (16 * it + i) * 136 + 32 * kk + 8 * g);
#pragma unroll
      for (int n = 0; n < 2; ++n) {
        const bf16x8 kf = *(const bf16x8*)(ks + (16 * (jt0 + n) + i) * 136 + 32 * kk + 8 * g);
        acc[n] = __builtin_amdgcn_mfma_f32_16x16x32_bf16(kf, qa, acc[n], 0, 0, 0);
      }
    }
#pragma unroll
    for (int n = 0; n < 2; ++n) {
      const int ri = 16 * it + i, cj0 = 16 * (jt0 + n) + 4 * g;
      float v[4];
#pragma unroll
      for (int r = 0; r < 4; ++r) v[r] = (cj0 + r <= ri) ? acc[n][r] : 0.f;
      st8_wt(ATT + ri * 64 + kperm(cj0), cvtpk(v[0], v[1]), cvtpk(v[2], v[3]));
    }
  }
  asm volatile("s_waitcnt vmcnt(0)" ::: "memory");
  wg_sync();
  if (tid == 0) __hip_atomic_store((unsigned*)P.ws + CTL_GLA + 64 * item, 1u, __ATOMIC_RELAXED, __HIP_MEMORY_SCOPE_AGENT);
}
__device__ __forceinline__ void gla_wait_items(const Params& P, int first, int n, int tid) {
  if (tid < n) {
    unsigned* f = (unsigned*)P.ws + CTL_GLA + 64 * (first + tid);
    unsigned sp = 0;
    while (__hip_atomic_load(f, __ATOMIC_RELAXED, __HIP_MEMORY_SCOPE_AGENT) == 0u) { __builtin_amdgcn_s_sleep(2); if (++sp > (1u << 22)) break; }
  }
  wg_sync();
}
constexpr int GS_Q = 0, GS_K = 16384, GS_V = 32768, GS_A = 49152, GS_D = 57344, GS_BYTES = 57856;
__device__ __forceinline__ void gla_stage_dma(LAS unsigned char* st, const Params& P, int item, size_t rowbase, int h, int eh, int lane, int wid) {
  const bf16_t* QT = (const bf16_t*)(P.ws + WS_QT) + (size_t)item * 8192;
  const bf16_t* KH = (const bf16_t*)(P.ws + WS_KH) + (size_t)item * 8192;
  const bf16_t* ATT = (const bf16_t*)(P.ws + WS_ATT) + (size_t)item * 4096;
  const bf16_t* V = (const bf16_t*)(P.ws + WS_H) + rowbase * P1 + G_V + h * 256 + eh * 128;
#pragma unroll
  for (int n = 0; n < 2; ++n) {
    const int q = 2 * wid + n;
    { const int row = 4 * q + (lane >> 4), ch = (lane & 15) ^ (row & 15);
      __builtin_amdgcn_global_load_lds((const unsigned*)(QT + row * 128 + ch * 8), (LAS unsigned*)(st + GS_Q + q * 1024), 16, 0, 0); }
    { const int dt = q >> 1, j = 32 * (q & 1) + (lane >> 1);
      __builtin_amdgcn_global_load_lds((const unsigned*)(KH + j * 128 + dt * 16 + (lane & 1) * 8), (LAS unsigned*)(st + GS_K + q * 1024), 16, 0, 0);
      __builtin_amdgcn_global_load_lds((const unsigned*)(V + (unsigned)j * P1 + dt * 16 + (lane & 1) * 8), (LAS unsigned*)(st + GS_V + q * 1024), 16, 0, 0); }
  }
  { const int row = 8 * wid + (lane >> 3), ch = (lane & 7) ^ ((row >> 1) & 7);
    __builtin_amdgcn_global_load_lds((const unsigned*)(ATT + row * 64 + ch * 8), (LAS unsigned*)(st + GS_A + wid * 1024), 16, 0, 0); }
  if (wid < 2) __builtin_amdgcn_global_load_lds((const unsigned*)((const float*)(P.ws + WS_DEC) + (size_t)item * 128 + wid * 64 + lane), (LAS unsigned*)(st + GS_D + wid * 256), 4, 0, 0);
}
__device__ __forceinline__ void gla_chain(const Params& P, int chain, unsigned char* smem_g) {
  LAS unsigned char* lds = (LAS unsigned char*)smem_g;
  bf16_t* __restrict__ O = (bf16_t*)(P.ws + WS_XB);
  const int tid = otid(), lane = tid & 63, wid = __builtin_amdgcn_readfirstlane(tid >> 6), g = lane >> 4, i = lane & 15;
  const int eh = chain & 1, h = (chain >> 1) & 3, b = chain >> 3;
  const int item0 = (b * 4 + h) * 64;
  f32x4 S[8];
#pragma unroll
  for (int dt = 0; dt < 8; ++dt) S[dt] = (f32x4){0.f, 0.f, 0.f, 0.f};
  gla_wait_items(P, item0, 9, tid);
  gla_stage_dma(lds, P, item0, (size_t)b * S_, h, eh, lane, wid);
  wg_sync();
  for (int c = 0; c < 64; ++c) {
    if ((c & 7) == 0 && c > 0) gla_wait_items(P, item0 + c + 1, (64 - (c + 1)) < 8 ? (64 - (c + 1)) : 8, tid);
    if (c + 1 < 64) gla_stage_dma(lds + ((c + 1) & 1) * GS_BYTES, P, item0 + c + 1, (size_t)b * S_ + (c + 1) * 64, h, eh, lane, wid);
    LAS const unsigned char* st = lds + (c & 1) * GS_BYTES;
    f32x4 dc[8];
#pragma unroll
    for (int dt = 0; dt < 8; ++dt) dc[dt] = *(LAS const f32x4*)(st + GS_D + (16 * dt + 4 * g) * 4);
    u32x4 spk[4];
#pragma unroll
    for (int kk = 0; kk < 4; ++kk) {
      spk[kk][0] = cvtpk(S[2 * kk][0], S[2 * kk][1]); spk[kk][1] = cvtpk(S[2 * kk][2], S[2 * kk][3]);
      spk[kk][2] = cvtpk(S[2 * kk + 1][0], S[2 * kk + 1][1]); spk[kk][3] = cvtpk(S[2 * kk + 1][2], S[2 * kk + 1][3]);
    }
    bf16x8 vf[2];
    const unsigned trb = (unsigned)(unsigned long long)st + (4 * g + (i >> 2)) * 32 + (i & 3) * 8;
    {
      const unsigned vb = trb + GS_V + wid * 2048;
      const s16x4 v0 = vtra<0>(vb), v1 = vtra<512>(vb), v2 = vtra<1024>(vb), v3 = vtra<1536>(vb);
      LGKM0();
      vf[0] = (bf16x8){v0[0], v0[1], v0[2], v0[3], v1[0], v1[1], v1[2], v1[3]};
      vf[1] = (bf16x8){v2[0], v2[1], v2[2], v2[3], v3[0], v3[1], v3[2], v3[3]};
    }
#pragma unroll
    for (int it = 0; it < 4; ++it) {
      f32x4 acc = (f32x4){0.f, 0.f, 0.f, 0.f};
      LAS const unsigned char* qrow = st + GS_Q + (16 * it + i) * 256;
#pragma unroll
      for (int kk = 0; kk < 4; ++kk) {
        const bf16x8 a = *(LAS const bf16x8*)(qrow + (((4 * kk + g) ^ i) << 4));
        acc = __builtin_amdgcn_mfma_f32_16x16x32_bf16(a, __builtin_bit_cast(bf16x8, spk[kk]), acc, 0, 0, 0);
      }
      LAS const unsigned char* arow = st + GS_A + (16 * it + i) * 128;
#pragma unroll
      for (int k2 = 0; k2 < 2; ++k2) {
        const bf16x8 a = *(LAS const bf16x8*)(arow + (((4 * k2 + g) ^ ((i >> 1) & 7)) << 4));
        acc = __builtin_amdgcn_mfma_f32_16x16x32_bf16(a, vf[k2], acc, 0, 0, 0);
      }
      bf16_t* op = O + ((size_t)b * S_ + c * 64 + 16 * it + 4 * g) * D_ + h * 256 + eh * 128 + 16 * wid + i;
#pragma unroll
      for (int r = 0; r < 4; ++r) op[(size_t)r * D_] = f2bf(acc[r]);
    }
    __builtin_amdgcn_sched_barrier(0);
#define GL_KRD(dt, q0, q1, q2, q3) { q0 = vtra<GS_K + (dt) * 2048>(trb); q1 = vtra<GS_K + (dt) * 2048 + 512>(trb); q2 = vtra<GS_K + (dt) * 2048 + 1024>(trb); q3 = vtra<GS_K + (dt) * 2048 + 1536>(trb); }
#define GL_UPD(dt, q0, q1, q2, q3) { S[dt] = S[dt] * dc[dt]; \
      S[dt] = __builtin_amdgcn_mfma_f32_16x16x32_bf16((bf16x8){q0[0], q0[1], q0[2], q0[3], q1[0], q1[1], q1[2], q1[3]}, vf[0], S[dt], 0, 0, 0); \
      S[dt] = __builtin_amdgcn_mfma_f32_16x16x32_bf16((bf16x8){q2[0], q2[1], q2[2], q2[3], q3[0], q3[1], q3[2], q3[3]}, vf[1], S[dt], 0, 0, 0); }
    {
      s16x4 e0, e1, e2, e3, e4, e5, e6, e7, f0, f1, f2, f3, f4, f5, f6, f7;
      GL_KRD(0, e0, e1, e2, e3) GL_KRD(1, e4, e5, e6, e7)
      LGKM0();
      GL_KRD(2, f0, f1, f2, f3) GL_KRD(3, f4, f5, f6, f7)
      GL_UPD(0, e0, e1, e2, e3) GL_UPD(1, e4, e5, e6, e7)
      LGKM0();
      GL_KRD(4, e0, e1, e2, e3) GL_KRD(5, e4, e5, e6, e7)
      GL_UPD(2, f0, f1, f2, f3) GL_UPD(3, f4, f5, f6, f7)
      LGKM0();
      GL_KRD(6, f0, f1, f2, f3) GL_KRD(7, f4, f5, f6, f7)
      GL_UPD(4, e0, e1, e2, e3) GL_UPD(5, e4, e5, e6, e7)
      LGKM0();
      GL_UPD(6, f0, f1, f2, f3) GL_UPD(7, f4, f5, f6, f7)
    }
#undef GL_KRD
#undef GL_UPD
    wg_sync();
  }
}


constexpr int G4_Q = 0, G4_K = 16384, G4_V = 32768, G4_A = 40960, G4_D = 49152, G4_BYTES = 49664, G4_EXCH = 3 * G4_BYTES, G4_END = G4_EXCH + 8192;
__device__ __forceinline__ void gla4_stage_dma(LAS unsigned char* st, const Params& P, int item, size_t rowbase, int h, int eq, int lane, int wid) {
  const bf16_t* QT = (const bf16_t*)(P.ws + WS_QT) + (size_t)item * 8192;
  const bf16_t* KH = (const bf16_t*)(P.ws + WS_KH) + (size_t)item * 8192;
  const bf16_t* ATT = (const bf16_t*)(P.ws + WS_ATT) + (size_t)item * 4096;
  const bf16_t* V = (const bf16_t*)(P.ws + WS_H) + rowbase * P1 + G_V + h * 256 + eq * 64;
#pragma unroll
  for (int n = 0; n < 2; ++n) {
    const int q = 2 * wid + n;
    { const int row = 4 * q + (lane >> 4), ch = (lane & 15) ^ (row & 15);
      __builtin_amdgcn_global_load_lds((const unsigned*)(QT + row * 128 + ch * 8), (LAS unsigned*)(st + G4_Q + q * 1024), 16, 0, 0); }
    { const int dt = q >> 1, j = 32 * (q & 1) + (lane >> 1);
      __builtin_amdgcn_global_load_lds((const unsigned*)(KH + j * 128 + dt * 16 + (lane & 1) * 8), (LAS unsigned*)(st + G4_K + q * 1024), 16, 0, 0); }
  }
  { const int et = wid >> 1, j = 32 * (wid & 1) + (lane >> 1);
    __builtin_amdgcn_global_load_lds((const unsigned*)(V + (unsigned)j * P1 + et * 16 + (lane & 1) * 8), (LAS unsigned*)(st + G4_V + wid * 1024), 16, 0, 0); }
  { const int row = 8 * wid + (lane >> 3), ch = (lane & 7) ^ ((row >> 1) & 7);
    __builtin_amdgcn_global_load_lds((const unsigned*)(ATT + row * 64 + ch * 8), (LAS unsigned*)(st + G4_A + wid * 1024), 16, 0, 0); }
  __builtin_amdgcn_global_load_lds((const unsigned*)((const float*)(P.ws + WS_DEC) + (size_t)item * 128 + (wid & 1) * 64 + lane), (LAS unsigned*)(st + G4_D + (wid & 1) * 256), 4, 0, 0);
}
__device__ __forceinline__ void gla_chain64(const Params& P, int chain, int seg, unsigned char* smem_g) {
  LAS unsigned char* lds = (LAS unsigned char*)smem_g;
  bf16_t* __restrict__ O = (bf16_t*)(P.ws + WS_XB);
  const int tid = otid(), lane = tid & 63, wid = __builtin_amdgcn_readfirstlane(tid >> 6), g = lane >> 4, i = lane & 15;
  const int et = wid & 3, dh = wid >> 2;
  const int eq = chain & 3, h = (chain >> 2) & 3, b = chain >> 4;
  const int item0 = (b * 4 + h) * 64 + 32 * seg;
  const size_t row0 = (size_t)b * S_ + (size_t)seg * 32 * 64;
  f32x4 S[4];
#pragma unroll
  for (int t = 0; t < 4; ++t) S[t] = (f32x4){0.f, 0.f, 0.f, 0.f};
  f32x4 opend[2] = {(f32x4){0.f, 0.f, 0.f, 0.f}, (f32x4){0.f, 0.f, 0.f, 0.f}};
  gla_wait_items(P, item0, 10, tid);
  gla4_stage_dma(lds, P, item0, row0, h, eq, lane, wid);
  gla4_stage_dma(lds + G4_BYTES, P, item0 + 1, row0 + 64, h, eq, lane, wid);
  for (int c = 0; c < 32; ++c) {
    if ((c & 7) == 0 && c > 0 && c + 2 < 32) gla_wait_items(P, item0 + c + 2, (32 - (c + 2)) < 8 ? (32 - (c + 2)) : 8, tid);
    if (c + 1 < 32) asm volatile("s_waitcnt vmcnt(7)" ::: "memory"); else asm volatile("s_waitcnt vmcnt(0)" ::: "memory");
    __builtin_amdgcn_s_barrier();
    asm volatile("" ::: "memory");
    if (c > 0) {
#pragma unroll
      for (int q = 0; q < 2; ++q) { bf16_t* op = O + (row0 + (c - 1) * 64 + 16 * (2 * dh + q) + 4 * g) * D_ + h * 256 + eq * 64 + 16 * et + i;
#pragma unroll
        for (int r = 0; r < 4; ++r) op[(size_t)r * D_] = f2bf(opend[q][r]); }
    }
    if (c + 2 < 32) gla4_stage_dma(lds + ((c + 2) % 3) * G4_BYTES, P, item0 + c + 2, row0 + (c + 2) * 64, h, eq, lane, wid);
    LAS const unsigned char* st = lds + (c % 3) * G4_BYTES;
    f32x4 dc[4];
#pragma unroll
    for (int t = 0; t < 4; ++t) dc[t] = *(LAS const f32x4*)(st + G4_D + (16 * (4 * dh + t) + 4 * g) * 4);
    bf16x8 qa[4][2], aa[2][2];
#pragma unroll
    for (int it = 0; it < 4; ++it)
#pragma unroll
      for (int q = 0; q < 2; ++q) qa[it][q] = *(LAS const bf16x8*)(st + G4_Q + (16 * it + i) * 256 + (((4 * (2 * dh + q) + g) ^ i) << 4));
#pragma unroll
    for (int q = 0; q < 2; ++q)
#pragma unroll
      for (int k2 = 0; k2 < 2; ++k2) aa[q][k2] = *(LAS const bf16x8*)(st + G4_A + (16 * (2 * dh + q) + i) * 128 + (((4 * k2 + g) ^ ((i >> 1) & 7)) << 4));
    const unsigned trb = (unsigned)(unsigned long long)st + (4 * g + (i >> 2)) * 32 + (i & 3) * 8;
    const unsigned vb = trb + G4_V + et * 2048, kb = trb + G4_K + (4 * dh) * 2048;
    const s16x4 v0 = vtra<0>(vb), v1 = vtra<512>(vb), v2 = vtra<1024>(vb), v3 = vtra<1536>(vb);
    s16x4 kq[4][4];
#define G4_KRD(t) { kq[t][0] = vtra<(t) * 2048>(kb); kq[t][1] = vtra<(t) * 2048 + 512>(kb); kq[t][2] = vtra<(t) * 2048 + 1024>(kb); kq[t][3] = vtra<(t) * 2048 + 1536>(kb); }
    G4_KRD(0) G4_KRD(1) G4_KRD(2) G4_KRD(3)
#undef G4_KRD
    u32x4 spk[2];
#pragma unroll
    for (int q = 0; q < 2; ++q) {
      spk[q][0] = cvtpk(S[2 * q][0], S[2 * q][1]); spk[q][1] = cvtpk(S[2 * q][2], S[2 * q][3]);
      spk[q][2] = cvtpk(S[2 * q + 1][0], S[2 * q + 1][1]); spk[q][3] = cvtpk(S[2 * q + 1][2], S[2 * q + 1][3]);
    }
    LGKM0();
    bf16x8 vf[2];
    vf[0] = (bf16x8){v0[0], v0[1], v0[2], v0[3], v1[0], v1[1], v1[2], v1[3]};
    vf[1] = (bf16x8){v2[0], v2[1], v2[2], v2[3], v3[0], v3[1], v3[2], v3[3]};
    f32x4 acc[4];
#pragma unroll
    for (int it = 0; it < 4; ++it) {
      acc[it] = (f32x4){0.f, 0.f, 0.f, 0.f};
      if (it >> 1 == dh) {
#pragma unroll
        for (int k2 = 0; k2 < 2; ++k2) acc[it] = __builtin_amdgcn_mfma_f32_16x16x32_bf16(aa[it & 1][k2], vf[k2], acc[it], 0, 0, 0);
      }
#pragma unroll
      for (int q = 0; q < 2; ++q) acc[it] = __builtin_amdgcn_mfma_f32_16x16x32_bf16(qa[it][q], __builtin_bit_cast(bf16x8, spk[q]), acc[it], 0, 0, 0);
    }
#pragma unroll
    for (int t = 0; t < 4; ++t) {
      S[t] = S[t] * dc[t];
      S[t] = __builtin_amdgcn_mfma_f32_16x16x32_bf16((bf16x8){kq[t][0][0], kq[t][0][1], kq[t][0][2], kq[t][0][3], kq[t][1][0], kq[t][1][1], kq[t][1][2], kq[t][1][3]}, vf[0], S[t], 0, 0, 0);
      S[t] = __builtin_amdgcn_mfma_f32_16x16x32_bf16((bf16x8){kq[t][2][0], kq[t][2][1], kq[t][2][2], kq[t][2][3], kq[t][3][0], kq[t][3][1], kq[t][3][2], kq[t][3][3]}, vf[1], S[t], 0, 0, 0);
    }
    {
      LAS u32x2* ex = (LAS u32x2*)(lds + G4_EXCH) + (wid * 2) * 64 + lane;
#pragma unroll
      for (int q = 0; q < 2; ++q) { const f32x4 v = dh == 0 ? acc[2 + q] : acc[q]; ex[q * 64] = (u32x2){cvtpk(v[0], v[1]), cvtpk(v[2], v[3])}; }
    }
    asm volatile("s_waitcnt lgkmcnt(0)" ::: "memory");
    __builtin_amdgcn_s_barrier();
    asm volatile("" ::: "memory");
    {
      LAS const u32x2* ex = (LAS const u32x2*)(lds + G4_EXCH) + ((wid ^ 4) * 2) * 64 + lane;
#pragma unroll
      for (int q = 0; q < 2; ++q) {
        const u32x2 pv = ex[q * 64];
        f32x4 mine = dh == 0 ? acc[q] : acc[2 + q];
        mine[0] += __uint_as_float(pv.x << 16); mine[1] += __uint_as_float(pv.x & 0xffff0000u); mine[2] += __uint_as_float(pv.y << 16); mine[3] += __uint_as_float(pv.y & 0xffff0000u);
        opend[q] = mine;
      }
    }
  }
#pragma unroll
  for (int q = 0; q < 2; ++q) { bf16_t* op = O + (row0 + 31 * 64 + 16 * (2 * dh + q) + 4 * g) * D_ + h * 256 + eq * 64 + 16 * et + i;
#pragma unroll
    for (int r = 0; r < 4; ++r) op[(size_t)r * D_] = f2bf(opend[q][r]); }
  if (seg == 0) {
    bf16_t* smt = (bf16_t*)(P.ws + WS_SMT) + ((size_t)(b * 4 + h) * 256 + eq * 64 + 16 * et + i) * 128;
#pragma unroll
    for (int t = 0; t < 4; ++t) { const int T = 4 * dh + t, p0 = 32 * (T >> 1) + 8 * g + 4 * (T & 1);
      *(u32x2*)(smt + p0) = (u32x2){cvtpk(S[t][0], S[t][1]), cvtpk(S[t][2], S[t][3])}; }
  }
  __builtin_amdgcn_s_barrier();
}

__device__ __forceinline__ void gla_norm_phase(const Params& P) {
  const bf16_t* H1 = (const bf16_t*)(P.ws + WS_H);
  const bf16_t* O = (const bf16_t*)(P.ws + WS_XB);
  bf16_t* MIX = (bf16_t*)(P.ws + WS_MIX);
  const float* gn = P.in[12];
  const int lane = otid() & 63, wid = otid() >> 6;
  for (int it = blockIdx.x * 8 + wid; it < M_ * 4; it += gridDim.x * 8) {
    const int h = it & 3; const size_t row = it >> 2;
    float v[4]; float ss = 0.f;
#pragma unroll
    for (int k = 0; k < 4; ++k) { v[k] = bf2f(O[row * D_ + h * 256 + k * 64 + lane]); ss += v[k] * v[k]; }
    const float r = 1.f / sqrtf(wave_sum(ss) * (1.f / 256.f) + LN_EPS);
#pragma unroll
    for (int k = 0; k < 4; ++k) {
      const int c = h * 256 + k * 64 + lane;
      const float z = bf2f(H1[row * P1 + G_Z + c]);
      MIX[row * D_ + c] = f2bf(v[k] * r * gn[c] * silu_f(z));
    }
  }
}


constexpr int RG_RED = 131072;
__device__ __forceinline__ size_t wfrag_off(int n, int k) { return ((size_t)(((n >> 4) * 32 + (k >> 5)) * 64 + ((k >> 3) & 3) * 16 + (n & 15))) * 8 + (k & 7); }
template <int AMODE  , bool GLR  >
__device__ __forceinline__ void rowgemm_block(const Params& P, int rb, const bf16_t* __restrict__ Wf, const float* base, float* out, bf16_t* outb,
                                              const float* __restrict__ gam, const float* __restrict__ bet, unsigned char* smem_g) {
  LAS unsigned char* lds = (LAS unsigned char*)smem_g;
  const int tid = otid(), lane = tid & 63, wid = __builtin_amdgcn_readfirstlane(tid >> 6), g = lane >> 4, i = lane & 15;
  const size_t r0 = (size_t)rb * 64;
  if (AMODE == 0) {
    const bf16_t* A = (const bf16_t*)(P.ws + WS_MIX) + r0 * D_;
#pragma unroll
    for (int q0 = 0; q0 < 16; ++q0) {
      const int q = wid * 16 + q0, row = q >> 1, ch = ((q & 1) * 64 + lane) ^ (row & 15);
      __builtin_amdgcn_global_load_lds((const unsigned*)(A + (size_t)row * D_ + ch * 8), (LAS unsigned*)(lds + q * 1024), 16, 0, 0);
    }
  } else {
    const bf16_t* __restrict__ O = (const bf16_t*)(P.ws + WS_XB) + r0 * D_;
    const bf16_t* __restrict__ H1 = (const bf16_t*)(P.ws + WS_H) + r0 * P1 + G_Z;
    const float* __restrict__ gn = P.in[12];
    const int row = tid >> 3, part = tid & 7;
    u32x4 ov[16];
#pragma unroll
    for (int c = 0; c < 16; ++c) ov[c] = *(const u32x4*)(O + (size_t)row * D_ + part * 128 + c * 8);
    const int bb = rb >> 6, cc = rb & 63;
    if (cc >= 32) {
      LAS float* PP = (LAS float*)(lds + RG_RED);
      LAS unsigned char* QP = lds + RG_RED + 4096;
#pragma unroll 1
      for (int hh = 0; hh < 4; ++hh) {
        const int itm = (bb * 4 + hh) * 64;
        if (tid < 128) {
          const int pp = tid, dd = (pp & ~31) + 16 * ((pp >> 2) & 1) + 4 * ((pp >> 3) & 3) + (pp & 3);
          const float* dec = (const float*)(P.ws + WS_DEC) + (size_t)itm * 128 + dd;
          float pr = 1.f;
#pragma unroll 4
          for (int c2 = 32; c2 < cc; ++c2) pr *= dec[(size_t)c2 * 128];
          PP[pp] = pr;
        }
        wg_sync();
        {
          const int p0 = (tid & 7) * 16;
          const bf16_t* qsrc = (const bf16_t*)(P.ws + WS_QT) + (size_t)(itm + cc) * 8192 + row * 128 + p0;
          const u32x4 q0 = *(const u32x4*)qsrc, q1 = *(const u32x4*)(qsrc + 8);
          u32x4 w0, w1;
#pragma unroll
          for (int e = 0; e < 4; ++e) {
            w0[e] = cvtpk(__uint_as_float(q0[e] << 16) * PP[p0 + 2 * e], __uint_as_float(q0[e] & 0xffff0000u) * PP[p0 + 2 * e + 1]);
            w1[e] = cvtpk(__uint_as_float(q1[e] << 16) * PP[p0 + 8 + 2 * e], __uint_as_float(q1[e] & 0xffff0000u) * PP[p0 + 8 + 2 * e + 1]);
          }
          *(LAS u32x4*)(QP + row * 272 + p0 * 2) = w0; *(LAS u32x4*)(QP + row * 272 + p0 * 2 + 16) = w1;
        }
        wg_sync();
        {
          const bf16_t* smt = (const bf16_t*)(P.ws + WS_SMT) + ((size_t)(bb * 4 + hh) * 256 + 32 * wid + i) * 128 + 8 * g;
          bf16x8 af[2][4];
#pragma unroll
          for (int q = 0; q < 2; ++q)
#pragma unroll
            for (int kk = 0; kk < 4; ++kk) af[q][kk] = *(const bf16x8*)(smt + (size_t)q * 16 * 128 + 32 * kk);
#pragma unroll 1
          for (int mm = 0; mm < 4; ++mm) {
            bf16x8 bfm[4];
#pragma unroll
            for (int kk = 0; kk < 4; ++kk) bfm[kk] = *(LAS const bf16x8*)(QP + (16 * mm + i) * 272 + (32 * kk + 8 * g) * 2);
#pragma unroll
            for (int q = 0; q < 2; ++q) {
              f32x4 ca = (f32x4){0.f, 0.f, 0.f, 0.f};
#pragma unroll
              for (int kk = 0; kk < 4; ++kk) ca = __builtin_amdgcn_mfma_f32_16x16x32_bf16(af[q][kk], bfm[kk], ca, 0, 0, 0);
              *(LAS u32x2*)(lds + (16 * mm + i) * 2048 + (hh * 256 + 32 * wid + 16 * q + 4 * g) * 2) = (u32x2){cvtpk(ca[0], ca[1]), cvtpk(ca[2], ca[3])};
            }
          }
        }
        wg_sync();
      }
#pragma unroll
      for (int c = 0; c < 16; ++c) {
        const u32x4 cr = *(LAS const u32x4*)(lds + row * 2048 + (part * 128 + c * 8) * 2);
#pragma unroll
        for (int e = 0; e < 4; ++e)
          ov[c][e] = cvtpk(__uint_as_float(ov[c][e] << 16) + __uint_as_float(cr[e] << 16), __uint_as_float(ov[c][e] & 0xffff0000u) + __uint_as_float(cr[e] & 0xffff0000u));
      }
      wg_sync();
    }
    float ss = 0.f;
#pragma unroll
    for (int c = 0; c < 16; ++c)
#pragma unroll
      for (int e = 0; e < 4; ++e) { const float lo = __uint_as_float(ov[c][e] << 16), hi = __uint_as_float(ov[c][e] & 0xffff0000u); ss += lo * lo + hi * hi; }
    ss = xsum<1>(ss);
    const float rinv = 1.f / sqrtf(ss * (1.f / 256.f) + LN_EPS);
#pragma unroll
    for (int c = 0; c < 16; ++c) {
      asm volatile("" ::: "memory");
      const int col = part * 128 + c * 8;
      const u32x4 zv = *(const u32x4*)(H1 + (size_t)row * P1 + col);
      const f32x4 g0 = *(const f32x4*)(gn + col), g1 = *(const f32x4*)(gn + col + 4);
      const float gg[8] = {g0[0], g0[1], g0[2], g0[3], g1[0], g1[1], g1[2], g1[3]};
      u32x4 w;
#pragma unroll
      for (int e = 0; e < 4; ++e) {
        const float o0 = __uint_as_float(ov[c][e] << 16), o1 = __uint_as_float(ov[c][e] & 0xffff0000u);
        const float z0 = __uint_as_float(zv[e] << 16), z1 = __uint_as_float(zv[e] & 0xffff0000u);
        w[e] = cvtpk(o0 * rinv * gg[2 * e] * silu_f(z0), o1 * rinv * gg[2 * e + 1] * silu_f(z1));
      }
      *(LAS u32x4*)(lds + row * 2048 + ((((part * 16 + c)) ^ (row & 15)) << 4)) = w;
    }
  }
  wg_sync();
  f32x4 acc[4][8];
#pragma unroll
  for (int m = 0; m < 4; ++m)
#pragma unroll
    for (int nt = 0; nt < 8; ++nt) acc[m][nt] = (f32x4){0.f, 0.f, 0.f, 0.f};
  const bf16_t* wp = Wf + ((size_t)(wid * 8) * 32 * 64 + lane) * 8;
  bf16x8 wf[2][8];
#pragma unroll
  for (int nt = 0; nt < 8; ++nt) wf[0][nt] = *(const bf16x8*)(wp + (size_t)(nt * 32) * 512);
#pragma unroll 1
  for (int ks = 0; ks < 32; ks += 2) {
#pragma unroll
    for (int hf = 0; hf < 2; ++hf) {
      const int kc = ks + hf;
      if (kc + 1 < 32) {
#pragma unroll
        for (int nt = 0; nt < 8; ++nt) wf[hf ^ 1][nt] = *(const bf16x8*)(wp + (size_t)(nt * 32 + kc + 1) * 512);
      }
      bf16x8 xf[4];
#pragma unroll
      for (int m = 0; m < 4; ++m) xf[m] = *(LAS const bf16x8*)(lds + (16 * m + i) * 2048 + (((4 * kc + g) ^ i) << 4));
#pragma unroll
      for (int m = 0; m < 4; ++m)
#pragma unroll
        for (int nt = 0; nt < 8; ++nt) acc[m][nt] = __builtin_amdgcn_mfma_f32_16x16x32_bf16(wf[hf][nt], xf[m], acc[m][nt], 0, 0, 0);
    }
  }
  LAS float* red = (LAS float*)(lds + RG_RED);
  {
  const int tid = otid(), lane = tid & 63, wid = __builtin_amdgcn_readfirstlane(tid >> 6), g = lane >> 4, i = lane & 15; (void)lane;
#pragma unroll
  for (int m = 0; m < 4; ++m) {
    const float* bp = base + (r0 + 16 * m + i) * D_ + wid * 128 + 4 * g;
    f32x4 bv[8];
#pragma unroll
    for (int nt = 0; nt < 8; ++nt) bv[nt] = *(const f32x4*)(bp + 16 * nt);
    float s1 = 0.f, s2 = 0.f;
#pragma unroll
    for (int nt = 0; nt < 8; ++nt) { const f32x4 v = acc[m][nt] + bv[nt] * ALPHA; acc[m][nt] = v; s1 += (v[0] + v[1]) + (v[2] + v[3]); s2 += (v[0] * v[0] + v[1] * v[1]) + (v[2] * v[2] + v[3] * v[3]); }
    s1 = xsum<16>(s1); s1 = xsum<32>(s1); s2 = xsum<16>(s2); s2 = xsum<32>(s2);
    if (g == 0) { red[((16 * m + i) * 8 + wid) * 2] = s1; red[((16 * m + i) * 8 + wid) * 2 + 1] = s2; }
  }
  wg_sync();
#pragma unroll 1
  for (int m = 0; m < 4; ++m) {
    float s1 = 0.f, s2 = 0.f;
#pragma unroll
    for (int w2 = 0; w2 < 8; ++w2) { s1 += red[((16 * m + i) * 8 + w2) * 2]; s2 += red[((16 * m + i) * 8 + w2) * 2 + 1]; }
    const float mean = s1 * (1.f / D_);
    const float var = fmaxf(s2 * (1.f / D_) - mean * mean, 0.f);
    const float rstd = 1.f / sqrtf(var + LN_EPS);
    const size_t off = (r0 + 16 * m + i) * D_ + wid * 128 + 4 * g;
#pragma unroll
    for (int nt = 0; nt < 8; ++nt) {
      const f32x4 gvv = *(const f32x4*)(gam + wid * 128 + 16 * nt + 4 * g), tvv = *(const f32x4*)(bet + wid * 128 + 16 * nt + 4 * g);
      const f32x4 av = m == 0 ? acc[0][nt] : (m == 1 ? acc[1][nt] : (m == 2 ? acc[2][nt] : acc[3][nt]));
      const f32x4 o = (av - mean) * rstd * gvv + tvv;
      *(f32x4*)(out + off + 16 * nt) = o;
      u32x2 w; w[0] = cvtpk(o[0], o[1]); w[1] = cvtpk(o[2], o[3]);
      if (outb) *(u32x2*)(outb + off + 16 * nt) = w;
      if (GLR) { const int row = 16 * m + i, chunk = 16 * wid + 2 * nt + (g >> 1);
        *(LAS u32x2*)(lds + row * 2048 + ((chunk ^ (row & 15)) << 4) + (g & 1) * 8) = w; }
    }
  }
  if (GLR) {
    wg_sync();
    const bf16_t* wg = (const bf16_t*)(P.ws + WS_WT1) + (size_t)(3072 + i) * D_ + 8 * g;
    const int mt = wid & 3, kh = wid >> 2;
    f32x4 a2 = (f32x4){0.f, 0.f, 0.f, 0.f};
#pragma unroll 4
    for (int q = 0; q < 16; ++q) {
      const int kc = kh * 16 + q;
      const bf16x8 wfr = *(const bf16x8*)(wg + 32 * kc);
      const bf16x8 xfr = *(LAS const bf16x8*)(lds + (16 * mt + i) * 2048 + (((4 * kc + g) ^ i) << 4));
      a2 = __builtin_amdgcn_mfma_f32_16x16x32_bf16(wfr, xfr, a2, 0, 0, 0);
    }
    LAS f32x4* r2 = (LAS f32x4*)(lds + RG_RED + 4096);
    if (kh == 1) r2[mt * 64 + lane] = a2;
    wg_sync();
    if (kh == 0) {
      const f32x4 tot = a2 + r2[mt * 64 + lane];
      *(f32x4*)((float*)(P.ws + WS_GLR) + (r0 + 16 * mt + i) * 16 + 4 * g) = tot;
    }
  }
  }
  wg_sync();
}

#define XB_TMO      128
#define XB_XCNT(j)  (256  + 64 * (j))
#define XB_XSUB(j)  (1280 + 64 * (j))
#define XB_XGEN(j)  (2304 + 64 * (j))
#define XB_TOP      3328
#define XB_TOPGEN   3392
#define XCD_BAR_WORDS 3456
#define XB_SPIN_CAP (1u << 18)

__device__ __forceinline__ unsigned xb_ld(unsigned* p)              { return __hip_atomic_load(p, __ATOMIC_RELAXED, __HIP_MEMORY_SCOPE_AGENT); }
__device__ __forceinline__ unsigned xb_add(unsigned* p, unsigned v) { return __hip_atomic_fetch_add(p, v, __ATOMIC_RELAXED, __HIP_MEMORY_SCOPE_AGENT); }
__device__ __forceinline__ unsigned xb_xcc_id() { return (unsigned)__builtin_amdgcn_s_getreg((3 << 11) | 20) & 0xFu; }
#define XB_SPIN(cond, bar) do { unsigned _sp = 0; while (cond) { __builtin_amdgcn_s_sleep(1); \
    if ((++_sp & 255u) == 0u) { if (xb_ld(&(bar)[XB_TMO])) break; if (_sp > XB_SPIN_CAP) { (void)__hip_atomic_fetch_add(&(bar)[XB_TMO], 1u, __ATOMIC_RELAXED, __HIP_MEMORY_SCOPE_AGENT); break; } } } } while (0)

struct XcdBarrier {
    unsigned* bar; unsigned x;
    volatile LAS unsigned* st;
};

__device__ __forceinline__ XcdBarrier xcd_barrier_post(unsigned* bar, volatile LAS unsigned* st) {
    XcdBarrier b; b.bar = bar; b.x = xb_xcc_id(); b.st = st;
    if (threadIdx.x == 0) (void)xb_add(&bar[XB_XCNT(b.x)], 1u);
    return b;
}
__device__ __forceinline__ void xcd_barrier_complete(unsigned* bar, unsigned x, unsigned& nloc, unsigned& nx) {
    const unsigned G = gridDim.x * gridDim.y * gridDim.z;
    unsigned sum, cnt, mine, sp = 0u;
    for (;;) {
        sum = 0u; cnt = 0u; mine = 0u;
#pragma unroll
        for (unsigned j = 0; j < 16; ++j) { const unsigned c = xb_ld(&bar[XB_XCNT(j)]); sum += c; cnt += (c > 0u) ? 1u : 0u; mine = (j == x) ? c : mine; }
        if (sum == G) break;
        __builtin_amdgcn_s_sleep(1);
        if ((++sp & 255u) == 0u) { if (xb_ld(&bar[XB_TMO])) break; if (sp > XB_SPIN_CAP) { (void)__hip_atomic_fetch_add(&bar[XB_TMO], 1u, __ATOMIC_RELAXED, __HIP_MEMORY_SCOPE_AGENT); break; } }
    }
    nloc = mine > 0u ? mine : 1u; nx = cnt > 0u ? cnt : 1u;
}

__device__ __forceinline__ void xcd_barrier(const XcdBarrier& b) {
    asm volatile("s_waitcnt vmcnt(0)" ::: "memory");
    wg_sync();
    if (threadIdx.x == 0) {
        unsigned* bar = b.bar;
        __builtin_amdgcn_s_waitcnt(0);
        unsigned nloc = b.st[0], nx = b.st[1];
        if (nloc == 0u) { xcd_barrier_complete(bar, b.x, nloc, nx); b.st[0] = nloc; b.st[1] = nx; }
        const unsigned old = xb_add(&bar[XB_XSUB(b.x)], 1u);
        const unsigned gen = old / nloc;
        if (old + 1u == (gen + 1u) * nloc) {
            __builtin_amdgcn_fence(__ATOMIC_RELEASE, "agent");
            asm volatile("s_waitcnt vmcnt(0)" ::: "memory");
            const unsigned og = xb_add(&bar[XB_TOP], 1u);
            const unsigned tg = og / nx;
            if (og + 1u == (tg + 1u) * nx) xb_add(&bar[XB_TOPGEN], 1u);
            else XB_SPIN(xb_ld(&bar[XB_TOPGEN]) == tg, bar);
            __builtin_amdgcn_fence(__ATOMIC_ACQUIRE, "agent");
            xb_add(&bar[XB_XGEN(b.x)], 1u);
            asm volatile("s_waitcnt vmcnt(0)" ::: "memory");
        } else {
            XB_SPIN(xb_ld(&bar[XB_XGEN(b.x)]) == gen, bar);
            __builtin_amdgcn_fence(__ATOMIC_ACQUIRE, "agent");
            asm volatile("s_waitcnt vmcnt(0)" ::: "memory");
        }
    }
    wg_sync();
}


__device__ const unsigned short p3_order[1024] = {638,636,634,632,630,628,626,624,15,143,271,399,622,14,142,270,398,620,618,13,141,269,397,616,614,12,140,268,396,612,610,11,139,267,395,608,606,10,138,266,394,604,602,9,137,265,393,560,562,564,566,568,570,572,574,544,546,548,550,552,554,556,558,600,536,538,540,542,534,598,8,136,264,392,532,596,530,594,7,135,263,391,528,592,6,134,262,390,526,590,524,588,5,133,261,389,522,586,520,584,4,132,260,388,518,582,3,131,259,387,516,580,2,130,258,386,514,578,1,129,257,385,512,576,0,128,256,384,639,637,635,633,631,629,627,625,31,159,287,415,623,621,30,158,286,414,619,617,29,157,285,413,615,613,28,156,284,412,611,609,27,155,283,411,607,26,154,282,410,605,603,25,153,281,409,561,563,565,567,569,571,573,575,601,545,547,549,551,553,555,557,559,535,537,539,541,543,599,24,152,280,408,533,597,531,595,23,151,279,407,529,593,527,591,22,150,278,406,525,589,523,587,21,149,277,405,521,585,20,148,276,404,519,583,19,147,275,403,517,581,18,146,274,402,515,579,17,145,273,401,513,577,16,144,272,400,766,764,762,760,758,756,754,752,47,175,303,431,750,46,174,302,430,748,746,45,173,301,429,744,742,44,172,300,428,740,738,43,171,299,427,736,734,42,170,298,426,732,730,41,169,297,425,688,690,692,694,696,698,700,702,672,674,676,678,680,682,684,686,728,664,666,668,670,662,726,40,168,296,424,660,724,658,722,39,167,295,423,656,720,38,166,294,422,654,718,652,716,37,165,293,421,650,714,648,712,36,164,292,420,646,710,35,163,291,419,644,708,34,162,290,418,642,706,33,161,289,417,640,704,32,160,288,416,767,765,763,761,759,757,755,753,63,191,319,447,751,749,62,190,318,446,747,745,61,189,317,445,743,741,60,188,316,444,739,737,59,187,315,443,735,58,186,314,442,733,731,57,185,313,441,689,691,693,695,697,699,701,703,729,673,675,677,679,681,683,685,687,663,665,667,669,671,727,56,184,312,440,661,725,659,723,55,183,311,439,657,721,655,719,54,182,310,438,653,717,651,715,53,181,309,437,649,713,52,180,308,436,647,711,51,179,307,435,645,709,50,178,306,434,643,707,49,177,305,433,641,705,48,176,304,432,894,892,890,888,886,884,882,880,79,207,335,463,878,78,206,334,462,876,874,77,205,333,461,872,870,76,204,332,460,868,866,75,203,331,459,864,862,74,202,330,458,860,858,73,201,329,457,816,818,820,822,824,826,828,830,800,802,804,806,808,810,812,814,856,792,794,796,798,790,854,72,200,328,456,788,852,786,850,71,199,327,455,784,848,70,198,326,454,782,846,780,844,69,197,325,453,778,842,776,840,68,196,324,452,774,838,67,195,323,451,772,836,66,194,322,450,770,834,65,193,321,449,768,832,64,192,320,448,895,893,891,889,887,885,883,881,95,223,351,479,879,877,94,222,350,478,875,873,93,221,349,477,871,869,92,220,348,476,867,865,91,219,347,475,863,90,218,346,474,861,859,89,217,345,473,817,819,821,823,825,827,829,831,857,801,803,805,807,809,811,813,815,791,793,795,797,799,855,88,216,344,472,789,853,787,851,87,215,343,471,785,849,783,847,86,214,342,470,781,845,779,843,85,213,341,469,777,841,84,212,340,468,775,839,83,211,339,467,773,837,82,210,338,466,771,835,81,209,337,465,769,833,80,208,336,464,1022,1020,1018,1016,1014,1012,1010,1008,111,239,367,495,1006,110,238,366,494,1004,1002,109,237,365,493,1000,998,108,236,364,492,996,994,107,235,363,491,992,990,106,234,362,490,988,986,105,233,361,489,944,946,948,950,952,954,956,958,928,930,932,934,936,938,940,942,984,920,922,924,926,918,982,104,232,360,488,916,980,914,978,103,231,359,487,912,976,102,230,358,486,910,974,908,972,101,229,357,485,906,970,904,968,100,228,356,484,902,966,99,227,355,483,900,964,98,226,354,482,898,962,97,225,353,481,896,960,96,224,352,480,1023,1021,1019,1017,1015,1013,1011,1009,127,255,383,511,1007,1005,126,254,382,510,1003,1001,125,253,381,509,999,997,124,252,380,508,995,993,123,251,379,507,991,122,250,378,506,989,987,121,249,377,505,945,947,949,951,953,955,957,959,985,929,931,933,935,937,939,941,943,919,921,923,925,927,983,120,248,376,504,917,981,915,979,119,247,375,503,913,977,911,975,118,246,374,502,909,973,907,971,117,245,373,501,905,969,116,244,372,500,903,967,115,243,371,499,901,965,114,242,370,498,899,963,113,241,369,497,897,961,112,240,368,496};
constexpr int CTL_P3_QUEUE = 8192;
constexpr int CTL_LN0 = 4096, CTL_LN1 = 9216, CTL_TMO = 3520;
constexpr size_t WS_XCH0 = 253 * MiB, WS_XCH1 = 254 * MiB;

#ifndef REP_P0
#define REP_P0 1
#endif
#ifndef REP_P2
#define REP_P2 1
#endif
#ifndef REP_P3
#define REP_P3 1
#endif
#ifndef REP_P7
#define REP_P7 1
#endif
#ifndef REP_P8
#define REP_P8 1
#endif
__global__ void __launch_bounds__(512) __attribute__((target("no-packed-fp32-ops"))) fwd_megakernel(Params P) {
  cg::grid_group grid = cg::this_grid();
  extern __shared__ __attribute__((aligned(16))) unsigned char smem[];
  const int tid = otid(), lane = tid & 63, wid = tid >> 6;
  unsigned char* ws = P.ws;
  bf16_t* XB = (bf16_t*)(ws + WS_XB);
  bf16_t* MIX = (bf16_t*)(ws + WS_MIX);
  bf16_t* Hb = (bf16_t*)(ws + WS_H);
  float* Y = (float*)(ws + WS_H);
  volatile LAS unsigned* xst = (volatile LAS unsigned*)((LAS unsigned char*)smem + XB_LDS_OFF);
  if (tid < 4) xst[tid] = 0u;
  wg_sync();
  (void)xcd_barrier_post((unsigned*)ws, xst);
#define GRID_BAR() do { XcdBarrier xb_; xb_.bar = (unsigned*)P.ws; xb_.x = xb_xcc_id(); xb_.st = (volatile LAS unsigned*)((LAS unsigned char*)smem + XB_LDS_OFF); xcd_barrier(xb_); } while (0)

  for (int rep = 0; rep < REP_P0; ++rep) {
    const float4* x4 = (const float4*)P.in[0];
    const size_t n4 = (size_t)M_ * D_ / 4;
    {
      const size_t stride = (size_t)gridDim.x * 512;
      for (size_t i = (size_t)blockIdx.x * 512 + tid; i < n4; i += 8 * stride) {
        float4 v[8];
#pragma unroll
        for (int u = 0; u < 8; ++u) if (i + u * stride < n4) v[u] = x4[i + u * stride];
#pragma unroll
        for (int u = 0; u < 8; ++u) if (i + u * stride < n4) { ushort4 o; o.x = f2bf(v[u].x); o.y = f2bf(v[u].y); o.z = f2bf(v[u].z); o.w = f2bf(v[u].w); ((ushort4*)XB)[i + u * stride] = o; }
      }
    }
    {
      constexpr int T0 = (P0 / 32) * 16, T1 = 32 * 16, T2 = (P1 / 32) * 16, T3 = 32 * 16, T4 = 2 * 4 * 32, T5 = 2 * 2 * 2;
      float* scr = (float*)smem + wid * (64 * 33);
      for (int it = blockIdx.x * 8 + wid; it < T0 + T1 + T2 + T3 + T4 + T5; it += gridDim.x * 8) {
        int r = it;
        if (r < T0) { transpose_wave_tile(P.in[1], D_, EVEN_IN, (bf16_t*)(ws + WS_WT0), 0, r, P0 / 32, scr, lane); continue; } r -= T0;
        if (r < T1) { transpose_wave_tile(P.in[6], D_, D_, (bf16_t*)(ws + WS_WO0), 3, r, 32, scr, lane); continue; } r -= T1;
        if (r < T2) { transpose_wave_tile(P.in[9], D_, ODD_IN, (bf16_t*)(ws + WS_WT1), 1, r, P1 / 32, scr, lane); continue; } r -= T2;
        if (r < T3) { transpose_wave_tile(P.in[13], D_, D_, (bf16_t*)(ws + WS_WO1), 3, r, 32, scr, lane); continue; } r -= T3;
        if (r < T4) { const int i = r >> 7; transpose_wave_tile(P.in[3] + (size_t)i * 2048 * 128, 2048, 128, (bf16_t*)(ws + WS_W1T) + (size_t)i * 128 * 2048, 2, r & 127, 4, scr, lane); continue; } r -= T4;
        { const int i = r >> 2; transpose_wave_tile(P.in[5] + (size_t)i * 128 * 64, 128, 64, (bf16_t*)(ws + WS_W2T) + (size_t)i * 64 * 128, 2, r & 3, 2, scr, lane); }
      }
      wg_sync();
    }
    for (int it = blockIdx.x + 132; it < 2 * 64 + 2 * 2 + 64; it += gridDim.x) {
      {
        const int t2 = it - 132, i = t2 >> 5, q = t2 & 31, hh = tid & 127, sub = tid >> 7;
        const float* pos = P.in[2] + i * 2048 + q * 64 + sub * 16;
        const float* w1 = P.in[3] + ((size_t)i * 2048 + q * 64 + sub * 16) * 128 + hh;
        float a = 0.f;
#pragma unroll
        for (int f = 0; f < 16; ++f) a += pos[f] * w1[f * 128];
        float* red = (float*)smem;
        red[sub * 128 + hh] = a;
        wg_sync();
        if (tid < 128) ((float*)(ws + WS_C1P))[(i * 32 + q) * 128 + tid] = (red[tid] + red[128 + tid]) + (red[256 + tid] + red[384 + tid]);
        wg_sync();
      }
    }
    for (int q = blockIdx.x * 512 + tid; q < B_ * 16 * 512; q += gridDim.x * 512) ((float*)(ws + WS_KM))[q] = 0.f;
    if (blockIdx.x == 0) { const int which = tid >> 8, r = tid & 255;
      unsigned* z = (unsigned*)(ws + (which == 0 ? (size_t)(248 * MiB) : (size_t)(249 * MiB)));
      const int bg = r >> 5, wd = r & 31; z[((size_t)bg * 256 + 255) * 32 + wd] = 0u; }
    GRID_BAR();
  }
  if (P.out == nullptr) grid.sync();
  { pg8::Gemm gm{XB, (const bf16_t*)(ws + WS_WT0), M_, P0, D_}; pg8::StaticOrder so; so.init(M_, P0, (int)gridDim.x, (int)blockIdx.x);
    pg8::EpiBf16s ep{Hb, P0, (3u << (C_NQ / 256)) | (3u << (C_MQ / 256)), C1, (float*)(ws + WS_KM), C_MK / 256}; pg8::gemm_phase<pg8::EpiBf16s, pg8::StaticOrder, true, true>((LAS unsigned char*)smem, gm, so, ep); }
  GRID_BAR();
  for (int rep = 0; rep < REP_P2; ++rep) {
    for (int it = blockIdx.x; it < 256; it += gridDim.x) compress_mfma_tile(P, it, smem);
    GRID_BAR();
  }
  for (int rep = 0; rep < REP_P3; ++rep) {
    const int myx = (int)(xb_xcc_id() & 7u);
    int steal = 0;
    for (;;) {
      LAS int* qslot = (LAS int*)((LAS unsigned char*)smem + AT_MISC + 384);
      const int qx = (myx + steal) & 7;
      if (tid == 0) *qslot = (int)__hip_atomic_fetch_add((unsigned*)P.ws + CTL_P3_QUEUE + 64 * qx, 1u, __ATOMIC_RELAXED, __HIP_MEMORY_SCOPE_AGENT) - rep * 128;
      wg_sync();
      int it = __builtin_amdgcn_readfirstlane(*qslot);
      wg_sync();
      if (it >= 128) { if (++steal == 8) break; continue; }
      it += qx * 128;
      const int e = p3_order[it], pl = e & 511;
#ifdef FORCE_SAFE
      if (e >> 9) (void)nsa_mfma_item<true>(P, pl >> 7, (pl >> 6) & 1, pl & 63, smem);
      else (void)moba_mfma_item<true>(P, pl >> 7, (pl >> 4) & 7, pl & 15, smem);
#else
      if (e >> 9) { if (nsa_mfma_item<false>(P, pl >> 7, (pl >> 6) & 1, pl & 63, smem)) (void)nsa_mfma_item<true>(P, pl >> 7, (pl >> 6) & 1, pl & 63, smem); }
      else { if (moba_mfma_item<false>(P, pl >> 7, (pl >> 4) & 7, pl & 15, smem)) (void)moba_mfma_item<true>(P, pl >> 7, (pl >> 4) & 7, pl & 15, smem); }
#endif
    }
    GRID_BAR();
  }
  if ((int)blockIdx.x < M_ / 64) rowgemm_block<0, true>(P, (int)blockIdx.x, (const bf16_t*)(ws + WS_WO0), P.in[0], P.out, XB, P.in[7], P.in[8], smem);
  GRID_BAR();
  { pg8::Gemm gm{XB, (const bf16_t*)(ws + WS_WT1), M_, 3072, D_}; pg8::StaticOrder so; so.init(M_, 3072, (int)gridDim.x, (int)blockIdx.x);
    pg8::EpiBf16s ep{Hb, P1, 0u, 1.f, nullptr, 0}; pg8::gemm_phase<pg8::EpiBf16s, pg8::StaticOrder, true, true>((LAS unsigned char*)smem, gm, so, ep); }
  GRID_BAR();
  for (int rep = 0; rep < REP_P8; ++rep) {
    { const int j = (int)blockIdx.x; if (j < 256) gla_prep_item(P, (j & 15) * 64 + ((j >> 4) & 1) * 32 + (j >> 5), smem); }
    if ((int)blockIdx.x < 128) { const int w = (int)blockIdx.x, u = w >> 3, bh = (w & 7) + 8 * (u >> 3), eq = u & 3, seg = (u >> 2) & 1;
      gla_chain64(P, bh * 4 + eq, seg, smem); }
    else for (int j = 256 + (int)blockIdx.x - 128; j < 1024; j += 128) gla_prep_item(P, (j & 15) * 64 + ((j >> 4) & 1) * 32 + (j >> 5), smem);
    GRID_BAR();
  }
  if ((int)blockIdx.x < M_ / 64) rowgemm_block<1, false>(P, (int)blockIdx.x, (const bf16_t*)(ws + WS_WO1), P.out, P.out, nullptr, P.in[14], P.in[15], smem);
}

extern "C" void kernel_launch(void* const* d_in, const int* in_sizes, int n_in, void* d_out, int out_size,
                              void* d_ws, size_t ws_size, hipStream_t stream) {
  constexpr size_t kDynLds = 157696;
  static_assert((size_t)XB_LDS_OFF >= (size_t)G4_END && kDynLds <= 163840 && kDynLds >= (size_t)XB_LDS_OFF + 16 && (size_t)XB_LDS_OFF >= (size_t)AT_LDS_END && kDynLds >= (size_t)AT_LDS_END && kDynLds >= 2 * (size_t)GS_BYTES && kDynLds >= (size_t)pg8::STAGE_BYTES, "LDS");
  static int grid_blocks = 0;
  if (!grid_blocks) {
    int dev = 0, cus = 0, per_cu = 0;
    (void)hipGetDevice(&dev);
    (void)hipDeviceGetAttribute(&cus, hipDeviceAttributeMultiprocessorCount, dev);
    (void)hipFuncSetAttribute((const void*)fwd_megakernel, hipFuncAttributeMaxDynamicSharedMemorySize, (int)kDynLds);
    (void)hipOccupancyMaxActiveBlocksPerMultiprocessor(&per_cu, fwd_megakernel, 512, kDynLds);
    if (per_cu < 1) per_cu = 1;
    if (per_cu > 2) per_cu = 2;
    grid_blocks = cus * per_cu;
    if (grid_blocks != 256) { fprintf(stderr, "kernel_launch: this kernel is laid out for exactly 256 co-resident workgroups (256 CUs x 1); got %d x %d\n", cus, per_cu); grid_blocks = 256; }
    if (n_in != 16 || ws_size < WS_END) { fprintf(stderr, "kernel_launch: unexpected n_in %d / ws %zu\n", n_in, ws_size); }
  }
  (void)hipMemsetAsync(d_ws, 0, 524288, stream);
  Params p{};
  for (int i = 0; i < 16; ++i) p.in[i] = (const float*)d_in[i];
  p.out = (float*)d_out; p.ws = (unsigned char*)d_ws;
  void* args[] = {&p};
  hipError_t e = hipLaunchCooperativeKernel((void*)fwd_megakernel, dim3(grid_blocks), dim3(512), args, kDynLds, stream);
  if (e != hipSuccess) fprintf(stderr, "cooperative launch failed: %s (grid %d)\n", hipGetErrorString(e), grid_blocks);
}
```

```cpp
#include <hip/hip_runtime.h>
#include <hip/hip_cooperative_groups.h>
#include <cstdio>
#include <cstdint>
namespace cg = cooperative_groups;

typedef unsigned short bf16_t;
typedef short bf16x8 __attribute__((ext_vector_type(8)));
typedef float f32x4 __attribute__((ext_vector_type(4)));
typedef unsigned u32x4 __attribute__((ext_vector_type(4)));
typedef unsigned u32x2 __attribute__((ext_vector_type(2)));

constexpr int B_ = 4, S_ = 4096, M_ = B_ * S_, D_ = 1024;
constexpr int P0 = 4096;
constexpr int P1 = 3328;
constexpr int EVEN_IN = 3864, ODD_IN = 3088;
constexpr int C_NQ = 0, C_KCMP = 512, C_VCMP = 640, C_KSEL = 768, C_VSEL = 896, C_KWIN = 1024, C_VWIN = 1152;
constexpr int C_NZ = 1280, C_MQ = 1792, C_MK = 2304, C_MV = 2816, C_MZ = 3328, C_NG = 3840;
constexpr int G_Q = 0, G_K = 512, G_V = 1024, G_Z = 2048, G_LR = 3072;
constexpr int NCMP = 255;
constexpr float ALPHA = 1.4142135623730951f;
constexpr float LN_EPS = 1e-5f;

constexpr size_t MiB = 1u << 20;
constexpr int XB_LDS_OFF = 157440;
constexpr size_t WS_WT0 = 1 * MiB;
constexpr size_t WS_WO0 = 9 * MiB;
constexpr size_t WS_WT1 = 11 * MiB;
constexpr size_t WS_WO1 = 18 * MiB;
constexpr size_t WS_XB = 20 * MiB;
constexpr size_t WS_MIX = 52 * MiB;
constexpr size_t WS_H = 84 * MiB;
constexpr size_t WS_G = 212 * MiB;
constexpr size_t WS_GLR = 245 * MiB;
constexpr size_t WS_SMT = 246 * MiB;
constexpr size_t WS_KC = 245 * MiB;
constexpr size_t WS_VC = 246 * MiB;
constexpr size_t WS_KM = 247 * MiB;
constexpr size_t WS_END = 256 * MiB;

struct Params { const float* in[16]; float* out; unsigned char* ws; };

__device__ __forceinline__ int otid() { int t = __builtin_amdgcn_workitem_id_x(); asm volatile("" : "+v"(t)); return t; }
__device__ __forceinline__ void wg_sync() { __builtin_amdgcn_fence(__ATOMIC_RELEASE, "workgroup"); __builtin_amdgcn_s_barrier(); __builtin_amdgcn_fence(__ATOMIC_ACQUIRE, "workgroup"); }
__device__ __forceinline__ float bf2f(bf16_t v) { return __uint_as_float(((unsigned)v) << 16); }
__device__ __forceinline__ bf16_t f2bf(float f) { unsigned u = __float_as_uint(f); return (bf16_t)((u + 0x7fffu + ((u >> 16) & 1u)) >> 16); }
template <int M> __device__ __forceinline__ float xsum(float v) {
  if constexpr (M == 32) { auto rr = __builtin_amdgcn_permlane32_swap(__float_as_uint(v), __float_as_uint(v), false, false); return __uint_as_float(rr[0]) + __uint_as_float(rr[1]); }
  else return v + __int_as_float(__builtin_amdgcn_ds_swizzle(__float_as_int(v), (M << 10) | 0x1f));
}
template <int M> __device__ __forceinline__ float xmax(float v) {
  if constexpr (M == 32) { auto rr = __builtin_amdgcn_permlane32_swap(__float_as_uint(v), __float_as_uint(v), false, false); return fmaxf(__uint_as_float(rr[0]), __uint_as_float(rr[1])); }
  else return fmaxf(v, __int_as_float(__builtin_amdgcn_ds_swizzle(__float_as_int(v), (M << 10) | 0x1f)));
}
template <int M> __device__ __forceinline__ unsigned xorr(unsigned v) {
  if constexpr (M == 32) { auto rr = __builtin_amdgcn_permlane32_swap(v, v, false, false); return rr[0] | rr[1]; }
  else return v | (unsigned)__builtin_amdgcn_ds_swizzle((int)v, (M << 10) | 0x1f);
}
__device__ __forceinline__ float wave_sum(float v) { v = xsum<1>(v); v = xsum<2>(v); v = xsum<4>(v); v = xsum<8>(v); v = xsum<16>(v); return xsum<32>(v); }
__device__ __forceinline__ float wave_max(float v) { v = xmax<1>(v); v = xmax<2>(v); v = xmax<4>(v); v = xmax<8>(v); v = xmax<16>(v); return xmax<32>(v); }
__device__ __forceinline__ float silu_f(float z) { return z / (1.f + __expf(-z)); }
__device__ __forceinline__ float sigmoid_f(float z) { return 1.f / (1.f + __expf(-z)); }

__device__ __forceinline__ int colmap0(int c) {
  if (c < 1280) return c;
  if (c < 1792) return 1304 + (c - 1280);
  if (c < 3840) return 1816 + (c - 1792);
  if (c < 3864) return 1280 + (c - 3840);
  return -1;
}
__device__ __forceinline__ int colmap1(int c) {
  if (c < 2048) return c;
  if (c < 3072) return 2064 + (c - 2048);
  if (c < 3088) return 2048 + (c - 3072);
  return -1;
}

__device__ __forceinline__ void transpose_tile(const float* __restrict__ W, int K, int Nsrc, bf16_t* __restrict__ Wt, int which, int tile, int ntn, float* sm) {
  const int tid = otid();
  const int nb = tile % ntn, kb = tile / ntn, n0 = nb * 64, k0 = kb * 64;
#pragma unroll
  for (int i = 0; i < 8; ++i) {
    const int kk = i * 8 + (tid >> 6), nn = tid & 63;
    const int c = n0 + nn;
    const int src = which == 0 ? colmap0(c) : (which == 1 ? colmap1(c) : c);
    sm[kk * 65 + nn] = src >= 0 ? W[(size_t)(k0 + kk) * Nsrc + src] : 0.f;
  }
  wg_sync();
#pragma unroll
  for (int i = 0; i < 8; ++i) {
    const int nn = i * 8 + (tid >> 6), kk = tid & 63;
    Wt[(size_t)(n0 + nn) * K + k0 + kk] = f2bf(sm[kk * 65 + nn]);
  }
  wg_sync();
}


__device__ __forceinline__ void transpose_wave_tile(const float* __restrict__ W, int K, int Nsrc, bf16_t* __restrict__ Wt, int which, int tile, int ntn, float* scr, int lane) {
  const int nb = tile % ntn, kb = tile / ntn, n0 = nb * 32, k0 = kb * 64;
  const int c = n0 + (lane & 31);
  const int src = which == 0 ? colmap0(c) : (which == 1 ? colmap1(c) : c);
  float v[32];
#pragma unroll
  for (int q = 0; q < 32; ++q) { const int kk = 2 * q + (lane >> 5); v[q] = src >= 0 ? W[(size_t)(k0 + kk) * Nsrc + src] : 0.f; }
#pragma unroll
  for (int q = 0; q < 32; ++q) { const int kk = 2 * q + (lane >> 5); scr[kk * 33 + (lane & 31)] = v[q]; }
  __builtin_amdgcn_wave_barrier();
  if (which == 3) {
    const int k = k0 + lane;
#pragma unroll 8
    for (int nn = 0; nn < 32; ++nn) { const int n = n0 + nn; Wt[((size_t)(((n >> 4) * 32 + (k >> 5)) * 64 + ((k >> 3) & 3) * 16 + (n & 15))) * 8 + (k & 7)] = f2bf(scr[lane * 33 + nn]); }
  } else {
#pragma unroll 8
    for (int nn = 0; nn < 32; ++nn) Wt[(size_t)(n0 + nn) * K + k0 + lane] = f2bf(scr[lane * 33 + nn]);
  }
  __builtin_amdgcn_wave_barrier();
}

__device__ __forceinline__ void gemm_tile(const bf16_t* __restrict__ A, const bf16_t* __restrict__ Bt, int K, int m0, int n0, int mode, void* outp, int ldc, unsigned char* smem) {
  bf16_t* As = (bf16_t*)smem;
  bf16_t* Bs = As + 128 * 72;
  const int tid = otid(), lane = tid & 63, wid = tid >> 6, wm = wid >> 1, wn = wid & 1;
  f32x4 acc[2][4];
#pragma unroll
  for (int i = 0; i < 2; ++i)
#pragma unroll
    for (int j = 0; j < 4; ++j) acc[i][j] = (f32x4){0.f, 0.f, 0.f, 0.f};
  for (int k0 = 0; k0 < K; k0 += 64) {
#pragma unroll
    for (int i = 0; i < 2; ++i) {
      const int idx = tid + i * 512, r = idx >> 3, c = (idx & 7) * 8;
      *(uint4*)(As + r * 72 + c) = *(const uint4*)(A + (size_t)(m0 + r) * K + k0 + c);
      *(uint4*)(Bs + r * 72 + c) = *(const uint4*)(Bt + (size_t)(n0 + r) * K + k0 + c);
    }
    wg_sync();
#pragma unroll
    for (int kk = 0; kk < 64; kk += 32) {
      bf16x8 a[2], b[4];
#pragma unroll
      for (int i = 0; i < 2; ++i) a[i] = *(const bf16x8*)(As + (wm * 32 + i * 16 + (lane & 15)) * 72 + kk + (lane >> 4) * 8);
#pragma unroll
      for (int j = 0; j < 4; ++j) b[j] = *(const bf16x8*)(Bs + (wn * 64 + j * 16 + (lane & 15)) * 72 + kk + (lane >> 4) * 8);
#pragma unroll
      for (int i = 0; i < 2; ++i)
#pragma unroll
        for (int j = 0; j < 4; ++j) acc[i][j] = __builtin_amdgcn_mfma_f32_16x16x32_bf16(a[i], b[j], acc[i][j], 0, 0, 0);
    }
    wg_sync();
  }
#pragma unroll
  for (int i = 0; i < 2; ++i)
#pragma unroll
    for (int j = 0; j < 4; ++j)
#pragma unroll
      for (int r = 0; r < 4; ++r) {
        const int row = m0 + wm * 32 + i * 16 + (lane >> 4) * 4 + r, col = n0 + wn * 64 + j * 16 + (lane & 15);
        if (mode == 0) ((bf16_t*)outp)[(size_t)row * ldc + col] = f2bf(acc[i][j][r]);
        else ((float*)outp)[(size_t)row * ldc + col] = acc[i][j][r];
      }
}
__device__ __forceinline__ void gemm_phase(const bf16_t* A, const bf16_t* Bt, int K, int N, int mode, void* outp, int ldc, unsigned char* smem) {
  const int ntn = N / 128, ntm = M_ / 128;
  for (int t = blockIdx.x; t < ntn * ntm; t += gridDim.x) {
    const int tn = t % ntn, tm = t / ntn;
    gemm_tile(A, Bt, K, tm * 128, tn * 128, mode, outp, ldc, smem);
  }
}

namespace pg8 {
#define PG8_LAS __attribute__((address_space(3)))
typedef unsigned short bf16_t;
typedef short bf16x8 __attribute__((ext_vector_type(8)));
typedef float f32x4 __attribute__((ext_vector_type(4)));
typedef unsigned u32x4 __attribute__((ext_vector_type(4)));
constexpr int BM = 256, BK = 64, HALF = 128, HTB = HALF * BK * 2  , STAGE_BYTES = 8 * HTB, NXCD = 8, WGM = 8;

__host__ __device__ __forceinline__ int lds_byte(int r, int c) { const int st = (r >> 4) * 2 + (c >> 5), rr = r & 15, cc = c & 31, ob = rr * 64 + cc * 2; return st * 1024 + (ob ^ (((ob >> 9) & 1) << 5)); }
__host__ __device__ __forceinline__ void stage_rc(int b, int& R, int& C) { const int st = b / 1024, sb = b % 1024, swz = sb ^ (((sb >> 9) & 1) << 5); R = (st >> 1) * 16 + swz / 64; C = (st & 1) * 32 + (swz % 64) / 2; }
__host__ __device__ __forceinline__ int perm32(int rho) { const int n = rho >> 4, i = rho & 15; return 8 * (i >> 2) + 4 * n + (i & 3); }

__device__ __forceinline__ unsigned cvtpk(float lo, float hi) { typedef float f2 __attribute__((ext_vector_type(2))); typedef __bf16 b2 __attribute__((ext_vector_type(2))); f2 v = {lo, hi}; b2 b = __builtin_convertvector(v, b2); return __builtin_bit_cast(unsigned, b); }
template <int M> __device__ __forceinline__ float xsum_sw(float v) { return v + __int_as_float(__builtin_amdgcn_ds_swizzle(__float_as_int(v), (M << 10) | 0x1f)); }
struct Unit { int pm, pn; };
struct Gemm { const bf16_t* A; const bf16_t* Bt; int M, N, K; };

struct StaticOrder {
    int nM, nN, nwg, G, c;
    __host__ __device__ __forceinline__ void init(int M, int N, int G_, int c_) { nM = M / BM; nN = N / BM; nwg = nM * nN; G = G_; c = c_; }
    __host__ __device__ bool next(int i, Unit& u) const {
        const long L = (long)i * G + c; if (L >= nwg) return false;
        int wgid = (int)L; { const int q = nwg / NXCD, r = nwg % NXCD, xcd = wgid % NXCD, off = wgid / NXCD; wgid = (xcd < r ? xcd * (q + 1) : r * (q + 1) + (xcd - r) * q) + off; }
        const int nig = WGM * nN, gid = wgid / nig, fm = gid * WGM, gsz = (nM - fm) < WGM ? (nM - fm) : WGM;
        u.pm = fm + ((wgid % nig) % gsz); u.pn = (wgid % nig) / gsz; return true;
    }
    __device__ __forceinline__ void a_ready(const Unit&) const {}
    __device__ __forceinline__ void done(const Unit&) const {}
};


struct EpiBf16s {
    static constexpr bool PERM = true, AFTER_DRAIN = false;
    bf16_t* O; int ldc;
    unsigned qmask; float qscale;
    float* km; int km_pn0;
    __device__ __forceinline__ void operator()(const f32x4 (&acc)[2][2][4][2], const Unit& u, int wr, int wc, int fr, int fq) const {
        const int row0 = u.pm * BM + wr * 64 + fr, col0 = u.pn * BM + wc * 32 + 8 * fq;
        const float sc = ((qmask >> u.pn) & 1u) ? qscale : 1.f;
#pragma unroll
        for (int ai = 0; ai < 2; ++ai)
#pragma unroll
            for (int m = 0; m < 4; ++m) { bf16_t* rowp = O + (size_t)(row0 + ai * HALF + m * 16) * ldc + col0;
#pragma unroll
                for (int bj = 0; bj < 2; ++bj) { const f32x4 v0 = acc[ai][bj][m][0] * sc, v1 = acc[ai][bj][m][1] * sc;
                    u32x4 w; w.x = cvtpk(v0[0], v0[1]); w.y = cvtpk(v0[2], v0[3]); w.z = cvtpk(v1[0], v1[1]); w.w = cvtpk(v1[2], v1[3]);
                    *(u32x4*)(rowp + bj * HALF) = w; } }
        if (km != nullptr && (u.pn == km_pn0 || u.pn == km_pn0 + 1)) {
#pragma unroll
            for (int bj = 0; bj < 2; ++bj)
#pragma unroll
                for (int n = 0; n < 2; ++n) {
                    f32x4 sacc = (f32x4){0.f, 0.f, 0.f, 0.f};
#pragma unroll
                    for (int ai = 0; ai < 2; ++ai)
#pragma unroll
                        for (int m = 0; m < 4; ++m) sacc += acc[ai][bj][m][n];
#pragma unroll
                    for (int e = 0; e < 4; ++e) { float v = sacc[e]; v = xsum_sw<1>(v); v = xsum_sw<2>(v); v = xsum_sw<4>(v); v = xsum_sw<8>(v); sacc[e] = v; }
                    if (fr == 0) { float* dst = km + (size_t)u.pm * 512 + (u.pn - km_pn0) * BM + bj * HALF + wc * 32 + 8 * fq + 4 * n;
#pragma unroll
                        for (int e = 0; e < 4; ++e) atomicAdd(dst + e, sacc[e] * (1.0f / 256.0f)); }
                }
        }
    }
};
struct EpiF32 {
    static constexpr bool PERM = false, AFTER_DRAIN = false;
    float* O; int ldc;
    __device__ __forceinline__ void operator()(const f32x4 (&acc)[2][2][4][2], const Unit& u, int wr, int wc, int fr, int fq) const {
        const int col0 = u.pn * BM + wc * 32 + 4 * fq;
#pragma unroll
        for (int ai = 0; ai < 2; ++ai)
#pragma unroll
            for (int m = 0; m < 4; ++m) { float* rowp = O + (size_t)(u.pm * BM + ai * HALF + wr * 64 + m * 16 + fr) * ldc + col0;
#pragma unroll
                for (int bj = 0; bj < 2; ++bj)
#pragma unroll
                    for (int n = 0; n < 2; ++n) *(f32x4*)(rowp + bj * HALF + n * 16) = acc[ai][bj][m][n]; }
    }
};

struct PanelStats {
    unsigned* xbuf;
    unsigned* cnt;
    unsigned* tmo;
    int ntn; float eps;
    unsigned code;
    __device__ __forceinline__ bool run(const f32x4 (&v)[2][2][4][2], const Unit& u, int wr, int wc, int fr, int fq, PG8_LAS unsigned char* lds, int wid, int lane) const {
        typedef float f32x2v __attribute__((ext_vector_type(2)));
        PG8_LAS f32x2v* P = (PG8_LAS f32x2v*)lds;
        PG8_LAS f32x2v* S = (PG8_LAS f32x2v*)(lds + 8192);
        PG8_LAS unsigned* flag = (PG8_LAS unsigned*)(lds + 8192 + 2048);
#pragma unroll
        for (int ai = 0; ai < 2; ++ai)
#pragma unroll
            for (int m = 0; m < 4; ++m) {
                float s = 0.f;
#pragma unroll
                for (int bj = 0; bj < 2; ++bj)
#pragma unroll
                    for (int n = 0; n < 2; ++n) { const f32x4 x = v[ai][bj][m][n]; s += (x[0] + x[1]) + (x[2] + x[3]); }
                s += __shfl_xor(s, 16); s += __shfl_xor(s, 32);
                const float mw = s * (1.0f / 64.0f); float q = 0.f;
#pragma unroll
                for (int bj = 0; bj < 2; ++bj)
#pragma unroll
                    for (int n = 0; n < 2; ++n) { const f32x4 d = v[ai][bj][m][n] - mw; q += (d[0] * d[0] + d[1] * d[1]) + (d[2] * d[2] + d[3] * d[3]); }
                q += __shfl_xor(q, 16); q += __shfl_xor(q, 32);
                if (fq == 0) P[(ai * HALF + wr * 64 + m * 16 + fr) * 4 + wc] = (f32x2v){mw, q};
            }
        asm volatile("s_waitcnt lgkmcnt(0)" ::: "memory"); __builtin_amdgcn_s_barrier(); asm volatile("" ::: "memory");
#if defined(BROKEN_EXCHANGE_NO_WAIT)
#warning BROKEN CONTROL BUILD: the row-statistics exchange does not wait; results are wrong by design
        if (blockIdx.x >= 64) { const long long t0_ = clock64(); while (clock64() - t0_ < 60000) __builtin_amdgcn_s_sleep(8); }
#endif
        const int row = wid * 32 + (lane & 31);
        if (lane < 32) {
            const f32x2v a = P[row * 4 + 0], b = P[row * 4 + 1], c = P[row * 4 + 2], d = P[row * 4 + 3];
            const float mt = (a.x + b.x + c.x + d.x) * 0.25f;
            const float da = a.x - mt, db = b.x - mt, dc = c.x - mt, dd = d.x - mt;
            const float m2 = (a.y + b.y) + (c.y + d.y) + 64.0f * ((da * da + db * db) + (dc * dc + dd * dd));
            unsigned long long* slot = (unsigned long long*)xbuf + ((size_t)(u.pm * BM + row) * 4 + u.pn);
            __hip_atomic_store(slot, ((unsigned long long)__float_as_uint(m2) << 32) | __float_as_uint(mt), __ATOMIC_RELAXED, __HIP_MEMORY_SCOPE_AGENT);
        }
        asm volatile("s_waitcnt vmcnt(0)" ::: "memory");
        if (lane == 0) __hip_atomic_fetch_add(cnt + 64 * u.pm, 1u, __ATOMIC_RELAXED, __HIP_MEMORY_SCOPE_AGENT);
        if (wid == 0) {
            bool dead = false; const unsigned long long t0 = __builtin_amdgcn_s_memrealtime(); const unsigned want = 8u * (unsigned)ntn;
            for (;;) {
#if defined(BROKEN_EXCHANGE_NO_WAIT)
                break;
#endif
                if ((unsigned)__builtin_amdgcn_readfirstlane(__hip_atomic_load(cnt + 64 * u.pm, __ATOMIC_RELAXED, __HIP_MEMORY_SCOPE_AGENT)) >= want) break;
                if (__builtin_amdgcn_s_memrealtime() - t0 > 2000000ull) {
                    if (lane == 0) { unsigned expect = 0u; __hip_atomic_compare_exchange_strong(tmo + 1, &expect, code | (unsigned)(u.pm & 0xff), __ATOMIC_RELAXED, __ATOMIC_RELAXED, __HIP_MEMORY_SCOPE_AGENT);
                                     __hip_atomic_store(tmo, 1u, __ATOMIC_RELAXED, __HIP_MEMORY_SCOPE_AGENT); }
                    dead = true; break; }
                __builtin_amdgcn_s_sleep(2);
            }
            __builtin_amdgcn_fence(__ATOMIC_ACQUIRE, "agent");
            if (lane == 0) flag[0] = dead ? 1u : 0u;
        }
        asm volatile("s_waitcnt vmcnt(0) lgkmcnt(0)" ::: "memory"); __builtin_amdgcn_s_barrier(); asm volatile("" ::: "memory");
        const bool bad = flag[0] != 0u;
        if (lane < 32) {
            const unsigned long long* slot = (const unsigned long long*)xbuf + (size_t)(u.pm * BM + row) * 4; float mt[4], m2[4]; float ms = 0.f;
#pragma unroll
            for (int t = 0; t < 4; ++t) { if (t < ntn) { const unsigned long long w = __hip_atomic_load(slot + t, __ATOMIC_RELAXED, __HIP_MEMORY_SCOPE_AGENT); mt[t] = __uint_as_float((unsigned)w); m2[t] = __uint_as_float((unsigned)(w >> 32)); } else { mt[t] = 0.f; m2[t] = 0.f; } ms += mt[t]; }
            const float mean = ms / (float)ntn; float q = 0.f;
#pragma unroll
            for (int t = 0; t < 4; ++t) if (t < ntn) { const float dm = mt[t] - mean; q += m2[t] + 256.0f * dm * dm; }
            S[row] = (f32x2v){mean, 1.0f / sqrtf(q / (256.0f * (float)ntn) + eps)};
        }
        asm volatile("s_waitcnt lgkmcnt(0)" ::: "memory"); __builtin_amdgcn_s_barrier(); asm volatile("" ::: "memory");
        return bad;
    }
};

struct EpiLn {
    static constexpr bool PERM = false, AFTER_DRAIN = true;
    const float* base; float* out; bf16_t* outb; int ldc; const float* gam; const float* bet; PanelStats st; float alpha;
    __device__ __forceinline__ void fused(f32x4 (&acc)[2][2][4][2], const Unit& u, int wr, int wc, int fr, int fq, PG8_LAS unsigned char* lds, int wid, int lane) const {
        typedef float f32x2v __attribute__((ext_vector_type(2))); typedef unsigned u32x2v __attribute__((ext_vector_type(2)));
        const PG8_LAS f32x2v* S = (const PG8_LAS f32x2v*)(lds + 8192);
        const int col0 = u.pn * BM + wc * 32 + 4 * fq;
#pragma unroll
        for (int ai = 0; ai < 2; ++ai) {
            f32x4 bs[4][2][2];
#pragma unroll
            for (int m = 0; m < 4; ++m) { const size_t off = (size_t)(u.pm * BM + ai * HALF + wr * 64 + m * 16 + fr) * ldc + col0;
#pragma unroll
                for (int bj = 0; bj < 2; ++bj)
#pragma unroll
                    for (int n = 0; n < 2; ++n) bs[m][bj][n] = *(const f32x4*)(base + off + bj * HALF + n * 16); }
#pragma unroll
            for (int m = 0; m < 4; ++m) {
#pragma unroll
                for (int bj = 0; bj < 2; ++bj)
#pragma unroll
                    for (int n = 0; n < 2; ++n) acc[ai][bj][m][n] += bs[m][bj][n] * alpha;
                asm volatile("" : "+v"(acc[ai][0][m][0]), "+v"(acc[ai][0][m][1]), "+v"(acc[ai][1][m][0]), "+v"(acc[ai][1][m][1])); }
            asm volatile("" ::: "memory"); }
        const bool bad = st.run(acc, u, wr, wc, fr, fq, lds, wid, lane);
        const float qnan = __builtin_nanf("");
        f32x4 gv[2][2], bv[2][2];
#pragma unroll
        for (int bj = 0; bj < 2; ++bj)
#pragma unroll
            for (int n = 0; n < 2; ++n) { gv[bj][n] = *(const f32x4*)(gam + col0 + bj * HALF + n * 16); bv[bj][n] = *(const f32x4*)(bet + col0 + bj * HALF + n * 16); }
#pragma unroll
        for (int ai = 0; ai < 2; ++ai)
#pragma unroll
            for (int m = 0; m < 4; ++m) { const int r = ai * HALF + wr * 64 + m * 16 + fr; const f32x2v sr = S[r]; const size_t off = (size_t)(u.pm * BM + r) * ldc + col0;
#pragma unroll
                for (int bj = 0; bj < 2; ++bj)
#pragma unroll
                    for (int n = 0; n < 2; ++n) { f32x4 o = (acc[ai][bj][m][n] - sr.x) * sr.y * gv[bj][n] + bv[bj][n];
                        if (bad) o = (f32x4){qnan, qnan, qnan, qnan};
                        *(f32x4*)(out + off + bj * HALF + n * 16) = o;
                        if (outb) { u32x2v w; w.x = cvtpk(o[0], o[1]); w.y = cvtpk(o[2], o[3]); *(u32x2v*)(outb + off + bj * HALF + n * 16) = w; } }
                asm volatile("" ::: "memory"); }
    }
};

template <class Epi, class Sched, bool ALIGN_EPI = false, bool SP2 = false>
__device__ __forceinline__ void gemm_phase(PG8_LAS unsigned char* lds, const Gemm g, const Sched& S, const Epi& E) {
    const int tid = otid(), wid = __builtin_amdgcn_readfirstlane(tid >> 6), lane = tid & 63, wr = wid >> 2, wc = wid & 3, fr = lane & 15, fq = lane >> 4;
    const int K = g.K, nt = K / BK;
    unsigned voffA[2], voffB[2];
#pragma unroll
    for (int i = 0; i < 2; ++i) { int R, C; stage_rc(tid * 16 + i * 8192, R, C); const int Rb = Epi::PERM ? ((R & ~31) + perm32(R & 31)) : R;
        voffA[i] = (unsigned)(R * K + C) * 2u; voffB[i] = (unsigned)(Rb * K + C) * 2u; }
    const size_t kstep = (size_t)(BK * 2);
    const size_t hstep = (size_t)HALF * K * 2;
    const size_t tstep = 2 * hstep;
    const unsigned ldsw = (unsigned)wid * 1024u;
    const int aoff = lds_byte(wr * 64 + fr, fq * 8), boff = lds_byte(wc * 32 + fr, fq * 8);
#define PG8_SA(b, h) (((b) * 2 + (h)) * HTB)
#define PG8_SB(b, h) ((4 + (b) * 2 + (h)) * HTB)
#define PG8_STAGE(bufoff, gbase, voff) do { _Pragma("unroll") for (int _i = 0; _i < 2; ++_i) \
        __builtin_amdgcn_global_load_lds((const unsigned*)((const char*)(gbase) + (voff)[_i]), (PG8_LAS unsigned*)(lds + (bufoff) + ldsw + _i * 8192), 16, 0, 0); } while (0)
#define PG8_LDA(dst, b, h) do { _Pragma("unroll") for (int m = 0; m < 4; ++m) _Pragma("unroll") for (int k = 0; k < 2; ++k) dst[m][k] = *(const PG8_LAS bf16x8*)(lds + PG8_SA(b, h) + aoff + m * 2048 + k * 1024); } while (0)
#define PG8_LDB(dst, b, h) do { _Pragma("unroll") for (int n = 0; n < 2; ++n) _Pragma("unroll") for (int k = 0; k < 2; ++k) dst[n][k] = *(const PG8_LAS bf16x8*)(lds + PG8_SB(b, h) + boff + n * 2048 + k * 1024); } while (0)
#define PG8_MMA(ai, bj, At, Bt) do { __builtin_amdgcn_s_setprio(1); _Pragma("unroll") for (int m = 0; m < 4; ++m) _Pragma("unroll") for (int n = 0; n < 2; ++n) _Pragma("unroll") for (int k = 0; k < 2; ++k) \
        acc[ai][bj][m][n] = __builtin_amdgcn_mfma_f32_16x16x32_bf16(Bt[n][k], At[m][k], acc[ai][bj][m][n], 0, 0, 0); __builtin_amdgcn_s_setprio(0); } while (0)
#define PG8_WAIT_V(n) asm volatile("s_waitcnt vmcnt(" #n ")" ::: "memory")
#define PG8_WAIT_L(n) asm volatile("s_waitcnt lgkmcnt(" #n ")" ::: "memory")
#define PG8_BAR __builtin_amdgcn_s_barrier()
#define PG8_SCHED __builtin_amdgcn_sched_barrier(0)
    Unit cur, nxt; int ui = 0;
    if (!S.next(0, cur)) return;
    f32x4 acc[2][2][4][2];
#pragma unroll
    for (int a = 0; a < 2; ++a)
#pragma unroll
        for (int b = 0; b < 2; ++b)
#pragma unroll
            for (int m = 0; m < 4; ++m)
#pragma unroll
                for (int n = 0; n < 2; ++n) acc[a][b][m][n] = (f32x4){0.f, 0.f, 0.f, 0.f};
    bf16x8 At[4][2], B0[2][2], B1[2][2];
    const char* cA = (const char*)g.A + (size_t)cur.pm * tstep; const char* cB = (const char*)g.Bt + (size_t)cur.pn * tstep;
    S.a_ready(cur);
    if constexpr (SP2) {
        PG8_STAGE(PG8_SB(0, 0), cB, voffB); PG8_STAGE(PG8_SB(0, 1), cB + hstep, voffB); PG8_STAGE(PG8_SA(0, 0), cA, voffA); PG8_STAGE(PG8_SA(0, 1), cA + hstep, voffA);
        if (wr == 1) PG8_BAR;
        PG8_WAIT_V(2); PG8_BAR;
        PG8_STAGE(PG8_SB(1, 0), cB + kstep, voffB); PG8_STAGE(PG8_SA(1, 0), cA + kstep, voffA); PG8_STAGE(PG8_SB(1, 1), cB + hstep + kstep, voffB);
        PG8_WAIT_V(6); PG8_BAR;
    } else {
        PG8_STAGE(PG8_SB(0, 0), cB, voffB); PG8_STAGE(PG8_SA(0, 0), cA, voffA); PG8_STAGE(PG8_SB(0, 1), cB + hstep, voffB); PG8_STAGE(PG8_SA(0, 1), cA + hstep, voffA);
        if (wr == 1) PG8_BAR;
        PG8_WAIT_V(4); PG8_BAR;
        PG8_STAGE(PG8_SB(1, 0), cB + kstep, voffB); PG8_STAGE(PG8_SA(1, 0), cA + kstep, voffA); PG8_STAGE(PG8_SB(1, 1), cB + hstep + kstep, voffB);
        PG8_WAIT_V(6); PG8_BAR;
    }
    for (;;) {
        const bool has_next = S.next(ui + 1, nxt);
        const char* nA = has_next ? (const char*)g.A + (size_t)nxt.pm * tstep : cA; const char* nB = has_next ? (const char*)g.Bt + (size_t)nxt.pn * tstep : cB;
        for (int t = 0; t < nt; t += 2) {
            const bool last = (t == nt - 2);
            const char* a1 = cA + (size_t)(t + 1) * kstep;
            const char* a2 = last ? nA : cA + (size_t)(t + 2) * kstep; const char* b2 = last ? nB : cB + (size_t)(t + 2) * kstep;
            const char* a3 = a2 + kstep; const char* b3 = b2 + kstep;
            if (last && has_next) S.a_ready(nxt);
            if constexpr (SP2) {
            PG8_LDB(B0, 0, 0); PG8_LDB(B1, 0, 1); PG8_SCHED; PG8_LDA(At, 0, 0); PG8_STAGE(PG8_SA(1, 1), a1 + hstep, voffA);
            PG8_WAIT_V(8); PG8_WAIT_L(0); PG8_BAR; PG8_MMA(0, 0, At, B0); PG8_MMA(0, 1, At, B1); PG8_BAR; PG8_SCHED;
            PG8_LDA(At, 0, 1); PG8_STAGE(PG8_SB(0, 0), b2, voffB); PG8_STAGE(PG8_SB(0, 1), b2 + hstep, voffB); PG8_STAGE(PG8_SA(0, 0), a2, voffA);
            PG8_WAIT_V(8); PG8_WAIT_L(0); PG8_BAR; PG8_MMA(1, 0, At, B0); PG8_MMA(1, 1, At, B1); PG8_BAR; PG8_SCHED;
            PG8_LDB(B0, 1, 0); PG8_LDB(B1, 1, 1); PG8_SCHED; PG8_LDA(At, 1, 0); PG8_STAGE(PG8_SA(0, 1), a2 + hstep, voffA);
            PG8_WAIT_V(8); PG8_WAIT_L(0); PG8_BAR; PG8_MMA(0, 0, At, B0); PG8_MMA(0, 1, At, B1); PG8_BAR; PG8_SCHED;
            PG8_LDA(At, 1, 1); PG8_STAGE(PG8_SB(1, 0), b3, voffB); PG8_STAGE(PG8_SB(1, 1), b3 + hstep, voffB); PG8_STAGE(PG8_SA(1, 0), a3, voffA);
            PG8_WAIT_V(8); PG8_WAIT_L(0); PG8_BAR; PG8_MMA(1, 0, At, B0); PG8_MMA(1, 1, At, B1); PG8_BAR; PG8_SCHED;
            } else {
            PG8_LDB(B0, 0, 0); PG8_SCHED; PG8_LDA(At, 0, 0); PG8_STAGE(PG8_SA(1, 1), a1 + hstep, voffA);
            PG8_WAIT_L(8); PG8_BAR; PG8_WAIT_L(0); PG8_MMA(0, 0, At, B0); PG8_BAR; PG8_SCHED;
            PG8_LDB(B1, 0, 1); PG8_STAGE(PG8_SB(0, 0), b2, voffB);
            PG8_BAR; PG8_WAIT_L(0); PG8_MMA(0, 1, At, B1); PG8_BAR;
            PG8_LDA(At, 0, 1); PG8_STAGE(PG8_SA(0, 0), a2, voffA);
            PG8_BAR; PG8_WAIT_L(0); PG8_MMA(1, 0, At, B0); PG8_BAR; PG8_SCHED;
            PG8_STAGE(PG8_SB(0, 1), b2 + hstep, voffB);
            PG8_WAIT_V(6); PG8_BAR; PG8_MMA(1, 1, At, B1); PG8_BAR;
            PG8_LDB(B0, 1, 0); PG8_SCHED; PG8_LDA(At, 1, 0); PG8_STAGE(PG8_SA(0, 1), a2 + hstep, voffA);
            PG8_WAIT_L(8); PG8_BAR; PG8_WAIT_L(0); PG8_MMA(0, 0, At, B0); PG8_BAR; PG8_SCHED;
            PG8_LDB(B1, 1, 1); PG8_STAGE(PG8_SB(1, 0), b3, voffB);
            PG8_BAR; PG8_WAIT_L(0); PG8_MMA(0, 1, At, B1); PG8_BAR;
            PG8_LDA(At, 1, 1); PG8_STAGE(PG8_SA(1, 0), a3, voffA);
            PG8_BAR; PG8_WAIT_L(0); PG8_MMA(1, 0, At, B0); PG8_BAR; PG8_SCHED;
            PG8_STAGE(PG8_SB(1, 1), b3 + hstep, voffB);
            PG8_WAIT_V(6); PG8_BAR; PG8_MMA(1, 1, At, B1); PG8_BAR;
            }
        }
        if constexpr (ALIGN_EPI) { if (wr == 0) PG8_BAR; }
        if constexpr (!Epi::AFTER_DRAIN) { E(acc, cur, wr, wc, fr, fq); S.done(cur); }
        if (!has_next) break;
#pragma unroll
        for (int a = 0; a < 2; ++a)
#pragma unroll
            for (int b = 0; b < 2; ++b)
#pragma unroll
                for (int m = 0; m < 4; ++m)
#pragma unroll
                    for (int n = 0; n < 2; ++n) acc[a][b][m][n] = (f32x4){0.f, 0.f, 0.f, 0.f};
        cur = nxt; cA = nA; cB = nB; ++ui;
        if constexpr (ALIGN_EPI) { if (wr == 1) PG8_BAR; }
    }
    PG8_WAIT_V(0);
    if constexpr (!ALIGN_EPI) { if (wr == 0) PG8_BAR; }
    PG8_BAR;
    if constexpr (Epi::AFTER_DRAIN) { E.fused(acc, cur, wr, wc, fr, fq, lds, wid, lane); S.done(cur); }
#undef PG8_SA
#undef PG8_SB
#undef PG8_STAGE
#undef PG8_LDA
#undef PG8_LDB
#undef PG8_MMA
#undef PG8_WAIT_V
#undef PG8_WAIT_L
#undef PG8_BAR
#undef PG8_SCHED
}
}

__device__ __forceinline__ void ln_phase(const float* xin, const float* Y, const float* g, const float* bb, float* out, bf16_t* outb) {
  const int lane = otid() & 63, wid = otid() >> 6;
  for (int row = blockIdx.x * 8 + wid; row < M_; row += gridDim.x * 8) {
    const float4* xr = (const float4*)(xin + (size_t)row * D_);
    const float4* yr = (const float4*)(Y + (size_t)row * D_);
    float4 v[4]; float s = 0.f;
#pragma unroll
    for (int j = 0; j < 4; ++j) {
      const float4 a = xr[j * 64 + lane], y = yr[j * 64 + lane];
      v[j].x = ALPHA * a.x + y.x; v[j].y = ALPHA * a.y + y.y; v[j].z = ALPHA * a.z + y.z; v[j].w = ALPHA * a.w + y.w;
      s += (v[j].x + v[j].y) + (v[j].z + v[j].w);
    }
    const float mean = wave_sum(s) * (1.f / D_);
    float q = 0.f;
#pragma unroll
    for (int j = 0; j < 4; ++j) {
      v[j].x -= mean; v[j].y -= mean; v[j].z -= mean; v[j].w -= mean;
      q += (v[j].x * v[j].x + v[j].y * v[j].y) + (v[j].z * v[j].z + v[j].w * v[j].w);
    }
    const float rstd = 1.f / sqrtf(wave_sum(q) * (1.f / D_) + LN_EPS);
#pragma unroll
    for (int j = 0; j < 4; ++j) {
      const float4 gg = ((const float4*)g)[j * 64 + lane], bv = ((const float4*)bb)[j * 64 + lane];
      float4 o;
      o.x = v[j].x * rstd * gg.x + bv.x; o.y = v[j].y * rstd * gg.y + bv.y; o.z = v[j].z * rstd * gg.z + bv.z; o.w = v[j].w * rstd * gg.w + bv.w;
      ((float4*)(out + (size_t)row * D_))[j * 64 + lane] = o;
      if (outb) {
        ushort4 ob; ob.x = f2bf(o.x); ob.y = f2bf(o.y); ob.z = f2bf(o.z); ob.w = f2bf(o.w);
        ((ushort4*)(outb + (size_t)row * D_))[j * 64 + lane] = ob;
      }
    }
  }
}

__device__ __forceinline__ void compress_item(const Params& P, int item, float* sm) {
  const bf16_t* H0 = (const bf16_t*)(P.ws + WS_H);
  const int tid = otid();
  const int g = item & 1; int r = item >> 1; const int n = r % NCMP; r /= NCMP; const int b = r & 3; const int i = r >> 2;
  const float* pos = P.in[2] + i * 2048;
  const float* w1 = P.in[3] + (size_t)i * 2048 * 128;
  const float* b1 = P.in[4] + i * 128;
  const float* w2 = P.in[5] + (size_t)i * 128 * 64;
  float* blk = sm;
  float* part = sm + 2048;
  float* hid = sm + 2048 + 512;
  const int col = (i == 0 ? C_KCMP : C_VCMP) + g * 64;
#pragma unroll
  for (int k = 0; k < 4; ++k) {
    const int f = tid + k * 512, l = f >> 6, d = f & 63;
    blk[f] = bf2f(H0[((size_t)b * S_ + 16 * n + l) * P0 + col + d]) + pos[f];
  }
  wg_sync();
  const int hh = tid & 127, pt = tid >> 7;
  float acc = 0.f;
  for (int f = pt * 512; f < pt * 512 + 512; ++f) acc += blk[f] * w1[(size_t)f * 128 + hh];
  part[pt * 128 + hh] = acc;
  wg_sync();
  if (tid < 128) {
    const float a = part[tid] + part[128 + tid] + part[256 + tid] + part[384 + tid] + b1[tid];
    hid[tid] = silu_f(a);
  }
  wg_sync();
  if (tid < 64) {
    float o = 0.f;
    for (int k = 0; k < 128; ++k) o += hid[k] * w2[k * 64 + tid];
    float* dst = (float*)(P.ws + (i == 0 ? WS_KC : WS_VC));
    dst[(((size_t)b * NCMP + n) * 2 + g) * 64 + tid] = o;
    bf16_t* dstb = (bf16_t*)(P.ws + (i == 0 ? (size_t)(248 * MiB) : (size_t)(249 * MiB)));
    dstb[(((size_t)b * 2 + g) * 256 + n) * 64 + tid] = f2bf(o);
    if (n == 0) dstb[(((size_t)b * 2 + g) * 256 + 255) * 64 + tid] = 0;
  }
  wg_sync();
}
__device__ __forceinline__ void kmean_item(const Params& P, int item, int lane) {
  const bf16_t* H0 = (const bf16_t*)(P.ws + WS_H);
  const int h = item & 7, n = (item >> 3) & 15, b = item >> 7;
  float s = 0.f;
  for (int k = 0; k < 256; ++k) s += bf2f(H0[((size_t)b * S_ + n * 256 + k) * P0 + C_MK + h * 64 + lane]);
  ((float*)(P.ws + WS_KM))[(((size_t)b * 16 + n) * 8 + h) * 64 + lane] = s * (1.f / 256.f);
}


constexpr size_t WS_W1T = 250 * MiB;
constexpr size_t WS_W2T = 251 * MiB;
constexpr size_t WS_C1P = 252 * MiB;
__device__ __forceinline__ void compress_mfma_tile(const Params& P, int tile, unsigned char* smem_g) {
  const bf16_t* __restrict__ H0 = (const bf16_t*)(P.ws + WS_H);
  const int tid = otid(), lane = tid & 63, wid = __builtin_amdgcn_readfirstlane(tid >> 6), g = lane >> 4, ii = lane & 15;
  const int i = tile >> 7, R0 = (tile & 127) * 16;
  bf16_t* hs = (bf16_t*)smem_g;
  {
    const int R = min(R0 + ii, 2039), b = R / 510, rem = R - b * 510, n = rem >> 1, grp = rem & 1;
    const bf16_t* abase = H0 + ((size_t)b * S_ + 16 * n) * P0 + (i == 0 ? C_KCMP : C_VCMP) + grp * 64 + 8 * g;
    const bf16_t* bbase = (const bf16_t*)(P.ws + WS_W1T) + (size_t)(i * 128 + 16 * wid + ii) * 2048 + 8 * g;
    f32x4 acc = (f32x4){0.f, 0.f, 0.f, 0.f};
#pragma unroll 16
    for (int ks = 0; ks < 64; ++ks) {
      const bf16x8 a = *(const bf16x8*)(abase + (size_t)(ks >> 1) * P0 + (ks & 1) * 32);
      const bf16x8 bq = *(const bf16x8*)(bbase + ks * 32);
      acc = __builtin_amdgcn_mfma_f32_16x16x32_bf16(a, bq, acc, 0, 0, 0);
    }
    const int col = 16 * wid + ii;
    float bias = P.in[4][i * 128 + col];
    const float* c1p = (const float*)(P.ws + WS_C1P) + i * 32 * 128 + col;
#pragma unroll 8
    for (int q = 0; q < 32; ++q) bias += c1p[q * 128];
#pragma unroll
    for (int r = 0; r < 4; ++r) hs[(4 * g + r) * 136 + col] = f2bf(silu_f(acc[r] + bias));
  }
  wg_sync();
  if (wid < 4) {
    const bf16_t* b2 = (const bf16_t*)(P.ws + WS_W2T) + (size_t)(i * 64 + 16 * wid + ii) * 128 + 8 * g;
    f32x4 acc = (f32x4){0.f, 0.f, 0.f, 0.f};
#pragma unroll
    for (int k2 = 0; k2 < 4; ++k2) {
      const bf16x8 a = *(const bf16x8*)(hs + ii * 136 + 32 * k2 + 8 * g);
      const bf16x8 bq = *(const bf16x8*)(b2 + 32 * k2);
      acc = __builtin_amdgcn_mfma_f32_16x16x32_bf16(a, bq, acc, 0, 0, 0);
    }
    bf16_t* dst = (bf16_t*)(P.ws + (i == 0 ? (size_t)(248 * MiB) : (size_t)(249 * MiB)));
#pragma unroll
    for (int r = 0; r < 4; ++r) {
      const int R = R0 + 4 * g + r;
      if (R < 2040) { const int b = R / 510, rem = R - b * 510, n = rem >> 1, grp = rem & 1;
        dst[(((size_t)b * 2 + grp) * 256 + n) * 64 + 16 * wid + ii] = f2bf(acc[r]); }
    }
  }
  wg_sync();
}
__device__ __forceinline__ void kmean_item2(const Params& P, int item) {
  const bf16_t* __restrict__ H0 = (const bf16_t*)(P.ws + WS_H);
  const int tid = otid();
  const bf16_t* src = H0 + ((size_t)(item >> 4) * S_ + (item & 15) * 256) * P0 + C_MK + tid;
  float s0 = 0.f, s1 = 0.f, s2 = 0.f, s3 = 0.f;
#pragma unroll 4
  for (int r = 0; r < 256; r += 4) {
    s0 += bf2f(src[(size_t)r * P0]); s1 += bf2f(src[(size_t)(r + 1) * P0]); s2 += bf2f(src[(size_t)(r + 2) * P0]); s3 += bf2f(src[(size_t)(r + 3) * P0]);
  }
  ((float*)(P.ws + WS_KM))[(size_t)item * 512 + tid] = ((s0 + s1) + (s2 + s3)) * (1.f / 256.f);
}

template <int NH>
__device__ __forceinline__ void attend_block(const bf16_t* __restrict__ Kp, const bf16_t* __restrict__ Vp, size_t rowbase, int kp0, int t, int kmin,
                                             const float* qs, float* pb, const float* slope, float* m, float* l, float* o, int lane) {
  asm volatile("" ::: "memory");
  const int kp = kp0 + lane;
  const bool valid = (kp <= t) && (kp >= kmin);
  const uint4* kr = (const uint4*)(Kp + (rowbase + kp) * P0);
  float dot[NH];
#pragma unroll
  for (int j = 0; j < NH; ++j) dot[j] = 0.f;
#pragma unroll 1
  for (int c = 0; c < 8; ++c) {
    asm volatile("" ::: "memory");
    const uint4 u = kr[c];
    float kv[8];
    kv[0] = __uint_as_float(u.x << 16); kv[1] = __uint_as_float(u.x & 0xffff0000u);
    kv[2] = __uint_as_float(u.y << 16); kv[3] = __uint_as_float(u.y & 0xffff0000u);
    kv[4] = __uint_as_float(u.z << 16); kv[5] = __uint_as_float(u.z & 0xffff0000u);
    kv[6] = __uint_as_float(u.w << 16); kv[7] = __uint_as_float(u.w & 0xffff0000u);
#pragma unroll
    for (int j = 0; j < NH; ++j) {
      const float4 q0 = *(const float4*)(qs + j * 64 + c * 8), q1 = *(const float4*)(qs + j * 64 + c * 8 + 4);
      dot[j] += kv[0] * q0.x + kv[1] * q0.y + kv[2] * q0.z + kv[3] * q0.w + kv[4] * q1.x + kv[5] * q1.y + kv[6] * q1.z + kv[7] * q1.w;
    }
  }
#pragma unroll
  for (int j = 0; j < NH; ++j) {
    const float s = valid ? 0.125f * dot[j] - slope[j] * (float)(t - kp) : -1e30f;
    const float mn = fmaxf(m[j], wave_max(s));
    const float al = __expf(m[j] - mn);
    const float p = valid ? __expf(s - mn) : 0.f;
    l[j] = l[j] * al + wave_sum(p);
    o[j] *= al; m[j] = mn;
    pb[j * 64 + lane] = p;
  }
  __builtin_amdgcn_wave_barrier();
  const bf16_t* vr = Vp + (rowbase + kp0) * P0 + lane;
#pragma unroll 8
  for (int k = 0; k < 64; ++k) {
    const float v = bf2f(vr[(size_t)k * P0]);
#pragma unroll
    for (int j = 0; j < NH; ++j) o[j] += pb[j * 64 + k] * v;
  }
  __builtin_amdgcn_wave_barrier();
}

__device__ __forceinline__ void nsa_item(const Params& P, int b, int g, int t, float* wsm, int lane) {
  const bf16_t* H0 = (const bf16_t*)(P.ws + WS_H);
  const float* KC = (const float*)(P.ws + WS_KC);
  const float* VC = (const float*)(P.ws + WS_VC);
  bf16_t* MIX = (bf16_t*)(P.ws + WS_MIX);
  float* qs = wsm;
  float* pc = wsm + 256;
  float* pb = wsm + 1280;
  const size_t row = (size_t)b * S_ + t;
  const bf16_t* hrow = H0 + row * P0;
  float slope[4];
#pragma unroll
  for (int j = 0; j < 4; ++j) { qs[j * 64 + lane] = bf2f(hrow[C_NQ + (g * 4 + j) * 64 + lane]); slope[j] = exp2f(-(float)(g * 4 + j + 1)); }
  __builtin_amdgcn_wave_barrier();
  const int nv = t >= 31 ? (t - 31) / 16 + 1 : 0;
#pragma unroll 1
  for (int c = 0; c < 4; ++c) {
    asm volatile("" ::: "memory");
    const int n = c * 64 + lane;
    float dot[4] = {0.f, 0.f, 0.f, 0.f};
    if (n < nv) {
      const float4* kr = (const float4*)(KC + (((size_t)b * NCMP + n) * 2 + g) * 64);
#pragma unroll 4
      for (int d4 = 0; d4 < 16; ++d4) {
        const float4 kv = kr[d4];
#pragma unroll
        for (int j = 0; j < 4; ++j) {
          const float4 q = *(const float4*)(qs + j * 64 + d4 * 4);
          dot[j] += kv.x * q.x + kv.y * q.y + kv.z * q.z + kv.w * q.w;
        }
      }
    }
#pragma unroll
    for (int j = 0; j < 4; ++j) pc[j * 256 + n] = (n < nv) ? 0.125f * dot[j] - slope[j] * (float)(t - (16 * n + 31)) : -1e30f;
  }
  __builtin_amdgcn_wave_barrier();
#pragma unroll
  for (int j = 0; j < 4; ++j) {
    float sc[4];
#pragma unroll
    for (int c = 0; c < 4; ++c) sc[c] = pc[j * 256 + c * 64 + lane];
    float mx = fmaxf(fmaxf(sc[0], sc[1]), fmaxf(sc[2], sc[3]));
    mx = wave_max(mx);
    float sum = 0.f;
#pragma unroll
    for (int c = 0; c < 4; ++c) { const int n = c * 64 + lane; const float p = (n < nv) ? __expf(sc[c] - mx) : 0.f; sc[c] = p; sum += p; }
    sum = wave_sum(sum);
    const float inv = nv > 0 ? 1.f / sum : 0.f;
#pragma unroll
    for (int c = 0; c < 4; ++c) pc[j * 256 + c * 64 + lane] = sc[c] * inv;
  }
  __builtin_amdgcn_wave_barrier();
  float ocmp[4] = {0.f, 0.f, 0.f, 0.f};
  for (int n = 0; n < nv; ++n) {
    const float v = VC[(((size_t)b * NCMP + n) * 2 + g) * 64 + lane];
#pragma unroll
    for (int j = 0; j < 4; ++j) ocmp[j] += pc[j * 256 + n] * v;
  }
  float imp = 0.f;
  {
    const int lo = max(0, 4 * lane - 1), hi = min(NCMP - 1, 4 * lane + 3);
    for (int n = lo; n <= hi; ++n) imp += (pc[n] + pc[256 + n]) + (pc[512 + n] + pc[768 + n]);
  }
  const int cur = t >> 6;
  const bool bvalid = lane <= cur;
  const bool forced = (lane == 0) || (lane == cur) || (lane == cur - 1);
  const float key = bvalid ? (forced ? 1e9f : imp) : -1e30f;
  int rank = 0;
  for (int s2 = 0; s2 < 64; ++s2) {
    const float ks = __shfl(key, s2);
    rank += (ks > key || (ks == key && s2 < lane)) ? 1 : 0;
  }
  const unsigned long long selmask = __ballot(bvalid && rank < 16);
  float m[4], l[4], osel[4], owin[4];
#pragma unroll
  for (int j = 0; j < 4; ++j) { m[j] = -1e30f; l[j] = 0.f; osel[j] = 0.f; }
  {
    unsigned long long mk = selmask;
    while (mk) {
      const int blk = __builtin_ctzll(mk); mk &= mk - 1;
      attend_block<4>(H0 + C_KSEL + g * 64, H0 + C_VSEL + g * 64, (size_t)b * S_, blk * 64, t, 0, qs, pb, slope, m, l, osel, lane);
    }
  }
#pragma unroll
  for (int j = 0; j < 4; ++j) { osel[j] /= l[j]; m[j] = -1e30f; l[j] = 0.f; owin[j] = 0.f; }
  {
    const int kmin = t - 511;
    const int b0 = (kmin > 0 ? kmin : 0) >> 6;
    for (int blk = b0; blk <= cur; ++blk)
      attend_block<4>(H0 + C_KWIN + g * 64, H0 + C_VWIN + g * 64, (size_t)b * S_, blk * 64, t, kmin, qs, pb, slope, m, l, owin, lane);
  }
#pragma unroll
  for (int j = 0; j < 4; ++j) {
    const int h = g * 4 + j;
    const float g0 = sigmoid_f(bf2f(hrow[C_NG + h * 3 + 0])), g1 = sigmoid_f(bf2f(hrow[C_NG + h * 3 + 1])), g2 = sigmoid_f(bf2f(hrow[C_NG + h * 3 + 2]));
    const float o = g0 * ocmp[j] + g1 * osel[j] + g2 * (owin[j] / l[j]);
    const float z = bf2f(hrow[C_NZ + h * 64 + lane]);
    MIX[row * D_ + h * 64 + lane] = f2bf(o * silu_f(z));
  }
}

__device__ __forceinline__ void moba_item(const Params& P, int b, int h, int t, float* wsm, int lane) {
  const bf16_t* H0 = (const bf16_t*)(P.ws + WS_H);
  const float* KM = (const float*)(P.ws + WS_KM);
  bf16_t* MIX = (bf16_t*)(P.ws + WS_MIX);
  float* qs = wsm;
  float* pb = wsm + 1280;
  const size_t row = (size_t)b * S_ + t;
  const bf16_t* hrow = H0 + row * P0;
  qs[lane] = bf2f(hrow[C_MQ + h * 64 + lane]);
  __builtin_amdgcn_wave_barrier();
  float slope[1] = {exp2f(-(float)(h + 1))};
  const int cur = t >> 8;
  float gate = -1e30f;
  if (lane < cur) {
    const float4* kr = (const float4*)(KM + (((size_t)b * 16 + lane) * 8 + h) * 64);
    float d = 0.f;
#pragma unroll 4
    for (int d4 = 0; d4 < 16; ++d4) { const float4 kv = kr[d4]; const float4 q = *(const float4*)(qs + d4 * 4); d += kv.x * q.x + kv.y * q.y + kv.z * q.z + kv.w * q.w; }
    gate = d;
  }
  int rank = 0;
  for (int s2 = 0; s2 < 16; ++s2) {
    const float ks = __shfl(gate, s2);
    rank += (ks > gate || (ks == gate && s2 < lane)) ? 1 : 0;
  }
  unsigned long long mk = __ballot(lane < cur && rank < 3) | (1ull << cur);
  float m[1] = {-1e30f}, l[1] = {0.f}, o[1] = {0.f};
  while (mk) {
    const int blk = __builtin_ctzll(mk); mk &= mk - 1;
    for (int c = 0; c < 4; ++c) {
      const int kp0 = blk * 256 + c * 64;
      if (kp0 > t) break;
      attend_block<1>(H0 + C_MK + h * 64, H0 + C_MV + h * 64, (size_t)b * S_, kp0, t, 0, qs, pb, slope, m, l, o, lane);
    }
  }
  const float z = bf2f(hrow[C_MZ + h * 64 + lane]);
  MIX[row * D_ + 512 + h * 64 + lane] = f2bf((o[0] / l[0]) * silu_f(z));
}


#define LAS __attribute__((address_space(3)))
typedef short s16x4 __attribute__((ext_vector_type(4)));
typedef short s16x8_t __attribute__((ext_vector_type(8)));
typedef float f32x2_t __attribute__((ext_vector_type(2)));
typedef __bf16 bf16x2_t __attribute__((ext_vector_type(2)));
__device__ __forceinline__ unsigned cvtpk(float lo, float hi) { f32x2_t v = {lo, hi}; bf16x2_t b = __builtin_convertvector(v, bf16x2_t); return __builtin_bit_cast(unsigned, b); }
__device__ __forceinline__ s16x4 vtr(LAS const unsigned char* p) { return __builtin_bit_cast(s16x4, __builtin_amdgcn_ds_read_tr16_b64_v4i16((LAS s16x4*)p)); }
template <int OFF> __device__ __forceinline__ s16x4 vtra(unsigned a) { s16x4 r; asm volatile("ds_read_b64_tr_b16 %0, %1 offset:%2" : "=&v"(r) : "v"(a), "i"(OFF) : "memory"); return r; }
#define LGKM0() do { asm volatile("s_waitcnt lgkmcnt(0)" ::: "memory"); __builtin_amdgcn_sched_barrier(0); } while (0)
constexpr int KT_BYTES = 8192;
constexpr int VT_DT = 2080;
constexpr int VT_BYTES = 4 * VT_DT;
constexpr int AT_BUF = KT_BYTES + VT_BYTES;
constexpr int AT_NST = 4;
constexpr int AT_MISC = AT_NST * AT_BUF;
constexpr int AT_TL = AT_MISC + 64;
constexpr int AT_STASH = AT_MISC + 512;
constexpr int AT_RANK = AT_STASH + 8 * 512 * 16;
constexpr int AT_LDS_END = AT_RANK + 8 * 1024;
__device__ __forceinline__ void ring_wait(int rem) {
  if (rem >= 3) asm volatile("s_waitcnt vmcnt(6)" ::: "memory");
  else if (rem == 2) asm volatile("s_waitcnt vmcnt(4)" ::: "memory");
  else if (rem == 1) asm volatile("s_waitcnt vmcnt(2)" ::: "memory");
  else asm volatile("s_waitcnt vmcnt(0)" ::: "memory");
  __builtin_amdgcn_s_barrier();
  asm volatile("" ::: "memory");
}
constexpr float C1 = 0.125f * 1.4426950408889634f;
constexpr float LOG2E = 1.4426950408889634f;
constexpr float AT_LIM = 1.2379400392853803e27f;
constexpr float AT_TINY = 7.8886090522101181e-31f;

__device__ __forceinline__ void at_stage_write(LAS unsigned char* buf, const u32x4& kreg, const u32x4& vreg, int tid) {
  const int key = tid >> 3, c = tid & 7;
  *(LAS u32x4*)(buf + key * 128 + ((c ^ ((key >> 1) & 7)) << 4)) = kreg;
  *(LAS u32x4*)(buf + KT_BYTES + (c >> 1) * VT_DT + key * 32 + (c & 1) * 16) = vreg;
}
__device__ __forceinline__ void at_stage_dma(LAS unsigned char* buf, const bf16_t* Kt, const bf16_t* Vt, unsigned pitch, int lane, int wid) {
  const int kkey = 8 * wid + (lane >> 3), c = (lane & 7) ^ ((kkey >> 1) & 7);
  __builtin_amdgcn_global_load_lds((const unsigned*)(Kt + (unsigned)kkey * pitch + c * 8), (LAS unsigned*)(buf + wid * 1024), 16, 0, 0);
  const int vkey = 32 * (wid & 1) + (lane >> 1), dt = wid >> 1;
  __builtin_amdgcn_global_load_lds((const unsigned*)(Vt + (unsigned)vkey * pitch + dt * 16 + (lane & 1) * 8), (LAS unsigned*)(buf + KT_BYTES + dt * VT_DT + (wid & 1) * 1024), 16, 0, 0);
}
template <int NRG, bool EDGE, bool IMP  , bool SAFE>
__device__ __forceinline__ void at_tile_x(LAS const unsigned char* buf, const bf16x8 (&qf)[NRG][2], f32x4 (&O)[NRG][4], float (&m)[NRG], float (&l)[NRG], f32x4 (&L)[NRG],
                                        const float (&base)[NRG], const float (&soff)[NRG], const int (&lim)[NRG], const int (&lo)[NRG], int lane,
                                        float (&imp)[NRG][16], float (&carry)[NRG], int tile = 0) {
  const int g = lane >> 4, i = lane & 15;
  const int swz = (i >> 1) & 7;
  LAS const unsigned char* kb = buf + i * 128;
  const int kc0 = ((g ^ swz) << 4), kc1 = (((4 + g) ^ swz) << 4);
  bf16x8 kf[4][2];
#pragma unroll
  for (int mt = 0; mt < 4; ++mt) { kf[mt][0] = *(LAS const bf16x8*)(kb + mt * 2048 + kc0); kf[mt][1] = *(LAS const bf16x8*)(kb + mt * 2048 + kc1); }
  __builtin_amdgcn_sched_barrier(0);
  f32x4 S[NRG][4];
#pragma unroll
  for (int rg = 0; rg < NRG; ++rg) {
    const float bm = base[rg];
#pragma unroll
    for (int mt = 0; mt < 4; ++mt)
#pragma unroll
      for (int r = 0; r < 4; ++r) S[rg][mt][r] = bm + soff[rg] * (float)(16 * mt + r);
  }
  __builtin_amdgcn_sched_barrier(0);
  __builtin_amdgcn_s_setprio(1);
#pragma unroll
  for (int mt = 0; mt < 4; ++mt) {
#pragma unroll
    for (int rg = 0; rg < NRG; ++rg) {
      f32x4 a = __builtin_amdgcn_mfma_f32_16x16x32_bf16(kf[mt][0], qf[rg][0], S[rg][mt], 0, 0, 0);
      S[rg][mt] = __builtin_amdgcn_mfma_f32_16x16x32_bf16(kf[mt][1], qf[rg][1], a, 0, 0, 0);
    }
  }
  __builtin_amdgcn_s_setprio(0);
  __builtin_amdgcn_sched_barrier(0);
  const unsigned vb = (unsigned)(unsigned long long)(buf + KT_BYTES) + (4 * g + (i >> 2)) * 32 + (i & 3) * 8;
#define AT_VRD(dt, ks, d0, d1) { d0 = vtra<(dt) * VT_DT + (ks) * 1024>(vb); d1 = vtra<(dt) * VT_DT + (ks) * 1024 + 512>(vb); }
  s16x4 a0, a1, a2, a3, a4, a5, a6, a7, c0, c1, c2, c3, c4, c5, c6, c7;
  AT_VRD(0, 0, a0, a1) AT_VRD(0, 1, a2, a3) AT_VRD(1, 0, a4, a5) AT_VRD(1, 1, a6, a7)
  __builtin_amdgcn_sched_barrier(0);
  unsigned pk[NRG][2][4];
#pragma unroll
  for (int rg = 0; rg < NRG; ++rg) {
    if (EDGE) {
#pragma unroll
      for (int mt = 0; mt < 4; ++mt)
#pragma unroll
        for (int r = 0; r < 4; ++r) { const int c = 16 * mt + r; S[rg][mt][r] = (c <= lim[rg] && c >= lo[rg]) ? S[rg][mt][r] : -INFINITY; }
    }
    if (SAFE) {
      float mx = -INFINITY;
#pragma unroll
      for (int mt = 0; mt < 4; ++mt)
#pragma unroll
        for (int r = 0; r < 4; ++r) mx = fmaxf(mx, S[rg][mt][r]);
      mx = xmax<16>(mx); mx = xmax<32>(mx);
      const float mn = fmaxf(m[rg], mx);
      const float mu = mn == -INFINITY ? 0.f : mn;
      const float al = __builtin_amdgcn_exp2f(m[rg] - mu);
      m[rg] = mn; l[rg] *= al;
#pragma unroll
      for (int dt = 0; dt < 4; ++dt) O[rg][dt] = O[rg][dt] * al;
      if (IMP) {
#pragma unroll
        for (int k = 0; k < 16; ++k) imp[rg][k] *= al;
        carry[rg] *= al;
      }
      float ps = 0.f;
#pragma unroll
      for (int mt = 0; mt < 4; ++mt)
#pragma unroll
        for (int r = 0; r < 4; ++r) { const float pv = __builtin_amdgcn_exp2f(S[rg][mt][r] - mu); S[rg][mt][r] = pv; ps += pv; }
      l[rg] += ps;
    } else {
#pragma unroll
      for (int mt = 0; mt < 4; ++mt)
#pragma unroll
        for (int r = 0; r < 4; ++r) S[rg][mt][r] = __builtin_amdgcn_exp2f(S[rg][mt][r]);
    }
    if (IMP) {
      const int g = lane >> 4;
      float sh[4], nv[4];
#pragma unroll
      for (int mt = 0; mt < 4; ++mt) sh[mt] = __uint_as_float(__builtin_amdgcn_ds_bpermute(((lane + 48) & 63) << 2, __float_as_uint(S[rg][mt][3])));
#pragma unroll
      for (int mt = 0; mt < 4; ++mt) {
        const float own = (S[rg][mt][0] + S[rg][mt][1]) + (S[rg][mt][2] + S[rg][mt][3]);
        const float prev = g > 0 ? sh[mt] : (mt > 0 ? sh[mt > 0 ? mt - 1 : 0] : carry[rg]);
        nv[mt] = own + prev;
      }
      if (tile == 0) { imp[rg][0] = nv[0]; imp[rg][1] = nv[1]; imp[rg][2] = nv[2]; imp[rg][3] = nv[3]; }
      else if (tile == 1) { imp[rg][4] = nv[0]; imp[rg][5] = nv[1]; imp[rg][6] = nv[2]; imp[rg][7] = nv[3]; }
      else if (tile == 2) { imp[rg][8] = nv[0]; imp[rg][9] = nv[1]; imp[rg][10] = nv[2]; imp[rg][11] = nv[3]; }
      else { imp[rg][12] = nv[0]; imp[rg][13] = nv[1]; imp[rg][14] = nv[2]; imp[rg][15] = nv[3]; }
      carry[rg] = sh[3];
    }
#pragma unroll
    for (int ks = 0; ks < 2; ++ks) {
      pk[rg][ks][0] = cvtpk(S[rg][2 * ks][0], S[rg][2 * ks][1]); pk[rg][ks][1] = cvtpk(S[rg][2 * ks][2], S[rg][2 * ks][3]);
      pk[rg][ks][2] = cvtpk(S[rg][2 * ks + 1][0], S[rg][2 * ks + 1][1]); pk[rg][ks][3] = cvtpk(S[rg][2 * ks + 1][2], S[rg][2 * ks + 1][3]);
    }
  }
  __builtin_amdgcn_sched_barrier(0);
#define AT_PV(dt, ks, d0, d1) { const bf16x8 vf = (bf16x8){d0[0], d0[1], d0[2], d0[3], d1[0], d1[1], d1[2], d1[3]}; \
    _Pragma("unroll") for (int rg = 0; rg < NRG; ++rg) { const u32x4 pw = {pk[rg][ks][0], pk[rg][ks][1], pk[rg][ks][2], pk[rg][ks][3]}; \
      O[rg][dt] = __builtin_amdgcn_mfma_f32_16x16x32_bf16(vf, __builtin_bit_cast(bf16x8, pw), O[rg][dt], 0, 0, 0); } }
  LGKM0();
  AT_VRD(2, 0, c0, c1) AT_VRD(2, 1, c2, c3) AT_VRD(3, 0, c4, c5) AT_VRD(3, 1, c6, c7)
  if (!SAFE) {
    const short one = (short)0x3F80; const bf16x8 ones = __builtin_bit_cast(bf16x8, (s16x8_t){one, one, one, one, one, one, one, one});
#pragma unroll
    for (int ks = 0; ks < 2; ++ks)
#pragma unroll
      for (int rg = 0; rg < NRG; ++rg) { const u32x4 pw = {pk[rg][ks][0], pk[rg][ks][1], pk[rg][ks][2], pk[rg][ks][3]};
        L[rg] = __builtin_amdgcn_mfma_f32_16x16x32_bf16(ones, __builtin_bit_cast(bf16x8, pw), L[rg], 0, 0, 0); }
  }
  __builtin_amdgcn_s_setprio(1);
  AT_PV(0, 0, a0, a1) AT_PV(0, 1, a2, a3) AT_PV(1, 0, a4, a5) AT_PV(1, 1, a6, a7)
  LGKM0();
  AT_PV(2, 0, c0, c1) AT_PV(2, 1, c2, c3) AT_PV(3, 0, c4, c5) AT_PV(3, 1, c6, c7)
  __builtin_amdgcn_s_setprio(0);
#undef AT_VRD
#undef AT_PV
}

template <int NRG, bool EDGE, bool SAFE>
__device__ __forceinline__ void at_tile(LAS const unsigned char* buf, const bf16x8 (&qf)[NRG][2], f32x4 (&O)[NRG][4], float (&m)[NRG], float (&l)[NRG], f32x4 (&L)[NRG],
                                        const float (&base)[NRG], const float (&soff)[NRG], const int (&lim)[NRG], const int (&lo)[NRG], int lane) {
  float dimp[NRG][16]; float dc[NRG];
  at_tile_x<NRG, EDGE, false, SAFE>(buf, qf, O, m, l, L, base, soff, lim, lo, lane, dimp, dc);
}

__device__ __forceinline__ bool at_any_bad(bool bad, LAS unsigned char* lds, int lane, int wid) {
  LAS unsigned* fl = (LAS unsigned*)(lds + AT_MISC + 320);
  const bool wb = __any(bad);
  if (lane == 0) fl[wid] = wb ? 1u : 0u;
  wg_sync();
  unsigned a = 0u;
#pragma unroll
  for (int w = 0; w < 8; ++w) a |= fl[w];
  return __builtin_amdgcn_readfirstlane(a) != 0u;
}

template <bool SAFE>
__device__ __forceinline__ bool moba_mfma_item(const Params& P, int b, int h, int cur, unsigned char* smem_g) {
  LAS unsigned char* lds = (LAS unsigned char*)smem_g;
  const bf16_t* __restrict__ H0 = (const bf16_t*)(P.ws + WS_H);
  const float* __restrict__ KM = (const float*)(P.ws + WS_KM);
  bf16_t* __restrict__ MIX = (bf16_t*)(P.ws + WS_MIX);
  const int tid = otid(), lane = tid & 63, wid = __builtin_amdgcn_readfirstlane(tid >> 6), g = lane >> 4, i = lane & 15;
  const float slope2 = exp2f(-(float)(h + 1)) * LOG2E;
  const int t0 = cur * 256;
  int trow[2]; bf16x8 qf[2][2]; unsigned sel[2];
#pragma unroll
  for (int rg = 0; rg < 2; ++rg) {
    trow[rg] = t0 + wid * 32 + rg * 16 + i;
    const bf16_t* qp = H0 + ((size_t)b * S_ + trow[rg]) * P0 + C_MQ + h * 64 + 8 * g;
    qf[rg][0] = *(const bf16x8*)qp; qf[rg][1] = *(const bf16x8*)(qp + 32);
  }
  {
    LAS float* kml = (LAS float*)(lds + AT_STASH);
#pragma unroll
    for (int k = 0; k < 2; ++k) { const int e = tid + 512 * k, n = e >> 6; if (n < cur) kml[e] = KM[(((size_t)b * 16 + n) * 8 + h) * 64 + (e & 63)]; }
    wg_sync();
#pragma unroll
    for (int rg = 0; rg < 2; ++rg) {
      float qv[16];
#pragma unroll
      for (int j = 0; j < 8; ++j) { qv[j] = bf2f((bf16_t)qf[rg][0][j]); qv[8 + j] = bf2f((bf16_t)qf[rg][1][j]); }
      float v1 = -INFINITY, v2 = -INFINITY, v3 = -INFINITY; int i1 = -1, i2 = -1, i3 = -1;
      for (int n = 0; n < cur; ++n) {
        LAS const float* kr = kml + n * 64 + 8 * g;
        const f32x4 a0 = *(LAS const f32x4*)kr, a1 = *(LAS const f32x4*)(kr + 4), b0 = *(LAS const f32x4*)(kr + 32), b1 = *(LAS const f32x4*)(kr + 36);
        float d = qv[0] * a0[0] + qv[1] * a0[1] + qv[2] * a0[2] + qv[3] * a0[3] + qv[4] * a1[0] + qv[5] * a1[1] + qv[6] * a1[2] + qv[7] * a1[3]
                + qv[8] * b0[0] + qv[9] * b0[1] + qv[10] * b0[2] + qv[11] * b0[3] + qv[12] * b1[0] + qv[13] * b1[1] + qv[14] * b1[2] + qv[15] * b1[3];
        d = xsum<16>(d); d = xsum<32>(d);
        if (d > v1) { v3 = v2; i3 = i2; v2 = v1; i2 = i1; v1 = d; i1 = n; }
        else if (d > v2) { v3 = v2; i3 = i2; v2 = d; i2 = n; }
        else if (d > v3) { v3 = d; i3 = n; }
      }
      unsigned mk = 0u;
      if (i1 >= 0) mk |= 1u << i1;
      if (i2 >= 0) mk |= 1u << i2;
      if (i3 >= 0) mk |= 1u << i3;
      sel[rg] = mk;
    }
  }
  {
    unsigned u = sel[0] | sel[1];
    u = xorr<1>(u); u = xorr<2>(u); u = xorr<4>(u); u = xorr<8>(u);
    LAS unsigned* misc = (LAS unsigned*)(lds + AT_MISC);
    if (lane == 0) misc[wid] = u;
  }
  wg_sync();
  unsigned umask = 0u;
  {
    LAS unsigned* misc = (LAS unsigned*)(lds + AT_MISC);
#pragma unroll
    for (int w = 0; w < 8; ++w) umask |= misc[w];
  }
  umask = __builtin_amdgcn_readfirstlane(umask);
  const int npast = __builtin_popcount(umask);
  const int nt = 4 * npast + 4;
  f32x4 O[2][4], L[2]; float m[2], l[2];
#pragma unroll
  for (int rg = 0; rg < 2; ++rg) { m[rg] = SAFE ? -INFINITY : 0.f; l[rg] = 0.f; L[rg] = (f32x4){0.f, 0.f, 0.f, 0.f};
#pragma unroll
    for (int dt = 0; dt < 4; ++dt) O[rg][dt] = (f32x4){0.f, 0.f, 0.f, 0.f}; }
  const bf16_t* Kg = H0 + (size_t)b * S_ * P0 + C_MK + h * 64;
  const bf16_t* Vg = H0 + (size_t)b * S_ * P0 + C_MV + h * 64;
  LAS int* tl = (LAS int*)(lds + AT_TL);
  if (tid < nt) {
    int k0v;
    if (tid < 4 * npast) { unsigned r = umask; for (int q = 0; q < (tid >> 2); ++q) r &= r - 1; k0v = __builtin_ctz(r) * 256 + (tid & 3) * 64; }
    else k0v = cur * 256 + (tid - 4 * npast) * 64;
    tl[tid] = k0v;
  }
  asm volatile("s_waitcnt vmcnt(0)" ::: "memory");
  wg_sync();
  const int tlv = tl[lane];
#define TLR(ix) __builtin_amdgcn_readlane(tlv, (ix))
#pragma unroll
  for (int st = 0; st < 3; ++st) if (st < nt) { const int k0s = TLR(st); at_stage_dma(lds + st * AT_BUF, Kg + (size_t)k0s * P0, Vg + (size_t)k0s * P0, P0, lane, wid); }
  const int ntp = 4 * npast;
#pragma unroll 1
  for (int ti = 0; ti < ntp; ++ti) {
    ring_wait(min(nt - 1 - ti, 2));
    if (ti + 3 < nt) { const int k0n = TLR(ti + 3); at_stage_dma(lds + ((ti + 3) & 3) * AT_BUF, Kg + (size_t)k0n * P0, Vg + (size_t)k0n * P0, P0, lane, wid); }
    const int ck0 = TLR(ti), cblk = ck0 >> 8;
    LAS const unsigned char* buf = lds + (ti & 3) * AT_BUF;
    float base[2], soff[2]; int lim[2], lo[2];
#pragma unroll
    for (int rg = 0; rg < 2; ++rg) {
      const bool rs = (sel[rg] >> cblk) & 1u;
      base[rg] = rs ? slope2 * (float)(ck0 + 4 * g - trow[rg]) : -INFINITY;
      soff[rg] = slope2; lim[rg] = 0; lo[rg] = 0;
    }
    at_tile<2, false, SAFE>(buf, qf, O, m, l, L, base, soff, lim, lo, lane);
  }
#pragma unroll 1
  for (int ti = ntp; ti < nt; ++ti) {
    ring_wait(min(nt - 1 - ti, 2));
    if (ti + 3 < nt) { const int k0n = TLR(ti + 3); at_stage_dma(lds + ((ti + 3) & 3) * AT_BUF, Kg + (size_t)k0n * P0, Vg + (size_t)k0n * P0, P0, lane, wid); }
    const int ck0 = TLR(ti);
    if (ck0 > t0 + wid * 32 + 31) continue;
    LAS const unsigned char* buf = lds + (ti & 3) * AT_BUF;
    float base[2], soff[2]; int lim[2], lo[2];
#pragma unroll
    for (int rg = 0; rg < 2; ++rg) {
      base[rg] = slope2 * (float)(ck0 + 4 * g - trow[rg]);
      soff[rg] = slope2; lim[rg] = trow[rg] - ck0 - 4 * g; lo[rg] = -1000000;
    }
    at_tile<2, true, SAFE>(buf, qf, O, m, l, L, base, soff, lim, lo, lane);
  }
  float ltot[2];
#pragma unroll
  for (int rg = 0; rg < 2; ++rg) { float lt = l[rg]; lt = xsum<16>(lt); lt = xsum<32>(lt); ltot[rg] = SAFE ? lt : L[rg][0]; }
  if (SAFE) __builtin_amdgcn_s_barrier();
  else if (at_any_bad(!(ltot[0] <= AT_LIM) | !(ltot[1] <= AT_LIM) | !(ltot[0] >= AT_TINY) | !(ltot[1] >= AT_TINY), lds, lane, wid)) return true;
#pragma unroll
  for (int rg = 0; rg < 2; ++rg) {
    const float lt = ltot[rg];
    const float inv = 1.f / lt;
    const size_t row = (size_t)b * S_ + trow[rg];
#pragma unroll
    for (int dt = 0; dt < 4; ++dt) {
      const int dv = 16 * dt + 4 * g;
      const ushort4 zz = *(const ushort4*)(H0 + row * P0 + C_MZ + h * 64 + dv);
      ushort4 ov;
      ov.x = f2bf(O[rg][dt][0] * inv * silu_f(bf2f(zz.x))); ov.y = f2bf(O[rg][dt][1] * inv * silu_f(bf2f(zz.y)));
      ov.z = f2bf(O[rg][dt][2] * inv * silu_f(bf2f(zz.z))); ov.w = f2bf(O[rg][dt][3] * inv * silu_f(bf2f(zz.w)));
      *(ushort4*)(MIX + row * D_ + 512 + h * 64 + dv) = ov;
    }
  }
  return false;
}


constexpr size_t WS_KCB = 248 * MiB;
constexpr size_t WS_VCB = 249 * MiB;
template <bool SAFE>
__device__ __forceinline__ bool nsa_mfma_item(const Params& P, int b, int grp, int sb, unsigned char* smem_g) {
  LAS unsigned char* lds = (LAS unsigned char*)smem_g;
  const bf16_t* __restrict__ H0 = (const bf16_t*)(P.ws + WS_H);
  bf16_t* __restrict__ MIX = (bf16_t*)(P.ws + WS_MIX);
  const int tid = otid(), lane = tid & 63, wid = __builtin_amdgcn_readfirstlane(tid >> 6), g = lane >> 4, i = lane & 15;
  const int t0 = sb * 64;
  int trow[2]; bf16x8 qf[2][2];
  const int hh = grp * 4 + (i & 3);
  const float slope2 = exp2f(-(float)(hh + 1)) * LOG2E;
  const bf16_t* __restrict__ Hb = H0 + (size_t)b * S_ * P0;
#pragma unroll
  for (int rg = 0; rg < 2; ++rg) {
    trow[rg] = t0 + wid * 8 + rg * 4 + (i >> 2);
    const unsigned qo = (unsigned)trow[rg] * P0 + C_NQ + hh * 64 + 8 * g;
    qf[rg][0] = *(const bf16x8*)(Hb + qo); qf[rg][1] = *(const bf16x8*)(Hb + qo + 32);
  }
  LAS f32x4* stash = (LAS f32x4*)(lds + AT_STASH) + tid;
  f32x4 O[2][4], L[2]; float m[2], l[2];
  unsigned mlo[2], mhi[2];
  bool bad = false;
  const int ntc = ((4 * sb + 2) >> 6) + 1;
  {
    const bf16_t* Kg = (const bf16_t*)(P.ws + WS_KCB) + (size_t)(b * 2 + grp) * 256 * 64;
    const bf16_t* Vg = (const bf16_t*)(P.ws + WS_VCB) + (size_t)(b * 2 + grp) * 256 * 64;
    asm volatile("s_waitcnt vmcnt(0)" ::: "memory");
#pragma unroll
    for (int tile = 0; tile < 4; ++tile) if (tile < ntc) at_stage_dma(lds + tile * AT_BUF, Kg + tile * 4096, Vg + tile * 4096, 64, lane, wid);
  }
#pragma unroll
  for (int rg = 0; rg < 2; ++rg) {
    float imp[1][16], carry[1], m1[1], l1[1]; f32x4 O1[1][4], L1[1]; bf16x8 q1[1][2];
    L1[0] = (f32x4){0.f, 0.f, 0.f, 0.f};
    q1[0][0] = qf[rg][0]; q1[0][1] = qf[rg][1];
    m1[0] = SAFE ? -INFINITY : 0.f; l1[0] = 0.f; carry[0] = 0.f;
#pragma unroll
    for (int k = 0; k < 16; ++k) imp[0][k] = 0.f;
#pragma unroll
    for (int dt = 0; dt < 4; ++dt) O1[0][dt] = (f32x4){0.f, 0.f, 0.f, 0.f};
#pragma unroll 1
    for (int tile = 0; tile < ntc; ++tile) {
      if (rg == 0) ring_wait(ntc - 1 - tile);
      LAS const unsigned char* buf = lds + tile * AT_BUF;
      float base[1], soff[1]; int lim[1], lo[1];
      const int nlim = trow[rg] >= 31 ? ((trow[rg] - 31) >> 4) : -1;
      base[0] = slope2 * (float)(16 * (64 * tile + 4 * g) + 31 - trow[rg]);
      soff[0] = 16.f * slope2; lim[0] = nlim - 64 * tile - 4 * g; lo[0] = -1000000;
      at_tile_x<1, true, true, SAFE>(buf, q1, O1, m1, l1, L1, base, soff, lim, lo, lane, imp, carry, tile);
    }
    {
      float lt = l1[0]; lt = xsum<16>(lt); lt = xsum<32>(lt);
      if (!SAFE) { lt = L1[0][0]; bad |= !(lt <= AT_LIM) | (trow[rg] >= 31 && !(lt >= AT_TINY)); }
      const float inv = lt > 0.f ? 1.f / lt : 0.f;
      const float g0 = sigmoid_f(bf2f(Hb[(unsigned)trow[rg] * P0 + C_NG + hh * 3 + 0]));
#pragma unroll
      for (int dt = 0; dt < 4; ++dt) stash[(rg * 4 + dt) * 512] = O1[0][dt] * (g0 * inv);
      if (sb < 16) { mlo[rg] = (1u << (sb + 1)) - 1u; mhi[rg] = 0u; }
      else {
        const int j = i & 3;
        unsigned mykey[4]; int mys[4], rank[4];
#pragma unroll
        for (int q = 0; q < 4; ++q) { mykey[q] = 0u; mys[q] = 4 * (4 * j + q) + g; rank[q] = 0; }
#pragma unroll
        for (int k = 0; k < 16; ++k) {
          float v = imp[0][k] * inv; v = xsum<1>(v); v = xsum<2>(v);
          const int sidx = 4 * k + g;
          const bool forced = (sidx == 0) || (sidx == sb) || (sidx == sb - 1);
          const unsigned u = sidx <= sb ? ((__float_as_uint(forced ? 1e9f : v) & ~63u) | (unsigned)(63 - sidx)) : 0u;
          if ((k >> 2) == j) mykey[k & 3] = u;
        }
        LAS unsigned* rk = (LAS unsigned*)(lds + AT_RANK + wid * 1024) + (i >> 2) * 64;
#pragma unroll
        for (int q = 0; q < 4; ++q) rk[mys[q]] = mykey[q];
#pragma unroll 1
        for (int c4 = 0; c4 < 4; ++c4) {
          u32x4 o[4];
#pragma unroll
          for (int c = 0; c < 4; ++c) o[c] = *(LAS const u32x4*)(rk + 16 * c4 + 4 * c);
#pragma unroll
          for (int c = 0; c < 4; ++c)
#pragma unroll
            for (int e = 0; e < 4; ++e)
#pragma unroll
              for (int q = 0; q < 4; ++q) rank[q] += (o[c][e] > mykey[q]) ? 1 : 0;
        }
        unsigned a = 0u, bb = 0u;
#pragma unroll
        for (int q = 0; q < 4; ++q) if (rank[q] < 16 && mys[q] <= sb) { if (mys[q] < 32) a |= 1u << mys[q]; else bb |= 1u << (mys[q] - 32); }
        a = xorr<1>(a); bb = xorr<1>(bb); a = xorr<2>(a); bb = xorr<2>(bb);
        a = xorr<16>(a); bb = xorr<16>(bb); a = xorr<32>(a); bb = xorr<32>(bb);
        mlo[rg] = a; mhi[rg] = bb;
      }
    }
  }
  {
    unsigned ua = mlo[0] | mlo[1], ub = mhi[0] | mhi[1];
    ua = xorr<4>(ua); ub = xorr<4>(ub); ua = xorr<8>(ua); ub = xorr<8>(ub);
    LAS unsigned* misc = (LAS unsigned*)(lds + AT_MISC);
    if (lane == 0) { misc[2 * wid] = ua; misc[2 * wid + 1] = ub; }
    wg_sync();
    ua = 0u; ub = 0u;
#pragma unroll
    for (int w = 0; w < 8; ++w) { ua |= misc[2 * w]; ub |= misc[2 * w + 1]; }
    unsigned long long rem = ((unsigned long long)(unsigned)__builtin_amdgcn_readfirstlane(ub) << 32) | (unsigned)__builtin_amdgcn_readfirstlane(ua);
    const int nt = __builtin_popcountll(rem);
#pragma unroll
    for (int rg = 0; rg < 2; ++rg) { m[rg] = SAFE ? -INFINITY : 0.f; l[rg] = 0.f; L[rg] = (f32x4){0.f, 0.f, 0.f, 0.f};
#pragma unroll
      for (int dt = 0; dt < 4; ++dt) O[rg][dt] = (f32x4){0.f, 0.f, 0.f, 0.f}; }
    const bf16_t* Kg = Hb + C_KSEL + grp * 64;
    const bf16_t* Vg = Hb + C_VSEL + grp * 64;
    LAS int* tl = (LAS int*)(lds + AT_TL);
    if (tid < nt) { unsigned long long r = rem; for (int q = 0; q < tid; ++q) r &= r - 1; tl[tid] = __builtin_ctzll(r); }
    asm volatile("s_waitcnt vmcnt(0)" ::: "memory");
    wg_sync();
    const int tlv = tl[lane];
#pragma unroll
    for (int st = 0; st < 3; ++st) if (st < nt) { const int bs = TLR(st); at_stage_dma(lds + st * AT_BUF, Kg + (size_t)bs * 64 * P0, Vg + (size_t)bs * 64 * P0, P0, lane, wid); }
#define NSA_SEL_STEP(EDGEV) { \
      ring_wait(min(nt - 1 - ti, 2)); \
      if (ti + 3 < nt) { const int bn = TLR(ti + 3); at_stage_dma(lds + ((ti + 3) & 3) * AT_BUF, Kg + (size_t)bn * 64 * P0, Vg + (size_t)bn * 64 * P0, P0, lane, wid); } \
      const int cblk = TLR(ti); \
      LAS const unsigned char* buf = lds + (ti & 3) * AT_BUF; \
      float base[2], soff[2]; int lim[2], lo[2]; \
      _Pragma("unroll") for (int rg = 0; rg < 2; ++rg) { \
        const bool rs = cblk < 32 ? ((mlo[rg] >> cblk) & 1u) : ((mhi[rg] >> (cblk - 32)) & 1u); \
        base[rg] = rs ? slope2 * (float)(cblk * 64 + 4 * g - trow[rg]) : -INFINITY; \
        soff[rg] = slope2; lim[rg] = trow[rg] - cblk * 64 - 4 * g; lo[rg] = -1000000; \
      } \
      at_tile<2, EDGEV, SAFE>(buf, qf, O, m, l, L, base, soff, lim, lo, lane); }
    int ti = 0;
#pragma unroll 1
    for (; ti < nt - 1; ++ti) NSA_SEL_STEP(false)
    NSA_SEL_STEP(true)
#undef NSA_SEL_STEP
    __builtin_amdgcn_s_barrier();
#pragma unroll
    for (int rg = 0; rg < 2; ++rg) {
      float lt = l[rg]; lt = xsum<16>(lt); lt = xsum<32>(lt);
      if (!SAFE) { lt = L[rg][0]; bad |= !(lt <= AT_LIM) | !(lt >= AT_TINY); }
      const float g1 = sigmoid_f(bf2f(Hb[(unsigned)trow[rg] * P0 + C_NG + hh * 3 + 1]));
#pragma unroll
      for (int dt = 0; dt < 4; ++dt) stash[(rg * 4 + dt) * 512] += O[rg][dt] * (g1 / lt);
    }
  }
  {
    const int b0 = sb >= 8 ? sb - 8 : 0;
    const int nt = sb - b0 + 1;
#pragma unroll
    for (int rg = 0; rg < 2; ++rg) { m[rg] = SAFE ? -INFINITY : 0.f; l[rg] = 0.f; L[rg] = (f32x4){0.f, 0.f, 0.f, 0.f};
#pragma unroll
      for (int dt = 0; dt < 4; ++dt) O[rg][dt] = (f32x4){0.f, 0.f, 0.f, 0.f}; }
    const bf16_t* Kg = Hb + C_KWIN + grp * 64;
    const bf16_t* Vg = Hb + C_VWIN + grp * 64;
    asm volatile("s_waitcnt vmcnt(0)" ::: "memory");
#pragma unroll
    for (int st = 0; st < 3; ++st) if (st < nt) at_stage_dma(lds + st * AT_BUF, Kg + (size_t)(b0 + st) * 64 * P0, Vg + (size_t)(b0 + st) * 64 * P0, P0, lane, wid);
#define NSA_WIN_STEP(EDGEV) { \
      ring_wait(min(nt - 1 - ti, 2)); \
      const int cblk = b0 + ti; \
      if (ti + 3 < nt) at_stage_dma(lds + ((ti + 3) & 3) * AT_BUF, Kg + (size_t)(cblk + 3) * 64 * P0, Vg + (size_t)(cblk + 3) * 64 * P0, P0, lane, wid); \
      LAS const unsigned char* buf = lds + (ti & 3) * AT_BUF; \
      float base[2], soff[2]; int lim[2], lo[2]; \
      _Pragma("unroll") for (int rg = 0; rg < 2; ++rg) { \
        base[rg] = slope2 * (float)(cblk * 64 + 4 * g - trow[rg]); \
        soff[rg] = slope2; lim[rg] = trow[rg] - cblk * 64 - 4 * g; lo[rg] = trow[rg] - 511 - cblk * 64 - 4 * g; \
      } \
      at_tile<2, EDGEV, SAFE>(buf, qf, O, m, l, L, base, soff, lim, lo, lane); }
    int ti = 0;
    if (sb >= 8) { NSA_WIN_STEP(true) ++ti; }
#pragma unroll 1
    for (; ti < nt - 1; ++ti) NSA_WIN_STEP(false)
    NSA_WIN_STEP(true)
#undef NSA_WIN_STEP
  }
  float ltot[2];
#pragma unroll
  for (int rg = 0; rg < 2; ++rg) { float lt = l[rg]; lt = xsum<16>(lt); lt = xsum<32>(lt); ltot[rg] = SAFE ? lt : L[rg][0]; }
  if (SAFE) __builtin_amdgcn_s_barrier();
  else if (at_any_bad(bad | !(ltot[0] <= AT_LIM) | !(ltot[1] <= AT_LIM) | !(ltot[0] >= AT_TINY) | !(ltot[1] >= AT_TINY), lds, lane, wid)) return true;
#pragma unroll
  for (int rg = 0; rg < 2; ++rg) {
    const float lt = ltot[rg];
    const unsigned ro = (unsigned)trow[rg] * P0;
    const float g2 = sigmoid_f(bf2f(Hb[ro + C_NG + hh * 3 + 2])) / lt;
#pragma unroll
    for (int dt = 0; dt < 4; ++dt) {
      const int dv = 16 * dt + 4 * g;
      const ushort4 zz = *(const ushort4*)(Hb + ro + C_NZ + hh * 64 + dv);
      const f32x4 ov = stash[(rg * 4 + dt) * 512] + O[rg][dt] * g2;
      ushort4 o4;
      o4.x = f2bf(ov[0] * silu_f(bf2f(zz.x))); o4.y = f2bf(ov[1] * silu_f(bf2f(zz.y)));
      o4.z = f2bf(ov[2] * silu_f(bf2f(zz.z))); o4.w = f2bf(ov[3] * silu_f(bf2f(zz.w)));
      *(ushort4*)(MIX + (size_t)b * S_ * D_ + (unsigned)trow[rg] * D_ + hh * 64 + dv) = o4;
    }
  }
  return false;
}

__device__ __forceinline__ void gla_gate_phase(const Params& P) {
  const bf16_t* H1 = (const bf16_t*)(P.ws + WS_H);
  float* G = (float*)(P.ws + WS_G);
  const float* w2 = P.in[10]; const float* gb = P.in[11];
  const size_t total = (size_t)M_ * 512;
  for (size_t i = (size_t)blockIdx.x * 512 + otid(); i < total; i += (size_t)gridDim.x * 512) {
    const int c = (int)(i & 511); const size_t row = i >> 9;
    float x = gb[c];
#pragma unroll
    for (int r = 0; r < 16; ++r) x += bf2f(H1[row * P1 + G_LR + r]) * w2[r * 512 + c];
    const float ls = fminf(x, 0.f) - log1pf(__expf(-fabsf(x)));
    G[i] = ls * (1.f / 16.f);
  }
}
__device__ __forceinline__ void gla_scan_vblock(const Params& P, int vb) {
  const bf16_t* __restrict__ H1 = (const bf16_t*)(P.ws + WS_H);
  const float* __restrict__ G = (const float*)(P.ws + WS_G);
  bf16_t* __restrict__ O = (bf16_t*)(P.ws + WS_XB);
  const int tid = otid(), lane = tid & 63, wid = tid >> 6;
  const int eh = vb & 1, h = (vb >> 1) & 3, b = vb >> 3;
  const int e = eh * 128 + wid * 16 + (lane >> 2), dq = lane & 3;
  float St[32];
#pragma unroll
  for (int i = 0; i < 32; ++i) St[i] = 0.f;
  const float qscale = 0.08838834764831845f;
  for (int t = 0; t < S_; ++t) {
    const size_t row = (size_t)b * S_ + t;
    const float4* gr = (const float4*)(G + row * 512 + h * 128 + dq * 32);
    const uint4* kr = (const uint4*)(H1 + row * P1 + G_K + h * 128 + dq * 32);
    const uint4* qr = (const uint4*)(H1 + row * P1 + G_Q + h * 128 + dq * 32);
    const float v = bf2f(H1[row * P1 + G_V + h * 256 + e]);
    float o = 0.f;
#pragma unroll
    for (int c = 0; c < 4; ++c) {
      const uint4 ku = kr[c], qu = qr[c];
      const float4 g0 = gr[2 * c], g1 = gr[2 * c + 1];
      const float kk[8] = {__uint_as_float(ku.x << 16), __uint_as_float(ku.x & 0xffff0000u), __uint_as_float(ku.y << 16), __uint_as_float(ku.y & 0xffff0000u),
                           __uint_as_float(ku.z << 16), __uint_as_float(ku.z & 0xffff0000u), __uint_as_float(ku.w << 16), __uint_as_float(ku.w & 0xffff0000u)};
      const float qq[8] = {__uint_as_float(qu.x << 16), __uint_as_float(qu.x & 0xffff0000u), __uint_as_float(qu.y << 16), __uint_as_float(qu.y & 0xffff0000u),
                           __uint_as_float(qu.z << 16), __uint_as_float(qu.z & 0xffff0000u), __uint_as_float(qu.w << 16), __uint_as_float(qu.w & 0xffff0000u)};
      const float gg[8] = {g0.x, g0.y, g0.z, g0.w, g1.x, g1.y, g1.z, g1.w};
#pragma unroll
      for (int i = 0; i < 8; ++i) {
        const float a = __expf(gg[i]);
        St[c * 8 + i] = a * St[c * 8 + i] + kk[i] * v;
        o += qq[i] * St[c * 8 + i];
      }
    }
    o = xsum<1>(o); o = xsum<2>(o);
    if (dq == 0) O[row * D_ + h * 256 + e] = f2bf(o * qscale);
  }
}

constexpr int CTL_GLA = 16384;
constexpr size_t WS_QT = WS_G;
constexpr size_t WS_KH = WS_G + 16 * MiB;
constexpr size_t WS_ATT = 190 * MiB;
constexpr size_t WS_DEC = 199 * MiB;
__device__ __forceinline__ int kperm(int x) { const int dl = x & 31, hi = dl >> 4, d2 = dl & 15; return (x & ~31) + 8 * (d2 >> 2) + 4 * hi + (d2 & 3); }

__device__ __forceinline__ void st8_wt(void* p, unsigned lo, unsigned hi) {
  __hip_atomic_store((unsigned long long*)p, ((unsigned long long)hi << 32) | lo, __ATOMIC_RELAXED, __HIP_MEMORY_SCOPE_AGENT);
}
__device__ __forceinline__ void gla_prep_item(const Params& P, int item, unsigned char* smem_g) {
  const bf16_t* __restrict__ H1 = (const bf16_t*)(P.ws + WS_H);
  bf16_t* __restrict__ QT = (bf16_t*)(P.ws + WS_QT) + (size_t)item * 8192;
  bf16_t* __restrict__ KH = (bf16_t*)(P.ws + WS_KH) + (size_t)item * 8192;
  bf16_t* __restrict__ ATT = (bf16_t*)(P.ws + WS_ATT) + (size_t)item * 4096;
  float* __restrict__ DEC = (float*)(P.ws + WS_DEC) + (size_t)item * 128;
  const int tid = otid(), lane = tid & 63, wid = tid >> 6, g = lane >> 4, i = lane & 15;
  const int c = item & 63, h = (item >> 6) & 3, b = item >> 8;
  const size_t rowbase = (size_t)b * S_ + c * 64;
  float* glr = (float*)smem_g;
  float* tot = (float*)(smem_g + 4096);
  bf16_t* qs = (bf16_t*)(smem_g + 12288);
  bf16_t* ks = (bf16_t*)(smem_g + 12288 + 17408);
  const int d0 = (tid & 31) * 4, rgp = tid >> 5;
#pragma unroll
  for (int k = 0; k < 2; ++k) { const int e = tid + 512 * k; glr[e] = ((const float*)(P.ws + WS_GLR))[rowbase * 16 + e]; }
  uint2 qraw[4], kraw[4];
#pragma unroll
  for (int k = 0; k < 4; ++k) {
    qraw[k] = *(const uint2*)(H1 + (rowbase + 4 * rgp + k) * P1 + G_Q + h * 128 + d0);
    kraw[k] = *(const uint2*)(H1 + (rowbase + 4 * rgp + k) * P1 + G_K + h * 128 + d0);
  }
  float4 w[16];
#pragma unroll
  for (int r = 0; r < 16; ++r) w[r] = *(const float4*)(P.in[10] + r * 512 + h * 128 + d0);
  const float4 gb = *(const float4*)(P.in[11] + h * 128 + d0);
  wg_sync();
  float bb[4][4];
  float run[4] = {0.f, 0.f, 0.f, 0.f};
#pragma unroll
  for (int k = 0; k < 4; ++k) {
    const float* gr = glr + (4 * rgp + k) * 16;
    float x[4] = {gb.x, gb.y, gb.z, gb.w};
#pragma unroll
    for (int r = 0; r < 16; ++r) { const float gv = gr[r]; x[0] += gv * w[r].x; x[1] += gv * w[r].y; x[2] += gv * w[r].z; x[3] += gv * w[r].w; }
#pragma unroll
    for (int j = 0; j < 4; ++j) {
      const float la = (fminf(x[j], 0.f) - __logf(1.f + __expf(-fabsf(x[j])))) * (1.f / 16.f);
      run[j] += la; bb[k][j] = run[j];
    }
  }
  *(float4*)(tot + rgp * 128 + d0) = (float4){run[0], run[1], run[2], run[3]};
  wg_sync();
  float off[4] = {0.f, 0.f, 0.f, 0.f}, total[4] = {0.f, 0.f, 0.f, 0.f};
#pragma unroll
  for (int q = 0; q < 16; ++q) {
    const float4 tv = *(const float4*)(tot + q * 128 + d0);
    total[0] += tv.x; total[1] += tv.y; total[2] += tv.z; total[3] += tv.w;
    if (q < rgp) { off[0] += tv.x; off[1] += tv.y; off[2] += tv.z; off[3] += tv.w; }
  }
  const float qscale = 0.08838834764831845f;
  const int dp = kperm(d0);
#pragma unroll
  for (int k = 0; k < 4; ++k) {
    const int r = 4 * rgp + k;
    const float qv[4] = {__uint_as_float(qraw[k].x << 16), __uint_as_float(qraw[k].x & 0xffff0000u), __uint_as_float(qraw[k].y << 16), __uint_as_float(qraw[k].y & 0xffff0000u)};
    const float kv[4] = {__uint_as_float(kraw[k].x << 16), __uint_as_float(kraw[k].x & 0xffff0000u), __uint_as_float(kraw[k].y << 16), __uint_as_float(kraw[k].y & 0xffff0000u)};
    float qt[4], kt[4], kh[4];
#pragma unroll
    for (int j = 0; j < 4; ++j) {
      const float bv = bb[k][j] + off[j];
      const float eb = __expf(bv);
      qt[j] = qv[j] * eb * qscale; kt[j] = kv[j] * __expf(-bv); kh[j] = kv[j] * __expf(total[j] - bv);
    }
    const unsigned q01 = cvtpk(qt[0], qt[1]), q23 = cvtpk(qt[2], qt[3]), k01 = cvtpk(kt[0], kt[1]), k23 = cvtpk(kt[2], kt[3]);
    *(uint2*)(qs + r * 136 + d0) = (uint2){q01, q23};
    *(uint2*)(ks + r * 136 + d0) = (uint2){k01, k23};
    st8_wt(QT + r * 128 + dp, q01, q23);
    st8_wt(KH + r * 128 + d0, cvtpk(kh[0], kh[1]), cvtpk(kh[2], kh[3]));
  }
  if (rgp == 0) {
    st8_wt(DEC + d0, __float_as_uint(__expf(total[0])), __float_as_uint(__expf(total[1])));
    st8_wt(DEC + d0 + 2, __float_as_uint(__expf(total[2])), __float_as_uint(__expf(total[3])));
  }
  wg_sync();
  {
    const int it = wid >> 1, jt0 = 2 * (wid & 1);
    f32x4 acc[2] = {(f32x4){0.f, 0.f, 0.f, 0.f}, (f32x4){0.f, 0.f, 0.f, 0.f}};
#pragma unroll
    for (int kk = 0; kk < 4; ++kk) {
      const bf16x8 qa = *(const bf16x8*)(qs + (16 * it + i) * 136 + 32 * kk + 8 * g);
#pragma unroll
      for (int n = 0; n < 2; ++n) {
        const bf16x8 kf = *(const bf16x8*)(ks + (16 * (jt0 + n) + i) * 136 + 32 * kk + 8 * g);
        acc[n] = __builtin_amdgcn_mfma_f32_16x16x32_bf16(kf, qa, acc[n], 0, 0, 0);
      }
    }
#pragma unroll
    for (int n = 0; n < 2; ++n) {
      const int ri = 16 * it + i, cj0 = 16 * (jt0 + n) + 4 * g;
      float v[4];
#pragma unroll
      for (int r = 0; r < 4; ++r) v[r] = (cj0 + r <= ri) ? acc[n][r] : 0.f;
      st8_wt(ATT + ri * 64 + kperm(cj0), cvtpk(v[0], v[1]), cvtpk(v[2], v[3]));
    }
  }
  asm volatile("s_waitcnt vmcnt(0)" ::: "memory");
  wg_sync();
  if (tid == 0) __hip_atomic_store((unsigned*)P.ws + CTL_GLA + 64 * item, 1u, __ATOMIC_RELAXED, __HIP_MEMORY_SCOPE_AGENT);
}
__device__ __forceinline__ void gla_wait_items(const Params& P, int first, int n, int tid) {
  if (tid < n) {
    unsigned* f = (unsigned*)P.ws + CTL_GLA + 64 * (first + tid);
    unsigned sp = 0;
    while (__hip_atomic_load(f, __ATOMIC_RELAXED, __HIP_MEMORY_SCOPE_AGENT) == 0u) { __builtin_amdgcn_s_sleep(2); if (++sp > (1u << 22)) break; }
  }
  wg_sync();
}
constexpr int GS_Q = 0, GS_K = 16384, GS_V = 32768, GS_A = 49152, GS_D = 57344, GS_BYTES = 57856;
__device__ __forceinline__ void gla_stage_dma(LAS unsigned char* st, const Params& P, int item, size_t rowbase, int h, int eh, int lane, int wid) {
  const bf16_t* QT = (const bf16_t*)(P.ws + WS_QT) + (size_t)item * 8192;
  const bf16_t* KH = (const bf16_t*)(P.ws + WS_KH) + (size_t)item * 8192;
  const bf16_t* ATT = (const bf16_t*)(P.ws + WS_ATT) + (size_t)item * 4096;
  const bf16_t* V = (const bf16_t*)(P.ws + WS_H) + rowbase * P1 + G_V + h * 256 + eh * 128;
#pragma unroll
  for (int n = 0; n < 2; ++n) {
    const int q = 2 * wid + n;
    { const int row = 4 * q + (lane >> 4), ch = (lane & 15) ^ (row & 15);
      __builtin_amdgcn_global_load_lds((const unsigned*)(QT + row * 128 + ch * 8), (LAS unsigned*)(st + GS_Q + q * 1024), 16, 0, 0); }
    { const int dt = q >> 1, j = 32 * (q & 1) + (lane >> 1);
      __builtin_amdgcn_global_load_lds((const unsigned*)(KH + j * 128 + dt * 16 + (lane & 1) * 8), (LAS unsigned*)(st + GS_K + q * 1024), 16, 0, 0);
      __builtin_amdgcn_global_load_lds((const unsigned*)(V + (unsigned)j * P1 + dt * 16 + (lane & 1) * 8), (LAS unsigned*)(st + GS_V + q * 1024), 16, 0, 0); }
  }
  { const int row = 8 * wid + (lane >> 3), ch = (lane & 7) ^ ((row >> 1) & 7);
    __builtin_amdgcn_global_load_lds((const unsigned*)(ATT + row * 64 + ch * 8), (LAS unsigned*)(st + GS_A + wid * 1024), 16, 0, 0); }
  if (wid < 2) __builtin_amdgcn_global_load_lds((const unsigned*)((const float*)(P.ws + WS_DEC) + (size_t)item * 128 + wid * 64 + lane), (LAS unsigned*)(st + GS_D + wid * 256), 4, 0, 0);
}
__device__ __forceinline__ void gla_chain(const Params& P, int chain, unsigned char* smem_g) {
  LAS unsigned char* lds = (LAS unsigned char*)smem_g;
  bf16_t* __restrict__ O = (bf16_t*)(P.ws + WS_XB);
  const int tid = otid(), lane = tid & 63, wid = __builtin_amdgcn_readfirstlane(tid >> 6), g = lane >> 4, i = lane & 15;
  const int eh = chain & 1, h = (chain >> 1) & 3, b = chain >> 3;
  const int item0 = (b * 4 + h) * 64;
  f32x4 S[8];
#pragma unroll
  for (int dt = 0; dt < 8; ++dt) S[dt] = (f32x4){0.f, 0.f, 0.f, 0.f};
  gla_wait_items(P, item0, 9, tid);
  gla_stage_dma(lds, P, item0, (size_t)b * S_, h, eh, lane, wid);
  wg_sync();
  for (int c = 0; c < 64; ++c) {
    if ((c & 7) == 0 && c > 0) gla_wait_items(P, item0 + c + 1, (64 - (c + 1)) < 8 ? (64 - (c + 1)) : 8, tid);
    if (c + 1 < 64) gla_stage_dma(lds + ((c + 1) & 1) * GS_BYTES, P, item0 + c + 1, (size_t)b * S_ + (c + 1) * 64, h, eh, lane, wid);
    LAS const unsigned char* st = lds + (c & 1) * GS_BYTES;
    f32x4 dc[8];
#pragma unroll
    for (int dt = 0; dt < 8; ++dt) dc[dt] = *(LAS const f32x4*)(st + GS_D + (16 * dt + 4 * g) * 4);
    u32x4 spk[4];
#pragma unroll
    for (int kk = 0; kk < 4; ++kk) {
      spk[kk][0] = cvtpk(S[2 * kk][0], S[2 * kk][1]); spk[kk][1] = cvtpk(S[2 * kk][2], S[2 * kk][3]);
      spk[kk][2] = cvtpk(S[2 * kk + 1][0], S[2 * kk + 1][1]); spk[kk][3] = cvtpk(S[2 * kk + 1][2], S[2 * kk + 1][3]);
    }
    bf16x8 vf[2];
    const unsigned trb = (unsigned)(unsigned long long)st + (4 * g + (i >> 2)) * 32 + (i & 3) * 8;
    {
      const unsigned vb = trb + GS_V + wid * 2048;
      const s16x4 v0 = vtra<0>(vb), v1 = vtra<512>(vb), v2 = vtra<1024>(vb), v3 = vtra<1536>(vb);
      LGKM0();
      vf[0] = (bf16x8){v0[0], v0[1], v0[2], v0[3], v1[0], v1[1], v1[2], v1[3]};
      vf[1] = (bf16x8){v2[0], v2[1], v2[2], v2[3], v3[0], v3[1], v3[2], v3[3]};
    }
#pragma unroll
    for (int it = 0; it < 4; ++it) {
      f32x4 acc = (f32x4){0.f, 0.f, 0.f, 0.f};
      LAS const unsigned char* qrow = st + GS_Q + (16 * it + i) * 256;
#pragma unroll
      for (int kk = 0; kk < 4; ++kk) {
        const bf16x8 a = *(LAS const bf16x8*)(qrow + (((4 * kk + g) ^ i) << 4));
        acc = __builtin_amdgcn_mfma_f32_16x16x32_bf16(a, __builtin_bit_cast(bf16x8, spk[kk]), acc, 0, 0, 0);
      }
      LAS const unsigned char* arow = st + GS_A + (16 * it + i) * 128;
#pragma unroll
      for (int k2 = 0; k2 < 2; ++k2) {
        const bf16x8 a = *(LAS const bf16x8*)(arow + (((4 * k2 + g) ^ ((i >> 1) & 7)) << 4));
        acc = __builtin_amdgcn_mfma_f32_16x16x32_bf16(a, vf[k2], acc, 0, 0, 0);
      }
      bf16_t* op = O + ((size_t)b * S_ + c * 64 + 16 * it + 4 * g) * D_ + h * 256 + eh * 128 + 16 * wid + i;
#pragma unroll
      for (int r = 0; r < 4; ++r) op[(size_t)r * D_] = f2bf(acc[r]);
    }
    __builtin_amdgcn_sched_barrier(0);
#define GL_KRD(dt, q0, q1, q2, q3) { q0 = vtra<GS_K + (dt) * 2048>(trb); q1 = vtra<GS_K + (dt) * 2048 + 512>(trb); q2 = vtra<GS_K + (dt) * 2048 + 1024>(trb); q3 = vtra<GS_K + (dt) * 2048 + 1536>(trb); }
#define GL_UPD(dt, q0, q1, q2, q3) { S[dt] = S[dt] * dc[dt]; \
      S[dt] = __builtin_amdgcn_mfma_f32_16x16x32_bf16((bf16x8){q0[0], q0[1], q0[2], q0[3], q1[0], q1[1], q1[2], q1[3]}, vf[0], S[dt], 0, 0, 0); \
      S[dt] = __builtin_amdgcn_mfma_f32_16x16x32_bf16((bf16x8){q2[0], q2[1], q2[2], q2[3], q3[0], q3[1], q3[2], q3[3]}, vf[1], S[dt], 0, 0, 0); }
    {
      s16x4 e0, e1, e2, e3, e4, e5, e6, e7, f0, f1, f2, f3, f4, f5, f6, f7;
      GL_KRD(0, e0, e1, e2, e3) GL_KRD(1, e4, e5, e6, e7)
      LGKM0();
      GL_KRD(2, f0, f1, f2, f3) GL_KRD(3, f4, f5, f6, f7)
      GL_UPD(0, e0, e1, e2, e3) GL_UPD(1, e4, e5, e6, e7)
      LGKM0();
      GL_KRD(4, e0, e1, e2, e3) GL_KRD(5, e4, e5, e6, e7)
      GL_UPD(2, f0, f1, f2, f3) GL_UPD(3, f4, f5, f6, f7)
      LGKM0();
      GL_KRD(6, f0, f1, f2, f3) GL_KRD(7, f4, f5, f6, f7)
      GL_UPD(4, e0, e1, e2, e3) GL_UPD(5, e4, e5, e6, e7)
      LGKM0();
      GL_UPD(6, f0, f1, f2, f3) GL_UPD(7, f4, f5, f6, f7)
    }
#undef GL_KRD
#undef GL_UPD
    wg_sync();
  }
}


constexpr int G4_Q = 0, G4_K = 16384, G4_V = 32768, G4_A = 40960, G4_D = 49152, G4_BYTES = 49664, G4_EXCH = 3 * G4_BYTES, G4_END = G4_EXCH + 8192;
__device__ __forceinline__ void gla4_stage_dma(LAS unsigned char* st, const Params& P, int item, size_t rowbase, int h, int eq, int lane, int wid) {
  const bf16_t* QT = (const bf16_t*)(P.ws + WS_QT) + (size_t)item * 8192;
  const bf16_t* KH = (const bf16_t*)(P.ws + WS_KH) + (size_t)item * 8192;
  const bf16_t* ATT = (const bf16_t*)(P.ws + WS_ATT) + (size_t)item * 4096;
  const bf16_t* V = (const bf16_t*)(P.ws + WS_H) + rowbase * P1 + G_V + h * 256 + eq * 64;
#pragma unroll
  for (int n = 0; n < 2; ++n) {
    const int q = 2 * wid + n;
    { const int row = 4 * q + (lane >> 4), ch = (lane & 15) ^ (row & 15);
      __builtin_amdgcn_global_load_lds((const unsigned*)(QT + row * 128 + ch * 8), (LAS unsigned*)(st + G4_Q + q * 1024), 16, 0, 0); }
    { const int dt = q >> 1, j = 32 * (q & 1) + (lane >> 1);
      __builtin_amdgcn_global_load_lds((const unsigned*)(KH + j * 128 + dt * 16 + (lane & 1) * 8), (LAS unsigned*)(st + G4_K + q * 1024), 16, 0, 0); }
  }
  { const int et = wid >> 1, j = 32 * (wid & 1) + (lane >> 1);
    __builtin_amdgcn_global_load_lds((const unsigned*)(V + (unsigned)j * P1 + et * 16 + (lane & 1) * 8), (LAS unsigned*)(st + G4_V + wid * 1024), 16, 0, 0); }
  { const int row = 8 * wid + (lane >> 3), ch = (lane & 7) ^ ((row >> 1) & 7);
    __builtin_amdgcn_global_load_lds((const unsigned*)(ATT + row * 64 + ch * 8), (LAS unsigned*)(st + G4_A + wid * 1024), 16, 0, 0); }
  __builtin_amdgcn_global_load_lds((const unsigned*)((const float*)(P.ws + WS_DEC) + (size_t)item * 128 + (wid & 1) * 64 + lane), (LAS unsigned*)(st + G4_D + (wid & 1) * 256), 4, 0, 0);
}
__device__ __forceinline__ void gla_chain64(const Params& P, int chain, int seg, unsigned char* smem_g) {
  LAS unsigned char* lds = (LAS unsigned char*)smem_g;
  bf16_t* __restrict__ O = (bf16_t*)(P.ws + WS_XB);
  const int tid = otid(), lane = tid & 63, wid = __builtin_amdgcn_readfirstlane(tid >> 6), g = lane >> 4, i = lane & 15;
  const int et = wid & 3, dh = wid >> 2;
  const int eq = chain & 3, h = (chain >> 2) & 3, b = chain >> 4;
  const int item0 = (b * 4 + h) * 64 + 32 * seg;
  const size_t row0 = (size_t)b * S_ + (size_t)seg * 32 * 64;
  f32x4 S[4];
#pragma unroll
  for (int t = 0; t < 4; ++t) S[t] = (f32x4){0.f, 0.f, 0.f, 0.f};
  f32x4 opend[2] = {(f32x4){0.f, 0.f, 0.f, 0.f}, (f32x4){0.f, 0.f, 0.f, 0.f}};
  gla_wait_items(P, item0, 10, tid);
  gla4_stage_dma(lds, P, item0, row0, h, eq, lane, wid);
  gla4_stage_dma(lds + G4_BYTES, P, item0 + 1, row0 + 64, h, eq, lane, wid);
  for (int c = 0; c < 32; ++c) {
    if ((c & 7) == 0 && c > 0 && c + 2 < 32) gla_wait_items(P, item0 + c + 2, (32 - (c + 2)) < 8 ? (32 - (c + 2)) : 8, tid);
    if (c + 1 < 32) asm volatile("s_waitcnt vmcnt(7)" ::: "memory"); else asm volatile("s_waitcnt vmcnt(0)" ::: "memory");
    __builtin_amdgcn_s_barrier();
    asm volatile("" ::: "memory");
    if (c > 0) {
#pragma unroll
      for (int q = 0; q < 2; ++q) { bf16_t* op = O + (row0 + (c - 1) * 64 + 16 * (2 * dh + q) + 4 * g) * D_ + h * 256 + eq * 64 + 16 * et + i;
#pragma unroll
        for (int r = 0; r < 4; ++r) op[(size_t)r * D_] = f2bf(opend[q][r]); }
    }
    if (c + 2 < 32) gla4_stage_dma(lds + ((c + 2) % 3) * G4_BYTES, P, item0 + c + 2, row0 + (c + 2) * 64, h, eq, lane, wid);
    LAS const unsigned char* st = lds + (c % 3) * G4_BYTES;
    f32x4 dc[4];
#pragma unroll
    for (int t = 0; t < 4; ++t) dc[t] = *(LAS const f32x4*)(st + G4_D + (16 * (4 * dh + t) + 4 * g) * 4);
    bf16x8 qa[4][2], aa[2][2];
#pragma unroll
    for (int it = 0; it < 4; ++it)
#pragma unroll
      for (int q = 0; q < 2; ++q) qa[it][q] = *(LAS const bf16x8*)(st + G4_Q + (16 * it + i) * 256 + (((4 * (2 * dh + q) + g) ^ i) << 4));
#pragma unroll
    for (int q = 0; q < 2; ++q)
#pragma unroll
      for (int k2 = 0; k2 < 2; ++k2) aa[q][k2] = *(LAS const bf16x8*)(st + G4_A + (16 * (2 * dh + q) + i) * 128 + (((4 * k2 + g) ^ ((i >> 1) & 7)) << 4));
    const unsigned trb = (unsigned)(unsigned long long)st + (4 * g + (i >> 2)) * 32 + (i & 3) * 8;
    const unsigned vb = trb + G4_V + et * 2048, kb = trb + G4_K + (4 * dh) * 2048;
    const s16x4 v0 = vtra<0>(vb), v1 = vtra<512>(vb), v2 = vtra<1024>(vb), v3 = vtra<1536>(vb);
    s16x4 kq[4][4];
#define G4_KRD(t) { kq[t][0] = vtra<(t) * 2048>(kb); kq[t][1] = vtra<(t) * 2048 + 512>(kb); kq[t][2] = vtra<(t) * 2048 + 1024>(kb); kq[t][3] = vtra<(t) * 2048 + 1536>(kb); }
    G4_KRD(0) G4_KRD(1) G4_KRD(2) G4_KRD(3)
#undef G4_KRD
    u32x4 spk[2];
#pragma unroll
    for (int q = 0; q < 2; ++q) {
      spk[q][0] = cvtpk(S[2 * q][0], S[2 * q][1]); spk[q][1] = cvtpk(S[2 * q][2], S[2 * q][3]);
      spk[q][2] = cvtpk(S[2 * q + 1][0], S[2 * q + 1][1]); spk[q][3] = cvtpk(S[2 * q + 1][2], S[2 * q + 1][3]);
    }
    LGKM0();
    bf16x8 vf[2];
    vf[0] = (bf16x8){v0[0], v0[1], v0[2], v0[3], v1[0], v1[1], v1[2], v1[3]};
    vf[1] = (bf16x8){v2[0], v2[1], v2[2], v2[3], v3[0], v3[1], v3[2], v3[3]};
    f32x4 acc[4];
#pragma unroll
    for (int it = 0; it < 4; ++it) {
      acc[it] = (f32x4){0.f, 0.f, 0.f, 0.f};
      if (it >> 1 == dh) {
#pragma unroll
        for (int k2 = 0; k2 < 2; ++k2) acc[it] = __builtin_amdgcn_mfma_f32_16x16x32_bf16(aa[it & 1][k2], vf[k2], acc[it], 0, 0, 0);
      }
#pragma unroll
      for (int q = 0; q < 2; ++q) acc[it] = __builtin_amdgcn_mfma_f32_16x16x32_bf16(qa[it][q], __builtin_bit_cast(bf16x8, spk[q]), acc[it], 0, 0, 0);
    }
#pragma unroll
    for (int t = 0; t < 4; ++t) {
      S[t] = S[t] * dc[t];
      S[t] = __builtin_amdgcn_mfma_f32_16x16x32_bf16((bf16x8){kq[t][0][0], kq[t][0][1], kq[t][0][2], kq[t][0][3], kq[t][1][0], kq[t][1][1], kq[t][1][2], kq[t][1][3]}, vf[0], S[t], 0, 0, 0);
      S[t] = __builtin_amdgcn_mfma_f32_16x16x32_bf16((bf16x8){kq[t][2][0], kq[t][2][1], kq[t][2][2], kq[t][2][3], kq[t][3][0], kq[t][3][1], kq[t][3][2], kq[t][3][3]}, vf[1], S[t], 0, 0, 0);
    }
    {
      LAS u32x2* ex = (LAS u32x2*)(lds + G4_EXCH) + (wid * 2) * 64 + lane;
#pragma unroll
      for (int q = 0; q < 2; ++q) { const f32x4 v = dh == 0 ? acc[2 + q] : acc[q]; ex[q * 64] = (u32x2){cvtpk(v[0], v[1]), cvtpk(v[2], v[3])}; }
    }
    asm volatile("s_waitcnt lgkmcnt(0)" ::: "memory");
    __builtin_amdgcn_s_barrier();
    asm volatile("" ::: "memory");
    {
      LAS const u32x2* ex = (LAS const u32x2*)(lds + G4_EXCH) + ((wid ^ 4) * 2) * 64 + lane;
#pragma unroll
      for (int q = 0; q < 2; ++q) {
        const u32x2 pv = ex[q * 64];
        f32x4 mine = dh == 0 ? acc[q] : acc[2 + q];
        mine[0] += __uint_as_float(pv.x << 16); mine[1] += __uint_as_float(pv.x & 0xffff0000u); mine[2] += __uint_as_float(pv.y << 16); mine[3] += __uint_as_float(pv.y & 0xffff0000u);
        opend[q] = mine;
      }
    }
  }
#pragma unroll
  for (int q = 0; q < 2; ++q) { bf16_t* op = O + (row0 + 31 * 64 + 16 * (2 * dh + q) + 4 * g) * D_ + h * 256 + eq * 64 + 16 * et + i;
#pragma unroll
    for (int r = 0; r < 4; ++r) op[(size_t)r * D_] = f2bf(opend[q][r]); }
  if (seg == 0) {
    bf16_t* smt = (bf16_t*)(P.ws + WS_SMT) + ((size_t)(b * 4 + h) * 256 + eq * 64 + 16 * et + i) * 128;
#pragma unroll
    for (int t = 0; t < 4; ++t) { const int T = 4 * dh + t, p0 = 32 * (T >> 1) + 8 * g + 4 * (T & 1);
      *(u32x2*)(smt + p0) = (u32x2){cvtpk(S[t][0], S[t][1]), cvtpk(S[t][2], S[t][3])}; }
  }
  __builtin_amdgcn_s_barrier();
}

__device__ __forceinline__ void gla_norm_phase(const Params& P) {
  const bf16_t* H1 = (const bf16_t*)(P.ws + WS_H);
  const bf16_t* O = (const bf16_t*)(P.ws + WS_XB);
  bf16_t* MIX = (bf16_t*)(P.ws + WS_MIX);
  const float* gn = P.in[12];
  const int lane = otid() & 63, wid = otid() >> 6;
  for (int it = blockIdx.x * 8 + wid; it < M_ * 4; it += gridDim.x * 8) {
    const int h = it & 3; const size_t row = it >> 2;
    float v[4]; float ss = 0.f;
#pragma unroll
    for (int k = 0; k < 4; ++k) { v[k] = bf2f(O[row * D_ + h * 256 + k * 64 + lane]); ss += v[k] * v[k]; }
    const float r = 1.f / sqrtf(wave_sum(ss) * (1.f / 256.f) + LN_EPS);
#pragma unroll
    for (int k = 0; k < 4; ++k) {
      const int c = h * 256 + k * 64 + lane;
      const float z = bf2f(H1[row * P1 + G_Z + c]);
      MIX[row * D_ + c] = f2bf(v[k] * r * gn[c] * silu_f(z));
    }
  }
}


constexpr int RG_RED = 131072;
__device__ __forceinline__ size_t wfrag_off(int n, int k) { return ((size_t)(((n >> 4) * 32 + (k >> 5)) * 64 + ((k >> 3) & 3) * 16 + (n & 15))) * 8 + (k & 7); }
template <int AMODE  , bool GLR  >
__device__ __forceinline__ void rowgemm_block(const Params& P, int rb, const bf16_t* __restrict__ Wf, const float* base, float* out, bf16_t* outb,
                                              const float* __restrict__ gam, const float* __restrict__ bet, unsigned char* smem_g) {
  LAS unsigned char* lds = (LAS unsigned char*)smem_g;
  const int tid = otid(), lane = tid & 63, wid = __builtin_amdgcn_readfirstlane(tid >> 6), g = lane >> 4, i = lane & 15;
  const size_t r0 = (size_t)rb * 64;
  if (AMODE == 0) {
    const bf16_t* A = (const bf16_t*)(P.ws + WS_MIX) + r0 * D_;
#pragma unroll
    for (int q0 = 0; q0 < 16; ++q0) {
      const int q = wid * 16 + q0, row = q >> 1, ch = ((q & 1) * 64 + lane) ^ (row & 15);
      __builtin_amdgcn_global_load_lds((const unsigned*)(A + (size_t)row * D_ + ch * 8), (LAS unsigned*)(lds + q * 1024), 16, 0, 0);
    }
  } else {
    const bf16_t* __restrict__ O = (const bf16_t*)(P.ws + WS_XB) + r0 * D_;
    const bf16_t* __restrict__ H1 = (const bf16_t*)(P.ws + WS_H) + r0 * P1 + G_Z;
    const float* __restrict__ gn = P.in[12];
    const int row = tid >> 3, part = tid & 7;
    u32x4 ov[16];
#pragma unroll
    for (int c = 0; c < 16; ++c) ov[c] = *(const u32x4*)(O + (size_t)row * D_ + part * 128 + c * 8);
    const int bb = rb >> 6, cc = rb & 63;
    if (cc >= 32) {
      LAS float* PP = (LAS float*)(lds + RG_RED);
      LAS unsigned char* QP = lds + RG_RED + 4096;
#pragma unroll 1
      for (int hh = 0; hh < 4; ++hh) {
        const int itm = (bb * 4 + hh) * 64;
        if (tid < 128) {
          const int pp = tid, dd = (pp & ~31) + 16 * ((pp >> 2) & 1) + 4 * ((pp >> 3) & 3) + (pp & 3);
          const float* dec = (const float*)(P.ws + WS_DEC) + (size_t)itm * 128 + dd;
          float pr = 1.f;
#pragma unroll 4
          for (int c2 = 32; c2 < cc; ++c2) pr *= dec[(size_t)c2 * 128];
          PP[pp] = pr;
        }
        wg_sync();
        {
          const int p0 = (tid & 7) * 16;
          const bf16_t* qsrc = (const bf16_t*)(P.ws + WS_QT) + (size_t)(itm + cc) * 8192 + row * 128 + p0;
          const u32x4 q0 = *(const u32x4*)qsrc, q1 = *(const u32x4*)(qsrc + 8);
          u32x4 w0, w1;
#pragma unroll
          for (int e = 0; e < 4; ++e) {
            w0[e] = cvtpk(__uint_as_float(q0[e] << 16) * PP[p0 + 2 * e], __uint_as_float(q0[e] & 0xffff0000u) * PP[p0 + 2 * e + 1]);
            w1[e] = cvtpk(__uint_as_float(q1[e] << 16) * PP[p0 + 8 + 2 * e], __uint_as_float(q1[e] & 0xffff0000u) * PP[p0 + 8 + 2 * e + 1]);
          }
          *(LAS u32x4*)(QP + row * 272 + p0 * 2) = w0; *(LAS u32x4*)(QP + row * 272 + p0 * 2 + 16) = w1;
        }
        wg_sync();
        {
          const bf16_t* smt = (const bf16_t*)(P.ws + WS_SMT) + ((size_t)(bb * 4 + hh) * 256 + 32 * wid + i) * 128 + 8 * g;
          bf16x8 af[2][4];
#pragma unroll
          for (int q = 0; q < 2; ++q)
#pragma unroll
            for (int kk = 0; kk < 4; ++kk) af[q][kk] = *(const bf16x8*)(smt + (size_t)q * 16 * 128 + 32 * kk);
#pragma unroll 1
          for (int mm = 0; mm < 4; ++mm) {
            bf16x8 bfm[4];
#pragma unroll
            for (int kk = 0; kk < 4; ++kk) bfm[kk] = *(LAS const bf16x8*)(QP + (16 * mm + i) * 272 + (32 * kk + 8 * g) * 2);
#pragma unroll
            for (int q = 0; q < 2; ++q) {
              f32x4 ca = (f32x4){0.f, 0.f, 0.f, 0.f};
#pragma unroll
              for (int kk = 0; kk < 4; ++kk) ca = __builtin_amdgcn_mfma_f32_16x16x32_bf16(af[q][kk], bfm[kk], ca, 0, 0, 0);
              *(LAS u32x2*)(lds + (16 * mm + i) * 2048 + (hh * 256 + 32 * wid + 16 * q + 4 * g) * 2) = (u32x2){cvtpk(ca[0], ca[1]), cvtpk(ca[2], ca[3])};
            }
          }
        }
        wg_sync();
      }
#pragma unroll
      for (int c = 0; c < 16; ++c) {
        const u32x4 cr = *(LAS const u32x4*)(lds + row * 2048 + (part * 128 + c * 8) * 2);
#pragma unroll
        for (int e = 0; e < 4; ++e)
          ov[c][e] = cvtpk(__uint_as_float(ov[c][e] << 16) + __uint_as_float(cr[e] << 16), __uint_as_float(ov[c][e] & 0xffff0000u) + __uint_as_float(cr[e] & 0xffff0000u));
      }
      wg_sync();
    }
    float ss = 0.f;
#pragma unroll
    for (int c = 0; c < 16; ++c)
#pragma unroll
      for (int e = 0; e < 4; ++e) { const float lo = __uint_as_float(ov[c][e] << 16), hi = __uint_as_float(ov[c][e] & 0xffff0000u); ss += lo * lo + hi * hi; }
    ss = xsum<1>(ss);
    const float rinv = 1.f / sqrtf(ss * (1.f / 256.f) + LN_EPS);
#pragma unroll
    for (int c = 0; c < 16; ++c) {
      asm volatile("" ::: "memory");
      const int col = part * 128 + c * 8;
      const u32x4 zv = *(const u32x4*)(H1 + (size_t)row * P1 + col);
      const f32x4 g0 = *(const f32x4*)(gn + col), g1 = *(const f32x4*)(gn + col + 4);
      const float gg[8] = {g0[0], g0[1], g0[2], g0[3], g1[0], g1[1], g1[2], g1[3]};
      u32x4 w;
#pragma unroll
      for (int e = 0; e < 4; ++e) {
        const float o0 = __uint_as_float(ov[c][e] << 16), o1 = __uint_as_float(ov[c][e] & 0xffff0000u);
        const float z0 = __uint_as_float(zv[e] << 16), z1 = __uint_as_float(zv[e] & 0xffff0000u);
        w[e] = cvtpk(o0 * rinv * gg[2 * e] * silu_f(z0), o1 * rinv * gg[2 * e + 1] * silu_f(z1));
      }
      *(LAS u32x4*)(lds + row * 2048 + ((((part * 16 + c)) ^ (row & 15)) << 4)) = w;
    }
  }
  wg_sync();
  f32x4 acc[4][8];
#pragma unroll
  for (int m = 0; m < 4; ++m)
#pragma unroll
    for (int nt = 0; nt < 8; ++nt) acc[m][nt] = (f32x4){0.f, 0.f, 0.f, 0.f};
  const bf16_t* wp = Wf + ((size_t)(wid * 8) * 32 * 64 + lane) * 8;
  bf16x8 wf[2][8];
#pragma unroll
  for (int nt = 0; nt < 8; ++nt) wf[0][nt] = *(const bf16x8*)(wp + (size_t)(nt * 32) * 512);
#pragma unroll 1
  for (int ks = 0; ks < 32; ks += 2) {
#pragma unroll
    for (int hf = 0; hf < 2; ++hf) {
      const int kc = ks + hf;
      if (kc + 1 < 32) {
#pragma unroll
        for (int nt = 0; nt < 8; ++nt) wf[hf ^ 1][nt] = *(const bf16x8*)(wp + (size_t)(nt * 32 + kc + 1) * 512);
      }
      bf16x8 xf[4];
#pragma unroll
      for (int m = 0; m < 4; ++m) xf[m] = *(LAS const bf16x8*)(lds + (16 * m + i) * 2048 + (((4 * kc + g) ^ i) << 4));
#pragma unroll
      for (int m = 0; m < 4; ++m)
#pragma unroll
        for (int nt = 0; nt < 8; ++nt) acc[m][nt] = __builtin_amdgcn_mfma_f32_16x16x32_bf16(wf[hf][nt], xf[m], acc[m][nt], 0, 0, 0);
    }
  }
  LAS float* red = (LAS float*)(lds + RG_RED);
  {
  const int tid = otid(), lane = tid & 63, wid = __builtin_amdgcn_readfirstlane(tid >> 6), g = lane >> 4, i = lane & 15; (void)lane;
#pragma unroll
  for (int m = 0; m < 4; ++m) {
    const float* bp = base + (r0 + 16 * m + i) * D_ + wid * 128 + 4 * g;
    f32x4 bv[8];
#pragma unroll
    for (int nt = 0; nt < 8; ++nt) bv[nt] = *(const f32x4*)(bp + 16 * nt);
    float s1 = 0.f, s2 = 0.f;
#pragma unroll
    for (int nt = 0; nt < 8; ++nt) { const f32x4 v = acc[m][nt] + bv[nt] * ALPHA; acc[m][nt] = v; s1 += (v[0] + v[1]) + (v[2] + v[3]); s2 += (v[0] * v[0] + v[1] * v[1]) + (v[2] * v[2] + v[3] * v[3]); }
    s1 = xsum<16>(s1); s1 = xsum<32>(s1); s2 = xsum<16>(s2); s2 = xsum<32>(s2);
    if (g == 0) { red[((16 * m + i) * 8 + wid) * 2] = s1; red[((16 * m + i) * 8 + wid) * 2 + 1] = s2; }
  }
  wg_sync();
#pragma unroll 1
  for (int m = 0; m < 4; ++m) {
    float s1 = 0.f, s2 = 0.f;
#pragma unroll
    for (int w2 = 0; w2 < 8; ++w2) { s1 += red[((16 * m + i) * 8 + w2) * 2]; s2 += red[((16 * m + i) * 8 + w2) * 2 + 1]; }
    const float mean = s1 * (1.f / D_);
    const float var = fmaxf(s2 * (1.f / D_) - mean * mean, 0.f);
    const float rstd = 1.f / sqrtf(var + LN_EPS);
    const size_t off = (r0 + 16 * m + i) * D_ + wid * 128 + 4 * g;
#pragma unroll
    for (int nt = 0; nt < 8; ++nt) {
      const f32x4 gvv = *(const f32x4*)(gam + wid * 128 + 16 * nt + 4 * g), tvv = *(const f32x4*)(bet + wid * 128 + 16 * nt + 4 * g);
      const f32x4 av = m == 0 ? acc[0][nt] : (m == 1 ? acc[1][nt] : (m == 2 ? acc[2][nt] : acc[3][nt]));
      const f32x4 o = (av - mean) * rstd * gvv + tvv;
      *(f32x4*)(out + off + 16 * nt) = o;
      u32x2 w; w[0] = cvtpk(o[0], o[1]); w[1] = cvtpk(o[2], o[3]);
      if (outb) *(u32x2*)(outb + off + 16 * nt) = w;
      if (GLR) { const int row = 16 * m + i, chunk = 16 * wid + 2 * nt + (g >> 1);
        *(LAS u32x2*)(lds + row * 2048 + ((chunk ^ (row & 15)) << 4) + (g & 1) * 8) = w; }
    }
  }
  if (GLR) {
    wg_sync();
    const bf16_t* wg = (const bf16_t*)(P.ws + WS_WT1) + (size_t)(3072 + i) * D_ + 8 * g;
    const int mt = wid & 3, kh = wid >> 2;
    f32x4 a2 = (f32x4){0.f, 0.f, 0.f, 0.f};
#pragma unroll 4
    for (int q = 0; q < 16; ++q) {
      const int kc = kh * 16 + q;
      const bf16x8 wfr = *(const bf16x8*)(wg + 32 * kc);
      const bf16x8 xfr = *(LAS const bf16x8*)(lds + (16 * mt + i) * 2048 + (((4 * kc + g) ^ i) << 4));
      a2 = __builtin_amdgcn_mfma_f32_16x16x32_bf16(wfr, xfr, a2, 0, 0, 0);
    }
    LAS f32x4* r2 = (LAS f32x4*)(lds + RG_RED + 4096);
    if (kh == 1) r2[mt * 64 + lane] = a2;
    wg_sync();
    if (kh == 0) {
      const f32x4 tot = a2 + r2[mt * 64 + lane];
      *(f32x4*)((float*)(P.ws + WS_GLR) + (r0 + 16 * mt + i) * 16 + 4 * g) = tot;
    }
  }
  }
  wg_sync();
}

#define XB_TMO      128
#define XB_XCNT(j)  (256  + 64 * (j))
#define XB_XSUB(j)  (1280 + 64 * (j))
#define XB_XGEN(j)  (2304 + 64 * (j))
#define XB_TOP      3328
#define XB_TOPGEN   3392
#define XCD_BAR_WORDS 3456
#define XB_SPIN_CAP (1u << 18)

__device__ __forceinline__ unsigned xb_ld(unsigned* p)              { return __hip_atomic_load(p, __ATOMIC_RELAXED, __HIP_MEMORY_SCOPE_AGENT); }
__device__ __forceinline__ unsigned xb_add(unsigned* p, unsigned v) { return __hip_atomic_fetch_add(p, v, __ATOMIC_RELAXED, __HIP_MEMORY_SCOPE_AGENT); }
__device__ __forceinline__ unsigned xb_xcc_id() { return (unsigned)__builtin_amdgcn_s_getreg((3 << 11) | 20) & 0xFu; }
#define XB_SPIN(cond, bar) do { unsigned _sp = 0; while (cond) { __builtin_amdgcn_s_sleep(1); \
    if ((++_sp & 255u) == 0u) { if (xb_ld(&(bar)[XB_TMO])) break; if (_sp > XB_SPIN_CAP) { (void)__hip_atomic_fetch_add(&(bar)[XB_TMO], 1u, __ATOMIC_RELAXED, __HIP_MEMORY_SCOPE_AGENT); break; } } } } while (0)

struct XcdBarrier {
    unsigned* bar; unsigned x;
    volatile LAS unsigned* st;
};

__device__ __forceinline__ XcdBarrier xcd_barrier_post(unsigned* bar, volatile LAS unsigned* st) {
    XcdBarrier b; b.bar = bar; b.x = xb_xcc_id(); b.st = st;
    if (threadIdx.x == 0) (void)xb_add(&bar[XB_XCNT(b.x)], 1u);
    return b;
}
__device__ __forceinline__ void xcd_barrier_complete(unsigned* bar, unsigned x, unsigned& nloc, unsigned& nx) {
    const unsigned G = gridDim.x * gridDim.y * gridDim.z;
    unsigned sum, cnt, mine, sp = 0u;
    for (;;) {
        sum = 0u; cnt = 0u; mine = 0u;
#pragma unroll
        for (unsigned j = 0; j < 16; ++j) { const unsigned c = xb_ld(&bar[XB_XCNT(j)]); sum += c; cnt += (c > 0u) ? 1u : 0u; mine = (j == x) ? c : mine; }
        if (sum == G) break;
        __builtin_amdgcn_s_sleep(1);
        if ((++sp & 255u) == 0u) { if (xb_ld(&bar[XB_TMO])) break; if (sp > XB_SPIN_CAP) { (void)__hip_atomic_fetch_add(&bar[XB_TMO], 1u, __ATOMIC_RELAXED, __HIP_MEMORY_SCOPE_AGENT); break; } }
    }
    nloc = mine > 0u ? mine : 1u; nx = cnt > 0u ? cnt : 1u;
}

__device__ __forceinline__ void xcd_barrier(const XcdBarrier& b) {
    asm volatile("s_waitcnt vmcnt(0)" ::: "memory");
    wg_sync();
    if (threadIdx.x == 0) {
        unsigned* bar = b.bar;
        __builtin_amdgcn_s_waitcnt(0);
        unsigned nloc = b.st[0], nx = b.st[1];
        if (nloc == 0u) { xcd_barrier_complete(bar, b.x, nloc, nx); b.st[0] = nloc; b.st[1] = nx; }
        const unsigned old = xb_add(&bar[XB_XSUB(b.x)], 1u);
        const unsigned gen = old / nloc;
        if (old + 1u == (gen + 1u) * nloc) {
            __builtin_amdgcn_fence(__ATOMIC_RELEASE, "agent");
            asm volatile("s_waitcnt vmcnt(0)" ::: "memory");
            const unsigned og = xb_add(&bar[XB_TOP], 1u);
            const unsigned tg = og / nx;
            if (og + 1u == (tg + 1u) * nx) xb_add(&bar[XB_TOPGEN], 1u);
            else XB_SPIN(xb_ld(&bar[XB_TOPGEN]) == tg, bar);
            __builtin_amdgcn_fence(__ATOMIC_ACQUIRE, "agent");
            xb_add(&bar[XB_XGEN(b.x)], 1u);
            asm volatile("s_waitcnt vmcnt(0)" ::: "memory");
        } else {
            XB_SPIN(xb_ld(&bar[XB_XGEN(b.x)]) == gen, bar);
            __builtin_amdgcn_fence(__ATOMIC_ACQUIRE, "agent");
            asm volatile("s_waitcnt vmcnt(0)" ::: "memory");
        }
    }
    wg_sync();
}


__device__ const unsigned short p3_order[1024] = {638,636,634,632,630,628,626,624,15,143,271,399,622,14,142,270,398,620,618,13,141,269,397,616,614,12,140,268,396,612,610,11,139,267,395,608,606,10,138,266,394,604,602,9,137,265,393,560,562,564,566,568,570,572,574,544,546,548,550,552,554,556,558,600,536,538,540,542,534,598,8,136,264,392,532,596,530,594,7,135,263,391,528,592,6,134,262,390,526,590,524,588,5,133,261,389,522,586,520,584,4,132,260,388,518,582,3,131,259,387,516,580,2,130,258,386,514,578,1,129,257,385,512,576,0,128,256,384,639,637,635,633,631,629,627,625,31,159,287,415,623,621,30,158,286,414,619,617,29,157,285,413,615,613,28,156,284,412,611,609,27,155,283,411,607,26,154,282,410,605,603,25,153,281,409,561,563,565,567,569,571,573,575,601,545,547,549,551,553,555,557,559,535,537,539,541,543,599,24,152,280,408,533,597,531,595,23,151,279,407,529,593,527,591,22,150,278,406,525,589,523,587,21,149,277,405,521,585,20,148,276,404,519,583,19,147,275,403,517,581,18,146,274,402,515,579,17,145,273,401,513,577,16,144,272,400,766,764,762,760,758,756,754,752,47,175,303,431,750,46,174,302,430,748,746,45,173,301,429,744,742,44,172,300,428,740,738,43,171,299,427,736,734,42,170,298,426,732,730,41,169,297,425,688,690,692,694,696,698,700,702,672,674,676,678,680,682,684,686,728,664,666,668,670,662,726,40,168,296,424,660,724,658,722,39,167,295,423,656,720,38,166,294,422,654,718,652,716,37,165,293,421,650,714,648,712,36,164,292,420,646,710,35,163,291,419,644,708,34,162,290,418,642,706,33,161,289,417,640,704,32,160,288,416,767,765,763,761,759,757,755,753,63,191,319,447,751,749,62,190,318,446,747,745,61,189,317,445,743,741,60,188,316,444,739,737,59,187,315,443,735,58,186,314,442,733,731,57,185,313,441,689,691,693,695,697,699,701,703,729,673,675,677,679,681,683,685,687,663,665,667,669,671,727,56,184,312,440,661,725,659,723,55,183,311,439,657,721,655,719,54,182,310,438,653,717,651,715,53,181,309,437,649,713,52,180,308,436,647,711,51,179,307,435,645,709,50,178,306,434,643,707,49,177,305,433,641,705,48,176,304,432,894,892,890,888,886,884,882,880,79,207,335,463,878,78,206,334,462,876,874,77,205,333,461,872,870,76,204,332,460,868,866,75,203,331,459,864,862,74,202,330,458,860,858,73,201,329,457,816,818,820,822,824,826,828,830,800,802,804,806,808,810,812,814,856,792,794,796,798,790,854,72,200,328,456,788,852,786,850,71,199,327,455,784,848,70,198,326,454,782,846,780,844,69,197,325,453,778,842,776,840,68,196,324,452,774,838,67,195,323,451,772,836,66,194,322,450,770,834,65,193,321,449,768,832,64,192,320,448,895,893,891,889,887,885,883,881,95,223,351,479,879,877,94,222,350,478,875,873,93,221,349,477,871,869,92,220,348,476,867,865,91,219,347,475,863,90,218,346,474,861,859,89,217,345,473,817,819,821,823,825,827,829,831,857,801,803,805,807,809,811,813,815,791,793,795,797,799,855,88,216,344,472,789,853,787,851,87,215,343,471,785,849,783,847,86,214,342,470,781,845,779,843,85,213,341,469,777,841,84,212,340,468,775,839,83,211,339,467,773,837,82,210,338,466,771,835,81,209,337,465,769,833,80,208,336,464,1022,1020,1018,1016,1014,1012,1010,1008,111,239,367,495,1006,110,238,366,494,1004,1002,109,237,365,493,1000,998,108,236,364,492,996,994,107,235,363,491,992,990,106,234,362,490,988,986,105,233,361,489,944,946,948,950,952,954,956,958,928,930,932,934,936,938,940,942,984,920,922,924,926,918,982,104,232,360,488,916,980,914,978,103,231,359,487,912,976,102,230,358,486,910,974,908,972,101,229,357,485,906,970,904,968,100,228,356,484,902,966,99,227,355,483,900,964,98,226,354,482,898,962,97,225,353,481,896,960,96,224,352,480,1023,1021,1019,1017,1015,1013,1011,1009,127,255,383,511,1007,1005,126,254,382,510,1003,1001,125,253,381,509,999,997,124,252,380,508,995,993,123,251,379,507,991,122,250,378,506,989,987,121,249,377,505,945,947,949,951,953,955,957,959,985,929,931,933,935,937,939,941,943,919,921,923,925,927,983,120,248,376,504,917,981,915,979,119,247,375,503,913,977,911,975,118,246,374,502,909,973,907,971,117,245,373,501,905,969,116,244,372,500,903,967,115,243,371,499,901,965,114,242,370,498,899,963,113,241,369,497,897,961,112,240,368,496};
constexpr int CTL_P3_QUEUE = 8192;
constexpr int CTL_LN0 = 4096, CTL_LN1 = 9216, CTL_TMO = 3520;
constexpr size_t WS_XCH0 = 253 * MiB, WS_XCH1 = 254 * MiB;

#ifndef REP_P0
#define REP_P0 1
#endif
#ifndef REP_P2
#define REP_P2 1
#endif
#ifndef REP_P3
#define REP_P3 1
#endif
#ifndef REP_P7
#define REP_P7 1
#endif
#ifndef REP_P8
#define REP_P8 1
#endif
__global__ void __launch_bounds__(512) __attribute__((target("no-packed-fp32-ops"))) fwd_megakernel(Params P) {
  cg::grid_group grid = cg::this_grid();
  extern __shared__ __attribute__((aligned(16))) unsigned char smem[];
  const int tid = otid(), lane = tid & 63, wid = tid >> 6;
  unsigned char* ws = P.ws;
  bf16_t* XB = (bf16_t*)(ws + WS_XB);
  bf16_t* MIX = (bf16_t*)(ws + WS_MIX);
  bf16_t* Hb = (bf16_t*)(ws + WS_H);
  float* Y = (float*)(ws + WS_H);
  volatile LAS unsigned* xst = (volatile LAS unsigned*)((LAS unsigned char*)smem + XB_LDS_OFF);
  if (tid < 4) xst[tid] = 0u;
  wg_sync();
  (void)xcd_barrier_post((unsigned*)ws, xst);
#define GRID_BAR() do { XcdBarrier xb_; xb_.bar = (unsigned*)P.ws; xb_.x = xb_xcc_id(); xb_.st = (volatile LAS unsigned*)((LAS unsigned char*)smem + XB_LDS_OFF); xcd_barrier(xb_); } while (0)

  for (int rep = 0; rep < REP_P0; ++rep) {
    const float4* x4 = (const float4*)P.in[0];
    const size_t n4 = (size_t)M_ * D_ / 4;
    {
      const size_t stride = (size_t)gridDim.x * 512;
      for (size_t i = (size_t)blockIdx.x * 512 + tid; i < n4; i += 8 * stride) {
        float4 v[8];
#pragma unroll
        for (int u = 0; u < 8; ++u) if (i + u * stride < n4) v[u] = x4[i + u * stride];
#pragma unroll
        for (int u = 0; u < 8; ++u) if (i + u * stride < n4) { ushort4 o; o.x = f2bf(v[u].x); o.y = f2bf(v[u].y); o.z = f2bf(v[u].z); o.w = f2bf(v[u].w); ((ushort4*)XB)[i + u * stride] = o; }
      }
    }
    {
      constexpr int T0 = (P0 / 32) * 16, T1 = 32 * 16, T2 = (P1 / 32) * 16, T3 = 32 * 16, T4 = 2 * 4 * 32, T5 = 2 * 2 * 2;
      float* scr = (float*)smem + wid * (64 * 33);
      for (int it = blockIdx.x * 8 + wid; it < T0 + T1 + T2 + T3 + T4 + T5; it += gridDim.x * 8) {
        int r = it;
        if (r < T0) { transpose_wave_tile(P.in[1], D_, EVEN_IN, (bf16_t*)(ws + WS_WT0), 0, r, P0 / 32, scr, lane); continue; } r -= T0;
        if (r < T1) { transpose_wave_tile(P.in[6], D_, D_, (bf16_t*)(ws + WS_WO0), 3, r, 32, scr, lane); continue; } r -= T1;
        if (r < T2) { transpose_wave_tile(P.in[9], D_, ODD_IN, (bf16_t*)(ws + WS_WT1), 1, r, P1 / 32, scr, lane); continue; } r -= T2;
        if (r < T3) { transpose_wave_tile(P.in[13], D_, D_, (bf16_t*)(ws + WS_WO1), 3, r, 32, scr, lane); continue; } r -= T3;
        if (r < T4) { const int i = r >> 7; transpose_wave_tile(P.in[3] + (size_t)i * 2048 * 128, 2048, 128, (bf16_t*)(ws + WS_W1T) + (size_t)i * 128 * 2048, 2, r & 127, 4, scr, lane); continue; } r -= T4;
        { const int i = r >> 2; transpose_wave_tile(P.in[5] + (size_t)i * 128 * 64, 128, 64, (bf16_t*)(ws + WS_W2T) + (size_t)i * 64 * 128, 2, r & 3, 2, scr, lane); }
      }
      wg_sync();
    }
    for (int it = blockIdx.x + 132; it < 2 * 64 + 2 * 2 + 64; it += gridDim.x) {
      {
        const int t2 = it - 132, i = t2 >> 5, q = t2 & 31, hh = tid & 127, sub = tid >> 7;
        const float* pos = P.in[2] + i * 2048 + q * 64 + sub * 16;
        const float* w1 = P.in[3] + ((size_t)i * 2048 + q * 64 + sub * 16) * 128 + hh;
        float a = 0.f;
#pragma unroll
        for (int f = 0; f < 16; ++f) a += pos[f] * w1[f * 128];
        float* red = (float*)smem;
        red[sub * 128 + hh] = a;
        wg_sync();
        if (tid < 128) ((float*)(ws + WS_C1P))[(i * 32 + q) * 128 + tid] = (red[tid] + red[128 + tid]) + (red[256 + tid] + red[384 + tid]);
        wg_sync();
      }
    }
    for (int q = blockIdx.x * 512 + tid; q < B_ * 16 * 512; q += gridDim.x * 512) ((float*)(ws + WS_KM))[q] = 0.f;
    if (blockIdx.x == 0) { const int which = tid >> 8, r = tid & 255;
      unsigned* z = (unsigned*)(ws + (which == 0 ? (size_t)(248 * MiB) : (size_t)(249 * MiB)));
      const int bg = r >> 5, wd = r & 31; z[((size_t)bg * 256 + 255) * 32 + wd] = 0u; }
    GRID_BAR();
  }
  if (P.out == nullptr) grid.sync();
  { pg8::Gemm gm{XB, (const bf16_t*)(ws + WS_WT0), M_, P0, D_}; pg8::StaticOrder so; so.init(M_, P0, (int)gridDim.x, (int)blockIdx.x);
    pg8::EpiBf16s ep{Hb, P0, (3u << (C_NQ / 256)) | (3u << (C_MQ / 256)), C1, (float*)(ws + WS_KM), C_MK / 256}; pg8::gemm_phase<pg8::EpiBf16s, pg8::StaticOrder, true, true>((LAS unsigned char*)smem, gm, so, ep); }
  GRID_BAR();
  for (int rep = 0; rep < REP_P2; ++rep) {
    for (int it = blockIdx.x; it < 256; it += gridDim.x) compress_mfma_tile(P, it, smem);
    GRID_BAR();
  }
  for (int rep = 0; rep < REP_P3; ++rep) {
    const int myx = (int)(xb_xcc_id() & 7u);
    int steal = 0;
    for (;;) {
      LAS int* qslot = (LAS int*)((LAS unsigned char*)smem + AT_MISC + 384);
      const int qx = (myx + steal) & 7;
      if (tid == 0) *qslot = (int)__hip_atomic_fetch_add((unsigned*)P.ws + CTL_P3_QUEUE + 64 * qx, 1u, __ATOMIC_RELAXED, __HIP_MEMORY_SCOPE_AGENT) - rep * 128;
      wg_sync();
      int it = __builtin_amdgcn_readfirstlane(*qslot);
      wg_sync();
      if (it >= 128) { if (++steal == 8) break; continue; }
      it += qx * 128;
      const int e = p3_order[it], pl = e & 511;
#ifdef FORCE_SAFE
      if (e >> 9) (void)nsa_mfma_item<true>(P, pl >> 7, (pl >> 6) & 1, pl & 63, smem);
      else (void)moba_mfma_item<true>(P, pl >> 7, (pl >> 4) & 7, pl & 15, smem);
#else
      if (e >> 9) { if (nsa_mfma_item<false>(P, pl >> 7, (pl >> 6) & 1, pl & 63, smem)) (void)nsa_mfma_item<true>(P, pl >> 7, (pl >> 6) & 1, pl & 63, smem); }
      else { if (moba_mfma_item<false>(P, pl >> 7, (pl >> 4) & 7, pl & 15, smem)) (void)moba_mfma_item<true>(P, pl >> 7, (pl >> 4) & 7, pl & 15, smem); }
#endif
    }
    GRID_BAR();
  }
  if ((int)blockIdx.x < M_ / 64) rowgemm_block<0, true>(P, (int)blockIdx.x, (const bf16_t*)(ws + WS_WO0), P.in[0], P.out, XB, P.in[7], P.in[8], smem);
  GRID_BAR();
  { pg8::Gemm gm{XB, (const bf16_t*)(ws + WS_WT1), M_, 3072, D_}; pg8::StaticOrder so; so.init(M_, 3072, (int)gridDim.x, (int)blockIdx.x);
    pg8::EpiBf16s ep{Hb, P1, 0u, 1.f, nullptr, 0}; pg8::gemm_phase<pg8::EpiBf16s, pg8::StaticOrder, true, true>((LAS unsigned char*)smem, gm, so, ep); }
  GRID_BAR();
  for (int rep = 0; rep < REP_P8; ++rep) {
    { const int j = (int)blockIdx.x; if (j < 256) gla_prep_item(P, (j & 15) * 64 + ((j >> 4) & 1) * 32 + (j >> 5), smem); }
    if ((int)blockIdx.x < 128) { const int w = (int)blockIdx.x, u = w >> 3, bh = (w & 7) + 8 * (u >> 3), eq = u & 3, seg = (u >> 2) & 1;
      gla_chain64(P, bh * 4 + eq, seg, smem); }
    else for (int j = 256 + (int)blockIdx.x - 128; j < 1024; j += 128) gla_prep_item(P, (j & 15) * 64 + ((j >> 4) & 1) * 32 + (j >> 5), smem);
    GRID_BAR();
  }
  if ((int)blockIdx.x < M_ / 64) rowgemm_block<1, false>(P, (int)blockIdx.x, (const bf16_t*)(ws + WS_WO1), P.out, P.out, nullptr, P.in[14], P.in[15], smem);
}

extern "C" void kernel_launch(void* const* d_in, const int* in_sizes, int n_in, void* d_out, int out_size,
                              void* d_ws, size_t ws_size, hipStream_t stream) {
  constexpr size_t kDynLds = 157696;
  static_assert((size_t)XB_LDS_OFF >= (size_t)G4_END && kDynLds <= 163840 && kDynLds >= (size_t)XB_LDS_OFF + 16 && (size_t)XB_LDS_OFF >= (size_t)AT_LDS_END && kDynLds >= (size_t)AT_LDS_END && kDynLds >= 2 * (size_t)GS_BYTES && kDynLds >= (size_t)pg8::STAGE_BYTES, "LDS");
  static int grid_blocks = 0;
  if (!grid_blocks) {
    int dev = 0, cus = 0, per_cu = 0;
    (void)hipGetDevice(&dev);
    (void)hipDeviceGetAttribute(&cus, hipDeviceAttributeMultiprocessorCount, dev);
    (void)hipFuncSetAttribute((const void*)fwd_megakernel, hipFuncAttributeMaxDynamicSharedMemorySize, (int)kDynLds);
    (void)hipOccupancyMaxActiveBlocksPerMultiprocessor(&per_cu, fwd_megakernel, 512, kDynLds);
    if (per_cu < 1) per_cu = 1;
    if (per_cu > 2) per_cu = 2;
    grid_blocks = cus * per_cu;
    if (grid_blocks != 256) { fprintf(stderr, "kernel_launch: this kernel is laid out for exactly 256 co-resident workgroups (256 CUs x 1); got %d x %d\n", cus, per_cu); grid_blocks = 256; }
    if (n_in != 16 || ws_size < WS_END) { fprintf(stderr, "kernel_launch: unexpected n_in %d / ws %zu\n", n_in, ws_size); }
  }
  (void)hipMemsetAsync(d_ws, 0, 524288, stream);
  Params p{};
  for (int i = 0; i < 16; ++i) p.in[i] = (const float*)d_in[i];
  p.out = (float*)d_out; p.ws = (unsigned char*)d_ws;
  void* args[] = {&p};
  hipError_t e = hipLaunchCooperativeKernel((void*)fwd_megakernel, dim3(grid_blocks), dim3(512), args, kDynLds, stream);
  if (e != hipSuccess) fprintf(stderr, "cooperative launch failed: %s (grid %d)\n", hipGetErrorString(e), grid_blocks);
}
```

```cpp
#include <hip/hip_runtime.h>
#include <hip/hip_cooperative_groups.h>
#include <cstdio>
#include <cstdint>
namespace cg = cooperative_groups;

typedef unsigned short bf16_t;
typedef short bf16x8 __attribute__((ext_vector_type(8)));
typedef float f32x4 __attribute__((ext_vector_type(4)));
typedef unsigned u32x4 __attribute__((ext_vector_type(4)));
typedef unsigned u32x2 __attribute__((ext_vector_type(2)));

constexpr int B_ = 4, S_ = 4096, M_ = B_ * S_, D_ = 1024;
constexpr int P0 = 4096;
constexpr int P1 = 3328;
constexpr int EVEN_IN = 3864, ODD_IN = 3088;
constexpr int C_NQ = 0, C_KCMP = 512, C_VCMP = 640, C_KSEL = 768, C_VSEL = 896, C_KWIN = 1024, C_VWIN = 1152;
constexpr int C_NZ = 1280, C_MQ = 1792, C_MK = 2304, C_MV = 2816, C_MZ = 3328, C_NG = 3840;
constexpr int G_Q = 0, G_K = 512, G_V = 1024, G_Z = 2048, G_LR = 3072;
constexpr int NCMP = 255;
constexpr float ALPHA = 1.4142135623730951f;
constexpr float LN_EPS = 1e-5f;

constexpr size_t MiB = 1u << 20;
constexpr int XB_LDS_OFF = 157440;
constexpr size_t WS_WT0 = 1 * MiB;
constexpr size_t WS_WO0 = 9 * MiB;
constexpr size_t WS_WT1 = 11 * MiB;
constexpr size_t WS_WO1 = 18 * MiB;
constexpr size_t WS_XB = 20 * MiB;
constexpr size_t WS_MIX = 52 * MiB;
constexpr size_t WS_GO = WS_MIX;
constexpr size_t WS_H = 84 * MiB;
constexpr size_t WS_G = 212 * MiB;
constexpr size_t WS_GLR = 245 * MiB;
constexpr size_t WS_SMT = 246 * MiB;
constexpr size_t WS_KC = 245 * MiB;
constexpr size_t WS_VC = 246 * MiB;
constexpr size_t WS_KM = 247 * MiB;
constexpr size_t WS_END = 256 * MiB;

struct Params { const float* in[16]; float* out; unsigned char* ws; };

__device__ __forceinline__ int otid() { int t = __builtin_amdgcn_workitem_id_x(); asm volatile("" : "+v"(t)); return t; }
__device__ __forceinline__ void wg_sync() { __builtin_amdgcn_fence(__ATOMIC_RELEASE, "workgroup"); __builtin_amdgcn_s_barrier(); __builtin_amdgcn_fence(__ATOMIC_ACQUIRE, "workgroup"); }
__device__ __forceinline__ float bf2f(bf16_t v) { return __uint_as_float(((unsigned)v) << 16); }
__device__ __forceinline__ bf16_t f2bf(float f) { unsigned u = __float_as_uint(f); return (bf16_t)((u + 0x7fffu + ((u >> 16) & 1u)) >> 16); }
template <int M> __device__ __forceinline__ float xsum(float v) {
  if constexpr (M == 32) { auto rr = __builtin_amdgcn_permlane32_swap(__float_as_uint(v), __float_as_uint(v), false, false); return __uint_as_float(rr[0]) + __uint_as_float(rr[1]); }
  else return v + __int_as_float(__builtin_amdgcn_ds_swizzle(__float_as_int(v), (M << 10) | 0x1f));
}
template <int M> __device__ __forceinline__ float xmax(float v) {
  if constexpr (M == 32) { auto rr = __builtin_amdgcn_permlane32_swap(__float_as_uint(v), __float_as_uint(v), false, false); return fmaxf(__uint_as_float(rr[0]), __uint_as_float(rr[1])); }
  else return fmaxf(v, __int_as_float(__builtin_amdgcn_ds_swizzle(__float_as_int(v), (M << 10) | 0x1f)));
}
template <int M> __device__ __forceinline__ unsigned xorr(unsigned v) {
  if constexpr (M == 32) { auto rr = __builtin_amdgcn_permlane32_swap(v, v, false, false); return rr[0] | rr[1]; }
  else return v | (unsigned)__builtin_amdgcn_ds_swizzle((int)v, (M << 10) | 0x1f);
}
__device__ __forceinline__ float wave_sum(float v) { v = xsum<1>(v); v = xsum<2>(v); v = xsum<4>(v); v = xsum<8>(v); v = xsum<16>(v); return xsum<32>(v); }
__device__ __forceinline__ float wave_max(float v) { v = xmax<1>(v); v = xmax<2>(v); v = xmax<4>(v); v = xmax<8>(v); v = xmax<16>(v); return xmax<32>(v); }
__device__ __forceinline__ float silu_f(float z) { return z / (1.f + __expf(-z)); }
__device__ __forceinline__ float sigmoid_f(float z) { return 1.f / (1.f + __expf(-z)); }

__device__ __forceinline__ int colmap0(int c) {
  if (c < 1280) return c;
  if (c < 1792) return 1304 + (c - 1280);
  if (c < 3840) return 1816 + (c - 1792);
  if (c < 3864) return 1280 + (c - 3840);
  return -1;
}
__device__ __forceinline__ int colmap1(int c) {
  if (c < 2048) return c;
  if (c < 3072) return 2064 + (c - 2048);
  if (c < 3088) return 2048 + (c - 3072);
  return -1;
}

__device__ __forceinline__ void transpose_tile(const float* __restrict__ W, int K, int Nsrc, bf16_t* __restrict__ Wt, int which, int tile, int ntn, float* sm) {
  const int tid = otid();
  const int nb = tile % ntn, kb = tile / ntn, n0 = nb * 64, k0 = kb * 64;
#pragma unroll
  for (int i = 0; i < 8; ++i) {
    const int kk = i * 8 + (tid >> 6), nn = tid & 63;
    const int c = n0 + nn;
    const int src = which == 0 ? colmap0(c) : (which == 1 ? colmap1(c) : c);
    sm[kk * 65 + nn] = src >= 0 ? W[(size_t)(k0 + kk) * Nsrc + src] : 0.f;
  }
  wg_sync();
#pragma unroll
  for (int i = 0; i < 8; ++i) {
    const int nn = i * 8 + (tid >> 6), kk = tid & 63;
    Wt[(size_t)(n0 + nn) * K + k0 + kk] = f2bf(sm[kk * 65 + nn]);
  }
  wg_sync();
}


__device__ __forceinline__ void transpose_wave_tile(const float* __restrict__ W, int K, int Nsrc, bf16_t* __restrict__ Wt, int which, int tile, int ntn, float* scr, int lane) {
  const int nb = tile % ntn, kb = tile / ntn, n0 = nb * 32, k0 = kb * 64;
  const int c = n0 + (lane & 31);
  const int src = which == 0 ? colmap0(c) : (which == 1 ? colmap1(c) : c);
  float v[32];
#pragma unroll
  for (int q = 0; q < 32; ++q) { const int kk = 2 * q + (lane >> 5); v[q] = src >= 0 ? __builtin_nontemporal_load(W + (size_t)(k0 + kk) * Nsrc + src) : 0.f; }
#pragma unroll
  for (int q = 0; q < 32; ++q) { const int kk = 2 * q + (lane >> 5); scr[kk * 33 + (lane & 31)] = v[q]; }
  __builtin_amdgcn_wave_barrier();
  if (which == 3) {
    const int k = k0 + lane;
#pragma unroll 8
    for (int nn = 0; nn < 32; ++nn) { const int n = n0 + nn; Wt[((size_t)(((n >> 4) * 32 + (k >> 5)) * 64 + ((k >> 3) & 3) * 16 + (n & 15))) * 8 + (k & 7)] = f2bf(scr[lane * 33 + nn]); }
  } else {
#pragma unroll 8
    for (int nn = 0; nn < 32; ++nn) Wt[(size_t)(n0 + nn) * K + k0 + lane] = f2bf(scr[lane * 33 + nn]);
  }
  __builtin_amdgcn_wave_barrier();
}

__device__ __forceinline__ void gemm_tile(const bf16_t* __restrict__ A, const bf16_t* __restrict__ Bt, int K, int m0, int n0, int mode, void* outp, int ldc, unsigned char* smem) {
  bf16_t* As = (bf16_t*)smem;
  bf16_t* Bs = As + 128 * 72;
  const int tid = otid(), lane = tid & 63, wid = tid >> 6, wm = wid >> 1, wn = wid & 1;
  f32x4 acc[2][4];
#pragma unroll
  for (int i = 0; i < 2; ++i)
#pragma unroll
    for (int j = 0; j < 4; ++j) acc[i][j] = (f32x4){0.f, 0.f, 0.f, 0.f};
  for (int k0 = 0; k0 < K; k0 += 64) {
#pragma unroll
    for (int i = 0; i < 2; ++i) {
      const int idx = tid + i * 512, r = idx >> 3, c = (idx & 7) * 8;
      *(uint4*)(As + r * 72 + c) = *(const uint4*)(A + (size_t)(m0 + r) * K + k0 + c);
      *(uint4*)(Bs + r * 72 + c) = *(const uint4*)(Bt + (size_t)(n0 + r) * K + k0 + c);
    }
    wg_sync();
#pragma unroll
    for (int kk = 0; kk < 64; kk += 32) {
      bf16x8 a[2], b[4];
#pragma unroll
      for (int i = 0; i < 2; ++i) a[i] = *(const bf16x8*)(As + (wm * 32 + i * 16 + (lane & 15)) * 72 + kk + (lane >> 4) * 8);
#pragma unroll
      for (int j = 0; j < 4; ++j) b[j] = *(const bf16x8*)(Bs + (wn * 64 + j * 16 + (lane & 15)) * 72 + kk + (lane >> 4) * 8);
#pragma unroll
      for (int i = 0; i < 2; ++i)
#pragma unroll
        for (int j = 0; j < 4; ++j) acc[i][j] = __builtin_amdgcn_mfma_f32_16x16x32_bf16(a[i], b[j], acc[i][j], 0, 0, 0);
    }
    wg_sync();
  }
#pragma unroll
  for (int i = 0; i < 2; ++i)
#pragma unroll
    for (int j = 0; j < 4; ++j)
#pragma unroll
      for (int r = 0; r < 4; ++r) {
        const int row = m0 + wm * 32 + i * 16 + (lane >> 4) * 4 + r, col = n0 + wn * 64 + j * 16 + (lane & 15);
        if (mode == 0) ((bf16_t*)outp)[(size_t)row * ldc + col] = f2bf(acc[i][j][r]);
        else ((float*)outp)[(size_t)row * ldc + col] = acc[i][j][r];
      }
}
__device__ __forceinline__ void gemm_phase(const bf16_t* A, const bf16_t* Bt, int K, int N, int mode, void* outp, int ldc, unsigned char* smem) {
  const int ntn = N / 128, ntm = M_ / 128;
  for (int t = blockIdx.x; t < ntn * ntm; t += gridDim.x) {
    const int tn = t % ntn, tm = t / ntn;
    gemm_tile(A, Bt, K, tm * 128, tn * 128, mode, outp, ldc, smem);
  }
}

namespace pg8 {
#define PG8_LAS __attribute__((address_space(3)))
typedef unsigned short bf16_t;
typedef short bf16x8 __attribute__((ext_vector_type(8)));
typedef float f32x4 __attribute__((ext_vector_type(4)));
typedef unsigned u32x4 __attribute__((ext_vector_type(4)));
constexpr int BM = 256, BK = 64, HALF = 128, HTB = HALF * BK * 2  , STAGE_BYTES = 8 * HTB, NXCD = 8, WGM = 8;

__host__ __device__ __forceinline__ int lds_byte(int r, int c) { const int st = (r >> 4) * 2 + (c >> 5), rr = r & 15, cc = c & 31, ob = rr * 64 + cc * 2; return st * 1024 + (ob ^ (((ob >> 9) & 1) << 5)); }
__host__ __device__ __forceinline__ void stage_rc(int b, int& R, int& C) { const int st = b / 1024, sb = b % 1024, swz = sb ^ (((sb >> 9) & 1) << 5); R = (st >> 1) * 16 + swz / 64; C = (st & 1) * 32 + (swz % 64) / 2; }
__host__ __device__ __forceinline__ int perm32(int rho) { const int n = rho >> 4, i = rho & 15; return 8 * (i >> 2) + 4 * n + (i & 3); }

__device__ __forceinline__ unsigned cvtpk(float lo, float hi) { typedef float f2 __attribute__((ext_vector_type(2))); typedef __bf16 b2 __attribute__((ext_vector_type(2))); f2 v = {lo, hi}; b2 b = __builtin_convertvector(v, b2); return __builtin_bit_cast(unsigned, b); }
template <int M> __device__ __forceinline__ float xsum_sw(float v) { return v + __int_as_float(__builtin_amdgcn_ds_swizzle(__float_as_int(v), (M << 10) | 0x1f)); }
struct Unit { int pm, pn; };
struct Gemm { const bf16_t* A; const bf16_t* Bt; int M, N, K; };

struct StaticOrder {
    int nM, nN, nwg, G, c;
    __host__ __device__ __forceinline__ void init(int M, int N, int G_, int c_) { nM = M / BM; nN = N / BM; nwg = nM * nN; G = G_; c = c_; }
    __host__ __device__ bool next(int i, Unit& u) const {
        const long L = (long)i * G + c; if (L >= nwg) return false;
        int wgid = (int)L; { const int q = nwg / NXCD, r = nwg % NXCD, xcd = wgid % NXCD, off = wgid / NXCD; wgid = (xcd < r ? xcd * (q + 1) : r * (q + 1) + (xcd - r) * q) + off; }
        const int nig = WGM * nN, gid = wgid / nig, fm = gid * WGM, gsz = (nM - fm) < WGM ? (nM - fm) : WGM;
        u.pm = fm + ((wgid % nig) % gsz); u.pn = (wgid % nig) / gsz; return true;
    }
    __device__ __forceinline__ void a_ready(const Unit&) const {}
    __device__ __forceinline__ void done(const Unit&) const {}
};


struct EpiBf16s {
    static constexpr bool PERM = true, AFTER_DRAIN = false;
    bf16_t* O; int ldc;
    unsigned qmask; float qscale;
    float* km; int km_pn0;
    __device__ __forceinline__ void operator()(const f32x4 (&acc)[2][2][4][2], const Unit& u, int wr, int wc, int fr, int fq) const {
        const int row0 = u.pm * BM + wr * 64 + fr, col0 = u.pn * BM + wc * 32 + 8 * fq;
        const float sc = ((qmask >> u.pn) & 1u) ? qscale : 1.f;
#pragma unroll
        for (int ai = 0; ai < 2; ++ai)
#pragma unroll
            for (int m = 0; m < 4; ++m) { bf16_t* rowp = O + (size_t)(row0 + ai * HALF + m * 16) * ldc + col0;
#pragma unroll
                for (int bj = 0; bj < 2; ++bj) { const f32x4 v0 = acc[ai][bj][m][0] * sc, v1 = acc[ai][bj][m][1] * sc;
                    u32x4 w; w.x = cvtpk(v0[0], v0[1]); w.y = cvtpk(v0[2], v0[3]); w.z = cvtpk(v1[0], v1[1]); w.w = cvtpk(v1[2], v1[3]);
                    *(u32x4*)(rowp + bj * HALF) = w; } }
        if (km != nullptr && (u.pn == km_pn0 || u.pn == km_pn0 + 1)) {
#pragma unroll
            for (int bj = 0; bj < 2; ++bj)
#pragma unroll
                for (int n = 0; n < 2; ++n) {
                    f32x4 sacc = (f32x4){0.f, 0.f, 0.f, 0.f};
#pragma unroll
                    for (int ai = 0; ai < 2; ++ai)
#pragma unroll
                        for (int m = 0; m < 4; ++m) sacc += acc[ai][bj][m][n];
#pragma unroll
                    for (int e = 0; e < 4; ++e) { float v = sacc[e]; v = xsum_sw<1>(v); v = xsum_sw<2>(v); v = xsum_sw<4>(v); v = xsum_sw<8>(v); sacc[e] = v; }
                    if (fr == 0) { float* dst = km + (size_t)u.pm * 512 + (u.pn - km_pn0) * BM + bj * HALF + wc * 32 + 8 * fq + 4 * n;
#pragma unroll
                        for (int e = 0; e < 4; ++e) atomicAdd(dst + e, sacc[e] * (1.0f / 256.0f)); }
                }
        }
    }
};
struct EpiF32 {
    static constexpr bool PERM = false, AFTER_DRAIN = false;
    float* O; int ldc;
    __device__ __forceinline__ void operator()(const f32x4 (&acc)[2][2][4][2], const Unit& u, int wr, int wc, int fr, int fq) const {
        const int col0 = u.pn * BM + wc * 32 + 4 * fq;
#pragma unroll
        for (int ai = 0; ai < 2; ++ai)
#pragma unroll
            for (int m = 0; m < 4; ++m) { float* rowp = O + (size_t)(u.pm * BM + ai * HALF + wr * 64 + m * 16 + fr) * ldc + col0;
#pragma unroll
                for (int bj = 0; bj < 2; ++bj)
#pragma unroll
                    for (int n = 0; n < 2; ++n) *(f32x4*)(rowp + bj * HALF + n * 16) = acc[ai][bj][m][n]; }
    }
};

struct PanelStats {
    unsigned* xbuf;
    unsigned* cnt;
    unsigned* tmo;
    int ntn; float eps;
    unsigned code;
    __device__ __forceinline__ bool run(const f32x4 (&v)[2][2][4][2], const Unit& u, int wr, int wc, int fr, int fq, PG8_LAS unsigned char* lds, int wid, int lane) const {
        typedef float f32x2v __attribute__((ext_vector_type(2)));
        PG8_LAS f32x2v* P = (PG8_LAS f32x2v*)lds;
        PG8_LAS f32x2v* S = (PG8_LAS f32x2v*)(lds + 8192);
        PG8_LAS unsigned* flag = (PG8_LAS unsigned*)(lds + 8192 + 2048);
#pragma unroll
        for (int ai = 0; ai < 2; ++ai)
#pragma unroll
            for (int m = 0; m < 4; ++m) {
                float s = 0.f;
#pragma unroll
                for (int bj = 0; bj < 2; ++bj)
#pragma unroll
                    for (int n = 0; n < 2; ++n) { const f32x4 x = v[ai][bj][m][n]; s += (x[0] + x[1]) + (x[2] + x[3]); }
                s += __shfl_xor(s, 16); s += __shfl_xor(s, 32);
                const float mw = s * (1.0f / 64.0f); float q = 0.f;
#pragma unroll
                for (int bj = 0; bj < 2; ++bj)
#pragma unroll
                    for (int n = 0; n < 2; ++n) { const f32x4 d = v[ai][bj][m][n] - mw; q += (d[0] * d[0] + d[1] * d[1]) + (d[2] * d[2] + d[3] * d[3]); }
                q += __shfl_xor(q, 16); q += __shfl_xor(q, 32);
                if (fq == 0) P[(ai * HALF + wr * 64 + m * 16 + fr) * 4 + wc] = (f32x2v){mw, q};
            }
        asm volatile("s_waitcnt lgkmcnt(0)" ::: "memory"); __builtin_amdgcn_s_barrier(); asm volatile("" ::: "memory");
#if defined(BROKEN_EXCHANGE_NO_WAIT)
#warning BROKEN CONTROL BUILD: the row-statistics exchange does not wait; results are wrong by design
        if (blockIdx.x >= 64) { const long long t0_ = clock64(); while (clock64() - t0_ < 60000) __builtin_amdgcn_s_sleep(8); }
#endif
        const int row = wid * 32 + (lane & 31);
        if (lane < 32) {
            const f32x2v a = P[row * 4 + 0], b = P[row * 4 + 1], c = P[row * 4 + 2], d = P[row * 4 + 3];
            const float mt = (a.x + b.x + c.x + d.x) * 0.25f;
            const float da = a.x - mt, db = b.x - mt, dc = c.x - mt, dd = d.x - mt;
            const float m2 = (a.y + b.y) + (c.y + d.y) + 64.0f * ((da * da + db * db) + (dc * dc + dd * dd));
            unsigned long long* slot = (unsigned long long*)xbuf + ((size_t)(u.pm * BM + row) * 4 + u.pn);
            __hip_atomic_store(slot, ((unsigned long long)__float_as_uint(m2) << 32) | __float_as_uint(mt), __ATOMIC_RELAXED, __HIP_MEMORY_SCOPE_AGENT);
        }
        asm volatile("s_waitcnt vmcnt(0)" ::: "memory");
        if (lane == 0) __hip_atomic_fetch_add(cnt + 64 * u.pm, 1u, __ATOMIC_RELAXED, __HIP_MEMORY_SCOPE_AGENT);
        if (wid == 0) {
            bool dead = false; const unsigned long long t0 = __builtin_amdgcn_s_memrealtime(); const unsigned want = 8u * (unsigned)ntn;
            for (;;) {
#if defined(BROKEN_EXCHANGE_NO_WAIT)
                break;
#endif
                if ((unsigned)__builtin_amdgcn_readfirstlane(__hip_atomic_load(cnt + 64 * u.pm, __ATOMIC_RELAXED, __HIP_MEMORY_SCOPE_AGENT)) >= want) break;
                if (__builtin_amdgcn_s_memrealtime() - t0 > 2000000ull) {
                    if (lane == 0) { unsigned expect = 0u; __hip_atomic_compare_exchange_strong(tmo + 1, &expect, code | (unsigned)(u.pm & 0xff), __ATOMIC_RELAXED, __ATOMIC_RELAXED, __HIP_MEMORY_SCOPE_AGENT);
                                     __hip_atomic_store(tmo, 1u, __ATOMIC_RELAXED, __HIP_MEMORY_SCOPE_AGENT); }
                    dead = true; break; }
                __builtin_amdgcn_s_sleep(2);
            }
            __builtin_amdgcn_fence(__ATOMIC_ACQUIRE, "agent");
            if (lane == 0) flag[0] = dead ? 1u : 0u;
        }
        asm volatile("s_waitcnt vmcnt(0) lgkmcnt(0)" ::: "memory"); __builtin_amdgcn_s_barrier(); asm volatile("" ::: "memory");
        const bool bad = flag[0] != 0u;
        if (lane < 32) {
            const unsigned long long* slot = (const unsigned long long*)xbuf + (size_t)(u.pm * BM + row) * 4; float mt[4], m2[4]; float ms = 0.f;
#pragma unroll
            for (int t = 0; t < 4; ++t) { if (t < ntn) { const unsigned long long w = __hip_atomic_load(slot + t, __ATOMIC_RELAXED, __HIP_MEMORY_SCOPE_AGENT); mt[t] = __uint_as_float((unsigned)w); m2[t] = __uint_as_float((unsigned)(w >> 32)); } else { mt[t] = 0.f; m2[t] = 0.f; } ms += mt[t]; }
            const float mean = ms / (float)ntn; float q = 0.f;
#pragma unroll
            for (int t = 0; t < 4; ++t) if (t < ntn) { const float dm = mt[t] - mean; q += m2[t] + 256.0f * dm * dm; }
            S[row] = (f32x2v){mean, 1.0f / sqrtf(q / (256.0f * (float)ntn) + eps)};
        }
        asm volatile("s_waitcnt lgkmcnt(0)" ::: "memory"); __builtin_amdgcn_s_barrier(); asm volatile("" ::: "memory");
        return bad;
    }
};

struct EpiLn {
    static constexpr bool PERM = false, AFTER_DRAIN = true;
    const float* base; float* out; bf16_t* outb; int ldc; const float* gam; const float* bet; PanelStats st; float alpha;
    __device__ __forceinline__ void fused(f32x4 (&acc)[2][2][4][2], const Unit& u, int wr, int wc, int fr, int fq, PG8_LAS unsigned char* lds, int wid, int lane) const {
        typedef float f32x2v __attribute__((ext_vector_type(2))); typedef unsigned u32x2v __attribute__((ext_vector_type(2)));
        const PG8_LAS f32x2v* S = (const PG8_LAS f32x2v*)(lds + 8192);
        const int col0 = u.pn * BM + wc * 32 + 4 * fq;
#pragma unroll
        for (int ai = 0; ai < 2; ++ai) {
            f32x4 bs[4][2][2];
#pragma unroll
            for (int m = 0; m < 4; ++m) { const size_t off = (size_t)(u.pm * BM + ai * HALF + wr * 64 + m * 16 + fr) * ldc + col0;
#pragma unroll
                for (int bj = 0; bj < 2; ++bj)
#pragma unroll
                    for (int n = 0; n < 2; ++n) bs[m][bj][n] = *(const f32x4*)(base + off + bj * HALF + n * 16); }
#pragma unroll
            for (int m = 0; m < 4; ++m) {
#pragma unroll
                for (int bj = 0; bj < 2; ++bj)
#pragma unroll
                    for (int n = 0; n < 2; ++n) acc[ai][bj][m][n] += bs[m][bj][n] * alpha;
                asm volatile("" : "+v"(acc[ai][0][m][0]), "+v"(acc[ai][0][m][1]), "+v"(acc[ai][1][m][0]), "+v"(acc[ai][1][m][1])); }
            asm volatile("" ::: "memory"); }
        const bool bad = st.run(acc, u, wr, wc, fr, fq, lds, wid, lane);
        const float qnan = __builtin_nanf("");
        f32x4 gv[2][2], bv[2][2];
#pragma unroll
        for (int bj = 0; bj < 2; ++bj)
#pragma unroll
            for (int n = 0; n < 2; ++n) { gv[bj][n] = *(const f32x4*)(gam + col0 + bj * HALF + n * 16); bv[bj][n] = *(const f32x4*)(bet + col0 + bj * HALF + n * 16); }
#pragma unroll
        for (int ai = 0; ai < 2; ++ai)
#pragma unroll
            for (int m = 0; m < 4; ++m) { const int r = ai * HALF + wr * 64 + m * 16 + fr; const f32x2v sr = S[r]; const size_t off = (size_t)(u.pm * BM + r) * ldc + col0;
#pragma unroll
                for (int bj = 0; bj < 2; ++bj)
#pragma unroll
                    for (int n = 0; n < 2; ++n) { f32x4 o = (acc[ai][bj][m][n] - sr.x) * sr.y * gv[bj][n] + bv[bj][n];
                        if (bad) o = (f32x4){qnan, qnan, qnan, qnan};
                        *(f32x4*)(out + off + bj * HALF + n * 16) = o;
                        if (outb) { u32x2v w; w.x = cvtpk(o[0], o[1]); w.y = cvtpk(o[2], o[3]); *(u32x2v*)(outb + off + bj * HALF + n * 16) = w; } }
                asm volatile("" ::: "memory"); }
    }
};

template <class Epi, class Sched, bool ALIGN_EPI = false, bool SP2 = false>
__device__ __forceinline__ void gemm_phase(PG8_LAS unsigned char* lds, const Gemm g, const Sched& S, const Epi& E) {
    const int tid = otid(), wid = __builtin_amdgcn_readfirstlane(tid >> 6), lane = tid & 63, wr = wid >> 2, wc = wid & 3, fr = lane & 15, fq = lane >> 4;
    const int K = g.K, nt = K / BK;
    unsigned voffA[2], voffB[2];
#pragma unroll
    for (int i = 0; i < 2; ++i) { int R, C; stage_rc(tid * 16 + i * 8192, R, C); const int Rb = Epi::PERM ? ((R & ~31) + perm32(R & 31)) : R;
        voffA[i] = (unsigned)(R * K + C) * 2u; voffB[i] = (unsigned)(Rb * K + C) * 2u; }
    const size_t kstep = (size_t)(BK * 2);
    const size_t hstep = (size_t)HALF * K * 2;
    const size_t tstep = 2 * hstep;
    const unsigned ldsw = (unsigned)wid * 1024u;
    const int aoff = lds_byte(wr * 64 + fr, fq * 8), boff = lds_byte(wc * 32 + fr, fq * 8);
#define PG8_SA(b, h) (((b) * 2 + (h)) * HTB)
#define PG8_SB(b, h) ((4 + (b) * 2 + (h)) * HTB)
#define PG8_STAGE(bufoff, gbase, voff) do { _Pragma("unroll") for (int _i = 0; _i < 2; ++_i) \
        __builtin_amdgcn_global_load_lds((const unsigned*)((const char*)(gbase) + (voff)[_i]), (PG8_LAS unsigned*)(lds + (bufoff) + ldsw + _i * 8192), 16, 0, 0); } while (0)
#define PG8_LDA(dst, b, h) do { _Pragma("unroll") for (int m = 0; m < 4; ++m) _Pragma("unroll") for (int k = 0; k < 2; ++k) dst[m][k] = *(const PG8_LAS bf16x8*)(lds + PG8_SA(b, h) + aoff + m * 2048 + k * 1024); } while (0)
#define PG8_LDB(dst, b, h) do { _Pragma("unroll") for (int n = 0; n < 2; ++n) _Pragma("unroll") for (int k = 0; k < 2; ++k) dst[n][k] = *(const PG8_LAS bf16x8*)(lds + PG8_SB(b, h) + boff + n * 2048 + k * 1024); } while (0)
#define PG8_MMA(ai, bj, At, Bt) do { __builtin_amdgcn_s_setprio(1); _Pragma("unroll") for (int m = 0; m < 4; ++m) _Pragma("unroll") for (int n = 0; n < 2; ++n) _Pragma("unroll") for (int k = 0; k < 2; ++k) \
        acc[ai][bj][m][n] = __builtin_amdgcn_mfma_f32_16x16x32_bf16(Bt[n][k], At[m][k], acc[ai][bj][m][n], 0, 0, 0); __builtin_amdgcn_s_setprio(0); } while (0)
#define PG8_WAIT_V(n) asm volatile("s_waitcnt vmcnt(" #n ")" ::: "memory")
#define PG8_WAIT_L(n) asm volatile("s_waitcnt lgkmcnt(" #n ")" ::: "memory")
#define PG8_BAR __builtin_amdgcn_s_barrier()
#define PG8_SCHED __builtin_amdgcn_sched_barrier(0)
    Unit cur, nxt; int ui = 0;
    if (!S.next(0, cur)) return;
    f32x4 acc[2][2][4][2];
#pragma unroll
    for (int a = 0; a < 2; ++a)
#pragma unroll
        for (int b = 0; b < 2; ++b)
#pragma unroll
            for (int m = 0; m < 4; ++m)
#pragma unroll
                for (int n = 0; n < 2; ++n) acc[a][b][m][n] = (f32x4){0.f, 0.f, 0.f, 0.f};
    bf16x8 At[4][2], B0[2][2], B1[2][2];
    const char* cA = (const char*)g.A + (size_t)cur.pm * tstep; const char* cB = (const char*)g.Bt + (size_t)cur.pn * tstep;
    S.a_ready(cur);
    if constexpr (SP2) {
        PG8_STAGE(PG8_SB(0, 0), cB, voffB); PG8_STAGE(PG8_SB(0, 1), cB + hstep, voffB); PG8_STAGE(PG8_SA(0, 0), cA, voffA); PG8_STAGE(PG8_SA(0, 1), cA + hstep, voffA);
        if (wr == 1) PG8_BAR;
        PG8_WAIT_V(2); PG8_BAR;
        PG8_STAGE(PG8_SB(1, 0), cB + kstep, voffB); PG8_STAGE(PG8_SA(1, 0), cA + kstep, voffA); PG8_STAGE(PG8_SB(1, 1), cB + hstep + kstep, voffB);
        PG8_WAIT_V(6); PG8_BAR;
    } else {
        PG8_STAGE(PG8_SB(0, 0), cB, voffB); PG8_STAGE(PG8_SA(0, 0), cA, voffA); PG8_STAGE(PG8_SB(0, 1), cB + hstep, voffB); PG8_STAGE(PG8_SA(0, 1), cA + hstep, voffA);
        if (wr == 1) PG8_BAR;
        PG8_WAIT_V(4); PG8_BAR;
        PG8_STAGE(PG8_SB(1, 0), cB + kstep, voffB); PG8_STAGE(PG8_SA(1, 0), cA + kstep, voffA); PG8_STAGE(PG8_SB(1, 1), cB + hstep + kstep, voffB);
        PG8_WAIT_V(6); PG8_BAR;
    }
    for (;;) {
        const bool has_next = S.next(ui + 1, nxt);
        const char* nA = has_next ? (const char*)g.A + (size_t)nxt.pm * tstep : cA; const char* nB = has_next ? (const char*)g.Bt + (size_t)nxt.pn * tstep : cB;
        for (int t = 0; t < nt; t += 2) {
            const bool last = (t == nt - 2);
            const char* a1 = cA + (size_t)(t + 1) * kstep;
            const char* a2 = last ? nA : cA + (size_t)(t + 2) * kstep; const char* b2 = last ? nB : cB + (size_t)(t + 2) * kstep;
            const char* a3 = a2 + kstep; const char* b3 = b2 + kstep;
            if (last && has_next) S.a_ready(nxt);
            if constexpr (SP2) {
            PG8_LDB(B0, 0, 0); PG8_LDB(B1, 0, 1); PG8_SCHED; PG8_LDA(At, 0, 0); PG8_STAGE(PG8_SA(1, 1), a1 + hstep, voffA);
            PG8_WAIT_V(8); PG8_WAIT_L(0); PG8_BAR; PG8_MMA(0, 0, At, B0); PG8_MMA(0, 1, At, B1); PG8_BAR; PG8_SCHED;
            PG8_LDA(At, 0, 1); PG8_STAGE(PG8_SB(0, 0), b2, voffB); PG8_STAGE(PG8_SB(0, 1), b2 + hstep, voffB); PG8_STAGE(PG8_SA(0, 0), a2, voffA);
            PG8_WAIT_V(8); PG8_WAIT_L(0); PG8_BAR; PG8_MMA(1, 0, At, B0); PG8_MMA(1, 1, At, B1); PG8_BAR; PG8_SCHED;
            PG8_LDB(B0, 1, 0); PG8_LDB(B1, 1, 1); PG8_SCHED; PG8_LDA(At, 1, 0); PG8_STAGE(PG8_SA(0, 1), a2 + hstep, voffA);
            PG8_WAIT_V(8); PG8_WAIT_L(0); PG8_BAR; PG8_MMA(0, 0, At, B0); PG8_MMA(0, 1, At, B1); PG8_BAR; PG8_SCHED;
            PG8_LDA(At, 1, 1); PG8_STAGE(PG8_SB(1, 0), b3, voffB); PG8_STAGE(PG8_SB(1, 1), b3 + hstep, voffB); PG8_STAGE(PG8_SA(1, 0), a3, voffA);
            PG8_WAIT_V(8); PG8_WAIT_L(0); PG8_BAR; PG8_MMA(1, 0, At, B0); PG8_MMA(1, 1, At, B1); PG8_BAR; PG8_SCHED;
            } else {
            PG8_LDB(B0, 0, 0); PG8_SCHED; PG8_LDA(At, 0, 0); PG8_STAGE(PG8_SA(1, 1), a1 + hstep, voffA);
            PG8_WAIT_L(8); PG8_BAR; PG8_WAIT_L(0); PG8_MMA(0, 0, At, B0); PG8_BAR; PG8_SCHED;
            PG8_LDB(B1, 0, 1); PG8_STAGE(PG8_SB(0, 0), b2, voffB);
            PG8_BAR; PG8_WAIT_L(0); PG8_MMA(0, 1, At, B1); PG8_BAR;
            PG8_LDA(At, 0, 1); PG8_STAGE(PG8_SA(0, 0), a2, voffA);
            PG8_BAR; PG8_WAIT_L(0); PG8_MMA(1, 0, At, B0); PG8_BAR; PG8_SCHED;
            PG8_STAGE(PG8_SB(0, 1), b2 + hstep, voffB);
            PG8_WAIT_V(6); PG8_BAR; PG8_MMA(1, 1, At, B1); PG8_BAR;
            PG8_LDB(B0, 1, 0); PG8_SCHED; PG8_LDA(At, 1, 0); PG8_STAGE(PG8_SA(0, 1), a2 + hstep, voffA);
            PG8_WAIT_L(8); PG8_BAR; PG8_WAIT_L(0); PG8_MMA(0, 0, At, B0); PG8_BAR; PG8_SCHED;
            PG8_LDB(B1, 1, 1); PG8_STAGE(PG8_SB(1, 0), b3, voffB);
            PG8_BAR; PG8_WAIT_L(0); PG8_MMA(0, 1, At, B1); PG8_BAR;
            PG8_LDA(At, 1, 1); PG8_STAGE(PG8_SA(1, 0), a3, voffA);
            PG8_BAR; PG8_WAIT_L(0); PG8_MMA(1, 0, At, B0); PG8_BAR; PG8_SCHED;
            PG8_STAGE(PG8_SB(1, 1), b3 + hstep, voffB);
            PG8_WAIT_V(6); PG8_BAR; PG8_MMA(1, 1, At, B1); PG8_BAR;
            }
        }
        if constexpr (ALIGN_EPI) { if (wr == 0) PG8_BAR; }
        if constexpr (!Epi::AFTER_DRAIN) { E(acc, cur, wr, wc, fr, fq); S.done(cur); }
        if (!has_next) break;
#pragma unroll
        for (int a = 0; a < 2; ++a)
#pragma unroll
            for (int b = 0; b < 2; ++b)
#pragma unroll
                for (int m = 0; m < 4; ++m)
#pragma unroll
                    for (int n = 0; n < 2; ++n) acc[a][b][m][n] = (f32x4){0.f, 0.f, 0.f, 0.f};
        cur = nxt; cA = nA; cB = nB; ++ui;
        if constexpr (ALIGN_EPI) { if (wr == 1) PG8_BAR; }
    }
    PG8_WAIT_V(0);
    if constexpr (!ALIGN_EPI) { if (wr == 0) PG8_BAR; }
    PG8_BAR;
    if constexpr (Epi::AFTER_DRAIN) { E.fused(acc, cur, wr, wc, fr, fq, lds, wid, lane); S.done(cur); }
#undef PG8_SA
#undef PG8_SB
#undef PG8_STAGE
#undef PG8_LDA
#undef PG8_LDB
#undef PG8_MMA
#undef PG8_WAIT_V
#undef PG8_WAIT_L
#undef PG8_BAR
#undef PG8_SCHED
}
}

__device__ __forceinline__ void ln_phase(const float* xin, const float* Y, const float* g, const float* bb, float* out, bf16_t* outb) {
  const int lane = otid() & 63, wid = otid() >> 6;
  for (int row = blockIdx.x * 8 + wid; row < M_; row += gridDim.x * 8) {
    const float4* xr = (const float4*)(xin + (size_t)row * D_);
    const float4* yr = (const float4*)(Y + (size_t)row * D_);
    float4 v[4]; float s = 0.f;
#pragma unroll
    for (int j = 0; j < 4; ++j) {
      const float4 a = xr[j * 64 + lane], y = yr[j * 64 + lane];
      v[j].x = ALPHA * a.x + y.x; v[j].y = ALPHA * a.y + y.y; v[j].z = ALPHA * a.z + y.z; v[j].w = ALPHA * a.w + y.w;
      s += (v[j].x + v[j].y) + (v[j].z + v[j].w);
    }
    const float mean = wave_sum(s) * (1.f / D_);
    float q = 0.f;
#pragma unroll
    for (int j = 0; j < 4; ++j) {
      v[j].x -= mean; v[j].y -= mean; v[j].z -= mean; v[j].w -= mean;
      q += (v[j].x * v[j].x + v[j].y * v[j].y) + (v[j].z * v[j].z + v[j].w * v[j].w);
    }
    const float rstd = 1.f / sqrtf(wave_sum(q) * (1.f / D_) + LN_EPS);
#pragma unroll
    for (int j = 0; j < 4; ++j) {
      const float4 gg = ((const float4*)g)[j * 64 + lane], bv = ((const float4*)bb)[j * 64 + lane];
      float4 o;
      o.x = v[j].x * rstd * gg.x + bv.x; o.y = v[j].y * rstd * gg.y + bv.y; o.z = v[j].z * rstd * gg.z + bv.z; o.w = v[j].w * rstd * gg.w + bv.w;
      ((float4*)(out + (size_t)row * D_))[j * 64 + lane] = o;
      if (outb) {
        ushort4 ob; ob.x = f2bf(o.x); ob.y = f2bf(o.y); ob.z = f2bf(o.z); ob.w = f2bf(o.w);
        ((ushort4*)(outb + (size_t)row * D_))[j * 64 + lane] = ob;
      }
    }
  }
}

__device__ __forceinline__ void compress_item(const Params& P, int item, float* sm) {
  const bf16_t* H0 = (const bf16_t*)(P.ws + WS_H);
  const int tid = otid();
  const int g = item & 1; int r = item >> 1; const int n = r % NCMP; r /= NCMP; const int b = r & 3; const int i = r >> 2;
  const float* pos = P.in[2] + i * 2048;
  const float* w1 = P.in[3] + (size_t)i * 2048 * 128;
  const float* b1 = P.in[4] + i * 128;
  const float* w2 = P.in[5] + (size_t)i * 128 * 64;
  float* blk = sm;
  float* part = sm + 2048;
  float* hid = sm + 2048 + 512;
  const int col = (i == 0 ? C_KCMP : C_VCMP) + g * 64;
#pragma unroll
  for (int k = 0; k < 4; ++k) {
    const int f = tid + k * 512, l = f >> 6, d = f & 63;
    blk[f] = bf2f(H0[((size_t)b * S_ + 16 * n + l) * P0 + col + d]) + pos[f];
  }
  wg_sync();
  const int hh = tid & 127, pt = tid >> 7;
  float acc = 0.f;
  for (int f = pt * 512; f < pt * 512 + 512; ++f) acc += blk[f] * w1[(size_t)f * 128 + hh];
  part[pt * 128 + hh] = acc;
  wg_sync();
  if (tid < 128) {
    const float a = part[tid] + part[128 + tid] + part[256 + tid] + part[384 + tid] + b1[tid];
    hid[tid] = silu_f(a);
  }
  wg_sync();
  if (tid < 64) {
    float o = 0.f;
    for (int k = 0; k < 128; ++k) o += hid[k] * w2[k * 64 + tid];
    float* dst = (float*)(P.ws + (i == 0 ? WS_KC : WS_VC));
    dst[(((size_t)b * NCMP + n) * 2 + g) * 64 + tid] = o;
    bf16_t* dstb = (bf16_t*)(P.ws + (i == 0 ? (size_t)(248 * MiB) : (size_t)(249 * MiB)));
    dstb[(((size_t)b * 2 + g) * 256 + n) * 64 + tid] = f2bf(o);
    if (n == 0) dstb[(((size_t)b * 2 + g) * 256 + 255) * 64 + tid] = 0;
  }
  wg_sync();
}
__device__ __forceinline__ void kmean_item(const Params& P, int item, int lane) {
  const bf16_t* H0 = (const bf16_t*)(P.ws + WS_H);
  const int h = item & 7, n = (item >> 3) & 15, b = item >> 7;
  float s = 0.f;
  for (int k = 0; k < 256; ++k) s += bf2f(H0[((size_t)b * S_ + n * 256 + k) * P0 + C_MK + h * 64 + lane]);
  ((float*)(P.ws + WS_KM))[(((size_t)b * 16 + n) * 8 + h) * 64 + lane] = s * (1.f / 256.f);
}


constexpr size_t WS_W1T = 250 * MiB;
constexpr size_t WS_W2T = 251 * MiB;
constexpr size_t WS_C1P = 252 * MiB;
#define LAS3 __attribute__((address_space(3)))
__device__ __forceinline__ void compress_mfma_tile(const Params& P, int tile, unsigned char* smem_g) {
  const bf16_t* __restrict__ H0 = (const bf16_t*)(P.ws + WS_H);
  LAS3 unsigned char* lds = (LAS3 unsigned char*)smem_g;
  const int tid = otid(), lane = tid & 63, wid = __builtin_amdgcn_readfirstlane(tid >> 6), g = lane >> 4, ii = lane & 15;
  const int i = tile >> 6, R0 = (tile & 63) * 32;
  bf16_t* hs = (bf16_t*)(smem_g + 131072);
#pragma unroll
  for (int rr = 0; rr < 4; ++rr) {
    const int row = 4 * wid + rr;
    const int R = min(R0 + row, 2039), b = R / 510, rem = R - b * 510, n = rem >> 1, grp = rem & 1;
    const bf16_t* src = H0 + ((size_t)b * S_ + 16 * n) * P0 + (i == 0 ? C_KCMP : C_VCMP) + grp * 64;
#pragma unroll
    for (int q = 0; q < 4; ++q) {
      const int c = (64 * q + lane) ^ (row & 15);
      __builtin_amdgcn_global_load_lds((const unsigned*)(src + (size_t)(c >> 3) * P0 + (c & 7) * 8), (LAS3 unsigned*)(lds + row * 4096 + q * 1024), 16, 0, 0);
    }
  }
  const int col = 16 * wid + ii;
  float bias = P.in[4][i * 128 + col];
  {
    const float* c1p = (const float*)(P.ws + WS_C1P) + i * 32 * 128 + col;
    float cp[32];
#pragma unroll
    for (int q = 0; q < 32; ++q) cp[q] = c1p[q * 128];
#pragma unroll
    for (int q = 0; q < 32; ++q) bias += cp[q];
  }
  asm volatile("s_waitcnt vmcnt(0)" ::: "memory");
  wg_sync();
  {
    const bf16_t* bbase = (const bf16_t*)(P.ws + WS_W1T) + (size_t)(i * 128 + 16 * wid + ii) * 2048 + 8 * g;
    f32x4 acc[2] = {(f32x4){0.f, 0.f, 0.f, 0.f}, (f32x4){0.f, 0.f, 0.f, 0.f}};
#pragma unroll 16
    for (int ks = 0; ks < 64; ++ks) {
      const bf16x8 bq = *(const bf16x8*)(bbase + ks * 32);
#pragma unroll
      for (int rt = 0; rt < 2; ++rt) {
        const int row = 16 * rt + ii;
        const bf16x8 a = *(LAS3 const bf16x8*)(lds + row * 4096 + (((4 * ks + g) ^ (row & 15)) << 4));
        acc[rt] = __builtin_amdgcn_mfma_f32_16x16x32_bf16(a, bq, acc[rt], 0, 0, 0);
      }
    }
#pragma unroll
    for (int rt = 0; rt < 2; ++rt)
#pragma unroll
      for (int r = 0; r < 4; ++r) hs[(16 * rt + 4 * g + r) * 136 + col] = f2bf(silu_f(acc[rt][r] + bias));
  }
  wg_sync();
  {
    const int ct = wid & 3, rt = wid >> 2;
    const bf16_t* b2 = (const bf16_t*)(P.ws + WS_W2T) + (size_t)(i * 64 + 16 * ct + ii) * 128 + 8 * g;
    f32x4 acc = (f32x4){0.f, 0.f, 0.f, 0.f};
#pragma unroll
    for (int k2 = 0; k2 < 4; ++k2) {
      const bf16x8 a = *(const bf16x8*)(hs + (16 * rt + ii) * 136 + 32 * k2 + 8 * g);
      const bf16x8 bq = *(const bf16x8*)(b2 + 32 * k2);
      acc = __builtin_amdgcn_mfma_f32_16x16x32_bf16(a, bq, acc, 0, 0, 0);
    }
    bf16_t* dst = (bf16_t*)(P.ws + (i == 0 ? (size_t)(248 * MiB) : (size_t)(249 * MiB)));
#pragma unroll
    for (int r = 0; r < 4; ++r) {
      const int R = R0 + 16 * rt + 4 * g + r;
      if (R < 2040) { const int b = R / 510, rem = R - b * 510, n = rem >> 1, grp = rem & 1;
        dst[(((size_t)b * 2 + grp) * 256 + n) * 64 + 16 * ct + ii] = f2bf(acc[r]); }
    }
  }
  wg_sync();
}
__device__ __forceinline__ void kmean_item2(const Params& P, int item) {
  const bf16_t* __restrict__ H0 = (const bf16_t*)(P.ws + WS_H);
  const int tid = otid();
  const bf16_t* src = H0 + ((size_t)(item >> 4) * S_ + (item & 15) * 256) * P0 + C_MK + tid;
  float s0 = 0.f, s1 = 0.f, s2 = 0.f, s3 = 0.f;
#pragma unroll 4
  for (int r = 0; r < 256; r += 4) {
    s0 += bf2f(src[(size_t)r * P0]); s1 += bf2f(src[(size_t)(r + 1) * P0]); s2 += bf2f(src[(size_t)(r + 2) * P0]); s3 += bf2f(src[(size_t)(r + 3) * P0]);
  }
  ((float*)(P.ws + WS_KM))[(size_t)item * 512 + tid] = ((s0 + s1) + (s2 + s3)) * (1.f / 256.f);
}

template <int NH>
__device__ __forceinline__ void attend_block(const bf16_t* __restrict__ Kp, const bf16_t* __restrict__ Vp, size_t rowbase, int kp0, int t, int kmin,
                                             const float* qs, float* pb, const float* slope, float* m, float* l, float* o, int lane) {
  asm volatile("" ::: "memory");
  const int kp = kp0 + lane;
  const bool valid = (kp <= t) && (kp >= kmin);
  const uint4* kr = (const uint4*)(Kp + (rowbase + kp) * P0);
  float dot[NH];
#pragma unroll
  for (int j = 0; j < NH; ++j) dot[j] = 0.f;
#pragma unroll 1
  for (int c = 0; c < 8; ++c) {
    asm volatile("" ::: "memory");
    const uint4 u = kr[c];
    float kv[8];
    kv[0] = __uint_as_float(u.x << 16); kv[1] = __uint_as_float(u.x & 0xffff0000u);
    kv[2] = __uint_as_float(u.y << 16); kv[3] = __uint_as_float(u.y & 0xffff0000u);
    kv[4] = __uint_as_float(u.z << 16); kv[5] = __uint_as_float(u.z & 0xffff0000u);
    kv[6] = __uint_as_float(u.w << 16); kv[7] = __uint_as_float(u.w & 0xffff0000u);
#pragma unroll
    for (int j = 0; j < NH; ++j) {
      const float4 q0 = *(const float4*)(qs + j * 64 + c * 8), q1 = *(const float4*)(qs + j * 64 + c * 8 + 4);
      dot[j] += kv[0] * q0.x + kv[1] * q0.y + kv[2] * q0.z + kv[3] * q0.w + kv[4] * q1.x + kv[5] * q1.y + kv[6] * q1.z + kv[7] * q1.w;
    }
  }
#pragma unroll
  for (int j = 0; j < NH; ++j) {
    const float s = valid ? 0.125f * dot[j] - slope[j] * (float)(t - kp) : -1e30f;
    const float mn = fmaxf(m[j], wave_max(s));
    const float al = __expf(m[j] - mn);
    const float p = valid ? __expf(s - mn) : 0.f;
    l[j] = l[j] * al + wave_sum(p);
    o[j] *= al; m[j] = mn;
    pb[j * 64 + lane] = p;
  }
  __builtin_amdgcn_wave_barrier();
  const bf16_t* vr = Vp + (rowbase + kp0) * P0 + lane;
#pragma unroll 8
  for (int k = 0; k < 64; ++k) {
    const float v = bf2f(vr[(size_t)k * P0]);
#pragma unroll
    for (int j = 0; j < NH; ++j) o[j] += pb[j * 64 + k] * v;
  }
  __builtin_amdgcn_wave_barrier();
}

__device__ __forceinline__ void nsa_item(const Params& P, int b, int g, int t, float* wsm, int lane) {
  const bf16_t* H0 = (const bf16_t*)(P.ws + WS_H);
  const float* KC = (const float*)(P.ws + WS_KC);
  const float* VC = (const float*)(P.ws + WS_VC);
  bf16_t* MIX = (bf16_t*)(P.ws + WS_MIX);
  float* qs = wsm;
  float* pc = wsm + 256;
  float* pb = wsm + 1280;
  const size_t row = (size_t)b * S_ + t;
  const bf16_t* hrow = H0 + row * P0;
  float slope[4];
#pragma unroll
  for (int j = 0; j < 4; ++j) { qs[j * 64 + lane] = bf2f(hrow[C_NQ + (g * 4 + j) * 64 + lane]); slope[j] = exp2f(-(float)(g * 4 + j + 1)); }
  __builtin_amdgcn_wave_barrier();
  const int nv = t >= 31 ? (t - 31) / 16 + 1 : 0;
#pragma unroll 1
  for (int c = 0; c < 4; ++c) {
    asm volatile("" ::: "memory");
    const int n = c * 64 + lane;
    float dot[4] = {0.f, 0.f, 0.f, 0.f};
    if (n < nv) {
      const float4* kr = (const float4*)(KC + (((size_t)b * NCMP + n) * 2 + g) * 64);
#pragma unroll 4
      for (int d4 = 0; d4 < 16; ++d4) {
        const float4 kv = kr[d4];
#pragma unroll
        for (int j = 0; j < 4; ++j) {
          const float4 q = *(const float4*)(qs + j * 64 + d4 * 4);
          dot[j] += kv.x * q.x + kv.y * q.y + kv.z * q.z + kv.w * q.w;
        }
      }
    }
#pragma unroll
    for (int j = 0; j < 4; ++j) pc[j * 256 + n] = (n < nv) ? 0.125f * dot[j] - slope[j] * (float)(t - (16 * n + 31)) : -1e30f;
  }
  __builtin_amdgcn_wave_barrier();
#pragma unroll
  for (int j = 0; j < 4; ++j) {
    float sc[4];
#pragma unroll
    for (int c = 0; c < 4; ++c) sc[c] = pc[j * 256 + c * 64 + lane];
    float mx = fmaxf(fmaxf(sc[0], sc[1]), fmaxf(sc[2], sc[3]));
    mx = wave_max(mx);
    float sum = 0.f;
#pragma unroll
    for (int c = 0; c < 4; ++c) { const int n = c * 64 + lane; const float p = (n < nv) ? __expf(sc[c] - mx) : 0.f; sc[c] = p; sum += p; }
    sum = wave_sum(sum);
    const float inv = nv > 0 ? 1.f / sum : 0.f;
#pragma unroll
    for (int c = 0; c < 4; ++c) pc[j * 256 + c * 64 + lane] = sc[c] * inv;
  }
  __builtin_amdgcn_wave_barrier();
  float ocmp[4] = {0.f, 0.f, 0.f, 0.f};
  for (int n = 0; n < nv; ++n) {
    const float v = VC[(((size_t)b * NCMP + n) * 2 + g) * 64 + lane];
#pragma unroll
    for (int j = 0; j < 4; ++j) ocmp[j] += pc[j * 256 + n] * v;
  }
  float imp = 0.f;
  {
    const int lo = max(0, 4 * lane - 1), hi = min(NCMP - 1, 4 * lane + 3);
    for (int n = lo; n <= hi; ++n) imp += (pc[n] + pc[256 + n]) + (pc[512 + n] + pc[768 + n]);
  }
  const int cur = t >> 6;
  const bool bvalid = lane <= cur;
  const bool forced = (lane == 0) || (lane == cur) || (lane == cur - 1);
  const float key = bvalid ? (forced ? 1e9f : imp) : -1e30f;
  int rank = 0;
  for (int s2 = 0; s2 < 64; ++s2) {
    const float ks = __shfl(key, s2);
    rank += (ks > key || (ks == key && s2 < lane)) ? 1 : 0;
  }
  const unsigned long long selmask = __ballot(bvalid && rank < 16);
  float m[4], l[4], osel[4], owin[4];
#pragma unroll
  for (int j = 0; j < 4; ++j) { m[j] = -1e30f; l[j] = 0.f; osel[j] = 0.f; }
  {
    unsigned long long mk = selmask;
    while (mk) {
      const int blk = __builtin_ctzll(mk); mk &= mk - 1;
      attend_block<4>(H0 + C_KSEL + g * 64, H0 + C_VSEL + g * 64, (size_t)b * S_, blk * 64, t, 0, qs, pb, slope, m, l, osel, lane);
    }
  }
#pragma unroll
  for (int j = 0; j < 4; ++j) { osel[j] /= l[j]; m[j] = -1e30f; l[j] = 0.f; owin[j] = 0.f; }
  {
    const int kmin = t - 511;
    const int b0 = (kmin > 0 ? kmin : 0) >> 6;
    for (int blk = b0; blk <= cur; ++blk)
      attend_block<4>(H0 + C_KWIN + g * 64, H0 + C_VWIN + g * 64, (size_t)b * S_, blk * 64, t, kmin, qs, pb, slope, m, l, owin, lane);
  }
#pragma unroll
  for (int j = 0; j < 4; ++j) {
    const int h = g * 4 + j;
    const float g0 = sigmoid_f(bf2f(hrow[C_NG + h * 3 + 0])), g1 = sigmoid_f(bf2f(hrow[C_NG + h * 3 + 1])), g2 = sigmoid_f(bf2f(hrow[C_NG + h * 3 + 2]));
    const float o = g0 * ocmp[j] + g1 * osel[j] + g2 * (owin[j] / l[j]);
    const float z = bf2f(hrow[C_NZ + h * 64 + lane]);
    MIX[row * D_ + h * 64 + lane] = f2bf(o * silu_f(z));
  }
}

__device__ __forceinline__ void moba_item(const Params& P, int b, int h, int t, float* wsm, int lane) {
  const bf16_t* H0 = (const bf16_t*)(P.ws + WS_H);
  const float* KM = (const float*)(P.ws + WS_KM);
  bf16_t* MIX = (bf16_t*)(P.ws + WS_MIX);
  float* qs = wsm;
  float* pb = wsm + 1280;
  const size_t row = (size_t)b * S_ + t;
  const bf16_t* hrow = H0 + row * P0;
  qs[lane] = bf2f(hrow[C_MQ + h * 64 + lane]);
  __builtin_amdgcn_wave_barrier();
  float slope[1] = {exp2f(-(float)(h + 1))};
  const int cur = t >> 8;
  float gate = -1e30f;
  if (lane < cur) {
    const float4* kr = (const float4*)(KM + (((size_t)b * 16 + lane) * 8 + h) * 64);
    float d = 0.f;
#pragma unroll 4
    for (int d4 = 0; d4 < 16; ++d4) { const float4 kv = kr[d4]; const float4 q = *(const float4*)(qs + d4 * 4); d += kv.x * q.x + kv.y * q.y + kv.z * q.z + kv.w * q.w; }
    gate = d;
  }
  int rank = 0;
  for (int s2 = 0; s2 < 16; ++s2) {
    const float ks = __shfl(gate, s2);
    rank += (ks > gate || (ks == gate && s2 < lane)) ? 1 : 0;
  }
  unsigned long long mk = __ballot(lane < cur && rank < 3) | (1ull << cur);
  float m[1] = {-1e30f}, l[1] = {0.f}, o[1] = {0.f};
  while (mk) {
    const int blk = __builtin_ctzll(mk); mk &= mk - 1;
    for (int c = 0; c < 4; ++c) {
      const int kp0 = blk * 256 + c * 64;
      if (kp0 > t) break;
      attend_block<1>(H0 + C_MK + h * 64, H0 + C_MV + h * 64, (size_t)b * S_, kp0, t, 0, qs, pb, slope, m, l, o, lane);
    }
  }
  const float z = bf2f(hrow[C_MZ + h * 64 + lane]);
  MIX[row * D_ + 512 + h * 64 + lane] = f2bf((o[0] / l[0]) * silu_f(z));
}


#define LAS __attribute__((address_space(3)))
typedef short s16x4 __attribute__((ext_vector_type(4)));
typedef short s16x8_t __attribute__((ext_vector_type(8)));
typedef float f32x2_t __attribute__((ext_vector_type(2)));
typedef __bf16 bf16x2_t __attribute__((ext_vector_type(2)));
__device__ __forceinline__ unsigned cvtpk(float lo, float hi) { f32x2_t v = {lo, hi}; bf16x2_t b = __builtin_convertvector(v, bf16x2_t); return __builtin_bit_cast(unsigned, b); }
__device__ __forceinline__ s16x4 vtr(LAS const unsigned char* p) { return __builtin_bit_cast(s16x4, __builtin_amdgcn_ds_read_tr16_b64_v4i16((LAS s16x4*)p)); }
template <int OFF> __device__ __forceinline__ s16x4 vtra(unsigned a) { s16x4 r; asm volatile("ds_read_b64_tr_b16 %0, %1 offset:%2" : "=&v"(r) : "v"(a), "i"(OFF) : "memory"); return r; }
#define LGKM0() do { asm volatile("s_waitcnt lgkmcnt(0)" ::: "memory"); __builtin_amdgcn_sched_barrier(0); } while (0)
constexpr int KT_BYTES = 8192;
constexpr int VT_DT = 2080;
constexpr int VT_BYTES = 4 * VT_DT;
constexpr int AT_BUF = KT_BYTES + VT_BYTES;
constexpr int AT_NST = 4;
constexpr int AT_MISC = AT_NST * AT_BUF;
constexpr int AT_TL = AT_MISC + 64;
constexpr int AT_STASH = AT_MISC + 512;
constexpr int AT_RANK = AT_STASH + 8 * 512 * 16;
constexpr int AT_LDS_END = AT_RANK + 8 * 1024;
__device__ __forceinline__ void ring_wait(int rem) {
  if (rem >= 3) asm volatile("s_waitcnt vmcnt(6)" ::: "memory");
  else if (rem == 2) asm volatile("s_waitcnt vmcnt(4)" ::: "memory");
  else if (rem == 1) asm volatile("s_waitcnt vmcnt(2)" ::: "memory");
  else asm volatile("s_waitcnt vmcnt(0)" ::: "memory");
  __builtin_amdgcn_s_barrier();
  asm volatile("" ::: "memory");
}
constexpr float C1 = 0.125f * 1.4426950408889634f;
constexpr float LOG2E = 1.4426950408889634f;
constexpr float AT_LIM = 1.2379400392853803e27f;
constexpr float AT_TINY = 7.8886090522101181e-31f;

__device__ __forceinline__ void at_stage_write(LAS unsigned char* buf, const u32x4& kreg, const u32x4& vreg, int tid) {
  const int key = tid >> 3, c = tid & 7;
  *(LAS u32x4*)(buf + key * 128 + ((c ^ ((key >> 1) & 7)) << 4)) = kreg;
  *(LAS u32x4*)(buf + KT_BYTES + (c >> 1) * VT_DT + key * 32 + (c & 1) * 16) = vreg;
}
__device__ __forceinline__ void at_stage_dma(LAS unsigned char* buf, const bf16_t* Kt, const bf16_t* Vt, unsigned pitch, int lane, int wid) {
  const int kkey = 8 * wid + (lane >> 3), c = (lane & 7) ^ ((kkey >> 1) & 7);
  __builtin_amdgcn_global_load_lds((const unsigned*)(Kt + (unsigned)kkey * pitch + c * 8), (LAS unsigned*)(buf + wid * 1024), 16, 0, 0);
  const int vkey = 32 * (wid & 1) + (lane >> 1), dt = wid >> 1;
  __builtin_amdgcn_global_load_lds((const unsigned*)(Vt + (unsigned)vkey * pitch + dt * 16 + (lane & 1) * 8), (LAS unsigned*)(buf + KT_BYTES + dt * VT_DT + (wid & 1) * 1024), 16, 0, 0);
}
template <int NRG, bool EDGE, bool IMP  , bool SAFE>
__device__ __forceinline__ void at_tile_x(LAS const unsigned char* buf, const bf16x8 (&qf)[NRG][2], f32x4 (&O)[NRG][4], float (&m)[NRG], float (&l)[NRG], f32x4 (&L)[NRG],
                                        const float (&base)[NRG], const float (&soff)[NRG], const int (&lim)[NRG], const int (&lo)[NRG], int lane,
                                        float (&imp)[NRG][16], float (&carry)[NRG], int tile = 0) {
  const int g = lane >> 4, i = lane & 15;
  const int swz = (i >> 1) & 7;
  LAS const unsigned char* kb = buf + i * 128;
  const int kc0 = ((g ^ swz) << 4), kc1 = (((4 + g) ^ swz) << 4);
  bf16x8 kf[4][2];
#pragma unroll
  for (int mt = 0; mt < 4; ++mt) { kf[mt][0] = *(LAS const bf16x8*)(kb + mt * 2048 + kc0); kf[mt][1] = *(LAS const bf16x8*)(kb + mt * 2048 + kc1); }
  __builtin_amdgcn_sched_barrier(0);
  f32x4 S[NRG][4];
#pragma unroll
  for (int rg = 0; rg < NRG; ++rg) {
    const float bm = base[rg];
#pragma unroll
    for (int mt = 0; mt < 4; ++mt)
#pragma unroll
      for (int r = 0; r < 4; ++r) S[rg][mt][r] = bm + soff[rg] * (float)(16 * mt + r);
  }
  __builtin_amdgcn_sched_barrier(0);
  __builtin_amdgcn_s_setprio(1);
#pragma unroll
  for (int mt = 0; mt < 4; ++mt) {
#pragma unroll
    for (int rg = 0; rg < NRG; ++rg) {
      f32x4 a = __builtin_amdgcn_mfma_f32_16x16x32_bf16(kf[mt][0], qf[rg][0], S[rg][mt], 0, 0, 0);
      S[rg][mt] = __builtin_amdgcn_mfma_f32_16x16x32_bf16(kf[mt][1], qf[rg][1], a, 0, 0, 0);
    }
  }
  __builtin_amdgcn_s_setprio(0);
  __builtin_amdgcn_sched_barrier(0);
  const unsigned vb = (unsigned)(unsigned long long)(buf + KT_BYTES) + (4 * g + (i >> 2)) * 32 + (i & 3) * 8;
#define AT_VRD(dt, ks, d0, d1) { d0 = vtra<(dt) * VT_DT + (ks) * 1024>(vb); d1 = vtra<(dt) * VT_DT + (ks) * 1024 + 512>(vb); }
  s16x4 a0, a1, a2, a3, a4, a5, a6, a7, c0, c1, c2, c3, c4, c5, c6, c7;
  AT_VRD(0, 0, a0, a1) AT_VRD(0, 1, a2, a3) AT_VRD(1, 0, a4, a5) AT_VRD(1, 1, a6, a7)
  __builtin_amdgcn_sched_barrier(0);
  unsigned pk[NRG][2][4];
#pragma unroll
  for (int rg = 0; rg < NRG; ++rg) {
    if (EDGE) {
#pragma unroll
      for (int mt = 0; mt < 4; ++mt)
#pragma unroll
        for (int r = 0; r < 4; ++r) { const int c = 16 * mt + r; S[rg][mt][r] = (c <= lim[rg] && c >= lo[rg]) ? S[rg][mt][r] : -INFINITY; }
    }
    if (SAFE) {
      float mx = -INFINITY;
#pragma unroll
      for (int mt = 0; mt < 4; ++mt)
#pragma unroll
        for (int r = 0; r < 4; ++r) mx = fmaxf(mx, S[rg][mt][r]);
      mx = xmax<16>(mx); mx = xmax<32>(mx);
      const float mn = fmaxf(m[rg], mx);
      const float mu = mn == -INFINITY ? 0.f : mn;
      const float al = __builtin_amdgcn_exp2f(m[rg] - mu);
      m[rg] = mn; l[rg] *= al;
#pragma unroll
      for (int dt = 0; dt < 4; ++dt) O[rg][dt] = O[rg][dt] * al;
      if (IMP) {
#pragma unroll
        for (int k = 0; k < 16; ++k) imp[rg][k] *= al;
        carry[rg] *= al;
      }
      float ps = 0.f;
#pragma unroll
      for (int mt = 0; mt < 4; ++mt)
#pragma unroll
        for (int r = 0; r < 4; ++r) { const float pv = __builtin_amdgcn_exp2f(S[rg][mt][r] - mu); S[rg][mt][r] = pv; ps += pv; }
      l[rg] += ps;
    } else {
#pragma unroll
      for (int mt = 0; mt < 4; ++mt)
#pragma unroll
        for (int r = 0; r < 4; ++r) S[rg][mt][r] = __builtin_amdgcn_exp2f(S[rg][mt][r]);
    }
    if (IMP) {
      const int g = lane >> 4;
      float sh[4], nv[4];
#pragma unroll
      for (int mt = 0; mt < 4; ++mt) sh[mt] = __uint_as_float(__builtin_amdgcn_ds_bpermute(((lane + 48) & 63) << 2, __float_as_uint(S[rg][mt][3])));
#pragma unroll
      for (int mt = 0; mt < 4; ++mt) {
        const float own = (S[rg][mt][0] + S[rg][mt][1]) + (S[rg][mt][2] + S[rg][mt][3]);
        const float prev = g > 0 ? sh[mt] : (mt > 0 ? sh[mt > 0 ? mt - 1 : 0] : carry[rg]);
        nv[mt] = own + prev;
      }
      if (tile == 0) { imp[rg][0] = nv[0]; imp[rg][1] = nv[1]; imp[rg][2] = nv[2]; imp[rg][3] = nv[3]; }
      else if (tile == 1) { imp[rg][4] = nv[0]; imp[rg][5] = nv[1]; imp[rg][6] = nv[2]; imp[rg][7] = nv[3]; }
      else if (tile == 2) { imp[rg][8] = nv[0]; imp[rg][9] = nv[1]; imp[rg][10] = nv[2]; imp[rg][11] = nv[3]; }
      else { imp[rg][12] = nv[0]; imp[rg][13] = nv[1]; imp[rg][14] = nv[2]; imp[rg][15] = nv[3]; }
      carry[rg] = sh[3];
    }
#pragma unroll
    for (int ks = 0; ks < 2; ++ks) {
      pk[rg][ks][0] = cvtpk(S[rg][2 * ks][0], S[rg][2 * ks][1]); pk[rg][ks][1] = cvtpk(S[rg][2 * ks][2], S[rg][2 * ks][3]);
      pk[rg][ks][2] = cvtpk(S[rg][2 * ks + 1][0], S[rg][2 * ks + 1][1]); pk[rg][ks][3] = cvtpk(S[rg][2 * ks + 1][2], S[rg][2 * ks + 1][3]);
    }
  }
  __builtin_amdgcn_sched_barrier(0);
#define AT_PV(dt, ks, d0, d1) { const bf16x8 vf = (bf16x8){d0[0], d0[1], d0[2], d0[3], d1[0], d1[1], d1[2], d1[3]}; \
    _Pragma("unroll") for (int rg = 0; rg < NRG; ++rg) { const u32x4 pw = {pk[rg][ks][0], pk[rg][ks][1], pk[rg][ks][2], pk[rg][ks][3]}; \
      O[rg][dt] = __builtin_amdgcn_mfma_f32_16x16x32_bf16(vf, __builtin_bit_cast(bf16x8, pw), O[rg][dt], 0, 0, 0); } }
  LGKM0();
  AT_VRD(2, 0, c0, c1) AT_VRD(2, 1, c2, c3) AT_VRD(3, 0, c4, c5) AT_VRD(3, 1, c6, c7)
  if (!SAFE) {
    const short one = (short)0x3F80; const bf16x8 ones = __builtin_bit_cast(bf16x8, (s16x8_t){one, one, one, one, one, one, one, one});
#pragma unroll
    for (int ks = 0; ks < 2; ++ks)
#pragma unroll
      for (int rg = 0; rg < NRG; ++rg) { const u32x4 pw = {pk[rg][ks][0], pk[rg][ks][1], pk[rg][ks][2], pk[rg][ks][3]};
        L[rg] = __builtin_amdgcn_mfma_f32_16x16x32_bf16(ones, __builtin_bit_cast(bf16x8, pw), L[rg], 0, 0, 0); }
  }
  __builtin_amdgcn_s_setprio(1);
  AT_PV(0, 0, a0, a1) AT_PV(0, 1, a2, a3) AT_PV(1, 0, a4, a5) AT_PV(1, 1, a6, a7)
  LGKM0();
  AT_PV(2, 0, c0, c1) AT_PV(2, 1, c2, c3) AT_PV(3, 0, c4, c5) AT_PV(3, 1, c6, c7)
  __builtin_amdgcn_s_setprio(0);
#undef AT_VRD
#undef AT_PV
}

template <int NRG, bool EDGE, bool SAFE>
__device__ __forceinline__ void at_tile(LAS const unsigned char* buf, const bf16x8 (&qf)[NRG][2], f32x4 (&O)[NRG][4], float (&m)[NRG], float (&l)[NRG], f32x4 (&L)[NRG],
                                        const float (&base)[NRG], const float (&soff)[NRG], const int (&lim)[NRG], const int (&lo)[NRG], int lane) {
  float dimp[NRG][16]; float dc[NRG];
  at_tile_x<NRG, EDGE, false, SAFE>(buf, qf, O, m, l, L, base, soff, lim, lo, lane, dimp, dc);
}

__device__ __forceinline__ void pair_load8(const bf16_t* rowp, int g, int dp, u32x2& e, u32x2& o) {
  const bool odd = (g & 1) != 0;
  const u32x4 ld = *(const u32x4*)(rowp + 16 * (2 * dp + (odd ? 1 : 0)) + 4 * (g & ~1));
  const unsigned s0 = odd ? ld[0] : ld[2], s1 = odd ? ld[1] : ld[3];
  const unsigned c0 = (unsigned)__builtin_amdgcn_ds_swizzle((int)s0, (16 << 10) | 0x1f), c1 = (unsigned)__builtin_amdgcn_ds_swizzle((int)s1, (16 << 10) | 0x1f);
  e = (u32x2){odd ? c0 : ld[0], odd ? c1 : ld[1]}; o = (u32x2){odd ? ld[2] : c0, odd ? ld[3] : c1};
}
__device__ __forceinline__ void pair_store8(bf16_t* rowp, int g, int dp, u32x2 e, u32x2 o) {
  const bool odd = (g & 1) != 0;
  const u32x2 snd = odd ? e : o;
  const unsigned r0 = (unsigned)__builtin_amdgcn_ds_swizzle((int)snd[0], (16 << 10) | 0x1f), r1 = (unsigned)__builtin_amdgcn_ds_swizzle((int)snd[1], (16 << 10) | 0x1f);
  const u32x4 w16 = odd ? (u32x4){r0, r1, o[0], o[1]} : (u32x4){e[0], e[1], r0, r1};
  *(u32x4*)(rowp + 16 * (2 * dp + (odd ? 1 : 0)) + 4 * (g & ~1)) = w16;
}
__device__ __forceinline__ u32x2 gate_pack(const f32x4 v, const u32x2 z) {
  return (u32x2){cvtpk(v[0] * silu_f(__uint_as_float(z[0] << 16)), v[1] * silu_f(__uint_as_float(z[0] & 0xffff0000u))),
                 cvtpk(v[2] * silu_f(__uint_as_float(z[1] << 16)), v[3] * silu_f(__uint_as_float(z[1] & 0xffff0000u)))};
}
__device__ __forceinline__ bool at_any_bad(bool bad, LAS unsigned char* lds, int lane, int wid) {
  LAS unsigned* fl = (LAS unsigned*)(lds + AT_MISC + 320);
  const bool wb = __any(bad);
  if (lane == 0) fl[wid] = wb ? 1u : 0u;
  wg_sync();
  unsigned a = 0u;
#pragma unroll
  for (int w = 0; w < 8; ++w) a |= fl[w];
  return __builtin_amdgcn_readfirstlane(a) != 0u;
}

template <bool SAFE>
__device__ __forceinline__ bool moba_mfma_item(const Params& P, int b, int h, int cur, unsigned char* smem_g) {
  LAS unsigned char* lds = (LAS unsigned char*)smem_g;
  const bf16_t* __restrict__ H0 = (const bf16_t*)(P.ws + WS_H);
  const float* __restrict__ KM = (const float*)(P.ws + WS_KM);
  bf16_t* __restrict__ MIX = (bf16_t*)(P.ws + WS_MIX);
  const int tid = otid(), lane = tid & 63, wid = __builtin_amdgcn_readfirstlane(tid >> 6), g = lane >> 4, i = lane & 15;
  const float slope2 = exp2f(-(float)(h + 1)) * LOG2E;
  const int t0 = cur * 256;
  int trow[2]; bf16x8 qf[2][2]; unsigned sel[2];
#pragma unroll
  for (int rg = 0; rg < 2; ++rg) {
    trow[rg] = t0 + wid * 32 + rg * 16 + i;
    const bf16_t* qp = H0 + ((size_t)b * S_ + trow[rg]) * P0 + C_MQ + h * 64 + 8 * g;
    qf[rg][0] = *(const bf16x8*)qp; qf[rg][1] = *(const bf16x8*)(qp + 32);
  }
  {
    LAS float* kml = (LAS float*)(lds + AT_STASH);
#pragma unroll
    for (int k = 0; k < 2; ++k) { const int e = tid + 512 * k, n = e >> 6; if (n < cur) kml[e] = KM[(((size_t)b * 16 + n) * 8 + h) * 64 + (e & 63)]; }
    wg_sync();
#pragma unroll
    for (int rg = 0; rg < 2; ++rg) {
      float qv[16];
#pragma unroll
      for (int j = 0; j < 8; ++j) { qv[j] = bf2f((bf16_t)qf[rg][0][j]); qv[8 + j] = bf2f((bf16_t)qf[rg][1][j]); }
      float v1 = -INFINITY, v2 = -INFINITY, v3 = -INFINITY; int i1 = -1, i2 = -1, i3 = -1;
      for (int n = 0; n < cur; ++n) {
        LAS const float* kr = kml + n * 64 + 8 * g;
        const f32x4 a0 = *(LAS const f32x4*)kr, a1 = *(LAS const f32x4*)(kr + 4), b0 = *(LAS const f32x4*)(kr + 32), b1 = *(LAS const f32x4*)(kr + 36);
        float d = qv[0] * a0[0] + qv[1] * a0[1] + qv[2] * a0[2] + qv[3] * a0[3] + qv[4] * a1[0] + qv[5] * a1[1] + qv[6] * a1[2] + qv[7] * a1[3]
                + qv[8] * b0[0] + qv[9] * b0[1] + qv[10] * b0[2] + qv[11] * b0[3] + qv[12] * b1[0] + qv[13] * b1[1] + qv[14] * b1[2] + qv[15] * b1[3];
        d = xsum<16>(d); d = xsum<32>(d);
        if (d > v1) { v3 = v2; i3 = i2; v2 = v1; i2 = i1; v1 = d; i1 = n; }
        else if (d > v2) { v3 = v2; i3 = i2; v2 = d; i2 = n; }
        else if (d > v3) { v3 = d; i3 = n; }
      }
      unsigned mk = 0u;
      if (i1 >= 0) mk |= 1u << i1;
      if (i2 >= 0) mk |= 1u << i2;
      if (i3 >= 0) mk |= 1u << i3;
      sel[rg] = mk;
    }
  }
  {
    unsigned u = sel[0] | sel[1];
    u = xorr<1>(u); u = xorr<2>(u); u = xorr<4>(u); u = xorr<8>(u);
    LAS unsigned* misc = (LAS unsigned*)(lds + AT_MISC);
    if (lane == 0) misc[wid] = u;
  }
  wg_sync();
  unsigned umask = 0u;
  {
    LAS unsigned* misc = (LAS unsigned*)(lds + AT_MISC);
#pragma unroll
    for (int w = 0; w < 8; ++w) umask |= misc[w];
  }
  umask = __builtin_amdgcn_readfirstlane(umask);
  const int npast = __builtin_popcount(umask);
  const int nt = 4 * npast + 4;
  f32x4 O[2][4], L[2]; float m[2], l[2];
#pragma unroll
  for (int rg = 0; rg < 2; ++rg) { m[rg] = SAFE ? -INFINITY : 0.f; l[rg] = 0.f; L[rg] = (f32x4){0.f, 0.f, 0.f, 0.f};
#pragma unroll
    for (int dt = 0; dt < 4; ++dt) O[rg][dt] = (f32x4){0.f, 0.f, 0.f, 0.f}; }
  const bf16_t* Kg = H0 + (size_t)b * S_ * P0 + C_MK + h * 64;
  const bf16_t* Vg = H0 + (size_t)b * S_ * P0 + C_MV + h * 64;
  LAS int* tl = (LAS int*)(lds + AT_TL);
  if (tid < nt) {
    int k0v;
    if (tid < 4 * npast) { unsigned r = umask; for (int q = 0; q < (tid >> 2); ++q) r &= r - 1; k0v = __builtin_ctz(r) * 256 + (tid & 3) * 64; }
    else k0v = cur * 256 + (tid - 4 * npast) * 64;
    tl[tid] = k0v;
  }
  asm volatile("s_waitcnt vmcnt(0)" ::: "memory");
  wg_sync();
  const int tlv = tl[lane];
#define TLR(ix) __builtin_amdgcn_readlane(tlv, (ix))
#pragma unroll
  for (int st = 0; st < 3; ++st) if (st < nt) { const int k0s = TLR(st); at_stage_dma(lds + st * AT_BUF, Kg + (size_t)k0s * P0, Vg + (size_t)k0s * P0, P0, lane, wid); }
  const int ntp = 4 * npast;
#pragma unroll 1
  for (int ti = 0; ti < ntp; ++ti) {
    ring_wait(min(nt - 1 - ti, 2));
    if (ti + 3 < nt) { const int k0n = TLR(ti + 3); at_stage_dma(lds + ((ti + 3) & 3) * AT_BUF, Kg + (size_t)k0n * P0, Vg + (size_t)k0n * P0, P0, lane, wid); }
    const int ck0 = TLR(ti), cblk = ck0 >> 8;
    LAS const unsigned char* buf = lds + (ti & 3) * AT_BUF;
    float base[2], soff[2]; int lim[2], lo[2];
#pragma unroll
    for (int rg = 0; rg < 2; ++rg) {
      const bool rs = (sel[rg] >> cblk) & 1u;
      base[rg] = rs ? slope2 * (float)(ck0 + 4 * g - trow[rg]) : -INFINITY;
      soff[rg] = slope2; lim[rg] = 0; lo[rg] = 0;
    }
    at_tile<2, false, SAFE>(buf, qf, O, m, l, L, base, soff, lim, lo, lane);
  }
#pragma unroll 1
  for (int ti = ntp; ti < nt; ++ti) {
    ring_wait(min(nt - 1 - ti, 2));
    if (ti + 3 < nt) { const int k0n = TLR(ti + 3); at_stage_dma(lds + ((ti + 3) & 3) * AT_BUF, Kg + (size_t)k0n * P0, Vg + (size_t)k0n * P0, P0, lane, wid); }
    const int ck0 = TLR(ti);
    if (ck0 > t0 + wid * 32 + 31) continue;
    LAS const unsigned char* buf = lds + (ti & 3) * AT_BUF;
    float base[2], soff[2]; int lim[2], lo[2];
#pragma unroll
    for (int rg = 0; rg < 2; ++rg) {
      base[rg] = slope2 * (float)(ck0 + 4 * g - trow[rg]);
      soff[rg] = slope2; lim[rg] = trow[rg] - ck0 - 4 * g; lo[rg] = -1000000;
    }
    at_tile<2, true, SAFE>(buf, qf, O, m, l, L, base, soff, lim, lo, lane);
  }
  float ltot[2];
#pragma unroll
  for (int rg = 0; rg < 2; ++rg) { float lt = l[rg]; lt = xsum<16>(lt); lt = xsum<32>(lt); ltot[rg] = SAFE ? lt : L[rg][0]; }
  u32x2 ze[2][2], zo[2][2];
#pragma unroll
  for (int rg = 0; rg < 2; ++rg)
#pragma unroll
    for (int dp = 0; dp < 2; ++dp) pair_load8(H0 + ((size_t)b * S_ + trow[rg]) * P0 + C_MZ + h * 64, g, dp, ze[rg][dp], zo[rg][dp]);
  if (SAFE) __builtin_amdgcn_s_barrier();
  else if (at_any_bad(!(ltot[0] <= AT_LIM) | !(ltot[1] <= AT_LIM) | !(ltot[0] >= AT_TINY) | !(ltot[1] >= AT_TINY), lds, lane, wid)) return true;
#pragma unroll
  for (int rg = 0; rg < 2; ++rg) {
    const float lt = ltot[rg];
    const float inv = 1.f / lt;
    const size_t row = (size_t)b * S_ + trow[rg];
#pragma unroll
    for (int dp = 0; dp < 2; ++dp)
      pair_store8(MIX + row * D_ + 512 + h * 64, g, dp, gate_pack(O[rg][2 * dp] * inv, ze[rg][dp]), gate_pack(O[rg][2 * dp + 1] * inv, zo[rg][dp]));
  }
  return false;
}


constexpr size_t WS_KCB = 248 * MiB;
constexpr size_t WS_VCB = 249 * MiB;
template <bool SAFE>
__device__ __forceinline__ bool nsa_mfma_item(const Params& P, int b, int grp, int sb, unsigned char* smem_g) {
  LAS unsigned char* lds = (LAS unsigned char*)smem_g;
  const bf16_t* __restrict__ H0 = (const bf16_t*)(P.ws + WS_H);
  bf16_t* __restrict__ MIX = (bf16_t*)(P.ws + WS_MIX);
  const int tid = otid(), lane = tid & 63, wid = __builtin_amdgcn_readfirstlane(tid >> 6), g = lane >> 4, i = lane & 15;
  const int t0 = sb * 64;
  int trow[2]; bf16x8 qf[2][2];
  const int hh = grp * 4 + (i & 3);
  const float slope2 = exp2f(-(float)(hh + 1)) * LOG2E;
  const bf16_t* __restrict__ Hb = H0 + (size_t)b * S_ * P0;
#pragma unroll
  for (int rg = 0; rg < 2; ++rg) {
    trow[rg] = t0 + wid * 8 + rg * 4 + (i >> 2);
    const unsigned qo = (unsigned)trow[rg] * P0 + C_NQ + hh * 64 + 8 * g;
    qf[rg][0] = *(const bf16x8*)(Hb + qo); qf[rg][1] = *(const bf16x8*)(Hb + qo + 32);
  }
  unsigned gp01[2], gp2[2];
#pragma unroll
  for (int rg = 0; rg < 2; ++rg) { const bf16_t* gsrc = Hb + (unsigned)trow[rg] * P0 + C_NG + hh * 3;
    gp01[rg] = (unsigned)gsrc[0] | ((unsigned)gsrc[1] << 16); gp2[rg] = (unsigned)gsrc[2]; }
  LAS f32x4* stash = (LAS f32x4*)(lds + AT_STASH) + tid;
  f32x4 O[2][4], L[2]; float m[2], l[2];
  unsigned mlo[2], mhi[2];
  bool bad = false;
  const int ntc = ((4 * sb + 2) >> 6) + 1;
  {
    const bf16_t* Kg = (const bf16_t*)(P.ws + WS_KCB) + (size_t)(b * 2 + grp) * 256 * 64;
    const bf16_t* Vg = (const bf16_t*)(P.ws + WS_VCB) + (size_t)(b * 2 + grp) * 256 * 64;
    asm volatile("s_waitcnt vmcnt(0)" ::: "memory");
#pragma unroll
    for (int tile = 0; tile < 4; ++tile) if (tile < ntc) at_stage_dma(lds + tile * AT_BUF, Kg + tile * 4096, Vg + tile * 4096, 64, lane, wid);
  }
#pragma unroll
  for (int rg = 0; rg < 2; ++rg) {
    float imp[1][16], carry[1], m1[1], l1[1]; f32x4 O1[1][4], L1[1]; bf16x8 q1[1][2];
    L1[0] = (f32x4){0.f, 0.f, 0.f, 0.f};
    q1[0][0] = qf[rg][0]; q1[0][1] = qf[rg][1];
    m1[0] = SAFE ? -INFINITY : 0.f; l1[0] = 0.f; carry[0] = 0.f;
#pragma unroll
    for (int k = 0; k < 16; ++k) imp[0][k] = 0.f;
#pragma unroll
    for (int dt = 0; dt < 4; ++dt) O1[0][dt] = (f32x4){0.f, 0.f, 0.f, 0.f};
#pragma unroll 1
    for (int tile = 0; tile < ntc; ++tile) {
      if (rg == 0) ring_wait(ntc - 1 - tile);
      LAS const unsigned char* buf = lds + tile * AT_BUF;
      float base[1], soff[1]; int lim[1], lo[1];
      const int nlim = trow[rg] >= 31 ? ((trow[rg] - 31) >> 4) : -1;
      base[0] = slope2 * (float)(16 * (64 * tile + 4 * g) + 31 - trow[rg]);
      soff[0] = 16.f * slope2; lim[0] = nlim - 64 * tile - 4 * g; lo[0] = -1000000;
      at_tile_x<1, true, true, SAFE>(buf, q1, O1, m1, l1, L1, base, soff, lim, lo, lane, imp, carry, tile);
    }
    {
      float lt = l1[0]; lt = xsum<16>(lt); lt = xsum<32>(lt);
      if (!SAFE) { lt = L1[0][0]; bad |= !(lt <= AT_LIM) | (trow[rg] >= 31 && !(lt >= AT_TINY)); }
      const float inv = lt > 0.f ? 1.f / lt : 0.f;
      const float g0 = sigmoid_f(__uint_as_float(gp01[rg] << 16));
#pragma unroll
      for (int dt = 0; dt < 4; ++dt) stash[(rg * 4 + dt) * 512] = O1[0][dt] * (g0 * inv);
      if (sb < 16) { mlo[rg] = (1u << (sb + 1)) - 1u; mhi[rg] = 0u; }
      else {
        const int j = i & 3;
        unsigned mykey[4]; int mys[4], rank[4];
#pragma unroll
        for (int q = 0; q < 4; ++q) { mykey[q] = 0u; mys[q] = 4 * (4 * j + q) + g; rank[q] = 0; }
#pragma unroll
        for (int k = 0; k < 16; ++k) {
          float v = imp[0][k] * inv; v = xsum<1>(v); v = xsum<2>(v);
          const int sidx = 4 * k + g;
          const bool forced = (sidx == 0) || (sidx == sb) || (sidx == sb - 1);
          const unsigned u = sidx <= sb ? ((__float_as_uint(forced ? 1e9f : v) & ~63u) | (unsigned)(63 - sidx)) : 0u;
          if ((k >> 2) == j) mykey[k & 3] = u;
        }
        LAS unsigned* rk = (LAS unsigned*)(lds + AT_RANK + wid * 1024) + (i >> 2) * 64;
#pragma unroll
        for (int q = 0; q < 4; ++q) rk[mys[q]] = mykey[q];
#pragma unroll 1
        for (int c4 = 0; 16 * c4 <= sb; ++c4) {
          u32x4 o[4];
#pragma unroll
          for (int c = 0; c < 4; ++c) o[c] = *(LAS const u32x4*)(rk + 16 * c4 + 4 * c);
#pragma unroll
          for (int c = 0; c < 4; ++c)
#pragma unroll
            for (int e = 0; e < 4; ++e)
#pragma unroll
              for (int q = 0; q < 4; ++q) rank[q] += (o[c][e] > mykey[q]) ? 1 : 0;
        }
        unsigned a = 0u, bb = 0u;
#pragma unroll
        for (int q = 0; q < 4; ++q) if (rank[q] < 16 && mys[q] <= sb) { if (mys[q] < 32) a |= 1u << mys[q]; else bb |= 1u << (mys[q] - 32); }
        a = xorr<1>(a); bb = xorr<1>(bb); a = xorr<2>(a); bb = xorr<2>(bb);
        a = xorr<16>(a); bb = xorr<16>(bb); a = xorr<32>(a); bb = xorr<32>(bb);
        mlo[rg] = a; mhi[rg] = bb;
      }
    }
  }
  {
    unsigned ua = mlo[0] | mlo[1], ub = mhi[0] | mhi[1];
    ua = xorr<4>(ua); ub = xorr<4>(ub); ua = xorr<8>(ua); ub = xorr<8>(ub);
    LAS unsigned* misc = (LAS unsigned*)(lds + AT_MISC);
    if (lane == 0) { misc[2 * wid] = ua; misc[2 * wid + 1] = ub; }
    wg_sync();
    ua = 0u; ub = 0u;
#pragma unroll
    for (int w = 0; w < 8; ++w) { ua |= misc[2 * w]; ub |= misc[2 * w + 1]; }
    unsigned long long rem = ((unsigned long long)(unsigned)__builtin_amdgcn_readfirstlane(ub) << 32) | (unsigned)__builtin_amdgcn_readfirstlane(ua);
    const int nt = __builtin_popcountll(rem);
#pragma unroll
    for (int rg = 0; rg < 2; ++rg) { m[rg] = SAFE ? -INFINITY : 0.f; l[rg] = 0.f; L[rg] = (f32x4){0.f, 0.f, 0.f, 0.f};
#pragma unroll
      for (int dt = 0; dt < 4; ++dt) O[rg][dt] = (f32x4){0.f, 0.f, 0.f, 0.f}; }
    const bf16_t* Kg = Hb + C_KSEL + grp * 64;
    const bf16_t* Vg = Hb + C_VSEL + grp * 64;
    LAS int* tl = (LAS int*)(lds + AT_TL);
    if (tid < nt) { unsigned long long r = rem; for (int q = 0; q < tid; ++q) r &= r - 1; tl[tid] = __builtin_ctzll(r); }
    asm volatile("s_waitcnt vmcnt(0)" ::: "memory");
    wg_sync();
    const int tlv = tl[lane];
#pragma unroll
    for (int st = 0; st < 3; ++st) if (st < nt) { const int bs = TLR(st); at_stage_dma(lds + st * AT_BUF, Kg + (size_t)bs * 64 * P0, Vg + (size_t)bs * 64 * P0, P0, lane, wid); }
#define NSA_SEL_STEP(EDGEV) { \
      ring_wait(min(nt - 1 - ti, 2)); \
      if (ti + 3 < nt) { const int bn = TLR(ti + 3); at_stage_dma(lds + ((ti + 3) & 3) * AT_BUF, Kg + (size_t)bn * 64 * P0, Vg + (size_t)bn * 64 * P0, P0, lane, wid); } \
      const int cblk = TLR(ti); \
      LAS const unsigned char* buf = lds + (ti & 3) * AT_BUF; \
      float base[2], soff[2]; int lim[2], lo[2]; \
      _Pragma("unroll") for (int rg = 0; rg < 2; ++rg) { \
        const bool rs = cblk < 32 ? ((mlo[rg] >> cblk) & 1u) : ((mhi[rg] >> (cblk - 32)) & 1u); \
        base[rg] = rs ? slope2 * (float)(cblk * 64 + 4 * g - trow[rg]) : -INFINITY; \
        soff[rg] = slope2; lim[rg] = trow[rg] - cblk * 64 - 4 * g; lo[rg] = -1000000; \
      } \
      at_tile<2, EDGEV, SAFE>(buf, qf, O, m, l, L, base, soff, lim, lo, lane); }
    int ti = 0;
#pragma unroll 1
    for (; ti < nt - 1; ++ti) NSA_SEL_STEP(false)
    NSA_SEL_STEP(true)
#undef NSA_SEL_STEP
    __builtin_amdgcn_s_barrier();
#pragma unroll
    for (int rg = 0; rg < 2; ++rg) {
      float lt = l[rg]; lt = xsum<16>(lt); lt = xsum<32>(lt);
      if (!SAFE) { lt = L[rg][0]; bad |= !(lt <= AT_LIM) | !(lt >= AT_TINY); }
      const float g1 = sigmoid_f(__uint_as_float(gp01[rg] & 0xffff0000u));
#pragma unroll
      for (int dt = 0; dt < 4; ++dt) stash[(rg * 4 + dt) * 512] += O[rg][dt] * (g1 / lt);
    }
  }
  {
    const int b0 = sb >= 8 ? sb - 8 : 0;
    const int nt = sb - b0 + 1;
#pragma unroll
    for (int rg = 0; rg < 2; ++rg) { m[rg] = SAFE ? -INFINITY : 0.f; l[rg] = 0.f; L[rg] = (f32x4){0.f, 0.f, 0.f, 0.f};
#pragma unroll
      for (int dt = 0; dt < 4; ++dt) O[rg][dt] = (f32x4){0.f, 0.f, 0.f, 0.f}; }
    const bf16_t* Kg = Hb + C_KWIN + grp * 64;
    const bf16_t* Vg = Hb + C_VWIN + grp * 64;
    asm volatile("s_waitcnt vmcnt(0)" ::: "memory");
#pragma unroll
    for (int st = 0; st < 3; ++st) if (st < nt) at_stage_dma(lds + st * AT_BUF, Kg + (size_t)(b0 + st) * 64 * P0, Vg + (size_t)(b0 + st) * 64 * P0, P0, lane, wid);
#define NSA_WIN_STEP(EDGEV) { \
      ring_wait(min(nt - 1 - ti, 2)); \
      const int cblk = b0 + ti; \
      if (ti + 3 < nt) at_stage_dma(lds + ((ti + 3) & 3) * AT_BUF, Kg + (size_t)(cblk + 3) * 64 * P0, Vg + (size_t)(cblk + 3) * 64 * P0, P0, lane, wid); \
      LAS const unsigned char* buf = lds + (ti & 3) * AT_BUF; \
      float base[2], soff[2]; int lim[2], lo[2]; \
      _Pragma("unroll") for (int rg = 0; rg < 2; ++rg) { \
        base[rg] = slope2 * (float)(cblk * 64 + 4 * g - trow[rg]); \
        soff[rg] = slope2; lim[rg] = trow[rg] - cblk * 64 - 4 * g; lo[rg] = trow[rg] - 511 - cblk * 64 - 4 * g; \
      } \
      at_tile<2, EDGEV, SAFE>(buf, qf, O, m, l, L, base, soff, lim, lo, lane); }
    int ti = 0;
    if (sb >= 8) { NSA_WIN_STEP(true) ++ti; }
#pragma unroll 1
    for (; ti < nt - 1; ++ti) NSA_WIN_STEP(false)
    NSA_WIN_STEP(true)
#undef NSA_WIN_STEP
  }
  float ltot[2];
#pragma unroll
  for (int rg = 0; rg < 2; ++rg) { float lt = l[rg]; lt = xsum<16>(lt); lt = xsum<32>(lt); ltot[rg] = SAFE ? lt : L[rg][0]; }
  if (SAFE) __builtin_amdgcn_s_barrier();
  else if (at_any_bad(bad | !(ltot[0] <= AT_LIM) | !(ltot[1] <= AT_LIM) | !(ltot[0] >= AT_TINY) | !(ltot[1] >= AT_TINY), lds, lane, wid)) return true;
#pragma unroll
  for (int rg = 0; rg < 2; ++rg) {
    const float lt = ltot[rg];
    const unsigned ro = (unsigned)trow[rg] * P0;
    const float g2 = sigmoid_f(__uint_as_float(gp2[rg] << 16)) / lt;
    u32x2 ze[2], zo[2];
#pragma unroll
    for (int dp = 0; dp < 2; ++dp) pair_load8(Hb + ro + C_NZ + hh * 64, g, dp, ze[dp], zo[dp]);
#pragma unroll
    for (int dp = 0; dp < 2; ++dp) {
      const f32x4 ve = stash[(rg * 4 + 2 * dp) * 512] + O[rg][2 * dp] * g2, vo = stash[(rg * 4 + 2 * dp + 1) * 512] + O[rg][2 * dp + 1] * g2;
      pair_store8(MIX + (size_t)b * S_ * D_ + (unsigned)trow[rg] * D_ + hh * 64, g, dp, gate_pack(ve, ze[dp]), gate_pack(vo, zo[dp]));
    }
  }
  return false;
}

__device__ __forceinline__ void gla_gate_phase(const Params& P) {
  const bf16_t* H1 = (const bf16_t*)(P.ws + WS_H);
  float* G = (float*)(P.ws + WS_G);
  const float* w2 = P.in[10]; const float* gb = P.in[11];
  const size_t total = (size_t)M_ * 512;
  for (size_t i = (size_t)blockIdx.x * 512 + otid(); i < total; i += (size_t)gridDim.x * 512) {
    const int c = (int)(i & 511); const size_t row = i >> 9;
    float x = gb[c];
#pragma unroll
    for (int r = 0; r < 16; ++r) x += bf2f(H1[row * P1 + G_LR + r]) * w2[r * 512 + c];
    const float ls = fminf(x, 0.f) - log1pf(__expf(-fabsf(x)));
    G[i] = ls * (1.f / 16.f);
  }
}
__device__ __forceinline__ void gla_scan_vblock(const Params& P, int vb) {
  const bf16_t* __restrict__ H1 = (const bf16_t*)(P.ws + WS_H);
  const float* __restrict__ G = (const float*)(P.ws + WS_G);
  bf16_t* __restrict__ O = (bf16_t*)(P.ws + WS_XB);
  const int tid = otid(), lane = tid & 63, wid = tid >> 6;
  const int eh = vb & 1, h = (vb >> 1) & 3, b = vb >> 3;
  const int e = eh * 128 + wid * 16 + (lane >> 2), dq = lane & 3;
  float St[32];
#pragma unroll
  for (int i = 0; i < 32; ++i) St[i] = 0.f;
  const float qscale = 0.08838834764831845f;
  for (int t = 0; t < S_; ++t) {
    const size_t row = (size_t)b * S_ + t;
    const float4* gr = (const float4*)(G + row * 512 + h * 128 + dq * 32);
    const uint4* kr = (const uint4*)(H1 + row * P1 + G_K + h * 128 + dq * 32);
    const uint4* qr = (const uint4*)(H1 + row * P1 + G_Q + h * 128 + dq * 32);
    const float v = bf2f(H1[row * P1 + G_V + h * 256 + e]);
    float o = 0.f;
#pragma unroll
    for (int c = 0; c < 4; ++c) {
      const uint4 ku = kr[c], qu = qr[c];
      const float4 g0 = gr[2 * c], g1 = gr[2 * c + 1];
      const float kk[8] = {__uint_as_float(ku.x << 16), __uint_as_float(ku.x & 0xffff0000u), __uint_as_float(ku.y << 16), __uint_as_float(ku.y & 0xffff0000u),
                           __uint_as_float(ku.z << 16), __uint_as_float(ku.z & 0xffff0000u), __uint_as_float(ku.w << 16), __uint_as_float(ku.w & 0xffff0000u)};
      const float qq[8] = {__uint_as_float(qu.x << 16), __uint_as_float(qu.x & 0xffff0000u), __uint_as_float(qu.y << 16), __uint_as_float(qu.y & 0xffff0000u),
                           __uint_as_float(qu.z << 16), __uint_as_float(qu.z & 0xffff0000u), __uint_as_float(qu.w << 16), __uint_as_float(qu.w & 0xffff0000u)};
      const float gg[8] = {g0.x, g0.y, g0.z, g0.w, g1.x, g1.y, g1.z, g1.w};
#pragma unroll
      for (int i = 0; i < 8; ++i) {
        const float a = __expf(gg[i]);
        St[c * 8 + i] = a * St[c * 8 + i] + kk[i] * v;
        o += qq[i] * St[c * 8 + i];
      }
    }
    o = xsum<1>(o); o = xsum<2>(o);
    if (dq == 0) O[row * D_ + h * 256 + e] = f2bf(o * qscale);
  }
}

constexpr int CTL_GLA = 16384;
constexpr size_t WS_QT = WS_G;
constexpr size_t WS_KH = WS_G + 16 * MiB;
constexpr size_t WS_ATT = 190 * MiB;
constexpr size_t WS_DEC = 199 * MiB;
__device__ __forceinline__ int kperm(int x) { const int dl = x & 31, hi = dl >> 4, d2 = dl & 15; return (x & ~31) + 8 * (d2 >> 2) + 4 * hi + (d2 & 3); }

__device__ __forceinline__ void st8_wt(void* p, unsigned lo, unsigned hi) {
  __hip_atomic_store((unsigned long long*)p, ((unsigned long long)hi << 32) | lo, __ATOMIC_RELAXED, __HIP_MEMORY_SCOPE_AGENT);
}
__device__ __forceinline__ void gla_prep_item(const Params& P, int item, unsigned char* smem_g) {
  const bf16_t* __restrict__ H1 = (const bf16_t*)(P.ws + WS_H);
  bf16_t* __restrict__ QT = (bf16_t*)(P.ws + WS_QT) + (size_t)item * 8192;
  bf16_t* __restrict__ KH = (bf16_t*)(P.ws + WS_KH) + (size_t)item * 8192;
  bf16_t* __restrict__ ATT = (bf16_t*)(P.ws + WS_ATT) + (size_t)item * 4096;
  float* __restrict__ DEC = (float*)(P.ws + WS_DEC) + (size_t)item * 128;
  const int tid = otid(), lane = tid & 63, wid = tid >> 6, g = lane >> 4, i = lane & 15;
  const int c = item & 63, h = (item >> 6) & 3, b = item >> 8;
  const size_t rowbase = (size_t)b * S_ + c * 64;
  float* glr = (float*)smem_g;
  float* tot = (float*)(smem_g + 4096);
  bf16_t* qs = (bf16_t*)(smem_g + 12288);
  bf16_t* ks = (bf16_t*)(smem_g + 12288 + 17408);
  const int d0 = (tid & 31) * 4, rgp = tid >> 5;
#pragma unroll
  for (int k = 0; k < 2; ++k) { const int e = tid + 512 * k; glr[e] = ((const float*)(P.ws + WS_GLR))[rowbase * 16 + e]; }
  uint2 qraw[4], kraw[4];
#pragma unroll
  for (int k = 0; k < 4; ++k) {
    qraw[k] = *(const uint2*)(H1 + (rowbase + 4 * rgp + k) * P1 + G_Q + h * 128 + d0);
    kraw[k] = *(const uint2*)(H1 + (rowbase + 4 * rgp + k) * P1 + G_K + h * 128 + d0);
  }
  float4 w[16];
#pragma unroll
  for (int r = 0; r < 16; ++r) w[r] = *(const float4*)(P.in[10] + r * 512 + h * 128 + d0);
  const float4 gb = *(const float4*)(P.in[11] + h * 128 + d0);
  wg_sync();
  float bb[4][4];
  float run[4] = {0.f, 0.f, 0.f, 0.f};
#pragma unroll
  for (int k = 0; k < 4; ++k) {
    const float* gr = glr + (4 * rgp + k) * 16;
    float x[4] = {gb.x, gb.y, gb.z, gb.w};
#pragma unroll
    for (int r = 0; r < 16; ++r) { const float gv = gr[r]; x[0] += gv * w[r].x; x[1] += gv * w[r].y; x[2] += gv * w[r].z; x[3] += gv * w[r].w; }
#pragma unroll
    for (int j = 0; j < 4; ++j) {
      const float la = (fminf(x[j], 0.f) - __logf(1.f + __expf(-fabsf(x[j])))) * (1.f / 16.f);
      run[j] += la; bb[k][j] = run[j];
    }
  }
  *(float4*)(tot + rgp * 128 + d0) = (float4){run[0], run[1], run[2], run[3]};
  wg_sync();
  float off[4] = {0.f, 0.f, 0.f, 0.f}, total[4] = {0.f, 0.f, 0.f, 0.f};
#pragma unroll
  for (int q = 0; q < 16; ++q) {
    const float4 tv = *(const float4*)(tot + q * 128 + d0);
    total[0] += tv.x; total[1] += tv.y; total[2] += tv.z; total[3] += tv.w;
    if (q < rgp) { off[0] += tv.x; off[1] += tv.y; off[2] += tv.z; off[3] += tv.w; }
  }
  const float qscale = 0.08838834764831845f;
  const int dp = kperm(d0);
#pragma unroll
  for (int k = 0; k < 4; ++k) {
    const int r = 4 * rgp + k;
    const float qv[4] = {__uint_as_float(qraw[k].x << 16), __uint_as_float(qraw[k].x & 0xffff0000u), __uint_as_float(qraw[k].y << 16), __uint_as_float(qraw[k].y & 0xffff0000u)};
    const float kv[4] = {__uint_as_float(kraw[k].x << 16), __uint_as_float(kraw[k].x & 0xffff0000u), __uint_as_float(kraw[k].y << 16), __uint_as_float(kraw[k].y & 0xffff0000u)};
    float qt[4], kt[4], kh[4];
#pragma unroll
    for (int j = 0; j < 4; ++j) {
      const float bv = bb[k][j] + off[j];
      const float eb = __expf(bv);
      qt[j] = qv[j] * eb * qscale; kt[j] = kv[j] * __expf(-bv); kh[j] = kv[j] * __expf(total[j] - bv);
    }
    const unsigned q01 = cvtpk(qt[0], qt[1]), q23 = cvtpk(qt[2], qt[3]), k01 = cvtpk(kt[0], kt[1]), k23 = cvtpk(kt[2], kt[3]);
    *(uint2*)(qs + r * 136 + d0) = (uint2){q01, q23};
    *(uint2*)(ks + r * 136 + d0) = (uint2){k01, k23};
    st8_wt(QT + r * 128 + dp, q01, q23);
    st8_wt(KH + r * 128 + d0, cvtpk(kh[0], kh[1]), cvtpk(kh[2], kh[3]));
  }
  if (rgp == 0) {
    st8_wt(DEC + d0, __float_as_uint(__expf(total[0])), __float_as_uint(__expf(total[1])));
    st8_wt(DEC + d0 + 2, __float_as_uint(__expf(total[2])), __float_as_uint(__expf(total[3])));
  }
  wg_sync();
  {
    const int it = wid >> 1, jt0 = 2 * (wid & 1);
    f32x4 acc[2] = {(f32x4){0.f, 0.f, 0.f, 0.f}, (f32x4){0.f, 0.f, 0.f, 0.f}};
#pragma unroll
    for (int kk = 0; kk < 4; ++kk) {
      const bf16x8 qa = *(const bf16x8*)(qs + (16 * it + i) * 136 + 32 * kk + 8 * g);
#pragma unroll
      for (int n = 0; n < 2; ++n) {
        const bf16x8 kf = *(const bf16x8*)(ks + (16 * (jt0 + n) + i) * 136 + 32 * kk + 8 * g);
        acc[n] = __builtin_amdgcn_mfma_f32_16x16x32_bf16(kf, qa, acc[n], 0, 0, 0);
      }
    }
#pragma unroll
    for (int n = 0; n < 2; ++n) {
      const int ri = 16 * it + i, cj0 = 16 * (jt0 + n) + 4 * g;
      float v[4];
#pragma unroll
      for (int r = 0; r < 4; ++r) v[r] = (cj0 + r <= ri) ? acc[n][r] : 0.f;
      st8_wt(ATT + ri * 64 + kperm(cj0), cvtpk(v[0], v[1]), cvtpk(v[2], v[3]));
    }
  }
  asm volatile("s_waitcnt vmcnt(0)" ::: "memory");
  wg_sync();
  if (tid == 0) __hip_atomic_store((unsigned*)P.ws + CTL_GLA + 64 * item, 1u, __ATOMIC_RELAXED, __HIP_MEMORY_SCOPE_AGENT);
}
__device__ __forceinline__ void gla_wait_items(const Params& P, int first, int n, int tid) {
  if (tid < n) {
    unsigned* f = (unsigned*)P.ws + CTL_GLA + 64 * (first + tid);
    unsigned sp = 0;
    while (__hip_atomic_load(f, __ATOMIC_RELAXED, __HIP_MEMORY_SCOPE_AGENT) == 0u) { __builtin_amdgcn_s_sleep(2); if (++sp > (1u << 22)) break; }
  }
  wg_sync();
}
constexpr int GS_Q = 0, GS_K = 16384, GS_V = 32768, GS_A = 49152, GS_D = 57344, GS_BYTES = 57856;
__device__ __forceinline__ void gla_stage_dma(LAS unsigned char* st, const Params& P, int item, size_t rowbase, int h, int eh, int lane, int wid) {
  const bf16_t* QT = (const bf16_t*)(P.ws + WS_QT) + (size_t)item * 8192;
  const bf16_t* KH = (const bf16_t*)(P.ws + WS_KH) + (size_t)item * 8192;
  const bf16_t* ATT = (const bf16_t*)(P.ws + WS_ATT) + (size_t)item * 4096;
  const bf16_t* V = (const bf16_t*)(P.ws + WS_H) + rowbase * P1 + G_V + h * 256 + eh * 128;
#pragma unroll
  for (int n = 0; n < 2; ++n) {
    const int q = 2 * wid + n;
    { const int row = 4 * q + (lane >> 4), ch = (lane & 15) ^ (row & 15);
      __builtin_amdgcn_global_load_lds((const unsigned*)(QT + row * 128 + ch * 8), (LAS unsigned*)(st + GS_Q + q * 1024), 16, 0, 0); }
    { const int dt = q >> 1, j = 32 * (q & 1) + (lane >> 1);
      __builtin_amdgcn_global_load_lds((const unsigned*)(KH + j * 128 + dt * 16 + (lane & 1) * 8), (LAS unsigned*)(st + GS_K + q * 1024), 16, 0, 0);
      __builtin_amdgcn_global_load_lds((const unsigned*)(V + (unsigned)j * P1 + dt * 16 + (lane & 1) * 8), (LAS unsigned*)(st + GS_V + q * 1024), 16, 0, 0); }
  }
  { const int row = 8 * wid + (lane >> 3), ch = (lane & 7) ^ ((row >> 1) & 7);
    __builtin_amdgcn_global_load_lds((const unsigned*)(ATT + row * 64 + ch * 8), (LAS unsigned*)(st + GS_A + wid * 1024), 16, 0, 0); }
  if (wid < 2) __builtin_amdgcn_global_load_lds((const unsigned*)((const float*)(P.ws + WS_DEC) + (size_t)item * 128 + wid * 64 + lane), (LAS unsigned*)(st + GS_D + wid * 256), 4, 0, 0);
}
__device__ __forceinline__ void gla_chain(const Params& P, int chain, unsigned char* smem_g) {
  LAS unsigned char* lds = (LAS unsigned char*)smem_g;
  bf16_t* __restrict__ O = (bf16_t*)(P.ws + WS_XB);
  const int tid = otid(), lane = tid & 63, wid = __builtin_amdgcn_readfirstlane(tid >> 6), g = lane >> 4, i = lane & 15;
  const int eh = chain & 1, h = (chain >> 1) & 3, b = chain >> 3;
  const int item0 = (b * 4 + h) * 64;
  f32x4 S[8];
#pragma unroll
  for (int dt = 0; dt < 8; ++dt) S[dt] = (f32x4){0.f, 0.f, 0.f, 0.f};
  gla_wait_items(P, item0, 9, tid);
  gla_stage_dma(lds, P, item0, (size_t)b * S_, h, eh, lane, wid);
  wg_sync();
  for (int c = 0; c < 64; ++c) {
    if ((c & 7) == 0 && c > 0) gla_wait_items(P, item0 + c + 1, (64 - (c + 1)) < 8 ? (64 - (c + 1)) : 8, tid);
    if (c + 1 < 64) gla_stage_dma(lds + ((c + 1) & 1) * GS_BYTES, P, item0 + c + 1, (size_t)b * S_ + (c + 1) * 64, h, eh, lane, wid);
    LAS const unsigned char* st = lds + (c & 1) * GS_BYTES;
    f32x4 dc[8];
#pragma unroll
    for (int dt = 0; dt < 8; ++dt) dc[dt] = *(LAS const f32x4*)(st + GS_D + (16 * dt + 4 * g) * 4);
    u32x4 spk[4];
#pragma unroll
    for (int kk = 0; kk < 4; ++kk) {
      spk[kk][0] = cvtpk(S[2 * kk][0], S[2 * kk][1]); spk[kk][1] = cvtpk(S[2 * kk][2], S[2 * kk][3]);
      spk[kk][2] = cvtpk(S[2 * kk + 1][0], S[2 * kk + 1][1]); spk[kk][3] = cvtpk(S[2 * kk + 1][2], S[2 * kk + 1][3]);
    }
    bf16x8 vf[2];
    const unsigned trb = (unsigned)(unsigned long long)st + (4 * g + (i >> 2)) * 32 + (i & 3) * 8;
    {
      const unsigned vb = trb + GS_V + wid * 2048;
      const s16x4 v0 = vtra<0>(vb), v1 = vtra<512>(vb), v2 = vtra<1024>(vb), v3 = vtra<1536>(vb);
      LGKM0();
      vf[0] = (bf16x8){v0[0], v0[1], v0[2], v0[3], v1[0], v1[1], v1[2], v1[3]};
      vf[1] = (bf16x8){v2[0], v2[1], v2[2], v2[3], v3[0], v3[1], v3[2], v3[3]};
    }
#pragma unroll
    for (int it = 0; it < 4; ++it) {
      f32x4 acc = (f32x4){0.f, 0.f, 0.f, 0.f};
      LAS const unsigned char* qrow = st + GS_Q + (16 * it + i) * 256;
#pragma unroll
      for (int kk = 0; kk < 4; ++kk) {
        const bf16x8 a = *(LAS const bf16x8*)(qrow + (((4 * kk + g) ^ i) << 4));
        acc = __builtin_amdgcn_mfma_f32_16x16x32_bf16(a, __builtin_bit_cast(bf16x8, spk[kk]), acc, 0, 0, 0);
      }
      LAS const unsigned char* arow = st + GS_A + (16 * it + i) * 128;
#pragma unroll
      for (int k2 = 0; k2 < 2; ++k2) {
        const bf16x8 a = *(LAS const bf16x8*)(arow + (((4 * k2 + g) ^ ((i >> 1) & 7)) << 4));
        acc = __builtin_amdgcn_mfma_f32_16x16x32_bf16(a, vf[k2], acc, 0, 0, 0);
      }
      bf16_t* op = O + ((size_t)b * S_ + c * 64 + 16 * it + 4 * g) * D_ + h * 256 + eh * 128 + 16 * wid + i;
#pragma unroll
      for (int r = 0; r < 4; ++r) op[(size_t)r * D_] = f2bf(acc[r]);
    }
    __builtin_amdgcn_sched_barrier(0);
#define GL_KRD(dt, q0, q1, q2, q3) { q0 = vtra<GS_K + (dt) * 2048>(trb); q1 = vtra<GS_K + (dt) * 2048 + 512>(trb); q2 = vtra<GS_K + (dt) * 2048 + 1024>(trb); q3 = vtra<GS_K + (dt) * 2048 + 1536>(trb); }
#define GL_UPD(dt, q0, q1, q2, q3) { S[dt] = S[dt] * dc[dt]; \
      S[dt] = __builtin_amdgcn_mfma_f32_16x16x32_bf16((bf16x8){q0[0], q0[1], q0[2], q0[3], q1[0], q1[1], q1[2], q1[3]}, vf[0], S[dt], 0, 0, 0); \
      S[dt] = __builtin_amdgcn_mfma_f32_16x16x32_bf16((bf16x8){q2[0], q2[1], q2[2], q2[3], q3[0], q3[1], q3[2], q3[3]}, vf[1], S[dt], 0, 0, 0); }
    {
      s16x4 e0, e1, e2, e3, e4, e5, e6, e7, f0, f1, f2, f3, f4, f5, f6, f7;
      GL_KRD(0, e0, e1, e2, e3) GL_KRD(1, e4, e5, e6, e7)
      LGKM0();
      GL_KRD(2, f0, f1, f2, f3) GL_KRD(3, f4, f5, f6, f7)
      GL_UPD(0, e0, e1, e2, e3) GL_UPD(1, e4, e5, e6, e7)
      LGKM0();
      GL_KRD(4, e0, e1, e2, e3) GL_KRD(5, e4, e5, e6, e7)
      GL_UPD(2, f0, f1, f2, f3) GL_UPD(3, f4, f5, f6, f7)
      LGKM0();
      GL_KRD(6, f0, f1, f2, f3) GL_KRD(7, f4, f5, f6, f7)
      GL_UPD(4, e0, e1, e2, e3) GL_UPD(5, e4, e5, e6, e7)
      LGKM0();
      GL_UPD(6, f0, f1, f2, f3) GL_UPD(7, f4, f5, f6, f7)
    }
#undef GL_KRD
#undef GL_UPD
    wg_sync();
  }
}


constexpr int G4_Q = 0, G4_K = 16384, G4_V = 32768, G4_A = 40960, G4_D = 49152, G4_BYTES = 49664, G4_EXCH = 3 * G4_BYTES, G4_END = G4_EXCH + 8192;
__device__ __forceinline__ void gla4_stage_dma(LAS unsigned char* st, const Params& P, int item, size_t rowbase, int h, int eq, int lane, int wid) {
  const bf16_t* QT = (const bf16_t*)(P.ws + WS_QT) + (size_t)item * 8192;
  const bf16_t* KH = (const bf16_t*)(P.ws + WS_KH) + (size_t)item * 8192;
  const bf16_t* ATT = (const bf16_t*)(P.ws + WS_ATT) + (size_t)item * 4096;
  const bf16_t* V = (const bf16_t*)(P.ws + WS_H) + rowbase * P1 + G_V + h * 256 + eq * 64;
#pragma unroll
  for (int n = 0; n < 2; ++n) {
    const int q = 2 * wid + n;
    { const int row = 4 * q + (lane >> 4), ch = (lane & 15) ^ (row & 15);
      __builtin_amdgcn_global_load_lds((const unsigned*)(QT + row * 128 + ch * 8), (LAS unsigned*)(st + G4_Q + q * 1024), 16, 0, 0); }
    { const int dt = q >> 1, j = 32 * (q & 1) + (lane >> 1);
      __builtin_amdgcn_global_load_lds((const unsigned*)(KH + j * 128 + dt * 16 + (lane & 1) * 8), (LAS unsigned*)(st + G4_K + q * 1024), 16, 0, 0); }
  }
  { const int et = wid >> 1, j = 32 * (wid & 1) + (lane >> 1);
    __builtin_amdgcn_global_load_lds((const unsigned*)(V + (unsigned)j * P1 + et * 16 + (lane & 1) * 8), (LAS unsigned*)(st + G4_V + wid * 1024), 16, 0, 0); }
  { const int row = 8 * wid + (lane >> 3), ch = (lane & 7) ^ ((row >> 1) & 7);
    __builtin_amdgcn_global_load_lds((const unsigned*)(ATT + row * 64 + ch * 8), (LAS unsigned*)(st + G4_A + wid * 1024), 16, 0, 0); }
  __builtin_amdgcn_global_load_lds((const unsigned*)((const float*)(P.ws + WS_DEC) + (size_t)item * 128 + (wid & 1) * 64 + lane), (LAS unsigned*)(st + G4_D + (wid & 1) * 256), 4, 0, 0);
}
__device__ __forceinline__ void gla_chain64(const Params& P, int chain, int seg, unsigned char* smem_g) {
  LAS unsigned char* lds = (LAS unsigned char*)smem_g;
  bf16_t* __restrict__ O = (bf16_t*)(P.ws + WS_GO);
  const int tid = otid(), lane = tid & 63, wid = __builtin_amdgcn_readfirstlane(tid >> 6), g = lane >> 4, i = lane & 15;
  const int et = wid & 3, dh = wid >> 2;
  const int eq = chain & 3, h = (chain >> 2) & 3, b = chain >> 4;
  const int item0 = (b * 4 + h) * 64 + 32 * seg;
  const size_t row0 = (size_t)b * S_ + (size_t)seg * 32 * 64;
  f32x4 S[4];
#pragma unroll
  for (int t = 0; t < 4; ++t) S[t] = (f32x4){0.f, 0.f, 0.f, 0.f};
  f32x4 opend[2] = {(f32x4){0.f, 0.f, 0.f, 0.f}, (f32x4){0.f, 0.f, 0.f, 0.f}};
  gla_wait_items(P, item0, 10, tid);
  gla4_stage_dma(lds, P, item0, row0, h, eq, lane, wid);
  gla4_stage_dma(lds + G4_BYTES, P, item0 + 1, row0 + 64, h, eq, lane, wid);
  for (int c = 0; c < 32; ++c) {
    if ((c & 7) == 0 && c > 0 && c + 2 < 32) gla_wait_items(P, item0 + c + 2, (32 - (c + 2)) < 8 ? (32 - (c + 2)) : 8, tid);
    if (c + 1 < 32) asm volatile("s_waitcnt vmcnt(7)" ::: "memory"); else asm volatile("s_waitcnt vmcnt(0)" ::: "memory");
    __builtin_amdgcn_s_barrier();
    asm volatile("" ::: "memory");
    if (c > 0) {
#pragma unroll
      for (int q = 0; q < 2; ++q) { bf16_t* op = O + (row0 + (c - 1) * 64 + 16 * (2 * dh + q) + 4 * g) * D_ + h * 256 + eq * 64 + 16 * et + i;
#pragma unroll
        for (int r = 0; r < 4; ++r) op[(size_t)r * D_] = f2bf(opend[q][r]); }
    }
    if (c + 2 < 32) gla4_stage_dma(lds + ((c + 2) % 3) * G4_BYTES, P, item0 + c + 2, row0 + (c + 2) * 64, h, eq, lane, wid);
    LAS const unsigned char* st = lds + (c % 3) * G4_BYTES;
    f32x4 dc[4];
#pragma unroll
    for (int t = 0; t < 4; ++t) dc[t] = *(LAS const f32x4*)(st + G4_D + (16 * (4 * dh + t) + 4 * g) * 4);
    bf16x8 qa[4][2], aa[2][2];
#pragma unroll
    for (int it = 0; it < 4; ++it)
#pragma unroll
      for (int q = 0; q < 2; ++q) qa[it][q] = *(LAS const bf16x8*)(st + G4_Q + (16 * it + i) * 256 + (((4 * (2 * dh + q) + g) ^ i) << 4));
#pragma unroll
    for (int q = 0; q < 2; ++q)
#pragma unroll
      for (int k2 = 0; k2 < 2; ++k2) aa[q][k2] = *(LAS const bf16x8*)(st + G4_A + (16 * (2 * dh + q) + i) * 128 + (((4 * k2 + g) ^ ((i >> 1) & 7)) << 4));
    const unsigned trb = (unsigned)(unsigned long long)st + (4 * g + (i >> 2)) * 32 + (i & 3) * 8;
    const unsigned vb = trb + G4_V + et * 2048, kb = trb + G4_K + (4 * dh) * 2048;
    const s16x4 v0 = vtra<0>(vb), v1 = vtra<512>(vb), v2 = vtra<1024>(vb), v3 = vtra<1536>(vb);
    s16x4 kq[4][4];
#define G4_KRD(t) { kq[t][0] = vtra<(t) * 2048>(kb); kq[t][1] = vtra<(t) * 2048 + 512>(kb); kq[t][2] = vtra<(t) * 2048 + 1024>(kb); kq[t][3] = vtra<(t) * 2048 + 1536>(kb); }
    G4_KRD(0) G4_KRD(1) G4_KRD(2) G4_KRD(3)
#undef G4_KRD
    u32x4 spk[2];
#pragma unroll
    for (int q = 0; q < 2; ++q) {
      spk[q][0] = cvtpk(S[2 * q][0], S[2 * q][1]); spk[q][1] = cvtpk(S[2 * q][2], S[2 * q][3]);
      spk[q][2] = cvtpk(S[2 * q + 1][0], S[2 * q + 1][1]); spk[q][3] = cvtpk(S[2 * q + 1][2], S[2 * q + 1][3]);
    }
    LGKM0();
    bf16x8 vf[2];
    vf[0] = (bf16x8){v0[0], v0[1], v0[2], v0[3], v1[0], v1[1], v1[2], v1[3]};
    vf[1] = (bf16x8){v2[0], v2[1], v2[2], v2[3], v3[0], v3[1], v3[2], v3[3]};
    f32x4 acc[4];
#pragma unroll
    for (int it = 0; it < 4; ++it) {
      acc[it] = (f32x4){0.f, 0.f, 0.f, 0.f};
      if (it >> 1 == dh) {
#pragma unroll
        for (int k2 = 0; k2 < 2; ++k2) acc[it] = __builtin_amdgcn_mfma_f32_16x16x32_bf16(aa[it & 1][k2], vf[k2], acc[it], 0, 0, 0);
      }
#pragma unroll
      for (int q = 0; q < 2; ++q) acc[it] = __builtin_amdgcn_mfma_f32_16x16x32_bf16(qa[it][q], __builtin_bit_cast(bf16x8, spk[q]), acc[it], 0, 0, 0);
    }
#pragma unroll
    for (int t = 0; t < 4; ++t) {
      S[t] = S[t] * dc[t];
      S[t] = __builtin_amdgcn_mfma_f32_16x16x32_bf16((bf16x8){kq[t][0][0], kq[t][0][1], kq[t][0][2], kq[t][0][3], kq[t][1][0], kq[t][1][1], kq[t][1][2], kq[t][1][3]}, vf[0], S[t], 0, 0, 0);
      S[t] = __builtin_amdgcn_mfma_f32_16x16x32_bf16((bf16x8){kq[t][2][0], kq[t][2][1], kq[t][2][2], kq[t][2][3], kq[t][3][0], kq[t][3][1], kq[t][3][2], kq[t][3][3]}, vf[1], S[t], 0, 0, 0);
    }
    {
      LAS u32x2* ex = (LAS u32x2*)(lds + G4_EXCH) + (wid * 2) * 64 + lane;
#pragma unroll
      for (int q = 0; q < 2; ++q) { const f32x4 v = dh == 0 ? acc[2 + q] : acc[q]; ex[q * 64] = (u32x2){cvtpk(v[0], v[1]), cvtpk(v[2], v[3])}; }
    }
    asm volatile("s_waitcnt lgkmcnt(0)" ::: "memory");
    __builtin_amdgcn_s_barrier();
    asm volatile("" ::: "memory");
    {
      LAS const u32x2* ex = (LAS const u32x2*)(lds + G4_EXCH) + ((wid ^ 4) * 2) * 64 + lane;
#pragma unroll
      for (int q = 0; q < 2; ++q) {
        const u32x2 pv = ex[q * 64];
        f32x4 mine = dh == 0 ? acc[q] : acc[2 + q];
        mine[0] += __uint_as_float(pv.x << 16); mine[1] += __uint_as_float(pv.x & 0xffff0000u); mine[2] += __uint_as_float(pv.y << 16); mine[3] += __uint_as_float(pv.y & 0xffff0000u);
        opend[q] = mine;
      }
    }
  }
#pragma unroll
  for (int q = 0; q < 2; ++q) { bf16_t* op = O + (row0 + 31 * 64 + 16 * (2 * dh + q) + 4 * g) * D_ + h * 256 + eq * 64 + 16 * et + i;
#pragma unroll
    for (int r = 0; r < 4; ++r) op[(size_t)r * D_] = f2bf(opend[q][r]); }
  if (seg == 0) {
    bf16_t* smt = (bf16_t*)(P.ws + WS_SMT) + ((size_t)(b * 4 + h) * 256 + eq * 64 + 16 * et + i) * 128;
#pragma unroll
    for (int t = 0; t < 4; ++t) { const int T = 4 * dh + t, p0 = 32 * (T >> 1) + 8 * g + 4 * (T & 1);
      *(u32x2*)(smt + p0) = (u32x2){cvtpk(S[t][0], S[t][1]), cvtpk(S[t][2], S[t][3])}; }
  }
  __builtin_amdgcn_s_barrier();
}

__device__ __forceinline__ void gla_norm_phase(const Params& P) {
  const bf16_t* H1 = (const bf16_t*)(P.ws + WS_H);
  const bf16_t* O = (const bf16_t*)(P.ws + WS_XB);
  bf16_t* MIX = (bf16_t*)(P.ws + WS_MIX);
  const float* gn = P.in[12];
  const int lane = otid() & 63, wid = otid() >> 6;
  for (int it = blockIdx.x * 8 + wid; it < M_ * 4; it += gridDim.x * 8) {
    const int h = it & 3; const size_t row = it >> 2;
    float v[4]; float ss = 0.f;
#pragma unroll
    for (int k = 0; k < 4; ++k) { v[k] = bf2f(O[row * D_ + h * 256 + k * 64 + lane]); ss += v[k] * v[k]; }
    const float r = 1.f / sqrtf(wave_sum(ss) * (1.f / 256.f) + LN_EPS);
#pragma unroll
    for (int k = 0; k < 4; ++k) {
      const int c = h * 256 + k * 64 + lane;
      const float z = bf2f(H1[row * P1 + G_Z + c]);
      MIX[row * D_ + c] = f2bf(v[k] * r * gn[c] * silu_f(z));
    }
  }
}


constexpr int RG_RED = 131072;
__device__ __forceinline__ size_t wfrag_off(int n, int k) { return ((size_t)(((n >> 4) * 32 + (k >> 5)) * 64 + ((k >> 3) & 3) * 16 + (n & 15))) * 8 + (k & 7); }
template <int AMODE  , bool GLR  ,
          bool RES32 = false  >
__device__ __forceinline__ void rowgemm_block(const Params& P, int rb, const bf16_t* __restrict__ Wf, const float* base, float* out, bf16_t* outb,
                                              const float* __restrict__ gam, const float* __restrict__ bet, unsigned char* smem_g) {
  LAS unsigned char* lds = (LAS unsigned char*)smem_g;
  const int tid = otid(), lane = tid & 63, wid = __builtin_amdgcn_readfirstlane(tid >> 6), g = lane >> 4, i = lane & 15;
  const size_t r0 = (size_t)rb * 64;
  if (AMODE == 0) {
    const bf16_t* A = (const bf16_t*)(P.ws + WS_MIX) + r0 * D_;
#pragma unroll
    for (int q0 = 0; q0 < 16; ++q0) {
      const int q = wid * 16 + q0, row = q >> 1, ch = ((q & 1) * 64 + lane) ^ (row & 15);
      __builtin_amdgcn_global_load_lds((const unsigned*)(A + (size_t)row * D_ + ch * 8), (LAS unsigned*)(lds + q * 1024), 16, 0, 0);
    }
  } else {
    const bf16_t* __restrict__ O = (const bf16_t*)(P.ws + WS_GO) + r0 * D_;
    const bf16_t* __restrict__ H1 = (const bf16_t*)(P.ws + WS_H) + r0 * P1 + G_Z;
    const float* __restrict__ gn = P.in[12];
    const int row = tid >> 3;
#define PN_ROW(c) (8 * wid + ((c) >> 1))
#define PN_CH(c) ((((c) & 1) << 6) + lane)
    u32x4 ov[16];
#pragma unroll
    for (int c = 0; c < 16; ++c) ov[c] = *(const u32x4*)(O + (size_t)PN_ROW(c) * D_ + PN_CH(c) * 8);
    const int bb = rb >> 6, cc = rb & 63;
    if (cc >= 32) {
      LAS float* PP = (LAS float*)(lds + RG_RED);
      LAS unsigned char* QP = lds + RG_RED + 4096;
      {
        const int hh = tid >> 7, pp = tid & 127, dd = (pp & ~31) + 16 * ((pp >> 2) & 1) + 4 * ((pp >> 3) & 3) + (pp & 3);
        const float* dec = (const float*)(P.ws + WS_DEC) + (size_t)((bb * 4 + hh) * 64) * 128 + dd;
        float dv[32];
#pragma unroll
        for (int c2 = 0; c2 < 32; ++c2) dv[c2] = (32 + c2 < cc) ? dec[(size_t)(32 + c2) * 128] : 1.f;
#pragma unroll
        for (int st = 16; st >= 1; st >>= 1)
#pragma unroll
          for (int c2 = 0; c2 < st; ++c2) dv[c2] *= dv[c2 + st];
        PP[hh * 128 + pp] = dv[0];
      }
      const int p0 = (tid & 7) * 16;
      u32x4 qpre[4][2];
#pragma unroll
      for (int hh = 0; hh < 4; ++hh) {
        const bf16_t* qsrc = (const bf16_t*)(P.ws + WS_QT) + (size_t)((bb * 4 + hh) * 64 + cc) * 8192 + row * 128 + p0;
        qpre[hh][0] = *(const u32x4*)qsrc; qpre[hh][1] = *(const u32x4*)(qsrc + 8);
      }
      bf16x8 afn[2][4];
      {
        const bf16_t* smt = (const bf16_t*)(P.ws + WS_SMT) + ((size_t)(bb * 4) * 256 + 32 * wid + i) * 128 + 8 * g;
#pragma unroll
        for (int q = 0; q < 2; ++q)
#pragma unroll
          for (int kk = 0; kk < 4; ++kk) afn[q][kk] = *(const bf16x8*)(smt + (size_t)q * 16 * 128 + 32 * kk);
      }
      wg_sync();
#pragma unroll
      for (int hh = 0; hh < 4; ++hh) {
        {
          const u32x4 q0 = qpre[hh][0], q1 = qpre[hh][1];
          LAS const float* PPh = PP + hh * 128;
          u32x4 w0, w1;
#pragma unroll
          for (int e = 0; e < 4; ++e) {
            w0[e] = cvtpk(__uint_as_float(q0[e] << 16) * PPh[p0 + 2 * e], __uint_as_float(q0[e] & 0xffff0000u) * PPh[p0 + 2 * e + 1]);
            w1[e] = cvtpk(__uint_as_float(q1[e] << 16) * PPh[p0 + 8 + 2 * e], __uint_as_float(q1[e] & 0xffff0000u) * PPh[p0 + 8 + 2 * e + 1]);
          }
          *(LAS u32x4*)(QP + row * 272 + p0 * 2) = w0; *(LAS u32x4*)(QP + row * 272 + p0 * 2 + 16) = w1;
        }
        bf16x8 af[2][4];
#pragma unroll
        for (int q = 0; q < 2; ++q)
#pragma unroll
          for (int kk = 0; kk < 4; ++kk) af[q][kk] = afn[q][kk];
        if (hh < 3) {
          const bf16_t* smt = (const bf16_t*)(P.ws + WS_SMT) + ((size_t)(bb * 4 + hh + 1) * 256 + 32 * wid + i) * 128 + 8 * g;
#pragma unroll
          for (int q = 0; q < 2; ++q)
#pragma unroll
            for (int kk = 0; kk < 4; ++kk) afn[q][kk] = *(const bf16x8*)(smt + (size_t)q * 16 * 128 + 32 * kk);
        }
        wg_sync();
        {
#pragma unroll 1
          for (int mm = 0; mm < 4; ++mm) {
            bf16x8 bfm[4];
#pragma unroll
            for (int kk = 0; kk < 4; ++kk) bfm[kk] = *(LAS const bf16x8*)(QP + (16 * mm + i) * 272 + (32 * kk + 8 * g) * 2);
#pragma unroll
            for (int q = 0; q < 2; ++q) {
              f32x4 ca = (f32x4){0.f, 0.f, 0.f, 0.f};
#pragma unroll
              for (int kk = 0; kk < 4; ++kk) ca = __builtin_amdgcn_mfma_f32_16x16x32_bf16(af[q][kk], bfm[kk], ca, 0, 0, 0);
              { const int crow = 16 * mm + i, ccol = hh * 256 + 32 * wid + 16 * q + 4 * g;
                *(LAS u32x2*)(lds + crow * 2048 + (((ccol >> 3) ^ (crow & 15)) << 4) + ((ccol >> 2) & 1) * 8) = (u32x2){cvtpk(ca[0], ca[1]), cvtpk(ca[2], ca[3])}; }
            }
          }
        }
        wg_sync();
      }
#pragma unroll
      for (int c = 0; c < 16; ++c) {
        const u32x4 cr = *(LAS const u32x4*)(lds + PN_ROW(c) * 2048 + ((PN_CH(c) ^ (PN_ROW(c) & 15)) << 4));
#pragma unroll
        for (int e = 0; e < 4; ++e)
          ov[c][e] = cvtpk(__uint_as_float(ov[c][e] << 16) + __uint_as_float(cr[e] << 16), __uint_as_float(ov[c][e] & 0xffff0000u) + __uint_as_float(cr[e] & 0xffff0000u));
      }
      wg_sync();
    }
#pragma unroll
    for (int c0 = 0; c0 < 16; c0 += 4) {
      asm volatile("" ::: "memory");
      u32x4 zv[4]; f32x4 g0[4], g1[4];
#pragma unroll
      for (int u = 0; u < 4; ++u) { const int c = c0 + u, col = PN_CH(c) * 8;
        zv[u] = *(const u32x4*)(H1 + (size_t)PN_ROW(c) * P1 + col); g0[u] = *(const f32x4*)(gn + col); g1[u] = *(const f32x4*)(gn + col + 4); }
#pragma unroll
      for (int u = 0; u < 4; ++u) {
        const int c = c0 + u;
        float ss = 0.f;
#pragma unroll
        for (int e = 0; e < 4; ++e) { const float lo = __uint_as_float(ov[c][e] << 16), hi = __uint_as_float(ov[c][e] & 0xffff0000u); ss += lo * lo + hi * hi; }
        ss = xsum<1>(ss); ss = xsum<2>(ss); ss = xsum<4>(ss); ss = xsum<8>(ss); ss = xsum<16>(ss);
        const float rinv = 1.f / sqrtf(ss * (1.f / 256.f) + LN_EPS);
        const int prow = PN_ROW(c), ch = PN_CH(c);
        const float gg[8] = {g0[u][0], g0[u][1], g0[u][2], g0[u][3], g1[u][0], g1[u][1], g1[u][2], g1[u][3]};
        u32x4 w;
#pragma unroll
        for (int e = 0; e < 4; ++e) {
          const float o0 = __uint_as_float(ov[c][e] << 16), o1 = __uint_as_float(ov[c][e] & 0xffff0000u);
          const float z0 = __uint_as_float(zv[u][e] << 16), z1 = __uint_as_float(zv[u][e] & 0xffff0000u);
          w[e] = cvtpk(o0 * rinv * gg[2 * e] * silu_f(z0), o1 * rinv * gg[2 * e + 1] * silu_f(z1));
        }
        *(LAS u32x4*)(lds + prow * 2048 + ((ch ^ (prow & 15)) << 4)) = w;
      }
    }
#undef PN_ROW
#undef PN_CH
  }
  wg_sync();
  f32x4 acc[4][8];
#pragma unroll
  for (int m = 0; m < 4; ++m)
#pragma unroll
    for (int nt = 0; nt < 8; ++nt) acc[m][nt] = (f32x4){0.f, 0.f, 0.f, 0.f};
  const bf16_t* wp = Wf + ((size_t)(wid * 8) * 32 * 64 + lane) * 8;
  bf16x8 wf[2][8];
#pragma unroll
  for (int nt = 0; nt < 8; ++nt) wf[0][nt] = *(const bf16x8*)(wp + (size_t)(nt * 32) * 512);
#pragma unroll 1
  for (int ks = 0; ks < 32; ks += 2) {
#pragma unroll
    for (int hf = 0; hf < 2; ++hf) {
      const int kc = ks + hf;
      if (kc + 1 < 32) {
#pragma unroll
        for (int nt = 0; nt < 8; ++nt) wf[hf ^ 1][nt] = *(const bf16x8*)(wp + (size_t)(nt * 32 + kc + 1) * 512);
      }
      bf16x8 xf[4];
#pragma unroll
      for (int m = 0; m < 4; ++m) xf[m] = *(LAS const bf16x8*)(lds + (16 * m + i) * 2048 + (((4 * kc + g) ^ i) << 4));
#pragma unroll
      for (int m = 0; m < 4; ++m)
#pragma unroll
        for (int nt = 0; nt < 8; ++nt) acc[m][nt] = __builtin_amdgcn_mfma_f32_16x16x32_bf16(wf[hf][nt], xf[m], acc[m][nt], 0, 0, 0);
    }
  }
  LAS float* red = (LAS float*)(lds + RG_RED);
  {
  const int tid = otid(), lane = tid & 63, wid = __builtin_amdgcn_readfirstlane(tid >> 6), g = lane >> 4, i = lane & 15; (void)lane;
  f32x4 bvf[2][8]; u32x4 bvq[2][4];
#define RG_LOADB(slot, mm) { \
    if (RES32) { const float* bp = base + (r0 + 16 * (mm) + i) * D_ + wid * 128 + 4 * g; \
      _Pragma("unroll") for (int nt = 0; nt < 8; ++nt) bvf[slot][nt] = __builtin_nontemporal_load((const f32x4*)(bp + 16 * nt)); } \
    else { const bf16_t* bp = (const bf16_t*)base + (r0 + 16 * (mm) + i) * D_ + wid * 128 + 16 * (g & 1) + 4 * (g & ~1); \
      _Pragma("unroll") for (int np = 0; np < 4; ++np) bvq[slot][np] = *(const u32x4*)(bp + 32 * np); } }
  RG_LOADB(0, 0)
#pragma unroll
  for (int m = 0; m < 4; ++m) {
    if (m + 1 < 4) RG_LOADB((m + 1) & 1, m + 1)
    f32x4 bv[8];
#pragma unroll
    for (int nt = 0; nt < 8; ++nt) if (RES32) bv[nt] = bvf[m & 1][nt];
    if (!RES32) {
      const bool odd = (g & 1) != 0;
#pragma unroll
      for (int np = 0; np < 4; ++np) {
        const u32x4 ld = bvq[m & 1][np];
        const unsigned s0 = odd ? ld[0] : ld[2], s1 = odd ? ld[1] : ld[3];
        const unsigned c0 = (unsigned)__builtin_amdgcn_ds_swizzle((int)s0, (16 << 10) | 0x1f), c1 = (unsigned)__builtin_amdgcn_ds_swizzle((int)s1, (16 << 10) | 0x1f);
        const unsigned e0 = odd ? c0 : ld[0], e1 = odd ? c1 : ld[1];
        const unsigned o0 = odd ? ld[2] : c0, o1 = odd ? ld[3] : c1;
        bv[2 * np] = (f32x4){__uint_as_float(e0 << 16), __uint_as_float(e0 & 0xffff0000u), __uint_as_float(e1 << 16), __uint_as_float(e1 & 0xffff0000u)};
        bv[2 * np + 1] = (f32x4){__uint_as_float(o0 << 16), __uint_as_float(o0 & 0xffff0000u), __uint_as_float(o1 << 16), __uint_as_float(o1 & 0xffff0000u)};
      }
    }
    float s1 = 0.f, s2 = 0.f;
#pragma unroll
    for (int nt = 0; nt < 8; ++nt) { const f32x4 v = acc[m][nt] + bv[nt] * ALPHA; acc[m][nt] = v; s1 += (v[0] + v[1]) + (v[2] + v[3]); s2 += (v[0] * v[0] + v[1] * v[1]) + (v[2] * v[2] + v[3] * v[3]); }
    s1 = xsum<16>(s1); s1 = xsum<32>(s1); s2 = xsum<16>(s2); s2 = xsum<32>(s2);
    if (g == 0) { red[((16 * m + i) * 8 + wid) * 2] = s1; red[((16 * m + i) * 8 + wid) * 2 + 1] = s2; }
  }
#undef RG_LOADB
  wg_sync();
#pragma unroll
  for (int m = 0; m < 4; ++m) {
    float s1 = 0.f, s2 = 0.f;
#pragma unroll
    for (int w2 = 0; w2 < 8; ++w2) { s1 += red[((16 * m + i) * 8 + w2) * 2]; s2 += red[((16 * m + i) * 8 + w2) * 2 + 1]; }
    const float mean = s1 * (1.f / D_);
    const float var = fmaxf(s2 * (1.f / D_) - mean * mean, 0.f);
    const float rstd = 1.f / sqrtf(var + LN_EPS);
    const size_t off = (r0 + 16 * m + i) * D_ + wid * 128 + 4 * g;
#pragma unroll
    for (int np = 0; np < 4; ++np) {
      u32x2 wab[2];
#pragma unroll
      for (int q = 0; q < 2; ++q) {
        const int nt = 2 * np + q;
        const f32x4 gvv = *(const f32x4*)(gam + wid * 128 + 16 * nt + 4 * g), tvv = *(const f32x4*)(bet + wid * 128 + 16 * nt + 4 * g);
        const f32x4 av = m == 0 ? acc[0][nt] : (m == 1 ? acc[1][nt] : (m == 2 ? acc[2][nt] : acc[3][nt]));
        const f32x4 o = (av - mean) * rstd * gvv + tvv;
        if (AMODE == 1) __builtin_nontemporal_store(o, (f32x4*)(out + off + 16 * nt));
        u32x2 w; w[0] = cvtpk(o[0], o[1]); w[1] = cvtpk(o[2], o[3]);
        wab[q] = w;
        if (GLR) { const int row = 16 * m + i, chunk = 16 * wid + 2 * nt + (g >> 1);
          *(LAS u32x2*)(lds + row * 2048 + ((chunk ^ (row & 15)) << 4) + (g & 1) * 8) = w; }
      }
      if (AMODE == 0) {
        const bool odd = (g & 1) != 0;
        const u32x2 snd = odd ? wab[0] : wab[1];
        u32x2 rcv; rcv[0] = (unsigned)__builtin_amdgcn_ds_swizzle((int)snd[0], (16 << 10) | 0x1f); rcv[1] = (unsigned)__builtin_amdgcn_ds_swizzle((int)snd[1], (16 << 10) | 0x1f);
        const u32x4 w16 = odd ? (u32x4){rcv[0], rcv[1], wab[1][0], wab[1][1]} : (u32x4){wab[0][0], wab[0][1], rcv[0], rcv[1]};
        *(u32x4*)(outb + (off - 4 * g) + 16 * (2 * np + (odd ? 1 : 0)) + 4 * (g & ~1)) = w16;
      }
    }
  }
  if (GLR) {
    wg_sync();
    const bf16_t* wg = (const bf16_t*)(P.ws + WS_WT1) + (size_t)(3072 + i) * D_ + 8 * g;
    const int mt = wid & 3, kh = wid >> 2;
    f32x4 a2 = (f32x4){0.f, 0.f, 0.f, 0.f};
#pragma unroll 4
    for (int q = 0; q < 16; ++q) {
      const int kc = kh * 16 + q;
      const bf16x8 wfr = *(const bf16x8*)(wg + 32 * kc);
      const bf16x8 xfr = *(LAS const bf16x8*)(lds + (16 * mt + i) * 2048 + (((4 * kc + g) ^ i) << 4));
      a2 = __builtin_amdgcn_mfma_f32_16x16x32_bf16(wfr, xfr, a2, 0, 0, 0);
    }
    LAS f32x4* r2 = (LAS f32x4*)(lds + RG_RED + 4096);
    if (kh == 1) r2[mt * 64 + lane] = a2;
    wg_sync();
    if (kh == 0) {
      const f32x4 tot = a2 + r2[mt * 64 + lane];
      *(f32x4*)((float*)(P.ws + WS_GLR) + (r0 + 16 * mt + i) * 16 + 4 * g) = tot;
    }
  }
  }
  wg_sync();
}

#define XB_TMO      128
#define XB_XCNT(j)  (256  + 64 * (j))
#define XB_XSUB(j)  (1280 + 64 * (j))
#define XB_XGEN(j)  (2304 + 64 * (j))
#define XB_TOP      3328
#define XB_TOPGEN   3392
#define XCD_BAR_WORDS 3456
#define XB_SPIN_CAP (1u << 18)

__device__ __forceinline__ unsigned xb_ld(unsigned* p)              { return __hip_atomic_load(p, __ATOMIC_RELAXED, __HIP_MEMORY_SCOPE_AGENT); }
__device__ __forceinline__ unsigned xb_add(unsigned* p, unsigned v) { return __hip_atomic_fetch_add(p, v, __ATOMIC_RELAXED, __HIP_MEMORY_SCOPE_AGENT); }
__device__ __forceinline__ unsigned xb_xcc_id() { return (unsigned)__builtin_amdgcn_s_getreg((3 << 11) | 20) & 0xFu; }
#define XB_SPIN(cond, bar) do { unsigned _sp = 0; while (cond) { __builtin_amdgcn_s_sleep(1); \
    if ((++_sp & 255u) == 0u) { if (xb_ld(&(bar)[XB_TMO])) break; if (_sp > XB_SPIN_CAP) { (void)__hip_atomic_fetch_add(&(bar)[XB_TMO], 1u, __ATOMIC_RELAXED, __HIP_MEMORY_SCOPE_AGENT); break; } } } } while (0)

struct XcdBarrier {
    unsigned* bar; unsigned x;
    volatile LAS unsigned* st;
};

__device__ __forceinline__ XcdBarrier xcd_barrier_post(unsigned* bar, volatile LAS unsigned* st) {
    XcdBarrier b; b.bar = bar; b.x = xb_xcc_id(); b.st = st;
    if (threadIdx.x == 0) (void)xb_add(&bar[XB_XCNT(b.x)], 1u);
    return b;
}
__device__ __forceinline__ void xcd_barrier_complete(unsigned* bar, unsigned x, unsigned& nloc, unsigned& nx) {
    const unsigned G = gridDim.x * gridDim.y * gridDim.z;
    unsigned sum, cnt, mine, sp = 0u;
    for (;;) {
        sum = 0u; cnt = 0u; mine = 0u;
#pragma unroll
        for (unsigned j = 0; j < 16; ++j) { const unsigned c = xb_ld(&bar[XB_XCNT(j)]); sum += c; cnt += (c > 0u) ? 1u : 0u; mine = (j == x) ? c : mine; }
        if (sum == G) break;
        __builtin_amdgcn_s_sleep(1);
        if ((++sp & 255u) == 0u) { if (xb_ld(&bar[XB_TMO])) break; if (sp > XB_SPIN_CAP) { (void)__hip_atomic_fetch_add(&bar[XB_TMO], 1u, __ATOMIC_RELAXED, __HIP_MEMORY_SCOPE_AGENT); break; } }
    }
    nloc = mine > 0u ? mine : 1u; nx = cnt > 0u ? cnt : 1u;
}

__device__ __forceinline__ void xcd_barrier(const XcdBarrier& b) {
    asm volatile("s_waitcnt vmcnt(0)" ::: "memory");
    wg_sync();
    if (threadIdx.x == 0) {
        unsigned* bar = b.bar;
        __builtin_amdgcn_s_waitcnt(0);
        unsigned nloc = b.st[0], nx = b.st[1];
        if (nloc == 0u) { xcd_barrier_complete(bar, b.x, nloc, nx); b.st[0] = nloc; b.st[1] = nx; }
        const unsigned old = xb_add(&bar[XB_XSUB(b.x)], 1u);
        const unsigned gen = old / nloc;
        if (old + 1u == (gen + 1u) * nloc) {
            __builtin_amdgcn_fence(__ATOMIC_RELEASE, "agent");
            asm volatile("s_waitcnt vmcnt(0)" ::: "memory");
            const unsigned og = xb_add(&bar[XB_TOP], 1u);
            const unsigned tg = og / nx;
            if (og + 1u == (tg + 1u) * nx) xb_add(&bar[XB_TOPGEN], 1u);
            else XB_SPIN(xb_ld(&bar[XB_TOPGEN]) == tg, bar);
            __builtin_amdgcn_fence(__ATOMIC_ACQUIRE, "agent");
            xb_add(&bar[XB_XGEN(b.x)], 1u);
            asm volatile("s_waitcnt vmcnt(0)" ::: "memory");
        } else {
            XB_SPIN(xb_ld(&bar[XB_XGEN(b.x)]) == gen, bar);
            __builtin_amdgcn_fence(__ATOMIC_ACQUIRE, "agent");
            asm volatile("s_waitcnt vmcnt(0)" ::: "memory");
        }
    }
    wg_sync();
}


__device__ const unsigned short p3_order[1024] = {15,143,271,399,14,142,270,398,13,141,269,397,12,140,268,396,11,139,267,395,10,138,266,394,9,137,265,393,8,136,264,392,560,562,564,566,568,570,572,574,624,626,628,630,632,634,636,638,7,135,263,391,544,546,548,550,552,554,556,558,608,610,612,614,616,618,620,622,528,530,532,534,536,538,540,542,592,594,596,598,600,602,604,606,6,134,262,390,5,133,261,389,526,590,524,588,4,132,260,388,522,586,520,584,3,131,259,387,518,582,2,130,258,386,516,580,1,129,257,385,514,578,0,128,256,384,512,576,31,159,287,415,30,158,286,414,29,157,285,413,28,156,284,412,27,155,283,411,26,154,282,410,25,153,281,409,24,152,280,408,561,563,565,567,569,571,573,575,625,627,629,631,633,635,637,639,23,151,279,407,545,547,549,551,553,555,557,559,609,611,613,615,617,619,621,623,529,531,533,535,537,539,541,543,593,595,597,599,601,603,605,607,22,150,278,406,527,591,21,149,277,405,525,589,523,587,20,148,276,404,521,585,519,583,19,147,275,403,517,581,18,146,274,402,515,579,17,145,273,401,513,577,16,144,272,400,47,175,303,431,46,174,302,430,45,173,301,429,44,172,300,428,43,171,299,427,42,170,298,426,41,169,297,425,40,168,296,424,688,690,692,694,696,698,700,702,752,754,756,758,760,762,764,766,39,167,295,423,672,674,676,678,680,682,684,686,736,738,740,742,744,746,748,750,656,658,660,662,664,666,668,670,720,722,724,726,728,730,732,734,38,166,294,422,37,165,293,421,654,718,652,716,36,164,292,420,650,714,648,712,35,163,291,419,646,710,34,162,290,418,644,708,33,161,289,417,642,706,32,160,288,416,640,704,63,191,319,447,62,190,318,446,61,189,317,445,60,188,316,444,59,187,315,443,58,186,314,442,57,185,313,441,56,184,312,440,689,691,693,695,697,699,701,703,753,755,757,759,761,763,765,767,55,183,311,439,673,675,677,679,681,683,685,687,737,739,741,743,745,747,749,751,657,659,661,663,665,667,669,671,721,723,725,727,729,731,733,735,54,182,310,438,655,719,53,181,309,437,653,717,651,715,52,180,308,436,649,713,647,711,51,179,307,435,645,709,50,178,306,434,643,707,49,177,305,433,641,705,48,176,304,432,79,207,335,463,78,206,334,462,77,205,333,461,76,204,332,460,75,203,331,459,74,202,330,458,73,201,329,457,72,200,328,456,816,818,820,822,824,826,828,830,880,882,884,886,888,890,892,894,71,199,327,455,800,802,804,806,808,810,812,814,864,866,868,870,872,874,876,878,784,786,788,790,792,794,796,798,848,850,852,854,856,858,860,862,70,198,326,454,69,197,325,453,782,846,780,844,68,196,324,452,778,842,776,840,67,195,323,451,774,838,66,194,322,450,772,836,65,193,321,449,770,834,64,192,320,448,768,832,95,223,351,479,94,222,350,478,93,221,349,477,92,220,348,476,91,219,347,475,90,218,346,474,89,217,345,473,88,216,344,472,817,819,821,823,825,827,829,831,881,883,885,887,889,891,893,895,87,215,343,471,801,803,805,807,809,811,813,815,865,867,869,871,873,875,877,879,785,787,789,791,793,795,797,799,849,851,853,855,857,859,861,863,86,214,342,470,783,847,85,213,341,469,781,845,779,843,84,212,340,468,777,841,775,839,83,211,339,467,773,837,82,210,338,466,771,835,81,209,337,465,769,833,80,208,336,464,111,239,367,495,110,238,366,494,109,237,365,493,108,236,364,492,107,235,363,491,106,234,362,490,105,233,361,489,104,232,360,488,944,946,948,950,952,954,956,958,1008,1010,1012,1014,1016,1018,1020,1022,103,231,359,487,928,930,932,934,936,938,940,942,992,994,996,998,1000,1002,1004,1006,912,914,916,918,920,922,924,926,976,978,980,982,984,986,988,990,102,230,358,486,101,229,357,485,910,974,908,972,100,228,356,484,906,970,904,968,99,227,355,483,902,966,98,226,354,482,900,964,97,225,353,481,898,962,96,224,352,480,896,960,127,255,383,511,126,254,382,510,125,253,381,509,124,252,380,508,123,251,379,507,122,250,378,506,121,249,377,505,120,248,376,504,945,947,949,951,953,955,957,959,1009,1011,1013,1015,1017,1019,1021,1023,119,247,375,503,929,931,933,935,937,939,941,943,993,995,997,999,1001,1003,1005,1007,913,915,917,919,921,923,925,927,977,979,981,983,985,987,989,991,118,246,374,502,911,975,117,245,373,501,909,973,907,971,116,244,372,500,905,969,903,967,115,243,371,499,901,965,114,242,370,498,899,963,113,241,369,497,897,961,112,240,368,496};
constexpr int CTL_P3_QUEUE = 8192;
constexpr int CTL_CMP = 8192 + 64 * 9;
constexpr int CTL_TQ = 8192 + 64 * 8;
constexpr int CTL_LN0 = 4096, CTL_LN1 = 9216, CTL_TMO = 3520;
constexpr size_t WS_XCH0 = 253 * MiB, WS_XCH1 = 254 * MiB;

#ifndef REP_P0
#define REP_P0 1
#endif
#ifndef REP_P2
#define REP_P2 1
#endif
#ifndef REP_P3
#define REP_P3 1
#endif
#ifndef REP_P7
#define REP_P7 1
#endif
#ifndef REP_P8
#define REP_P8 1
#endif
__global__ void __launch_bounds__(512) __attribute__((target("no-packed-fp32-ops"))) fwd_megakernel(Params P) {
  cg::grid_group grid = cg::this_grid();
  extern __shared__ __attribute__((aligned(16))) unsigned char smem[];
  const int tid = otid(), lane = tid & 63, wid = tid >> 6;
  unsigned char* ws = P.ws;
  bf16_t* XB = (bf16_t*)(ws + WS_XB);
  bf16_t* MIX = (bf16_t*)(ws + WS_MIX);
  bf16_t* Hb = (bf16_t*)(ws + WS_H);
  float* Y = (float*)(ws + WS_H);
  volatile LAS unsigned* xst = (volatile LAS unsigned*)((LAS unsigned char*)smem + XB_LDS_OFF);
  if (tid < 4) xst[tid] = 0u;
  wg_sync();
  (void)xcd_barrier_post((unsigned*)ws, xst);
#define GRID_BAR() do { XcdBarrier xb_; xb_.bar = (unsigned*)P.ws; xb_.x = xb_xcc_id(); xb_.st = (volatile LAS unsigned*)((LAS unsigned char*)smem + XB_LDS_OFF); xcd_barrier(xb_); } while (0)

  for (int rep = 0; rep < REP_P0; ++rep) {
    const float4* x4 = (const float4*)P.in[0];
    const size_t n4 = (size_t)M_ * D_ / 4;
    {
      const size_t stride = (size_t)gridDim.x * 512;
      for (size_t i = (size_t)blockIdx.x * 512 + tid; i < n4; i += 8 * stride) {
        f32x4 v[8];
#pragma unroll
        for (int u = 0; u < 8; ++u) if (i + u * stride < n4) v[u] = __builtin_nontemporal_load((const f32x4*)x4 + i + u * stride);
#pragma unroll
        for (int u = 0; u < 8; ++u) if (i + u * stride < n4) { ushort4 o; o.x = f2bf(v[u][0]); o.y = f2bf(v[u][1]); o.z = f2bf(v[u][2]); o.w = f2bf(v[u][3]); ((ushort4*)XB)[i + u * stride] = o; }
      }
    }
    {
      constexpr int T0 = (P0 / 32) * 16, T1 = 32 * 16, T2 = (P1 / 32) * 16, T3 = 32 * 16, T4 = 2 * 4 * 32, T5 = 2 * 2 * 2;
      float* scr = (float*)smem + wid * (64 * 33);
      for (int it = blockIdx.x * 8 + wid; it < T0 + T1 + T2 + T3 + T4 + T5; it += gridDim.x * 8) {
        int r = it;
        if (r < T0) { transpose_wave_tile(P.in[1], D_, EVEN_IN, (bf16_t*)(ws + WS_WT0), 0, r, P0 / 32, scr, lane); continue; } r -= T0;
        if (r < T1 + T2 + T3) continue;  r -= T1 + T2 + T3;
        if (r < T4) { const int i = r >> 7; transpose_wave_tile(P.in[3] + (size_t)i * 2048 * 128, 2048, 128, (bf16_t*)(ws + WS_W1T) + (size_t)i * 128 * 2048, 2, r & 127, 4, scr, lane); continue; } r -= T4;
        { const int i = r >> 2; transpose_wave_tile(P.in[5] + (size_t)i * 128 * 64, 128, 64, (bf16_t*)(ws + WS_W2T) + (size_t)i * 64 * 128, 2, r & 3, 2, scr, lane); }
      }
      wg_sync();
    }
    for (int it = blockIdx.x + 132; it < 2 * 64 + 2 * 2 + 64; it += gridDim.x) {
      {
        const int t2 = it - 132, i = t2 >> 5, q = t2 & 31, hh = tid & 127, sub = tid >> 7;
        const float* pos = P.in[2] + i * 2048 + q * 64 + sub * 16;
        const float* w1 = P.in[3] + ((size_t)i * 2048 + q * 64 + sub * 16) * 128 + hh;
        float a = 0.f;
#pragma unroll
        for (int f = 0; f < 16; ++f) a += pos[f] * w1[f * 128];
        float* red = (float*)smem;
        red[sub * 128 + hh] = a;
        wg_sync();
        if (tid < 128) ((float*)(ws + WS_C1P))[(i * 32 + q) * 128 + tid] = (red[tid] + red[128 + tid]) + (red[256 + tid] + red[384 + tid]);
        wg_sync();
      }
    }
    for (int q = blockIdx.x * 512 + tid; q < B_ * 16 * 512; q += gridDim.x * 512) ((float*)(ws + WS_KM))[q] = 0.f;
    if (blockIdx.x == 0) { const int which = tid >> 8, r = tid & 255;
      unsigned* z = (unsigned*)(ws + (which == 0 ? (size_t)(248 * MiB) : (size_t)(249 * MiB)));
      const int bg = r >> 5, wd = r & 31; z[((size_t)bg * 256 + 255) * 32 + wd] = 0u; }
    GRID_BAR();
  }
  if (P.out == nullptr) grid.sync();
  { pg8::Gemm gm{XB, (const bf16_t*)(ws + WS_WT0), M_, P0, D_}; pg8::StaticOrder so; so.init(M_, P0, (int)gridDim.x, (int)blockIdx.x);
    pg8::EpiBf16s ep{Hb, P0, (3u << (C_NQ / 256)) | (3u << (C_MQ / 256)), C1, (float*)(ws + WS_KM), C_MK / 256}; pg8::gemm_phase<pg8::EpiBf16s, pg8::StaticOrder, true, true>((LAS unsigned char*)smem, gm, so, ep); }
  GRID_BAR();
  for (int rep = 0; rep < REP_P3; ++rep) {
    if ((int)blockIdx.x < 128) {
      compress_mfma_tile(P, (int)blockIdx.x, smem);
      asm volatile("s_waitcnt vmcnt(0)" ::: "memory");
      wg_sync();
      if (tid == 0) { __builtin_amdgcn_fence(__ATOMIC_RELEASE, "agent");
        (void)__hip_atomic_fetch_add((unsigned*)P.ws + CTL_CMP, 1u, __ATOMIC_RELAXED, __HIP_MEMORY_SCOPE_AGENT); }
    }
    bool cmp_ready = false;
    const int myx = (int)(xb_xcc_id() & 7u);
    int qx = myx;
    bool first = true;
    for (;;) {
      LAS int* qslot = (LAS int*)((LAS unsigned char*)smem + AT_MISC + 384);
      int it; const bool stat = first;
      if (first) { first = false; qx = (int)blockIdx.x & 7; it = ((int)blockIdx.x >> 3) ^ 16; }
      else {
        if (tid == 0) *qslot = 32 + (int)__hip_atomic_fetch_add((unsigned*)P.ws + CTL_P3_QUEUE + 64 * qx, 1u, __ATOMIC_RELAXED, __HIP_MEMORY_SCOPE_AGENT) - rep * 96;
        wg_sync();
        it = __builtin_amdgcn_readfirstlane(*qslot);
        wg_sync();
      }
      if (it >= 128) {
        if (tid == 0) {
          unsigned hd[8];
#pragma unroll
          for (int k = 0; k < 8; ++k) hd[k] = __hip_atomic_load((unsigned*)P.ws + CTL_P3_QUEUE + 64 * k, __ATOMIC_RELAXED, __HIP_MEMORY_SCOPE_AGENT);
          int best = -1; unsigned bh = 96u + (unsigned)rep * 96u;
#pragma unroll
          for (int k = 0; k < 8; ++k) { const int x = (myx + k) & 7; unsigned hx = 0u;
#pragma unroll
            for (int j = 0; j < 8; ++j) hx = (j == x) ? hd[j] : hx;
            if (hx < bh) { bh = hx; best = x; } }
          *qslot = best;
        }
        wg_sync();
        qx = __builtin_amdgcn_readfirstlane(*qslot);
        wg_sync();
        if (qx < 0) break;
        continue;
      }
      it += qx * 128;
      if (stat) qx = myx;
      const int e = p3_order[it], pl = e & 511;
      if ((e >> 9) && !cmp_ready) {
        if (tid == 0) { unsigned sp = 0u;
          while (__hip_atomic_load((unsigned*)P.ws + CTL_CMP, __ATOMIC_RELAXED, __HIP_MEMORY_SCOPE_AGENT) < 128u * (unsigned)(rep + 1)) { __builtin_amdgcn_s_sleep(2); if (++sp > (1u << 22)) break; }
          __builtin_amdgcn_fence(__ATOMIC_ACQUIRE, "agent");
          asm volatile("s_waitcnt vmcnt(0)" ::: "memory"); }
        wg_sync();
        cmp_ready = true;
      }
#ifdef FORCE_SAFE
      if (e >> 9) (void)nsa_mfma_item<true>(P, pl >> 7, (pl >> 6) & 1, pl & 63, smem);
      else (void)moba_mfma_item<true>(P, pl >> 7, (pl >> 4) & 7, pl & 15, smem);
#else
      if (e >> 9) { if (nsa_mfma_item<false>(P, pl >> 7, (pl >> 6) & 1, pl & 63, smem)) (void)nsa_mfma_item<true>(P, pl >> 7, (pl >> 6) & 1, pl & 63, smem); }
      else { if (moba_mfma_item<false>(P, pl >> 7, (pl >> 4) & 7, pl & 15, smem)) (void)moba_mfma_item<true>(P, pl >> 7, (pl >> 4) & 7, pl & 15, smem); }
#endif
    }
    {
      constexpr int T1 = 32 * 16, T2 = (P1 / 32) * 16, T3 = 32 * 16;
      float* scr = (float*)smem + wid * (64 * 33);
      LAS int* qslot = (LAS int*)((LAS unsigned char*)smem + XB_LDS_OFF + 128);
      for (;;) {
        wg_sync();
        if (tid == 0) *qslot = (int)__hip_atomic_fetch_add((unsigned*)P.ws + CTL_TQ, 8u, __ATOMIC_RELAXED, __HIP_MEMORY_SCOPE_AGENT) - rep * (T1 + T2 + T3 + 8 * 256);
        wg_sync();
        const int u0 = __builtin_amdgcn_readfirstlane(*qslot);
        if (u0 >= T1 + T2 + T3) break;
        const int r = u0 + wid;
        if (r < T1) transpose_wave_tile(P.in[6], D_, D_, (bf16_t*)(ws + WS_WO0), 3, r, 32, scr, lane);
        else if (r < T1 + T2) transpose_wave_tile(P.in[9], D_, ODD_IN, (bf16_t*)(ws + WS_WT1), 1, r - T1, P1 / 32, scr, lane);
        else if (r < T1 + T2 + T3) transpose_wave_tile(P.in[13], D_, D_, (bf16_t*)(ws + WS_WO1), 3, r - T1 - T2, 32, scr, lane);
      }
    }
    GRID_BAR();
  }
  if ((int)blockIdx.x < M_ / 64) rowgemm_block<0, true>(P, (int)blockIdx.x, (const bf16_t*)(ws + WS_WO0), (const float*)XB, nullptr, XB, P.in[7], P.in[8], smem);
  GRID_BAR();
  { pg8::Gemm gm{XB, (const bf16_t*)(ws + WS_WT1), M_, 3072, D_}; pg8::StaticOrder so; so.init(M_, 3072, (int)gridDim.x, (int)blockIdx.x);
    pg8::EpiBf16s ep{Hb, P1, 0u, 1.f, nullptr, 0}; pg8::gemm_phase<pg8::EpiBf16s, pg8::StaticOrder, true, true>((LAS unsigned char*)smem, gm, so, ep); }
  GRID_BAR();
  for (int rep = 0; rep < REP_P8; ++rep) {
    for (int j = (int)blockIdx.x; j < 512; j += 256) gla_prep_item(P, (j & 15) * 64 + ((j >> 4) & 1) * 32 + (j >> 5), smem);
    if ((int)blockIdx.x < 128) { const int w = (int)blockIdx.x, u = w >> 3, bh = (w & 7) + 8 * (u >> 3), eq = u & 3, seg = (u >> 2) & 1;
      gla_chain64(P, bh * 4 + eq, seg, smem); }
    else for (int j = 512 + (int)blockIdx.x - 128; j < 1024; j += 128) gla_prep_item(P, (j & 15) * 64 + ((j >> 4) & 1) * 32 + (j >> 5), smem);
    GRID_BAR();
  }
  if ((int)blockIdx.x < M_ / 64) rowgemm_block<1, false>(P, (int)blockIdx.x, (const bf16_t*)(ws + WS_WO1), (const float*)XB, P.out, nullptr, P.in[14], P.in[15], smem);
}

extern "C" void kernel_launch(void* const* d_in, const int* in_sizes, int n_in, void* d_out, int out_size,
                              void* d_ws, size_t ws_size, hipStream_t stream) {
  constexpr size_t kDynLds = 157696;
  static_assert((size_t)XB_LDS_OFF >= (size_t)G4_END && kDynLds <= 163840 && kDynLds >= (size_t)XB_LDS_OFF + 16 && (size_t)XB_LDS_OFF >= (size_t)AT_LDS_END && kDynLds >= (size_t)AT_LDS_END && kDynLds >= 2 * (size_t)GS_BYTES && kDynLds >= (size_t)pg8::STAGE_BYTES, "LDS");
  static int grid_blocks = 0;
  if (!grid_blocks) {
    int dev = 0, cus = 0, per_cu = 0;
    (void)hipGetDevice(&dev);
    (void)hipDeviceGetAttribute(&cus, hipDeviceAttributeMultiprocessorCount, dev);
    (void)hipFuncSetAttribute((const void*)fwd_megakernel, hipFuncAttributeMaxDynamicSharedMemorySize, (int)kDynLds);
    (void)hipOccupancyMaxActiveBlocksPerMultiprocessor(&per_cu, fwd_megakernel, 512, kDynLds);
    if (per_cu < 1) per_cu = 1;
    if (per_cu > 2) per_cu = 2;
    grid_blocks = cus * per_cu;
    if (grid_blocks != 256) { fprintf(stderr, "kernel_launch: this kernel is laid out for exactly 256 co-resident workgroups (256 CUs x 1); got %d x %d\n", cus, per_cu); grid_blocks = 256; }
    if (n_in != 16 || ws_size < WS_END) { fprintf(stderr, "kernel_launch: unexpected n_in %d / ws %zu\n", n_in, ws_size); }
  }
  (void)hipMemsetAsync(d_ws, 0, 524288, stream);
  Params p{};
  for (int i = 0; i < 16; ++i) p.in[i] = (const float*)d_in[i];
  p.out = (float*)d_out; p.ws = (unsigned char*)d_ws;
  void* args[] = {&p};
  hipError_t e = hipLaunchCooperativeKernel((void*)fwd_megakernel, dim3(grid_blocks), dim3(512), args, kDynLds, stream);
  if (e != hipSuccess) fprintf(stderr, "cooperative launch failed: %s (grid %d)\n", hipGetErrorString(e), grid_blocks);
}
```
